# Optimizing an MI355X kernel written in HIP

```python
import jax, jax.numpy as jnp
from jax import lax
import numpy as np

D_MODEL = 1024
BATCH = 16
SEQ = 2048
DEPTH = 4
DEC_BATCH = 8
DEC_SEQ = 4096
PAST_LEN = 128

GRID_W = 64
RMS_EPS = 1e-6
F_FLOOR = 1e-30
MASK_VALUE = -1e30
D_FF = 2816
HG_HEADS = 4
HG_DK = 128
HG_DV = 128
HG_KWIDTH = HG_HEADS * HG_DK
HG_WIDTH = HG_HEADS * HG_DV
HG_CHUNK = 64
CV_GROUPS = 4
CV_GROUP_DIM = 128
CV_WIDTH = CV_GROUPS * CV_GROUP_DIM
CONV_K = 3
NA_HEADS = 8
NA_DH = 64
NA_WIDTH = NA_HEADS * NA_DH
NA_KH = 8
NA_KW = 16
NA_QB = 16
NA_NQB = GRID_W // NA_QB
NA_KBW = NA_QB + NA_KW
NA_SCALE = NA_DH ** -0.5
IN_WIDTHS = (HG_KWIDTH, HG_WIDTH, HG_KWIDTH, HG_KWIDTH, HG_WIDTH,
             CV_WIDTH, CV_WIDTH, CV_WIDTH,
             NA_WIDTH, NA_WIDTH, NA_WIDTH,
             D_MODEL, D_MODEL, D_MODEL)
N_IN = sum(IN_WIDTHS)

kernel_name = 'hybrid_bidir_hgrn2_conv_natten_encoder'


def rmsnorm(x, gain):
    x32 = x.astype(jnp.float32)
    y = x32 * lax.rsqrt(jnp.mean(x32 * x32, axis=-1, keepdims=True) + RMS_EPS)
    return (y * gain.astype(jnp.float32)).astype(x.dtype)


def swiglu_ffn(x, norm_g, w_gu, w_down):
    h = rmsnorm(x, norm_g) @ w_gu
    a, b = jnp.split(h, 2, axis=-1)
    return (jax.nn.silu(a) * b) @ w_down


def hgrn2_lower_bounds(lb_logits):
    p = jax.nn.softmax(lb_logits.astype(jnp.float32), axis=1)
    return jnp.cumsum(p, axis=1) - p[:, :1]


def hgrn2_gates(z, lb):
    z32 = z.astype(jnp.float32)
    f = lb + (1.0 - lb) * jax.nn.sigmoid(z32)
    logf = jnp.log(jnp.maximum(f, F_FLOOR))
    k = (1.0 - lb) * jax.nn.sigmoid(-z32)
    return k, logf


def hgrn2_chunk_scan(q, k, v, logf):
    B, T, H, DK = q.shape
    DV = v.shape[-1]
    C = HG_CHUNK
    N = T // C

    def to_chunks(a):
        return a.reshape(B, N, C, H, a.shape[-1]).transpose(1, 0, 3, 2, 4)

    tri = jnp.asarray(np.tril(np.ones((C, C), dtype=bool)))[:, :, None]

    def step(S, inp):
        qc, kc, vc, lc = inp
        b = jnp.cumsum(lc, axis=2)
        o_inter = jnp.einsum('bhtk,bhkv->bhtv', qc * jnp.exp(b), S)
        diff = b[:, :, :, None, :] - b[:, :, None, :, :]
        decay = jnp.where(tri, jnp.exp(jnp.where(tri, diff, 0.0)), 0.0)
        A = jnp.einsum('bhtk,bhtsk->bhts', qc, decay * kc[:, :, None, :, :])
        o_intra = jnp.einsum('bhts,bhsv->bhtv', A, vc)
        b_end = b[:, :, -1, :]
        S = jnp.exp(b_end)[..., None] * S + jnp.einsum(
            'bhsk,bhsv->bhkv', kc * jnp.exp(b_end[:, :, None, :] - b), vc)
        return S, o_inter + o_intra

    S0 = jnp.zeros((B, H, DK, DV), jnp.float32)
    _, o = lax.scan(step, S0, (to_chunks(q), to_chunks(k), to_chunks(v), to_chunks(logf)))
    return o.transpose(1, 0, 3, 2, 4).reshape(B, T, H, DV)


def neighbourhood_attention(q, k, v, rpb):
    B, T, H, dh = q.shape
    rows = T // GRID_W
    kh = min(NA_KH, rows)
    qg = q.reshape(B, rows, NA_NQB, NA_QB, H, dh).transpose(1, 0, 2, 3, 4, 5)
    kg = k.reshape(B, rows, GRID_W, H, dh)
    vg = v.reshape(B, rows, GRID_W, H, dh)
    qcol = np.arange(GRID_W).reshape(NA_NQB, NA_QB)
    kstart = np.clip(np.arange(NA_NQB) * NA_QB - NA_KW // 2, 0, GRID_W - NA_KBW)
    kcol = kstart[:, None] + np.arange(NA_KBW)
    cs = np.clip(qcol - NA_KW // 2, 0, GRID_W - NA_KW)
    col_ok = jnp.asarray((kcol[:, None, :] >= cs[..., None]) & (kcol[:, None, :] < cs[..., None] + NA_KW))
    dc = np.clip(kcol[:, None, :] - qcol[..., None] + NA_KW - 1, 0, 2 * NA_KW - 2)
    rpb_col = rpb.astype(jnp.float32)[:, :, dc]

    def one_row(args):
        r, q_row = args
        rs = jnp.clip(r - kh // 2, 0, rows - kh)
        k_win = lax.dynamic_slice_in_dim(kg, rs, kh, axis=1)[:, :, kcol]
        v_win = lax.dynamic_slice_in_dim(vg, rs, kh, axis=1)[:, :, kcol]
        s = jnp.einsum('bjqhd,bajkhd->bhjqak', q_row, k_win).astype(jnp.float32) * NA_SCALE
        dr = rs + jnp.arange(kh) - r + NA_KH - 1
        bias = jnp.take(rpb_col, dr, axis=1).transpose(0, 2, 3, 1, 4)
        s = jnp.where(col_ok[:, :, None, :], s + bias, MASK_VALUE)
        p = jax.nn.softmax(s, axis=(-2, -1))
        o = jnp.einsum('bhjqak,bajkhd->bjqhd', p.astype(v_win.dtype), v_win)
        return o.reshape(B, GRID_W, H * dh)

    out = lax.map(one_row, (jnp.arange(rows), qg))
    return out.transpose(1, 0, 2, 3).reshape(B, T, H * dh)


def hybrid_mixer(u, layer_lb, w_in, hg_out_norm, w_hg_out, conv_w, conv_b, w_cv_out,
                 na_rpb, w_na_out, w_out):
    B, T, _ = u.shape
    proj = u @ w_in
    splits = np.cumsum(IN_WIDTHS)[:-1].tolist()
    (hq, hi, hzf, hzb, hg, ca, cb, cc, nq, nk, nv, g_hg, g_cv, g_na) = jnp.split(proj, splits, axis=-1)

    q = hq.reshape(B, T, HG_HEADS, HG_DK).astype(jnp.float32)
    v = hi.reshape(B, T, HG_HEADS, HG_DV).astype(jnp.float32)
    k_f, logf_f = hgrn2_gates(hzf.reshape(B, T, HG_HEADS, HG_DK), layer_lb[0].reshape(HG_HEADS, HG_DK))
    k_b, logf_b = hgrn2_gates(hzb.reshape(B, T, HG_HEADS, HG_DK), layer_lb[1].reshape(HG_HEADS, HG_DK))
    flip = lambda a: jnp.flip(a, axis=1)
    o = hgrn2_chunk_scan(q, k_f, v, logf_f) + flip(hgrn2_chunk_scan(flip(q), flip(k_b), flip(v), flip(logf_b)))
    o = o * lax.rsqrt(jnp.mean(o * o, axis=-1, keepdims=True) + RMS_EPS) \
        * hg_out_norm.astype(jnp.float32).reshape(HG_HEADS, HG_DV)
    o = o.reshape(B, T, HG_WIDTH) * jax.nn.silu(hg.astype(jnp.float32))
    y_hg = o.astype(u.dtype) @ w_hg_out

    z = cc * ca
    zc = lax.conv_general_dilated(z, conv_w[:, None, :].astype(z.dtype), window_strides=(1,),
                                  padding=((CONV_K // 2, CONV_K // 2),),
                                  dimension_numbers=('NWC', 'WIO', 'NWC'),
                                  feature_group_count=CV_WIDTH)
    y_cv = (cb * (zc + conv_b)) @ w_cv_out

    o_na = neighbourhood_attention(nq.reshape(B, T, NA_HEADS, NA_DH), nk.reshape(B, T, NA_HEADS, NA_DH),
                                   nv.reshape(B, T, NA_HEADS, NA_DH), na_rpb)
    y_na = o_na @ w_na_out

    m = jax.nn.sigmoid(g_hg) * y_hg + jax.nn.sigmoid(g_cv) * y_cv + jax.nn.sigmoid(g_na) * y_na
    return m @ w_out


def run_trunk(x, ffn1_norm, ffn1_w_gu, ffn1_w_down, mix_norm, w_in, hg_lb_logits, hg_out_norm,
              w_hg_out, conv_w, conv_b, w_cv_out, na_rpb, w_na_out, w_out,
              ffn2_norm, ffn2_w_gu, ffn2_w_down, final_norm):
    lb_all = hgrn2_lower_bounds(hg_lb_logits)
    for l in range(DEPTH):
        x = x + 0.5 * swiglu_ffn(x, ffn1_norm[l], ffn1_w_gu[l], ffn1_w_down[l])
        x = x + hybrid_mixer(rmsnorm(x, mix_norm[l]), lb_all[:, l], w_in[l], hg_out_norm[l], w_hg_out[l],
                             conv_w[l], conv_b[l], w_cv_out[l], na_rpb[l], w_na_out[l], w_out[l])
        x = x + 0.5 * swiglu_ffn(x, ffn2_norm[l], ffn2_w_gu[l], ffn2_w_down[l])
    return rmsnorm(x, final_norm)


def setup_inputs(seed: int = 0) -> dict:
    key = jax.random.key(seed)
    ks = jax.random.split(key, 24)
    nrm = lambda k, shape, scale: jax.random.normal(k, shape, jnp.float32) * scale
    L, D = DEPTH, D_MODEL
    return {
        'x_prompt': nrm(ks[0], (BATCH, SEQ, D), 1.0),
        'x_sample': nrm(ks[1], (DEC_BATCH, DEC_SEQ, D), 1.0),
        'ffn1_norm': 1.0 + nrm(ks[2], (L, D), 0.02),
        'ffn1_w_gu': nrm(ks[3], (L, D, 2 * D_FF), D ** -0.5),
        'ffn1_w_down': nrm(ks[4], (L, D_FF, D), D_FF ** -0.5),
        'mix_norm': 1.0 + nrm(ks[5], (L, D), 0.02),
        'w_in': nrm(ks[6], (L, D, N_IN), D ** -0.5),
        'hg_lb_logits': 1.0 + nrm(ks[7], (2, L, HG_KWIDTH), 0.1),
        'hg_out_norm': 1.0 + nrm(ks[8], (L, HG_WIDTH), 0.02),
        'w_hg_out': nrm(ks[9], (L, HG_WIDTH, D), HG_WIDTH ** -0.5),
        'conv_w': nrm(ks[10], (L, CONV_K, CV_WIDTH), CONV_K ** -0.5),
        'conv_b': nrm(ks[11], (L, CV_WIDTH), 0.01),
        'w_cv_out': nrm(ks[12], (L, CV_WIDTH, D), CV_WIDTH ** -0.5),
        'na_rpb': nrm(ks[13], (L, NA_HEADS, 2 * NA_KH - 1, 2 * NA_KW - 1), 0.1),
        'w_na_out': nrm(ks[14], (L, NA_WIDTH, D), NA_WIDTH ** -0.5),
        'w_out': nrm(ks[15], (L, D, D), D ** -0.5),
        'ffn2_norm': 1.0 + nrm(ks[16], (L, D), 0.02),
        'ffn2_w_gu': nrm(ks[17], (L, D, 2 * D_FF), D ** -0.5),
        'ffn2_w_down': nrm(ks[18], (L, D_FF, D), D_FF ** -0.5),
        'final_norm': 1.0 + nrm(ks[19], (D,), 0.02),
    }


def reference(x_prompt, x_sample, ffn1_norm, ffn1_w_gu, ffn1_w_down, mix_norm, w_in, hg_lb_logits,
              hg_out_norm, w_hg_out, conv_w, conv_b, w_cv_out, na_rpb, w_na_out, w_out,
              ffn2_norm, ffn2_w_gu, ffn2_w_down, final_norm):
    y_prompt = run_trunk(x_prompt, ffn1_norm, ffn1_w_gu, ffn1_w_down, mix_norm, w_in, hg_lb_logits,
                         hg_out_norm, w_hg_out, conv_w, conv_b, w_cv_out, na_rpb, w_na_out, w_out,
                         ffn2_norm, ffn2_w_gu, ffn2_w_down, final_norm)
    y_sample = run_trunk(x_sample, ffn1_norm, ffn1_w_gu, ffn1_w_down, mix_norm, w_in, hg_lb_logits,
                         hg_out_norm, w_hg_out, conv_w, conv_b, w_cv_out, na_rpb, w_na_out, w_out,
                         ffn2_norm, ffn2_w_gu, ffn2_w_down, final_norm)
    return (y_prompt, y_sample)
```

```cpp
#include <hip/hip_runtime.h>
#include <hip/hip_cooperative_groups.h>
#include <cstdio>
#include <cstdint>
namespace cg = cooperative_groups;
#ifndef ONE_LAUNCH
#define ONE_LAUNCH 1
#endif
namespace pg8 {
#define PG8_LAS __attribute__((address_space(3)))
typedef unsigned short bf16_t;
typedef short bf16x8 __attribute__((ext_vector_type(8)));
typedef float f32x4 __attribute__((ext_vector_type(4)));
typedef unsigned u32x4 __attribute__((ext_vector_type(4)));
constexpr int BM = 256, BK = 64, HALF = 128, HTB = HALF * BK * 2  , STAGE_BYTES = 8 * HTB, NXCD = 8, WGM = 8;

__host__ __device__ __forceinline__ int lds_byte(int r, int c) { const int st = (r >> 4) * 2 + (c >> 5), rr = r & 15, cc = c & 31, ob = rr * 64 + cc * 2; return st * 1024 + (ob ^ (((ob >> 9) & 1) << 5)); }
__host__ __device__ __forceinline__ void stage_rc(int b, int& R, int& C) { const int st = b / 1024, sb = b % 1024, swz = sb ^ (((sb >> 9) & 1) << 5); R = (st >> 1) * 16 + swz / 64; C = (st & 1) * 32 + (swz % 64) / 2; }
__host__ __device__ __forceinline__ int perm32(int rho) { const int n = rho >> 4, i = rho & 15; return 8 * (i >> 2) + 4 * n + (i & 3); }

struct Unit { int pm, pn; };
struct Gemm { const bf16_t* A; const bf16_t* Bt; int M, N, K; };

struct StaticOrder {
    int nM, nN, nwg, G, c;
    __host__ __device__ void init(int M, int N, int G_, int c_) { nM = M / BM; nN = N / BM; nwg = nM * nN; G = G_; c = c_; }
    __host__ __device__ bool next(int i, Unit& u) const {
        const long L = (long)i * G + c; if (L >= nwg) return false;
        int wgid = (int)L; { const int q = nwg / NXCD, r = nwg % NXCD, xcd = wgid % NXCD, off = wgid / NXCD; wgid = (xcd < r ? xcd * (q + 1) : r * (q + 1) + (xcd - r) * q) + off; }
        const int nig = WGM * nN, gid = wgid / nig, fm = gid * WGM, gsz = (nM - fm) < WGM ? (nM - fm) : WGM;
        u.pm = fm + ((wgid % nig) % gsz); u.pn = (wgid % nig) / gsz; return true;
    }
    __device__ __forceinline__ void a_ready(const Unit&) const {}
    __device__ __forceinline__ void done(const Unit&) const {}
};

__device__ __forceinline__ unsigned cvt_pk_bf16(float lo, float hi) { unsigned r; asm volatile("v_cvt_pk_bf16_f32 %0, %1, %2" : "=v"(r) : "v"(lo), "v"(hi)); return r; }
__device__ __forceinline__ float row_rs(const float* ssq, int row) {
    const f32x4* p = (const f32x4*)(ssq + (size_t)row * 16);
    const f32x4 a = p[0], b = p[1], c = p[2], d = p[3];
    const float s = (((a[0] + a[1]) + (a[2] + a[3])) + ((b[0] + b[1]) + (b[2] + b[3]))) + (((c[0] + c[1]) + (c[2] + c[3])) + ((d[0] + d[1]) + (d[2] + d[3])));
    return __builtin_amdgcn_rsqf(s * (1.0f / 1024.0f) + 1e-6f);
}
__device__ __forceinline__ float sigm(float v) { return __builtin_amdgcn_rcpf(1.0f + __expf(-v)); }

struct EpiSwiGLU {
    static constexpr bool PERM = true, AFTER_DRAIN = false;
    bf16_t* H; const float* ssq;
    __device__ __forceinline__ void operator()(const f32x4 (&acc)[2][2][4][2], const Unit& u, int wr, int wc, int fr, int fq) const {
        const int row0 = u.pm * BM + wr * 64 + fr, col0 = u.pn * 128 + wc * 32 + 8 * fq;
#pragma unroll
        for (int ai = 0; ai < 2; ++ai)
#pragma unroll
            for (int m = 0; m < 4; ++m) {
                const int row = row0 + ai * HALF + m * 16; const float rs = row_rs(ssq, row);
                u32x4 w;
#pragma unroll
                for (int n = 0; n < 2; ++n) {
                    const f32x4 a = acc[ai][0][m][n] * rs, b = acc[ai][1][m][n] * rs; f32x4 h;
#pragma unroll
                    for (int e = 0; e < 4; ++e) h[e] = a[e] * sigm(a[e]) * b[e];
                    w[2 * n] = cvt_pk_bf16(h[0], h[1]); w[2 * n + 1] = cvt_pk_bf16(h[2], h[3]);
                }
                *(u32x4*)(H + (size_t)row * 2816 + col0) = w;
                asm volatile("" ::: "memory");
            }
    }
};
struct EpiRes {
    static constexpr bool PERM = true, AFTER_DRAIN = false;
    float* X; bf16_t* XB; float* ssq; float alpha;
    __device__ __forceinline__ void operator()(const f32x4 (&acc)[2][2][4][2], const Unit& u, int wr, int wc, int fr, int fq) const {
        const int row0 = u.pm * BM + wr * 64 + fr, col0 = u.pn * BM + wc * 32 + 8 * fq;
#pragma unroll
        for (int ai = 0; ai < 2; ++ai)
#pragma unroll
            for (int m = 0; m < 4; ++m) {
                const int row = row0 + ai * HALF + m * 16; float ss = 0.f;
#pragma unroll
                for (int bj = 0; bj < 2; ++bj) {
                    float* xp = X + (size_t)row * 1024 + col0 + bj * HALF;
                    f32x4 x0 = *(const f32x4*)xp, x1 = *(const f32x4*)(xp + 4);
                    x0 = x0 + acc[ai][bj][m][0] * alpha; x1 = x1 + acc[ai][bj][m][1] * alpha;
                    *(f32x4*)xp = x0; *(f32x4*)(xp + 4) = x1;
                    u32x4 w; w.x = cvt_pk_bf16(x0[0], x0[1]); w.y = cvt_pk_bf16(x0[2], x0[3]); w.z = cvt_pk_bf16(x1[0], x1[1]); w.w = cvt_pk_bf16(x1[2], x1[3]);
                    *(u32x4*)(XB + (size_t)row * 1024 + col0 + bj * HALF) = w;
                    ss += ((x0[0] * x0[0] + x0[1] * x0[1]) + (x0[2] * x0[2] + x0[3] * x0[3])) + ((x1[0] * x1[0] + x1[1] * x1[1]) + (x1[2] * x1[2] + x1[3] * x1[3]));
                }
                ss += __shfl_xor(ss, 16); ss += __shfl_xor(ss, 32);
                if (fq == 0) ssq[(size_t)row * 16 + u.pn * 4 + wc] = ss;
                asm volatile("" ::: "memory");
            }
    }
};
struct EpiProj {
    static constexpr bool PERM = true, AFTER_DRAIN = false;
    bf16_t* PA; bf16_t* PG; const float* ssq;
    __device__ __forceinline__ void operator()(const f32x4 (&acc)[2][2][4][2], const Unit& u, int wr, int wc, int fr, int fq) const {
        const int row0 = u.pm * BM + wr * 64 + fr;
        bf16_t* base; int ld, colt;
        if (u.pn < 22) { base = PA; ld = 5632; colt = u.pn * BM; } else { base = PG; ld = 3072; colt = (u.pn - 22) * BM; }
        const int col0 = colt + wc * 32 + 8 * fq;
#pragma unroll
        for (int ai = 0; ai < 2; ++ai)
#pragma unroll
            for (int m = 0; m < 4; ++m) {
                const int row = row0 + ai * HALF + m * 16; const float rs = row_rs(ssq, row);
#pragma unroll
                for (int bj = 0; bj < 2; ++bj) {
                    const f32x4 v0 = acc[ai][bj][m][0] * rs, v1 = acc[ai][bj][m][1] * rs;
                    u32x4 w; w.x = cvt_pk_bf16(v0[0], v0[1]); w.y = cvt_pk_bf16(v0[2], v0[3]); w.z = cvt_pk_bf16(v1[0], v1[1]); w.w = cvt_pk_bf16(v1[2], v1[3]);
                    *(u32x4*)(base + (size_t)row * ld + col0 + bj * HALF) = w;
                }
                asm volatile("" ::: "memory");
            }
    }
};
template <int I> struct EpiMerge {
    static constexpr bool PERM = true, AFTER_DRAIN = false;
    const bf16_t* PG; float* MF; bf16_t* MB;
    __device__ __forceinline__ void operator()(const f32x4 (&acc)[2][2][4][2], const Unit& u, int wr, int wc, int fr, int fq) const {
        const int row0 = u.pm * BM + wr * 64 + fr, col0 = u.pn * BM + wc * 32 + 8 * fq;
#pragma unroll
        for (int ai = 0; ai < 2; ++ai)
#pragma unroll
            for (int m = 0; m < 4; ++m) {
                const int row = row0 + ai * HALF + m * 16;
#pragma unroll
                for (int bj = 0; bj < 2; ++bj) {
                    const int col = col0 + bj * HALF;
                    const u32x4 gw = *(const u32x4*)(PG + (size_t)row * 3072 + I * 1024 + col);
                    f32x4 g0, g1;
                    g0[0] = __uint_as_float(gw.x << 16); g0[1] = __uint_as_float(gw.x & 0xffff0000u); g0[2] = __uint_as_float(gw.y << 16); g0[3] = __uint_as_float(gw.y & 0xffff0000u);
                    g1[0] = __uint_as_float(gw.z << 16); g1[1] = __uint_as_float(gw.z & 0xffff0000u); g1[2] = __uint_as_float(gw.w << 16); g1[3] = __uint_as_float(gw.w & 0xffff0000u);
                    f32x4 t0, t1;
#pragma unroll
                    for (int e = 0; e < 4; ++e) { t0[e] = sigm(g0[e]) * acc[ai][bj][m][0][e]; t1[e] = sigm(g1[e]) * acc[ai][bj][m][1][e]; }
                    float* mp = MF + (size_t)row * 1024 + col;
                    if (I > 0) { t0 = t0 + *(const f32x4*)mp; t1 = t1 + *(const f32x4*)(mp + 4); }
                    if (I < 2) { *(f32x4*)mp = t0; *(f32x4*)(mp + 4) = t1; }
                    else { u32x4 w; w.x = cvt_pk_bf16(t0[0], t0[1]); w.y = cvt_pk_bf16(t0[2], t0[3]); w.z = cvt_pk_bf16(t1[0], t1[1]); w.w = cvt_pk_bf16(t1[2], t1[3]);
                           *(u32x4*)(MB + (size_t)row * 1024 + col) = w; }
                }
                asm volatile("" ::: "memory");
            }
    }
};
template <class Epi, class Sched, bool ALIGN_EPI = false, bool SP2 = false>
__device__ __forceinline__ void gemm_phase(PG8_LAS unsigned char* lds, const Gemm g, const Sched& S, const Epi& E) {
    int tid = threadIdx.x; asm volatile("" : "+v"(tid));
    const int wid = __builtin_amdgcn_readfirstlane(tid >> 6), lane = tid & 63, wr = wid >> 2, wc = wid & 3, fr = lane & 15, fq = lane >> 4;
    const int K = g.K, nt = K / BK;
    unsigned voffA[2], voffB[2];
#pragma unroll
    for (int i = 0; i < 2; ++i) { int R, C; stage_rc(tid * 16 + i * 8192, R, C); const int Rb = Epi::PERM ? ((R & ~31) + perm32(R & 31)) : R;
        voffA[i] = (unsigned)(R * K + C) * 2u; voffB[i] = (unsigned)(Rb * K + C) * 2u; }
    const size_t kstep = (size_t)(BK * 2);
    const size_t hstep = (size_t)HALF * K * 2;
    const size_t tstep = 2 * hstep;
    const unsigned ldsw = (unsigned)wid * 1024u;
    const int aoff = lds_byte(wr * 64 + fr, fq * 8), boff = lds_byte(wc * 32 + fr, fq * 8);
#define PG8_SA(b, h) (((b) * 2 + (h)) * HTB)
#define PG8_SB(b, h) ((4 + (b) * 2 + (h)) * HTB)
#define PG8_STAGE(bufoff, gbase, voff) do { _Pragma("unroll") for (int _i = 0; _i < 2; ++_i) \
        __builtin_amdgcn_global_load_lds((const unsigned*)((const char*)(gbase) + (voff)[_i]), (PG8_LAS unsigned*)(lds + (bufoff) + ldsw + _i * 8192), 16, 0, 0); } while (0)
#define PG8_LDA(dst, b, h) do { _Pragma("unroll") for (int m = 0; m < 4; ++m) _Pragma("unroll") for (int k = 0; k < 2; ++k) dst[m][k] = *(const PG8_LAS bf16x8*)(lds + PG8_SA(b, h) + aoff + m * 2048 + k * 1024); } while (0)
#define PG8_LDB(dst, b, h) do { _Pragma("unroll") for (int n = 0; n < 2; ++n) _Pragma("unroll") for (int k = 0; k < 2; ++k) dst[n][k] = *(const PG8_LAS bf16x8*)(lds + PG8_SB(b, h) + boff + n * 2048 + k * 1024); } while (0)
#define PG8_MMA(ai, bj, At, Bt) do { __builtin_amdgcn_s_setprio(1); _Pragma("unroll") for (int m = 0; m < 4; ++m) _Pragma("unroll") for (int n = 0; n < 2; ++n) _Pragma("unroll") for (int k = 0; k < 2; ++k) \
        acc[ai][bj][m][n] = __builtin_amdgcn_mfma_f32_16x16x32_bf16(Bt[n][k], At[m][k], acc[ai][bj][m][n], 0, 0, 0); __builtin_amdgcn_s_setprio(0); } while (0)
#define PG8_WAIT_V(n) asm volatile("s_waitcnt vmcnt(" #n ")" ::: "memory")
#define PG8_WAIT_L(n) asm volatile("s_waitcnt lgkmcnt(" #n ")" ::: "memory")
#define PG8_BAR __builtin_amdgcn_s_barrier()
#define PG8_SCHED __builtin_amdgcn_sched_barrier(0)
    Unit cur, nxt; int ui = 0;
    if (!S.next(0, cur)) return;
    f32x4 acc[2][2][4][2];
#pragma unroll
    for (int a = 0; a < 2; ++a)
#pragma unroll
        for (int b = 0; b < 2; ++b)
#pragma unroll
            for (int m = 0; m < 4; ++m)
#pragma unroll
                for (int n = 0; n < 2; ++n) acc[a][b][m][n] = (f32x4){0.f, 0.f, 0.f, 0.f};
    bf16x8 At[4][2], B0[2][2], B1[2][2];
    const char* cA = (const char*)g.A + (size_t)cur.pm * tstep; const char* cB = (const char*)g.Bt + (size_t)cur.pn * tstep;
    S.a_ready(cur);
    if constexpr (SP2) {
        PG8_STAGE(PG8_SB(0, 0), cB, voffB); PG8_STAGE(PG8_SB(0, 1), cB + hstep, voffB); PG8_STAGE(PG8_SA(0, 0), cA, voffA); PG8_STAGE(PG8_SA(0, 1), cA + hstep, voffA);
        if (wr == 1) PG8_BAR;
        PG8_WAIT_V(2); PG8_BAR;
        PG8_STAGE(PG8_SB(1, 0), cB + kstep, voffB); PG8_STAGE(PG8_SA(1, 0), cA + kstep, voffA); PG8_STAGE(PG8_SB(1, 1), cB + hstep + kstep, voffB);
        PG8_WAIT_V(6); PG8_BAR;
    } else {
        PG8_STAGE(PG8_SB(0, 0), cB, voffB); PG8_STAGE(PG8_SA(0, 0), cA, voffA); PG8_STAGE(PG8_SB(0, 1), cB + hstep, voffB); PG8_STAGE(PG8_SA(0, 1), cA + hstep, voffA);
        if (wr == 1) PG8_BAR;
        PG8_WAIT_V(4); PG8_BAR;
        PG8_STAGE(PG8_SB(1, 0), cB + kstep, voffB); PG8_STAGE(PG8_SA(1, 0), cA + kstep, voffA); PG8_STAGE(PG8_SB(1, 1), cB + hstep + kstep, voffB);
        PG8_WAIT_V(6); PG8_BAR;
    }
    for (;;) {
        const bool has_next = S.next(ui + 1, nxt);
        const char* nA = has_next ? (const char*)g.A + (size_t)nxt.pm * tstep : cA; const char* nB = has_next ? (const char*)g.Bt + (size_t)nxt.pn * tstep : cB;
        for (int t = 0; t < nt; t += 2) {
            const bool last = (t == nt - 2);
            const char* a1 = cA + (size_t)(t + 1) * kstep;
            const char* a2 = last ? nA : cA + (size_t)(t + 2) * kstep; const char* b2 = last ? nB : cB + (size_t)(t + 2) * kstep;
            const char* a3 = a2 + kstep; const char* b3 = b2 + kstep;
            if (last && has_next) S.a_ready(nxt);
            if constexpr (SP2) {
            PG8_LDB(B0, 0, 0); PG8_LDB(B1, 0, 1); PG8_SCHED; PG8_LDA(At, 0, 0); PG8_STAGE(PG8_SA(1, 1), a1 + hstep, voffA);
            PG8_WAIT_V(8); PG8_WAIT_L(0); PG8_BAR; PG8_MMA(0, 0, At, B0); PG8_MMA(0, 1, At, B1); PG8_BAR; PG8_SCHED;
            PG8_LDA(At, 0, 1); PG8_STAGE(PG8_SB(0, 0), b2, voffB); PG8_STAGE(PG8_SB(0, 1), b2 + hstep, voffB); PG8_STAGE(PG8_SA(0, 0), a2, voffA);
            PG8_WAIT_V(8); PG8_WAIT_L(0); PG8_BAR; PG8_MMA(1, 0, At, B0); PG8_MMA(1, 1, At, B1); PG8_BAR; PG8_SCHED;
            PG8_LDB(B0, 1, 0); PG8_LDB(B1, 1, 1); PG8_SCHED; PG8_LDA(At, 1, 0); PG8_STAGE(PG8_SA(0, 1), a2 + hstep, voffA);
            PG8_WAIT_V(8); PG8_WAIT_L(0); PG8_BAR; PG8_MMA(0, 0, At, B0); PG8_MMA(0, 1, At, B1); PG8_BAR; PG8_SCHED;
            PG8_LDA(At, 1, 1); PG8_STAGE(PG8_SB(1, 0), b3, voffB); PG8_STAGE(PG8_SB(1, 1), b3 + hstep, voffB); PG8_STAGE(PG8_SA(1, 0), a3, voffA);
            PG8_WAIT_V(8); PG8_WAIT_L(0); PG8_BAR; PG8_MMA(1, 0, At, B0); PG8_MMA(1, 1, At, B1); PG8_BAR; PG8_SCHED;
            } else {
            PG8_LDB(B0, 0, 0); PG8_SCHED; PG8_LDA(At, 0, 0); PG8_STAGE(PG8_SA(1, 1), a1 + hstep, voffA);
            PG8_WAIT_L(8); PG8_BAR; PG8_WAIT_L(0); PG8_MMA(0, 0, At, B0); PG8_BAR; PG8_SCHED;
            PG8_LDB(B1, 0, 1); PG8_STAGE(PG8_SB(0, 0), b2, voffB);
            PG8_BAR; PG8_WAIT_L(0); PG8_MMA(0, 1, At, B1); PG8_BAR;
            PG8_LDA(At, 0, 1); PG8_STAGE(PG8_SA(0, 0), a2, voffA);
            PG8_BAR; PG8_WAIT_L(0); PG8_MMA(1, 0, At, B0); PG8_BAR; PG8_SCHED;
            PG8_STAGE(PG8_SB(0, 1), b2 + hstep, voffB);
            PG8_WAIT_V(6); PG8_BAR; PG8_MMA(1, 1, At, B1); PG8_BAR;
            PG8_LDB(B0, 1, 0); PG8_SCHED; PG8_LDA(At, 1, 0); PG8_STAGE(PG8_SA(0, 1), a2 + hstep, voffA);
            PG8_WAIT_L(8); PG8_BAR; PG8_WAIT_L(0); PG8_MMA(0, 0, At, B0); PG8_BAR; PG8_SCHED;
            PG8_LDB(B1, 1, 1); PG8_STAGE(PG8_SB(1, 0), b3, voffB);
            PG8_BAR; PG8_WAIT_L(0); PG8_MMA(0, 1, At, B1); PG8_BAR;
            PG8_LDA(At, 1, 1); PG8_STAGE(PG8_SA(1, 0), a3, voffA);
            PG8_BAR; PG8_WAIT_L(0); PG8_MMA(1, 0, At, B0); PG8_BAR; PG8_SCHED;
            PG8_STAGE(PG8_SB(1, 1), b3 + hstep, voffB);
            PG8_WAIT_V(6); PG8_BAR; PG8_MMA(1, 1, At, B1); PG8_BAR;
            }
        }
        if constexpr (ALIGN_EPI) { if (wr == 0) PG8_BAR; }
        if constexpr (!Epi::AFTER_DRAIN) { E(acc, cur, wr, wc, fr, fq); S.done(cur); }
        if (!has_next) break;
#pragma unroll
        for (int a = 0; a < 2; ++a)
#pragma unroll
            for (int b = 0; b < 2; ++b)
#pragma unroll
                for (int m = 0; m < 4; ++m)
#pragma unroll
                    for (int n = 0; n < 2; ++n) acc[a][b][m][n] = (f32x4){0.f, 0.f, 0.f, 0.f};
        cur = nxt; cA = nA; cB = nB; ++ui;
        if constexpr (ALIGN_EPI) { if (wr == 1) PG8_BAR; }
    }
    PG8_WAIT_V(0);
    if constexpr (!ALIGN_EPI) { if (wr == 0) PG8_BAR; }
    PG8_BAR;
    if constexpr (Epi::AFTER_DRAIN) { E.fused(acc, cur, wr, wc, fr, fq, lds, wid, lane); S.done(cur); }
#undef PG8_SA
#undef PG8_SB
#undef PG8_STAGE
#undef PG8_LDA
#undef PG8_LDB
#undef PG8_MMA
#undef PG8_WAIT_V
#undef PG8_WAIT_L
#undef PG8_BAR
#undef PG8_SCHED
}
}
#define LAS __attribute__((address_space(3)))
typedef unsigned short bf16;
typedef unsigned v4u __attribute__((ext_vector_type(4)));
typedef unsigned v2u __attribute__((ext_vector_type(2)));
using pg8::f32x4; using pg8::bf16x8; using pg8::cvt_pk_bf16;

constexpr int D = 1024, FF = 2816, NLAYER = 4, TG = 16384, NGROUP = 4, NTHR = 512, NWAVES = 8;
constexpr int PA_LD = 5632, PG_LD = 3072;
constexpr int C_HQ = 0, C_HI = 512, C_HZF = 1024, C_HZB = 1536, C_HG = 2048, C_CA = 2560, C_CB = 3072, C_CC = 3584, C_NQ = 4096, C_NK = 4608, C_NV = 5120;
constexpr size_t MiB = 1u << 20;
constexpr size_t WS_CTL = 0, CTL_BYTES = 1 * MiB, WS_W = 1 * MiB, WS_XB = 221 * MiB, WS_SSQ = 253 * MiB, WS_PA = 254 * MiB, WS_PG = 430 * MiB, WS_O3 = 526 * MiB, WS_OD = 574 * MiB, WS_END = 638 * MiB;
constexpr size_t OFF_GU1 = 0, OFF_D1 = 5767168, OFF_IN = 8650752, OFF_HG = 17563648, OFF_CV = 18087936, OFF_NA = 18612224, OFF_OUT = 19136512, OFF_GU2 = 20185088, OFF_D2 = 25952256, LAYER_EL = 28835840;
constexpr int LDS_BYTES = 147456, LDS_MISC = 147456 - 64;

__device__ __forceinline__ unsigned f2bf(float f) { unsigned u = __float_as_uint(f); return (u + 0x7fffu + ((u >> 16) & 1u)) >> 16; }
__device__ __forceinline__ float bf2f(unsigned b) { return __uint_as_float(b << 16); }
__device__ __forceinline__ float bflo(unsigned w) { return __uint_as_float(w << 16); }
__device__ __forceinline__ float bfhi(unsigned w) { return __uint_as_float(w & 0xffff0000u); }
__device__ __forceinline__ float sigm(float v) { return __builtin_amdgcn_rcpf(1.0f + __expf(-v)); }
__device__ __forceinline__ float wave_sum(float v) {
#pragma unroll
    for (int o = 1; o < 64; o <<= 1) v += __shfl_xor(v, o);
    return v;
}

__device__ __forceinline__ void cvt_item(const float* W, int K, int N, bf16* WT, const float* gain, bool permgu, LAS float* scr, int item, int lane) {
    const int nblk = N / 32, kb = item / nblk, nb = item % nblk, k0 = 64 * kb, n0 = 32 * nb;
#pragma unroll 8
    for (int i = 0; i < 32; ++i) { const int kk = 2 * i + (lane >> 5); const float g = gain ? gain[k0 + kk] : 1.0f; scr[kk * 33 + (lane & 31)] = W[(size_t)(k0 + kk) * N + n0 + (lane & 31)] * g; }
    asm volatile("s_waitcnt lgkmcnt(0)" ::: "memory");
    int dn0 = n0;
    if (permgu) { const int half = n0 >= FF ? 1 : 0; const int j = n0 - half * FF; dn0 = (j >> 7) * 256 + half * 128 + (j & 127); }
    const int c = lane & 7;
#pragma unroll
    for (int j = 0; j < 4; ++j) { const int n = (lane >> 3) + 8 * j; const LAS float* s = scr + (8 * c) * 33 + n;
        v4u o; o.x = cvt_pk_bf16(s[0 * 33], s[1 * 33]); o.y = cvt_pk_bf16(s[2 * 33], s[3 * 33]); o.z = cvt_pk_bf16(s[4 * 33], s[5 * 33]); o.w = cvt_pk_bf16(s[6 * 33], s[7 * 33]);
        *(v4u*)(WT + (size_t)(dn0 + n) * K + k0 + 8 * c) = o; }
    asm volatile("s_waitcnt lgkmcnt(0)" ::: "memory");
}

template <int K> __device__ __forceinline__ f32x4 mma_lds(f32x4 acc, const LAS bf16* A, int pa, const LAS bf16* B, int pb, int lane) {
    const int r = lane & 15, q = lane >> 4;
#pragma unroll
    for (int ks = 0; ks < K / 32; ++ks) {
        const bf16x8 a = *(const LAS bf16x8*)(A + r * pa + ks * 32 + q * 8);
        const bf16x8 b = *(const LAS bf16x8*)(B + r * pb + ks * 32 + q * 8);
        acc = __builtin_amdgcn_mfma_f32_16x16x32_bf16(a, b, acc, 0, 0, 0);
    }
    return acc;
}

constexpr int H_QT = 0, H_KT = 17408, H_KTT = 34816, H_VT = 53248, H_ST = 57856, H_AM = 66560, H_SEG = 75776, H_ER = 77824, H_EE = 78336;
__device__ __forceinline__ void hgrn2_item(LAS unsigned char* lds, const bf16* PA, float* OD, const float* lb_logits, int layer, int item, int T, int tid) {
    const int lane = tid & 63, wave = __builtin_amdgcn_readfirstlane(tid >> 6), c16 = lane & 15, quad = lane >> 4;
    const int vs = item & 3, dir = (item >> 2) & 1, h = (item >> 3) & 3, seq = item >> 5;
    const int base = seq * T;
    const int k = tid & 127, tq = tid >> 7;
    LAS bf16* QT = (LAS bf16*)(lds + H_QT); LAS bf16* KT = (LAS bf16*)(lds + H_KT); LAS bf16* KTT = (LAS bf16*)(lds + H_KTT);
    LAS bf16* VT = (LAS bf16*)(lds + H_VT); LAS bf16* STt = (LAS bf16*)(lds + H_ST); LAS bf16* AM = (LAS bf16*)(lds + H_AM);
    LAS float* SEG = (LAS float*)(lds + H_SEG); LAS float* ER = (LAS float*)(lds + H_ER); LAS float* EE = (LAS float*)(lds + H_EE);
    float lb;
    { float lg[4], mx = -3e38f;
#pragma unroll
      for (int l = 0; l < 4; ++l) { lg[l] = lb_logits[(dir * 4 + l) * 512 + h * 128 + k]; mx = fmaxf(mx, lg[l]); }
      float tot = 0.f, num = 0.f;
#pragma unroll
      for (int l = 0; l < 4; ++l) { const float e = __expf(lg[l] - mx); tot += e; if (l >= 1 && l <= layer) num += e; }
      lb = num / tot; }
    const float oml = 1.0f - lb;
    const int nchunk = T / 64;
    const bf16* zsrc = PA + (dir ? C_HZB : C_HZF) + h * 128 + k;
    const bf16* qsrc = PA + C_HQ + h * 128 + k;
    const bf16* vsrc = PA + C_HI + h * 128 + vs * 32 + (tid & 3) * 8;
    float* odst = OD + (size_t)dir * TG * 512 + h * 128 + vs * 32;
    unsigned short zr[16], qr[16]; v4u vr = {0u, 0u, 0u, 0u};
#define HG_ROW(tau) (base + (dir ? (T - 1 - (tau)) : (tau)))
#define HG_LOAD(c) do { _Pragma("unroll") for (int i = 0; i < 16; ++i) { const size_t ro = (size_t)HG_ROW((c) * 64 + 16 * tq + i) * PA_LD; zr[i] = zsrc[ro]; qr[i] = qsrc[ro]; } \
        if (tid < 256) vr = *(const v4u*)(vsrc + (size_t)HG_ROW((c) * 64 + (tid >> 2)) * PA_LD); } while (0)
    HG_LOAD(0);
    f32x4 accS[2]; accS[0] = (f32x4){0.f, 0.f, 0.f, 0.f}; accS[1] = accS[0];
    for (int c = 0; c < nchunk; ++c) {
        float b[16], kv[16]; float cum = 0.f;
#pragma unroll
        for (int i = 0; i < 16; ++i) { const float zf = bf2f(zr[i]); const float sg = sigm(zf); const float f = lb + oml * sg; cum += __logf(fmaxf(f, 1e-30f)); b[i] = cum; kv[i] = oml * (1.0f - sg); }
        SEG[tq * 128 + k] = cum;
        __syncthreads();
        const float s0 = SEG[k], s1 = SEG[128 + k], s2 = SEG[256 + k], s3 = SEG[384 + k];
        const float pre = tq == 0 ? 0.f : (tq == 1 ? s0 : (tq == 2 ? s0 + s1 : (s0 + s1) + s2));
        const float r = s0 + s1, bend = (s0 + s1) + (s2 + s3);
        unsigned kpk[8];
#pragma unroll
        for (int i = 0; i < 16; ++i) {
            const float bt = pre + b[i];
            const float eq = __expf(fminf(bt - r, 80.f)), ek = __expf(fminf(r - bt, 80.f));
            const unsigned qb = f2bf(bf2f(qr[i]) * eq), kb = f2bf(kv[i] * ek);
            const int tau = 16 * tq + i;
            QT[tau * 136 + k] = (bf16)qb; KT[tau * 136 + k] = (bf16)kb;
            if (i & 1) kpk[i >> 1] |= kb << 16; else kpk[i >> 1] = kb;
        }
        *(LAS v4u*)(KTT + k * 72 + 16 * tq) = (v4u){kpk[0], kpk[1], kpk[2], kpk[3]};
        *(LAS v4u*)(KTT + k * 72 + 16 * tq + 8) = (v4u){kpk[4], kpk[5], kpk[6], kpk[7]};
        if (tq == 0) { ER[k] = __expf(r); EE[k] = __expf(bend - r); }
        if (tid < 256) { const int s = tid >> 2, vq = tid & 3;
            VT[(vq * 8 + 0) * 72 + s] = (bf16)(vr.x & 0xffffu); VT[(vq * 8 + 1) * 72 + s] = (bf16)(vr.x >> 16);
            VT[(vq * 8 + 2) * 72 + s] = (bf16)(vr.y & 0xffffu); VT[(vq * 8 + 3) * 72 + s] = (bf16)(vr.y >> 16);
            VT[(vq * 8 + 4) * 72 + s] = (bf16)(vr.z & 0xffffu); VT[(vq * 8 + 5) * 72 + s] = (bf16)(vr.z >> 16);
            VT[(vq * 8 + 6) * 72 + s] = (bf16)(vr.w & 0xffffu); VT[(vq * 8 + 7) * 72 + s] = (bf16)(vr.w >> 16); }
        __syncthreads();
        if (c + 1 < nchunk) HG_LOAD(c + 1);
#pragma unroll
        for (int e = 0; e < 2; ++e) { const int id = wave * 2 + e, tt = id >> 2, st = id & 3;
            f32x4 a = (f32x4){0.f, 0.f, 0.f, 0.f};
            if (st <= tt) a = mma_lds<128>(a, QT + tt * 16 * 136, 136, KT + st * 16 * 136, 136, lane);
#pragma unroll
            for (int i = 0; i < 4; ++i) { const int t = tt * 16 + quad * 4 + i, s = st * 16 + c16; const float val = (st <= tt && s <= t) ? a[i] : 0.f; AM[t * 72 + s] = (bf16)f2bf(val); } }
        { const f32x4 erv = *(const LAS f32x4*)(ER + wave * 16 + quad * 4);
#pragma unroll
          for (int e = 0; e < 2; ++e) { const f32x4 sp = accS[e] * erv; v2u w; w.x = cvt_pk_bf16(sp[0], sp[1]); w.y = cvt_pk_bf16(sp[2], sp[3]);
              *(LAS v2u*)(STt + (e * 16 + c16) * 136 + wave * 16 + quad * 4) = w; } }
        __syncthreads();
        { const int tt = wave & 3, vt = wave >> 2; f32x4 o = (f32x4){0.f, 0.f, 0.f, 0.f};
          o = mma_lds<128>(o, QT + tt * 16 * 136, 136, STt + vt * 16 * 136, 136, lane);
          o = mma_lds<64>(o, AM + tt * 16 * 72, 72, VT + vt * 16 * 72, 72, lane);
#pragma unroll
          for (int i = 0; i < 4; ++i) { const int tau = c * 64 + tt * 16 + quad * 4 + i; odst[(size_t)HG_ROW(tau) * 512 + vt * 16 + c16] = o[i]; } }
        { const f32x4 erv = *(const LAS f32x4*)(ER + wave * 16 + quad * 4); const f32x4 eev = *(const LAS f32x4*)(EE + wave * 16 + quad * 4);
#pragma unroll
          for (int e = 0; e < 2; ++e) { f32x4 sp = accS[e] * erv; sp = mma_lds<64>(sp, KTT + wave * 16 * 72, 72, VT + e * 16 * 72, 72, lane); accS[e] = sp * eev; } }
    }
    __syncthreads();
#undef HG_ROW
#undef HG_LOAD
}

__device__ __forceinline__ void na_item(LAS unsigned char* lds, const bf16* PA, const float* rpb, bf16* ONA, int item, int T, int tid) {
    const int lane = tid & 63, h = __builtin_amdgcn_readfirstlane(tid >> 6), c16 = lane & 15, quad = lane >> 4;
    const int ips = T / 16, seq = item / ips, rem = item % ips, r = rem >> 2, j = rem & 3;
    const int rows = T / 64, rs = min(max(r - 4, 0), rows - 8), kstart = (j == 0) ? 0 : (j == 1) ? 8 : (j == 2) ? 24 : 32;
    const int base = seq * T, qtok = base + r * 64 + 16 * j + c16;
    const bf16* qp = PA + (size_t)qtok * PA_LD + C_NQ + h * 64 + quad * 8;
    const bf16x8 Qb0 = *(const bf16x8*)qp, Qb1 = *(const bf16x8*)(qp + 32);
    const int qcol = 16 * j + c16, cs = min(max(qcol - 8, 0), 48);
    const float* rp = rpb + h * 465;
    f32x4 sacc[16]; float mx = -3e38f;
#pragma unroll
    for (int a = 0; a < 8; ++a)
#pragma unroll
        for (int hh = 0; hh < 2; ++hh) {
            const int ktok = base + (rs + a) * 64 + kstart + hh * 16 + c16;
            const bf16* kp = PA + (size_t)ktok * PA_LD + C_NK + h * 64 + quad * 8;
            const bf16x8 Ka0 = *(const bf16x8*)kp, Ka1 = *(const bf16x8*)(kp + 32);
            f32x4 s = (f32x4){0.f, 0.f, 0.f, 0.f};
            s = __builtin_amdgcn_mfma_f32_16x16x32_bf16(Ka0, Qb0, s, 0, 0, 0);
            s = __builtin_amdgcn_mfma_f32_16x16x32_bf16(Ka1, Qb1, s, 0, 0, 0);
            const int dr = rs + a - r + 7;
#pragma unroll
            for (int i = 0; i < 4; ++i) { const int kcol = kstart + hh * 16 + quad * 4 + i; const bool ok = (kcol >= cs) && (kcol < cs + 16); const int dc = min(max(kcol - qcol + 15, 0), 30);
                const float val = ok ? s[i] * 0.125f + rp[dr * 31 + dc] : -1e30f; s[i] = val; mx = fmaxf(mx, val); }
            sacc[a * 2 + hh] = s;
        }
    mx = fmaxf(mx, __shfl_xor(mx, 16)); mx = fmaxf(mx, __shfl_xor(mx, 32));
    float sum = 0.f;
#pragma unroll
    for (int t = 0; t < 16; ++t)
#pragma unroll
        for (int i = 0; i < 4; ++i) { const float p = __expf(sacc[t][i] - mx); sacc[t][i] = p; sum += p; }
    sum += __shfl_xor(sum, 16); sum += __shfl_xor(sum, 32);
    bf16x8 pb[8];
#pragma unroll
    for (int a = 0; a < 8; ++a) { v4u w; w.x = cvt_pk_bf16(sacc[2 * a][0], sacc[2 * a][1]); w.y = cvt_pk_bf16(sacc[2 * a][2], sacc[2 * a][3]);
        w.z = cvt_pk_bf16(sacc[2 * a + 1][0], sacc[2 * a + 1][1]); w.w = cvt_pk_bf16(sacc[2 * a + 1][2], sacc[2 * a + 1][3]); pb[a] = __builtin_bit_cast(bf16x8, w); }
    LAS bf16* VT = (LAS bf16*)(lds + h * 17408);
    f32x4 oacc[4];
#pragma unroll
    for (int dt = 0; dt < 4; ++dt) oacc[dt] = (f32x4){0.f, 0.f, 0.f, 0.f};
#pragma unroll
    for (int half = 0; half < 2; ++half) {
        __syncthreads();
#pragma unroll 4
        for (int it = 0; it < 16; ++it) { const int idx = it * 64 + lane, key = idx >> 3, dg = idx & 7, al = key >> 5, kc = key & 31;
            const int tok = base + (rs + half * 4 + al) * 64 + kstart + kc;
            const v4u vec = *(const v4u*)(PA + (size_t)tok * PA_LD + C_NV + h * 64 + dg * 8);
            LAS bf16* vp = VT + (dg * 8) * 136 + key;
            vp[0 * 136] = (bf16)(vec.x & 0xffffu); vp[1 * 136] = (bf16)(vec.x >> 16); vp[2 * 136] = (bf16)(vec.y & 0xffffu); vp[3 * 136] = (bf16)(vec.y >> 16);
            vp[4 * 136] = (bf16)(vec.z & 0xffffu); vp[5 * 136] = (bf16)(vec.z >> 16); vp[6 * 136] = (bf16)(vec.w & 0xffffu); vp[7 * 136] = (bf16)(vec.w >> 16); }
        __syncthreads();
#pragma unroll
        for (int al = 0; al < 4; ++al)
#pragma unroll
            for (int dt = 0; dt < 4; ++dt) { const LAS bf16* p = VT + (dt * 16 + c16) * 136 + al * 32 + quad * 4;
                const v2u lo = *(const LAS v2u*)p, hi = *(const LAS v2u*)(p + 16);
                const bf16x8 af = __builtin_bit_cast(bf16x8, (v4u){lo.x, lo.y, hi.x, hi.y});
                oacc[dt] = __builtin_amdgcn_mfma_f32_16x16x32_bf16(af, pb[half * 4 + al], oacc[dt], 0, 0, 0); }
    }
    const float inv = __builtin_amdgcn_rcpf(sum);
#pragma unroll
    for (int dt = 0; dt < 4; ++dt) { const f32x4 o = oacc[dt] * inv; v2u w; w.x = cvt_pk_bf16(o[0], o[1]); w.y = cvt_pk_bf16(o[2], o[3]);
        *(v2u*)(ONA + (size_t)qtok * 512 + h * 64 + dt * 16 + quad * 4) = w; }
}

struct Args { const float* in[20]; float* out; unsigned char* ws; int ph_lo, ph_hi; };
enum { K_CVT = 0, K_G0, K_UP, K_RES, K_M1, K_M2, K_M3, K_M4, K_GF };

__global__ void __launch_bounds__(NTHR, 2) mk_fwd(Args args) {
    extern __shared__ __attribute__((aligned(16))) unsigned char lds_raw[];
    LAS unsigned char* lds = (LAS unsigned char*)lds_raw;
    cg::grid_group grid = cg::this_grid();
    const int hi = args.ph_hi;
    for (int ph = args.ph_lo; ph < hi; ++ph) {
        int bid = blockIdx.x, G = gridDim.x; asm volatile("" : "+s"(bid), "+s"(G));
        int tid = threadIdx.x; asm volatile("" : "+v"(tid));
        const int lane = tid & 63, wave = __builtin_amdgcn_readfirstlane(tid >> 6);
        const int gw = bid * NWAVES + wave, NGW = G * NWAVES;
        int kind, g = 0, l = 0, s = 0;
        if (ph == 0) kind = K_CVT;
        else { const int q = ph - 1; g = q / 38; const int r = q % 38;
            if (r == 0) kind = K_G0; else if (r == 37) kind = K_GF;
            else { l = (r - 1) / 9; s = (r - 1) % 9; kind = (s == 0 || s == 7) ? K_UP : (s == 1 || s == 8 || s == 6) ? K_RES : (s == 2) ? K_M1 : (s == 3) ? K_M2 : (s == 4) ? K_M3 : K_M4; } }
        unsigned char* ws = args.ws;
        bf16* XB = (bf16*)(ws + WS_XB); float* SSQ = (float*)(ws + WS_SSQ);
        bf16* PA = (bf16*)(ws + WS_PA); bf16* PG = (bf16*)(ws + WS_PG);
        bf16* OHG = (bf16*)(ws + WS_O3); bf16* OCV = OHG + (size_t)TG * 512; bf16* ONA = OCV + (size_t)TG * 512;
        float* OD = (float*)(ws + WS_OD);
        const bf16* Wl = (const bf16*)(ws + WS_W) + (size_t)l * LAYER_EL;
        const int T = g < 2 ? 2048 : 4096;
        float* X = args.out + (size_t)g * TG * D;

        if (kind == K_CVT) {
            LAS float* scr = (LAS float*)(lds + wave * 16384);
            constexpr int I_GU = 16 * 176, I_DN = 44 * 32, I_IN = 16 * 272, I_MX = 8 * 32, I_OUT = 16 * 32;
            constexpr int I_LAYER = 2 * I_GU + 2 * I_DN + I_IN + 3 * I_MX + I_OUT;
            for (int it = gw; it < NLAYER * I_LAYER; it += NGW) {
                const int ll = it / I_LAYER; int r = it % I_LAYER; bf16* Wd = (bf16*)(ws + WS_W) + (size_t)ll * LAYER_EL;
                const float* src; const float* gain = nullptr; int K, N; size_t off; bool perm = false;
                if (r < I_GU) { src = args.in[3] + (size_t)ll * D * 2 * FF; K = D; N = 2 * FF; off = OFF_GU1; gain = args.in[2] + ll * D; perm = true; }
                else if ((r -= I_GU) < I_DN) { src = args.in[4] + (size_t)ll * FF * D; K = FF; N = D; off = OFF_D1; }
                else if ((r -= I_DN) < I_IN) { src = args.in[6] + (size_t)ll * D * 8704; K = D; N = 8704; off = OFF_IN; gain = args.in[5] + ll * D; }
                else if ((r -= I_IN) < I_MX) { src = args.in[9] + (size_t)ll * 512 * D; K = 512; N = D; off = OFF_HG; }
                else if ((r -= I_MX) < I_MX) { src = args.in[12] + (size_t)ll * 512 * D; K = 512; N = D; off = OFF_CV; }
                else if ((r -= I_MX) < I_MX) { src = args.in[14] + (size_t)ll * 512 * D; K = 512; N = D; off = OFF_NA; }
                else if ((r -= I_MX) < I_OUT) { src = args.in[15] + (size_t)ll * D * D; K = D; N = D; off = OFF_OUT; }
                else if ((r -= I_OUT) < I_GU) { src = args.in[17] + (size_t)ll * D * 2 * FF; K = D; N = 2 * FF; off = OFF_GU2; gain = args.in[16] + ll * D; perm = true; }
                else { r -= I_GU; src = args.in[18] + (size_t)ll * FF * D; K = FF; N = D; off = OFF_D2; }
                cvt_item(src, K, N, Wd + off, gain, perm, scr, r, lane);
            }
        } else if (kind == K_G0) {
            const float* xin = (g < 2 ? args.in[0] : args.in[1]) + (size_t)(g & 1) * TG * D;
            for (int row = gw; row < TG; row += NGW) {
                const f32x4* xr = (const f32x4*)(xin + (size_t)row * D) + lane; f32x4* xo = (f32x4*)(X + (size_t)row * D) + lane; v2u* bo = (v2u*)(XB + (size_t)row * D) + lane;
                float ss = 0.f;
#pragma unroll
                for (int j = 0; j < 4; ++j) { const f32x4 v = xr[64 * j]; xo[64 * j] = v; v2u w; w.x = cvt_pk_bf16(v[0], v[1]); w.y = cvt_pk_bf16(v[2], v[3]); bo[64 * j] = w; ss += (v[0] * v[0] + v[1] * v[1]) + (v[2] * v[2] + v[3] * v[3]); }
                ss = wave_sum(ss);
                if (lane < 16) SSQ[(size_t)row * 16 + lane] = lane == 0 ? ss : 0.f;
            }
        } else if (kind == K_UP) {
            pg8::Gemm gm{XB, Wl + (s == 7 ? OFF_GU2 : OFF_GU1), TG, 2 * FF, D}; pg8::StaticOrder S; S.init(TG, 2 * FF, G, bid);
            pg8::EpiSwiGLU E{PA, SSQ};
#ifndef NO_UP
            pg8::gemm_phase<pg8::EpiSwiGLU, pg8::StaticOrder, true, true>(lds, gm, S, E);
#endif
        } else if (kind == K_RES) {
            const int K = (s == 6) ? D : FF; const size_t off = (s == 6) ? OFF_OUT : (s == 1 ? OFF_D1 : OFF_D2);
            pg8::Gemm gm{PA, Wl + off, TG, D, K}; pg8::StaticOrder S; S.init(TG, D, G, bid);
            pg8::EpiRes E{X, XB, SSQ, (s == 6) ? 1.0f : 0.5f};
#ifndef NO_RES
            pg8::gemm_phase<pg8::EpiRes, pg8::StaticOrder, true, true>(lds, gm, S, E);
#endif
        } else if (kind == K_M1) {
            pg8::Gemm gm{XB, Wl + OFF_IN, TG, 8704, D}; pg8::StaticOrder S; S.init(TG, 8704, G, bid);
            pg8::EpiProj E{PA, PG, SSQ};
#ifndef NO_PROJ
            pg8::gemm_phase<pg8::EpiProj, pg8::StaticOrder, true, true>(lds, gm, S, E);
#endif
        } else if (kind == K_M2) {
            const int nH = (TG / T) * 32;
#ifndef NO_HG
            for (int it = bid; it < nH; it += G) hgrn2_item(lds, PA, OD, args.in[7], l, it, T, tid);
#endif
            unsigned* cnt = (unsigned*)(ws + WS_CTL) + 64 * (1 + g * NLAYER + l);
            LAS int* slot = (LAS int*)(lds + LDS_MISC);
            const float* rpb = args.in[13] + (size_t)l * 8 * 465;
            for (;;) {
                __syncthreads();
                if (tid == 0) *slot = (int)__hip_atomic_fetch_add(cnt, 1u, __ATOMIC_RELAXED, __HIP_MEMORY_SCOPE_AGENT);
                __syncthreads();
                const int it = *slot;
                if (it >= TG / 16) break;
#ifndef NO_NA
                na_item(lds, PA, rpb, ONA, it, T, tid);
#endif
            }
        } else if (kind == K_M3) {
            const float* gno = args.in[8] + l * 512; const float* cw = args.in[10] + l * 3 * 512; const float* cbias = args.in[11] + l * 512;
            const int c0 = lane * 8;
            for (int row = gw; row < TG; row += NGW) {
                const f32x4* pf = (const f32x4*)(OD + (size_t)row * 512 + c0); const f32x4* pbk = (const f32x4*)(OD + (size_t)TG * 512 + (size_t)row * 512 + c0);
                const f32x4 f0 = pf[0], f1 = pf[1], b0 = pbk[0], b1 = pbk[1];
                float o[8]; float ss = 0.f;
#pragma unroll
                for (int e = 0; e < 4; ++e) { o[e] = f0[e] + b0[e]; o[4 + e] = f1[e] + b1[e]; }
#pragma unroll
                for (int e = 0; e < 8; ++e) ss += o[e] * o[e];
                ss += __shfl_xor(ss, 1); ss += __shfl_xor(ss, 2); ss += __shfl_xor(ss, 4); ss += __shfl_xor(ss, 8);
                const float rs = __builtin_amdgcn_rsqf(ss * (1.0f / 128.0f) + 1e-6f);
                const bf16* prow = PA + (size_t)row * PA_LD;
                const v4u hgw = *(const v4u*)(prow + C_HG + c0);
                const float hgv[8] = {bflo(hgw.x), bfhi(hgw.x), bflo(hgw.y), bfhi(hgw.y), bflo(hgw.z), bfhi(hgw.z), bflo(hgw.w), bfhi(hgw.w)};
                const f32x4 gn0 = *(const f32x4*)(gno + c0), gn1 = *(const f32x4*)(gno + c0 + 4);
                const float gn[8] = {gn0[0], gn0[1], gn0[2], gn0[3], gn1[0], gn1[1], gn1[2], gn1[3]};
                float r8[8];
#pragma unroll
                for (int e = 0; e < 8; ++e) r8[e] = o[e] * rs * gn[e] * (hgv[e] * sigm(hgv[e]));
                v4u wo; wo.x = cvt_pk_bf16(r8[0], r8[1]); wo.y = cvt_pk_bf16(r8[2], r8[3]); wo.z = cvt_pk_bf16(r8[4], r8[5]); wo.w = cvt_pk_bf16(r8[6], r8[7]);
                *(v4u*)(OHG + (size_t)row * 512 + c0) = wo;
                const int tl = row & (T - 1);
                const v4u a1 = *(const v4u*)(prow + C_CA + c0), c1 = *(const v4u*)(prow + C_CC + c0), bb = *(const v4u*)(prow + C_CB + c0);
                v4u a0 = {0u, 0u, 0u, 0u}, cc0 = a0, a2 = a0, cc2 = a0;
                if (tl > 0) { a0 = *(const v4u*)(prow - PA_LD + C_CA + c0); cc0 = *(const v4u*)(prow - PA_LD + C_CC + c0); }
                if (tl < T - 1) { a2 = *(const v4u*)(prow + PA_LD + C_CA + c0); cc2 = *(const v4u*)(prow + PA_LD + C_CC + c0); }
                const float zm[8] = {bflo(a0.x) * bflo(cc0.x), bfhi(a0.x) * bfhi(cc0.x), bflo(a0.y) * bflo(cc0.y), bfhi(a0.y) * bfhi(cc0.y), bflo(a0.z) * bflo(cc0.z), bfhi(a0.z) * bfhi(cc0.z), bflo(a0.w) * bflo(cc0.w), bfhi(a0.w) * bfhi(cc0.w)};
                const float zc[8] = {bflo(a1.x) * bflo(c1.x), bfhi(a1.x) * bfhi(c1.x), bflo(a1.y) * bflo(c1.y), bfhi(a1.y) * bfhi(c1.y), bflo(a1.z) * bflo(c1.z), bfhi(a1.z) * bfhi(c1.z), bflo(a1.w) * bflo(c1.w), bfhi(a1.w) * bfhi(c1.w)};
                const float zp[8] = {bflo(a2.x) * bflo(cc2.x), bfhi(a2.x) * bfhi(cc2.x), bflo(a2.y) * bflo(cc2.y), bfhi(a2.y) * bfhi(cc2.y), bflo(a2.z) * bflo(cc2.z), bfhi(a2.z) * bfhi(cc2.z), bflo(a2.w) * bflo(cc2.w), bfhi(a2.w) * bfhi(cc2.w)};
                const float cbv[8] = {bflo(bb.x), bfhi(bb.x), bflo(bb.y), bfhi(bb.y), bflo(bb.z), bfhi(bb.z), bflo(bb.w), bfhi(bb.w)};
                const f32x4 w00 = *(const f32x4*)(cw + c0), w01 = *(const f32x4*)(cw + c0 + 4), w10 = *(const f32x4*)(cw + 512 + c0), w11 = *(const f32x4*)(cw + 512 + c0 + 4);
                const f32x4 w20 = *(const f32x4*)(cw + 1024 + c0), w21 = *(const f32x4*)(cw + 1024 + c0 + 4), bs0 = *(const f32x4*)(cbias + c0), bs1 = *(const f32x4*)(cbias + c0 + 4);
#pragma unroll
                for (int e = 0; e < 4; ++e) { r8[e] = cbv[e] * (w00[e] * zm[e] + w10[e] * zc[e] + w20[e] * zp[e] + bs0[e]); r8[4 + e] = cbv[4 + e] * (w01[e] * zm[4 + e] + w11[e] * zc[4 + e] + w21[e] * zp[4 + e] + bs1[e]); }
                wo.x = cvt_pk_bf16(r8[0], r8[1]); wo.y = cvt_pk_bf16(r8[2], r8[3]); wo.z = cvt_pk_bf16(r8[4], r8[5]); wo.w = cvt_pk_bf16(r8[6], r8[7]);
                *(v4u*)(OCV + (size_t)row * 512 + c0) = wo;
            }
        } else if (kind == K_M4) {
            pg8::StaticOrder S; S.init(TG, D, G, bid);
            { pg8::Gemm gm{OHG, Wl + OFF_HG, TG, D, 512}; pg8::EpiMerge<0> E{PG, OD, PA};
#ifndef NO_MERGE
            pg8::gemm_phase<pg8::EpiMerge<0>, pg8::StaticOrder, true, true>(lds, gm, S, E);
#endif
            }
            { pg8::Gemm gm{OCV, Wl + OFF_CV, TG, D, 512}; pg8::EpiMerge<1> E{PG, OD, PA};
#ifndef NO_MERGE
            pg8::gemm_phase<pg8::EpiMerge<1>, pg8::StaticOrder, true, true>(lds, gm, S, E);
#endif
            }
            { pg8::Gemm gm{ONA, Wl + OFF_NA, TG, D, 512}; pg8::EpiMerge<2> E{PG, OD, PA};
#ifndef NO_MERGE
            pg8::gemm_phase<pg8::EpiMerge<2>, pg8::StaticOrder, true, true>(lds, gm, S, E);
#endif
            }
        } else {
            const f32x4* fg = (const f32x4*)args.in[19] + lane;
            for (int row = gw; row < TG; row += NGW) {
                const float rs = pg8::row_rs(SSQ, row);
                f32x4* xo = (f32x4*)(X + (size_t)row * D) + lane;
#pragma unroll
                for (int j = 0; j < 4; ++j) xo[64 * j] = xo[64 * j] * fg[64 * j] * rs;
            }
        }
        if (ph + 1 < hi) grid.sync();
    }
}
constexpr int N_PHASES = 1 + NGROUP * (1 + NLAYER * 9 + 1);

extern "C" void kernel_launch(void* const* d_in, const int* in_sizes, int n_in, void* d_out, int out_size, void* d_ws, size_t ws_size, hipStream_t stream) {
    static int grid = 0;
    if (grid == 0) {
        if (n_in != 20 || ws_size < WS_END) { fprintf(stderr, "kernel_launch: unexpected n_in %d / ws %zu\n", n_in, ws_size); grid = -1; return; }
        int dev = 0, cus = 0, per_cu = 0;
        hipGetDevice(&dev); hipDeviceGetAttribute(&cus, hipDeviceAttributeMultiprocessorCount, dev);
        hipFuncSetAttribute((const void*)mk_fwd, hipFuncAttributeMaxDynamicSharedMemorySize, LDS_BYTES);
        hipOccupancyMaxActiveBlocksPerMultiprocessor(&per_cu, (const void*)mk_fwd, NTHR, LDS_BYTES);
        if (per_cu < 1) per_cu = 1;
        grid = cus * per_cu;
        (void)hipGetLastError();
    }
    if (grid < 0) return;
    hipMemsetAsync((char*)d_ws + WS_CTL, 0, CTL_BYTES, stream);
    Args a{};
    for (int i = 0; i < 20; ++i) a.in[i] = (const float*)d_in[i];
    a.out = (float*)d_out; a.ws = (unsigned char*)d_ws;
#if ONE_LAUNCH
    a.ph_lo = 0; a.ph_hi = N_PHASES;
    void* kargs[] = {&a};
    hipError_t e = hipLaunchCooperativeKernel((const void*)mk_fwd, dim3(grid), dim3(NTHR), kargs, LDS_BYTES, stream);
    if (e != hipSuccess) fprintf(stderr, "cooperative launch failed: %s (grid %d)\n", hipGetErrorString(e), grid);
#else
    for (int p = 0; p < N_PHASES; ++p) { a.ph_lo = p; a.ph_hi = p + 1; hipLaunchKernelGGL(mk_fwd, dim3(grid), dim3(NTHR), LDS_BYTES, stream, a); }
#endif
}
```

```cpp
#include <hip/hip_runtime.h>
#include <hip/hip_cooperative_groups.h>
#include <cstdio>
#include <cstdint>
namespace cg = cooperative_groups;
#ifndef ONE_LAUNCH
#define ONE_LAUNCH 1
#endif
#ifndef REP_HG
#define REP_HG 1
#endif
#ifndef REP_NA
#define REP_NA 1
#endif
#ifndef REP_SYNC
#define REP_SYNC 1
#endif
#ifndef REP_GEMM
#define REP_GEMM 1
#endif
#ifndef REP_M3
#define REP_M3 1
#endif
namespace pg8 {
#define PG8_LAS __attribute__((address_space(3)))
typedef unsigned short bf16_t;
typedef short bf16x8 __attribute__((ext_vector_type(8)));
typedef float f32x4 __attribute__((ext_vector_type(4)));
typedef unsigned u32x4 __attribute__((ext_vector_type(4)));
constexpr int BM = 256, BK = 64, HALF = 128, HTB = HALF * BK * 2  , STAGE_BYTES = 8 * HTB, NXCD = 8, WGM = 8;

__host__ __device__ __forceinline__ int lds_byte(int r, int c) { const int st = (r >> 4) * 2 + (c >> 5), rr = r & 15, cc = c & 31, ob = rr * 64 + cc * 2; return st * 1024 + (ob ^ (((ob >> 9) & 1) << 5)); }
__host__ __device__ __forceinline__ void stage_rc(int b, int& R, int& C) { const int st = b / 1024, sb = b % 1024, swz = sb ^ (((sb >> 9) & 1) << 5); R = (st >> 1) * 16 + swz / 64; C = (st & 1) * 32 + (swz % 64) / 2; }
__host__ __device__ __forceinline__ int perm32(int rho) { const int n = rho >> 4, i = rho & 15; return 8 * (i >> 2) + 4 * n + (i & 3); }

struct Unit { int pm, pn; };
struct Gemm { const bf16_t* A; const bf16_t* Bt; int M, N, K; };

struct StaticOrder {
    int nM, nN, nwg, G, c;
    __host__ __device__ void init(int M, int N, int G_, int c_) { nM = M / BM; nN = N / BM; nwg = nM * nN; G = G_; c = c_; }
    __host__ __device__ bool next(int i, Unit& u) const {
        const long L = (long)i * G + c; if (L >= nwg) return false;
        int wgid = (int)L; { const int q = nwg / NXCD, r = nwg % NXCD, xcd = wgid % NXCD, off = wgid / NXCD; wgid = (xcd < r ? xcd * (q + 1) : r * (q + 1) + (xcd - r) * q) + off; }
        const int nig = WGM * nN, gid = wgid / nig, fm = gid * WGM, gsz = (nM - fm) < WGM ? (nM - fm) : WGM;
        u.pm = fm + ((wgid % nig) % gsz); u.pn = (wgid % nig) / gsz; return true;
    }
    __device__ __forceinline__ void a_ready(const Unit&) const {}
    __device__ __forceinline__ void done(const Unit&) const {}
};

__device__ __forceinline__ unsigned cvt_pk_bf16(float lo, float hi) { unsigned r; asm volatile("v_cvt_pk_bf16_f32 %0, %1, %2" : "=v"(r) : "v"(lo), "v"(hi)); return r; }
__device__ __forceinline__ float row_rs(const float* ssq, int row) {
    const f32x4* p = (const f32x4*)(ssq + (size_t)row * 16);
    const f32x4 a = p[0], b = p[1], c = p[2], d = p[3];
    const float s = (((a[0] + a[1]) + (a[2] + a[3])) + ((b[0] + b[1]) + (b[2] + b[3]))) + (((c[0] + c[1]) + (c[2] + c[3])) + ((d[0] + d[1]) + (d[2] + d[3])));
    return __builtin_amdgcn_rsqf(s * (1.0f / 1024.0f) + 1e-6f);
}
__device__ __forceinline__ float sigm(float v) { return __builtin_amdgcn_rcpf(1.0f + __expf(-v)); }

struct EpiSwiGLU {
    static constexpr bool PERM = true, AFTER_DRAIN = false;
    bf16_t* H; const float* ssq;
    __device__ __forceinline__ void operator()(const f32x4 (&acc)[2][2][4][2], const Unit& u, int wr, int wc, int fr, int fq) const {
        const int row0 = u.pm * BM + wr * 64 + fr, col0 = u.pn * 128 + wc * 32 + 8 * fq;
#pragma unroll
        for (int ai = 0; ai < 2; ++ai)
#pragma unroll
            for (int m = 0; m < 4; ++m) {
                const int row = row0 + ai * HALF + m * 16; const float rs = row_rs(ssq, row);
                u32x4 w;
#pragma unroll
                for (int n = 0; n < 2; ++n) {
                    const f32x4 a = acc[ai][0][m][n] * rs, b = acc[ai][1][m][n] * rs; f32x4 h;
#pragma unroll
                    for (int e = 0; e < 4; ++e) h[e] = a[e] * sigm(a[e]) * b[e];
                    w[2 * n] = cvt_pk_bf16(h[0], h[1]); w[2 * n + 1] = cvt_pk_bf16(h[2], h[3]);
                }
                *(u32x4*)(H + (size_t)row * 2816 + col0) = w;
                asm volatile("" ::: "memory");
            }
    }
};
struct EpiRes {
    static constexpr bool PERM = true, AFTER_DRAIN = false;
    float* X; bf16_t* XB; float* ssq; float alpha;
    __device__ __forceinline__ void operator()(const f32x4 (&acc)[2][2][4][2], const Unit& u, int wr, int wc, int fr, int fq) const {
        const int row0 = u.pm * BM + wr * 64 + fr, col0 = u.pn * BM + wc * 32 + 8 * fq;
#pragma unroll
        for (int ai = 0; ai < 2; ++ai)
#pragma unroll
            for (int m = 0; m < 4; ++m) {
                const int row = row0 + ai * HALF + m * 16; float ss = 0.f;
#pragma unroll
                for (int bj = 0; bj < 2; ++bj) {
                    float* xp = X + (size_t)row * 1024 + col0 + bj * HALF;
                    f32x4 x0 = *(const f32x4*)xp, x1 = *(const f32x4*)(xp + 4);
                    x0 = x0 + acc[ai][bj][m][0] * alpha; x1 = x1 + acc[ai][bj][m][1] * alpha;
                    *(f32x4*)xp = x0; *(f32x4*)(xp + 4) = x1;
                    u32x4 w; w.x = cvt_pk_bf16(x0[0], x0[1]); w.y = cvt_pk_bf16(x0[2], x0[3]); w.z = cvt_pk_bf16(x1[0], x1[1]); w.w = cvt_pk_bf16(x1[2], x1[3]);
                    *(u32x4*)(XB + (size_t)row * 1024 + col0 + bj * HALF) = w;
                    ss += ((x0[0] * x0[0] + x0[1] * x0[1]) + (x0[2] * x0[2] + x0[3] * x0[3])) + ((x1[0] * x1[0] + x1[1] * x1[1]) + (x1[2] * x1[2] + x1[3] * x1[3]));
                }
                ss += __shfl_xor(ss, 16); ss += __shfl_xor(ss, 32);
                if (fq == 0) ssq[(size_t)row * 16 + u.pn * 4 + wc] = ss;
                asm volatile("" ::: "memory");
            }
    }
};
struct EpiProj {
    static constexpr bool PERM = true, AFTER_DRAIN = false;
    bf16_t* PA; bf16_t* PG; const float* ssq;
    __device__ __forceinline__ void operator()(const f32x4 (&acc)[2][2][4][2], const Unit& u, int wr, int wc, int fr, int fq) const {
        const int row0 = u.pm * BM + wr * 64 + fr;
        bf16_t* base; int ld, colt;
        if (u.pn < 22) { base = PA; ld = 5632; colt = u.pn * BM; } else { base = PG; ld = 3072; colt = (u.pn - 22) * BM; }
        const int col0 = colt + wc * 32 + 8 * fq;
#pragma unroll
        for (int ai = 0; ai < 2; ++ai)
#pragma unroll
            for (int m = 0; m < 4; ++m) {
                const int row = row0 + ai * HALF + m * 16; const float rs = row_rs(ssq, row);
#pragma unroll
                for (int bj = 0; bj < 2; ++bj) {
                    const f32x4 v0 = acc[ai][bj][m][0] * rs, v1 = acc[ai][bj][m][1] * rs;
                    u32x4 w; w.x = cvt_pk_bf16(v0[0], v0[1]); w.y = cvt_pk_bf16(v0[2], v0[3]); w.z = cvt_pk_bf16(v1[0], v1[1]); w.w = cvt_pk_bf16(v1[2], v1[3]);
                    *(u32x4*)(base + (size_t)row * ld + col0 + bj * HALF) = w;
                }
                asm volatile("" ::: "memory");
            }
    }
};
template <int I> struct EpiMerge {
    static constexpr bool PERM = true, AFTER_DRAIN = false;
    const bf16_t* PG; float* MF; bf16_t* MB;
    __device__ __forceinline__ void operator()(const f32x4 (&acc)[2][2][4][2], const Unit& u, int wr, int wc, int fr, int fq) const {
        const int row0 = u.pm * BM + wr * 64 + fr, col0 = u.pn * BM + wc * 32 + 8 * fq;
#pragma unroll
        for (int ai = 0; ai < 2; ++ai)
#pragma unroll
            for (int m = 0; m < 4; ++m) {
                const int row = row0 + ai * HALF + m * 16;
#pragma unroll
                for (int bj = 0; bj < 2; ++bj) {
                    const int col = col0 + bj * HALF;
                    const u32x4 gw = *(const u32x4*)(PG + (size_t)row * 3072 + I * 1024 + col);
                    f32x4 g0, g1;
                    g0[0] = __uint_as_float(gw.x << 16); g0[1] = __uint_as_float(gw.x & 0xffff0000u); g0[2] = __uint_as_float(gw.y << 16); g0[3] = __uint_as_float(gw.y & 0xffff0000u);
                    g1[0] = __uint_as_float(gw.z << 16); g1[1] = __uint_as_float(gw.z & 0xffff0000u); g1[2] = __uint_as_float(gw.w << 16); g1[3] = __uint_as_float(gw.w & 0xffff0000u);
                    f32x4 t0, t1;
#pragma unroll
                    for (int e = 0; e < 4; ++e) { t0[e] = sigm(g0[e]) * acc[ai][bj][m][0][e]; t1[e] = sigm(g1[e]) * acc[ai][bj][m][1][e]; }
                    float* mp = MF + (size_t)row * 1024 + col;
                    if (I > 0) { t0 = t0 + *(const f32x4*)mp; t1 = t1 + *(const f32x4*)(mp + 4); }
                    if (I < 2) { *(f32x4*)mp = t0; *(f32x4*)(mp + 4) = t1; }
                    else { u32x4 w; w.x = cvt_pk_bf16(t0[0], t0[1]); w.y = cvt_pk_bf16(t0[2], t0[3]); w.z = cvt_pk_bf16(t1[0], t1[1]); w.w = cvt_pk_bf16(t1[2], t1[3]);
                           *(u32x4*)(MB + (size_t)row * 1024 + col) = w; }
                }
                asm volatile("" ::: "memory");
            }
    }
};
template <class Epi, class Sched, bool ALIGN_EPI = false, bool SP2 = false>
__device__ __forceinline__ void gemm_phase(PG8_LAS unsigned char* lds, const Gemm g, const Sched& S, const Epi& E) {
    int tid = threadIdx.x; asm volatile("" : "+v"(tid));
    const int wid = __builtin_amdgcn_readfirstlane(tid >> 6), lane = tid & 63, wr = wid >> 2, wc = wid & 3, fr = lane & 15, fq = lane >> 4;
    const int K = g.K, nt = K / BK;
    unsigned voffA[2], voffB[2];
#pragma unroll
    for (int i = 0; i < 2; ++i) { int R, C; stage_rc(tid * 16 + i * 8192, R, C); const int Rb = Epi::PERM ? ((R & ~31) + perm32(R & 31)) : R;
        voffA[i] = (unsigned)(R * K + C) * 2u; voffB[i] = (unsigned)(Rb * K + C) * 2u; }
    const size_t kstep = (size_t)(BK * 2);
    const size_t hstep = (size_t)HALF * K * 2;
    const size_t tstep = 2 * hstep;
    const unsigned ldsw = (unsigned)wid * 1024u;
    const int aoff = lds_byte(wr * 64 + fr, fq * 8), boff = lds_byte(wc * 32 + fr, fq * 8);
#define PG8_SA(b, h) (((b) * 2 + (h)) * HTB)
#define PG8_SB(b, h) ((4 + (b) * 2 + (h)) * HTB)
#define PG8_STAGE(bufoff, gbase, voff) do { _Pragma("unroll") for (int _i = 0; _i < 2; ++_i) \
        __builtin_amdgcn_global_load_lds((const unsigned*)((const char*)(gbase) + (voff)[_i]), (PG8_LAS unsigned*)(lds + (bufoff) + ldsw + _i * 8192), 16, 0, 0); } while (0)
#define PG8_LDA(dst, b, h) do { _Pragma("unroll") for (int m = 0; m < 4; ++m) _Pragma("unroll") for (int k = 0; k < 2; ++k) dst[m][k] = *(const PG8_LAS bf16x8*)(lds + PG8_SA(b, h) + aoff + m * 2048 + k * 1024); } while (0)
#define PG8_LDB(dst, b, h) do { _Pragma("unroll") for (int n = 0; n < 2; ++n) _Pragma("unroll") for (int k = 0; k < 2; ++k) dst[n][k] = *(const PG8_LAS bf16x8*)(lds + PG8_SB(b, h) + boff + n * 2048 + k * 1024); } while (0)
#define PG8_MMA(ai, bj, At, Bt) do { __builtin_amdgcn_s_setprio(1); _Pragma("unroll") for (int m = 0; m < 4; ++m) _Pragma("unroll") for (int n = 0; n < 2; ++n) _Pragma("unroll") for (int k = 0; k < 2; ++k) \
        acc[ai][bj][m][n] = __builtin_amdgcn_mfma_f32_16x16x32_bf16(Bt[n][k], At[m][k], acc[ai][bj][m][n], 0, 0, 0); __builtin_amdgcn_s_setprio(0); } while (0)
#define PG8_WAIT_V(n) asm volatile("s_waitcnt vmcnt(" #n ")" ::: "memory")
#define PG8_WAIT_L(n) asm volatile("s_waitcnt lgkmcnt(" #n ")" ::: "memory")
#define PG8_BAR __builtin_amdgcn_s_barrier()
#define PG8_SCHED __builtin_amdgcn_sched_barrier(0)
    Unit cur, nxt; int ui = 0;
    if (!S.next(0, cur)) return;
    f32x4 acc[2][2][4][2];
#pragma unroll
    for (int a = 0; a < 2; ++a)
#pragma unroll
        for (int b = 0; b < 2; ++b)
#pragma unroll
            for (int m = 0; m < 4; ++m)
#pragma unroll
                for (int n = 0; n < 2; ++n) acc[a][b][m][n] = (f32x4){0.f, 0.f, 0.f, 0.f};
    bf16x8 At[4][2], B0[2][2], B1[2][2];
    const char* cA = (const char*)g.A + (size_t)cur.pm * tstep; const char* cB = (const char*)g.Bt + (size_t)cur.pn * tstep;
    S.a_ready(cur);
    if constexpr (SP2) {
        PG8_STAGE(PG8_SB(0, 0), cB, voffB); PG8_STAGE(PG8_SB(0, 1), cB + hstep, voffB); PG8_STAGE(PG8_SA(0, 0), cA, voffA); PG8_STAGE(PG8_SA(0, 1), cA + hstep, voffA);
        if (wr == 1) PG8_BAR;
        PG8_WAIT_V(2); PG8_BAR;
        PG8_STAGE(PG8_SB(1, 0), cB + kstep, voffB); PG8_STAGE(PG8_SA(1, 0), cA + kstep, voffA); PG8_STAGE(PG8_SB(1, 1), cB + hstep + kstep, voffB);
        PG8_WAIT_V(6); PG8_BAR;
    } else {
        PG8_STAGE(PG8_SB(0, 0), cB, voffB); PG8_STAGE(PG8_SA(0, 0), cA, voffA); PG8_STAGE(PG8_SB(0, 1), cB + hstep, voffB); PG8_STAGE(PG8_SA(0, 1), cA + hstep, voffA);
        if (wr == 1) PG8_BAR;
        PG8_WAIT_V(4); PG8_BAR;
        PG8_STAGE(PG8_SB(1, 0), cB + kstep, voffB); PG8_STAGE(PG8_SA(1, 0), cA + kstep, voffA); PG8_STAGE(PG8_SB(1, 1), cB + hstep + kstep, voffB);
        PG8_WAIT_V(6); PG8_BAR;
    }
    for (;;) {
        const bool has_next = S.next(ui + 1, nxt);
        const char* nA = has_next ? (const char*)g.A + (size_t)nxt.pm * tstep : cA; const char* nB = has_next ? (const char*)g.Bt + (size_t)nxt.pn * tstep : cB;
        for (int t = 0; t < nt; t += 2) {
            const bool last = (t == nt - 2);
            const char* a1 = cA + (size_t)(t + 1) * kstep;
            const char* a2 = last ? nA : cA + (size_t)(t + 2) * kstep; const char* b2 = last ? nB : cB + (size_t)(t + 2) * kstep;
            const char* a3 = a2 + kstep; const char* b3 = b2 + kstep;
            if (last && has_next) S.a_ready(nxt);
            if constexpr (SP2) {
            PG8_LDB(B0, 0, 0); PG8_LDB(B1, 0, 1); PG8_SCHED; PG8_LDA(At, 0, 0); PG8_STAGE(PG8_SA(1, 1), a1 + hstep, voffA);
            PG8_WAIT_V(8); PG8_WAIT_L(0); PG8_BAR; PG8_MMA(0, 0, At, B0); PG8_MMA(0, 1, At, B1); PG8_BAR; PG8_SCHED;
            PG8_LDA(At, 0, 1); PG8_STAGE(PG8_SB(0, 0), b2, voffB); PG8_STAGE(PG8_SB(0, 1), b2 + hstep, voffB); PG8_STAGE(PG8_SA(0, 0), a2, voffA);
            PG8_WAIT_V(8); PG8_WAIT_L(0); PG8_BAR; PG8_MMA(1, 0, At, B0); PG8_MMA(1, 1, At, B1); PG8_BAR; PG8_SCHED;
            PG8_LDB(B0, 1, 0); PG8_LDB(B1, 1, 1); PG8_SCHED; PG8_LDA(At, 1, 0); PG8_STAGE(PG8_SA(0, 1), a2 + hstep, voffA);
            PG8_WAIT_V(8); PG8_WAIT_L(0); PG8_BAR; PG8_MMA(0, 0, At, B0); PG8_MMA(0, 1, At, B1); PG8_BAR; PG8_SCHED;
            PG8_LDA(At, 1, 1); PG8_STAGE(PG8_SB(1, 0), b3, voffB); PG8_STAGE(PG8_SB(1, 1), b3 + hstep, voffB); PG8_STAGE(PG8_SA(1, 0), a3, voffA);
            PG8_WAIT_V(8); PG8_WAIT_L(0); PG8_BAR; PG8_MMA(1, 0, At, B0); PG8_MMA(1, 1, At, B1); PG8_BAR; PG8_SCHED;
            } else {
            PG8_LDB(B0, 0, 0); PG8_SCHED; PG8_LDA(At, 0, 0); PG8_STAGE(PG8_SA(1, 1), a1 + hstep, voffA);
            PG8_WAIT_L(8); PG8_BAR; PG8_WAIT_L(0); PG8_MMA(0, 0, At, B0); PG8_BAR; PG8_SCHED;
            PG8_LDB(B1, 0, 1); PG8_STAGE(PG8_SB(0, 0), b2, voffB);
            PG8_BAR; PG8_WAIT_L(0); PG8_MMA(0, 1, At, B1); PG8_BAR;
            PG8_LDA(At, 0, 1); PG8_STAGE(PG8_SA(0, 0), a2, voffA);
            PG8_BAR; PG8_WAIT_L(0); PG8_MMA(1, 0, At, B0); PG8_BAR; PG8_SCHED;
            PG8_STAGE(PG8_SB(0, 1), b2 + hstep, voffB);
            PG8_WAIT_V(6); PG8_BAR; PG8_MMA(1, 1, At, B1); PG8_BAR;
            PG8_LDB(B0, 1, 0); PG8_SCHED; PG8_LDA(At, 1, 0); PG8_STAGE(PG8_SA(0, 1), a2 + hstep, voffA);
            PG8_WAIT_L(8); PG8_BAR; PG8_WAIT_L(0); PG8_MMA(0, 0, At, B0); PG8_BAR; PG8_SCHED;
            PG8_LDB(B1, 1, 1); PG8_STAGE(PG8_SB(1, 0), b3, voffB);
            PG8_BAR; PG8_WAIT_L(0); PG8_MMA(0, 1, At, B1); PG8_BAR;
            PG8_LDA(At, 1, 1); PG8_STAGE(PG8_SA(1, 0), a3, voffA);
            PG8_BAR; PG8_WAIT_L(0); PG8_MMA(1, 0, At, B0); PG8_BAR; PG8_SCHED;
            PG8_STAGE(PG8_SB(1, 1), b3 + hstep, voffB);
            PG8_WAIT_V(6); PG8_BAR; PG8_MMA(1, 1, At, B1); PG8_BAR;
            }
        }
        if constexpr (ALIGN_EPI) { if (wr == 0) PG8_BAR; }
        if constexpr (!Epi::AFTER_DRAIN) { E(acc, cur, wr, wc, fr, fq); S.done(cur); }
        if (!has_next) break;
#pragma unroll
        for (int a = 0; a < 2; ++a)
#pragma unroll
            for (int b = 0; b < 2; ++b)
#pragma unroll
                for (int m = 0; m < 4; ++m)
#pragma unroll
                    for (int n = 0; n < 2; ++n) acc[a][b][m][n] = (f32x4){0.f, 0.f, 0.f, 0.f};
        cur = nxt; cA = nA; cB = nB; ++ui;
        if constexpr (ALIGN_EPI) { if (wr == 1) PG8_BAR; }
    }
    PG8_WAIT_V(0);
    if constexpr (!ALIGN_EPI) { if (wr == 0) PG8_BAR; }
    PG8_BAR;
    if constexpr (Epi::AFTER_DRAIN) { E.fused(acc, cur, wr, wc, fr, fq, lds, wid, lane); S.done(cur); }
#undef PG8_SA
#undef PG8_SB
#undef PG8_STAGE
#undef PG8_LDA
#undef PG8_LDB
#undef PG8_MMA
#undef PG8_WAIT_V
#undef PG8_WAIT_L
#undef PG8_BAR
#undef PG8_SCHED
}
}
#define LAS __attribute__((address_space(3)))
typedef unsigned short bf16;
typedef unsigned v4u __attribute__((ext_vector_type(4)));
typedef unsigned v2u __attribute__((ext_vector_type(2)));
using pg8::f32x4; using pg8::bf16x8; using pg8::cvt_pk_bf16;

constexpr int D = 1024, FF = 2816, NLAYER = 4, TG = 16384, NGROUP = 4, NTHR = 512, NWAVES = 8;
constexpr int PA_LD = 5632, PG_LD = 3072;
constexpr int C_HQ = 0, C_HI = 512, C_HZF = 1024, C_HZB = 1536, C_HG = 2048, C_CA = 2560, C_CB = 3072, C_CC = 3584, C_NQ = 4096, C_NK = 4608, C_NV = 5120;
constexpr size_t MiB = 1u << 20;
constexpr size_t WS_CTL = 0, CTL_BYTES = 1 * MiB, WS_W = 1 * MiB, WS_XB = 221 * MiB, WS_SSQ = 253 * MiB, WS_PA = 254 * MiB, WS_PG = 430 * MiB, WS_O3 = 526 * MiB, WS_OD = 574 * MiB, WS_END = 638 * MiB;
constexpr size_t OFF_GU1 = 0, OFF_D1 = 5767168, OFF_IN = 8650752, OFF_HG = 17563648, OFF_CV = 18087936, OFF_NA = 18612224, OFF_OUT = 19136512, OFF_GU2 = 20185088, OFF_D2 = 25952256, LAYER_EL = 28835840;
constexpr int LDS_BYTES = 147456, LDS_MISC = 147456 - 64;
constexpr int CW_BAR = 4096;

__device__ __forceinline__ unsigned f2bf(float f) { unsigned u = __float_as_uint(f); return (u + 0x7fffu + ((u >> 16) & 1u)) >> 16; }
__device__ __forceinline__ float bf2f(unsigned b) { return __uint_as_float(b << 16); }
__device__ __forceinline__ float bflo(unsigned w) { return __uint_as_float(w << 16); }
__device__ __forceinline__ float bfhi(unsigned w) { return __uint_as_float(w & 0xffff0000u); }
__device__ __forceinline__ float sigm(float v) { return __builtin_amdgcn_rcpf(1.0f + __expf(-v)); }
__device__ __forceinline__ float wave_sum(float v) {
#pragma unroll
    for (int o = 1; o < 64; o <<= 1) v += __shfl_xor(v, o);
    return v;
}

__device__ __forceinline__ void cvt_item(const float* W, int K, int N, bf16* WT, const float* gain, bool permgu, LAS float* scr, int item, int lane) {
    const int nblk = N / 32, kb = item / nblk, nb = item % nblk, k0 = 64 * kb, n0 = 32 * nb;
#pragma unroll 8
    for (int i = 0; i < 32; ++i) { const int kk = 2 * i + (lane >> 5); const float g = gain ? gain[k0 + kk] : 1.0f; scr[kk * 33 + (lane & 31)] = W[(size_t)(k0 + kk) * N + n0 + (lane & 31)] * g; }
    asm volatile("s_waitcnt lgkmcnt(0)" ::: "memory");
    int dn0 = n0;
    if (permgu) { const int half = n0 >= FF ? 1 : 0; const int j = n0 - half * FF; dn0 = (j >> 7) * 256 + half * 128 + (j & 127); }
    const int c = lane & 7;
#pragma unroll
    for (int j = 0; j < 4; ++j) { const int n = (lane >> 3) + 8 * j; const LAS float* s = scr + (8 * c) * 33 + n;
        v4u o; o.x = cvt_pk_bf16(s[0 * 33], s[1 * 33]); o.y = cvt_pk_bf16(s[2 * 33], s[3 * 33]); o.z = cvt_pk_bf16(s[4 * 33], s[5 * 33]); o.w = cvt_pk_bf16(s[6 * 33], s[7 * 33]);
        *(v4u*)(WT + (size_t)(dn0 + n) * K + k0 + 8 * c) = o; }
    asm volatile("s_waitcnt lgkmcnt(0)" ::: "memory");
}

template <int K> __device__ __forceinline__ f32x4 mma_lds(f32x4 acc, const LAS bf16* A, int pa, const LAS bf16* B, int pb, int lane) {
    const int r = lane & 15, q = lane >> 4;
#pragma unroll
    for (int ks = 0; ks < K / 32; ++ks) {
        const bf16x8 a = *(const LAS bf16x8*)(A + r * pa + ks * 32 + q * 8);
        const bf16x8 b = *(const LAS bf16x8*)(B + r * pb + ks * 32 + q * 8);
        acc = __builtin_amdgcn_mfma_f32_16x16x32_bf16(a, b, acc, 0, 0, 0);
    }
    return acc;
}

constexpr int H_QT = 0, H_KT = 17408, H_KTT = 34816, H_VT = 53248, H_ST = 57856, H_AM = 66560, H_SEG = 75776, H_ER = 77824, H_EE = 78336;
__device__ __forceinline__ void hgrn2_item(LAS unsigned char* lds, const bf16* PA, float* OD, const float* lb_logits, int layer, int item, int T, int tid) {
    const int lane = tid & 63, wave = __builtin_amdgcn_readfirstlane(tid >> 6), c16 = lane & 15, quad = lane >> 4;
    const int vs = item & 3, dir = (item >> 2) & 1, h = (item >> 3) & 3, seq = item >> 5;
    const int base = seq * T;
    const int k = tid & 127, tq = tid >> 7;
    LAS bf16* QT = (LAS bf16*)(lds + H_QT); LAS bf16* KT = (LAS bf16*)(lds + H_KT); LAS bf16* KTT = (LAS bf16*)(lds + H_KTT);
    LAS bf16* VT = (LAS bf16*)(lds + H_VT); LAS bf16* STt = (LAS bf16*)(lds + H_ST); LAS bf16* AM = (LAS bf16*)(lds + H_AM);
    LAS float* SEG = (LAS float*)(lds + H_SEG); LAS float* ER = (LAS float*)(lds + H_ER); LAS float* EE = (LAS float*)(lds + H_EE);
    float lb;
    { float lg[4], mx = -3e38f;
#pragma unroll
      for (int l = 0; l < 4; ++l) { lg[l] = lb_logits[(dir * 4 + l) * 512 + h * 128 + k]; mx = fmaxf(mx, lg[l]); }
      float tot = 0.f, num = 0.f;
#pragma unroll
      for (int l = 0; l < 4; ++l) { const float e = __expf(lg[l] - mx); tot += e; if (l >= 1 && l <= layer) num += e; }
      lb = num / tot; }
    const float oml = 1.0f - lb;
    const int nchunk = T / 64;
    const bf16* zsrc = PA + (dir ? C_HZB : C_HZF) + h * 128 + k;
    const bf16* qsrc = PA + C_HQ + h * 128 + k;
    const bf16* vsrc = PA + C_HI + h * 128 + vs * 32 + (tid & 3) * 8;
    float* odst = OD + (size_t)dir * TG * 512 + h * 128 + vs * 32;
    unsigned short zr[16], qr[16]; v4u vr = {0u, 0u, 0u, 0u};
#define HG_ROW(tau) (base + (dir ? (T - 1 - (tau)) : (tau)))
#define HG_LOAD(c) do { _Pragma("unroll") for (int i = 0; i < 16; ++i) { const size_t ro = (size_t)HG_ROW((c) * 64 + 16 * tq + i) * PA_LD; zr[i] = zsrc[ro]; qr[i] = qsrc[ro]; } \
        if (tid < 256) vr = *(const v4u*)(vsrc + (size_t)HG_ROW((c) * 64 + (tid >> 2)) * PA_LD); } while (0)
    HG_LOAD(0);
    f32x4 accS[2]; accS[0] = (f32x4){0.f, 0.f, 0.f, 0.f}; accS[1] = accS[0];
    for (int c = 0; c < nchunk; ++c) {
        float b[16], kv[16]; float cum = 0.f;
#pragma unroll
        for (int i = 0; i < 16; ++i) { const float zf = bf2f(zr[i]); const float sg = sigm(zf); const float f = lb + oml * sg; cum += __logf(fmaxf(f, 1e-30f)); b[i] = cum; kv[i] = oml * (1.0f - sg); }
        SEG[tq * 128 + k] = cum;
        __syncthreads();
        const float s0 = SEG[k], s1 = SEG[128 + k], s2 = SEG[256 + k], s3 = SEG[384 + k];
        const float pre = tq == 0 ? 0.f : (tq == 1 ? s0 : (tq == 2 ? s0 + s1 : (s0 + s1) + s2));
        const float r = s0 + s1, bend = (s0 + s1) + (s2 + s3);
        unsigned kpk[8];
#pragma unroll
        for (int i = 0; i < 16; ++i) {
            const float bt = pre + b[i];
            const float eq = __expf(fminf(bt - r, 80.f)), ek = __expf(fminf(r - bt, 80.f));
            const unsigned qb = f2bf(bf2f(qr[i]) * eq), kb = f2bf(kv[i] * ek);
            const int tau = 16 * tq + i;
            QT[tau * 136 + k] = (bf16)qb; KT[tau * 136 + k] = (bf16)kb;
            if (i & 1) kpk[i >> 1] |= kb << 16; else kpk[i >> 1] = kb;
        }
        *(LAS v4u*)(KTT + k * 72 + 16 * tq) = (v4u){kpk[0], kpk[1], kpk[2], kpk[3]};
        *(LAS v4u*)(KTT + k * 72 + 16 * tq + 8) = (v4u){kpk[4], kpk[5], kpk[6], kpk[7]};
        if (tq == 0) { ER[k] = __expf(r); EE[k] = __expf(bend - r); }
        if (tid < 256) { const int s = tid >> 2, vq = tid & 3;
            VT[(vq * 8 + 0) * 72 + s] = (bf16)(vr.x & 0xffffu); VT[(vq * 8 + 1) * 72 + s] = (bf16)(vr.x >> 16);
            VT[(vq * 8 + 2) * 72 + s] = (bf16)(vr.y & 0xffffu); VT[(vq * 8 + 3) * 72 + s] = (bf16)(vr.y >> 16);
            VT[(vq * 8 + 4) * 72 + s] = (bf16)(vr.z & 0xffffu); VT[(vq * 8 + 5) * 72 + s] = (bf16)(vr.z >> 16);
            VT[(vq * 8 + 6) * 72 + s] = (bf16)(vr.w & 0xffffu); VT[(vq * 8 + 7) * 72 + s] = (bf16)(vr.w >> 16); }
        __syncthreads();
        if (c + 1 < nchunk) HG_LOAD(c + 1);
#pragma unroll
        for (int e = 0; e < 2; ++e) { const int id = wave * 2 + e, tt = id >> 2, st = id & 3;
            f32x4 a = (f32x4){0.f, 0.f, 0.f, 0.f};
            if (st <= tt) a = mma_lds<128>(a, QT + tt * 16 * 136, 136, KT + st * 16 * 136, 136, lane);
#pragma unroll
            for (int i = 0; i < 4; ++i) { const int t = tt * 16 + quad * 4 + i, s = st * 16 + c16; const float val = (st <= tt && s <= t) ? a[i] : 0.f; AM[t * 72 + s] = (bf16)f2bf(val); } }
        { const f32x4 erv = *(const LAS f32x4*)(ER + wave * 16 + quad * 4);
#pragma unroll
          for (int e = 0; e < 2; ++e) { const f32x4 sp = accS[e] * erv; v2u w; w.x = cvt_pk_bf16(sp[0], sp[1]); w.y = cvt_pk_bf16(sp[2], sp[3]);
              *(LAS v2u*)(STt + (e * 16 + c16) * 136 + wave * 16 + quad * 4) = w; } }
        __syncthreads();
        { const int tt = wave & 3, vt = wave >> 2; f32x4 o = (f32x4){0.f, 0.f, 0.f, 0.f};
          o = mma_lds<128>(o, QT + tt * 16 * 136, 136, STt + vt * 16 * 136, 136, lane);
          o = mma_lds<64>(o, AM + tt * 16 * 72, 72, VT + vt * 16 * 72, 72, lane);
#pragma unroll
          for (int i = 0; i < 4; ++i) { const int tau = c * 64 + tt * 16 + quad * 4 + i; odst[(size_t)HG_ROW(tau) * 512 + vt * 16 + c16] = o[i]; } }
        { const f32x4 erv = *(const LAS f32x4*)(ER + wave * 16 + quad * 4); const f32x4 eev = *(const LAS f32x4*)(EE + wave * 16 + quad * 4);
#pragma unroll
          for (int e = 0; e < 2; ++e) { f32x4 sp = accS[e] * erv; sp = mma_lds<64>(sp, KTT + wave * 16 * 72, 72, VT + e * 16 * 72, 72, lane); accS[e] = sp * eev; } }
    }
    __syncthreads();
#undef HG_ROW
#undef HG_LOAD
}

__device__ __forceinline__ void na_item(LAS unsigned char* lds, const bf16* PA, const float* rpb, bf16* ONA, int item, int T, int tid) {
    const int lane = tid & 63, h = __builtin_amdgcn_readfirstlane(tid >> 6), c16 = lane & 15, quad = lane >> 4;
    const int ips = T / 16, seq = item / ips, rem = item % ips, r = rem >> 2, j = rem & 3;
    const int rows = T / 64, rs = min(max(r - 4, 0), rows - 8), kstart = (j == 0) ? 0 : (j == 1) ? 8 : (j == 2) ? 24 : 32;
    const int base = seq * T, qtok = base + r * 64 + 16 * j + c16;
    const bf16* qp = PA + (size_t)qtok * PA_LD + C_NQ + h * 64 + quad * 8;
    const bf16x8 Qb0 = *(const bf16x8*)qp, Qb1 = *(const bf16x8*)(qp + 32);
    const int qcol = 16 * j + c16, cs = min(max(qcol - 8, 0), 48);
    const float* rp = rpb + h * 465;
    f32x4 sacc[16]; float mx = -3e38f;
#pragma unroll
    for (int a = 0; a < 8; ++a)
#pragma unroll
        for (int hh = 0; hh < 2; ++hh) {
            const int ktok = base + (rs + a) * 64 + kstart + hh * 16 + c16;
            const bf16* kp = PA + (size_t)ktok * PA_LD + C_NK + h * 64 + quad * 8;
            const bf16x8 Ka0 = *(const bf16x8*)kp, Ka1 = *(const bf16x8*)(kp + 32);
            f32x4 s = (f32x4){0.f, 0.f, 0.f, 0.f};
            s = __builtin_amdgcn_mfma_f32_16x16x32_bf16(Ka0, Qb0, s, 0, 0, 0);
            s = __builtin_amdgcn_mfma_f32_16x16x32_bf16(Ka1, Qb1, s, 0, 0, 0);
            const int dr = rs + a - r + 7;
#pragma unroll
            for (int i = 0; i < 4; ++i) { const int kcol = kstart + hh * 16 + quad * 4 + i; const bool ok = (kcol >= cs) && (kcol < cs + 16); const int dc = min(max(kcol - qcol + 15, 0), 30);
                const float val = ok ? s[i] * 0.125f + rp[dr * 31 + dc] : -1e30f; s[i] = val; mx = fmaxf(mx, val); }
            sacc[a * 2 + hh] = s;
        }
    mx = fmaxf(mx, __shfl_xor(mx, 16)); mx = fmaxf(mx, __shfl_xor(mx, 32));
    float sum = 0.f;
#pragma unroll
    for (int t = 0; t < 16; ++t)
#pragma unroll
        for (int i = 0; i < 4; ++i) { const float p = __expf(sacc[t][i] - mx); sacc[t][i] = p; sum += p; }
    sum += __shfl_xor(sum, 16); sum += __shfl_xor(sum, 32);
    bf16x8 pb[8];
#pragma unroll
    for (int a = 0; a < 8; ++a) { v4u w; w.x = cvt_pk_bf16(sacc[2 * a][0], sacc[2 * a][1]); w.y = cvt_pk_bf16(sacc[2 * a][2], sacc[2 * a][3]);
        w.z = cvt_pk_bf16(sacc[2 * a + 1][0], sacc[2 * a + 1][1]); w.w = cvt_pk_bf16(sacc[2 * a + 1][2], sacc[2 * a + 1][3]); pb[a] = __builtin_bit_cast(bf16x8, w); }
    LAS bf16* VT = (LAS bf16*)(lds + h * 17408);
    f32x4 oacc[4];
#pragma unroll
    for (int dt = 0; dt < 4; ++dt) oacc[dt] = (f32x4){0.f, 0.f, 0.f, 0.f};
#pragma unroll
    for (int half = 0; half < 2; ++half) {
        __syncthreads();
#pragma unroll 4
        for (int it = 0; it < 16; ++it) { const int idx = it * 64 + lane, key = idx >> 3, dg = idx & 7, al = key >> 5, kc = key & 31;
            const int tok = base + (rs + half * 4 + al) * 64 + kstart + kc;
            const v4u vec = *(const v4u*)(PA + (size_t)tok * PA_LD + C_NV + h * 64 + dg * 8);
            LAS bf16* vp = VT + (dg * 8) * 136 + key;
            vp[0 * 136] = (bf16)(vec.x & 0xffffu); vp[1 * 136] = (bf16)(vec.x >> 16); vp[2 * 136] = (bf16)(vec.y & 0xffffu); vp[3 * 136] = (bf16)(vec.y >> 16);
            vp[4 * 136] = (bf16)(vec.z & 0xffffu); vp[5 * 136] = (bf16)(vec.z >> 16); vp[6 * 136] = (bf16)(vec.w & 0xffffu); vp[7 * 136] = (bf16)(vec.w >> 16); }
        __syncthreads();
#pragma unroll
        for (int al = 0; al < 4; ++al)
#pragma unroll
            for (int dt = 0; dt < 4; ++dt) { const LAS bf16* p = VT + (dt * 16 + c16) * 136 + al * 32 + quad * 4;
                const v2u lo = *(const LAS v2u*)p, hi = *(const LAS v2u*)(p + 16);
                const bf16x8 af = __builtin_bit_cast(bf16x8, (v4u){lo.x, lo.y, hi.x, hi.y});
                oacc[dt] = __builtin_amdgcn_mfma_f32_16x16x32_bf16(af, pb[half * 4 + al], oacc[dt], 0, 0, 0); }
    }
    const float inv = __builtin_amdgcn_rcpf(sum);
#pragma unroll
    for (int dt = 0; dt < 4; ++dt) { const f32x4 o = oacc[dt] * inv; v2u w; w.x = cvt_pk_bf16(o[0], o[1]); w.y = cvt_pk_bf16(o[2], o[3]);
        *(v2u*)(ONA + (size_t)qtok * 512 + h * 64 + dt * 16 + quad * 4) = w; }
}

#define XB_TMO      128
#define XB_XCNT(j)  (256  + 64 * (j))
#define XB_XSUB(j)  (1280 + 64 * (j))
#define XB_XGEN(j)  (2304 + 64 * (j))
#define XB_TOP      3328
#define XB_TOPGEN   3392
#define XCD_BAR_WORDS 3456
#define XB_SPIN_CAP (1u << 18)

__device__ __forceinline__ unsigned xb_ld(unsigned* p)              { return __hip_atomic_load(p, __ATOMIC_RELAXED, __HIP_MEMORY_SCOPE_AGENT); }
__device__ __forceinline__ unsigned xb_add(unsigned* p, unsigned v) { return __hip_atomic_fetch_add(p, v, __ATOMIC_RELAXED, __HIP_MEMORY_SCOPE_AGENT); }
__device__ __forceinline__ unsigned xb_xcc_id() { return (unsigned)__builtin_amdgcn_s_getreg((3 << 11) | 20) & 0xFu; }
#define XB_SPIN(cond, bar) do { unsigned _sp = 0; while (cond) { __builtin_amdgcn_s_sleep(1); \
    if ((++_sp & 255u) == 0u) { if (xb_ld(&(bar)[XB_TMO])) break; if (_sp > XB_SPIN_CAP) { atomicAdd(&(bar)[XB_TMO], 1u); break; } } } } while (0)

struct XcdBarrier {
    unsigned* bar; unsigned x;
    volatile LAS unsigned* st;
};

__device__ __forceinline__ XcdBarrier xcd_barrier_post(unsigned* bar, volatile LAS unsigned* st) {
    XcdBarrier b; b.bar = bar; b.x = xb_xcc_id(); b.st = st;
    if (threadIdx.x == 0) (void)xb_add(&bar[XB_XCNT(b.x)], 1u);
    return b;
}
__device__ __forceinline__ void xcd_barrier_complete(unsigned* bar, unsigned x, unsigned& nloc, unsigned& nx) {
    const unsigned G = gridDim.x * gridDim.y * gridDim.z;
    unsigned sum, cnt, mine, sp = 0u;
    for (;;) {
        sum = 0u; cnt = 0u; mine = 0u;
#pragma unroll
        for (unsigned j = 0; j < 16; ++j) { const unsigned c = xb_ld(&bar[XB_XCNT(j)]); sum += c; cnt += (c > 0u) ? 1u : 0u; mine = (j == x) ? c : mine; }
        if (sum == G) break;
        __builtin_amdgcn_s_sleep(1);
        if ((++sp & 255u) == 0u) { if (xb_ld(&bar[XB_TMO])) break; if (sp > XB_SPIN_CAP) { atomicAdd(&bar[XB_TMO], 1u); break; } }
    }
    nloc = mine > 0u ? mine : 1u; nx = cnt > 0u ? cnt : 1u;
}

__device__ __forceinline__ void xcd_barrier(const XcdBarrier& b) {
    asm volatile("s_waitcnt vmcnt(0)" ::: "memory");
    __syncthreads();
    if (threadIdx.x == 0) {
        unsigned* bar = b.bar;
        __builtin_amdgcn_s_waitcnt(0);
        unsigned nloc = b.st[0], nx = b.st[1];
        if (nloc == 0u) { xcd_barrier_complete(bar, b.x, nloc, nx); b.st[0] = nloc; b.st[1] = nx; }
        const unsigned old = xb_add(&bar[XB_XSUB(b.x)], 1u);
        const unsigned gen = old / nloc;
        if (old + 1u == (gen + 1u) * nloc) {
            __builtin_amdgcn_fence(__ATOMIC_RELEASE, "agent");
            asm volatile("s_waitcnt vmcnt(0)" ::: "memory");
            const unsigned og = xb_add(&bar[XB_TOP], 1u);
            const unsigned tg = og / nx;
            if (og + 1u == (tg + 1u) * nx) xb_add(&bar[XB_TOPGEN], 1u);
            else XB_SPIN(xb_ld(&bar[XB_TOPGEN]) == tg, bar);
            __builtin_amdgcn_fence(__ATOMIC_ACQUIRE, "agent");
            xb_add(&bar[XB_XGEN(b.x)], 1u);
            asm volatile("s_waitcnt vmcnt(0)" ::: "memory");
        } else {
            XB_SPIN(xb_ld(&bar[XB_XGEN(b.x)]) == gen, bar);
            __builtin_amdgcn_fence(__ATOMIC_ACQUIRE, "agent");
            asm volatile("s_waitcnt vmcnt(0)" ::: "memory");
        }
    }
    __syncthreads();
}
struct Args { const float* in[20]; float* out; unsigned char* ws; int ph_lo, ph_hi; };
enum { K_CVT = 0, K_G0, K_UP, K_RES, K_M1, K_M2, K_M3, K_M4, K_GF };

__global__ void __launch_bounds__(NTHR, 2) mk_fwd(Args args) {
    extern __shared__ __attribute__((aligned(16))) unsigned char lds_raw[];
    LAS unsigned char* lds = (LAS unsigned char*)lds_raw;
    cg::grid_group grid = cg::this_grid();
    const int hi = args.ph_hi;
    { volatile LAS unsigned* st0 = (volatile LAS unsigned*)(lds + LDS_MISC + 32); if (threadIdx.x < 2) st0[threadIdx.x] = 0u; __syncthreads(); }
    XcdBarrier xbar = xcd_barrier_post((unsigned*)(args.ws + WS_CTL) + CW_BAR, (volatile LAS unsigned*)(lds + LDS_MISC + 32));
    for (int ph = args.ph_lo; ph < hi; ++ph) {
        int bid = blockIdx.x, G = gridDim.x; asm volatile("" : "+s"(bid), "+s"(G));
        int tid = threadIdx.x; asm volatile("" : "+v"(tid));
        const int lane = tid & 63, wave = __builtin_amdgcn_readfirstlane(tid >> 6);
        const int gw = bid * NWAVES + wave, NGW = G * NWAVES;
        int kind, g = 0, l = 0, s = 0;
        if (ph == 0) kind = K_CVT;
        else { const int q = ph - 1; g = q / 38; const int r = q % 38;
            if (r == 0) kind = K_G0; else if (r == 37) kind = K_GF;
            else { l = (r - 1) / 9; s = (r - 1) % 9; kind = (s == 0 || s == 7) ? K_UP : (s == 1 || s == 8 || s == 6) ? K_RES : (s == 2) ? K_M1 : (s == 3) ? K_M2 : (s == 4) ? K_M3 : K_M4; } }
        unsigned char* ws = args.ws;
        bf16* XB = (bf16*)(ws + WS_XB); float* SSQ = (float*)(ws + WS_SSQ);
        bf16* PA = (bf16*)(ws + WS_PA); bf16* PG = (bf16*)(ws + WS_PG);
        bf16* OHG = (bf16*)(ws + WS_O3); bf16* OCV = OHG + (size_t)TG * 512; bf16* ONA = OCV + (size_t)TG * 512;
        float* OD = (float*)(ws + WS_OD);
        const bf16* Wl = (const bf16*)(ws + WS_W) + (size_t)l * LAYER_EL;
        const int T = g < 2 ? 2048 : 4096;
        float* X = args.out + (size_t)g * TG * D;

        if (kind == K_CVT) {
            LAS float* scr = (LAS float*)(lds + wave * 16384);
            constexpr int I_GU = 16 * 176, I_DN = 44 * 32, I_IN = 16 * 272, I_MX = 8 * 32, I_OUT = 16 * 32;
            constexpr int I_LAYER = 2 * I_GU + 2 * I_DN + I_IN + 3 * I_MX + I_OUT;
            for (int it = gw; it < NLAYER * I_LAYER; it += NGW) {
                const int ll = it / I_LAYER; int r = it % I_LAYER; bf16* Wd = (bf16*)(ws + WS_W) + (size_t)ll * LAYER_EL;
                const float* src; const float* gain = nullptr; int K, N; size_t off; bool perm = false;
                if (r < I_GU) { src = args.in[3] + (size_t)ll * D * 2 * FF; K = D; N = 2 * FF; off = OFF_GU1; gain = args.in[2] + ll * D; perm = true; }
                else if ((r -= I_GU) < I_DN) { src = args.in[4] + (size_t)ll * FF * D; K = FF; N = D; off = OFF_D1; }
                else if ((r -= I_DN) < I_IN) { src = args.in[6] + (size_t)ll * D * 8704; K = D; N = 8704; off = OFF_IN; gain = args.in[5] + ll * D; }
                else if ((r -= I_IN) < I_MX) { src = args.in[9] + (size_t)ll * 512 * D; K = 512; N = D; off = OFF_HG; }
                else if ((r -= I_MX) < I_MX) { src = args.in[12] + (size_t)ll * 512 * D; K = 512; N = D; off = OFF_CV; }
                else if ((r -= I_MX) < I_MX) { src = args.in[14] + (size_t)ll * 512 * D; K = 512; N = D; off = OFF_NA; }
                else if ((r -= I_MX) < I_OUT) { src = args.in[15] + (size_t)ll * D * D; K = D; N = D; off = OFF_OUT; }
                else if ((r -= I_OUT) < I_GU) { src = args.in[17] + (size_t)ll * D * 2 * FF; K = D; N = 2 * FF; off = OFF_GU2; gain = args.in[16] + ll * D; perm = true; }
                else { r -= I_GU; src = args.in[18] + (size_t)ll * FF * D; K = FF; N = D; off = OFF_D2; }
                cvt_item(src, K, N, Wd + off, gain, perm, scr, r, lane);
            }
        } else if (kind == K_G0) {
            const float* xin = (g < 2 ? args.in[0] : args.in[1]) + (size_t)(g & 1) * TG * D;
            for (int row = gw; row < TG; row += NGW) {
                const f32x4* xr = (const f32x4*)(xin + (size_t)row * D) + lane; f32x4* xo = (f32x4*)(X + (size_t)row * D) + lane; v2u* bo = (v2u*)(XB + (size_t)row * D) + lane;
                float ss = 0.f;
#pragma unroll
                for (int j = 0; j < 4; ++j) { const f32x4 v = xr[64 * j]; xo[64 * j] = v; v2u w; w.x = cvt_pk_bf16(v[0], v[1]); w.y = cvt_pk_bf16(v[2], v[3]); bo[64 * j] = w; ss += (v[0] * v[0] + v[1] * v[1]) + (v[2] * v[2] + v[3] * v[3]); }
                ss = wave_sum(ss);
                if (lane < 16) SSQ[(size_t)row * 16 + lane] = lane == 0 ? ss : 0.f;
            }
        } else if (kind == K_UP) {
            pg8::Gemm gm{XB, Wl + (s == 7 ? OFF_GU2 : OFF_GU1), TG, 2 * FF, D}; pg8::StaticOrder S; S.init(TG, 2 * FF, G, bid);
            pg8::EpiSwiGLU E{PA, SSQ};
#ifndef NO_UP
            for (int rep = 0; rep < REP_GEMM; ++rep) pg8::gemm_phase<pg8::EpiSwiGLU, pg8::StaticOrder, true, true>(lds, gm, S, E);
#endif
        } else if (kind == K_RES) {
            const int K = (s == 6) ? D : FF; const size_t off = (s == 6) ? OFF_OUT : (s == 1 ? OFF_D1 : OFF_D2);
            pg8::Gemm gm{PA, Wl + off, TG, D, K}; pg8::StaticOrder S; S.init(TG, D, G, bid);
            pg8::EpiRes E{X, XB, SSQ, (s == 6) ? 1.0f : 0.5f};
#ifndef NO_RES
            pg8::gemm_phase<pg8::EpiRes, pg8::StaticOrder, true, true>(lds, gm, S, E);
#endif
        } else if (kind == K_M1) {
            pg8::Gemm gm{XB, Wl + OFF_IN, TG, 8704, D}; pg8::StaticOrder S; S.init(TG, 8704, G, bid);
            pg8::EpiProj E{PA, PG, SSQ};
#ifndef NO_PROJ
            for (int rep = 0; rep < REP_GEMM; ++rep) pg8::gemm_phase<pg8::EpiProj, pg8::StaticOrder, true, true>(lds, gm, S, E);
#endif
        } else if (kind == K_M2) {
            const int nH = (TG / T) * 32;
#ifndef NO_HG
            for (int rep = 0; rep < REP_HG; ++rep) for (int it = bid; it < nH; it += G) hgrn2_item(lds, PA, OD, args.in[7], l, it, T, tid);
#endif
            LAS int* slot = (LAS int*)(lds + LDS_MISC);
            const float* rpb = args.in[13] + (size_t)l * 8 * 465;
            for (int rep = 0; rep < REP_NA; ++rep) {
            unsigned* cnt = (unsigned*)(ws + WS_CTL) + 64 * (1 + g * NLAYER + l) + 16 * rep;
            for (;;) {
                __syncthreads();
                if (tid == 0) *slot = (int)__hip_atomic_fetch_add(cnt, 1u, __ATOMIC_RELAXED, __HIP_MEMORY_SCOPE_AGENT);
                __syncthreads();
                const int it = *slot;
                if (it >= TG / 16) break;
#ifndef NO_NA
                na_item(lds, PA, rpb, ONA, it, T, tid);
#endif
            }
            }
        } else if (kind == K_M3) {
            const float* gno = args.in[8] + l * 512; const float* cw = args.in[10] + l * 3 * 512; const float* cbias = args.in[11] + l * 512;
            const int c0 = lane * 8;
            for (int rep = 0; rep < REP_M3; ++rep) for (int row = gw; row < TG; row += NGW) {
                const f32x4* pf = (const f32x4*)(OD + (size_t)row * 512 + c0); const f32x4* pbk = (const f32x4*)(OD + (size_t)TG * 512 + (size_t)row * 512 + c0);
                const f32x4 f0 = pf[0], f1 = pf[1], b0 = pbk[0], b1 = pbk[1];
                float o[8]; float ss = 0.f;
#pragma unroll
                for (int e = 0; e < 4; ++e) { o[e] = f0[e] + b0[e]; o[4 + e] = f1[e] + b1[e]; }
#pragma unroll
                for (int e = 0; e < 8; ++e) ss += o[e] * o[e];
                ss += __shfl_xor(ss, 1); ss += __shfl_xor(ss, 2); ss += __shfl_xor(ss, 4); ss += __shfl_xor(ss, 8);
                const float rs = __builtin_amdgcn_rsqf(ss * (1.0f / 128.0f) + 1e-6f);
                const bf16* prow = PA + (size_t)row * PA_LD;
                const v4u hgw = *(const v4u*)(prow + C_HG + c0);
                const float hgv[8] = {bflo(hgw.x), bfhi(hgw.x), bflo(hgw.y), bfhi(hgw.y), bflo(hgw.z), bfhi(hgw.z), bflo(hgw.w), bfhi(hgw.w)};
                const f32x4 gn0 = *(const f32x4*)(gno + c0), gn1 = *(const f32x4*)(gno + c0 + 4);
                const float gn[8] = {gn0[0], gn0[1], gn0[2], gn0[3], gn1[0], gn1[1], gn1[2], gn1[3]};
                float r8[8];
#pragma unroll
                for (int e = 0; e < 8; ++e) r8[e] = o[e] * rs * gn[e] * (hgv[e] * sigm(hgv[e]));
                v4u wo; wo.x = cvt_pk_bf16(r8[0], r8[1]); wo.y = cvt_pk_bf16(r8[2], r8[3]); wo.z = cvt_pk_bf16(r8[4], r8[5]); wo.w = cvt_pk_bf16(r8[6], r8[7]);
                *(v4u*)(OHG + (size_t)row * 512 + c0) = wo;
                const int tl = row & (T - 1);
                const v4u a1 = *(const v4u*)(prow + C_CA + c0), c1 = *(const v4u*)(prow + C_CC + c0), bb = *(const v4u*)(prow + C_CB + c0);
                v4u a0 = {0u, 0u, 0u, 0u}, cc0 = a0, a2 = a0, cc2 = a0;
                if (tl > 0) { a0 = *(const v4u*)(prow - PA_LD + C_CA + c0); cc0 = *(const v4u*)(prow - PA_LD + C_CC + c0); }
                if (tl < T - 1) { a2 = *(const v4u*)(prow + PA_LD + C_CA + c0); cc2 = *(const v4u*)(prow + PA_LD + C_CC + c0); }
                const float zm[8] = {bflo(a0.x) * bflo(cc0.x), bfhi(a0.x) * bfhi(cc0.x), bflo(a0.y) * bflo(cc0.y), bfhi(a0.y) * bfhi(cc0.y), bflo(a0.z) * bflo(cc0.z), bfhi(a0.z) * bfhi(cc0.z), bflo(a0.w) * bflo(cc0.w), bfhi(a0.w) * bfhi(cc0.w)};
                const float zc[8] = {bflo(a1.x) * bflo(c1.x), bfhi(a1.x) * bfhi(c1.x), bflo(a1.y) * bflo(c1.y), bfhi(a1.y) * bfhi(c1.y), bflo(a1.z) * bflo(c1.z), bfhi(a1.z) * bfhi(c1.z), bflo(a1.w) * bflo(c1.w), bfhi(a1.w) * bfhi(c1.w)};
                const float zp[8] = {bflo(a2.x) * bflo(cc2.x), bfhi(a2.x) * bfhi(cc2.x), bflo(a2.y) * bflo(cc2.y), bfhi(a2.y) * bfhi(cc2.y), bflo(a2.z) * bflo(cc2.z), bfhi(a2.z) * bfhi(cc2.z), bflo(a2.w) * bflo(cc2.w), bfhi(a2.w) * bfhi(cc2.w)};
                const float cbv[8] = {bflo(bb.x), bfhi(bb.x), bflo(bb.y), bfhi(bb.y), bflo(bb.z), bfhi(bb.z), bflo(bb.w), bfhi(bb.w)};
                const f32x4 w00 = *(const f32x4*)(cw + c0), w01 = *(const f32x4*)(cw + c0 + 4), w10 = *(const f32x4*)(cw + 512 + c0), w11 = *(const f32x4*)(cw + 512 + c0 + 4);
                const f32x4 w20 = *(const f32x4*)(cw + 1024 + c0), w21 = *(const f32x4*)(cw + 1024 + c0 + 4), bs0 = *(const f32x4*)(cbias + c0), bs1 = *(const f32x4*)(cbias + c0 + 4);
#pragma unroll
                for (int e = 0; e < 4; ++e) { r8[e] = cbv[e] * (w00[e] * zm[e] + w10[e] * zc[e] + w20[e] * zp[e] + bs0[e]); r8[4 + e] = cbv[4 + e] * (w01[e] * zm[4 + e] + w11[e] * zc[4 + e] + w21[e] * zp[4 + e] + bs1[e]); }
                wo.x = cvt_pk_bf16(r8[0], r8[1]); wo.y = cvt_pk_bf16(r8[2], r8[3]); wo.z = cvt_pk_bf16(r8[4], r8[5]); wo.w = cvt_pk_bf16(r8[6], r8[7]);
                *(v4u*)(OCV + (size_t)row * 512 + c0) = wo;
            }
        } else if (kind == K_M4) {
            pg8::StaticOrder S; S.init(TG, D, G, bid);
            { pg8::Gemm gm{OHG, Wl + OFF_HG, TG, D, 512}; pg8::EpiMerge<0> E{PG, OD, PA};
#ifndef NO_MERGE
            pg8::gemm_phase<pg8::EpiMerge<0>, pg8::StaticOrder, true, true>(lds, gm, S, E);
#endif
            }
            { pg8::Gemm gm{OCV, Wl + OFF_CV, TG, D, 512}; pg8::EpiMerge<1> E{PG, OD, PA};
#ifndef NO_MERGE
            pg8::gemm_phase<pg8::EpiMerge<1>, pg8::StaticOrder, true, true>(lds, gm, S, E);
#endif
            }
            { pg8::Gemm gm{ONA, Wl + OFF_NA, TG, D, 512}; pg8::EpiMerge<2> E{PG, OD, PA};
#ifndef NO_MERGE
            pg8::gemm_phase<pg8::EpiMerge<2>, pg8::StaticOrder, true, true>(lds, gm, S, E);
#endif
            }
        } else {
            const f32x4* fg = (const f32x4*)args.in[19] + lane;
            for (int row = gw; row < TG; row += NGW) {
                const float rs = pg8::row_rs(SSQ, row);
                f32x4* xo = (f32x4*)(X + (size_t)row * D) + lane;
#pragma unroll
                for (int j = 0; j < 4; ++j) xo[64 * j] = xo[64 * j] * fg[64 * j] * rs;
            }
        }
        if (ph + 1 < hi) { for (int rep = 0; rep < REP_SYNC; ++rep) { if (ph == 0) grid.sync(); else xcd_barrier(xbar); } }
    }
}
constexpr int N_PHASES = 1 + NGROUP * (1 + NLAYER * 9 + 1);

extern "C" void kernel_launch(void* const* d_in, const int* in_sizes, int n_in, void* d_out, int out_size, void* d_ws, size_t ws_size, hipStream_t stream) {
    static int grid = 0;
    if (grid == 0) {
        if (n_in != 20 || ws_size < WS_END) { fprintf(stderr, "kernel_launch: unexpected n_in %d / ws %zu\n", n_in, ws_size); grid = -1; return; }
        int dev = 0, cus = 0, per_cu = 0;
        hipGetDevice(&dev); hipDeviceGetAttribute(&cus, hipDeviceAttributeMultiprocessorCount, dev);
        hipFuncSetAttribute((const void*)mk_fwd, hipFuncAttributeMaxDynamicSharedMemorySize, LDS_BYTES);
        hipOccupancyMaxActiveBlocksPerMultiprocessor(&per_cu, (const void*)mk_fwd, NTHR, LDS_BYTES);
        if (per_cu < 1) per_cu = 1;
        grid = cus * per_cu;
        (void)hipGetLastError();
    }
    if (grid < 0) return;
    hipMemsetAsync((char*)d_ws + WS_CTL, 0, CTL_BYTES, stream);
    Args a{};
    for (int i = 0; i < 20; ++i) a.in[i] = (const float*)d_in[i];
    a.out = (float*)d_out; a.ws = (unsigned char*)d_ws;
#if ONE_LAUNCH
    a.ph_lo = 0; a.ph_hi = N_PHASES;
    void* kargs[] = {&a};
    hipError_t e = hipLaunchCooperativeKernel((const void*)mk_fwd, dim3(grid), dim3(NTHR), kargs, LDS_BYTES, stream);
    if (e != hipSuccess) fprintf(stderr, "cooperative launch failed: %s (grid %d)\n", hipGetErrorString(e), grid);
#else
    for (int p = 0; p < N_PHASES; ++p) { a.ph_lo = p; a.ph_hi = p + 1; hipLaunchKernelGGL(mk_fwd, dim3(grid), dim3(NTHR), LDS_BYTES, stream, a); }
#endif
}
```

```cpp
#include <hip/hip_runtime.h>
#include <hip/hip_cooperative_groups.h>
#include <cstdio>
#include <cstdint>
namespace cg = cooperative_groups;
#ifndef ONE_LAUNCH
#define ONE_LAUNCH 1
#endif
#ifndef REP_HG
#define REP_HG 1
#endif
#ifndef REP_NA
#define REP_NA 1
#endif
#ifndef REP_SYNC
#define REP_SYNC 1
#endif
#ifndef REP_GEMM
#define REP_GEMM 1
#endif
#ifndef REP_M3
#define REP_M3 1
#endif
namespace pg8 {
#define PG8_LAS __attribute__((address_space(3)))
typedef unsigned short bf16_t;
typedef short bf16x8 __attribute__((ext_vector_type(8)));
typedef float f32x4 __attribute__((ext_vector_type(4)));
typedef unsigned u32x4 __attribute__((ext_vector_type(4)));
constexpr int BM = 256, BK = 64, HALF = 128, HTB = HALF * BK * 2  , STAGE_BYTES = 8 * HTB, NXCD = 8, WGM = 8;

__host__ __device__ __forceinline__ int lds_byte(int r, int c) { const int st = (r >> 4) * 2 + (c >> 5), rr = r & 15, cc = c & 31, ob = rr * 64 + cc * 2; return st * 1024 + (ob ^ (((ob >> 9) & 1) << 5)); }
__host__ __device__ __forceinline__ void stage_rc(int b, int& R, int& C) { const int st = b / 1024, sb = b % 1024, swz = sb ^ (((sb >> 9) & 1) << 5); R = (st >> 1) * 16 + swz / 64; C = (st & 1) * 32 + (swz % 64) / 2; }
__host__ __device__ __forceinline__ int perm32(int rho) { const int n = rho >> 4, i = rho & 15; return 8 * (i >> 2) + 4 * n + (i & 3); }

struct Unit { int pm, pn; };
struct Gemm { const bf16_t* A; const bf16_t* Bt; int M, N, K; };

struct StaticOrder {
    int nM, nN, nwg, G, c;
    __host__ __device__ void init(int M, int N, int G_, int c_) { nM = M / BM; nN = N / BM; nwg = nM * nN; G = G_; c = c_; }
    __host__ __device__ bool next(int i, Unit& u) const {
        const long L = (long)i * G + c; if (L >= nwg) return false;
        int wgid = (int)L; { const int q = nwg / NXCD, r = nwg % NXCD, xcd = wgid % NXCD, off = wgid / NXCD; wgid = (xcd < r ? xcd * (q + 1) : r * (q + 1) + (xcd - r) * q) + off; }
        const int nig = WGM * nN, gid = wgid / nig, fm = gid * WGM, gsz = (nM - fm) < WGM ? (nM - fm) : WGM;
        u.pm = fm + ((wgid % nig) % gsz); u.pn = (wgid % nig) / gsz; return true;
    }
    __device__ __forceinline__ void a_ready(const Unit&) const {}
    __device__ __forceinline__ void done(const Unit&) const {}
};

__device__ __forceinline__ unsigned cvt_pk_bf16(float lo, float hi) { unsigned r; asm volatile("v_cvt_pk_bf16_f32 %0, %1, %2" : "=v"(r) : "v"(lo), "v"(hi)); return r; }
__device__ __forceinline__ float row_rs(const float* ssq, int row) {
    const f32x4* p = (const f32x4*)(ssq + (size_t)row * 16);
    const f32x4 a = p[0], b = p[1], c = p[2], d = p[3];
    const float s = (((a[0] + a[1]) + (a[2] + a[3])) + ((b[0] + b[1]) + (b[2] + b[3]))) + (((c[0] + c[1]) + (c[2] + c[3])) + ((d[0] + d[1]) + (d[2] + d[3])));
    return __builtin_amdgcn_rsqf(s * (1.0f / 1024.0f) + 1e-6f);
}
__device__ __forceinline__ float sigm(float v) { return __builtin_amdgcn_rcpf(1.0f + __expf(-v)); }

struct EpiSwiGLU {
    static constexpr bool PERM = true, AFTER_DRAIN = false;
    bf16_t* H; const float* ssq;
    __device__ __forceinline__ void operator()(const f32x4 (&acc)[2][2][4][2], const Unit& u, int wr, int wc, int fr, int fq) const {
        const int row0 = u.pm * BM + wr * 64 + fr, col0 = u.pn * 128 + wc * 32 + 8 * fq;
#pragma unroll
        for (int ai = 0; ai < 2; ++ai)
#pragma unroll
            for (int m = 0; m < 4; ++m) {
                const int row = row0 + ai * HALF + m * 16; const float rs = row_rs(ssq, row);
                u32x4 w;
#pragma unroll
                for (int n = 0; n < 2; ++n) {
                    const f32x4 a = acc[ai][0][m][n] * rs, b = acc[ai][1][m][n] * rs; f32x4 h;
#pragma unroll
                    for (int e = 0; e < 4; ++e) h[e] = a[e] * sigm(a[e]) * b[e];
                    w[2 * n] = cvt_pk_bf16(h[0], h[1]); w[2 * n + 1] = cvt_pk_bf16(h[2], h[3]);
                }
                *(u32x4*)(H + (size_t)row * 2816 + col0) = w;
                asm volatile("" ::: "memory");
            }
    }
};
__device__ __forceinline__ void unpack8(const u32x4 w, f32x4& lo, f32x4& hi) {
    lo[0] = __uint_as_float(w.x << 16); lo[1] = __uint_as_float(w.x & 0xffff0000u); lo[2] = __uint_as_float(w.y << 16); lo[3] = __uint_as_float(w.y & 0xffff0000u);
    hi[0] = __uint_as_float(w.z << 16); hi[1] = __uint_as_float(w.z & 0xffff0000u); hi[2] = __uint_as_float(w.w << 16); hi[3] = __uint_as_float(w.w & 0xffff0000u);
}
struct EpiRes {
    static constexpr bool PERM = true, AFTER_DRAIN = false;
    bf16_t* XB; float* ssq; float alpha;
    __device__ __forceinline__ void operator()(const f32x4 (&acc)[2][2][4][2], const Unit& u, int wr, int wc, int fr, int fq) const {
        const int row0 = u.pm * BM + wr * 64 + fr, col0 = u.pn * BM + wc * 32 + 8 * fq;
#pragma unroll
        for (int ai = 0; ai < 2; ++ai)
#pragma unroll
            for (int m = 0; m < 4; ++m) {
                const int row = row0 + ai * HALF + m * 16; float ss = 0.f;
#pragma unroll
                for (int bj = 0; bj < 2; ++bj) {
                    bf16_t* xp = XB + (size_t)row * 1024 + col0 + bj * HALF;
                    f32x4 x0, x1; unpack8(*(const u32x4*)xp, x0, x1);
                    x0 = x0 + acc[ai][bj][m][0] * alpha; x1 = x1 + acc[ai][bj][m][1] * alpha;
                    u32x4 w; w.x = cvt_pk_bf16(x0[0], x0[1]); w.y = cvt_pk_bf16(x0[2], x0[3]); w.z = cvt_pk_bf16(x1[0], x1[1]); w.w = cvt_pk_bf16(x1[2], x1[3]);
                    *(u32x4*)xp = w;
                    ss += ((x0[0] * x0[0] + x0[1] * x0[1]) + (x0[2] * x0[2] + x0[3] * x0[3])) + ((x1[0] * x1[0] + x1[1] * x1[1]) + (x1[2] * x1[2] + x1[3] * x1[3]));
                }
                ss += __shfl_xor(ss, 16); ss += __shfl_xor(ss, 32);
                if (fq == 0) ssq[(size_t)row * 16 + u.pn * 4 + wc] = ss;
                asm volatile("" ::: "memory");
            }
    }
};
struct EpiProj {
    static constexpr bool PERM = true, AFTER_DRAIN = false;
    bf16_t* PA; bf16_t* PG; const float* ssq;
    __device__ __forceinline__ void operator()(const f32x4 (&acc)[2][2][4][2], const Unit& u, int wr, int wc, int fr, int fq) const {
        const int row0 = u.pm * BM + wr * 64 + fr;
        bf16_t* base; int ld, colt;
        if (u.pn < 22) { base = PA; ld = 5632; colt = u.pn * BM; } else { base = PG; ld = 3072; colt = (u.pn - 22) * BM; }
        const int col0 = colt + wc * 32 + 8 * fq;
#pragma unroll
        for (int ai = 0; ai < 2; ++ai)
#pragma unroll
            for (int m = 0; m < 4; ++m) {
                const int row = row0 + ai * HALF + m * 16; const float rs = row_rs(ssq, row);
#pragma unroll
                for (int bj = 0; bj < 2; ++bj) {
                    const f32x4 v0 = acc[ai][bj][m][0] * rs, v1 = acc[ai][bj][m][1] * rs;
                    u32x4 w; w.x = cvt_pk_bf16(v0[0], v0[1]); w.y = cvt_pk_bf16(v0[2], v0[3]); w.z = cvt_pk_bf16(v1[0], v1[1]); w.w = cvt_pk_bf16(v1[2], v1[3]);
                    *(u32x4*)(base + (size_t)row * ld + col0 + bj * HALF) = w;
                }
                asm volatile("" ::: "memory");
            }
    }
};
template <int I> struct EpiMerge {
    static constexpr bool PERM = true, AFTER_DRAIN = false;
    const bf16_t* PG; bf16_t* MB;
    __device__ __forceinline__ void operator()(const f32x4 (&acc)[2][2][4][2], const Unit& u, int wr, int wc, int fr, int fq) const {
        const int row0 = u.pm * BM + wr * 64 + fr, col0 = u.pn * BM + wc * 32 + 8 * fq;
#pragma unroll
        for (int ai = 0; ai < 2; ++ai)
#pragma unroll
            for (int m = 0; m < 4; ++m) {
                const int row = row0 + ai * HALF + m * 16;
#pragma unroll
                for (int bj = 0; bj < 2; ++bj) {
                    const int col = col0 + bj * HALF;
                    f32x4 g0, g1; unpack8(*(const u32x4*)(PG + (size_t)row * 3072 + I * 1024 + col), g0, g1);
                    f32x4 t0, t1;
#pragma unroll
                    for (int e = 0; e < 4; ++e) { t0[e] = sigm(g0[e]) * acc[ai][bj][m][0][e]; t1[e] = sigm(g1[e]) * acc[ai][bj][m][1][e]; }
                    bf16_t* mp = MB + (size_t)row * 1024 + col;
                    if (I > 0) { f32x4 p0, p1; unpack8(*(const u32x4*)mp, p0, p1); t0 = t0 + p0; t1 = t1 + p1; }
                    u32x4 w; w.x = cvt_pk_bf16(t0[0], t0[1]); w.y = cvt_pk_bf16(t0[2], t0[3]); w.z = cvt_pk_bf16(t1[0], t1[1]); w.w = cvt_pk_bf16(t1[2], t1[3]);
                    *(u32x4*)mp = w;
                }
                asm volatile("" ::: "memory");
            }
    }
};
template <class Epi, class Sched, bool ALIGN_EPI = false, bool SP2 = false>
__device__ __forceinline__ void gemm_phase(PG8_LAS unsigned char* lds, const Gemm g, const Sched& S, const Epi& E) {
    int tid = threadIdx.x; asm volatile("" : "+v"(tid));
    const int wid = __builtin_amdgcn_readfirstlane(tid >> 6), lane = tid & 63, wr = wid >> 2, wc = wid & 3, fr = lane & 15, fq = lane >> 4;
    const int K = g.K, nt = K / BK;
    unsigned voffA[2], voffB[2];
#pragma unroll
    for (int i = 0; i < 2; ++i) { int R, C; stage_rc(tid * 16 + i * 8192, R, C); const int Rb = Epi::PERM ? ((R & ~31) + perm32(R & 31)) : R;
        voffA[i] = (unsigned)(R * K + C) * 2u; voffB[i] = (unsigned)(Rb * K + C) * 2u; }
    const size_t kstep = (size_t)(BK * 2);
    const size_t hstep = (size_t)HALF * K * 2;
    const size_t tstep = 2 * hstep;
    const unsigned ldsw = (unsigned)wid * 1024u;
    const int aoff = lds_byte(wr * 64 + fr, fq * 8), boff = lds_byte(wc * 32 + fr, fq * 8);
#define PG8_SA(b, h) (((b) * 2 + (h)) * HTB)
#define PG8_SB(b, h) ((4 + (b) * 2 + (h)) * HTB)
#define PG8_STAGE(bufoff, gbase, voff) do { _Pragma("unroll") for (int _i = 0; _i < 2; ++_i) \
        __builtin_amdgcn_global_load_lds((const unsigned*)((const char*)(gbase) + (voff)[_i]), (PG8_LAS unsigned*)(lds + (bufoff) + ldsw + _i * 8192), 16, 0, 0); } while (0)
#define PG8_LDA(dst, b, h) do { _Pragma("unroll") for (int m = 0; m < 4; ++m) _Pragma("unroll") for (int k = 0; k < 2; ++k) dst[m][k] = *(const PG8_LAS bf16x8*)(lds + PG8_SA(b, h) + aoff + m * 2048 + k * 1024); } while (0)
#define PG8_LDB(dst, b, h) do { _Pragma("unroll") for (int n = 0; n < 2; ++n) _Pragma("unroll") for (int k = 0; k < 2; ++k) dst[n][k] = *(const PG8_LAS bf16x8*)(lds + PG8_SB(b, h) + boff + n * 2048 + k * 1024); } while (0)
#define PG8_MMA(ai, bj, At, Bt) do { __builtin_amdgcn_s_setprio(1); _Pragma("unroll") for (int m = 0; m < 4; ++m) _Pragma("unroll") for (int n = 0; n < 2; ++n) _Pragma("unroll") for (int k = 0; k < 2; ++k) \
        acc[ai][bj][m][n] = __builtin_amdgcn_mfma_f32_16x16x32_bf16(Bt[n][k], At[m][k], acc[ai][bj][m][n], 0, 0, 0); __builtin_amdgcn_s_setprio(0); } while (0)
#define PG8_WAIT_V(n) asm volatile("s_waitcnt vmcnt(" #n ")" ::: "memory")
#define PG8_WAIT_L(n) asm volatile("s_waitcnt lgkmcnt(" #n ")" ::: "memory")
#define PG8_BAR __builtin_amdgcn_s_barrier()
#define PG8_SCHED __builtin_amdgcn_sched_barrier(0)
    Unit cur, nxt; int ui = 0;
    if (!S.next(0, cur)) return;
    f32x4 acc[2][2][4][2];
#pragma unroll
    for (int a = 0; a < 2; ++a)
#pragma unroll
        for (int b = 0; b < 2; ++b)
#pragma unroll
            for (int m = 0; m < 4; ++m)
#pragma unroll
                for (int n = 0; n < 2; ++n) acc[a][b][m][n] = (f32x4){0.f, 0.f, 0.f, 0.f};
    bf16x8 At[4][2], B0[2][2], B1[2][2];
    const char* cA = (const char*)g.A + (size_t)cur.pm * tstep; const char* cB = (const char*)g.Bt + (size_t)cur.pn * tstep;
    S.a_ready(cur);
    if constexpr (SP2) {
        PG8_STAGE(PG8_SB(0, 0), cB, voffB); PG8_STAGE(PG8_SB(0, 1), cB + hstep, voffB); PG8_STAGE(PG8_SA(0, 0), cA, voffA); PG8_STAGE(PG8_SA(0, 1), cA + hstep, voffA);
        if (wr == 1) PG8_BAR;
        PG8_WAIT_V(2); PG8_BAR;
        PG8_STAGE(PG8_SB(1, 0), cB + kstep, voffB); PG8_STAGE(PG8_SA(1, 0), cA + kstep, voffA); PG8_STAGE(PG8_SB(1, 1), cB + hstep + kstep, voffB);
        PG8_WAIT_V(6); PG8_BAR;
    } else {
        PG8_STAGE(PG8_SB(0, 0), cB, voffB); PG8_STAGE(PG8_SA(0, 0), cA, voffA); PG8_STAGE(PG8_SB(0, 1), cB + hstep, voffB); PG8_STAGE(PG8_SA(0, 1), cA + hstep, voffA);
        if (wr == 1) PG8_BAR;
        PG8_WAIT_V(4); PG8_BAR;
        PG8_STAGE(PG8_SB(1, 0), cB + kstep, voffB); PG8_STAGE(PG8_SA(1, 0), cA + kstep, voffA); PG8_STAGE(PG8_SB(1, 1), cB + hstep + kstep, voffB);
        PG8_WAIT_V(6); PG8_BAR;
    }
    for (;;) {
        const bool has_next = S.next(ui + 1, nxt);
        const char* nA = has_next ? (const char*)g.A + (size_t)nxt.pm * tstep : cA; const char* nB = has_next ? (const char*)g.Bt + (size_t)nxt.pn * tstep : cB;
        for (int t = 0; t < nt; t += 2) {
            const bool last = (t == nt - 2);
            const char* a1 = cA + (size_t)(t + 1) * kstep;
            const char* a2 = last ? nA : cA + (size_t)(t + 2) * kstep; const char* b2 = last ? nB : cB + (size_t)(t + 2) * kstep;
            const char* a3 = a2 + kstep; const char* b3 = b2 + kstep;
            if (last && has_next) S.a_ready(nxt);
            if constexpr (SP2) {
            PG8_LDB(B0, 0, 0); PG8_LDB(B1, 0, 1); PG8_SCHED; PG8_LDA(At, 0, 0); PG8_STAGE(PG8_SA(1, 1), a1 + hstep, voffA);
            PG8_WAIT_V(8); PG8_WAIT_L(0); PG8_BAR; PG8_MMA(0, 0, At, B0); PG8_MMA(0, 1, At, B1); PG8_BAR; PG8_SCHED;
            PG8_LDA(At, 0, 1); PG8_STAGE(PG8_SB(0, 0), b2, voffB); PG8_STAGE(PG8_SB(0, 1), b2 + hstep, voffB); PG8_STAGE(PG8_SA(0, 0), a2, voffA);
            PG8_WAIT_V(8); PG8_WAIT_L(0); PG8_BAR; PG8_MMA(1, 0, At, B0); PG8_MMA(1, 1, At, B1); PG8_BAR; PG8_SCHED;
            PG8_LDB(B0, 1, 0); PG8_LDB(B1, 1, 1); PG8_SCHED; PG8_LDA(At, 1, 0); PG8_STAGE(PG8_SA(0, 1), a2 + hstep, voffA);
            PG8_WAIT_V(8); PG8_WAIT_L(0); PG8_BAR; PG8_MMA(0, 0, At, B0); PG8_MMA(0, 1, At, B1); PG8_BAR; PG8_SCHED;
            PG8_LDA(At, 1, 1); PG8_STAGE(PG8_SB(1, 0), b3, voffB); PG8_STAGE(PG8_SB(1, 1), b3 + hstep, voffB); PG8_STAGE(PG8_SA(1, 0), a3, voffA);
            PG8_WAIT_V(8); PG8_WAIT_L(0); PG8_BAR; PG8_MMA(1, 0, At, B0); PG8_MMA(1, 1, At, B1); PG8_BAR; PG8_SCHED;
            } else {
            PG8_LDB(B0, 0, 0); PG8_SCHED; PG8_LDA(At, 0, 0); PG8_STAGE(PG8_SA(1, 1), a1 + hstep, voffA);
            PG8_WAIT_L(8); PG8_BAR; PG8_WAIT_L(0); PG8_MMA(0, 0, At, B0); PG8_BAR; PG8_SCHED;
            PG8_LDB(B1, 0, 1); PG8_STAGE(PG8_SB(0, 0), b2, voffB);
            PG8_BAR; PG8_WAIT_L(0); PG8_MMA(0, 1, At, B1); PG8_BAR;
            PG8_LDA(At, 0, 1); PG8_STAGE(PG8_SA(0, 0), a2, voffA);
            PG8_BAR; PG8_WAIT_L(0); PG8_MMA(1, 0, At, B0); PG8_BAR; PG8_SCHED;
            PG8_STAGE(PG8_SB(0, 1), b2 + hstep, voffB);
            PG8_WAIT_V(6); PG8_BAR; PG8_MMA(1, 1, At, B1); PG8_BAR;
            PG8_LDB(B0, 1, 0); PG8_SCHED; PG8_LDA(At, 1, 0); PG8_STAGE(PG8_SA(0, 1), a2 + hstep, voffA);
            PG8_WAIT_L(8); PG8_BAR; PG8_WAIT_L(0); PG8_MMA(0, 0, At, B0); PG8_BAR; PG8_SCHED;
            PG8_LDB(B1, 1, 1); PG8_STAGE(PG8_SB(1, 0), b3, voffB);
            PG8_BAR; PG8_WAIT_L(0); PG8_MMA(0, 1, At, B1); PG8_BAR;
            PG8_LDA(At, 1, 1); PG8_STAGE(PG8_SA(1, 0), a3, voffA);
            PG8_BAR; PG8_WAIT_L(0); PG8_MMA(1, 0, At, B0); PG8_BAR; PG8_SCHED;
            PG8_STAGE(PG8_SB(1, 1), b3 + hstep, voffB);
            PG8_WAIT_V(6); PG8_BAR; PG8_MMA(1, 1, At, B1); PG8_BAR;
            }
        }
        if constexpr (ALIGN_EPI) { if (wr == 0) PG8_BAR; }
        if constexpr (!Epi::AFTER_DRAIN) { E(acc, cur, wr, wc, fr, fq); S.done(cur); }
        if (!has_next) break;
#pragma unroll
        for (int a = 0; a < 2; ++a)
#pragma unroll
            for (int b = 0; b < 2; ++b)
#pragma unroll
                for (int m = 0; m < 4; ++m)
#pragma unroll
                    for (int n = 0; n < 2; ++n) acc[a][b][m][n] = (f32x4){0.f, 0.f, 0.f, 0.f};
        cur = nxt; cA = nA; cB = nB; ++ui;
        if constexpr (ALIGN_EPI) { if (wr == 1) PG8_BAR; }
    }
    PG8_WAIT_V(0);
    if constexpr (!ALIGN_EPI) { if (wr == 0) PG8_BAR; }
    PG8_BAR;
    if constexpr (Epi::AFTER_DRAIN) { E.fused(acc, cur, wr, wc, fr, fq, lds, wid, lane); S.done(cur); }
#undef PG8_SA
#undef PG8_SB
#undef PG8_STAGE
#undef PG8_LDA
#undef PG8_LDB
#undef PG8_MMA
#undef PG8_WAIT_V
#undef PG8_WAIT_L
#undef PG8_BAR
#undef PG8_SCHED
}
}
#define LAS __attribute__((address_space(3)))
typedef unsigned short bf16;
typedef unsigned v4u __attribute__((ext_vector_type(4)));
typedef unsigned v2u __attribute__((ext_vector_type(2)));
typedef short v4i16_t __attribute__((ext_vector_type(4)));
using pg8::f32x4; using pg8::bf16x8; using pg8::cvt_pk_bf16;

constexpr int D = 1024, FF = 2816, NLAYER = 4, TG = 16384, NGROUP = 4, NTHR = 512, NWAVES = 8;
constexpr int PA_LD = 5632, PG_LD = 3072;
constexpr int C_HQ = 0, C_HI = 512, C_HZF = 1024, C_HZB = 1536, C_HG = 2048, C_CA = 2560, C_CB = 3072, C_CC = 3584, C_NQ = 4096, C_NK = 4608, C_NV = 5120;
constexpr size_t MiB = 1u << 20;
constexpr size_t WS_CTL = 0, CTL_BYTES = 1 * MiB, WS_W = 1 * MiB, WS_XB = 221 * MiB, WS_SSQ = 253 * MiB, WS_PA = 254 * MiB, WS_PG = 430 * MiB, WS_O3 = 526 * MiB, WS_OD = 574 * MiB, WS_END = 638 * MiB;
constexpr size_t OFF_GU1 = 0, OFF_D1 = 5767168, OFF_IN = 8650752, OFF_HG = 17563648, OFF_CV = 18087936, OFF_NA = 18612224, OFF_OUT = 19136512, OFF_GU2 = 20185088, OFF_D2 = 25952256, LAYER_EL = 28835840;
constexpr int LDS_BYTES = 147456, LDS_MISC = 147456 - 64;
constexpr int CW_BAR = 4096;

__device__ __forceinline__ unsigned f2bf(float f) { unsigned u = __float_as_uint(f); return (u + 0x7fffu + ((u >> 16) & 1u)) >> 16; }
__device__ __forceinline__ float bf2f(unsigned b) { return __uint_as_float(b << 16); }
__device__ __forceinline__ float bflo(unsigned w) { return __uint_as_float(w << 16); }
__device__ __forceinline__ float bfhi(unsigned w) { return __uint_as_float(w & 0xffff0000u); }
__device__ __forceinline__ float sigm(float v) { return __builtin_amdgcn_rcpf(1.0f + __expf(-v)); }
__device__ __forceinline__ float wave_sum(float v) {
#pragma unroll
    for (int o = 1; o < 64; o <<= 1) v += __shfl_xor(v, o);
    return v;
}

__device__ __forceinline__ void cvt_item(const float* W, int K, int N, bf16* WT, const float* gain, bool permgu, LAS float* scr, int item, int lane) {
    const int nblk = N / 32, kb = item / nblk, nb = item % nblk, k0 = 64 * kb, n0 = 32 * nb;
#pragma unroll 8
    for (int i = 0; i < 32; ++i) { const int kk = 2 * i + (lane >> 5); const float g = gain ? gain[k0 + kk] : 1.0f; scr[kk * 33 + (lane & 31)] = W[(size_t)(k0 + kk) * N + n0 + (lane & 31)] * g; }
    asm volatile("s_waitcnt lgkmcnt(0)" ::: "memory");
    int dn0 = n0;
    if (permgu) { const int half = n0 >= FF ? 1 : 0; const int j = n0 - half * FF; dn0 = (j >> 7) * 256 + half * 128 + (j & 127); }
    const int c = lane & 7;
#pragma unroll
    for (int j = 0; j < 4; ++j) { const int n = (lane >> 3) + 8 * j; const LAS float* s = scr + (8 * c) * 33 + n;
        v4u o; o.x = cvt_pk_bf16(s[0 * 33], s[1 * 33]); o.y = cvt_pk_bf16(s[2 * 33], s[3 * 33]); o.z = cvt_pk_bf16(s[4 * 33], s[5 * 33]); o.w = cvt_pk_bf16(s[6 * 33], s[7 * 33]);
        *(v4u*)(WT + (size_t)(dn0 + n) * K + k0 + 8 * c) = o; }
    asm volatile("s_waitcnt lgkmcnt(0)" ::: "memory");
}

template <int K> __device__ __forceinline__ f32x4 mma_lds(f32x4 acc, const LAS bf16* A, int pa, const LAS bf16* B, int pb, int lane) {
    const int r = lane & 15, q = lane >> 4;
#pragma unroll
    for (int ks = 0; ks < K / 32; ++ks) {
        const bf16x8 a = *(const LAS bf16x8*)(A + r * pa + ks * 32 + q * 8);
        const bf16x8 b = *(const LAS bf16x8*)(B + r * pb + ks * 32 + q * 8);
        acc = __builtin_amdgcn_mfma_f32_16x16x32_bf16(a, b, acc, 0, 0, 0);
    }
    return acc;
}

constexpr int H_QT = 0, H_KT = 17408, H_KTT = 34816, H_VT = 53248, H_ST = 57856, H_AM = 66560, H_SEG = 75776, H_ER = 77824, H_EE = 78336;
template <int NVT> __device__ __forceinline__ void hgrn2_item(LAS unsigned char* lds, const bf16* PA, float* OD, const float* lb_logits, int layer, int item, int T, int tid) {
    const int lane = tid & 63, wave = __builtin_amdgcn_readfirstlane(tid >> 6), c16 = lane & 15, quad = lane >> 4;
    constexpr int NVS = 8 / NVT, VW = 16 * NVT, VTHR = 128 * NVT, VSH = (NVT == 2) ? 2 : 1;
    const int vs = item % NVS, dir = (item / NVS) & 1, h = (item / (2 * NVS)) & 3, seq = item / (8 * NVS);
    const int base = seq * T;
    const int k = tid & 127, tq = tid >> 7;
    LAS bf16* QT = (LAS bf16*)(lds + H_QT); LAS bf16* KT = (LAS bf16*)(lds + H_KT); LAS bf16* KTT = (LAS bf16*)(lds + H_KTT);
    LAS bf16* VT = (LAS bf16*)(lds + H_VT); LAS bf16* STt = (LAS bf16*)(lds + H_ST); LAS bf16* AM = (LAS bf16*)(lds + H_AM);
    LAS float* SEG = (LAS float*)(lds + H_SEG); LAS float* ER = (LAS float*)(lds + H_ER); LAS float* EE = (LAS float*)(lds + H_EE);
    float lb;
    { float lg[4], mx = -3e38f;
#pragma unroll
      for (int l = 0; l < 4; ++l) { lg[l] = lb_logits[(dir * 4 + l) * 512 + h * 128 + k]; mx = fmaxf(mx, lg[l]); }
      float tot = 0.f, num = 0.f;
#pragma unroll
      for (int l = 0; l < 4; ++l) { const float e = __expf(lg[l] - mx); tot += e; if (l >= 1 && l <= layer) num += e; }
      lb = num / tot; }
    const float oml = 1.0f - lb;
    const int nchunk = T / 64;
    const bf16* zsrc = PA + (dir ? C_HZB : C_HZF) + h * 128 + k;
    const bf16* qsrc = PA + C_HQ + h * 128 + k;
    const bf16* vsrc = PA + C_HI + h * 128 + vs * VW + (tid & (VW / 8 - 1)) * 8;
    float* odst = OD + (size_t)dir * TG * 512 + h * 128 + vs * VW;
    unsigned short zr[16], qr[16]; v4u vr = {0u, 0u, 0u, 0u};
#define HG_ROW(tau) (base + (dir ? (T - 1 - (tau)) : (tau)))
#define HG_LOAD(c) do { _Pragma("unroll") for (int i = 0; i < 16; ++i) { const size_t ro = (size_t)HG_ROW((c) * 64 + 16 * tq + i) * PA_LD; zr[i] = zsrc[ro]; qr[i] = qsrc[ro]; } \
        if (tid < VTHR) vr = *(const v4u*)(vsrc + (size_t)HG_ROW((c) * 64 + (tid >> VSH)) * PA_LD); } while (0)
    HG_LOAD(0);
    f32x4 accS[NVT];
#pragma unroll
    for (int e = 0; e < NVT; ++e) accS[e] = (f32x4){0.f, 0.f, 0.f, 0.f};
    for (int c = 0; c < nchunk; ++c) {
        float b[16], kv[16]; float cum = 0.f;
#pragma unroll
        for (int i = 0; i < 16; ++i) { const float zf = bf2f(zr[i]); const float sg = sigm(zf); const float f = lb + oml * sg; cum += __logf(fmaxf(f, 1e-30f)); b[i] = cum; kv[i] = oml * (1.0f - sg); }
        SEG[tq * 128 + k] = cum;
        __syncthreads();
        const float s0 = SEG[k], s1 = SEG[128 + k], s2 = SEG[256 + k], s3 = SEG[384 + k];
        const float pre = tq == 0 ? 0.f : (tq == 1 ? s0 : (tq == 2 ? s0 + s1 : (s0 + s1) + s2));
        const float r = s0 + s1, bend = (s0 + s1) + (s2 + s3);
        unsigned kpk[8];
#pragma unroll
        for (int i = 0; i < 16; ++i) {
            const float bt = pre + b[i];
            const float eq = __expf(fminf(bt - r, 80.f)), ek = __expf(fminf(r - bt, 80.f));
            const unsigned qb = f2bf(bf2f(qr[i]) * eq), kb = f2bf(kv[i] * ek);
            const int tau = 16 * tq + i;
            QT[tau * 136 + k] = (bf16)qb; KT[tau * 136 + k] = (bf16)kb;
            if (i & 1) kpk[i >> 1] |= kb << 16; else kpk[i >> 1] = kb;
        }
        *(LAS v4u*)(KTT + k * 72 + 16 * tq) = (v4u){kpk[0], kpk[1], kpk[2], kpk[3]};
        *(LAS v4u*)(KTT + k * 72 + 16 * tq + 8) = (v4u){kpk[4], kpk[5], kpk[6], kpk[7]};
        if (tq == 0) { ER[k] = __expf(r); EE[k] = __expf(bend - r); }
        if (tid < VTHR) { const int s = tid >> VSH, vq = tid & (VW / 8 - 1);
            VT[(vq * 8 + 0) * 72 + s] = (bf16)(vr.x & 0xffffu); VT[(vq * 8 + 1) * 72 + s] = (bf16)(vr.x >> 16);
            VT[(vq * 8 + 2) * 72 + s] = (bf16)(vr.y & 0xffffu); VT[(vq * 8 + 3) * 72 + s] = (bf16)(vr.y >> 16);
            VT[(vq * 8 + 4) * 72 + s] = (bf16)(vr.z & 0xffffu); VT[(vq * 8 + 5) * 72 + s] = (bf16)(vr.z >> 16);
            VT[(vq * 8 + 6) * 72 + s] = (bf16)(vr.w & 0xffffu); VT[(vq * 8 + 7) * 72 + s] = (bf16)(vr.w >> 16); }
        __syncthreads();
        if (c + 1 < nchunk) HG_LOAD(c + 1);
#pragma unroll
        for (int e = 0; e < 2; ++e) { const int id = wave * 2 + e, tt = id >> 2, st = id & 3;
            f32x4 a = (f32x4){0.f, 0.f, 0.f, 0.f};
            if (st <= tt) a = mma_lds<128>(a, QT + tt * 16 * 136, 136, KT + st * 16 * 136, 136, lane);
#pragma unroll
            for (int i = 0; i < 4; ++i) { const int t = tt * 16 + quad * 4 + i, s = st * 16 + c16; const float val = (st <= tt && s <= t) ? a[i] : 0.f; AM[t * 72 + s] = (bf16)f2bf(val); } }
        { const f32x4 erv = *(const LAS f32x4*)(ER + wave * 16 + quad * 4);
#pragma unroll
          for (int e = 0; e < NVT; ++e) { const f32x4 sp = accS[e] * erv; v2u w; w.x = cvt_pk_bf16(sp[0], sp[1]); w.y = cvt_pk_bf16(sp[2], sp[3]);
              *(LAS v2u*)(STt + (e * 16 + c16) * 136 + wave * 16 + quad * 4) = w; } }
        __syncthreads();
        if ((wave >> 2) < NVT) { const int tt = wave & 3, vt = wave >> 2; f32x4 o = (f32x4){0.f, 0.f, 0.f, 0.f};
          o = mma_lds<128>(o, QT + tt * 16 * 136, 136, STt + vt * 16 * 136, 136, lane);
          o = mma_lds<64>(o, AM + tt * 16 * 72, 72, VT + vt * 16 * 72, 72, lane);
#pragma unroll
          for (int i = 0; i < 4; ++i) { const int tau = c * 64 + tt * 16 + quad * 4 + i; odst[(size_t)HG_ROW(tau) * 512 + vt * 16 + c16] = o[i]; } }
        { const f32x4 erv = *(const LAS f32x4*)(ER + wave * 16 + quad * 4); const f32x4 eev = *(const LAS f32x4*)(EE + wave * 16 + quad * 4);
#pragma unroll
          for (int e = 0; e < NVT; ++e) { f32x4 sp = accS[e] * erv; sp = mma_lds<64>(sp, KTT + wave * 16 * 72, 72, VT + e * 16 * 72, 72, lane); accS[e] = sp * eev; } }
    }
    __syncthreads();
#undef HG_ROW
#undef HG_LOAD
}

__device__ __forceinline__ void na_item(LAS unsigned char* lds, const bf16* PA, const float* rpb, bf16* ONA, int item, int T, int tid) {
    const int lane = tid & 63, h = __builtin_amdgcn_readfirstlane(tid >> 6), c16 = lane & 15, quad = lane >> 4;
    const int ips = T / 16, seq = item / ips, rem = item % ips, r = rem >> 2, j = rem & 3;
    const int rows = T / 64, rs = min(max(r - 4, 0), rows - 8), kstart = (j == 0) ? 0 : (j == 1) ? 8 : (j == 2) ? 24 : 32;
    const int base = seq * T, qtok = base + r * 64 + 16 * j + c16;
    const bf16* qp = PA + (size_t)qtok * PA_LD + C_NQ + h * 64 + quad * 8;
    const bf16x8 Qb0 = *(const bf16x8*)qp, Qb1 = *(const bf16x8*)(qp + 32);
    const int qcol = 16 * j + c16, cs = min(max(qcol - 8, 0), 48);
    v4u vbuf[8];
#define NA_VLOAD(qd) do { _Pragma("unroll") for (int it = 0; it < 8; ++it) { const int idx = it * 64 + lane, key = idx >> 3, dg = idx & 7; \
        const int tok = base + (rs + 2 * (qd) + (key >> 5)) * 64 + kstart + (key & 31); vbuf[it] = *(const v4u*)(PA + (size_t)tok * PA_LD + C_NV + h * 64 + dg * 8); } } while (0)
    NA_VLOAD(0);
    const float* rp = rpb + h * 465;
    f32x4 sacc[16]; float mx = -3e38f;
    int dcv[8]; bool okv[8];
#pragma unroll
    for (int e = 0; e < 8; ++e) { const int kcol = kstart + (e >> 2) * 16 + quad * 4 + (e & 3); okv[e] = (kcol >= cs) && (kcol < cs + 16); dcv[e] = min(max(kcol - qcol + 15, 0), 30); }
#pragma unroll
    for (int a = 0; a < 8; ++a) {
        const float* rpa = rp + (rs + a - r + 7) * 31;
#pragma unroll
        for (int hh = 0; hh < 2; ++hh) {
            const int ktok = base + (rs + a) * 64 + kstart + hh * 16 + c16;
            const bf16* kp = PA + (size_t)ktok * PA_LD + C_NK + h * 64 + quad * 8;
            const bf16x8 Ka0 = *(const bf16x8*)kp, Ka1 = *(const bf16x8*)(kp + 32);
            f32x4 s = (f32x4){0.f, 0.f, 0.f, 0.f};
            s = __builtin_amdgcn_mfma_f32_16x16x32_bf16(Ka0, Qb0, s, 0, 0, 0);
            s = __builtin_amdgcn_mfma_f32_16x16x32_bf16(Ka1, Qb1, s, 0, 0, 0);
#pragma unroll
            for (int i = 0; i < 4; ++i) { const float val = okv[hh * 4 + i] ? s[i] * 0.125f + rpa[dcv[hh * 4 + i]] : -1e30f; s[i] = val; mx = fmaxf(mx, val); }
            sacc[a * 2 + hh] = s;
        }
    }
    mx = fmaxf(mx, __shfl_xor(mx, 16)); mx = fmaxf(mx, __shfl_xor(mx, 32));
    float sum = 0.f;
#pragma unroll
    for (int t = 0; t < 16; ++t)
#pragma unroll
        for (int i = 0; i < 4; ++i) { const float p = __expf(sacc[t][i] - mx); sacc[t][i] = p; sum += p; }
    sum += __shfl_xor(sum, 16); sum += __shfl_xor(sum, 32);
    bf16x8 pb[8];
#pragma unroll
    for (int a = 0; a < 8; ++a) { v4u w; w.x = cvt_pk_bf16(sacc[2 * a][0], sacc[2 * a][1]); w.y = cvt_pk_bf16(sacc[2 * a][2], sacc[2 * a][3]);
        w.z = cvt_pk_bf16(sacc[2 * a + 1][0], sacc[2 * a + 1][1]); w.w = cvt_pk_bf16(sacc[2 * a + 1][2], sacc[2 * a + 1][3]); pb[a] = __builtin_bit_cast(bf16x8, w); }
    LAS bf16* VS = (LAS bf16*)(lds + h * 10240);
    f32x4 oacc[4];
#pragma unroll
    for (int dt = 0; dt < 4; ++dt) oacc[dt] = (f32x4){0.f, 0.f, 0.f, 0.f};
    const int trq = (lane & 15) >> 2, trp = lane & 3;
    const LAS bf16* trbase = VS + (quad * 4 + trq) * 80 + 4 * trp;
#pragma unroll
    for (int qd = 0; qd < 4; ++qd) {
#pragma unroll
        for (int it = 0; it < 8; ++it) { const int idx = it * 64 + lane, key = idx >> 3, dg = idx & 7; *(LAS v4u*)(VS + key * 80 + dg * 8) = vbuf[it]; }
        if (qd < 3) { NA_VLOAD(qd + 1); }
#pragma unroll
        for (int al = 0; al < 2; ++al)
#pragma unroll
            for (int dt = 0; dt < 4; ++dt) { const LAS bf16* p = trbase + al * 32 * 80 + dt * 16;
                const v4i16_t lo = __builtin_amdgcn_ds_read_tr16_b64_v4i16((LAS v4i16_t*)p), hi = __builtin_amdgcn_ds_read_tr16_b64_v4i16((LAS v4i16_t*)(p + 16 * 80));
                const bf16x8 af = {lo[0], lo[1], lo[2], lo[3], hi[0], hi[1], hi[2], hi[3]};
                oacc[dt] = __builtin_amdgcn_mfma_f32_16x16x32_bf16(af, pb[qd * 2 + al], oacc[dt], 0, 0, 0); }
    }
#undef NA_VLOAD
    const float inv = __builtin_amdgcn_rcpf(sum);
#pragma unroll
    for (int dt = 0; dt < 4; ++dt) { const f32x4 o = oacc[dt] * inv; v2u w; w.x = cvt_pk_bf16(o[0], o[1]); w.y = cvt_pk_bf16(o[2], o[3]);
        *(v2u*)(ONA + (size_t)qtok * 512 + h * 64 + dt * 16 + quad * 4) = w; }
}

#define XB_TMO      128
#define XB_XCNT(j)  (256  + 64 * (j))
#define XB_XSUB(j)  (1280 + 64 * (j))
#define XB_XGEN(j)  (2304 + 64 * (j))
#define XB_TOP      3328
#define XB_TOPGEN   3392
#define XCD_BAR_WORDS 3456
#define XB_SPIN_CAP (1u << 18)

__device__ __forceinline__ unsigned xb_ld(unsigned* p)              { return __hip_atomic_load(p, __ATOMIC_RELAXED, __HIP_MEMORY_SCOPE_AGENT); }
__device__ __forceinline__ unsigned xb_add(unsigned* p, unsigned v) { return __hip_atomic_fetch_add(p, v, __ATOMIC_RELAXED, __HIP_MEMORY_SCOPE_AGENT); }
__device__ __forceinline__ unsigned xb_xcc_id() { return (unsigned)__builtin_amdgcn_s_getreg((3 << 11) | 20) & 0xFu; }
#define XB_SPIN(cond, bar) do { unsigned _sp = 0; while (cond) { __builtin_amdgcn_s_sleep(1); \
    if ((++_sp & 255u) == 0u) { if (xb_ld(&(bar)[XB_TMO])) break; if (_sp > XB_SPIN_CAP) { atomicAdd(&(bar)[XB_TMO], 1u); break; } } } } while (0)

struct XcdBarrier {
    unsigned* bar; unsigned x;
    volatile LAS unsigned* st;
};

__device__ __forceinline__ XcdBarrier xcd_barrier_post(unsigned* bar, volatile LAS unsigned* st) {
    XcdBarrier b; b.bar = bar; b.x = xb_xcc_id(); b.st = st;
    if (threadIdx.x == 0) (void)xb_add(&bar[XB_XCNT(b.x)], 1u);
    return b;
}
__device__ __forceinline__ void xcd_barrier_complete(unsigned* bar, unsigned x, unsigned& nloc, unsigned& nx) {
    const unsigned G = gridDim.x * gridDim.y * gridDim.z;
    unsigned sum, cnt, mine, sp = 0u;
    for (;;) {
        sum = 0u; cnt = 0u; mine = 0u;
#pragma unroll
        for (unsigned j = 0; j < 16; ++j) { const unsigned c = xb_ld(&bar[XB_XCNT(j)]); sum += c; cnt += (c > 0u) ? 1u : 0u; mine = (j == x) ? c : mine; }
        if (sum == G) break;
        __builtin_amdgcn_s_sleep(1);
        if ((++sp & 255u) == 0u) { if (xb_ld(&bar[XB_TMO])) break; if (sp > XB_SPIN_CAP) { atomicAdd(&bar[XB_TMO], 1u); break; } }
    }
    nloc = mine > 0u ? mine : 1u; nx = cnt > 0u ? cnt : 1u;
}

__device__ __forceinline__ void xcd_barrier(const XcdBarrier& b) {
    asm volatile("s_waitcnt vmcnt(0)" ::: "memory");
    __syncthreads();
    if (threadIdx.x == 0) {
        unsigned* bar = b.bar;
        __builtin_amdgcn_s_waitcnt(0);
        unsigned nloc = b.st[0], nx = b.st[1];
        if (nloc == 0u) { xcd_barrier_complete(bar, b.x, nloc, nx); b.st[0] = nloc; b.st[1] = nx; }
        const unsigned old = xb_add(&bar[XB_XSUB(b.x)], 1u);
        const unsigned gen = old / nloc;
        if (old + 1u == (gen + 1u) * nloc) {
            __builtin_amdgcn_fence(__ATOMIC_RELEASE, "agent");
            asm volatile("s_waitcnt vmcnt(0)" ::: "memory");
            const unsigned og = xb_add(&bar[XB_TOP], 1u);
            const unsigned tg = og / nx;
            if (og + 1u == (tg + 1u) * nx) xb_add(&bar[XB_TOPGEN], 1u);
            else XB_SPIN(xb_ld(&bar[XB_TOPGEN]) == tg, bar);
            __builtin_amdgcn_fence(__ATOMIC_ACQUIRE, "agent");
            xb_add(&bar[XB_XGEN(b.x)], 1u);
            asm volatile("s_waitcnt vmcnt(0)" ::: "memory");
        } else {
            XB_SPIN(xb_ld(&bar[XB_XGEN(b.x)]) == gen, bar);
            __builtin_amdgcn_fence(__ATOMIC_ACQUIRE, "agent");
            asm volatile("s_waitcnt vmcnt(0)" ::: "memory");
        }
    }
    __syncthreads();
}
struct Args { const float* in[20]; float* out; unsigned char* ws; int ph_lo, ph_hi; };
enum { K_CVT = 0, K_G0, K_UP, K_RES, K_M1, K_M2, K_M3, K_M4, K_GF };

__global__ void __launch_bounds__(NTHR, 2) mk_fwd(Args args) {
    extern __shared__ __attribute__((aligned(16))) unsigned char lds_raw[];
    LAS unsigned char* lds = (LAS unsigned char*)lds_raw;
    cg::grid_group grid = cg::this_grid();
    const int hi = args.ph_hi;
    { volatile LAS unsigned* st0 = (volatile LAS unsigned*)(lds + LDS_MISC + 32); if (threadIdx.x < 2) st0[threadIdx.x] = 0u; __syncthreads(); }
    XcdBarrier xbar = xcd_barrier_post((unsigned*)(args.ws + WS_CTL) + CW_BAR, (volatile LAS unsigned*)(lds + LDS_MISC + 32));
    for (int ph = args.ph_lo; ph < hi; ++ph) {
        int bid = blockIdx.x, G = gridDim.x; asm volatile("" : "+s"(bid), "+s"(G));
        int tid = threadIdx.x; asm volatile("" : "+v"(tid));
        const int lane = tid & 63, wave = __builtin_amdgcn_readfirstlane(tid >> 6);
        const int gw = bid * NWAVES + wave, NGW = G * NWAVES;
        int kind, g = 0, l = 0, s = 0;
        if (ph == 0) kind = K_CVT;
        else { const int q = ph - 1; g = q / 38; const int r = q % 38;
            if (r == 0) kind = K_G0; else if (r == 37) kind = K_GF;
            else { l = (r - 1) / 9; s = (r - 1) % 9; kind = (s == 0 || s == 7) ? K_UP : (s == 1 || s == 8 || s == 6) ? K_RES : (s == 2) ? K_M1 : (s == 3) ? K_M2 : (s == 4) ? K_M3 : K_M4; } }
        unsigned char* ws = args.ws;
        bf16* XB = (bf16*)(ws + WS_XB); float* SSQ = (float*)(ws + WS_SSQ);
        bf16* PA = (bf16*)(ws + WS_PA); bf16* PG = (bf16*)(ws + WS_PG);
        bf16* OHG = (bf16*)(ws + WS_O3); bf16* OCV = OHG + (size_t)TG * 512; bf16* ONA = OCV + (size_t)TG * 512;
        float* OD = (float*)(ws + WS_OD);
        const bf16* Wl = (const bf16*)(ws + WS_W) + (size_t)l * LAYER_EL;
        const int T = g < 2 ? 2048 : 4096;
        float* X = args.out + (size_t)g * TG * D;

        if (kind == K_CVT) {
            LAS float* scr = (LAS float*)(lds + wave * 16384);
            constexpr int I_GU = 16 * 176, I_DN = 44 * 32, I_IN = 16 * 272, I_MX = 8 * 32, I_OUT = 16 * 32;
            constexpr int I_LAYER = 2 * I_GU + 2 * I_DN + I_IN + 3 * I_MX + I_OUT;
            for (int it = gw; it < NLAYER * I_LAYER; it += NGW) {
                const int ll = it / I_LAYER; int r = it % I_LAYER; bf16* Wd = (bf16*)(ws + WS_W) + (size_t)ll * LAYER_EL;
                const float* src; const float* gain = nullptr; int K, N; size_t off; bool perm = false;
                if (r < I_GU) { src = args.in[3] + (size_t)ll * D * 2 * FF; K = D; N = 2 * FF; off = OFF_GU1; gain = args.in[2] + ll * D; perm = true; }
                else if ((r -= I_GU) < I_DN) { src = args.in[4] + (size_t)ll * FF * D; K = FF; N = D; off = OFF_D1; }
                else if ((r -= I_DN) < I_IN) { src = args.in[6] + (size_t)ll * D * 8704; K = D; N = 8704; off = OFF_IN; gain = args.in[5] + ll * D; }
                else if ((r -= I_IN) < I_MX) { src = args.in[9] + (size_t)ll * 512 * D; K = 512; N = D; off = OFF_HG; }
                else if ((r -= I_MX) < I_MX) { src = args.in[12] + (size_t)ll * 512 * D; K = 512; N = D; off = OFF_CV; }
                else if ((r -= I_MX) < I_MX) { src = args.in[14] + (size_t)ll * 512 * D; K = 512; N = D; off = OFF_NA; }
                else if ((r -= I_MX) < I_OUT) { src = args.in[15] + (size_t)ll * D * D; K = D; N = D; off = OFF_OUT; }
                else if ((r -= I_OUT) < I_GU) { src = args.in[17] + (size_t)ll * D * 2 * FF; K = D; N = 2 * FF; off = OFF_GU2; gain = args.in[16] + ll * D; perm = true; }
                else { r -= I_GU; src = args.in[18] + (size_t)ll * FF * D; K = FF; N = D; off = OFF_D2; }
                cvt_item(src, K, N, Wd + off, gain, perm, scr, r, lane);
            }
        } else if (kind == K_G0) {
            const float* xin = (g < 2 ? args.in[0] : args.in[1]) + (size_t)(g & 1) * TG * D;
            for (int row = gw; row < TG; row += NGW) {
                const f32x4* xr = (const f32x4*)(xin + (size_t)row * D) + lane; v2u* bo = (v2u*)(XB + (size_t)row * D) + lane;
                float ss = 0.f;
#pragma unroll
                for (int j = 0; j < 4; ++j) { const f32x4 v = xr[64 * j]; v2u w; w.x = cvt_pk_bf16(v[0], v[1]); w.y = cvt_pk_bf16(v[2], v[3]); bo[64 * j] = w; ss += (v[0] * v[0] + v[1] * v[1]) + (v[2] * v[2] + v[3] * v[3]); }
                ss = wave_sum(ss);
                if (lane < 16) SSQ[(size_t)row * 16 + lane] = lane == 0 ? ss : 0.f;
            }
        } else if (kind == K_UP) {
            pg8::Gemm gm{XB, Wl + (s == 7 ? OFF_GU2 : OFF_GU1), TG, 2 * FF, D}; pg8::StaticOrder S; S.init(TG, 2 * FF, G, bid);
            pg8::EpiSwiGLU E{PA, SSQ};
#ifndef NO_UP
            for (int rep = 0; rep < REP_GEMM; ++rep) pg8::gemm_phase<pg8::EpiSwiGLU, pg8::StaticOrder, true, true>(lds, gm, S, E);
#endif
        } else if (kind == K_RES) {
            const int K = (s == 6) ? D : FF; const size_t off = (s == 6) ? OFF_OUT : (s == 1 ? OFF_D1 : OFF_D2);
            pg8::Gemm gm{PA, Wl + off, TG, D, K}; pg8::StaticOrder S; S.init(TG, D, G, bid);
            pg8::EpiRes E{XB, SSQ, (s == 6) ? 1.0f : 0.5f};
#ifndef NO_RES
            pg8::gemm_phase<pg8::EpiRes, pg8::StaticOrder, true, true>(lds, gm, S, E);
#endif
        } else if (kind == K_M1) {
            pg8::Gemm gm{XB, Wl + OFF_IN, TG, 8704, D}; pg8::StaticOrder S; S.init(TG, 8704, G, bid);
            pg8::EpiProj E{PA, PG, SSQ};
#ifndef NO_PROJ
            for (int rep = 0; rep < REP_GEMM; ++rep) pg8::gemm_phase<pg8::EpiProj, pg8::StaticOrder, true, true>(lds, gm, S, E);
#endif
        } else if (kind == K_M2) {
#ifndef NO_HG
            for (int rep = 0; rep < REP_HG; ++rep) {
                if (g < 2) { for (int it = bid; it < 256; it += G) hgrn2_item<2>(lds, PA, OD, args.in[7], l, it, T, tid); }
                else       { for (int it = bid; it < 256; it += G) hgrn2_item<1>(lds, PA, OD, args.in[7], l, it, T, tid); }
            }
#endif
            const float* rpb = args.in[13] + (size_t)l * 8 * 465;
            const int vcu = (G % 8 == 0) ? (bid % 8) * (G / 8) + bid / 8 : bid;
            const int nNA = TG / 16, ipb = (nNA + G - 1) / G;
            for (int rep = 0; rep < REP_NA; ++rep)
                for (int q = 0; q < ipb; ++q) { const int it = vcu * ipb + q; if (it < nNA) {
#ifndef NO_NA
                    na_item(lds, PA, rpb, ONA, it, T, tid);
#endif
                    __syncthreads(); } }
        } else if (kind == K_M3) {
            const float* gno = args.in[8] + l * 512; const float* cw = args.in[10] + l * 3 * 512; const float* cbias = args.in[11] + l * 512;
            const int c0 = lane * 8;
            for (int rep = 0; rep < REP_M3; ++rep) for (int row = gw; row < TG; row += NGW) {
                const f32x4* pf = (const f32x4*)(OD + (size_t)row * 512 + c0); const f32x4* pbk = (const f32x4*)(OD + (size_t)TG * 512 + (size_t)row * 512 + c0);
                const f32x4 f0 = pf[0], f1 = pf[1], b0 = pbk[0], b1 = pbk[1];
                float o[8]; float ss = 0.f;
#pragma unroll
                for (int e = 0; e < 4; ++e) { o[e] = f0[e] + b0[e]; o[4 + e] = f1[e] + b1[e]; }
#pragma unroll
                for (int e = 0; e < 8; ++e) ss += o[e] * o[e];
                ss += __shfl_xor(ss, 1); ss += __shfl_xor(ss, 2); ss += __shfl_xor(ss, 4); ss += __shfl_xor(ss, 8);
                const float rs = __builtin_amdgcn_rsqf(ss * (1.0f / 128.0f) + 1e-6f);
                const bf16* prow = PA + (size_t)row * PA_LD;
                const v4u hgw = *(const v4u*)(prow + C_HG + c0);
                const float hgv[8] = {bflo(hgw.x), bfhi(hgw.x), bflo(hgw.y), bfhi(hgw.y), bflo(hgw.z), bfhi(hgw.z), bflo(hgw.w), bfhi(hgw.w)};
                const f32x4 gn0 = *(const f32x4*)(gno + c0), gn1 = *(const f32x4*)(gno + c0 + 4);
                const float gn[8] = {gn0[0], gn0[1], gn0[2], gn0[3], gn1[0], gn1[1], gn1[2], gn1[3]};
                float r8[8];
#pragma unroll
                for (int e = 0; e < 8; ++e) r8[e] = o[e] * rs * gn[e] * (hgv[e] * sigm(hgv[e]));
                v4u wo; wo.x = cvt_pk_bf16(r8[0], r8[1]); wo.y = cvt_pk_bf16(r8[2], r8[3]); wo.z = cvt_pk_bf16(r8[4], r8[5]); wo.w = cvt_pk_bf16(r8[6], r8[7]);
                *(v4u*)(OHG + (size_t)row * 512 + c0) = wo;
                const int tl = row & (T - 1);
                const v4u a1 = *(const v4u*)(prow + C_CA + c0), c1 = *(const v4u*)(prow + C_CC + c0), bb = *(const v4u*)(prow + C_CB + c0);
                v4u a0 = {0u, 0u, 0u, 0u}, cc0 = a0, a2 = a0, cc2 = a0;
                if (tl > 0) { a0 = *(const v4u*)(prow - PA_LD + C_CA + c0); cc0 = *(const v4u*)(prow - PA_LD + C_CC + c0); }
                if (tl < T - 1) { a2 = *(const v4u*)(prow + PA_LD + C_CA + c0); cc2 = *(const v4u*)(prow + PA_LD + C_CC + c0); }
                const float zm[8] = {bflo(a0.x) * bflo(cc0.x), bfhi(a0.x) * bfhi(cc0.x), bflo(a0.y) * bflo(cc0.y), bfhi(a0.y) * bfhi(cc0.y), bflo(a0.z) * bflo(cc0.z), bfhi(a0.z) * bfhi(cc0.z), bflo(a0.w) * bflo(cc0.w), bfhi(a0.w) * bfhi(cc0.w)};
                const float zc[8] = {bflo(a1.x) * bflo(c1.x), bfhi(a1.x) * bfhi(c1.x), bflo(a1.y) * bflo(c1.y), bfhi(a1.y) * bfhi(c1.y), bflo(a1.z) * bflo(c1.z), bfhi(a1.z) * bfhi(c1.z), bflo(a1.w) * bflo(c1.w), bfhi(a1.w) * bfhi(c1.w)};
                const float zp[8] = {bflo(a2.x) * bflo(cc2.x), bfhi(a2.x) * bfhi(cc2.x), bflo(a2.y) * bflo(cc2.y), bfhi(a2.y) * bfhi(cc2.y), bflo(a2.z) * bflo(cc2.z), bfhi(a2.z) * bfhi(cc2.z), bflo(a2.w) * bflo(cc2.w), bfhi(a2.w) * bfhi(cc2.w)};
                const float cbv[8] = {bflo(bb.x), bfhi(bb.x), bflo(bb.y), bfhi(bb.y), bflo(bb.z), bfhi(bb.z), bflo(bb.w), bfhi(bb.w)};
                const f32x4 w00 = *(const f32x4*)(cw + c0), w01 = *(const f32x4*)(cw + c0 + 4), w10 = *(const f32x4*)(cw + 512 + c0), w11 = *(const f32x4*)(cw + 512 + c0 + 4);
                const f32x4 w20 = *(const f32x4*)(cw + 1024 + c0), w21 = *(const f32x4*)(cw + 1024 + c0 + 4), bs0 = *(const f32x4*)(cbias + c0), bs1 = *(const f32x4*)(cbias + c0 + 4);
#pragma unroll
                for (int e = 0; e < 4; ++e) { r8[e] = cbv[e] * (w00[e] * zm[e] + w10[e] * zc[e] + w20[e] * zp[e] + bs0[e]); r8[4 + e] = cbv[4 + e] * (w01[e] * zm[4 + e] + w11[e] * zc[4 + e] + w21[e] * zp[4 + e] + bs1[e]); }
                wo.x = cvt_pk_bf16(r8[0], r8[1]); wo.y = cvt_pk_bf16(r8[2], r8[3]); wo.z = cvt_pk_bf16(r8[4], r8[5]); wo.w = cvt_pk_bf16(r8[6], r8[7]);
                *(v4u*)(OCV + (size_t)row * 512 + c0) = wo;
            }
        } else if (kind == K_M4) {
            pg8::StaticOrder S; S.init(TG, D, G, bid);
            { pg8::Gemm gm{OHG, Wl + OFF_HG, TG, D, 512}; pg8::EpiMerge<0> E{PG, PA};
#ifndef NO_MERGE
            pg8::gemm_phase<pg8::EpiMerge<0>, pg8::StaticOrder, true, true>(lds, gm, S, E);
#endif
            }
            { pg8::Gemm gm{OCV, Wl + OFF_CV, TG, D, 512}; pg8::EpiMerge<1> E{PG, PA};
#ifndef NO_MERGE
            pg8::gemm_phase<pg8::EpiMerge<1>, pg8::StaticOrder, true, true>(lds, gm, S, E);
#endif
            }
            { pg8::Gemm gm{ONA, Wl + OFF_NA, TG, D, 512}; pg8::EpiMerge<2> E{PG, PA};
#ifndef NO_MERGE
            pg8::gemm_phase<pg8::EpiMerge<2>, pg8::StaticOrder, true, true>(lds, gm, S, E);
#endif
            }
        } else {
            const f32x4* fg = (const f32x4*)args.in[19] + lane;
            for (int row = gw; row < TG; row += NGW) {
                const float rs = pg8::row_rs(SSQ, row);
                f32x4* xo = (f32x4*)(X + (size_t)row * D) + lane; const v2u* bi = (const v2u*)(XB + (size_t)row * D) + lane;
#pragma unroll
                for (int j = 0; j < 4; ++j) { const v2u w = bi[64 * j]; const f32x4 v = {bflo(w.x), bfhi(w.x), bflo(w.y), bfhi(w.y)}; xo[64 * j] = v * fg[64 * j] * rs; }
            }
        }
        if (ph + 1 < hi) { for (int rep = 0; rep < REP_SYNC; ++rep) { if (ph == 0) grid.sync(); else xcd_barrier(xbar); } }
    }
}
constexpr int N_PHASES = 1 + NGROUP * (1 + NLAYER * 9 + 1);

extern "C" void kernel_launch(void* const* d_in, const int* in_sizes, int n_in, void* d_out, int out_size, void* d_ws, size_t ws_size, hipStream_t stream) {
    static int grid = 0;
    if (grid == 0) {
        if (n_in != 20 || ws_size < WS_END) { fprintf(stderr, "kernel_launch: unexpected n_in %d / ws %zu\n", n_in, ws_size); grid = -1; return; }
        int dev = 0, cus = 0, per_cu = 0;
        hipGetDevice(&dev); hipDeviceGetAttribute(&cus, hipDeviceAttributeMultiprocessorCount, dev);
        hipFuncSetAttribute((const void*)mk_fwd, hipFuncAttributeMaxDynamicSharedMemorySize, LDS_BYTES);
        hipOccupancyMaxActiveBlocksPerMultiprocessor(&per_cu, (const void*)mk_fwd, NTHR, LDS_BYTES);
        if (per_cu < 1) per_cu = 1;
        grid = cus * per_cu;
        (void)hipGetLastError();
    }
    if (grid < 0) return;
    hipMemsetAsync((char*)d_ws + WS_CTL, 0, CTL_BYTES, stream);
    Args a{};
    for (int i = 0; i < 20; ++i) a.in[i] = (const float*)d_in[i];
    a.out = (float*)d_out; a.ws = (unsigned char*)d_ws;
#if ONE_LAUNCH
    a.ph_lo = 0; a.ph_hi = N_PHASES;
    void* kargs[] = {&a};
    hipError_t e = hipLaunchCooperativeKernel((const void*)mk_fwd, dim3(grid), dim3(NTHR), kargs, LDS_BYTES, stream);
    if (e != hipSuccess) fprintf(stderr, "cooperative launch failed: %s (grid %d)\n", hipGetErrorString(e), grid);
#else
    for (int p = 0; p < N_PHASES; ++p) { a.ph_lo = p; a.ph_hi = p + 1; hipLaunchKernelGGL(mk_fwd, dim3(grid), dim3(NTHR), LDS_BYTES, stream, a); }
#endif
}
```

```cpp
#include <hip/hip_runtime.h>
#include <hip/hip_cooperative_groups.h>
#include <cstdio>
#include <cstdint>
namespace cg = cooperative_groups;
#ifndef ONE_LAUNCH
#define ONE_LAUNCH 1
#endif
#ifndef REP_HG
#define REP_HG 1
#endif
#ifndef REP_NA
#define REP_NA 1
#endif
#ifndef REP_SYNC
#define REP_SYNC 1
#endif
#ifndef REP_GEMM
#define REP_GEMM 1
#endif
#ifndef REP_M3
#define REP_M3 1
#endif
namespace pg8 {
#define PG8_LAS __attribute__((address_space(3)))
typedef unsigned short bf16_t;
typedef short bf16x8 __attribute__((ext_vector_type(8)));
typedef float f32x4 __attribute__((ext_vector_type(4)));
typedef unsigned u32x4 __attribute__((ext_vector_type(4)));
constexpr int BM = 256, BK = 64, HALF = 128, HTB = HALF * BK * 2  , STAGE_BYTES = 8 * HTB, NXCD = 8, WGM = 8;

__host__ __device__ __forceinline__ int lds_byte(int r, int c) { const int st = (r >> 4) * 2 + (c >> 5), rr = r & 15, cc = c & 31, ob = rr * 64 + cc * 2; return st * 1024 + (ob ^ (((ob >> 9) & 1) << 5)); }
__host__ __device__ __forceinline__ void stage_rc(int b, int& R, int& C) { const int st = b / 1024, sb = b % 1024, swz = sb ^ (((sb >> 9) & 1) << 5); R = (st >> 1) * 16 + swz / 64; C = (st & 1) * 32 + (swz % 64) / 2; }
__host__ __device__ __forceinline__ int perm32(int rho) { const int n = rho >> 4, i = rho & 15; return 8 * (i >> 2) + 4 * n + (i & 3); }

struct Unit { int pm, pn; };
struct Gemm { const bf16_t* A; const bf16_t* Bt; int M, N, K; };

struct StaticOrder {
    int nM, nN, nwg, G, c;
    __host__ __device__ void init(int M, int N, int G_, int c_) { nM = M / BM; nN = N / BM; nwg = nM * nN; G = G_; c = c_; }
    __host__ __device__ bool next(int i, Unit& u) const {
        const long L = (long)i * G + c; if (L >= nwg) return false;
        int wgid = (int)L; { const int q = nwg / NXCD, r = nwg % NXCD, xcd = wgid % NXCD, off = wgid / NXCD; wgid = (xcd < r ? xcd * (q + 1) : r * (q + 1) + (xcd - r) * q) + off; }
        const int nig = WGM * nN, gid = wgid / nig, fm = gid * WGM, gsz = (nM - fm) < WGM ? (nM - fm) : WGM;
        u.pm = fm + ((wgid % nig) % gsz); u.pn = (wgid % nig) / gsz; return true;
    }
    __device__ __forceinline__ void a_ready(const Unit&) const {}
    __device__ __forceinline__ void done(const Unit&) const {}
};

__device__ __forceinline__ unsigned cvt_pk_bf16(float lo, float hi) { unsigned r; asm volatile("v_cvt_pk_bf16_f32 %0, %1, %2" : "=v"(r) : "v"(lo), "v"(hi)); return r; }
__device__ __forceinline__ float row_rs(const float* ssq, int row) {
    const f32x4* p = (const f32x4*)(ssq + (size_t)row * 16);
    const f32x4 a = p[0], b = p[1], c = p[2], d = p[3];
    const float s = (((a[0] + a[1]) + (a[2] + a[3])) + ((b[0] + b[1]) + (b[2] + b[3]))) + (((c[0] + c[1]) + (c[2] + c[3])) + ((d[0] + d[1]) + (d[2] + d[3])));
    return __builtin_amdgcn_rsqf(s * (1.0f / 1024.0f) + 1e-6f);
}
__device__ __forceinline__ float sigm(float v) { return __builtin_amdgcn_rcpf(1.0f + __expf(-v)); }

struct EpiSwiGLU {
    static constexpr bool PERM = true, AFTER_DRAIN = false;
    bf16_t* H; const float* ssq;
    __device__ __forceinline__ void operator()(const f32x4 (&acc)[2][2][4][2], const Unit& u, int wr, int wc, int fr, int fq) const {
        const int row0 = u.pm * BM + wr * 64 + fr, col0 = u.pn * 128 + wc * 32 + 8 * fq;
#pragma unroll
        for (int ai = 0; ai < 2; ++ai)
#pragma unroll
            for (int m = 0; m < 4; ++m) {
                const int row = row0 + ai * HALF + m * 16; const float rs = row_rs(ssq, row);
                u32x4 w;
#pragma unroll
                for (int n = 0; n < 2; ++n) {
                    const f32x4 a = acc[ai][0][m][n] * rs, b = acc[ai][1][m][n] * rs; f32x4 h;
#pragma unroll
                    for (int e = 0; e < 4; ++e) h[e] = a[e] * sigm(a[e]) * b[e];
                    w[2 * n] = cvt_pk_bf16(h[0], h[1]); w[2 * n + 1] = cvt_pk_bf16(h[2], h[3]);
                }
                *(u32x4*)(H + (size_t)row * 2816 + col0) = w;
                asm volatile("" ::: "memory");
            }
    }
};
__device__ __forceinline__ void unpack8(const u32x4 w, f32x4& lo, f32x4& hi) {
    lo[0] = __uint_as_float(w.x << 16); lo[1] = __uint_as_float(w.x & 0xffff0000u); lo[2] = __uint_as_float(w.y << 16); lo[3] = __uint_as_float(w.y & 0xffff0000u);
    hi[0] = __uint_as_float(w.z << 16); hi[1] = __uint_as_float(w.z & 0xffff0000u); hi[2] = __uint_as_float(w.w << 16); hi[3] = __uint_as_float(w.w & 0xffff0000u);
}
struct EpiRes {
    static constexpr bool PERM = true, AFTER_DRAIN = false;
    bf16_t* XB; float* ssq; float alpha;
    __device__ __forceinline__ void operator()(const f32x4 (&acc)[2][2][4][2], const Unit& u, int wr, int wc, int fr, int fq) const {
        const int row0 = u.pm * BM + wr * 64 + fr, col0 = u.pn * BM + wc * 32 + 8 * fq;
#pragma unroll
        for (int ai = 0; ai < 2; ++ai)
#pragma unroll
            for (int m = 0; m < 4; ++m) {
                const int row = row0 + ai * HALF + m * 16; float ss = 0.f;
#pragma unroll
                for (int bj = 0; bj < 2; ++bj) {
                    bf16_t* xp = XB + (size_t)row * 1024 + col0 + bj * HALF;
                    f32x4 x0, x1; unpack8(*(const u32x4*)xp, x0, x1);
                    x0 = x0 + acc[ai][bj][m][0] * alpha; x1 = x1 + acc[ai][bj][m][1] * alpha;
                    u32x4 w; w.x = cvt_pk_bf16(x0[0], x0[1]); w.y = cvt_pk_bf16(x0[2], x0[3]); w.z = cvt_pk_bf16(x1[0], x1[1]); w.w = cvt_pk_bf16(x1[2], x1[3]);
                    *(u32x4*)xp = w;
                    ss += ((x0[0] * x0[0] + x0[1] * x0[1]) + (x0[2] * x0[2] + x0[3] * x0[3])) + ((x1[0] * x1[0] + x1[1] * x1[1]) + (x1[2] * x1[2] + x1[3] * x1[3]));
                }
                ss += __shfl_xor(ss, 16); ss += __shfl_xor(ss, 32);
                if (fq == 0) ssq[(size_t)row * 16 + u.pn * 4 + wc] = ss;
                asm volatile("" ::: "memory");
            }
    }
};
struct EpiProj {
    static constexpr bool PERM = true, AFTER_DRAIN = false;
    bf16_t* PA; bf16_t* PG; const float* ssq;
    __device__ __forceinline__ void operator()(const f32x4 (&acc)[2][2][4][2], const Unit& u, int wr, int wc, int fr, int fq) const {
        const int row0 = u.pm * BM + wr * 64 + fr;
        bf16_t* base; int ld, colt;
        if (u.pn < 22) { base = PA; ld = 5632; colt = u.pn * BM; } else { base = PG; ld = 3072; colt = (u.pn - 22) * BM; }
        const int col0 = colt + wc * 32 + 8 * fq;
#pragma unroll
        for (int ai = 0; ai < 2; ++ai)
#pragma unroll
            for (int m = 0; m < 4; ++m) {
                const int row = row0 + ai * HALF + m * 16; const float rs = row_rs(ssq, row);
#pragma unroll
                for (int bj = 0; bj < 2; ++bj) {
                    const f32x4 v0 = acc[ai][bj][m][0] * rs, v1 = acc[ai][bj][m][1] * rs;
                    u32x4 w; w.x = cvt_pk_bf16(v0[0], v0[1]); w.y = cvt_pk_bf16(v0[2], v0[3]); w.z = cvt_pk_bf16(v1[0], v1[1]); w.w = cvt_pk_bf16(v1[2], v1[3]);
                    *(u32x4*)(base + (size_t)row * ld + col0 + bj * HALF) = w;
                }
                asm volatile("" ::: "memory");
            }
    }
};
template <int I> struct EpiMerge {
    static constexpr bool PERM = true, AFTER_DRAIN = false;
    const bf16_t* PG; bf16_t* MB;
    __device__ __forceinline__ void operator()(const f32x4 (&acc)[2][2][4][2], const Unit& u, int wr, int wc, int fr, int fq) const {
        const int row0 = u.pm * BM + wr * 64 + fr, col0 = u.pn * BM + wc * 32 + 8 * fq;
#pragma unroll
        for (int ai = 0; ai < 2; ++ai)
#pragma unroll
            for (int m = 0; m < 4; ++m) {
                const int row = row0 + ai * HALF + m * 16;
#pragma unroll
                for (int bj = 0; bj < 2; ++bj) {
                    const int col = col0 + bj * HALF;
                    f32x4 g0, g1; unpack8(*(const u32x4*)(PG + (size_t)row * 3072 + I * 1024 + col), g0, g1);
                    f32x4 t0, t1;
#pragma unroll
                    for (int e = 0; e < 4; ++e) { t0[e] = sigm(g0[e]) * acc[ai][bj][m][0][e]; t1[e] = sigm(g1[e]) * acc[ai][bj][m][1][e]; }
                    bf16_t* mp = MB + (size_t)row * 1024 + col;
                    if (I > 0) { f32x4 p0, p1; unpack8(*(const u32x4*)mp, p0, p1); t0 = t0 + p0; t1 = t1 + p1; }
                    u32x4 w; w.x = cvt_pk_bf16(t0[0], t0[1]); w.y = cvt_pk_bf16(t0[2], t0[3]); w.z = cvt_pk_bf16(t1[0], t1[1]); w.w = cvt_pk_bf16(t1[2], t1[3]);
                    *(u32x4*)mp = w;
                }
                asm volatile("" ::: "memory");
            }
    }
};
template <class Epi, class Sched, bool ALIGN_EPI = false, bool SP2 = false>
__device__ __forceinline__ void gemm_phase(PG8_LAS unsigned char* lds, const Gemm g, const Sched& S, const Epi& E) {
    int tid = threadIdx.x; asm volatile("" : "+v"(tid));
    const int wid = __builtin_amdgcn_readfirstlane(tid >> 6), lane = tid & 63, wr = wid >> 2, wc = wid & 3, fr = lane & 15, fq = lane >> 4;
    const int K = g.K, nt = K / BK;
    unsigned voffA[2], voffB[2];
#pragma unroll
    for (int i = 0; i < 2; ++i) { int R, C; stage_rc(tid * 16 + i * 8192, R, C); const int Rb = Epi::PERM ? ((R & ~31) + perm32(R & 31)) : R;
        voffA[i] = (unsigned)(R * K + C) * 2u; voffB[i] = (unsigned)(Rb * K + C) * 2u; }
    const size_t kstep = (size_t)(BK * 2);
    const size_t hstep = (size_t)HALF * K * 2;
    const size_t tstep = 2 * hstep;
    const unsigned ldsw = (unsigned)wid * 1024u;
    const int aoff = lds_byte(wr * 64 + fr, fq * 8), boff = lds_byte(wc * 32 + fr, fq * 8);
#define PG8_SA(b, h) (((b) * 2 + (h)) * HTB)
#define PG8_SB(b, h) ((4 + (b) * 2 + (h)) * HTB)
#define PG8_STAGE(bufoff, gbase, voff) do { _Pragma("unroll") for (int _i = 0; _i < 2; ++_i) \
        __builtin_amdgcn_global_load_lds((const unsigned*)((const char*)(gbase) + (voff)[_i]), (PG8_LAS unsigned*)(lds + (bufoff) + ldsw + _i * 8192), 16, 0, 0); } while (0)
#define PG8_LDA(dst, b, h) do { _Pragma("unroll") for (int m = 0; m < 4; ++m) _Pragma("unroll") for (int k = 0; k < 2; ++k) dst[m][k] = *(const PG8_LAS bf16x8*)(lds + PG8_SA(b, h) + aoff + m * 2048 + k * 1024); } while (0)
#define PG8_LDB(dst, b, h) do { _Pragma("unroll") for (int n = 0; n < 2; ++n) _Pragma("unroll") for (int k = 0; k < 2; ++k) dst[n][k] = *(const PG8_LAS bf16x8*)(lds + PG8_SB(b, h) + boff + n * 2048 + k * 1024); } while (0)
#define PG8_MMA(ai, bj, At, Bt) do { __builtin_amdgcn_s_setprio(1); _Pragma("unroll") for (int m = 0; m < 4; ++m) _Pragma("unroll") for (int n = 0; n < 2; ++n) _Pragma("unroll") for (int k = 0; k < 2; ++k) \
        acc[ai][bj][m][n] = __builtin_amdgcn_mfma_f32_16x16x32_bf16(Bt[n][k], At[m][k], acc[ai][bj][m][n], 0, 0, 0); __builtin_amdgcn_s_setprio(0); } while (0)
#define PG8_WAIT_V(n) asm volatile("s_waitcnt vmcnt(" #n ")" ::: "memory")
#define PG8_WAIT_L(n) asm volatile("s_waitcnt lgkmcnt(" #n ")" ::: "memory")
#define PG8_BAR __builtin_amdgcn_s_barrier()
#define PG8_SCHED __builtin_amdgcn_sched_barrier(0)
    Unit cur, nxt; int ui = 0;
    if (!S.next(0, cur)) return;
    f32x4 acc[2][2][4][2];
#pragma unroll
    for (int a = 0; a < 2; ++a)
#pragma unroll
        for (int b = 0; b < 2; ++b)
#pragma unroll
            for (int m = 0; m < 4; ++m)
#pragma unroll
                for (int n = 0; n < 2; ++n) acc[a][b][m][n] = (f32x4){0.f, 0.f, 0.f, 0.f};
    bf16x8 At[4][2], B0[2][2], B1[2][2];
    const char* cA = (const char*)g.A + (size_t)cur.pm * tstep; const char* cB = (const char*)g.Bt + (size_t)cur.pn * tstep;
    S.a_ready(cur);
    if constexpr (SP2) {
        PG8_STAGE(PG8_SB(0, 0), cB, voffB); PG8_STAGE(PG8_SB(0, 1), cB + hstep, voffB); PG8_STAGE(PG8_SA(0, 0), cA, voffA); PG8_STAGE(PG8_SA(0, 1), cA + hstep, voffA);
        if (wr == 1) PG8_BAR;
        PG8_WAIT_V(2); PG8_BAR;
        PG8_STAGE(PG8_SB(1, 0), cB + kstep, voffB); PG8_STAGE(PG8_SA(1, 0), cA + kstep, voffA); PG8_STAGE(PG8_SB(1, 1), cB + hstep + kstep, voffB);
        PG8_WAIT_V(6); PG8_BAR;
    } else {
        PG8_STAGE(PG8_SB(0, 0), cB, voffB); PG8_STAGE(PG8_SA(0, 0), cA, voffA); PG8_STAGE(PG8_SB(0, 1), cB + hstep, voffB); PG8_STAGE(PG8_SA(0, 1), cA + hstep, voffA);
        if (wr == 1) PG8_BAR;
        PG8_WAIT_V(4); PG8_BAR;
        PG8_STAGE(PG8_SB(1, 0), cB + kstep, voffB); PG8_STAGE(PG8_SA(1, 0), cA + kstep, voffA); PG8_STAGE(PG8_SB(1, 1), cB + hstep + kstep, voffB);
        PG8_WAIT_V(6); PG8_BAR;
    }
    for (;;) {
        const bool has_next = S.next(ui + 1, nxt);
        const char* nA = has_next ? (const char*)g.A + (size_t)nxt.pm * tstep : cA; const char* nB = has_next ? (const char*)g.Bt + (size_t)nxt.pn * tstep : cB;
        for (int t = 0; t < nt; t += 2) {
            const bool last = (t == nt - 2);
            const char* a1 = cA + (size_t)(t + 1) * kstep;
            const char* a2 = last ? nA : cA + (size_t)(t + 2) * kstep; const char* b2 = last ? nB : cB + (size_t)(t + 2) * kstep;
            const char* a3 = a2 + kstep; const char* b3 = b2 + kstep;
            if (last && has_next) S.a_ready(nxt);
            if constexpr (SP2) {
            PG8_LDB(B0, 0, 0); PG8_LDB(B1, 0, 1); PG8_SCHED; PG8_LDA(At, 0, 0); PG8_STAGE(PG8_SA(1, 1), a1 + hstep, voffA);
            PG8_WAIT_V(8); PG8_WAIT_L(0); PG8_BAR; PG8_MMA(0, 0, At, B0); PG8_MMA(0, 1, At, B1); PG8_BAR; PG8_SCHED;
            PG8_LDA(At, 0, 1); PG8_STAGE(PG8_SB(0, 0), b2, voffB); PG8_STAGE(PG8_SB(0, 1), b2 + hstep, voffB); PG8_STAGE(PG8_SA(0, 0), a2, voffA);
            PG8_WAIT_V(8); PG8_WAIT_L(0); PG8_BAR; PG8_MMA(1, 0, At, B0); PG8_MMA(1, 1, At, B1); PG8_BAR; PG8_SCHED;
            PG8_LDB(B0, 1, 0); PG8_LDB(B1, 1, 1); PG8_SCHED; PG8_LDA(At, 1, 0); PG8_STAGE(PG8_SA(0, 1), a2 + hstep, voffA);
            PG8_WAIT_V(8); PG8_WAIT_L(0); PG8_BAR; PG8_MMA(0, 0, At, B0); PG8_MMA(0, 1, At, B1); PG8_BAR; PG8_SCHED;
            PG8_LDA(At, 1, 1); PG8_STAGE(PG8_SB(1, 0), b3, voffB); PG8_STAGE(PG8_SB(1, 1), b3 + hstep, voffB); PG8_STAGE(PG8_SA(1, 0), a3, voffA);
            PG8_WAIT_V(8); PG8_WAIT_L(0); PG8_BAR; PG8_MMA(1, 0, At, B0); PG8_MMA(1, 1, At, B1); PG8_BAR; PG8_SCHED;
            } else {
            PG8_LDB(B0, 0, 0); PG8_SCHED; PG8_LDA(At, 0, 0); PG8_STAGE(PG8_SA(1, 1), a1 + hstep, voffA);
            PG8_WAIT_L(8); PG8_BAR; PG8_WAIT_L(0); PG8_MMA(0, 0, At, B0); PG8_BAR; PG8_SCHED;
            PG8_LDB(B1, 0, 1); PG8_STAGE(PG8_SB(0, 0), b2, voffB);
            PG8_BAR; PG8_WAIT_L(0); PG8_MMA(0, 1, At, B1); PG8_BAR;
            PG8_LDA(At, 0, 1); PG8_STAGE(PG8_SA(0, 0), a2, voffA);
            PG8_BAR; PG8_WAIT_L(0); PG8_MMA(1, 0, At, B0); PG8_BAR; PG8_SCHED;
            PG8_STAGE(PG8_SB(0, 1), b2 + hstep, voffB);
            PG8_WAIT_V(6); PG8_BAR; PG8_MMA(1, 1, At, B1); PG8_BAR;
            PG8_LDB(B0, 1, 0); PG8_SCHED; PG8_LDA(At, 1, 0); PG8_STAGE(PG8_SA(0, 1), a2 + hstep, voffA);
            PG8_WAIT_L(8); PG8_BAR; PG8_WAIT_L(0); PG8_MMA(0, 0, At, B0); PG8_BAR; PG8_SCHED;
            PG8_LDB(B1, 1, 1); PG8_STAGE(PG8_SB(1, 0), b3, voffB);
            PG8_BAR; PG8_WAIT_L(0); PG8_MMA(0, 1, At, B1); PG8_BAR;
            PG8_LDA(At, 1, 1); PG8_STAGE(PG8_SA(1, 0), a3, voffA);
            PG8_BAR; PG8_WAIT_L(0); PG8_MMA(1, 0, At, B0); PG8_BAR; PG8_SCHED;
            PG8_STAGE(PG8_SB(1, 1), b3 + hstep, voffB);
            PG8_WAIT_V(6); PG8_BAR; PG8_MMA(1, 1, At, B1); PG8_BAR;
            }
        }
        if constexpr (ALIGN_EPI) { if (wr == 0) PG8_BAR; }
        if constexpr (!Epi::AFTER_DRAIN) { E(acc, cur, wr, wc, fr, fq); S.done(cur); }
        if (!has_next) break;
#pragma unroll
        for (int a = 0; a < 2; ++a)
#pragma unroll
            for (int b = 0; b < 2; ++b)
#pragma unroll
                for (int m = 0; m < 4; ++m)
#pragma unroll
                    for (int n = 0; n < 2; ++n) acc[a][b][m][n] = (f32x4){0.f, 0.f, 0.f, 0.f};
        cur = nxt; cA = nA; cB = nB; ++ui;
        if constexpr (ALIGN_EPI) { if (wr == 1) PG8_BAR; }
    }
    PG8_WAIT_V(0);
    if constexpr (!ALIGN_EPI) { if (wr == 0) PG8_BAR; }
    PG8_BAR;
    if constexpr (Epi::AFTER_DRAIN) { E.fused(acc, cur, wr, wc, fr, fq, lds, wid, lane); S.done(cur); }
#undef PG8_SA
#undef PG8_SB
#undef PG8_STAGE
#undef PG8_LDA
#undef PG8_LDB
#undef PG8_MMA
#undef PG8_WAIT_V
#undef PG8_WAIT_L
#undef PG8_BAR
#undef PG8_SCHED
}
}
#define LAS __attribute__((address_space(3)))
typedef unsigned short bf16;
typedef unsigned v4u __attribute__((ext_vector_type(4)));
typedef unsigned v2u __attribute__((ext_vector_type(2)));
typedef short v4i16_t __attribute__((ext_vector_type(4)));
using pg8::f32x4; using pg8::bf16x8; using pg8::cvt_pk_bf16;

constexpr int D = 1024, FF = 2816, NLAYER = 4, TG = 16384, NGROUP = 4, NTHR = 512, NWAVES = 8;
constexpr int PA_LD = 5632, PG_LD = 3072;
constexpr int C_HQ = 0, C_HI = 512, C_HZF = 1024, C_HZB = 1536, C_HG = 2048, C_CA = 2560, C_CB = 3072, C_CC = 3584, C_NQ = 4096, C_NK = 4608, C_NV = 5120;
constexpr size_t MiB = 1u << 20;
constexpr size_t WS_CTL = 0, CTL_BYTES = 1 * MiB, WS_W = 1 * MiB, WS_XB = 221 * MiB, WS_SSQ = 253 * MiB, WS_PA = 254 * MiB, WS_PG = 430 * MiB, WS_ONA = 526 * MiB, WS_OD = 542 * MiB, WS_SCR = 574 * MiB, WS_END = 664 * MiB;
constexpr size_t OFF_GU1 = 0, OFF_D1 = 5767168, OFF_IN = 8650752, OFF_HG = 17563648, OFF_CV = 18087936, OFF_NA = 18612224, OFF_OUT = 19136512, OFF_GU2 = 20185088, OFF_D2 = 25952256, LAYER_EL = 28835840;
constexpr int LDS_BYTES = 147456, LDS_MISC = 147456 - 64;
constexpr int PH_PER_GROUP = 1 + NLAYER * 10 + 1;
constexpr int CW_BAR = 4096;

__device__ __forceinline__ unsigned f2bf(float f) { unsigned u = __float_as_uint(f); return (u + 0x7fffu + ((u >> 16) & 1u)) >> 16; }
__device__ __forceinline__ float bf2f(unsigned b) { return __uint_as_float(b << 16); }
__device__ __forceinline__ float bflo(unsigned w) { return __uint_as_float(w << 16); }
__device__ __forceinline__ float bfhi(unsigned w) { return __uint_as_float(w & 0xffff0000u); }
__device__ __forceinline__ float sigm(float v) { return __builtin_amdgcn_rcpf(1.0f + __expf(-v)); }
__device__ __forceinline__ float wave_sum(float v) {
#pragma unroll
    for (int o = 1; o < 64; o <<= 1) v += __shfl_xor(v, o);
    return v;
}

__device__ __forceinline__ void cvt_item(const float* W, int K, int N, bf16* WT, const float* gain, bool permgu, LAS float* scr, int item, int lane) {
    const int nblk = N / 32, kb = item / nblk, nb = item % nblk, k0 = 64 * kb, n0 = 32 * nb;
#pragma unroll 8
    for (int i = 0; i < 32; ++i) { const int kk = 2 * i + (lane >> 5); const float g = gain ? gain[k0 + kk] : 1.0f; scr[kk * 33 + (lane & 31)] = W[(size_t)(k0 + kk) * N + n0 + (lane & 31)] * g; }
    asm volatile("s_waitcnt lgkmcnt(0)" ::: "memory");
    int dn0 = n0;
    if (permgu) { const int half = n0 >= FF ? 1 : 0; const int j = n0 - half * FF; dn0 = (j >> 7) * 256 + half * 128 + (j & 127); }
    const int c = lane & 7;
#pragma unroll
    for (int j = 0; j < 4; ++j) { const int n = (lane >> 3) + 8 * j; const LAS float* s = scr + (8 * c) * 33 + n;
        v4u o; o.x = cvt_pk_bf16(s[0 * 33], s[1 * 33]); o.y = cvt_pk_bf16(s[2 * 33], s[3 * 33]); o.z = cvt_pk_bf16(s[4 * 33], s[5 * 33]); o.w = cvt_pk_bf16(s[6 * 33], s[7 * 33]);
        *(v4u*)(WT + (size_t)(dn0 + n) * K + k0 + 8 * c) = o; }
    asm volatile("s_waitcnt lgkmcnt(0)" ::: "memory");
}

template <int K> __device__ __forceinline__ f32x4 mma_lds(f32x4 acc, const LAS bf16* A, int pa, const LAS bf16* B, int pb, int lane) {
    const int r = lane & 15, q = lane >> 4;
#pragma unroll
    for (int ks = 0; ks < K / 32; ++ks) {
        const bf16x8 a = *(const LAS bf16x8*)(A + r * pa + ks * 32 + q * 8);
        const bf16x8 b = *(const LAS bf16x8*)(B + r * pb + ks * 32 + q * 8);
        acc = __builtin_amdgcn_mfma_f32_16x16x32_bf16(a, b, acc, 0, 0, 0);
    }
    return acc;
}

constexpr int HP_QT = 0, HP_KTT = 17408, HP_AM = 35840, HP_ER = 45056, HP_EE = 45568, HP_BLK = 46080;
constexpr int HP_KT = 46080, HP_SEG = 63488;
constexpr int HS_VT = 46080, HS_ST = 50688, HS_BUF = 59392;
__device__ __forceinline__ void hg_prep_item(LAS unsigned char* lds, const bf16* PA, unsigned char* SCR, const float* lb_logits, int layer, int item, int T, int tid) {
    const int lane = tid & 63, wave = __builtin_amdgcn_readfirstlane(tid >> 6), c16 = lane & 15, quad = lane >> 4;
    const int nchunk = T / 64, c = item % nchunk, sd = item / nchunk, dir = sd & 1, h = (sd >> 1) & 3, seq = sd >> 3;
    const int base = seq * T;
    const int k = tid & 127, tq = tid >> 7;
    LAS bf16* QT = (LAS bf16*)(lds + HP_QT); LAS bf16* KT = (LAS bf16*)(lds + HP_KT); LAS bf16* KTT = (LAS bf16*)(lds + HP_KTT); LAS bf16* AM = (LAS bf16*)(lds + HP_AM);
    LAS float* SEG = (LAS float*)(lds + HP_SEG); LAS float* ER = (LAS float*)(lds + HP_ER); LAS float* EE = (LAS float*)(lds + HP_EE);
    float lb;
    { float lg[4], mx = -3e38f;
#pragma unroll
      for (int l = 0; l < 4; ++l) { lg[l] = lb_logits[(dir * 4 + l) * 512 + h * 128 + k]; mx = fmaxf(mx, lg[l]); }
      float tot = 0.f, num = 0.f;
#pragma unroll
      for (int l = 0; l < 4; ++l) { const float e = __expf(lg[l] - mx); tot += e; if (l >= 1 && l <= layer) num += e; }
      lb = num / tot; }
    const float oml = 1.0f - lb;
    const bf16* zsrc = PA + (dir ? C_HZB : C_HZF) + h * 128 + k;
    const bf16* qsrc = PA + C_HQ + h * 128 + k;
    unsigned short zr[16], qr[16];
#pragma unroll
    for (int i = 0; i < 16; ++i) { const int tau = c * 64 + 16 * tq + i; const size_t ro = (size_t)(base + (dir ? (T - 1 - tau) : tau)) * PA_LD; zr[i] = zsrc[ro]; qr[i] = qsrc[ro]; }
    float b[16], kv[16]; float cum = 0.f;
#pragma unroll
    for (int i = 0; i < 16; ++i) { const float zf = bf2f(zr[i]); const float sg = sigm(zf); const float f = lb + oml * sg; cum += __logf(fmaxf(f, 1e-30f)); b[i] = cum; kv[i] = oml * (1.0f - sg); }
    SEG[tq * 128 + k] = cum;
    __syncthreads();
    const float s0 = SEG[k], s1 = SEG[128 + k], s2 = SEG[256 + k], s3 = SEG[384 + k];
    const float pre = tq == 0 ? 0.f : (tq == 1 ? s0 : (tq == 2 ? s0 + s1 : (s0 + s1) + s2));
    const float r = s0 + s1, bend = (s0 + s1) + (s2 + s3);
    unsigned kpk[8];
#pragma unroll
    for (int i = 0; i < 16; ++i) {
        const float bt = pre + b[i];
        const float eq = __expf(fminf(bt - r, 80.f)), ek = __expf(fminf(r - bt, 80.f));
        const unsigned qb = f2bf(bf2f(qr[i]) * eq), kb = f2bf(kv[i] * ek);
        const int tau = 16 * tq + i;
        QT[tau * 136 + k] = (bf16)qb; KT[tau * 136 + k] = (bf16)kb;
        if (i & 1) kpk[i >> 1] |= kb << 16; else kpk[i >> 1] = kb;
    }
    *(LAS v4u*)(KTT + k * 72 + 16 * tq) = (v4u){kpk[0], kpk[1], kpk[2], kpk[3]};
    *(LAS v4u*)(KTT + k * 72 + 16 * tq + 8) = (v4u){kpk[4], kpk[5], kpk[6], kpk[7]};
    if (tq == 0) { ER[k] = __expf(r); EE[k] = __expf(bend - r); }
    __syncthreads();
#pragma unroll
    for (int e = 0; e < 2; ++e) { const int id = wave * 2 + e, tt = id >> 2, st = id & 3;
        f32x4 a = (f32x4){0.f, 0.f, 0.f, 0.f};
        if (st <= tt) a = mma_lds<128>(a, QT + tt * 16 * 136, 136, KT + st * 16 * 136, 136, lane);
#pragma unroll
        for (int i = 0; i < 4; ++i) { const int t = tt * 16 + quad * 4 + i, s = st * 16 + c16; const float val = (st <= tt && s <= t) ? a[i] : 0.f; AM[t * 72 + s] = (bf16)f2bf(val); } }
    __syncthreads();
    unsigned char* dst = SCR + (size_t)item * HP_BLK;
#pragma unroll
    for (int j = 0; j < 6; ++j) { const int idx = tid + 512 * j; if (idx < HP_BLK / 16) *(v4u*)(dst + (size_t)idx * 16) = *(const LAS v4u*)(lds + idx * 16); }
    __syncthreads();
}

template <int NVT> __device__ __forceinline__ void hg_scan_item(LAS unsigned char* lds, const bf16* PA, const unsigned char* SCR, bf16* OD, int item, int T, int tid) {
    constexpr int NVS = 8 / NVT, VW = 16 * NVT, VTHR = 128 * NVT, VSH = (NVT == 2) ? 2 : 1;
    const int lane = tid & 63, wave = __builtin_amdgcn_readfirstlane(tid >> 6), c16 = lane & 15, quad = lane >> 4;
    const int vs = item % NVS, sd = item / NVS, dir = sd & 1, h = (sd >> 1) & 3, seq = sd >> 3;
    const int base = seq * T, nchunk = T / 64;
    const unsigned char* blk = SCR + (size_t)sd * nchunk * HP_BLK;
    const bf16* vsrc = PA + C_HI + h * 128 + vs * VW + (tid & (VW / 8 - 1)) * 8;
    bf16* odst = OD + (size_t)dir * TG * 512 + h * 128 + vs * VW;
    v4u pre[6]; v4u vr = {0u, 0u, 0u, 0u}; f32x4 erv, eev;
#define HG_ROW(tau) (base + (dir ? (T - 1 - (tau)) : (tau)))
#define HS_LOAD(c) do { const unsigned char* bp = blk + (size_t)(c) * HP_BLK; \
        _Pragma("unroll") for (int j = 0; j < 6; ++j) { const int idx = tid + 512 * j; if (idx < HP_BLK / 16) pre[j] = *(const v4u*)(bp + (size_t)idx * 16); } \
        erv = *(const f32x4*)(bp + HP_ER + (wave * 16 + quad * 4) * 4); eev = *(const f32x4*)(bp + HP_EE + (wave * 16 + quad * 4) * 4); \
        if (tid < VTHR) vr = *(const v4u*)(vsrc + (size_t)HG_ROW((c) * 64 + (tid >> VSH)) * PA_LD); } while (0)
    HS_LOAD(0);
    f32x4 accS[NVT];
#pragma unroll
    for (int e = 0; e < NVT; ++e) accS[e] = (f32x4){0.f, 0.f, 0.f, 0.f};
    for (int c = 0; c < nchunk; ++c) {
        LAS unsigned char* B = lds + (c & 1) * HS_BUF;
        LAS bf16* QT = (LAS bf16*)(B + HP_QT); LAS bf16* KTT = (LAS bf16*)(B + HP_KTT); LAS bf16* AM = (LAS bf16*)(B + HP_AM);
        LAS bf16* VT = (LAS bf16*)(B + HS_VT); LAS bf16* STt = (LAS bf16*)(B + HS_ST);
#pragma unroll
        for (int j = 0; j < 6; ++j) { const int idx = tid + 512 * j; if (idx < HP_BLK / 16) *(LAS v4u*)(B + idx * 16) = pre[j]; }
        if (tid < VTHR) { const int s = tid >> VSH, vq = tid & (VW / 8 - 1);
            VT[(vq * 8 + 0) * 72 + s] = (bf16)(vr.x & 0xffffu); VT[(vq * 8 + 1) * 72 + s] = (bf16)(vr.x >> 16);
            VT[(vq * 8 + 2) * 72 + s] = (bf16)(vr.y & 0xffffu); VT[(vq * 8 + 3) * 72 + s] = (bf16)(vr.y >> 16);
            VT[(vq * 8 + 4) * 72 + s] = (bf16)(vr.z & 0xffffu); VT[(vq * 8 + 5) * 72 + s] = (bf16)(vr.z >> 16);
            VT[(vq * 8 + 6) * 72 + s] = (bf16)(vr.w & 0xffffu); VT[(vq * 8 + 7) * 72 + s] = (bf16)(vr.w >> 16); }
        f32x4 sp[NVT]; const f32x4 ee_c = eev;
#pragma unroll
        for (int e = 0; e < NVT; ++e) { sp[e] = accS[e] * erv; v2u w; w.x = cvt_pk_bf16(sp[e][0], sp[e][1]); w.y = cvt_pk_bf16(sp[e][2], sp[e][3]);
            *(LAS v2u*)(STt + (e * 16 + c16) * 136 + wave * 16 + quad * 4) = w; }
        if (c + 1 < nchunk) HS_LOAD(c + 1);
        __syncthreads();
        if ((wave >> 2) < NVT) { const int tt = wave & 3, vt = wave >> 2; f32x4 o = (f32x4){0.f, 0.f, 0.f, 0.f};
          o = mma_lds<128>(o, QT + tt * 16 * 136, 136, STt + vt * 16 * 136, 136, lane);
          o = mma_lds<64>(o, AM + tt * 16 * 72, 72, VT + vt * 16 * 72, 72, lane);
#pragma unroll
          for (int i = 0; i < 4; ++i) { const int tau = c * 64 + tt * 16 + quad * 4 + i; odst[(size_t)HG_ROW(tau) * 512 + vt * 16 + c16] = (bf16)f2bf(o[i]); } }
#pragma unroll
        for (int e = 0; e < NVT; ++e) { f32x4 t = mma_lds<64>(sp[e], KTT + wave * 16 * 72, 72, VT + e * 16 * 72, 72, lane); accS[e] = t * ee_c; }
    }
    __syncthreads();
#undef HG_ROW
#undef HS_LOAD
}

__device__ __forceinline__ void na_item(LAS unsigned char* lds, const bf16* PA, const float* rpb, bf16* ONA, int item, int T, int tid) {
    const int lane = tid & 63, h = __builtin_amdgcn_readfirstlane(tid >> 6), c16 = lane & 15, quad = lane >> 4;
    const int ips = T / 16, seq = item / ips, rem = item % ips, r = rem >> 2, j = rem & 3;
    const int rows = T / 64, rs = min(max(r - 4, 0), rows - 8), kstart = (j == 0) ? 0 : (j == 1) ? 8 : (j == 2) ? 24 : 32;
    const int base = seq * T, qtok = base + r * 64 + 16 * j + c16;
    const bf16* qp = PA + (size_t)qtok * PA_LD + C_NQ + h * 64 + quad * 8;
    const bf16x8 Qb0 = *(const bf16x8*)qp, Qb1 = *(const bf16x8*)(qp + 32);
    const int qcol = 16 * j + c16, cs = min(max(qcol - 8, 0), 48);
    v4u vbuf[8];
#define NA_VLOAD(qd) do { _Pragma("unroll") for (int it = 0; it < 8; ++it) { const int idx = it * 64 + lane, key = idx >> 3, dg = idx & 7; \
        const int tok = base + (rs + 2 * (qd) + (key >> 5)) * 64 + kstart + (key & 31); vbuf[it] = *(const v4u*)(PA + (size_t)tok * PA_LD + C_NV + h * 64 + dg * 8); } } while (0)
    NA_VLOAD(0);
    const float* rp = rpb + h * 465;
    f32x4 sacc[16]; float mx = -3e38f;
    int dcv[8]; bool okv[8];
#pragma unroll
    for (int e = 0; e < 8; ++e) { const int kcol = kstart + (e >> 2) * 16 + quad * 4 + (e & 3); okv[e] = (kcol >= cs) && (kcol < cs + 16); dcv[e] = min(max(kcol - qcol + 15, 0), 30); }
#pragma unroll
    for (int a = 0; a < 8; ++a) {
        const float* rpa = rp + (rs + a - r + 7) * 31;
#pragma unroll
        for (int hh = 0; hh < 2; ++hh) {
            const int ktok = base + (rs + a) * 64 + kstart + hh * 16 + c16;
            const bf16* kp = PA + (size_t)ktok * PA_LD + C_NK + h * 64 + quad * 8;
            const bf16x8 Ka0 = *(const bf16x8*)kp, Ka1 = *(const bf16x8*)(kp + 32);
            f32x4 s = (f32x4){0.f, 0.f, 0.f, 0.f};
            s = __builtin_amdgcn_mfma_f32_16x16x32_bf16(Ka0, Qb0, s, 0, 0, 0);
            s = __builtin_amdgcn_mfma_f32_16x16x32_bf16(Ka1, Qb1, s, 0, 0, 0);
#pragma unroll
            for (int i = 0; i < 4; ++i) { const float val = okv[hh * 4 + i] ? s[i] * 0.125f + rpa[dcv[hh * 4 + i]] : -1e30f; s[i] = val; mx = fmaxf(mx, val); }
            sacc[a * 2 + hh] = s;
        }
    }
    mx = fmaxf(mx, __shfl_xor(mx, 16)); mx = fmaxf(mx, __shfl_xor(mx, 32));
    float sum = 0.f;
#pragma unroll
    for (int t = 0; t < 16; ++t)
#pragma unroll
        for (int i = 0; i < 4; ++i) { const float p = __expf(sacc[t][i] - mx); sacc[t][i] = p; sum += p; }
    sum += __shfl_xor(sum, 16); sum += __shfl_xor(sum, 32);
    bf16x8 pb[8];
#pragma unroll
    for (int a = 0; a < 8; ++a) { v4u w; w.x = cvt_pk_bf16(sacc[2 * a][0], sacc[2 * a][1]); w.y = cvt_pk_bf16(sacc[2 * a][2], sacc[2 * a][3]);
        w.z = cvt_pk_bf16(sacc[2 * a + 1][0], sacc[2 * a + 1][1]); w.w = cvt_pk_bf16(sacc[2 * a + 1][2], sacc[2 * a + 1][3]); pb[a] = __builtin_bit_cast(bf16x8, w); }
    LAS bf16* VS = (LAS bf16*)(lds + h * 10240);
    f32x4 oacc[4];
#pragma unroll
    for (int dt = 0; dt < 4; ++dt) oacc[dt] = (f32x4){0.f, 0.f, 0.f, 0.f};
    const int trq = (lane & 15) >> 2, trp = lane & 3;
    const LAS bf16* trbase = VS + (quad * 4 + trq) * 80 + 4 * trp;
#pragma unroll
    for (int qd = 0; qd < 4; ++qd) {
#pragma unroll
        for (int it = 0; it < 8; ++it) { const int idx = it * 64 + lane, key = idx >> 3, dg = idx & 7; *(LAS v4u*)(VS + key * 80 + dg * 8) = vbuf[it]; }
        if (qd < 3) { NA_VLOAD(qd + 1); }
#pragma unroll
        for (int al = 0; al < 2; ++al)
#pragma unroll
            for (int dt = 0; dt < 4; ++dt) { const LAS bf16* p = trbase + al * 32 * 80 + dt * 16;
                const v4i16_t lo = __builtin_amdgcn_ds_read_tr16_b64_v4i16((LAS v4i16_t*)p), hi = __builtin_amdgcn_ds_read_tr16_b64_v4i16((LAS v4i16_t*)(p + 16 * 80));
                const bf16x8 af = {lo[0], lo[1], lo[2], lo[3], hi[0], hi[1], hi[2], hi[3]};
                oacc[dt] = __builtin_amdgcn_mfma_f32_16x16x32_bf16(af, pb[qd * 2 + al], oacc[dt], 0, 0, 0); }
    }
#undef NA_VLOAD
    const float inv = __builtin_amdgcn_rcpf(sum);
#pragma unroll
    for (int dt = 0; dt < 4; ++dt) { const f32x4 o = oacc[dt] * inv; v2u w; w.x = cvt_pk_bf16(o[0], o[1]); w.y = cvt_pk_bf16(o[2], o[3]);
        *(v2u*)(ONA + (size_t)qtok * 512 + h * 64 + dt * 16 + quad * 4) = w; }
}

#define XB_TMO      128
#define XB_XCNT(j)  (256  + 64 * (j))
#define XB_XSUB(j)  (1280 + 64 * (j))
#define XB_XGEN(j)  (2304 + 64 * (j))
#define XB_TOP      3328
#define XB_TOPGEN   3392
#define XCD_BAR_WORDS 3456
#define XB_SPIN_CAP (1u << 18)

__device__ __forceinline__ unsigned xb_ld(unsigned* p)              { return __hip_atomic_load(p, __ATOMIC_RELAXED, __HIP_MEMORY_SCOPE_AGENT); }
__device__ __forceinline__ unsigned xb_add(unsigned* p, unsigned v) { return __hip_atomic_fetch_add(p, v, __ATOMIC_RELAXED, __HIP_MEMORY_SCOPE_AGENT); }
__device__ __forceinline__ unsigned xb_xcc_id() { return (unsigned)__builtin_amdgcn_s_getreg((3 << 11) | 20) & 0xFu; }
#define XB_SPIN(cond, bar) do { unsigned _sp = 0; while (cond) { __builtin_amdgcn_s_sleep(1); \
    if ((++_sp & 255u) == 0u) { if (xb_ld(&(bar)[XB_TMO])) break; if (_sp > XB_SPIN_CAP) { atomicAdd(&(bar)[XB_TMO], 1u); break; } } } } while (0)

struct XcdBarrier {
    unsigned* bar; unsigned x;
    volatile LAS unsigned* st;
};

__device__ __forceinline__ XcdBarrier xcd_barrier_post(unsigned* bar, volatile LAS unsigned* st) {
    XcdBarrier b; b.bar = bar; b.x = xb_xcc_id(); b.st = st;
    if (threadIdx.x == 0) (void)xb_add(&bar[XB_XCNT(b.x)], 1u);
    return b;
}
__device__ __forceinline__ void xcd_barrier_complete(unsigned* bar, unsigned x, unsigned& nloc, unsigned& nx) {
    const unsigned G = gridDim.x * gridDim.y * gridDim.z;
    unsigned sum, cnt, mine, sp = 0u;
    for (;;) {
        sum = 0u; cnt = 0u; mine = 0u;
#pragma unroll
        for (unsigned j = 0; j < 16; ++j) { const unsigned c = xb_ld(&bar[XB_XCNT(j)]); sum += c; cnt += (c > 0u) ? 1u : 0u; mine = (j == x) ? c : mine; }
        if (sum == G) break;
        __builtin_amdgcn_s_sleep(1);
        if ((++sp & 255u) == 0u) { if (xb_ld(&bar[XB_TMO])) break; if (sp > XB_SPIN_CAP) { atomicAdd(&bar[XB_TMO], 1u); break; } }
    }
    nloc = mine > 0u ? mine : 1u; nx = cnt > 0u ? cnt : 1u;
}

__device__ __forceinline__ void xcd_barrier(const XcdBarrier& b) {
    asm volatile("s_waitcnt vmcnt(0)" ::: "memory");
    __syncthreads();
    if (threadIdx.x == 0) {
        unsigned* bar = b.bar;
        __builtin_amdgcn_s_waitcnt(0);
        unsigned nloc = b.st[0], nx = b.st[1];
        if (nloc == 0u) { xcd_barrier_complete(bar, b.x, nloc, nx); b.st[0] = nloc; b.st[1] = nx; }
        const unsigned old = xb_add(&bar[XB_XSUB(b.x)], 1u);
        const unsigned gen = old / nloc;
        if (old + 1u == (gen + 1u) * nloc) {
            __builtin_amdgcn_fence(__ATOMIC_RELEASE, "agent");
            asm volatile("s_waitcnt vmcnt(0)" ::: "memory");
            const unsigned og = xb_add(&bar[XB_TOP], 1u);
            const unsigned tg = og / nx;
            if (og + 1u == (tg + 1u) * nx) xb_add(&bar[XB_TOPGEN], 1u);
            else XB_SPIN(xb_ld(&bar[XB_TOPGEN]) == tg, bar);
            __builtin_amdgcn_fence(__ATOMIC_ACQUIRE, "agent");
            xb_add(&bar[XB_XGEN(b.x)], 1u);
            asm volatile("s_waitcnt vmcnt(0)" ::: "memory");
        } else {
            XB_SPIN(xb_ld(&bar[XB_XGEN(b.x)]) == gen, bar);
            __builtin_amdgcn_fence(__ATOMIC_ACQUIRE, "agent");
            asm volatile("s_waitcnt vmcnt(0)" ::: "memory");
        }
    }
    __syncthreads();
}
struct Args { const float* in[20]; float* out; unsigned char* ws; int ph_lo, ph_hi; };
enum { K_CVT = 0, K_G0, K_UP, K_RES, K_M1, K_M2A, K_M2B, K_M3, K_M4, K_GF };

__global__ void __launch_bounds__(NTHR, 2) mk_fwd(Args args) {
    extern __shared__ __attribute__((aligned(16))) unsigned char lds_raw[];
    LAS unsigned char* lds = (LAS unsigned char*)lds_raw;
    cg::grid_group grid = cg::this_grid();
    const int hi = args.ph_hi;
    { volatile LAS unsigned* st0 = (volatile LAS unsigned*)(lds + LDS_MISC + 32); if (threadIdx.x < 2) st0[threadIdx.x] = 0u; __syncthreads(); }
    XcdBarrier xbar = xcd_barrier_post((unsigned*)(args.ws + WS_CTL) + CW_BAR, (volatile LAS unsigned*)(lds + LDS_MISC + 32));
    for (int ph = args.ph_lo; ph < hi; ++ph) {
        int bid = blockIdx.x, G = gridDim.x; asm volatile("" : "+s"(bid), "+s"(G));
        int tid = threadIdx.x; asm volatile("" : "+v"(tid));
        const int lane = tid & 63, wave = __builtin_amdgcn_readfirstlane(tid >> 6);
        const int gw = bid * NWAVES + wave, NGW = G * NWAVES;
        int kind, g = 0, l = 0, s = 0;
        if (ph == 0) kind = K_CVT;
        else { const int q = ph - 1; g = q / PH_PER_GROUP; const int r = q % PH_PER_GROUP;
            if (r == 0) kind = K_G0; else if (r == PH_PER_GROUP - 1) kind = K_GF;
            else { l = (r - 1) / 10; s = (r - 1) % 10;
                kind = (s == 0 || s == 8) ? K_UP : (s == 1 || s == 9 || s == 7) ? K_RES : (s == 2) ? K_M1 : (s == 3) ? K_M2A : (s == 4) ? K_M2B : (s == 5) ? K_M3 : K_M4; } }
        unsigned char* ws = args.ws;
        bf16* XB = (bf16*)(ws + WS_XB); float* SSQ = (float*)(ws + WS_SSQ);
        bf16* PA = (bf16*)(ws + WS_PA); bf16* PG = (bf16*)(ws + WS_PG);
        bf16* OHG = (bf16*)(ws + WS_SCR); bf16* OCV = OHG + (size_t)TG * 512; bf16* ONA = (bf16*)(ws + WS_ONA);
        bf16* OD = (bf16*)(ws + WS_OD); unsigned char* SCR = ws + WS_SCR;
        const bf16* Wl = (const bf16*)(ws + WS_W) + (size_t)l * LAYER_EL;
        const int T = g < 2 ? 2048 : 4096;
        float* X = args.out + (size_t)g * TG * D;

        if (kind == K_CVT) {
            LAS float* scr = (LAS float*)(lds + wave * 16384);
            constexpr int I_GU = 16 * 176, I_DN = 44 * 32, I_IN = 16 * 272, I_MX = 8 * 32, I_OUT = 16 * 32;
            constexpr int I_LAYER = 2 * I_GU + 2 * I_DN + I_IN + 3 * I_MX + I_OUT;
            for (int it = gw; it < NLAYER * I_LAYER; it += NGW) {
                const int ll = it / I_LAYER; int r = it % I_LAYER; bf16* Wd = (bf16*)(ws + WS_W) + (size_t)ll * LAYER_EL;
                const float* src; const float* gain = nullptr; int K, N; size_t off; bool perm = false;
                if (r < I_GU) { src = args.in[3] + (size_t)ll * D * 2 * FF; K = D; N = 2 * FF; off = OFF_GU1; gain = args.in[2] + ll * D; perm = true; }
                else if ((r -= I_GU) < I_DN) { src = args.in[4] + (size_t)ll * FF * D; K = FF; N = D; off = OFF_D1; }
                else if ((r -= I_DN) < I_IN) { src = args.in[6] + (size_t)ll * D * 8704; K = D; N = 8704; off = OFF_IN; gain = args.in[5] + ll * D; }
                else if ((r -= I_IN) < I_MX) { src = args.in[9] + (size_t)ll * 512 * D; K = 512; N = D; off = OFF_HG; }
                else if ((r -= I_MX) < I_MX) { src = args.in[12] + (size_t)ll * 512 * D; K = 512; N = D; off = OFF_CV; }
                else if ((r -= I_MX) < I_MX) { src = args.in[14] + (size_t)ll * 512 * D; K = 512; N = D; off = OFF_NA; }
                else if ((r -= I_MX) < I_OUT) { src = args.in[15] + (size_t)ll * D * D; K = D; N = D; off = OFF_OUT; }
                else if ((r -= I_OUT) < I_GU) { src = args.in[17] + (size_t)ll * D * 2 * FF; K = D; N = 2 * FF; off = OFF_GU2; gain = args.in[16] + ll * D; perm = true; }
                else { r -= I_GU; src = args.in[18] + (size_t)ll * FF * D; K = FF; N = D; off = OFF_D2; }
                cvt_item(src, K, N, Wd + off, gain, perm, scr, r, lane);
            }
        } else if (kind == K_G0) {
            const float* xin = (g < 2 ? args.in[0] : args.in[1]) + (size_t)(g & 1) * TG * D;
            for (int row = gw; row < TG; row += NGW) {
                const f32x4* xr = (const f32x4*)(xin + (size_t)row * D) + lane; v2u* bo = (v2u*)(XB + (size_t)row * D) + lane;
                float ss = 0.f;
#pragma unroll
                for (int j = 0; j < 4; ++j) { const f32x4 v = xr[64 * j]; v2u w; w.x = cvt_pk_bf16(v[0], v[1]); w.y = cvt_pk_bf16(v[2], v[3]); bo[64 * j] = w; ss += (v[0] * v[0] + v[1] * v[1]) + (v[2] * v[2] + v[3] * v[3]); }
                ss = wave_sum(ss);
                if (lane < 16) SSQ[(size_t)row * 16 + lane] = lane == 0 ? ss : 0.f;
            }
        } else if (kind == K_UP) {
            pg8::Gemm gm{XB, Wl + (s == 8 ? OFF_GU2 : OFF_GU1), TG, 2 * FF, D}; pg8::StaticOrder S; S.init(TG, 2 * FF, G, bid);
            pg8::EpiSwiGLU E{PA, SSQ};
#ifndef NO_UP
            for (int rep = 0; rep < REP_GEMM; ++rep) pg8::gemm_phase<pg8::EpiSwiGLU, pg8::StaticOrder, true, true>(lds, gm, S, E);
#endif
        } else if (kind == K_RES) {
            const int K = (s == 7) ? D : FF; const size_t off = (s == 7) ? OFF_OUT : (s == 1 ? OFF_D1 : OFF_D2);
            pg8::Gemm gm{PA, Wl + off, TG, D, K}; pg8::StaticOrder S; S.init(TG, D, G, bid);
            pg8::EpiRes E{XB, SSQ, (s == 7) ? 1.0f : 0.5f};
#ifndef NO_RES
            pg8::gemm_phase<pg8::EpiRes, pg8::StaticOrder, true, true>(lds, gm, S, E);
#endif
        } else if (kind == K_M1) {
            pg8::Gemm gm{XB, Wl + OFF_IN, TG, 8704, D}; pg8::StaticOrder S; S.init(TG, 8704, G, bid);
            pg8::EpiProj E{PA, PG, SSQ};
#ifndef NO_PROJ
            for (int rep = 0; rep < REP_GEMM; ++rep) pg8::gemm_phase<pg8::EpiProj, pg8::StaticOrder, true, true>(lds, gm, S, E);
#endif
        } else if (kind == K_M2A) {
#ifndef NO_HG
            { const int nP = (TG / 64) * 8;
              for (int rep = 0; rep < REP_HG; ++rep) for (int it = bid; it < nP; it += G) hg_prep_item(lds, PA, SCR, args.in[7], l, it, T, tid); }
#endif
            const float* rpb = args.in[13] + (size_t)l * 8 * 465;
            const int vcu = (G % 8 == 0) ? (bid % 8) * (G / 8) + bid / 8 : bid;
            const int nNA = TG / 16, ipb = (nNA + G - 1) / G;
            for (int rep = 0; rep < REP_NA; ++rep)
                for (int q = 0; q < ipb; ++q) { const int it = vcu * ipb + q; if (it < nNA) {
#ifndef NO_NA
                    na_item(lds, PA, rpb, ONA, it, T, tid);
#endif
                    __syncthreads(); } }
        } else if (kind == K_M2B) {
#ifndef NO_HG
            for (int rep = 0; rep < REP_HG; ++rep) {
                if (g < 2) { for (int it = bid; it < 256; it += G) hg_scan_item<2>(lds, PA, SCR, OD, it, T, tid); }
                else       { for (int it = bid; it < 256; it += G) hg_scan_item<1>(lds, PA, SCR, OD, it, T, tid); }
            }
#endif
        } else if (kind == K_M3) {
            const float* gno = args.in[8] + l * 512; const float* cw = args.in[10] + l * 3 * 512; const float* cbias = args.in[11] + l * 512;
            const int c0 = lane * 8;
            for (int rep = 0; rep < REP_M3; ++rep) for (int row = gw; row < TG; row += NGW) {
                const v4u fw = *(const v4u*)(OD + (size_t)row * 512 + c0), bw = *(const v4u*)(OD + (size_t)TG * 512 + (size_t)row * 512 + c0);
                float o[8] = {bflo(fw.x) + bflo(bw.x), bfhi(fw.x) + bfhi(bw.x), bflo(fw.y) + bflo(bw.y), bfhi(fw.y) + bfhi(bw.y), bflo(fw.z) + bflo(bw.z), bfhi(fw.z) + bfhi(bw.z), bflo(fw.w) + bflo(bw.w), bfhi(fw.w) + bfhi(bw.w)};
                float ss = 0.f;
#pragma unroll
                for (int e = 0; e < 8; ++e) ss += o[e] * o[e];
                ss += __shfl_xor(ss, 1); ss += __shfl_xor(ss, 2); ss += __shfl_xor(ss, 4); ss += __shfl_xor(ss, 8);
                const float rs = __builtin_amdgcn_rsqf(ss * (1.0f / 128.0f) + 1e-6f);
                const bf16* prow = PA + (size_t)row * PA_LD;
                const v4u hgw = *(const v4u*)(prow + C_HG + c0);
                const float hgv[8] = {bflo(hgw.x), bfhi(hgw.x), bflo(hgw.y), bfhi(hgw.y), bflo(hgw.z), bfhi(hgw.z), bflo(hgw.w), bfhi(hgw.w)};
                const f32x4 gn0 = *(const f32x4*)(gno + c0), gn1 = *(const f32x4*)(gno + c0 + 4);
                const float gn[8] = {gn0[0], gn0[1], gn0[2], gn0[3], gn1[0], gn1[1], gn1[2], gn1[3]};
                float r8[8];
#pragma unroll
                for (int e = 0; e < 8; ++e) r8[e] = o[e] * rs * gn[e] * (hgv[e] * sigm(hgv[e]));
                v4u wo; wo.x = cvt_pk_bf16(r8[0], r8[1]); wo.y = cvt_pk_bf16(r8[2], r8[3]); wo.z = cvt_pk_bf16(r8[4], r8[5]); wo.w = cvt_pk_bf16(r8[6], r8[7]);
                *(v4u*)(OHG + (size_t)row * 512 + c0) = wo;
                const int tl = row & (T - 1);
                const v4u a1 = *(const v4u*)(prow + C_CA + c0), c1 = *(const v4u*)(prow + C_CC + c0), bb = *(const v4u*)(prow + C_CB + c0);
                v4u a0 = {0u, 0u, 0u, 0u}, cc0 = a0, a2 = a0, cc2 = a0;
                if (tl > 0) { a0 = *(const v4u*)(prow - PA_LD + C_CA + c0); cc0 = *(const v4u*)(prow - PA_LD + C_CC + c0); }
                if (tl < T - 1) { a2 = *(const v4u*)(prow + PA_LD + C_CA + c0); cc2 = *(const v4u*)(prow + PA_LD + C_CC + c0); }
                const float zm[8] = {bflo(a0.x) * bflo(cc0.x), bfhi(a0.x) * bfhi(cc0.x), bflo(a0.y) * bflo(cc0.y), bfhi(a0.y) * bfhi(cc0.y), bflo(a0.z) * bflo(cc0.z), bfhi(a0.z) * bfhi(cc0.z), bflo(a0.w) * bflo(cc0.w), bfhi(a0.w) * bfhi(cc0.w)};
                const float zc[8] = {bflo(a1.x) * bflo(c1.x), bfhi(a1.x) * bfhi(c1.x), bflo(a1.y) * bflo(c1.y), bfhi(a1.y) * bfhi(c1.y), bflo(a1.z) * bflo(c1.z), bfhi(a1.z) * bfhi(c1.z), bflo(a1.w) * bflo(c1.w), bfhi(a1.w) * bfhi(c1.w)};
                const float zp[8] = {bflo(a2.x) * bflo(cc2.x), bfhi(a2.x) * bfhi(cc2.x), bflo(a2.y) * bflo(cc2.y), bfhi(a2.y) * bfhi(cc2.y), bflo(a2.z) * bflo(cc2.z), bfhi(a2.z) * bfhi(cc2.z), bflo(a2.w) * bflo(cc2.w), bfhi(a2.w) * bfhi(cc2.w)};
                const float cbv[8] = {bflo(bb.x), bfhi(bb.x), bflo(bb.y), bfhi(bb.y), bflo(bb.z), bfhi(bb.z), bflo(bb.w), bfhi(bb.w)};
                const f32x4 w00 = *(const f32x4*)(cw + c0), w01 = *(const f32x4*)(cw + c0 + 4), w10 = *(const f32x4*)(cw + 512 + c0), w11 = *(const f32x4*)(cw + 512 + c0 + 4);
                const f32x4 w20 = *(const f32x4*)(cw + 1024 + c0), w21 = *(const f32x4*)(cw + 1024 + c0 + 4), bs0 = *(const f32x4*)(cbias + c0), bs1 = *(const f32x4*)(cbias + c0 + 4);
#pragma unroll
                for (int e = 0; e < 4; ++e) { r8[e] = cbv[e] * (w00[e] * zm[e] + w10[e] * zc[e] + w20[e] * zp[e] + bs0[e]); r8[4 + e] = cbv[4 + e] * (w01[e] * zm[4 + e] + w11[e] * zc[4 + e] + w21[e] * zp[4 + e] + bs1[e]); }
                wo.x = cvt_pk_bf16(r8[0], r8[1]); wo.y = cvt_pk_bf16(r8[2], r8[3]); wo.z = cvt_pk_bf16(r8[4], r8[5]); wo.w = cvt_pk_bf16(r8[6], r8[7]);
                *(v4u*)(OCV + (size_t)row * 512 + c0) = wo;
            }
        } else if (kind == K_M4) {
            pg8::StaticOrder S; S.init(TG, D, G, bid);
            { pg8::Gemm gm{OHG, Wl + OFF_HG, TG, D, 512}; pg8::EpiMerge<0> E{PG, PA};
#ifndef NO_MERGE
            pg8::gemm_phase<pg8::EpiMerge<0>, pg8::StaticOrder, true, true>(lds, gm, S, E);
#endif
            }
            { pg8::Gemm gm{OCV, Wl + OFF_CV, TG, D, 512}; pg8::EpiMerge<1> E{PG, PA};
#ifndef NO_MERGE
            pg8::gemm_phase<pg8::EpiMerge<1>, pg8::StaticOrder, true, true>(lds, gm, S, E);
#endif
            }
            { pg8::Gemm gm{ONA, Wl + OFF_NA, TG, D, 512}; pg8::EpiMerge<2> E{PG, PA};
#ifndef NO_MERGE
            pg8::gemm_phase<pg8::EpiMerge<2>, pg8::StaticOrder, true, true>(lds, gm, S, E);
#endif
            }
        } else {
            const f32x4* fg = (const f32x4*)args.in[19] + lane;
            for (int row = gw; row < TG; row += NGW) {
                const float rs = pg8::row_rs(SSQ, row);
                f32x4* xo = (f32x4*)(X + (size_t)row * D) + lane; const v2u* bi = (const v2u*)(XB + (size_t)row * D) + lane;
#pragma unroll
                for (int j = 0; j < 4; ++j) { const v2u w = bi[64 * j]; const f32x4 v = {bflo(w.x), bfhi(w.x), bflo(w.y), bfhi(w.y)}; xo[64 * j] = v * fg[64 * j] * rs; }
            }
        }
        if (ph + 1 < hi) { for (int rep = 0; rep < REP_SYNC; ++rep) { if (ph == 0) grid.sync(); else xcd_barrier(xbar); } }
    }
}
constexpr int N_PHASES = 1 + NGROUP * PH_PER_GROUP;

extern "C" void kernel_launch(void* const* d_in, const int* in_sizes, int n_in, void* d_out, int out_size, void* d_ws, size_t ws_size, hipStream_t stream) {
    static int grid = 0;
    if (grid == 0) {
        if (n_in != 20 || ws_size < WS_END) { fprintf(stderr, "kernel_launch: unexpected n_in %d / ws %zu\n", n_in, ws_size); grid = -1; return; }
        int dev = 0, cus = 0, per_cu = 0;
        hipGetDevice(&dev); hipDeviceGetAttribute(&cus, hipDeviceAttributeMultiprocessorCount, dev);
        hipFuncSetAttribute((const void*)mk_fwd, hipFuncAttributeMaxDynamicSharedMemorySize, LDS_BYTES);
        hipOccupancyMaxActiveBlocksPerMultiprocessor(&per_cu, (const void*)mk_fwd, NTHR, LDS_BYTES);
        if (per_cu < 1) per_cu = 1;
        grid = cus * per_cu;
        (void)hipGetLastError();
    }
    if (grid < 0) return;
    hipMemsetAsync((char*)d_ws + WS_CTL, 0, CTL_BYTES, stream);
    Args a{};
    for (int i = 0; i < 20; ++i) a.in[i] = (const float*)d_in[i];
    a.out = (float*)d_out; a.ws = (unsigned char*)d_ws;
#if ONE_LAUNCH
    a.ph_lo = 0; a.ph_hi = N_PHASES;
    void* kargs[] = {&a};
    hipError_t e = hipLaunchCooperativeKernel((const void*)mk_fwd, dim3(grid), dim3(NTHR), kargs, LDS_BYTES, stream);
    if (e != hipSuccess) fprintf(stderr, "cooperative launch failed: %s (grid %d)\n", hipGetErrorString(e), grid);
#else
    for (int p = 0; p < N_PHASES; ++p) { a.ph_lo = p; a.ph_hi = p + 1; hipLaunchKernelGGL(mk_fwd, dim3(grid), dim3(NTHR), LDS_BYTES, stream, a); }
#endif
}
```

```cpp
#include <hip/hip_runtime.h>
#include <hip/hip_cooperative_groups.h>
#include <cstdio>
#include <cstdint>
namespace cg = cooperative_groups;
#ifndef ONE_LAUNCH
#define ONE_LAUNCH 1
#endif
#ifndef REP_HG
#define REP_HG 1
#endif
#ifndef REP_NA
#define REP_NA 1
#endif
#ifndef REP_SYNC
#define REP_SYNC 1
#endif
#ifndef REP_GEMM
#define REP_GEMM 1
#endif
#ifndef REP_M3
#define REP_M3 1
#endif
namespace pg8 {
#define PG8_LAS __attribute__((address_space(3)))
typedef unsigned short bf16_t;
typedef short bf16x8 __attribute__((ext_vector_type(8)));
typedef float f32x4 __attribute__((ext_vector_type(4)));
typedef unsigned u32x4 __attribute__((ext_vector_type(4)));
constexpr int BM = 256, BK = 64, HALF = 128, HTB = HALF * BK * 2  , STAGE_BYTES = 8 * HTB, NXCD = 8, WGM = 8;

__host__ __device__ __forceinline__ int lds_byte(int r, int c) { const int st = (r >> 4) * 2 + (c >> 5), rr = r & 15, cc = c & 31, ob = rr * 64 + cc * 2; return st * 1024 + (ob ^ (((ob >> 9) & 1) << 5)); }
__host__ __device__ __forceinline__ void stage_rc(int b, int& R, int& C) { const int st = b / 1024, sb = b % 1024, swz = sb ^ (((sb >> 9) & 1) << 5); R = (st >> 1) * 16 + swz / 64; C = (st & 1) * 32 + (swz % 64) / 2; }
__host__ __device__ __forceinline__ int perm32(int rho) { const int n = rho >> 4, i = rho & 15; return 8 * (i >> 2) + 4 * n + (i & 3); }

struct Unit { int pm, pn; };
struct Gemm { const bf16_t* A; const bf16_t* Bt; int M, N, K; };

struct StaticOrder {
    int nM, nN, nwg, G, c;
    __host__ __device__ void init(int M, int N, int G_, int c_) { nM = M / BM; nN = N / BM; nwg = nM * nN; G = G_; c = c_; }
    __host__ __device__ bool next(int i, Unit& u) const {
        const long L = (long)i * G + c; if (L >= nwg) return false;
        int wgid = (int)L; { const int q = nwg / NXCD, r = nwg % NXCD, xcd = wgid % NXCD, off = wgid / NXCD; wgid = (xcd < r ? xcd * (q + 1) : r * (q + 1) + (xcd - r) * q) + off; }
        const int nig = WGM * nN, gid = wgid / nig, fm = gid * WGM, gsz = (nM - fm) < WGM ? (nM - fm) : WGM;
        u.pm = fm + ((wgid % nig) % gsz); u.pn = (wgid % nig) / gsz; return true;
    }
    __device__ __forceinline__ void a_ready(const Unit&) const {}
    __device__ __forceinline__ void done(const Unit&) const {}
};

__device__ __forceinline__ unsigned cvt_pk_bf16(float lo, float hi) { unsigned r; asm volatile("v_cvt_pk_bf16_f32 %0, %1, %2" : "=v"(r) : "v"(lo), "v"(hi)); return r; }
__device__ __forceinline__ float row_rs(const float* ssq, int row) {
    const f32x4* p = (const f32x4*)(ssq + (size_t)row * 16);
    const f32x4 a = p[0], b = p[1], c = p[2], d = p[3];
    const float s = (((a[0] + a[1]) + (a[2] + a[3])) + ((b[0] + b[1]) + (b[2] + b[3]))) + (((c[0] + c[1]) + (c[2] + c[3])) + ((d[0] + d[1]) + (d[2] + d[3])));
    return __builtin_amdgcn_rsqf(s * (1.0f / 1024.0f) + 1e-6f);
}
__device__ __forceinline__ float sigm(float v) { return __builtin_amdgcn_rcpf(1.0f + __expf(-v)); }

struct EpiSwiGLU {
    static constexpr bool PERM = true, AFTER_DRAIN = false;
    bf16_t* H; const float* ssq;
    __device__ __forceinline__ void operator()(const f32x4 (&acc)[2][2][4][2], const Unit& u, int wr, int wc, int fr, int fq) const {
        const int row0 = u.pm * BM + wr * 64 + fr, col0 = u.pn * 128 + wc * 32 + 8 * fq;
#pragma unroll
        for (int ai = 0; ai < 2; ++ai)
#pragma unroll
            for (int m = 0; m < 4; ++m) {
                const int row = row0 + ai * HALF + m * 16; const float rs = row_rs(ssq, row);
                u32x4 w;
#pragma unroll
                for (int n = 0; n < 2; ++n) {
                    const f32x4 a = acc[ai][0][m][n] * rs, b = acc[ai][1][m][n] * rs; f32x4 h;
#pragma unroll
                    for (int e = 0; e < 4; ++e) h[e] = a[e] * sigm(a[e]) * b[e];
                    w[2 * n] = cvt_pk_bf16(h[0], h[1]); w[2 * n + 1] = cvt_pk_bf16(h[2], h[3]);
                }
                *(u32x4*)(H + (size_t)row * 2816 + col0) = w;
                asm volatile("" ::: "memory");
            }
    }
};
__device__ __forceinline__ void unpack8(const u32x4 w, f32x4& lo, f32x4& hi) {
    lo[0] = __uint_as_float(w.x << 16); lo[1] = __uint_as_float(w.x & 0xffff0000u); lo[2] = __uint_as_float(w.y << 16); lo[3] = __uint_as_float(w.y & 0xffff0000u);
    hi[0] = __uint_as_float(w.z << 16); hi[1] = __uint_as_float(w.z & 0xffff0000u); hi[2] = __uint_as_float(w.w << 16); hi[3] = __uint_as_float(w.w & 0xffff0000u);
}
struct EpiRes {
    static constexpr bool PERM = true, AFTER_DRAIN = false;
    bf16_t* XB; float* ssq; float alpha;
    __device__ __forceinline__ void operator()(const f32x4 (&acc)[2][2][4][2], const Unit& u, int wr, int wc, int fr, int fq) const {
        const int row0 = u.pm * BM + wr * 64 + fr, col0 = u.pn * BM + wc * 32 + 8 * fq;
#pragma unroll
        for (int ai = 0; ai < 2; ++ai)
#pragma unroll
            for (int m = 0; m < 4; ++m) {
                const int row = row0 + ai * HALF + m * 16; float ss = 0.f;
#pragma unroll
                for (int bj = 0; bj < 2; ++bj) {
                    bf16_t* xp = XB + (size_t)row * 1024 + col0 + bj * HALF;
                    f32x4 x0, x1; unpack8(*(const u32x4*)xp, x0, x1);
                    x0 = x0 + acc[ai][bj][m][0] * alpha; x1 = x1 + acc[ai][bj][m][1] * alpha;
                    u32x4 w; w.x = cvt_pk_bf16(x0[0], x0[1]); w.y = cvt_pk_bf16(x0[2], x0[3]); w.z = cvt_pk_bf16(x1[0], x1[1]); w.w = cvt_pk_bf16(x1[2], x1[3]);
                    *(u32x4*)xp = w;
                    ss += ((x0[0] * x0[0] + x0[1] * x0[1]) + (x0[2] * x0[2] + x0[3] * x0[3])) + ((x1[0] * x1[0] + x1[1] * x1[1]) + (x1[2] * x1[2] + x1[3] * x1[3]));
                }
                ss += __shfl_xor(ss, 16); ss += __shfl_xor(ss, 32);
                if (fq == 0) ssq[(size_t)row * 16 + u.pn * 4 + wc] = ss;
                asm volatile("" ::: "memory");
            }
    }
};
struct EpiProj {
    static constexpr bool PERM = true, AFTER_DRAIN = false;
    bf16_t* PA; bf16_t* PG; const float* ssq;
    __device__ __forceinline__ void operator()(const f32x4 (&acc)[2][2][4][2], const Unit& u, int wr, int wc, int fr, int fq) const {
        const int row0 = u.pm * BM + wr * 64 + fr;
        bf16_t* base; int ld, colt;
        if (u.pn < 22) { base = PA; ld = 5632; colt = u.pn * BM; } else { base = PG; ld = 3072; colt = (u.pn - 22) * BM; }
        const int col0 = colt + wc * 32 + 8 * fq;
#pragma unroll
        for (int ai = 0; ai < 2; ++ai)
#pragma unroll
            for (int m = 0; m < 4; ++m) {
                const int row = row0 + ai * HALF + m * 16; const float rs = row_rs(ssq, row);
#pragma unroll
                for (int bj = 0; bj < 2; ++bj) {
                    const f32x4 v0 = acc[ai][bj][m][0] * rs, v1 = acc[ai][bj][m][1] * rs;
                    u32x4 w; w.x = cvt_pk_bf16(v0[0], v0[1]); w.y = cvt_pk_bf16(v0[2], v0[3]); w.z = cvt_pk_bf16(v1[0], v1[1]); w.w = cvt_pk_bf16(v1[2], v1[3]);
                    *(u32x4*)(base + (size_t)row * ld + col0 + bj * HALF) = w;
                }
                asm volatile("" ::: "memory");
            }
    }
};
struct MergeOrder {
    StaticOrder so;
    __device__ void init(int M, int N, int G_, int c_) { so.init(M, N, G_, c_); }
    __device__ bool next(int i, Unit& u) const { Unit b; if (!so.next(i / 3, b)) return false; const int m = i % 3, w = (m == 0) ? 2 : m - 1; u.pm = b.pm + 64 * m; u.pn = b.pn + 4 * w; return true; }
    __device__ __forceinline__ void a_ready(const Unit&) const {}
    __device__ __forceinline__ void done(const Unit&) const {}
};
struct EpiMerge {
    static constexpr bool PERM = true, AFTER_DRAIN = false;
    const bf16_t* PG; bf16_t* MB;
    __device__ __forceinline__ void operator()(const f32x4 (&acc)[2][2][4][2], const Unit& u, int wr, int wc, int fr, int fq) const {
        const int m_ = u.pm >> 6, pm = u.pm & 63, w_ = u.pn >> 2, pn = u.pn & 3;
        const int row0 = pm * BM + wr * 64 + fr, col0 = pn * BM + wc * 32 + 8 * fq;
#pragma unroll
        for (int ai = 0; ai < 2; ++ai)
#pragma unroll
            for (int m = 0; m < 4; ++m) {
                const int row = row0 + ai * HALF + m * 16;
#pragma unroll
                for (int bj = 0; bj < 2; ++bj) {
                    const int col = col0 + bj * HALF;
                    f32x4 g0, g1; unpack8(*(const u32x4*)(PG + (size_t)row * 3072 + w_ * 1024 + col), g0, g1);
                    f32x4 t0, t1;
#pragma unroll
                    for (int e = 0; e < 4; ++e) { t0[e] = sigm(g0[e]) * acc[ai][bj][m][0][e]; t1[e] = sigm(g1[e]) * acc[ai][bj][m][1][e]; }
                    bf16_t* mp = MB + (size_t)row * 1024 + col;
                    if (m_ > 0) { f32x4 p0, p1; unpack8(*(const u32x4*)mp, p0, p1); t0 = t0 + p0; t1 = t1 + p1; }
                    u32x4 w; w.x = cvt_pk_bf16(t0[0], t0[1]); w.y = cvt_pk_bf16(t0[2], t0[3]); w.z = cvt_pk_bf16(t1[0], t1[1]); w.w = cvt_pk_bf16(t1[2], t1[3]);
                    *(u32x4*)mp = w;
                }
                asm volatile("" ::: "memory");
            }
    }
};
template <class Epi, class Sched, bool ALIGN_EPI = false, bool SP2 = false>
__device__ __forceinline__ void gemm_phase(PG8_LAS unsigned char* lds, const Gemm g, const Sched& S, const Epi& E) {
    int tid = threadIdx.x; asm volatile("" : "+v"(tid));
    const int wid = __builtin_amdgcn_readfirstlane(tid >> 6), lane = tid & 63, wr = wid >> 2, wc = wid & 3, fr = lane & 15, fq = lane >> 4;
    const int K = g.K, nt = K / BK;
    unsigned voffA[2], voffB[2];
#pragma unroll
    for (int i = 0; i < 2; ++i) { int R, C; stage_rc(tid * 16 + i * 8192, R, C); const int Rb = Epi::PERM ? ((R & ~31) + perm32(R & 31)) : R;
        voffA[i] = (unsigned)(R * K + C) * 2u; voffB[i] = (unsigned)(Rb * K + C) * 2u; }
    const size_t kstep = (size_t)(BK * 2);
    const size_t hstep = (size_t)HALF * K * 2;
    const size_t tstep = 2 * hstep;
    const unsigned ldsw = (unsigned)wid * 1024u;
    const int aoff = lds_byte(wr * 64 + fr, fq * 8), boff = lds_byte(wc * 32 + fr, fq * 8);
#define PG8_SA(b, h) (((b) * 2 + (h)) * HTB)
#define PG8_SB(b, h) ((4 + (b) * 2 + (h)) * HTB)
#define PG8_STAGE(bufoff, gbase, voff) do { _Pragma("unroll") for (int _i = 0; _i < 2; ++_i) \
        __builtin_amdgcn_global_load_lds((const unsigned*)((const char*)(gbase) + (voff)[_i]), (PG8_LAS unsigned*)(lds + (bufoff) + ldsw + _i * 8192), 16, 0, 0); } while (0)
#define PG8_LDA(dst, b, h) do { _Pragma("unroll") for (int m = 0; m < 4; ++m) _Pragma("unroll") for (int k = 0; k < 2; ++k) dst[m][k] = *(const PG8_LAS bf16x8*)(lds + PG8_SA(b, h) + aoff + m * 2048 + k * 1024); } while (0)
#define PG8_LDB(dst, b, h) do { _Pragma("unroll") for (int n = 0; n < 2; ++n) _Pragma("unroll") for (int k = 0; k < 2; ++k) dst[n][k] = *(const PG8_LAS bf16x8*)(lds + PG8_SB(b, h) + boff + n * 2048 + k * 1024); } while (0)
#define PG8_MMA(ai, bj, At, Bt) do { __builtin_amdgcn_s_setprio(1); _Pragma("unroll") for (int m = 0; m < 4; ++m) _Pragma("unroll") for (int n = 0; n < 2; ++n) _Pragma("unroll") for (int k = 0; k < 2; ++k) \
        acc[ai][bj][m][n] = __builtin_amdgcn_mfma_f32_16x16x32_bf16(Bt[n][k], At[m][k], acc[ai][bj][m][n], 0, 0, 0); __builtin_amdgcn_s_setprio(0); } while (0)
#define PG8_WAIT_V(n) asm volatile("s_waitcnt vmcnt(" #n ")" ::: "memory")
#define PG8_WAIT_L(n) asm volatile("s_waitcnt lgkmcnt(" #n ")" ::: "memory")
#define PG8_BAR __builtin_amdgcn_s_barrier()
#define PG8_SCHED __builtin_amdgcn_sched_barrier(0)
    Unit cur, nxt; int ui = 0;
    if (!S.next(0, cur)) return;
    f32x4 acc[2][2][4][2];
#pragma unroll
    for (int a = 0; a < 2; ++a)
#pragma unroll
        for (int b = 0; b < 2; ++b)
#pragma unroll
            for (int m = 0; m < 4; ++m)
#pragma unroll
                for (int n = 0; n < 2; ++n) acc[a][b][m][n] = (f32x4){0.f, 0.f, 0.f, 0.f};
    bf16x8 At[4][2], B0[2][2], B1[2][2];
    const char* cA = (const char*)g.A + (size_t)cur.pm * tstep; const char* cB = (const char*)g.Bt + (size_t)cur.pn * tstep;
    S.a_ready(cur);
    if constexpr (SP2) {
        PG8_STAGE(PG8_SB(0, 0), cB, voffB); PG8_STAGE(PG8_SB(0, 1), cB + hstep, voffB); PG8_STAGE(PG8_SA(0, 0), cA, voffA); PG8_STAGE(PG8_SA(0, 1), cA + hstep, voffA);
        if (wr == 1) PG8_BAR;
        PG8_WAIT_V(2); PG8_BAR;
        PG8_STAGE(PG8_SB(1, 0), cB + kstep, voffB); PG8_STAGE(PG8_SA(1, 0), cA + kstep, voffA); PG8_STAGE(PG8_SB(1, 1), cB + hstep + kstep, voffB);
        PG8_WAIT_V(6); PG8_BAR;
    } else {
        PG8_STAGE(PG8_SB(0, 0), cB, voffB); PG8_STAGE(PG8_SA(0, 0), cA, voffA); PG8_STAGE(PG8_SB(0, 1), cB + hstep, voffB); PG8_STAGE(PG8_SA(0, 1), cA + hstep, voffA);
        if (wr == 1) PG8_BAR;
        PG8_WAIT_V(4); PG8_BAR;
        PG8_STAGE(PG8_SB(1, 0), cB + kstep, voffB); PG8_STAGE(PG8_SA(1, 0), cA + kstep, voffA); PG8_STAGE(PG8_SB(1, 1), cB + hstep + kstep, voffB);
        PG8_WAIT_V(6); PG8_BAR;
    }
    for (;;) {
        const bool has_next = S.next(ui + 1, nxt);
        const char* nA = has_next ? (const char*)g.A + (size_t)nxt.pm * tstep : cA; const char* nB = has_next ? (const char*)g.Bt + (size_t)nxt.pn * tstep : cB;
        for (int t = 0; t < nt; t += 2) {
            const bool last = (t == nt - 2);
            const char* a1 = cA + (size_t)(t + 1) * kstep;
            const char* a2 = last ? nA : cA + (size_t)(t + 2) * kstep; const char* b2 = last ? nB : cB + (size_t)(t + 2) * kstep;
            const char* a3 = a2 + kstep; const char* b3 = b2 + kstep;
            if (last && has_next) S.a_ready(nxt);
            if constexpr (SP2) {
            PG8_LDB(B0, 0, 0); PG8_LDB(B1, 0, 1); PG8_SCHED; PG8_LDA(At, 0, 0); PG8_STAGE(PG8_SA(1, 1), a1 + hstep, voffA);
            PG8_WAIT_V(8); PG8_WAIT_L(0); PG8_BAR; PG8_MMA(0, 0, At, B0); PG8_MMA(0, 1, At, B1); PG8_BAR; PG8_SCHED;
            PG8_LDA(At, 0, 1); PG8_STAGE(PG8_SB(0, 0), b2, voffB); PG8_STAGE(PG8_SB(0, 1), b2 + hstep, voffB); PG8_STAGE(PG8_SA(0, 0), a2, voffA);
            PG8_WAIT_V(8); PG8_WAIT_L(0); PG8_BAR; PG8_MMA(1, 0, At, B0); PG8_MMA(1, 1, At, B1); PG8_BAR; PG8_SCHED;
            PG8_LDB(B0, 1, 0); PG8_LDB(B1, 1, 1); PG8_SCHED; PG8_LDA(At, 1, 0); PG8_STAGE(PG8_SA(0, 1), a2 + hstep, voffA);
            PG8_WAIT_V(8); PG8_WAIT_L(0); PG8_BAR; PG8_MMA(0, 0, At, B0); PG8_MMA(0, 1, At, B1); PG8_BAR; PG8_SCHED;
            PG8_LDA(At, 1, 1); PG8_STAGE(PG8_SB(1, 0), b3, voffB); PG8_STAGE(PG8_SB(1, 1), b3 + hstep, voffB); PG8_STAGE(PG8_SA(1, 0), a3, voffA);
            PG8_WAIT_V(8); PG8_WAIT_L(0); PG8_BAR; PG8_MMA(1, 0, At, B0); PG8_MMA(1, 1, At, B1); PG8_BAR; PG8_SCHED;
            } else {
            PG8_LDB(B0, 0, 0); PG8_SCHED; PG8_LDA(At, 0, 0); PG8_STAGE(PG8_SA(1, 1), a1 + hstep, voffA);
            PG8_WAIT_L(8); PG8_BAR; PG8_WAIT_L(0); PG8_MMA(0, 0, At, B0); PG8_BAR; PG8_SCHED;
            PG8_LDB(B1, 0, 1); PG8_STAGE(PG8_SB(0, 0), b2, voffB);
            PG8_BAR; PG8_WAIT_L(0); PG8_MMA(0, 1, At, B1); PG8_BAR;
            PG8_LDA(At, 0, 1); PG8_STAGE(PG8_SA(0, 0), a2, voffA);
            PG8_BAR; PG8_WAIT_L(0); PG8_MMA(1, 0, At, B0); PG8_BAR; PG8_SCHED;
            PG8_STAGE(PG8_SB(0, 1), b2 + hstep, voffB);
            PG8_WAIT_V(6); PG8_BAR; PG8_MMA(1, 1, At, B1); PG8_BAR;
            PG8_LDB(B0, 1, 0); PG8_SCHED; PG8_LDA(At, 1, 0); PG8_STAGE(PG8_SA(0, 1), a2 + hstep, voffA);
            PG8_WAIT_L(8); PG8_BAR; PG8_WAIT_L(0); PG8_MMA(0, 0, At, B0); PG8_BAR; PG8_SCHED;
            PG8_LDB(B1, 1, 1); PG8_STAGE(PG8_SB(1, 0), b3, voffB);
            PG8_BAR; PG8_WAIT_L(0); PG8_MMA(0, 1, At, B1); PG8_BAR;
            PG8_LDA(At, 1, 1); PG8_STAGE(PG8_SA(1, 0), a3, voffA);
            PG8_BAR; PG8_WAIT_L(0); PG8_MMA(1, 0, At, B0); PG8_BAR; PG8_SCHED;
            PG8_STAGE(PG8_SB(1, 1), b3 + hstep, voffB);
            PG8_WAIT_V(6); PG8_BAR; PG8_MMA(1, 1, At, B1); PG8_BAR;
            }
        }
        if constexpr (ALIGN_EPI) { if (wr == 0) PG8_BAR; }
        if constexpr (!Epi::AFTER_DRAIN) { E(acc, cur, wr, wc, fr, fq); S.done(cur); }
        if (!has_next) break;
#pragma unroll
        for (int a = 0; a < 2; ++a)
#pragma unroll
            for (int b = 0; b < 2; ++b)
#pragma unroll
                for (int m = 0; m < 4; ++m)
#pragma unroll
                    for (int n = 0; n < 2; ++n) acc[a][b][m][n] = (f32x4){0.f, 0.f, 0.f, 0.f};
        cur = nxt; cA = nA; cB = nB; ++ui;
        if constexpr (ALIGN_EPI) { if (wr == 1) PG8_BAR; }
    }
    PG8_WAIT_V(0);
    if constexpr (!ALIGN_EPI) { if (wr == 0) PG8_BAR; }
    PG8_BAR;
    if constexpr (Epi::AFTER_DRAIN) { E.fused(acc, cur, wr, wc, fr, fq, lds, wid, lane); S.done(cur); }
#undef PG8_SA
#undef PG8_SB
#undef PG8_STAGE
#undef PG8_LDA
#undef PG8_LDB
#undef PG8_MMA
#undef PG8_WAIT_V
#undef PG8_WAIT_L
#undef PG8_BAR
#undef PG8_SCHED
}
}
#define LAS __attribute__((address_space(3)))
typedef unsigned short bf16;
typedef unsigned v4u __attribute__((ext_vector_type(4)));
typedef unsigned v2u __attribute__((ext_vector_type(2)));
typedef short v4i16_t __attribute__((ext_vector_type(4)));
using pg8::f32x4; using pg8::bf16x8; using pg8::cvt_pk_bf16;

constexpr int D = 1024, FF = 2816, NLAYER = 4, TG = 16384, NGROUP = 4, NTHR = 512, NWAVES = 8;
constexpr int PA_LD = 5632, PG_LD = 3072;
constexpr int C_HQ = 0, C_HI = 512, C_HZF = 1024, C_HZB = 1536, C_HG = 2048, C_CA = 2560, C_CB = 3072, C_CC = 3584, C_NQ = 4096, C_NK = 4608, C_NV = 5120;
constexpr size_t MiB = 1u << 20;
constexpr size_t WS_CTL = 0, CTL_BYTES = 1 * MiB, WS_W = 1 * MiB, WS_XB = 221 * MiB, WS_SSQ = 285 * MiB, WS_PA = 287 * MiB, WS_PG = 463 * MiB, WS_ONA = 559 * MiB, WS_SCR = 575 * MiB, WS_END = 665 * MiB;
constexpr size_t OFF_GU1 = 0, OFF_D1 = 5767168, OFF_IN = 8650752, OFF_HG = 17563648, OFF_CV = 18087936, OFF_NA = 18612224, OFF_OUT = 19136512, OFF_GU2 = 20185088, OFF_D2 = 25952256, LAYER_EL = 28835840;
constexpr int LDS_BYTES = 147456, LDS_MISC = 147456 - 64;
constexpr int PH_PER_PAIR = 1 + NLAYER * 16 + 1;
constexpr int CW_BAR = 4096;

__device__ __forceinline__ unsigned f2bf(float f) { unsigned u = __float_as_uint(f); return (u + 0x7fffu + ((u >> 16) & 1u)) >> 16; }
__device__ __forceinline__ float bf2f(unsigned b) { return __uint_as_float(b << 16); }
__device__ __forceinline__ float bflo(unsigned w) { return __uint_as_float(w << 16); }
__device__ __forceinline__ float bfhi(unsigned w) { return __uint_as_float(w & 0xffff0000u); }
__device__ __forceinline__ float sigm(float v) { return __builtin_amdgcn_rcpf(1.0f + __expf(-v)); }
__device__ __forceinline__ float wave_sum(float v) {
#pragma unroll
    for (int o = 1; o < 64; o <<= 1) v += __shfl_xor(v, o);
    return v;
}

__device__ __forceinline__ void cvt_item(const float* W, int K, int N, bf16* WT, const float* gain, bool permgu, LAS float* scr, int item, int lane) {
    const int nblk = N / 32, kb = item / nblk, nb = item % nblk, k0 = 64 * kb, n0 = 32 * nb;
#pragma unroll 8
    for (int i = 0; i < 32; ++i) { const int kk = 2 * i + (lane >> 5); const float g = gain ? gain[k0 + kk] : 1.0f; scr[kk * 33 + (lane & 31)] = W[(size_t)(k0 + kk) * N + n0 + (lane & 31)] * g; }
    asm volatile("s_waitcnt lgkmcnt(0)" ::: "memory");
    int dn0 = n0;
    if (permgu) { const int half = n0 >= FF ? 1 : 0; const int j = n0 - half * FF; dn0 = (j >> 7) * 256 + half * 128 + (j & 127); }
    const int c = lane & 7;
#pragma unroll
    for (int j = 0; j < 4; ++j) { const int n = (lane >> 3) + 8 * j; const LAS float* s = scr + (8 * c) * 33 + n;
        v4u o; o.x = cvt_pk_bf16(s[0 * 33], s[1 * 33]); o.y = cvt_pk_bf16(s[2 * 33], s[3 * 33]); o.z = cvt_pk_bf16(s[4 * 33], s[5 * 33]); o.w = cvt_pk_bf16(s[6 * 33], s[7 * 33]);
        *(v4u*)(WT + (size_t)(dn0 + n) * K + k0 + 8 * c) = o; }
    asm volatile("s_waitcnt lgkmcnt(0)" ::: "memory");
}

template <int K> __device__ __forceinline__ f32x4 mma_lds(f32x4 acc, const LAS bf16* A, int pa, const LAS bf16* B, int pb, int lane) {
    const int r = lane & 15, q = lane >> 4;
#pragma unroll
    for (int ks = 0; ks < K / 32; ++ks) {
        const bf16x8 a = *(const LAS bf16x8*)(A + r * pa + ks * 32 + q * 8);
        const bf16x8 b = *(const LAS bf16x8*)(B + r * pb + ks * 32 + q * 8);
        acc = __builtin_amdgcn_mfma_f32_16x16x32_bf16(a, b, acc, 0, 0, 0);
    }
    return acc;
}

constexpr int HP_QT = 0, HP_KTT = 17408, HP_AM = 35840, HP_ER = 45056, HP_EE = 45568, HP_BLK = 46080;
constexpr int HP_KT = 46080, HP_SEG = 63488;
constexpr int HS_VT = 46080, HS_ST = 50688, HS_BUF = 59392;
__device__ __forceinline__ void hg_prep_item(LAS unsigned char* lds, const bf16* PA, unsigned char* SCR, const float* lb_logits, int layer, int item, int T, int tid) {
    const int lane = tid & 63, wave = __builtin_amdgcn_readfirstlane(tid >> 6), c16 = lane & 15, quad = lane >> 4;
    const int nchunk = T / 64, c = item % nchunk, sd = item / nchunk, dir = sd & 1, h = (sd >> 1) & 3, seq = sd >> 3;
    const int base = seq * T;
    const int k = tid & 127, tq = tid >> 7;
    LAS bf16* QT = (LAS bf16*)(lds + HP_QT); LAS bf16* KT = (LAS bf16*)(lds + HP_KT); LAS bf16* KTT = (LAS bf16*)(lds + HP_KTT); LAS bf16* AM = (LAS bf16*)(lds + HP_AM);
    LAS float* SEG = (LAS float*)(lds + HP_SEG); LAS float* ER = (LAS float*)(lds + HP_ER); LAS float* EE = (LAS float*)(lds + HP_EE);
    float lb;
    { float lg[4], mx = -3e38f;
#pragma unroll
      for (int l = 0; l < 4; ++l) { lg[l] = lb_logits[(dir * 4 + l) * 512 + h * 128 + k]; mx = fmaxf(mx, lg[l]); }
      float tot = 0.f, num = 0.f;
#pragma unroll
      for (int l = 0; l < 4; ++l) { const float e = __expf(lg[l] - mx); tot += e; if (l >= 1 && l <= layer) num += e; }
      lb = num / tot; }
    const float oml = 1.0f - lb;
    const bf16* zsrc = PA + (dir ? C_HZB : C_HZF) + h * 128 + k;
    const bf16* qsrc = PA + C_HQ + h * 128 + k;
    unsigned short zr[16], qr[16];
#pragma unroll
    for (int i = 0; i < 16; ++i) { const int tau = c * 64 + 16 * tq + i; const size_t ro = (size_t)(base + (dir ? (T - 1 - tau) : tau)) * PA_LD; zr[i] = zsrc[ro]; qr[i] = qsrc[ro]; }
    float b[16], kv[16]; float cum = 0.f;
#pragma unroll
    for (int i = 0; i < 16; ++i) { const float zf = bf2f(zr[i]); const float sg = sigm(zf); const float f = lb + oml * sg; cum += __logf(fmaxf(f, 1e-30f)); b[i] = cum; kv[i] = oml * (1.0f - sg); }
    SEG[tq * 128 + k] = cum;
    __syncthreads();
    const float s0 = SEG[k], s1 = SEG[128 + k], s2 = SEG[256 + k], s3 = SEG[384 + k];
    const float pre = tq == 0 ? 0.f : (tq == 1 ? s0 : (tq == 2 ? s0 + s1 : (s0 + s1) + s2));
    const float r = s0 + s1, bend = (s0 + s1) + (s2 + s3);
    unsigned kpk[8];
#pragma unroll
    for (int i = 0; i < 16; ++i) {
        const float bt = pre + b[i];
        const float eq = __expf(fminf(bt - r, 80.f)), ek = __expf(fminf(r - bt, 80.f));
        const unsigned qb = f2bf(bf2f(qr[i]) * eq), kb = f2bf(kv[i] * ek);
        const int tau = 16 * tq + i;
        QT[tau * 136 + k] = (bf16)qb; KT[tau * 136 + k] = (bf16)kb;
        if (i & 1) kpk[i >> 1] |= kb << 16; else kpk[i >> 1] = kb;
    }
    *(LAS v4u*)(KTT + k * 72 + 16 * tq) = (v4u){kpk[0], kpk[1], kpk[2], kpk[3]};
    *(LAS v4u*)(KTT + k * 72 + 16 * tq + 8) = (v4u){kpk[4], kpk[5], kpk[6], kpk[7]};
    if (tq == 0) { ER[k] = __expf(r); EE[k] = __expf(bend - r); }
    __syncthreads();
#pragma unroll
    for (int e = 0; e < 2; ++e) { const int id = wave * 2 + e, tt = id >> 2, st = id & 3;
        f32x4 a = (f32x4){0.f, 0.f, 0.f, 0.f};
        if (st <= tt) a = mma_lds<128>(a, QT + tt * 16 * 136, 136, KT + st * 16 * 136, 136, lane);
#pragma unroll
        for (int i = 0; i < 4; ++i) { const int t = tt * 16 + quad * 4 + i, s = st * 16 + c16; const float val = (st <= tt && s <= t) ? a[i] : 0.f; AM[t * 72 + s] = (bf16)f2bf(val); } }
    __syncthreads();
    unsigned char* dst = SCR + (size_t)item * HP_BLK;
#pragma unroll
    for (int j = 0; j < 6; ++j) { const int idx = tid + 512 * j; if (idx < HP_BLK / 16) *(v4u*)(dst + (size_t)idx * 16) = *(const LAS v4u*)(lds + idx * 16); }
    __syncthreads();
}

template <int NVT> __device__ __forceinline__ void hg_scan_item(LAS unsigned char* lds, bf16* PA, const unsigned char* SCR, int item, int T, int tid) {
    constexpr int NVS = 8 / NVT, VW = 16 * NVT, VTHR = 128 * NVT, VSH = (NVT == 2) ? 2 : 1;
    const int lane = tid & 63, wave = __builtin_amdgcn_readfirstlane(tid >> 6), c16 = lane & 15, quad = lane >> 4;
    const int vs = item % NVS, sd = item / NVS, dir = sd & 1, h = (sd >> 1) & 3, seq = sd >> 3;
    const int base = seq * T, nchunk = T / 64;
    const unsigned char* blk = SCR + (size_t)sd * nchunk * HP_BLK;
    const bf16* vsrc = PA + C_HI + h * 128 + vs * VW + (tid & (VW / 8 - 1)) * 8;
    bf16* odst = PA + (dir ? C_HZF : C_HQ) + h * 128 + vs * VW;
    v4u pre[6]; v4u vr = {0u, 0u, 0u, 0u}; f32x4 erv, eev;
#define HG_ROW(tau) (base + (dir ? (T - 1 - (tau)) : (tau)))
#define HS_LOAD(c) do { const unsigned char* bp = blk + (size_t)(c) * HP_BLK; \
        _Pragma("unroll") for (int j = 0; j < 6; ++j) { const int idx = tid + 512 * j; if (idx < HP_BLK / 16) pre[j] = *(const v4u*)(bp + (size_t)idx * 16); } \
        erv = *(const f32x4*)(bp + HP_ER + (wave * 16 + quad * 4) * 4); eev = *(const f32x4*)(bp + HP_EE + (wave * 16 + quad * 4) * 4); \
        if (tid < VTHR) vr = *(const v4u*)(vsrc + (size_t)HG_ROW((c) * 64 + (tid >> VSH)) * PA_LD); } while (0)
    HS_LOAD(0);
    f32x4 accS[NVT];
#pragma unroll
    for (int e = 0; e < NVT; ++e) accS[e] = (f32x4){0.f, 0.f, 0.f, 0.f};
    for (int c = 0; c < nchunk; ++c) {
        LAS unsigned char* B = lds + (c & 1) * HS_BUF;
        LAS bf16* QT = (LAS bf16*)(B + HP_QT); LAS bf16* KTT = (LAS bf16*)(B + HP_KTT); LAS bf16* AM = (LAS bf16*)(B + HP_AM);
        LAS bf16* VT = (LAS bf16*)(B + HS_VT); LAS bf16* STt = (LAS bf16*)(B + HS_ST);
#pragma unroll
        for (int j = 0; j < 6; ++j) { const int idx = tid + 512 * j; if (idx < HP_BLK / 16) *(LAS v4u*)(B + idx * 16) = pre[j]; }
        if (tid < VTHR) { const int s = tid >> VSH, vq = tid & (VW / 8 - 1);
            VT[(vq * 8 + 0) * 72 + s] = (bf16)(vr.x & 0xffffu); VT[(vq * 8 + 1) * 72 + s] = (bf16)(vr.x >> 16);
            VT[(vq * 8 + 2) * 72 + s] = (bf16)(vr.y & 0xffffu); VT[(vq * 8 + 3) * 72 + s] = (bf16)(vr.y >> 16);
            VT[(vq * 8 + 4) * 72 + s] = (bf16)(vr.z & 0xffffu); VT[(vq * 8 + 5) * 72 + s] = (bf16)(vr.z >> 16);
            VT[(vq * 8 + 6) * 72 + s] = (bf16)(vr.w & 0xffffu); VT[(vq * 8 + 7) * 72 + s] = (bf16)(vr.w >> 16); }
        f32x4 sp[NVT]; const f32x4 ee_c = eev;
#pragma unroll
        for (int e = 0; e < NVT; ++e) { sp[e] = accS[e] * erv; v2u w; w.x = cvt_pk_bf16(sp[e][0], sp[e][1]); w.y = cvt_pk_bf16(sp[e][2], sp[e][3]);
            *(LAS v2u*)(STt + (e * 16 + c16) * 136 + wave * 16 + quad * 4) = w; }
        if (c + 1 < nchunk) HS_LOAD(c + 1);
        __syncthreads();
        if ((wave >> 2) < NVT) { const int tt = wave & 3, vt = wave >> 2; f32x4 o = (f32x4){0.f, 0.f, 0.f, 0.f};
          o = mma_lds<128>(o, QT + tt * 16 * 136, 136, STt + vt * 16 * 136, 136, lane);
          o = mma_lds<64>(o, AM + tt * 16 * 72, 72, VT + vt * 16 * 72, 72, lane);
#pragma unroll
          for (int i = 0; i < 4; ++i) { const int tau = c * 64 + tt * 16 + quad * 4 + i; odst[(size_t)HG_ROW(tau) * PA_LD + vt * 16 + c16] = (bf16)f2bf(o[i]); } }
#pragma unroll
        for (int e = 0; e < NVT; ++e) { f32x4 t = mma_lds<64>(sp[e], KTT + wave * 16 * 72, 72, VT + e * 16 * 72, 72, lane); accS[e] = t * ee_c; }
    }
    __syncthreads();
#undef HG_ROW
#undef HS_LOAD
}

__device__ __forceinline__ void na_item(LAS unsigned char* lds, const bf16* PA, const float* rpb, bf16* ONA, int item, int T, int tid) {
    const int lane = tid & 63, h = __builtin_amdgcn_readfirstlane(tid >> 6), c16 = lane & 15, quad = lane >> 4;
    const int ips = T / 16, seq = item / ips, rem = item % ips, r = rem >> 2, j = rem & 3;
    const int rows = T / 64, rs = min(max(r - 4, 0), rows - 8), kstart = (j == 0) ? 0 : (j == 1) ? 8 : (j == 2) ? 24 : 32;
    const int base = seq * T, qtok = base + r * 64 + 16 * j + c16;
    const bf16* qp = PA + (size_t)qtok * PA_LD + C_NQ + h * 64 + quad * 8;
    const bf16x8 Qb0 = *(const bf16x8*)qp, Qb1 = *(const bf16x8*)(qp + 32);
    const int qcol = 16 * j + c16, cs = min(max(qcol - 8, 0), 48);
    v4u vbuf[8];
#define NA_VLOAD(qd) do { _Pragma("unroll") for (int it = 0; it < 8; ++it) { const int idx = it * 64 + lane, key = idx >> 3, dg = idx & 7; \
        const int tok = base + (rs + 2 * (qd) + (key >> 5)) * 64 + kstart + (key & 31); vbuf[it] = *(const v4u*)(PA + (size_t)tok * PA_LD + C_NV + h * 64 + dg * 8); } } while (0)
    NA_VLOAD(0);
    const float* rp = rpb + h * 465;
    f32x4 sacc[16]; float mx = -3e38f;
    int dcv[8]; bool okv[8];
#pragma unroll
    for (int e = 0; e < 8; ++e) { const int kcol = kstart + (e >> 2) * 16 + quad * 4 + (e & 3); okv[e] = (kcol >= cs) && (kcol < cs + 16); dcv[e] = min(max(kcol - qcol + 15, 0), 30); }
#pragma unroll
    for (int a = 0; a < 8; ++a) {
        const float* rpa = rp + (rs + a - r + 7) * 31;
#pragma unroll
        for (int hh = 0; hh < 2; ++hh) {
            const int ktok = base + (rs + a) * 64 + kstart + hh * 16 + c16;
            const bf16* kp = PA + (size_t)ktok * PA_LD + C_NK + h * 64 + quad * 8;
            const bf16x8 Ka0 = *(const bf16x8*)kp, Ka1 = *(const bf16x8*)(kp + 32);
            f32x4 s = (f32x4){0.f, 0.f, 0.f, 0.f};
            s = __builtin_amdgcn_mfma_f32_16x16x32_bf16(Ka0, Qb0, s, 0, 0, 0);
            s = __builtin_amdgcn_mfma_f32_16x16x32_bf16(Ka1, Qb1, s, 0, 0, 0);
#pragma unroll
            for (int i = 0; i < 4; ++i) { const float val = okv[hh * 4 + i] ? s[i] * 0.125f + rpa[dcv[hh * 4 + i]] : -1e30f; s[i] = val; mx = fmaxf(mx, val); }
            sacc[a * 2 + hh] = s;
        }
    }
    mx = fmaxf(mx, __shfl_xor(mx, 16)); mx = fmaxf(mx, __shfl_xor(mx, 32));
    float sum = 0.f;
#pragma unroll
    for (int t = 0; t < 16; ++t)
#pragma unroll
        for (int i = 0; i < 4; ++i) { const float p = __expf(sacc[t][i] - mx); sacc[t][i] = p; sum += p; }
    sum += __shfl_xor(sum, 16); sum += __shfl_xor(sum, 32);
    bf16x8 pb[8];
#pragma unroll
    for (int a = 0; a < 8; ++a) { v4u w; w.x = cvt_pk_bf16(sacc[2 * a][0], sacc[2 * a][1]); w.y = cvt_pk_bf16(sacc[2 * a][2], sacc[2 * a][3]);
        w.z = cvt_pk_bf16(sacc[2 * a + 1][0], sacc[2 * a + 1][1]); w.w = cvt_pk_bf16(sacc[2 * a + 1][2], sacc[2 * a + 1][3]); pb[a] = __builtin_bit_cast(bf16x8, w); }
    LAS bf16* VS = (LAS bf16*)(lds + h * 10240);
    f32x4 oacc[4];
#pragma unroll
    for (int dt = 0; dt < 4; ++dt) oacc[dt] = (f32x4){0.f, 0.f, 0.f, 0.f};
    const int trq = (lane & 15) >> 2, trp = lane & 3;
    const LAS bf16* trbase = VS + (quad * 4 + trq) * 80 + 4 * trp;
#pragma unroll
    for (int qd = 0; qd < 4; ++qd) {
#pragma unroll
        for (int it = 0; it < 8; ++it) { const int idx = it * 64 + lane, key = idx >> 3, dg = idx & 7; *(LAS v4u*)(VS + key * 80 + dg * 8) = vbuf[it]; }
        if (qd < 3) { NA_VLOAD(qd + 1); }
#pragma unroll
        for (int al = 0; al < 2; ++al)
#pragma unroll
            for (int dt = 0; dt < 4; ++dt) { const LAS bf16* p = trbase + al * 32 * 80 + dt * 16;
                const v4i16_t lo = __builtin_amdgcn_ds_read_tr16_b64_v4i16((LAS v4i16_t*)p), hi = __builtin_amdgcn_ds_read_tr16_b64_v4i16((LAS v4i16_t*)(p + 16 * 80));
                const bf16x8 af = {lo[0], lo[1], lo[2], lo[3], hi[0], hi[1], hi[2], hi[3]};
                oacc[dt] = __builtin_amdgcn_mfma_f32_16x16x32_bf16(af, pb[qd * 2 + al], oacc[dt], 0, 0, 0); }
    }
#undef NA_VLOAD
    const float inv = __builtin_amdgcn_rcpf(sum);
#pragma unroll
    for (int dt = 0; dt < 4; ++dt) { const f32x4 o = oacc[dt] * inv; v2u w; w.x = cvt_pk_bf16(o[0], o[1]); w.y = cvt_pk_bf16(o[2], o[3]);
        *(v2u*)(ONA + (size_t)qtok * 512 + h * 64 + dt * 16 + quad * 4) = w; }
}

#define XB_TMO      128
#define XB_XCNT(j)  (256  + 64 * (j))
#define XB_XSUB(j)  (1280 + 64 * (j))
#define XB_XGEN(j)  (2304 + 64 * (j))
#define XB_TOP      3328
#define XB_TOPGEN   3392
#define XCD_BAR_WORDS 3456
#define XB_SPIN_CAP (1u << 18)

__device__ __forceinline__ unsigned xb_ld(unsigned* p)              { return __hip_atomic_load(p, __ATOMIC_RELAXED, __HIP_MEMORY_SCOPE_AGENT); }
__device__ __forceinline__ unsigned xb_add(unsigned* p, unsigned v) { return __hip_atomic_fetch_add(p, v, __ATOMIC_RELAXED, __HIP_MEMORY_SCOPE_AGENT); }
__device__ __forceinline__ unsigned xb_xcc_id() { return (unsigned)__builtin_amdgcn_s_getreg((3 << 11) | 20) & 0xFu; }
#define XB_SPIN(cond, bar) do { unsigned _sp = 0; while (cond) { __builtin_amdgcn_s_sleep(1); \
    if ((++_sp & 255u) == 0u) { if (xb_ld(&(bar)[XB_TMO])) break; if (_sp > XB_SPIN_CAP) { atomicAdd(&(bar)[XB_TMO], 1u); break; } } } } while (0)

struct XcdBarrier {
    unsigned* bar; unsigned x;
    volatile LAS unsigned* st;
};

__device__ __forceinline__ XcdBarrier xcd_barrier_post(unsigned* bar, volatile LAS unsigned* st) {
    XcdBarrier b; b.bar = bar; b.x = xb_xcc_id(); b.st = st;
    if (threadIdx.x == 0) (void)xb_add(&bar[XB_XCNT(b.x)], 1u);
    return b;
}
__device__ __forceinline__ void xcd_barrier_complete(unsigned* bar, unsigned x, unsigned& nloc, unsigned& nx) {
    const unsigned G = gridDim.x * gridDim.y * gridDim.z;
    unsigned sum, cnt, mine, sp = 0u;
    for (;;) {
        sum = 0u; cnt = 0u; mine = 0u;
#pragma unroll
        for (unsigned j = 0; j < 16; ++j) { const unsigned c = xb_ld(&bar[XB_XCNT(j)]); sum += c; cnt += (c > 0u) ? 1u : 0u; mine = (j == x) ? c : mine; }
        if (sum == G) break;
        __builtin_amdgcn_s_sleep(1);
        if ((++sp & 255u) == 0u) { if (xb_ld(&bar[XB_TMO])) break; if (sp > XB_SPIN_CAP) { atomicAdd(&bar[XB_TMO], 1u); break; } }
    }
    nloc = mine > 0u ? mine : 1u; nx = cnt > 0u ? cnt : 1u;
}

__device__ __forceinline__ void xcd_barrier(const XcdBarrier& b) {
    asm volatile("s_waitcnt vmcnt(0)" ::: "memory");
    __syncthreads();
    if (threadIdx.x == 0) {
        unsigned* bar = b.bar;
        __builtin_amdgcn_s_waitcnt(0);
        unsigned nloc = b.st[0], nx = b.st[1];
        if (nloc == 0u) { xcd_barrier_complete(bar, b.x, nloc, nx); b.st[0] = nloc; b.st[1] = nx; }
        const unsigned old = xb_add(&bar[XB_XSUB(b.x)], 1u);
        const unsigned gen = old / nloc;
        if (old + 1u == (gen + 1u) * nloc) {
            __builtin_amdgcn_fence(__ATOMIC_RELEASE, "agent");
            asm volatile("s_waitcnt vmcnt(0)" ::: "memory");
            const unsigned og = xb_add(&bar[XB_TOP], 1u);
            const unsigned tg = og / nx;
            if (og + 1u == (tg + 1u) * nx) xb_add(&bar[XB_TOPGEN], 1u);
            else XB_SPIN(xb_ld(&bar[XB_TOPGEN]) == tg, bar);
            __builtin_amdgcn_fence(__ATOMIC_ACQUIRE, "agent");
            xb_add(&bar[XB_XGEN(b.x)], 1u);
            asm volatile("s_waitcnt vmcnt(0)" ::: "memory");
        } else {
            XB_SPIN(xb_ld(&bar[XB_XGEN(b.x)]) == gen, bar);
            __builtin_amdgcn_fence(__ATOMIC_ACQUIRE, "agent");
            asm volatile("s_waitcnt vmcnt(0)" ::: "memory");
        }
    }
    __syncthreads();
}
struct Args { const float* in[20]; float* out; unsigned char* ws; int ph_lo, ph_hi; };
enum { K_CVT = 0, K_G0, K_UP, K_RES, K_M1, K_M2A, K_M2B, K_M3, K_M4, K_GF };

__global__ void __launch_bounds__(NTHR, 2) mk_fwd(Args args) {
    extern __shared__ __attribute__((aligned(16))) unsigned char lds_raw[];
    LAS unsigned char* lds = (LAS unsigned char*)lds_raw;
    cg::grid_group grid = cg::this_grid();
    const int hi = args.ph_hi;
    { volatile LAS unsigned* st0 = (volatile LAS unsigned*)(lds + LDS_MISC + 32); if (threadIdx.x < 2) st0[threadIdx.x] = 0u; __syncthreads(); }
    XcdBarrier xbar = xcd_barrier_post((unsigned*)(args.ws + WS_CTL) + CW_BAR, (volatile LAS unsigned*)(lds + LDS_MISC + 32));
    for (int ph = args.ph_lo; ph < hi; ++ph) {
        int bid = blockIdx.x, G = gridDim.x; asm volatile("" : "+s"(bid), "+s"(G));
        int tid = threadIdx.x; asm volatile("" : "+v"(tid));
        const int lane = tid & 63, wave = __builtin_amdgcn_readfirstlane(tid >> 6);
        const int gw = bid * NWAVES + wave, NGW = G * NWAVES;
        int kind, pr = 0, l = 0, s = 0, g2 = 0;
        if (ph == 0) kind = K_CVT;
        else { const int q = ph - 1; pr = q / PH_PER_PAIR; const int r = q % PH_PER_PAIR;
            if (r == 0) kind = K_G0; else if (r == PH_PER_PAIR - 1) kind = K_GF;
            else { l = (r - 1) / 16; s = (r - 1) % 16;
                if (s == 0 || s == 14) kind = K_UP; else if (s == 1 || s == 15) kind = K_RES;
                else { g2 = (s - 2) / 6; const int t = (s - 2) % 6; kind = (t == 0) ? K_M1 : (t == 1) ? K_M2A : (t == 2) ? K_M2B : (t == 3) ? K_M3 : (t == 4) ? K_M4 : K_RES; } } }
        const bool mix = (s >= 2 && s <= 13);
        unsigned char* ws = args.ws;
        bf16* XBp = (bf16*)(ws + WS_XB); float* SSQp = (float*)(ws + WS_SSQ);
        bf16* XB = XBp + (size_t)g2 * TG * D; float* SSQ = SSQp + (size_t)g2 * TG * 16;
        bf16* PA = (bf16*)(ws + WS_PA); bf16* PG = (bf16*)(ws + WS_PG);
        bf16* ONA = (bf16*)(ws + WS_ONA); bf16* OHG = ONA + (size_t)TG * 512; bf16* OCV = OHG + (size_t)TG * 512;
        unsigned char* SCR = ws + WS_SCR;
        const bf16* Wl = (const bf16*)(ws + WS_W) + (size_t)l * LAYER_EL;
        const int T = pr == 0 ? 2048 : 4096;
        const int g = pr * 2 + g2;
        float* X = args.out + (size_t)pr * 2 * TG * D;

        if (kind == K_CVT) {
            LAS float* scr = (LAS float*)(lds + wave * 16384);
            constexpr int I_GU = 16 * 176, I_DN = 44 * 32, I_IN = 16 * 272, I_MX = 8 * 32, I_OUT = 16 * 32;
            constexpr int I_LAYER = 2 * I_GU + 2 * I_DN + I_IN + 3 * I_MX + I_OUT;
            for (int it = gw; it < NLAYER * I_LAYER; it += NGW) {
                const int ll = it / I_LAYER; int r = it % I_LAYER; bf16* Wd = (bf16*)(ws + WS_W) + (size_t)ll * LAYER_EL;
                const float* src; const float* gain = nullptr; int K, N; size_t off; bool perm = false;
                if (r < I_GU) { src = args.in[3] + (size_t)ll * D * 2 * FF; K = D; N = 2 * FF; off = OFF_GU1; gain = args.in[2] + ll * D; perm = true; }
                else if ((r -= I_GU) < I_DN) { src = args.in[4] + (size_t)ll * FF * D; K = FF; N = D; off = OFF_D1; }
                else if ((r -= I_DN) < I_IN) { src = args.in[6] + (size_t)ll * D * 8704; K = D; N = 8704; off = OFF_IN; gain = args.in[5] + ll * D; }
                else if ((r -= I_IN) < I_MX) { src = args.in[9] + (size_t)ll * 512 * D; K = 512; N = D; off = OFF_HG; }
                else if ((r -= I_MX) < I_MX) { src = args.in[12] + (size_t)ll * 512 * D; K = 512; N = D; off = OFF_CV; }
                else if ((r -= I_MX) < I_MX) { src = args.in[14] + (size_t)ll * 512 * D; K = 512; N = D; off = OFF_NA; }
                else if ((r -= I_MX) < I_OUT) { src = args.in[15] + (size_t)ll * D * D; K = D; N = D; off = OFF_OUT; }
                else if ((r -= I_OUT) < I_GU) { src = args.in[17] + (size_t)ll * D * 2 * FF; K = D; N = 2 * FF; off = OFF_GU2; gain = args.in[16] + ll * D; perm = true; }
                else { r -= I_GU; src = args.in[18] + (size_t)ll * FF * D; K = FF; N = D; off = OFF_D2; }
                cvt_item(src, K, N, Wd + off, gain, perm, scr, r, lane);
            }
        } else if (kind == K_G0) {
            const float* xin = pr == 0 ? args.in[0] : args.in[1];
            for (int row = gw; row < 2 * TG; row += NGW) {
                const f32x4* xr = (const f32x4*)(xin + (size_t)row * D) + lane; v2u* bo = (v2u*)(XBp + (size_t)row * D) + lane;
                float ss = 0.f;
#pragma unroll
                for (int j = 0; j < 4; ++j) { const f32x4 v = xr[64 * j]; v2u w; w.x = cvt_pk_bf16(v[0], v[1]); w.y = cvt_pk_bf16(v[2], v[3]); bo[64 * j] = w; ss += (v[0] * v[0] + v[1] * v[1]) + (v[2] * v[2] + v[3] * v[3]); }
                ss = wave_sum(ss);
                if (lane < 16) SSQp[(size_t)row * 16 + lane] = lane == 0 ? ss : 0.f;
            }
        } else if (kind == K_UP) {
            pg8::Gemm gm{XBp, Wl + (s == 14 ? OFF_GU2 : OFF_GU1), 2 * TG, 2 * FF, D}; pg8::StaticOrder S; S.init(2 * TG, 2 * FF, G, bid);
            pg8::EpiSwiGLU E{PA, SSQp};
#ifndef NO_UP
            for (int rep = 0; rep < REP_GEMM; ++rep) pg8::gemm_phase<pg8::EpiSwiGLU, pg8::StaticOrder, true, true>(lds, gm, S, E);
#endif
        } else if (kind == K_RES) {
            const int K = mix ? D : FF, Mr = mix ? TG : 2 * TG; const size_t off = mix ? OFF_OUT : (s == 1 ? OFF_D1 : OFF_D2);
            pg8::Gemm gm{PA, Wl + off, Mr, D, K}; pg8::StaticOrder S; S.init(Mr, D, G, bid);
            pg8::EpiRes E{mix ? XB : XBp, mix ? SSQ : SSQp, mix ? 1.0f : 0.5f};
#ifndef NO_RES
            pg8::gemm_phase<pg8::EpiRes, pg8::StaticOrder, true, true>(lds, gm, S, E);
#endif
        } else if (kind == K_M1) {
            pg8::Gemm gm{XB, Wl + OFF_IN, TG, 8704, D}; pg8::StaticOrder S; S.init(TG, 8704, G, bid);
            pg8::EpiProj E{PA, PG, SSQ};
#ifndef NO_PROJ
            for (int rep = 0; rep < REP_GEMM; ++rep) pg8::gemm_phase<pg8::EpiProj, pg8::StaticOrder, true, true>(lds, gm, S, E);
#endif
        } else if (kind == K_M2A) {
#ifndef NO_HG
            { const int nP = (TG / 64) * 8;
              for (int rep = 0; rep < REP_HG; ++rep) for (int it = bid; it < nP; it += G) hg_prep_item(lds, PA, SCR, args.in[7], l, it, T, tid); }
#endif
            const float* rpb = args.in[13] + (size_t)l * 8 * 465;
            const int vcu = (G % 8 == 0) ? (bid % 8) * (G / 8) + bid / 8 : bid;
            const int nNA = TG / 16, ipb = (nNA + G - 1) / G;
            for (int rep = 0; rep < REP_NA; ++rep)
                for (int q = 0; q < ipb; ++q) { const int it = vcu * ipb + q; if (it < nNA) {
#ifndef NO_NA
                    na_item(lds, PA, rpb, ONA, it, T, tid);
#endif
                    __syncthreads(); } }
        } else if (kind == K_M2B) {
#ifndef NO_HG
            const int vcu2 = (G % 8 == 0) ? (bid % 8) * (G / 8) + bid / 8 : bid;
            for (int rep = 0; rep < REP_HG; ++rep) {
                if (pr == 0) { for (int it = vcu2; it < 256; it += G) hg_scan_item<2>(lds, PA, SCR, it, T, tid); }
                else       { for (int it = vcu2; it < 256; it += G) hg_scan_item<1>(lds, PA, SCR, it, T, tid); }
            }
#endif
        } else if (kind == K_M3) {
            const float* gno = args.in[8] + l * 512; const float* cw = args.in[10] + l * 3 * 512; const float* cbias = args.in[11] + l * 512;
            const int c0 = lane * 8;
            for (int rep = 0; rep < REP_M3; ++rep) for (int row = gw; row < TG; row += NGW) {
                const bf16* prow = PA + (size_t)row * PA_LD;
                const v4u fw = *(const v4u*)(prow + C_HQ + c0), bw = *(const v4u*)(prow + C_HZF + c0);
                float o[8] = {bflo(fw.x) + bflo(bw.x), bfhi(fw.x) + bfhi(bw.x), bflo(fw.y) + bflo(bw.y), bfhi(fw.y) + bfhi(bw.y), bflo(fw.z) + bflo(bw.z), bfhi(fw.z) + bfhi(bw.z), bflo(fw.w) + bflo(bw.w), bfhi(fw.w) + bfhi(bw.w)};
                float ss = 0.f;
#pragma unroll
                for (int e = 0; e < 8; ++e) ss += o[e] * o[e];
                ss += __shfl_xor(ss, 1); ss += __shfl_xor(ss, 2); ss += __shfl_xor(ss, 4); ss += __shfl_xor(ss, 8);
                const float rs = __builtin_amdgcn_rsqf(ss * (1.0f / 128.0f) + 1e-6f);
                const v4u hgw = *(const v4u*)(prow + C_HG + c0);
                const float hgv[8] = {bflo(hgw.x), bfhi(hgw.x), bflo(hgw.y), bfhi(hgw.y), bflo(hgw.z), bfhi(hgw.z), bflo(hgw.w), bfhi(hgw.w)};
                const f32x4 gn0 = *(const f32x4*)(gno + c0), gn1 = *(const f32x4*)(gno + c0 + 4);
                const float gn[8] = {gn0[0], gn0[1], gn0[2], gn0[3], gn1[0], gn1[1], gn1[2], gn1[3]};
                float r8[8];
#pragma unroll
                for (int e = 0; e < 8; ++e) r8[e] = o[e] * rs * gn[e] * (hgv[e] * sigm(hgv[e]));
                v4u wo; wo.x = cvt_pk_bf16(r8[0], r8[1]); wo.y = cvt_pk_bf16(r8[2], r8[3]); wo.z = cvt_pk_bf16(r8[4], r8[5]); wo.w = cvt_pk_bf16(r8[6], r8[7]);
                *(v4u*)(OHG + (size_t)row * 512 + c0) = wo;
                const int tl = row & (T - 1);
                const v4u a1 = *(const v4u*)(prow + C_CA + c0), c1 = *(const v4u*)(prow + C_CC + c0), bb = *(const v4u*)(prow + C_CB + c0);
                v4u a0 = {0u, 0u, 0u, 0u}, cc0 = a0, a2 = a0, cc2 = a0;
                if (tl > 0) { a0 = *(const v4u*)(prow - PA_LD + C_CA + c0); cc0 = *(const v4u*)(prow - PA_LD + C_CC + c0); }
                if (tl < T - 1) { a2 = *(const v4u*)(prow + PA_LD + C_CA + c0); cc2 = *(const v4u*)(prow + PA_LD + C_CC + c0); }
                const float zm[8] = {bflo(a0.x) * bflo(cc0.x), bfhi(a0.x) * bfhi(cc0.x), bflo(a0.y) * bflo(cc0.y), bfhi(a0.y) * bfhi(cc0.y), bflo(a0.z) * bflo(cc0.z), bfhi(a0.z) * bfhi(cc0.z), bflo(a0.w) * bflo(cc0.w), bfhi(a0.w) * bfhi(cc0.w)};
                const float zc[8] = {bflo(a1.x) * bflo(c1.x), bfhi(a1.x) * bfhi(c1.x), bflo(a1.y) * bflo(c1.y), bfhi(a1.y) * bfhi(c1.y), bflo(a1.z) * bflo(c1.z), bfhi(a1.z) * bfhi(c1.z), bflo(a1.w) * bflo(c1.w), bfhi(a1.w) * bfhi(c1.w)};
                const float zp[8] = {bflo(a2.x) * bflo(cc2.x), bfhi(a2.x) * bfhi(cc2.x), bflo(a2.y) * bflo(cc2.y), bfhi(a2.y) * bfhi(cc2.y), bflo(a2.z) * bflo(cc2.z), bfhi(a2.z) * bfhi(cc2.z), bflo(a2.w) * bflo(cc2.w), bfhi(a2.w) * bfhi(cc2.w)};
                const float cbv[8] = {bflo(bb.x), bfhi(bb.x), bflo(bb.y), bfhi(bb.y), bflo(bb.z), bfhi(bb.z), bflo(bb.w), bfhi(bb.w)};
                const f32x4 w00 = *(const f32x4*)(cw + c0), w01 = *(const f32x4*)(cw + c0 + 4), w10 = *(const f32x4*)(cw + 512 + c0), w11 = *(const f32x4*)(cw + 512 + c0 + 4);
                const f32x4 w20 = *(const f32x4*)(cw + 1024 + c0), w21 = *(const f32x4*)(cw + 1024 + c0 + 4), bs0 = *(const f32x4*)(cbias + c0), bs1 = *(const f32x4*)(cbias + c0 + 4);
#pragma unroll
                for (int e = 0; e < 4; ++e) { r8[e] = cbv[e] * (w00[e] * zm[e] + w10[e] * zc[e] + w20[e] * zp[e] + bs0[e]); r8[4 + e] = cbv[4 + e] * (w01[e] * zm[4 + e] + w11[e] * zc[4 + e] + w21[e] * zp[4 + e] + bs1[e]); }
                wo.x = cvt_pk_bf16(r8[0], r8[1]); wo.y = cvt_pk_bf16(r8[2], r8[3]); wo.z = cvt_pk_bf16(r8[4], r8[5]); wo.w = cvt_pk_bf16(r8[6], r8[7]);
                *(v4u*)(OCV + (size_t)row * 512 + c0) = wo;
            }
        } else if (kind == K_M4) {
            pg8::Gemm gm{ONA, Wl + OFF_HG, 3 * TG, 3 * D, 512}; pg8::MergeOrder S; S.init(TG, D, G, bid);
            pg8::EpiMerge E{PG, PA};
#ifndef NO_MERGE
            pg8::gemm_phase<pg8::EpiMerge, pg8::MergeOrder, true, true>(lds, gm, S, E);
#endif
        } else {
            const f32x4* fg = (const f32x4*)args.in[19] + lane;
            for (int row = gw; row < 2 * TG; row += NGW) {
                const float rs = pg8::row_rs(SSQp, row);
                f32x4* xo = (f32x4*)(X + (size_t)row * D) + lane; const v2u* bi = (const v2u*)(XBp + (size_t)row * D) + lane;
#pragma unroll
                for (int j = 0; j < 4; ++j) { const v2u w = bi[64 * j]; const f32x4 v = {bflo(w.x), bfhi(w.x), bflo(w.y), bfhi(w.y)}; xo[64 * j] = v * fg[64 * j] * rs; }
            }
        }
        if (ph + 1 < hi) { for (int rep = 0; rep < REP_SYNC; ++rep) { if (ph == 0) grid.sync(); else xcd_barrier(xbar); } }
    }
}
constexpr int N_PHASES = 1 + 2 * PH_PER_PAIR;

extern "C" void kernel_launch(void* const* d_in, const int* in_sizes, int n_in, void* d_out, int out_size, void* d_ws, size_t ws_size, hipStream_t stream) {
    static int grid = 0;
    if (grid == 0) {
        if (n_in != 20 || ws_size < WS_END) { fprintf(stderr, "kernel_launch: unexpected n_in %d / ws %zu\n", n_in, ws_size); grid = -1; return; }
        int dev = 0, cus = 0, per_cu = 0;
        hipGetDevice(&dev); hipDeviceGetAttribute(&cus, hipDeviceAttributeMultiprocessorCount, dev);
        hipFuncSetAttribute((const void*)mk_fwd, hipFuncAttributeMaxDynamicSharedMemorySize, LDS_BYTES);
        hipOccupancyMaxActiveBlocksPerMultiprocessor(&per_cu, (const void*)mk_fwd, NTHR, LDS_BYTES);
        if (per_cu < 1) per_cu = 1;
        grid = cus * per_cu;
        (void)hipGetLastError();
    }
    if (grid < 0) return;
    hipMemsetAsync((char*)d_ws + WS_CTL, 0, CTL_BYTES, stream);
    Args a{};
    for (int i = 0; i < 20; ++i) a.in[i] = (const float*)d_in[i];
    a.out = (float*)d_out; a.ws = (unsigned char*)d_ws;
#if ONE_LAUNCH
    a.ph_lo = 0; a.ph_hi = N_PHASES;
    void* kargs[] = {&a};
    hipError_t e = hipLaunchCooperativeKernel((const void*)mk_fwd, dim3(grid), dim3(NTHR), kargs, LDS_BYTES, stream);
    if (e != hipSuccess) fprintf(stderr, "cooperative launch failed: %s (grid %d)\n", hipGetErrorString(e), grid);
#else
    for (int p = 0; p < N_PHASES; ++p) { a.ph_lo = p; a.ph_hi = p + 1; hipLaunchKernelGGL(mk_fwd, dim3(grid), dim3(NTHR), LDS_BYTES, stream, a); }
#endif
}
```

```cpp
#include <hip/hip_runtime.h>
#include <hip/hip_cooperative_groups.h>
#include <cstdio>
#include <cstdint>
namespace cg = cooperative_groups;
#ifndef ONE_LAUNCH
#define ONE_LAUNCH 1
#endif
#ifndef REP_HG
#define REP_HG 1
#endif
#ifndef REP_NA
#define REP_NA 1
#endif
#ifndef REP_SYNC
#define REP_SYNC 1
#endif
#ifndef REP_GEMM
#define REP_GEMM 1
#endif
#ifndef REP_M3
#define REP_M3 1
#endif
#ifndef REP_RES
#define REP_RES 1
#endif
#ifndef REP_MERGE
#define REP_MERGE 1
#endif
#ifndef REP_MISC
#define REP_MISC 1
#endif
#ifndef TPROBE
#define TPROBE 0
#endif
#ifndef TPROBE_BLOCK
#define TPROBE_BLOCK 0
#endif
namespace pg8 {
#define PG8_LAS __attribute__((address_space(3)))
typedef unsigned short bf16_t;
typedef short bf16x8 __attribute__((ext_vector_type(8)));
typedef float f32x4 __attribute__((ext_vector_type(4)));
typedef unsigned u32x4 __attribute__((ext_vector_type(4)));
constexpr int BM = 256, BK = 64, HALF = 128, HTB = HALF * BK * 2  , STAGE_BYTES = 8 * HTB, NXCD = 8, WGM = 8;

__host__ __device__ __forceinline__ int lds_byte(int r, int c) { const int st = (r >> 4) * 2 + (c >> 5), rr = r & 15, cc = c & 31, ob = rr * 64 + cc * 2; return st * 1024 + (ob ^ (((ob >> 9) & 1) << 5)); }
__host__ __device__ __forceinline__ void stage_rc(int b, int& R, int& C) { const int st = b / 1024, sb = b % 1024, swz = sb ^ (((sb >> 9) & 1) << 5); R = (st >> 1) * 16 + swz / 64; C = (st & 1) * 32 + (swz % 64) / 2; }
__host__ __device__ __forceinline__ int perm32(int rho) { const int n = rho >> 4, i = rho & 15; return 8 * (i >> 2) + 4 * n + (i & 3); }

struct Unit { int pm, pn; };
struct Gemm { const bf16_t* A; const bf16_t* Bt; int M, N, K; };

struct StaticOrder {
    int nM, nN, nwg, G, c;
    __host__ __device__ void init(int M, int N, int G_, int c_) { nM = M / BM; nN = N / BM; nwg = nM * nN; G = G_; c = c_; }
    __host__ __device__ bool next(int i, Unit& u) const {
        const long L = (long)i * G + c; if (L >= nwg) return false;
        int wgid = (int)L; { const int q = nwg / NXCD, r = nwg % NXCD, xcd = wgid % NXCD, off = wgid / NXCD; wgid = (xcd < r ? xcd * (q + 1) : r * (q + 1) + (xcd - r) * q) + off; }
        const int nig = WGM * nN, gid = wgid / nig, fm = gid * WGM, gsz = (nM - fm) < WGM ? (nM - fm) : WGM;
        u.pm = fm + ((wgid % nig) % gsz); u.pn = (wgid % nig) / gsz; return true;
    }
    __device__ __forceinline__ void a_ready(const Unit&) const {}
    __device__ __forceinline__ void done(const Unit&) const {}
};

__device__ __forceinline__ unsigned cvt_pk_bf16(float lo, float hi) { unsigned r; asm volatile("v_cvt_pk_bf16_f32 %0, %1, %2" : "=v"(r) : "v"(lo), "v"(hi)); return r; }
__device__ __forceinline__ float row_rs(const float* ssq, int row) {
    const f32x4* p = (const f32x4*)(ssq + (size_t)row * 16);
    const f32x4 a = p[0], b = p[1], c = p[2], d = p[3];
    const float s = (((a[0] + a[1]) + (a[2] + a[3])) + ((b[0] + b[1]) + (b[2] + b[3]))) + (((c[0] + c[1]) + (c[2] + c[3])) + ((d[0] + d[1]) + (d[2] + d[3])));
    return __builtin_amdgcn_rsqf(s * (1.0f / 1024.0f) + 1e-6f);
}
__device__ __forceinline__ float sigm(float v) { return __builtin_amdgcn_rcpf(1.0f + __expf(-v)); }

struct EpiSwiGLU {
    static constexpr bool PERM = true, AFTER_DRAIN = false;
    bf16_t* H; const float* ssq;
    __device__ __forceinline__ void operator()(const f32x4 (&acc)[2][2][4][2], const Unit& u, int wr, int wc, int fr, int fq) const {
        const int row0 = u.pm * BM + wr * 64 + fr, col0 = u.pn * 128 + wc * 32 + 8 * fq;
#pragma unroll
        for (int ai = 0; ai < 2; ++ai)
#pragma unroll
            for (int m = 0; m < 4; ++m) {
                const int row = row0 + ai * HALF + m * 16; const float rs = row_rs(ssq, row);
                u32x4 w;
#pragma unroll
                for (int n = 0; n < 2; ++n) {
                    const f32x4 a = acc[ai][0][m][n] * rs, b = acc[ai][1][m][n] * rs; f32x4 h;
#pragma unroll
                    for (int e = 0; e < 4; ++e) h[e] = a[e] * sigm(a[e]) * b[e];
                    w[2 * n] = cvt_pk_bf16(h[0], h[1]); w[2 * n + 1] = cvt_pk_bf16(h[2], h[3]);
                }
                *(u32x4*)(H + (size_t)row * 2816 + col0) = w;
                asm volatile("" ::: "memory");
            }
    }
};
__device__ __forceinline__ void unpack8(const u32x4 w, f32x4& lo, f32x4& hi) {
    lo[0] = __uint_as_float(w.x << 16); lo[1] = __uint_as_float(w.x & 0xffff0000u); lo[2] = __uint_as_float(w.y << 16); lo[3] = __uint_as_float(w.y & 0xffff0000u);
    hi[0] = __uint_as_float(w.z << 16); hi[1] = __uint_as_float(w.z & 0xffff0000u); hi[2] = __uint_as_float(w.w << 16); hi[3] = __uint_as_float(w.w & 0xffff0000u);
}
struct EpiRes {
    static constexpr bool PERM = true, AFTER_DRAIN = false;
    bf16_t* XB; float* ssq; float alpha;
    __device__ __forceinline__ void operator()(const f32x4 (&acc)[2][2][4][2], const Unit& u, int wr, int wc, int fr, int fq) const {
        const int row0 = u.pm * BM + wr * 64 + fr, col0 = u.pn * BM + wc * 32 + 8 * fq;
#pragma unroll
        for (int ai = 0; ai < 2; ++ai)
#pragma unroll
            for (int m = 0; m < 4; ++m) {
                const int row = row0 + ai * HALF + m * 16; float ss = 0.f;
#pragma unroll
                for (int bj = 0; bj < 2; ++bj) {
                    bf16_t* xp = XB + (size_t)row * 1024 + col0 + bj * HALF;
                    f32x4 x0, x1; unpack8(*(const u32x4*)xp, x0, x1);
                    x0 = x0 + acc[ai][bj][m][0] * alpha; x1 = x1 + acc[ai][bj][m][1] * alpha;
                    u32x4 w; w.x = cvt_pk_bf16(x0[0], x0[1]); w.y = cvt_pk_bf16(x0[2], x0[3]); w.z = cvt_pk_bf16(x1[0], x1[1]); w.w = cvt_pk_bf16(x1[2], x1[3]);
                    *(u32x4*)xp = w;
                    ss += ((x0[0] * x0[0] + x0[1] * x0[1]) + (x0[2] * x0[2] + x0[3] * x0[3])) + ((x1[0] * x1[0] + x1[1] * x1[1]) + (x1[2] * x1[2] + x1[3] * x1[3]));
                }
                ss += __shfl_xor(ss, 16); ss += __shfl_xor(ss, 32);
                if (fq == 0) ssq[(size_t)row * 16 + u.pn * 4 + wc] = ss;
                asm volatile("" ::: "memory");
            }
    }
};
struct EpiProj {
    static constexpr bool PERM = true, AFTER_DRAIN = false;
    bf16_t* PA; bf16_t* PG; const float* ssq;
    __device__ __forceinline__ void operator()(const f32x4 (&acc)[2][2][4][2], const Unit& u, int wr, int wc, int fr, int fq) const {
        const int row0 = u.pm * BM + wr * 64 + fr;
        bf16_t* base; int ld, colt;
        if (u.pn < 22) { base = PA; ld = 5632; colt = u.pn * BM; } else { base = PG; ld = 3072; colt = (u.pn - 22) * BM; }
        const int col0 = colt + wc * 32 + 8 * fq;
#pragma unroll
        for (int ai = 0; ai < 2; ++ai)
#pragma unroll
            for (int m = 0; m < 4; ++m) {
                const int row = row0 + ai * HALF + m * 16; const float rs = row_rs(ssq, row);
#pragma unroll
                for (int bj = 0; bj < 2; ++bj) {
                    const f32x4 v0 = acc[ai][bj][m][0] * rs, v1 = acc[ai][bj][m][1] * rs;
                    u32x4 w; w.x = cvt_pk_bf16(v0[0], v0[1]); w.y = cvt_pk_bf16(v0[2], v0[3]); w.z = cvt_pk_bf16(v1[0], v1[1]); w.w = cvt_pk_bf16(v1[2], v1[3]);
                    *(u32x4*)(base + (size_t)row * ld + col0 + bj * HALF) = w;
                }
                asm volatile("" ::: "memory");
            }
    }
};
struct MergeOrder {
    StaticOrder so;
    __device__ void init(int M, int N, int G_, int c_) { so.init(M, N, G_, c_); }
    __device__ bool next(int i, Unit& u) const { Unit b; if (!so.next(i / 3, b)) return false; const int m = i % 3, w = (m == 0) ? 2 : m - 1; u.pm = b.pm + 64 * m; u.pn = b.pn + 4 * w; return true; }
    __device__ __forceinline__ void a_ready(const Unit&) const {}
    __device__ __forceinline__ void done(const Unit&) const {}
};
struct EpiMerge {
    static constexpr bool PERM = true, AFTER_DRAIN = false;
    const bf16_t* PG; bf16_t* MB;
    __device__ __forceinline__ void operator()(const f32x4 (&acc)[2][2][4][2], const Unit& u, int wr, int wc, int fr, int fq) const {
        const int m_ = u.pm >> 6, pm = u.pm & 63, w_ = u.pn >> 2, pn = u.pn & 3;
        const int row0 = pm * BM + wr * 64 + fr, col0 = pn * BM + wc * 32 + 8 * fq;
#pragma unroll
        for (int ai = 0; ai < 2; ++ai)
#pragma unroll
            for (int m = 0; m < 4; ++m) {
                const int row = row0 + ai * HALF + m * 16;
#pragma unroll
                for (int bj = 0; bj < 2; ++bj) {
                    const int col = col0 + bj * HALF;
                    f32x4 g0, g1; unpack8(*(const u32x4*)(PG + (size_t)row * 3072 + w_ * 1024 + col), g0, g1);
                    f32x4 t0, t1;
#pragma unroll
                    for (int e = 0; e < 4; ++e) { t0[e] = sigm(g0[e]) * acc[ai][bj][m][0][e]; t1[e] = sigm(g1[e]) * acc[ai][bj][m][1][e]; }
                    bf16_t* mp = MB + (size_t)row * 1024 + col;
                    if (m_ > 0) { f32x4 p0, p1; unpack8(*(const u32x4*)mp, p0, p1); t0 = t0 + p0; t1 = t1 + p1; }
                    u32x4 w; w.x = cvt_pk_bf16(t0[0], t0[1]); w.y = cvt_pk_bf16(t0[2], t0[3]); w.z = cvt_pk_bf16(t1[0], t1[1]); w.w = cvt_pk_bf16(t1[2], t1[3]);
                    *(u32x4*)mp = w;
                }
                asm volatile("" ::: "memory");
            }
    }
};
template <class Epi, class Sched, bool ALIGN_EPI = false, bool SP2 = false>
__device__ __forceinline__ void gemm_phase(PG8_LAS unsigned char* lds, const Gemm g, const Sched& S, const Epi& E) {
    int tid = threadIdx.x; asm volatile("" : "+v"(tid));
    const int wid = __builtin_amdgcn_readfirstlane(tid >> 6), lane = tid & 63, wr = wid >> 2, wc = wid & 3, fr = lane & 15, fq = lane >> 4;
    const int K = g.K, nt = K / BK;
    unsigned voffA[2], voffB[2];
#pragma unroll
    for (int i = 0; i < 2; ++i) { int R, C; stage_rc(tid * 16 + i * 8192, R, C); const int Rb = Epi::PERM ? ((R & ~31) + perm32(R & 31)) : R;
        voffA[i] = (unsigned)(R * K + C) * 2u; voffB[i] = (unsigned)(Rb * K + C) * 2u; }
    const size_t kstep = (size_t)(BK * 2);
    const size_t hstep = (size_t)HALF * K * 2;
    const size_t tstep = 2 * hstep;
    const unsigned ldsw = (unsigned)wid * 1024u;
    const int aoff = lds_byte(wr * 64 + fr, fq * 8), boff = lds_byte(wc * 32 + fr, fq * 8);
#define PG8_SA(b, h) (((b) * 2 + (h)) * HTB)
#define PG8_SB(b, h) ((4 + (b) * 2 + (h)) * HTB)
#define PG8_STAGE(bufoff, gbase, voff) do { _Pragma("unroll") for (int _i = 0; _i < 2; ++_i) \
        __builtin_amdgcn_global_load_lds((const unsigned*)((const char*)(gbase) + (voff)[_i]), (PG8_LAS unsigned*)(lds + (bufoff) + ldsw + _i * 8192), 16, 0, 0); } while (0)
#define PG8_LDA(dst, b, h) do { _Pragma("unroll") for (int m = 0; m < 4; ++m) _Pragma("unroll") for (int k = 0; k < 2; ++k) dst[m][k] = *(const PG8_LAS bf16x8*)(lds + PG8_SA(b, h) + aoff + m * 2048 + k * 1024); } while (0)
#define PG8_LDB(dst, b, h) do { _Pragma("unroll") for (int n = 0; n < 2; ++n) _Pragma("unroll") for (int k = 0; k < 2; ++k) dst[n][k] = *(const PG8_LAS bf16x8*)(lds + PG8_SB(b, h) + boff + n * 2048 + k * 1024); } while (0)
#define PG8_MMA(ai, bj, At, Bt) do { __builtin_amdgcn_s_setprio(1); _Pragma("unroll") for (int m = 0; m < 4; ++m) _Pragma("unroll") for (int n = 0; n < 2; ++n) _Pragma("unroll") for (int k = 0; k < 2; ++k) \
        acc[ai][bj][m][n] = __builtin_amdgcn_mfma_f32_16x16x32_bf16(Bt[n][k], At[m][k], acc[ai][bj][m][n], 0, 0, 0); __builtin_amdgcn_s_setprio(0); } while (0)
#define PG8_WAIT_V(n) asm volatile("s_waitcnt vmcnt(" #n ")" ::: "memory")
#define PG8_WAIT_L(n) asm volatile("s_waitcnt lgkmcnt(" #n ")" ::: "memory")
#define PG8_BAR __builtin_amdgcn_s_barrier()
#define PG8_SCHED __builtin_amdgcn_sched_barrier(0)
    Unit cur, nxt; int ui = 0;
    if (!S.next(0, cur)) return;
    f32x4 acc[2][2][4][2];
#pragma unroll
    for (int a = 0; a < 2; ++a)
#pragma unroll
        for (int b = 0; b < 2; ++b)
#pragma unroll
            for (int m = 0; m < 4; ++m)
#pragma unroll
                for (int n = 0; n < 2; ++n) acc[a][b][m][n] = (f32x4){0.f, 0.f, 0.f, 0.f};
    bf16x8 At[4][2], B0[2][2], B1[2][2];
    const char* cA = (const char*)g.A + (size_t)cur.pm * tstep; const char* cB = (const char*)g.Bt + (size_t)cur.pn * tstep;
    S.a_ready(cur);
    if constexpr (SP2) {
        PG8_STAGE(PG8_SB(0, 0), cB, voffB); PG8_STAGE(PG8_SB(0, 1), cB + hstep, voffB); PG8_STAGE(PG8_SA(0, 0), cA, voffA); PG8_STAGE(PG8_SA(0, 1), cA + hstep, voffA);
        if (wr == 1) PG8_BAR;
        PG8_WAIT_V(2); PG8_BAR;
        PG8_STAGE(PG8_SB(1, 0), cB + kstep, voffB); PG8_STAGE(PG8_SA(1, 0), cA + kstep, voffA); PG8_STAGE(PG8_SB(1, 1), cB + hstep + kstep, voffB);
        PG8_WAIT_V(6); PG8_BAR;
    } else {
        PG8_STAGE(PG8_SB(0, 0), cB, voffB); PG8_STAGE(PG8_SA(0, 0), cA, voffA); PG8_STAGE(PG8_SB(0, 1), cB + hstep, voffB); PG8_STAGE(PG8_SA(0, 1), cA + hstep, voffA);
        if (wr == 1) PG8_BAR;
        PG8_WAIT_V(4); PG8_BAR;
        PG8_STAGE(PG8_SB(1, 0), cB + kstep, voffB); PG8_STAGE(PG8_SA(1, 0), cA + kstep, voffA); PG8_STAGE(PG8_SB(1, 1), cB + hstep + kstep, voffB);
        PG8_WAIT_V(6); PG8_BAR;
    }
    for (;;) {
        const bool has_next = S.next(ui + 1, nxt);
        const char* nA = has_next ? (const char*)g.A + (size_t)nxt.pm * tstep : cA; const char* nB = has_next ? (const char*)g.Bt + (size_t)nxt.pn * tstep : cB;
        for (int t = 0; t < nt; t += 2) {
            const bool last = (t == nt - 2);
            const char* a1 = cA + (size_t)(t + 1) * kstep;
            const char* a2 = last ? nA : cA + (size_t)(t + 2) * kstep; const char* b2 = last ? nB : cB + (size_t)(t + 2) * kstep;
            const char* a3 = a2 + kstep; const char* b3 = b2 + kstep;
            if (last && has_next) S.a_ready(nxt);
            if constexpr (SP2) {
            PG8_LDB(B0, 0, 0); PG8_LDB(B1, 0, 1); PG8_SCHED; PG8_LDA(At, 0, 0); PG8_STAGE(PG8_SA(1, 1), a1 + hstep, voffA);
            PG8_WAIT_V(8); PG8_WAIT_L(0); PG8_BAR; PG8_MMA(0, 0, At, B0); PG8_MMA(0, 1, At, B1); PG8_BAR; PG8_SCHED;
            PG8_LDA(At, 0, 1); PG8_STAGE(PG8_SB(0, 0), b2, voffB); PG8_STAGE(PG8_SB(0, 1), b2 + hstep, voffB); PG8_STAGE(PG8_SA(0, 0), a2, voffA);
            PG8_WAIT_V(8); PG8_WAIT_L(0); PG8_BAR; PG8_MMA(1, 0, At, B0); PG8_MMA(1, 1, At, B1); PG8_BAR; PG8_SCHED;
            PG8_LDB(B0, 1, 0); PG8_LDB(B1, 1, 1); PG8_SCHED; PG8_LDA(At, 1, 0); PG8_STAGE(PG8_SA(0, 1), a2 + hstep, voffA);
            PG8_WAIT_V(8); PG8_WAIT_L(0); PG8_BAR; PG8_MMA(0, 0, At, B0); PG8_MMA(0, 1, At, B1); PG8_BAR; PG8_SCHED;
            PG8_LDA(At, 1, 1); PG8_STAGE(PG8_SB(1, 0), b3, voffB); PG8_STAGE(PG8_SB(1, 1), b3 + hstep, voffB); PG8_STAGE(PG8_SA(1, 0), a3, voffA);
            PG8_WAIT_V(8); PG8_WAIT_L(0); PG8_BAR; PG8_MMA(1, 0, At, B0); PG8_MMA(1, 1, At, B1); PG8_BAR; PG8_SCHED;
            } else {
            PG8_LDB(B0, 0, 0); PG8_SCHED; PG8_LDA(At, 0, 0); PG8_STAGE(PG8_SA(1, 1), a1 + hstep, voffA);
            PG8_WAIT_L(8); PG8_BAR; PG8_WAIT_L(0); PG8_MMA(0, 0, At, B0); PG8_BAR; PG8_SCHED;
            PG8_LDB(B1, 0, 1); PG8_STAGE(PG8_SB(0, 0), b2, voffB);
            PG8_BAR; PG8_WAIT_L(0); PG8_MMA(0, 1, At, B1); PG8_BAR;
            PG8_LDA(At, 0, 1); PG8_STAGE(PG8_SA(0, 0), a2, voffA);
            PG8_BAR; PG8_WAIT_L(0); PG8_MMA(1, 0, At, B0); PG8_BAR; PG8_SCHED;
            PG8_STAGE(PG8_SB(0, 1), b2 + hstep, voffB);
            PG8_WAIT_V(6); PG8_BAR; PG8_MMA(1, 1, At, B1); PG8_BAR;
            PG8_LDB(B0, 1, 0); PG8_SCHED; PG8_LDA(At, 1, 0); PG8_STAGE(PG8_SA(0, 1), a2 + hstep, voffA);
            PG8_WAIT_L(8); PG8_BAR; PG8_WAIT_L(0); PG8_MMA(0, 0, At, B0); PG8_BAR; PG8_SCHED;
            PG8_LDB(B1, 1, 1); PG8_STAGE(PG8_SB(1, 0), b3, voffB);
            PG8_BAR; PG8_WAIT_L(0); PG8_MMA(0, 1, At, B1); PG8_BAR;
            PG8_LDA(At, 1, 1); PG8_STAGE(PG8_SA(1, 0), a3, voffA);
            PG8_BAR; PG8_WAIT_L(0); PG8_MMA(1, 0, At, B0); PG8_BAR; PG8_SCHED;
            PG8_STAGE(PG8_SB(1, 1), b3 + hstep, voffB);
            PG8_WAIT_V(6); PG8_BAR; PG8_MMA(1, 1, At, B1); PG8_BAR;
            }
        }
        if constexpr (ALIGN_EPI) { if (wr == 0) PG8_BAR; }
        if constexpr (!Epi::AFTER_DRAIN) { E(acc, cur, wr, wc, fr, fq); S.done(cur); }
        if (!has_next) break;
#pragma unroll
        for (int a = 0; a < 2; ++a)
#pragma unroll
            for (int b = 0; b < 2; ++b)
#pragma unroll
                for (int m = 0; m < 4; ++m)
#pragma unroll
                    for (int n = 0; n < 2; ++n) acc[a][b][m][n] = (f32x4){0.f, 0.f, 0.f, 0.f};
        cur = nxt; cA = nA; cB = nB; ++ui;
        if constexpr (ALIGN_EPI) { if (wr == 1) PG8_BAR; }
    }
    PG8_WAIT_V(0);
    if constexpr (!ALIGN_EPI) { if (wr == 0) PG8_BAR; }
    PG8_BAR;
    if constexpr (Epi::AFTER_DRAIN) { E.fused(acc, cur, wr, wc, fr, fq, lds, wid, lane); S.done(cur); }
#undef PG8_SA
#undef PG8_SB
#undef PG8_STAGE
#undef PG8_LDA
#undef PG8_LDB
#undef PG8_MMA
#undef PG8_WAIT_V
#undef PG8_WAIT_L
#undef PG8_BAR
#undef PG8_SCHED
}
}
#define LAS __attribute__((address_space(3)))
typedef unsigned short bf16;
typedef unsigned v4u __attribute__((ext_vector_type(4)));
typedef unsigned v2u __attribute__((ext_vector_type(2)));
typedef short v4i16_t __attribute__((ext_vector_type(4)));
using pg8::f32x4; using pg8::bf16x8; using pg8::cvt_pk_bf16;

constexpr int D = 1024, FF = 2816, NLAYER = 4, TG = 16384, NGROUP = 4, NTHR = 512, NWAVES = 8;
constexpr int PA_LD = 5632, PG_LD = 3072;
constexpr int C_HQ = 0, C_HI = 512, C_HZF = 1024, C_HZB = 1536, C_HG = 2048, C_CA = 2560, C_CB = 3072, C_CC = 3584, C_NQ = 4096, C_NK = 4608, C_NV = 5120;
constexpr size_t MiB = 1u << 20;
constexpr size_t WS_CTL = 0, CTL_BYTES = 1 * MiB, WS_W = 1 * MiB, WS_XB = 221 * MiB, WS_SSQ = 285 * MiB, WS_PA = 287 * MiB, WS_PG = 463 * MiB, WS_ONA = 559 * MiB, WS_SCR = 575 * MiB, WS_END = 671 * MiB;
constexpr size_t OFF_GU1 = 0, OFF_D1 = 5767168, OFF_IN = 8650752, OFF_HG = 17563648, OFF_CV = 18087936, OFF_NA = 18612224, OFF_OUT = 19136512, OFF_GU2 = 20185088, OFF_D2 = 25952256, LAYER_EL = 28835840;
constexpr int LDS_BYTES = 147456, LDS_MISC = 147456 - 64;
constexpr int PH_PER_PAIR = 1 + NLAYER * 16 + 1;
constexpr int CW_BAR = 4096;

__device__ __forceinline__ unsigned f2bf(float f) { unsigned u = __float_as_uint(f); return (u + 0x7fffu + ((u >> 16) & 1u)) >> 16; }
__device__ __forceinline__ float bf2f(unsigned b) { return __uint_as_float(b << 16); }
__device__ __forceinline__ float bflo(unsigned w) { return __uint_as_float(w << 16); }
__device__ __forceinline__ float bfhi(unsigned w) { return __uint_as_float(w & 0xffff0000u); }
__device__ __forceinline__ float sigm(float v) { return __builtin_amdgcn_rcpf(1.0f + __expf(-v)); }
__device__ __forceinline__ float wave_sum(float v) {
#pragma unroll
    for (int o = 1; o < 64; o <<= 1) v += __shfl_xor(v, o);
    return v;
}

__device__ __forceinline__ void cvt_item(const float* W, int K, int N, bf16* WT, const float* gain, bool permgu, LAS float* scr, int item, int lane) {
    const int nblk = N / 32, kb = item / nblk, nb = item % nblk, k0 = 64 * kb, n0 = 32 * nb;
#pragma unroll 8
    for (int i = 0; i < 32; ++i) { const int kk = 2 * i + (lane >> 5); const float g = gain ? gain[k0 + kk] : 1.0f; scr[kk * 33 + (lane & 31)] = W[(size_t)(k0 + kk) * N + n0 + (lane & 31)] * g; }
    asm volatile("s_waitcnt lgkmcnt(0)" ::: "memory");
    int dn0 = n0;
    if (permgu) { const int half = n0 >= FF ? 1 : 0; const int j = n0 - half * FF; dn0 = (j >> 7) * 256 + half * 128 + (j & 127); }
    const int c = lane & 7;
#pragma unroll
    for (int j = 0; j < 4; ++j) { const int n = (lane >> 3) + 8 * j; const LAS float* s = scr + (8 * c) * 33 + n;
        v4u o; o.x = cvt_pk_bf16(s[0 * 33], s[1 * 33]); o.y = cvt_pk_bf16(s[2 * 33], s[3 * 33]); o.z = cvt_pk_bf16(s[4 * 33], s[5 * 33]); o.w = cvt_pk_bf16(s[6 * 33], s[7 * 33]);
        *(v4u*)(WT + (size_t)(dn0 + n) * K + k0 + 8 * c) = o; }
    asm volatile("s_waitcnt lgkmcnt(0)" ::: "memory");
}

template <int K> __device__ __forceinline__ f32x4 mma_lds(f32x4 acc, const LAS bf16* A, int pa, const LAS bf16* B, int pb, int lane) {
    const int r = lane & 15, q = lane >> 4;
#pragma unroll
    for (int ks = 0; ks < K / 32; ++ks) {
        const bf16x8 a = *(const LAS bf16x8*)(A + r * pa + ks * 32 + q * 8);
        const bf16x8 b = *(const LAS bf16x8*)(B + r * pb + ks * 32 + q * 8);
        acc = __builtin_amdgcn_mfma_f32_16x16x32_bf16(a, b, acc, 0, 0, 0);
    }
    return acc;
}

constexpr int HP_QT = 0, HP_KTT = 17408, HP_AM = 35840, HP_ER = 45056, HP_EE = 45568, HP_BLK = 49152;
constexpr int HP_KT = 49152, HP_SEG = 66560;
constexpr int HS_VT = 49152, HS_ST = 53760, HS_BUF = 62464;
__device__ __forceinline__ void hg_prep_item(LAS unsigned char* lds, const bf16* PA, unsigned char* SCR, const float* lb_logits, int layer, int item, int T, int tid) {
    const int lane = tid & 63, wave = __builtin_amdgcn_readfirstlane(tid >> 6), c16 = lane & 15, quad = lane >> 4;
    const int nchunk = T / 64, c = item % nchunk, sd = item / nchunk, dir = sd & 1, h = (sd >> 1) & 3, seq = sd >> 3;
    const int base = seq * T;
    const int k = tid & 127, tq = tid >> 7;
    LAS bf16* QT = (LAS bf16*)(lds + HP_QT); LAS bf16* KT = (LAS bf16*)(lds + HP_KT); LAS bf16* KTT = (LAS bf16*)(lds + HP_KTT); LAS bf16* AM = (LAS bf16*)(lds + HP_AM);
    LAS float* SEG = (LAS float*)(lds + HP_SEG); LAS float* ER = (LAS float*)(lds + HP_ER); LAS float* EE = (LAS float*)(lds + HP_EE);
    float lb;
    { float lg[4], mx = -3e38f;
#pragma unroll
      for (int l = 0; l < 4; ++l) { lg[l] = lb_logits[(dir * 4 + l) * 512 + h * 128 + k]; mx = fmaxf(mx, lg[l]); }
      float tot = 0.f, num = 0.f;
#pragma unroll
      for (int l = 0; l < 4; ++l) { const float e = __expf(lg[l] - mx); tot += e; if (l >= 1 && l <= layer) num += e; }
      lb = num / tot; }
    const float oml = 1.0f - lb;
    const bf16* zsrc = PA + (dir ? C_HZB : C_HZF) + h * 128 + k;
    const bf16* qsrc = PA + C_HQ + h * 128 + k;
    unsigned short zr[16], qr[16];
#pragma unroll
    for (int i = 0; i < 16; ++i) { const int tau = c * 64 + 16 * tq + i; const size_t ro = (size_t)(base + (dir ? (T - 1 - tau) : tau)) * PA_LD; zr[i] = zsrc[ro]; qr[i] = qsrc[ro]; }
    float b[16], kv[16]; float cum = 0.f;
#pragma unroll
    for (int i = 0; i < 16; ++i) { const float zf = bf2f(zr[i]); const float sg = sigm(zf); const float f = lb + oml * sg; cum += __logf(fmaxf(f, 1e-30f)); b[i] = cum; kv[i] = oml * (1.0f - sg); }
    SEG[tq * 128 + k] = cum;
    __syncthreads();
    const float s0 = SEG[k], s1 = SEG[128 + k], s2 = SEG[256 + k], s3 = SEG[384 + k];
    const float pre = tq == 0 ? 0.f : (tq == 1 ? s0 : (tq == 2 ? s0 + s1 : (s0 + s1) + s2));
    const float r = s0 + s1, bend = (s0 + s1) + (s2 + s3);
    unsigned kpk[8];
#pragma unroll
    for (int i = 0; i < 16; ++i) {
        const float bt = pre + b[i];
        const float eq = __expf(fminf(bt - r, 80.f)), ek = __expf(fminf(r - bt, 80.f));
        const unsigned qb = f2bf(bf2f(qr[i]) * eq), kb = f2bf(kv[i] * ek);
        const int tau = 16 * tq + i;
        QT[tau * 136 + k] = (bf16)qb; KT[tau * 136 + k] = (bf16)kb;
        if (i & 1) kpk[i >> 1] |= kb << 16; else kpk[i >> 1] = kb;
    }
    *(LAS v4u*)(KTT + k * 72 + 16 * tq) = (v4u){kpk[0], kpk[1], kpk[2], kpk[3]};
    *(LAS v4u*)(KTT + k * 72 + 16 * tq + 8) = (v4u){kpk[4], kpk[5], kpk[6], kpk[7]};
    if (tq == 0) { ER[k] = __expf(r); EE[k] = __expf(bend - r); }
    __syncthreads();
#pragma unroll
    for (int e = 0; e < 2; ++e) { const int id = wave * 2 + e, tt = id >> 2, st = id & 3;
        f32x4 a = (f32x4){0.f, 0.f, 0.f, 0.f};
        if (st <= tt) a = mma_lds<128>(a, QT + tt * 16 * 136, 136, KT + st * 16 * 136, 136, lane);
#pragma unroll
        for (int i = 0; i < 4; ++i) { const int t = tt * 16 + quad * 4 + i, s = st * 16 + c16; const float val = (st <= tt && s <= t) ? a[i] : 0.f; AM[t * 72 + s] = (bf16)f2bf(val); } }
    __syncthreads();
    unsigned char* dst = SCR + (size_t)item * HP_BLK;
#pragma unroll
    for (int j = 0; j < 6; ++j) { const int idx = tid + 512 * j; *(v4u*)(dst + (size_t)idx * 16) = *(const LAS v4u*)(lds + idx * 16); }
    __syncthreads();
}

template <int NVT> __device__ __forceinline__ void hg_scan_item(LAS unsigned char* lds, bf16* PA, const unsigned char* SCR, int item, int T, int tid) {
    constexpr int NVS = 8 / NVT, VW = 16 * NVT, VTHR = 128 * NVT, VSH = (NVT == 2) ? 2 : 1;
    const int lane = tid & 63, wave = __builtin_amdgcn_readfirstlane(tid >> 6), c16 = lane & 15, quad = lane >> 4;
    const int vs = item % NVS, sd = item / NVS, dir = sd & 1, h = (sd >> 1) & 3, seq = sd >> 3;
    const int base = seq * T, nchunk = T / 64;
    const unsigned char* blk = SCR + (size_t)sd * nchunk * HP_BLK;
    const bf16* vsrc = PA + C_HI + h * 128 + vs * VW + (tid & (VW / 8 - 1)) * 8;
    bf16* odst = PA + (dir ? C_HZF : C_HQ) + h * 128 + vs * VW;
    v4u preA[6], preB[6]; v4u vrA = {0u, 0u, 0u, 0u}, vrB = vrA; f32x4 ervA, eevA, ervB, eevB;
#define HG_ROW(tau) (base + (dir ? (T - 1 - (tau)) : (tau)))
#define HS_LOAD(c, pre, vr, erv, eev) do { const int c_ = min((c), nchunk - 1); const unsigned char* bp = blk + (size_t)c_ * HP_BLK;     \
        _Pragma("unroll") for (int j = 0; j < 6; ++j) pre[j] = *(const v4u*)(bp + (size_t)(tid + 512 * j) * 16); \
        erv = *(const f32x4*)(bp + HP_ER + (wave * 16 + quad * 4) * 4); eev = *(const f32x4*)(blk + (size_t)max(c_ - 1, 0) * HP_BLK + HP_EE + (wave * 16 + quad * 4) * 4);     \
        vr = *(const v4u*)(vsrc + (size_t)HG_ROW(c_ * 64 + ((tid & (VTHR - 1)) >> VSH)) * PA_LD); } while (0)
    HS_LOAD(0, preA, vrA, ervA, eevA);
    HS_LOAD(1, preB, vrB, ervB, eevB);
    f32x4 accS[NVT];
#pragma unroll
    for (int e = 0; e < NVT; ++e) accS[e] = (f32x4){0.f, 0.f, 0.f, 0.f};
#define HS_STEP(c, BUFI, pre, vr, erv, eev) do { \
        LAS unsigned char* B = lds + (BUFI) * HS_BUF; \
        LAS bf16* QT = (LAS bf16*)(B + HP_QT); LAS bf16* KTT = (LAS bf16*)(B + HP_KTT); LAS bf16* AM = (LAS bf16*)(B + HP_AM); \
        LAS bf16* VT = (LAS bf16*)(B + HS_VT); LAS bf16* STt = (LAS bf16*)(B + HS_ST); \
        _Pragma("unroll") for (int j = 0; j < 6; ++j) *(LAS v4u*)(B + (tid + 512 * j) * 16) = pre[j]; \
        if (tid < VTHR) { const int s_ = tid >> VSH, vq = tid & (VW / 8 - 1); \
            VT[(vq * 8 + 0) * 72 + s_] = (bf16)(vr.x & 0xffffu); VT[(vq * 8 + 1) * 72 + s_] = (bf16)(vr.x >> 16); \
            VT[(vq * 8 + 2) * 72 + s_] = (bf16)(vr.y & 0xffffu); VT[(vq * 8 + 3) * 72 + s_] = (bf16)(vr.y >> 16); \
            VT[(vq * 8 + 4) * 72 + s_] = (bf16)(vr.z & 0xffffu); VT[(vq * 8 + 5) * 72 + s_] = (bf16)(vr.z >> 16); \
            VT[(vq * 8 + 6) * 72 + s_] = (bf16)(vr.w & 0xffffu); VT[(vq * 8 + 7) * 72 + s_] = (bf16)(vr.w >> 16); } \
        f32x4 sp[NVT]; const f32x4 sc_ = erv * eev;     \
        _Pragma("unroll") for (int e = 0; e < NVT; ++e) { sp[e] = accS[e] * sc_; v2u w; w.x = cvt_pk_bf16(sp[e][0], sp[e][1]); w.y = cvt_pk_bf16(sp[e][2], sp[e][3]); \
            *(LAS v2u*)(STt + (e * 16 + c16) * 136 + wave * 16 + quad * 4) = w; } \
        HS_LOAD((c) + 2, pre, vr, erv, eev); \
        __syncthreads(); \
        if ((wave >> 2) < NVT) { const int tt = wave & 3, vt = wave >> 2; f32x4 o = (f32x4){0.f, 0.f, 0.f, 0.f}; \
          o = mma_lds<128>(o, QT + tt * 16 * 136, 136, STt + vt * 16 * 136, 136, lane); \
          o = mma_lds<64>(o, AM + tt * 16 * 72, 72, VT + vt * 16 * 72, 72, lane); \
          _Pragma("unroll") for (int i = 0; i < 4; ++i) { const int tau = (c) * 64 + tt * 16 + quad * 4 + i; odst[(size_t)HG_ROW(tau) * PA_LD + vt * 16 + c16] = (bf16)f2bf(o[i]); } } \
        _Pragma("unroll") for (int e = 0; e < NVT; ++e) { accS[e] = mma_lds<64>(sp[e], KTT + wave * 16 * 72, 72, VT + e * 16 * 72, 72, lane); } \
    } while (0)
    for (int c = 0; c < nchunk; c += 2) {
        HS_STEP(c, 0, preA, vrA, ervA, eevA);
        HS_STEP(c + 1, 1, preB, vrB, ervB, eevB);
    }
    __syncthreads();
#undef HG_ROW
#undef HS_LOAD
#undef HS_STEP
}

__device__ __forceinline__ void na_item(LAS unsigned char* lds, const bf16* PA, const float* rpb, bf16* ONA, int item, int T, int tid) {
    const int lane = tid & 63, h = __builtin_amdgcn_readfirstlane(tid >> 6), c16 = lane & 15, quad = lane >> 4;
    const int ips = T / 16, seq = item / ips, rem = item % ips, r = rem >> 2, j = rem & 3;
    const int rows = T / 64, rs = min(max(r - 4, 0), rows - 8), kstart = (j == 0) ? 0 : (j == 1) ? 8 : (j == 2) ? 24 : 32;
    const int base = seq * T, qtok = base + r * 64 + 16 * j + c16;
    const bf16* qp = PA + (size_t)qtok * PA_LD + C_NQ + h * 64 + quad * 8;
    const bf16x8 Qb0 = *(const bf16x8*)qp, Qb1 = *(const bf16x8*)(qp + 32);
    const int qcol = 16 * j + c16, cs = min(max(qcol - 8, 0), 48);
    v4u vbufA[8], vbufB[8];
#define NA_VLOAD(qd, vbuf) do { _Pragma("unroll") for (int it = 0; it < 8; ++it) { const int idx = it * 64 + lane, key = idx >> 3, dg = idx & 7; \
        const int tok = base + (rs + 2 * (qd) + (key >> 5)) * 64 + kstart + (key & 31); vbuf[it] = *(const v4u*)(PA + (size_t)tok * PA_LD + C_NV + h * 64 + dg * 8); } } while (0)
    NA_VLOAD(0, vbufA); NA_VLOAD(1, vbufB);
    const float* rp = rpb + h * 465;
    f32x4 sacc[16]; float mx = -3e38f;
    int dcv[8]; bool okv[8];
#pragma unroll
    for (int e = 0; e < 8; ++e) { const int kcol = kstart + (e >> 2) * 16 + quad * 4 + (e & 3); okv[e] = (kcol >= cs) && (kcol < cs + 16); dcv[e] = min(max(kcol - qcol + 15, 0), 30); }
#pragma unroll
    for (int a = 0; a < 8; ++a) {
        const float* rpa = rp + (rs + a - r + 7) * 31;
#pragma unroll
        for (int hh = 0; hh < 2; ++hh) {
            const int ktok = base + (rs + a) * 64 + kstart + hh * 16 + c16;
            const bf16* kp = PA + (size_t)ktok * PA_LD + C_NK + h * 64 + quad * 8;
            const bf16x8 Ka0 = *(const bf16x8*)kp, Ka1 = *(const bf16x8*)(kp + 32);
            f32x4 s = (f32x4){0.f, 0.f, 0.f, 0.f};
            s = __builtin_amdgcn_mfma_f32_16x16x32_bf16(Ka0, Qb0, s, 0, 0, 0);
            s = __builtin_amdgcn_mfma_f32_16x16x32_bf16(Ka1, Qb1, s, 0, 0, 0);
#pragma unroll
            for (int i = 0; i < 4; ++i) { const float val = okv[hh * 4 + i] ? s[i] * 0.125f + rpa[dcv[hh * 4 + i]] : -1e30f; s[i] = val; mx = fmaxf(mx, val); }
            sacc[a * 2 + hh] = s;
        }
    }
    mx = fmaxf(mx, __shfl_xor(mx, 16)); mx = fmaxf(mx, __shfl_xor(mx, 32));
    float sum = 0.f;
#pragma unroll
    for (int t = 0; t < 16; ++t)
#pragma unroll
        for (int i = 0; i < 4; ++i) { const float p = __expf(sacc[t][i] - mx); sacc[t][i] = p; sum += p; }
    sum += __shfl_xor(sum, 16); sum += __shfl_xor(sum, 32);
    bf16x8 pb[8];
#pragma unroll
    for (int a = 0; a < 8; ++a) { v4u w; w.x = cvt_pk_bf16(sacc[2 * a][0], sacc[2 * a][1]); w.y = cvt_pk_bf16(sacc[2 * a][2], sacc[2 * a][3]);
        w.z = cvt_pk_bf16(sacc[2 * a + 1][0], sacc[2 * a + 1][1]); w.w = cvt_pk_bf16(sacc[2 * a + 1][2], sacc[2 * a + 1][3]); pb[a] = __builtin_bit_cast(bf16x8, w); }
    LAS bf16* VS = (LAS bf16*)(lds + h * 10240);
    f32x4 oacc[4];
#pragma unroll
    for (int dt = 0; dt < 4; ++dt) oacc[dt] = (f32x4){0.f, 0.f, 0.f, 0.f};
    const int trq = (lane & 15) >> 2, trp = lane & 3;
    const LAS bf16* trbase = VS + (quad * 4 + trq) * 80 + 4 * trp;
#define NA_PV(qd, vbuf) do { \
        _Pragma("unroll") for (int it = 0; it < 8; ++it) { const int idx = it * 64 + lane, key = idx >> 3, dg = idx & 7; *(LAS v4u*)(VS + key * 80 + dg * 8) = vbuf[it]; } \
        if ((qd) + 2 < 4) { NA_VLOAD((qd) + 2, vbuf); } \
        _Pragma("unroll") for (int al = 0; al < 2; ++al) \
            _Pragma("unroll") for (int dt = 0; dt < 4; ++dt) { const LAS bf16* p = trbase + al * 32 * 80 + dt * 16; \
                const v4i16_t lo = __builtin_amdgcn_ds_read_tr16_b64_v4i16((LAS v4i16_t*)p), hi = __builtin_amdgcn_ds_read_tr16_b64_v4i16((LAS v4i16_t*)(p + 16 * 80)); \
                const bf16x8 af = {lo[0], lo[1], lo[2], lo[3], hi[0], hi[1], hi[2], hi[3]}; \
                oacc[dt] = __builtin_amdgcn_mfma_f32_16x16x32_bf16(af, pb[(qd) * 2 + al], oacc[dt], 0, 0, 0); } } while (0)
    NA_PV(0, vbufA); NA_PV(1, vbufB); NA_PV(2, vbufA); NA_PV(3, vbufB);
#undef NA_PV
#undef NA_VLOAD
    const float inv = __builtin_amdgcn_rcpf(sum);
#pragma unroll
    for (int dt = 0; dt < 4; ++dt) { const f32x4 o = oacc[dt] * inv; v2u w; w.x = cvt_pk_bf16(o[0], o[1]); w.y = cvt_pk_bf16(o[2], o[3]);
        *(v2u*)(ONA + (size_t)qtok * 512 + h * 64 + dt * 16 + quad * 4) = w; }
}

#define XB_TMO      128
#define XB_XCNT(j)  (256  + 64 * (j))
#define XB_XSUB(j)  (1280 + 64 * (j))
#define XB_XGEN(j)  (2304 + 64 * (j))
#define XB_TOP      3328
#define XB_TOPGEN   3392
#define XCD_BAR_WORDS 3456
#define XB_SPIN_CAP (1u << 18)

__device__ __forceinline__ unsigned xb_ld(unsigned* p)              { return __hip_atomic_load(p, __ATOMIC_RELAXED, __HIP_MEMORY_SCOPE_AGENT); }
__device__ __forceinline__ unsigned xb_add(unsigned* p, unsigned v) { return __hip_atomic_fetch_add(p, v, __ATOMIC_RELAXED, __HIP_MEMORY_SCOPE_AGENT); }
__device__ __forceinline__ unsigned xb_xcc_id() { return (unsigned)__builtin_amdgcn_s_getreg((3 << 11) | 20) & 0xFu; }
#define XB_SPIN(cond, bar) do { unsigned _sp = 0; while (cond) { __builtin_amdgcn_s_sleep(1); \
    if ((++_sp & 255u) == 0u) { if (xb_ld(&(bar)[XB_TMO])) break; if (_sp > XB_SPIN_CAP) { atomicAdd(&(bar)[XB_TMO], 1u); break; } } } } while (0)

struct XcdBarrier {
    unsigned* bar; unsigned x;
    volatile LAS unsigned* st;
};

__device__ __forceinline__ XcdBarrier xcd_barrier_post(unsigned* bar, volatile LAS unsigned* st) {
    XcdBarrier b; b.bar = bar; b.x = xb_xcc_id(); b.st = st;
    if (threadIdx.x == 0) (void)xb_add(&bar[XB_XCNT(b.x)], 1u);
    return b;
}
__device__ __forceinline__ void xcd_barrier_complete(unsigned* bar, unsigned x, unsigned& nloc, unsigned& nx) {
    const unsigned G = gridDim.x * gridDim.y * gridDim.z;
    unsigned sum, cnt, mine, sp = 0u;
    for (;;) {
        sum = 0u; cnt = 0u; mine = 0u;
#pragma unroll
        for (unsigned j = 0; j < 16; ++j) { const unsigned c = xb_ld(&bar[XB_XCNT(j)]); sum += c; cnt += (c > 0u) ? 1u : 0u; mine = (j == x) ? c : mine; }
        if (sum == G) break;
        __builtin_amdgcn_s_sleep(1);
        if ((++sp & 255u) == 0u) { if (xb_ld(&bar[XB_TMO])) break; if (sp > XB_SPIN_CAP) { atomicAdd(&bar[XB_TMO], 1u); break; } }
    }
    nloc = mine > 0u ? mine : 1u; nx = cnt > 0u ? cnt : 1u;
}

__device__ __forceinline__ void xcd_barrier(const XcdBarrier& b) {
    asm volatile("s_waitcnt vmcnt(0)" ::: "memory");
    __syncthreads();
    if (threadIdx.x == 0) {
        unsigned* bar = b.bar;
        __builtin_amdgcn_s_waitcnt(0);
        unsigned nloc = b.st[0], nx = b.st[1];
        if (nloc == 0u) { xcd_barrier_complete(bar, b.x, nloc, nx); b.st[0] = nloc; b.st[1] = nx; }
        const unsigned old = xb_add(&bar[XB_XSUB(b.x)], 1u);
        const unsigned gen = old / nloc;
        if (old + 1u == (gen + 1u) * nloc) {
            __builtin_amdgcn_fence(__ATOMIC_RELEASE, "agent");
            asm volatile("s_waitcnt vmcnt(0)" ::: "memory");
            const unsigned og = xb_add(&bar[XB_TOP], 1u);
            const unsigned tg = og / nx;
            if (og + 1u == (tg + 1u) * nx) xb_add(&bar[XB_TOPGEN], 1u);
            else XB_SPIN(xb_ld(&bar[XB_TOPGEN]) == tg, bar);
            __builtin_amdgcn_fence(__ATOMIC_ACQUIRE, "agent");
            xb_add(&bar[XB_XGEN(b.x)], 1u);
            asm volatile("s_waitcnt vmcnt(0)" ::: "memory");
        } else {
            XB_SPIN(xb_ld(&bar[XB_XGEN(b.x)]) == gen, bar);
            __builtin_amdgcn_fence(__ATOMIC_ACQUIRE, "agent");
            asm volatile("s_waitcnt vmcnt(0)" ::: "memory");
        }
    }
    __syncthreads();
}
struct Args { const float* in[20]; float* out; unsigned char* ws; int ph_lo, ph_hi; };
enum { K_CVT = 0, K_G0, K_UP, K_RES, K_M1, K_M2A, K_M2B, K_M3, K_M4, K_GF };

__global__ void __launch_bounds__(NTHR, 2) mk_fwd(Args args) {
    extern __shared__ __attribute__((aligned(16))) unsigned char lds_raw[];
    LAS unsigned char* lds = (LAS unsigned char*)lds_raw;
    cg::grid_group grid = cg::this_grid();
    const int hi = args.ph_hi;
    { volatile LAS unsigned* st0 = (volatile LAS unsigned*)(lds + LDS_MISC + 32); if (threadIdx.x < 2) st0[threadIdx.x] = 0u; __syncthreads(); }
    XcdBarrier xbar = xcd_barrier_post((unsigned*)(args.ws + WS_CTL) + CW_BAR, (volatile LAS unsigned*)(lds + LDS_MISC + 32));
#if TPROBE
    unsigned long long tacc = 0ull;
#endif
    for (int ph = args.ph_lo; ph < hi; ++ph) {
#if TPROBE
        const unsigned long long tp0 = __builtin_amdgcn_s_memrealtime();
#endif
        int bid = blockIdx.x, G = gridDim.x; asm volatile("" : "+s"(bid), "+s"(G));
        int tid = threadIdx.x; asm volatile("" : "+v"(tid));
        const int lane = tid & 63, wave = __builtin_amdgcn_readfirstlane(tid >> 6);
        const int gw = bid * NWAVES + wave, NGW = G * NWAVES;
        int kind, pr = 0, l = 0, s = 0, g2 = 0;
        if (ph == 0) kind = K_CVT;
        else { const int q = ph - 1; pr = q / PH_PER_PAIR; const int r = q % PH_PER_PAIR;
            if (r == 0) kind = K_G0; else if (r == PH_PER_PAIR - 1) kind = K_GF;
            else { l = (r - 1) / 16; s = (r - 1) % 16;
                if (s == 0 || s == 14) kind = K_UP; else if (s == 1 || s == 15) kind = K_RES;
                else { g2 = (s - 2) / 6; const int t = (s - 2) % 6; kind = (t == 0) ? K_M1 : (t == 1) ? K_M2A : (t == 2) ? K_M2B : (t == 3) ? K_M3 : (t == 4) ? K_M4 : K_RES; } } }
        const bool mix = (s >= 2 && s <= 13);
        unsigned char* ws = args.ws;
        bf16* XBp = (bf16*)(ws + WS_XB); float* SSQp = (float*)(ws + WS_SSQ);
        bf16* XB = XBp + (size_t)g2 * TG * D; float* SSQ = SSQp + (size_t)g2 * TG * 16;
        bf16* PA = (bf16*)(ws + WS_PA); bf16* PG = (bf16*)(ws + WS_PG);
        bf16* ONA = (bf16*)(ws + WS_ONA); bf16* OHG = ONA + (size_t)TG * 512; bf16* OCV = OHG + (size_t)TG * 512;
        unsigned char* SCR = ws + WS_SCR;
        const bf16* Wl = (const bf16*)(ws + WS_W) + (size_t)l * LAYER_EL;
        const int T = pr == 0 ? 2048 : 4096;
        const int g = pr * 2 + g2;
        float* X = args.out + (size_t)pr * 2 * TG * D;

        if (kind == K_CVT) {
            LAS float* scr = (LAS float*)(lds + wave * 16384);
            constexpr int I_GU = 16 * 176, I_DN = 44 * 32, I_IN = 16 * 272, I_MX = 8 * 32, I_OUT = 16 * 32;
            constexpr int I_LAYER = 2 * I_GU + 2 * I_DN + I_IN + 3 * I_MX + I_OUT;
            for (int rep = 0; rep < REP_MISC; ++rep) for (int it = gw; it < NLAYER * I_LAYER; it += NGW) {
                const int ll = it / I_LAYER; int r = it % I_LAYER; bf16* Wd = (bf16*)(ws + WS_W) + (size_t)ll * LAYER_EL;
                const float* src; const float* gain = nullptr; int K, N; size_t off; bool perm = false;
                if (r < I_GU) { src = args.in[3] + (size_t)ll * D * 2 * FF; K = D; N = 2 * FF; off = OFF_GU1; gain = args.in[2] + ll * D; perm = true; }
                else if ((r -= I_GU) < I_DN) { src = args.in[4] + (size_t)ll * FF * D; K = FF; N = D; off = OFF_D1; }
                else if ((r -= I_DN) < I_IN) { src = args.in[6] + (size_t)ll * D * 8704; K = D; N = 8704; off = OFF_IN; gain = args.in[5] + ll * D; }
                else if ((r -= I_IN) < I_MX) { src = args.in[9] + (size_t)ll * 512 * D; K = 512; N = D; off = OFF_HG; }
                else if ((r -= I_MX) < I_MX) { src = args.in[12] + (size_t)ll * 512 * D; K = 512; N = D; off = OFF_CV; }
                else if ((r -= I_MX) < I_MX) { src = args.in[14] + (size_t)ll * 512 * D; K = 512; N = D; off = OFF_NA; }
                else if ((r -= I_MX) < I_OUT) { src = args.in[15] + (size_t)ll * D * D; K = D; N = D; off = OFF_OUT; }
                else if ((r -= I_OUT) < I_GU) { src = args.in[17] + (size_t)ll * D * 2 * FF; K = D; N = 2 * FF; off = OFF_GU2; gain = args.in[16] + ll * D; perm = true; }
                else { r -= I_GU; src = args.in[18] + (size_t)ll * FF * D; K = FF; N = D; off = OFF_D2; }
                cvt_item(src, K, N, Wd + off, gain, perm, scr, r, lane);
            }
        } else if (kind == K_G0) {
            const float* xin = pr == 0 ? args.in[0] : args.in[1];
            for (int rep = 0; rep < REP_MISC; ++rep) for (int row = gw; row < 2 * TG; row += NGW) {
                const f32x4* xr = (const f32x4*)(xin + (size_t)row * D) + lane; v2u* bo = (v2u*)(XBp + (size_t)row * D) + lane;
                float ss = 0.f;
#pragma unroll
                for (int j = 0; j < 4; ++j) { const f32x4 v = xr[64 * j]; v2u w; w.x = cvt_pk_bf16(v[0], v[1]); w.y = cvt_pk_bf16(v[2], v[3]); bo[64 * j] = w; ss += (v[0] * v[0] + v[1] * v[1]) + (v[2] * v[2] + v[3] * v[3]); }
                ss = wave_sum(ss);
                if (lane < 16) SSQp[(size_t)row * 16 + lane] = lane == 0 ? ss : 0.f;
            }
        } else if (kind == K_UP) {
            pg8::Gemm gm{XBp, Wl + (s == 14 ? OFF_GU2 : OFF_GU1), 2 * TG, 2 * FF, D}; pg8::StaticOrder S; S.init(2 * TG, 2 * FF, G, bid);
            pg8::EpiSwiGLU E{PA, SSQp};
#ifndef NO_UP
            for (int rep = 0; rep < REP_GEMM; ++rep) pg8::gemm_phase<pg8::EpiSwiGLU, pg8::StaticOrder, true, true>(lds, gm, S, E);
#endif
        } else if (kind == K_RES) {
            const int K = mix ? D : FF, Mr = mix ? TG : 2 * TG; const size_t off = mix ? OFF_OUT : (s == 1 ? OFF_D1 : OFF_D2);
            pg8::Gemm gm{PA, Wl + off, Mr, D, K}; pg8::StaticOrder S; S.init(Mr, D, G, bid);
            pg8::EpiRes E{mix ? XB : XBp, mix ? SSQ : SSQp, mix ? 1.0f : 0.5f};
#ifndef NO_RES
            for (int rep = 0; rep < REP_RES; ++rep) { if (rep + 1 < REP_RES) { pg8::EpiRes E0 = E; E0.alpha = 0.f; pg8::gemm_phase<pg8::EpiRes, pg8::StaticOrder, true, true>(lds, gm, S, E0); }
                else pg8::gemm_phase<pg8::EpiRes, pg8::StaticOrder, true, true>(lds, gm, S, E); }
#endif
        } else if (kind == K_M1) {
            pg8::Gemm gm{XB, Wl + OFF_IN, TG, 8704, D}; pg8::StaticOrder S; S.init(TG, 8704, G, bid);
            pg8::EpiProj E{PA, PG, SSQ};
#ifndef NO_PROJ
            for (int rep = 0; rep < REP_GEMM; ++rep) pg8::gemm_phase<pg8::EpiProj, pg8::StaticOrder, true, true>(lds, gm, S, E);
#endif
        } else if (kind == K_M2A) {
#ifndef NO_HG
            { const int nP = (TG / 64) * 8;
              for (int rep = 0; rep < REP_HG; ++rep) for (int it = bid; it < nP; it += G) hg_prep_item(lds, PA, SCR, args.in[7], l, it, T, tid); }
#endif
            const float* rpb = args.in[13] + (size_t)l * 8 * 465;
            const int vcu = (G % 8 == 0) ? (bid % 8) * (G / 8) + bid / 8 : bid;
            const int nNA = TG / 16, ipb = (nNA + G - 1) / G;
            for (int rep = 0; rep < REP_NA; ++rep)
                for (int q = 0; q < ipb; ++q) { const int it = vcu * ipb + q; if (it < nNA) {
#ifndef NO_NA
                    na_item(lds, PA, rpb, ONA, it, T, tid);
#endif
                    __syncthreads(); } }
        } else if (kind == K_M2B) {
#ifndef NO_HG
            const int vcu2 = (G % 8 == 0) ? (bid % 8) * (G / 8) + bid / 8 : bid;
            for (int rep = 0; rep < REP_HG; ++rep) {
                if (pr == 0) { for (int it = vcu2; it < 256; it += G) hg_scan_item<2>(lds, PA, SCR, it, T, tid); }
                else       { for (int it = vcu2; it < 256; it += G) hg_scan_item<1>(lds, PA, SCR, it, T, tid); }
            }
#endif
        } else if (kind == K_M3) {
            const float* gno = args.in[8] + l * 512; const float* cw = args.in[10] + l * 3 * 512; const float* cbias = args.in[11] + l * 512;
            const int c0 = lane * 8;
            for (int rep = 0; rep < REP_M3; ++rep) for (int row = gw; row < TG; row += NGW) {
                const bf16* prow = PA + (size_t)row * PA_LD;
                const v4u fw = *(const v4u*)(prow + C_HQ + c0), bw = *(const v4u*)(prow + C_HZF + c0);
                float o[8] = {bflo(fw.x) + bflo(bw.x), bfhi(fw.x) + bfhi(bw.x), bflo(fw.y) + bflo(bw.y), bfhi(fw.y) + bfhi(bw.y), bflo(fw.z) + bflo(bw.z), bfhi(fw.z) + bfhi(bw.z), bflo(fw.w) + bflo(bw.w), bfhi(fw.w) + bfhi(bw.w)};
                float ss = 0.f;
#pragma unroll
                for (int e = 0; e < 8; ++e) ss += o[e] * o[e];
                ss += __shfl_xor(ss, 1); ss += __shfl_xor(ss, 2); ss += __shfl_xor(ss, 4); ss += __shfl_xor(ss, 8);
                const float rs = __builtin_amdgcn_rsqf(ss * (1.0f / 128.0f) + 1e-6f);
                const v4u hgw = *(const v4u*)(prow + C_HG + c0);
                const float hgv[8] = {bflo(hgw.x), bfhi(hgw.x), bflo(hgw.y), bfhi(hgw.y), bflo(hgw.z), bfhi(hgw.z), bflo(hgw.w), bfhi(hgw.w)};
                const f32x4 gn0 = *(const f32x4*)(gno + c0), gn1 = *(const f32x4*)(gno + c0 + 4);
                const float gn[8] = {gn0[0], gn0[1], gn0[2], gn0[3], gn1[0], gn1[1], gn1[2], gn1[3]};
                float r8[8];
#pragma unroll
                for (int e = 0; e < 8; ++e) r8[e] = o[e] * rs * gn[e] * (hgv[e] * sigm(hgv[e]));
                v4u wo; wo.x = cvt_pk_bf16(r8[0], r8[1]); wo.y = cvt_pk_bf16(r8[2], r8[3]); wo.z = cvt_pk_bf16(r8[4], r8[5]); wo.w = cvt_pk_bf16(r8[6], r8[7]);
                *(v4u*)(OHG + (size_t)row * 512 + c0) = wo;
                const int tl = row & (T - 1);
                const v4u a1 = *(const v4u*)(prow + C_CA + c0), c1 = *(const v4u*)(prow + C_CC + c0), bb = *(const v4u*)(prow + C_CB + c0);
                v4u a0 = {0u, 0u, 0u, 0u}, cc0 = a0, a2 = a0, cc2 = a0;
                if (tl > 0) { a0 = *(const v4u*)(prow - PA_LD + C_CA + c0); cc0 = *(const v4u*)(prow - PA_LD + C_CC + c0); }
                if (tl < T - 1) { a2 = *(const v4u*)(prow + PA_LD + C_CA + c0); cc2 = *(const v4u*)(prow + PA_LD + C_CC + c0); }
                const float zm[8] = {bflo(a0.x) * bflo(cc0.x), bfhi(a0.x) * bfhi(cc0.x), bflo(a0.y) * bflo(cc0.y), bfhi(a0.y) * bfhi(cc0.y), bflo(a0.z) * bflo(cc0.z), bfhi(a0.z) * bfhi(cc0.z), bflo(a0.w) * bflo(cc0.w), bfhi(a0.w) * bfhi(cc0.w)};
                const float zc[8] = {bflo(a1.x) * bflo(c1.x), bfhi(a1.x) * bfhi(c1.x), bflo(a1.y) * bflo(c1.y), bfhi(a1.y) * bfhi(c1.y), bflo(a1.z) * bflo(c1.z), bfhi(a1.z) * bfhi(c1.z), bflo(a1.w) * bflo(c1.w), bfhi(a1.w) * bfhi(c1.w)};
                const float zp[8] = {bflo(a2.x) * bflo(cc2.x), bfhi(a2.x) * bfhi(cc2.x), bflo(a2.y) * bflo(cc2.y), bfhi(a2.y) * bfhi(cc2.y), bflo(a2.z) * bflo(cc2.z), bfhi(a2.z) * bfhi(cc2.z), bflo(a2.w) * bflo(cc2.w), bfhi(a2.w) * bfhi(cc2.w)};
                const float cbv[8] = {bflo(bb.x), bfhi(bb.x), bflo(bb.y), bfhi(bb.y), bflo(bb.z), bfhi(bb.z), bflo(bb.w), bfhi(bb.w)};
                const f32x4 w00 = *(const f32x4*)(cw + c0), w01 = *(const f32x4*)(cw + c0 + 4), w10 = *(const f32x4*)(cw + 512 + c0), w11 = *(const f32x4*)(cw + 512 + c0 + 4);
                const f32x4 w20 = *(const f32x4*)(cw + 1024 + c0), w21 = *(const f32x4*)(cw + 1024 + c0 + 4), bs0 = *(const f32x4*)(cbias + c0), bs1 = *(const f32x4*)(cbias + c0 + 4);
#pragma unroll
                for (int e = 0; e < 4; ++e) { r8[e] = cbv[e] * (w00[e] * zm[e] + w10[e] * zc[e] + w20[e] * zp[e] + bs0[e]); r8[4 + e] = cbv[4 + e] * (w01[e] * zm[4 + e] + w11[e] * zc[4 + e] + w21[e] * zp[4 + e] + bs1[e]); }
                wo.x = cvt_pk_bf16(r8[0], r8[1]); wo.y = cvt_pk_bf16(r8[2], r8[3]); wo.z = cvt_pk_bf16(r8[4], r8[5]); wo.w = cvt_pk_bf16(r8[6], r8[7]);
                *(v4u*)(OCV + (size_t)row * 512 + c0) = wo;
            }
        } else if (kind == K_M4) {
            pg8::Gemm gm{ONA, Wl + OFF_HG, 3 * TG, 3 * D, 512}; pg8::MergeOrder S; S.init(TG, D, G, bid);
            pg8::EpiMerge E{PG, PA};
#ifndef NO_MERGE
            for (int rep = 0; rep < REP_MERGE; ++rep) pg8::gemm_phase<pg8::EpiMerge, pg8::MergeOrder, true, true>(lds, gm, S, E);
#endif
        } else {
            const f32x4* fg = (const f32x4*)args.in[19] + lane;
            for (int rep = 0; rep < REP_MISC; ++rep) for (int row = gw; row < 2 * TG; row += NGW) {
                const float rs = pg8::row_rs(SSQp, row);
                f32x4* xo = (f32x4*)(X + (size_t)row * D) + lane; const v2u* bi = (const v2u*)(XBp + (size_t)row * D) + lane;
#pragma unroll
                for (int j = 0; j < 4; ++j) { const v2u w = bi[64 * j]; const f32x4 v = {bflo(w.x), bfhi(w.x), bflo(w.y), bfhi(w.y)}; xo[64 * j] = v * fg[64 * j] * rs; }
            }
        }
#if TPROBE
        __syncthreads();
        const unsigned long long tp1 = __builtin_amdgcn_s_memrealtime();
#endif
        if (ph + 1 < hi) { for (int rep = 0; rep < REP_SYNC; ++rep) { if (ph == 0) grid.sync(); else xcd_barrier(xbar); } }
#if TPROBE
        const unsigned long long tp2 = __builtin_amdgcn_s_memrealtime();
        if (TPROBE == 100) tacc += tp2 - tp1;
        else if (kind == TPROBE - 1) tacc += tp1 - tp0;
#endif
    }
#if TPROBE
    if (blockIdx.x == TPROBE_BLOCK) { const unsigned long long te = __builtin_amdgcn_s_memrealtime(); while (__builtin_amdgcn_s_memrealtime() - te < tacc) __builtin_amdgcn_s_sleep(8); }
#endif
}
constexpr int N_PHASES = 1 + 2 * PH_PER_PAIR;

extern "C" void kernel_launch(void* const* d_in, const int* in_sizes, int n_in, void* d_out, int out_size, void* d_ws, size_t ws_size, hipStream_t stream) {
    static int grid = 0;
    if (grid == 0) {
        if (n_in != 20 || ws_size < WS_END) { fprintf(stderr, "kernel_launch: unexpected n_in %d / ws %zu\n", n_in, ws_size); grid = -1; return; }
        int dev = 0, cus = 0, per_cu = 0;
        hipGetDevice(&dev); hipDeviceGetAttribute(&cus, hipDeviceAttributeMultiprocessorCount, dev);
        hipFuncSetAttribute((const void*)mk_fwd, hipFuncAttributeMaxDynamicSharedMemorySize, LDS_BYTES);
        hipOccupancyMaxActiveBlocksPerMultiprocessor(&per_cu, (const void*)mk_fwd, NTHR, LDS_BYTES);
        if (per_cu < 1) per_cu = 1;
        grid = cus * per_cu;
        (void)hipGetLastError();
    }
    if (grid < 0) return;
    hipMemsetAsync((char*)d_ws + WS_CTL, 0, CTL_BYTES, stream);
    Args a{};
    for (int i = 0; i < 20; ++i) a.in[i] = (const float*)d_in[i];
    a.out = (float*)d_out; a.ws = (unsigned char*)d_ws;
#if ONE_LAUNCH
    a.ph_lo = 0; a.ph_hi = N_PHASES;
    void* kargs[] = {&a};
    hipError_t e = hipLaunchCooperativeKernel((const void*)mk_fwd, dim3(grid), dim3(NTHR), kargs, LDS_BYTES, stream);
    if (e != hipSuccess) fprintf(stderr, "cooperative launch failed: %s (grid %d)\n", hipGetErrorString(e), grid);
#else
    for (int p = 0; p < N_PHASES; ++p) { a.ph_lo = p; a.ph_hi = p + 1; hipLaunchKernelGGL(mk_fwd, dim3(grid), dim3(NTHR), LDS_BYTES, stream, a); }
#endif
}
```

```cpp
#include <hip/hip_runtime.h>
#include <hip/hip_cooperative_groups.h>
#include <cstdio>
#include <cstdint>
namespace cg = cooperative_groups;
#ifndef ONE_LAUNCH
#define ONE_LAUNCH 1
#endif
#ifndef REP_HG
#define REP_HG 1
#endif
#ifndef REP_NA
#define REP_NA 1
#endif
#ifndef REP_SYNC
#define REP_SYNC 1
#endif
#ifndef REP_GEMM
#define REP_GEMM 1
#endif
#ifndef REP_M3
#define REP_M3 1
#endif
#ifndef REP_RES
#define REP_RES 1
#endif
#ifndef REP_MERGE
#define REP_MERGE 1
#endif
#ifndef REP_MISC
#define REP_MISC 1
#endif
#ifndef TPROBE
#define TPROBE 0
#endif
#ifndef TPROBE_BLOCK
#define TPROBE_BLOCK 0
#endif
#ifndef PGA
#define PGA true
#endif
#ifndef PGS
#define PGS true
#endif
namespace pg8 {
#define PG8_LAS __attribute__((address_space(3)))
typedef unsigned short bf16_t;
typedef short bf16x8 __attribute__((ext_vector_type(8)));
typedef float f32x4 __attribute__((ext_vector_type(4)));
typedef unsigned u32x4 __attribute__((ext_vector_type(4)));
constexpr int BM = 256, BK = 64, HALF = 128, HTB = HALF * BK * 2  , STAGE_BYTES = 8 * HTB, NXCD = 8, WGM = 8;

__host__ __device__ __forceinline__ int lds_byte(int r, int c) { const int st = (r >> 4) * 2 + (c >> 5), rr = r & 15, cc = c & 31, ob = rr * 64 + cc * 2; return st * 1024 + (ob ^ (((ob >> 9) & 1) << 5)); }
__host__ __device__ __forceinline__ void stage_rc(int b, int& R, int& C) { const int st = b / 1024, sb = b % 1024, swz = sb ^ (((sb >> 9) & 1) << 5); R = (st >> 1) * 16 + swz / 64; C = (st & 1) * 32 + (swz % 64) / 2; }
__host__ __device__ __forceinline__ int perm32(int rho) { const int n = rho >> 4, i = rho & 15; return 8 * (i >> 2) + 4 * n + (i & 3); }

struct Unit { int pm, pn; };
struct Gemm { const bf16_t* A; const bf16_t* Bt; int M, N, K; };

struct StaticOrder {
    int nM, nN, nwg, G, c;
    __host__ __device__ void init(int M, int N, int G_, int c_) { nM = M / BM; nN = N / BM; nwg = nM * nN; G = G_; c = c_; }
    __host__ __device__ bool next(int i, Unit& u) const {
        const long L = (long)i * G + c; if (L >= nwg) return false;
        int wgid = (int)L; { const int q = nwg / NXCD, r = nwg % NXCD, xcd = wgid % NXCD, off = wgid / NXCD; wgid = (xcd < r ? xcd * (q + 1) : r * (q + 1) + (xcd - r) * q) + off; }
        const int nig = WGM * nN, gid = wgid / nig, fm = gid * WGM, gsz = (nM - fm) < WGM ? (nM - fm) : WGM;
        u.pm = fm + ((wgid % nig) % gsz); u.pn = (wgid % nig) / gsz; return true;
    }
    __device__ __forceinline__ void a_ready(const Unit&) const {}
    __device__ __forceinline__ void done(const Unit&) const {}
};

__device__ __forceinline__ unsigned cvt_pk_bf16(float lo, float hi) { unsigned r; asm volatile("v_cvt_pk_bf16_f32 %0, %1, %2" : "=v"(r) : "v"(lo), "v"(hi)); return r; }
__device__ __forceinline__ float row_rs(const float* ssq, int row) {
    const f32x4* p = (const f32x4*)(ssq + (size_t)row * 16);
    const f32x4 a = p[0], b = p[1], c = p[2], d = p[3];
    const float s = (((a[0] + a[1]) + (a[2] + a[3])) + ((b[0] + b[1]) + (b[2] + b[3]))) + (((c[0] + c[1]) + (c[2] + c[3])) + ((d[0] + d[1]) + (d[2] + d[3])));
    return __builtin_amdgcn_rsqf(s * (1.0f / 1024.0f) + 1e-6f);
}
__device__ __forceinline__ void row_rs8(const float* ssq, int row0, float (&rsv)[8]) {
#pragma unroll
    for (int ai = 0; ai < 2; ++ai) {
        f32x4 p[4][4];
#pragma unroll
        for (int m = 0; m < 4; ++m) { const f32x4* q = (const f32x4*)(ssq + (size_t)(row0 + ai * HALF + m * 16) * 16);
#pragma unroll
            for (int j = 0; j < 4; ++j) p[m][j] = q[j]; }
#pragma unroll
        for (int m = 0; m < 4; ++m) { float t = 0.f;
#pragma unroll
            for (int j = 0; j < 4; ++j) t += (p[m][j][0] + p[m][j][1]) + (p[m][j][2] + p[m][j][3]);
            rsv[ai * 4 + m] = __builtin_amdgcn_rsqf(t * (1.0f / 1024.0f) + 1e-6f); }
    }
}
__device__ __forceinline__ float sigm(float v) { return __builtin_amdgcn_rcpf(1.0f + __expf(-v)); }

struct EpiSwiGLU {
    static constexpr bool PERM = true, AFTER_DRAIN = false;
    bf16_t* H; const float* ssq;
    __device__ __forceinline__ void operator()(const f32x4 (&acc)[2][2][4][2], const Unit& u, int wr, int wc, int fr, int fq) const {
        const int row0 = u.pm * BM + wr * 64 + fr, col0 = u.pn * 128 + wc * 32 + 8 * fq;
        float rsv[8]; row_rs8(ssq, row0, rsv);
#pragma unroll
        for (int ai = 0; ai < 2; ++ai)
#pragma unroll
            for (int m = 0; m < 4; ++m) {
                const int row = row0 + ai * HALF + m * 16; const float rs = rsv[ai * 4 + m];
                u32x4 w;
#pragma unroll
                for (int n = 0; n < 2; ++n) {
                    const f32x4 a = acc[ai][0][m][n] * rs, b = acc[ai][1][m][n] * rs; f32x4 h;
#pragma unroll
                    for (int e = 0; e < 4; ++e) h[e] = a[e] * sigm(a[e]) * b[e];
                    w[2 * n] = cvt_pk_bf16(h[0], h[1]); w[2 * n + 1] = cvt_pk_bf16(h[2], h[3]);
                }
                *(u32x4*)(H + (size_t)row * 2816 + col0) = w;
            }
    }
};
__device__ __forceinline__ void unpack8(const u32x4 w, f32x4& lo, f32x4& hi) {
    lo[0] = __uint_as_float(w.x << 16); lo[1] = __uint_as_float(w.x & 0xffff0000u); lo[2] = __uint_as_float(w.y << 16); lo[3] = __uint_as_float(w.y & 0xffff0000u);
    hi[0] = __uint_as_float(w.z << 16); hi[1] = __uint_as_float(w.z & 0xffff0000u); hi[2] = __uint_as_float(w.w << 16); hi[3] = __uint_as_float(w.w & 0xffff0000u);
}
struct EpiRes {
    static constexpr bool PERM = true, AFTER_DRAIN = false;
    bf16_t* XB; float* ssq; float alpha;
    __device__ __forceinline__ void operator()(const f32x4 (&acc)[2][2][4][2], const Unit& u, int wr, int wc, int fr, int fq) const {
        const int row0 = u.pm * BM + wr * 64 + fr, col0 = u.pn * BM + wc * 32 + 8 * fq;
#pragma unroll
        for (int ai = 0; ai < 2; ++ai) {
            u32x4 xin[4][2];
#pragma unroll
            for (int m = 0; m < 4; ++m)
#pragma unroll
                for (int bj = 0; bj < 2; ++bj) xin[m][bj] = *(const u32x4*)(XB + (size_t)(row0 + ai * HALF + m * 16) * 1024 + col0 + bj * HALF);
#pragma unroll
            for (int m = 0; m < 4; ++m) {
                const int row = row0 + ai * HALF + m * 16; float ss = 0.f;
#pragma unroll
                for (int bj = 0; bj < 2; ++bj) {
                    bf16_t* xp = XB + (size_t)row * 1024 + col0 + bj * HALF;
                    f32x4 x0, x1; unpack8(xin[m][bj], x0, x1);
                    x0 = x0 + acc[ai][bj][m][0] * alpha; x1 = x1 + acc[ai][bj][m][1] * alpha;
                    u32x4 w; w.x = cvt_pk_bf16(x0[0], x0[1]); w.y = cvt_pk_bf16(x0[2], x0[3]); w.z = cvt_pk_bf16(x1[0], x1[1]); w.w = cvt_pk_bf16(x1[2], x1[3]);
                    *(u32x4*)xp = w;
                    ss += ((x0[0] * x0[0] + x0[1] * x0[1]) + (x0[2] * x0[2] + x0[3] * x0[3])) + ((x1[0] * x1[0] + x1[1] * x1[1]) + (x1[2] * x1[2] + x1[3] * x1[3]));
                }
                ss += __shfl_xor(ss, 16); ss += __shfl_xor(ss, 32);
                if (fq == 0) ssq[(size_t)row * 16 + u.pn * 4 + wc] = ss;
            }
            asm volatile("" ::: "memory");
        }
    }
};
struct EpiProj {
    static constexpr bool PERM = true, AFTER_DRAIN = false;
    bf16_t* PA; bf16_t* PG; const float* ssq;
    __device__ __forceinline__ void operator()(const f32x4 (&acc)[2][2][4][2], const Unit& u, int wr, int wc, int fr, int fq) const {
        const int row0 = u.pm * BM + wr * 64 + fr;
        bf16_t* base; int ld, colt;
        if (u.pn < 22) { base = PA; ld = 5632; colt = u.pn * BM; } else { base = PG; ld = 3072; colt = (u.pn - 22) * BM; }
        const int col0 = colt + wc * 32 + 8 * fq;
        float rsv[8]; row_rs8(ssq, row0, rsv);
#pragma unroll
        for (int ai = 0; ai < 2; ++ai)
#pragma unroll
            for (int m = 0; m < 4; ++m) {
                const int row = row0 + ai * HALF + m * 16; const float rs = rsv[ai * 4 + m];
#pragma unroll
                for (int bj = 0; bj < 2; ++bj) {
                    const f32x4 v0 = acc[ai][bj][m][0] * rs, v1 = acc[ai][bj][m][1] * rs;
                    u32x4 w; w.x = cvt_pk_bf16(v0[0], v0[1]); w.y = cvt_pk_bf16(v0[2], v0[3]); w.z = cvt_pk_bf16(v1[0], v1[1]); w.w = cvt_pk_bf16(v1[2], v1[3]);
                    *(u32x4*)(base + (size_t)row * ld + col0 + bj * HALF) = w;
                }
            }
    }
};
struct MergeOrder {
    StaticOrder so;
    __device__ void init(int M, int N, int G_, int c_) { so.init(M, N, G_, c_); }
    __device__ bool next(int i, Unit& u) const { Unit b; if (!so.next(i / 3, b)) return false; const int m = i % 3, w = (m == 0) ? 2 : m - 1; u.pm = b.pm + 64 * m; u.pn = b.pn + 4 * w; return true; }
    __device__ __forceinline__ void a_ready(const Unit&) const {}
    __device__ __forceinline__ void done(const Unit&) const {}
};
struct EpiMerge {
    static constexpr bool PERM = true, AFTER_DRAIN = false;
    const bf16_t* PG; bf16_t* MB;
    __device__ __forceinline__ void operator()(const f32x4 (&acc)[2][2][4][2], const Unit& u, int wr, int wc, int fr, int fq) const {
        const int m_ = u.pm >> 6, pm = u.pm & 63, w_ = u.pn >> 2, pn = u.pn & 3;
        const int row0 = pm * BM + wr * 64 + fr, col0 = pn * BM + wc * 32 + 8 * fq;
#pragma unroll
        for (int ai = 0; ai < 2; ++ai) {
            u32x4 gin[4][2], pin[4][2];
#pragma unroll
            for (int m = 0; m < 4; ++m)
#pragma unroll
                for (int bj = 0; bj < 2; ++bj) { const int row = row0 + ai * HALF + m * 16, col = col0 + bj * HALF;
                    gin[m][bj] = *(const u32x4*)(PG + (size_t)row * 3072 + w_ * 1024 + col);
                    pin[m][bj] = (m_ > 0) ? *(const u32x4*)(MB + (size_t)row * 1024 + col) : (u32x4){0u, 0u, 0u, 0u}; }
#pragma unroll
            for (int m = 0; m < 4; ++m)
#pragma unroll
                for (int bj = 0; bj < 2; ++bj) { const int row = row0 + ai * HALF + m * 16, col = col0 + bj * HALF;
                    f32x4 g0, g1, p0, p1; unpack8(gin[m][bj], g0, g1); unpack8(pin[m][bj], p0, p1);
                    f32x4 t0, t1;
#pragma unroll
                    for (int e = 0; e < 4; ++e) { t0[e] = sigm(g0[e]) * acc[ai][bj][m][0][e] + p0[e]; t1[e] = sigm(g1[e]) * acc[ai][bj][m][1][e] + p1[e]; }
                    u32x4 w; w.x = cvt_pk_bf16(t0[0], t0[1]); w.y = cvt_pk_bf16(t0[2], t0[3]); w.z = cvt_pk_bf16(t1[0], t1[1]); w.w = cvt_pk_bf16(t1[2], t1[3]);
                    *(u32x4*)(MB + (size_t)row * 1024 + col) = w; }
            asm volatile("" ::: "memory");
        }
    }
};
template <class Epi, class Sched, bool ALIGN_EPI = false, bool SP2 = false>
__device__ __forceinline__ void gemm_phase(PG8_LAS unsigned char* lds, const Gemm g, const Sched& S, const Epi& E) {
    int tid = threadIdx.x; asm volatile("" : "+v"(tid));
    const int wid = __builtin_amdgcn_readfirstlane(tid >> 6), lane = tid & 63, wr = wid >> 2, wc = wid & 3, fr = lane & 15, fq = lane >> 4;
    const int K = g.K, nt = K / BK;
    unsigned voffA[2], voffB[2];
#pragma unroll
    for (int i = 0; i < 2; ++i) { int R, C; stage_rc(tid * 16 + i * 8192, R, C); const int Rb = Epi::PERM ? ((R & ~31) + perm32(R & 31)) : R;
        voffA[i] = (unsigned)(R * K + C) * 2u; voffB[i] = (unsigned)(Rb * K + C) * 2u; }
    const size_t kstep = (size_t)(BK * 2);
    const size_t hstep = (size_t)HALF * K * 2;
    const size_t tstep = 2 * hstep;
    const unsigned ldsw = (unsigned)wid * 1024u;
    const int aoff = lds_byte(wr * 64 + fr, fq * 8), boff = lds_byte(wc * 32 + fr, fq * 8);
#define PG8_SA(b, h) (((b) * 2 + (h)) * HTB)
#define PG8_SB(b, h) ((4 + (b) * 2 + (h)) * HTB)
#define PG8_STAGE(bufoff, gbase, voff) do { _Pragma("unroll") for (int _i = 0; _i < 2; ++_i) \
        __builtin_amdgcn_global_load_lds((const unsigned*)((const char*)(gbase) + (voff)[_i]), (PG8_LAS unsigned*)(lds + (bufoff) + ldsw + _i * 8192), 16, 0, 0); } while (0)
#define PG8_LDA(dst, b, h) do { _Pragma("unroll") for (int m = 0; m < 4; ++m) _Pragma("unroll") for (int k = 0; k < 2; ++k) dst[m][k] = *(const PG8_LAS bf16x8*)(lds + PG8_SA(b, h) + aoff + m * 2048 + k * 1024); } while (0)
#define PG8_LDB(dst, b, h) do { _Pragma("unroll") for (int n = 0; n < 2; ++n) _Pragma("unroll") for (int k = 0; k < 2; ++k) dst[n][k] = *(const PG8_LAS bf16x8*)(lds + PG8_SB(b, h) + boff + n * 2048 + k * 1024); } while (0)
#define PG8_MMA(ai, bj, At, Bt) do { __builtin_amdgcn_s_setprio(1); _Pragma("unroll") for (int m = 0; m < 4; ++m) _Pragma("unroll") for (int n = 0; n < 2; ++n) _Pragma("unroll") for (int k = 0; k < 2; ++k) \
        acc[ai][bj][m][n] = __builtin_amdgcn_mfma_f32_16x16x32_bf16(Bt[n][k], At[m][k], acc[ai][bj][m][n], 0, 0, 0); __builtin_amdgcn_s_setprio(0); } while (0)
#define PG8_WAIT_V(n) asm volatile("s_waitcnt vmcnt(" #n ")" ::: "memory")
#define PG8_WAIT_L(n) asm volatile("s_waitcnt lgkmcnt(" #n ")" ::: "memory")
#define PG8_BAR __builtin_amdgcn_s_barrier()
#define PG8_SCHED __builtin_amdgcn_sched_barrier(0)
    Unit cur, nxt; int ui = 0;
    if (!S.next(0, cur)) return;
    f32x4 acc[2][2][4][2];
#pragma unroll
    for (int a = 0; a < 2; ++a)
#pragma unroll
        for (int b = 0; b < 2; ++b)
#pragma unroll
            for (int m = 0; m < 4; ++m)
#pragma unroll
                for (int n = 0; n < 2; ++n) acc[a][b][m][n] = (f32x4){0.f, 0.f, 0.f, 0.f};
    bf16x8 At[4][2], B0[2][2], B1[2][2];
    const char* cA = (const char*)g.A + (size_t)cur.pm * tstep; const char* cB = (const char*)g.Bt + (size_t)cur.pn * tstep;
    S.a_ready(cur);
    if constexpr (SP2) {
        PG8_STAGE(PG8_SB(0, 0), cB, voffB); PG8_STAGE(PG8_SB(0, 1), cB + hstep, voffB); PG8_STAGE(PG8_SA(0, 0), cA, voffA); PG8_STAGE(PG8_SA(0, 1), cA + hstep, voffA);
        if (wr == 1) PG8_BAR;
        PG8_WAIT_V(2); PG8_BAR;
        PG8_STAGE(PG8_SB(1, 0), cB + kstep, voffB); PG8_STAGE(PG8_SA(1, 0), cA + kstep, voffA); PG8_STAGE(PG8_SB(1, 1), cB + hstep + kstep, voffB);
        PG8_WAIT_V(6); PG8_BAR;
    } else {
        PG8_STAGE(PG8_SB(0, 0), cB, voffB); PG8_STAGE(PG8_SA(0, 0), cA, voffA); PG8_STAGE(PG8_SB(0, 1), cB + hstep, voffB); PG8_STAGE(PG8_SA(0, 1), cA + hstep, voffA);
        if (wr == 1) PG8_BAR;
        PG8_WAIT_V(4); PG8_BAR;
        PG8_STAGE(PG8_SB(1, 0), cB + kstep, voffB); PG8_STAGE(PG8_SA(1, 0), cA + kstep, voffA); PG8_STAGE(PG8_SB(1, 1), cB + hstep + kstep, voffB);
        PG8_WAIT_V(6); PG8_BAR;
    }
    for (;;) {
        const bool has_next = S.next(ui + 1, nxt);
        const char* nA = has_next ? (const char*)g.A + (size_t)nxt.pm * tstep : cA; const char* nB = has_next ? (const char*)g.Bt + (size_t)nxt.pn * tstep : cB;
        for (int t = 0; t < nt; t += 2) {
            const bool last = (t == nt - 2);
            const char* a1 = cA + (size_t)(t + 1) * kstep;
            const char* a2 = last ? nA : cA + (size_t)(t + 2) * kstep; const char* b2 = last ? nB : cB + (size_t)(t + 2) * kstep;
            const char* a3 = a2 + kstep; const char* b3 = b2 + kstep;
            if (last && has_next) S.a_ready(nxt);
            if constexpr (SP2) {
            PG8_LDB(B0, 0, 0); PG8_LDB(B1, 0, 1); PG8_SCHED; PG8_LDA(At, 0, 0); PG8_STAGE(PG8_SA(1, 1), a1 + hstep, voffA);
            PG8_WAIT_V(8); PG8_WAIT_L(0); PG8_BAR; PG8_MMA(0, 0, At, B0); PG8_MMA(0, 1, At, B1); PG8_BAR; PG8_SCHED;
            PG8_LDA(At, 0, 1); PG8_STAGE(PG8_SB(0, 0), b2, voffB); PG8_STAGE(PG8_SB(0, 1), b2 + hstep, voffB); PG8_STAGE(PG8_SA(0, 0), a2, voffA);
            PG8_WAIT_V(8); PG8_WAIT_L(0); PG8_BAR; PG8_MMA(1, 0, At, B0); PG8_MMA(1, 1, At, B1); PG8_BAR; PG8_SCHED;
            PG8_LDB(B0, 1, 0); PG8_LDB(B1, 1, 1); PG8_SCHED; PG8_LDA(At, 1, 0); PG8_STAGE(PG8_SA(0, 1), a2 + hstep, voffA);
            PG8_WAIT_V(8); PG8_WAIT_L(0); PG8_BAR; PG8_MMA(0, 0, At, B0); PG8_MMA(0, 1, At, B1); PG8_BAR; PG8_SCHED;
            PG8_LDA(At, 1, 1); PG8_STAGE(PG8_SB(1, 0), b3, voffB); PG8_STAGE(PG8_SB(1, 1), b3 + hstep, voffB); PG8_STAGE(PG8_SA(1, 0), a3, voffA);
            PG8_WAIT_V(8); PG8_WAIT_L(0); PG8_BAR; PG8_MMA(1, 0, At, B0); PG8_MMA(1, 1, At, B1); PG8_BAR; PG8_SCHED;
            } else {
            PG8_LDB(B0, 0, 0); PG8_SCHED; PG8_LDA(At, 0, 0); PG8_STAGE(PG8_SA(1, 1), a1 + hstep, voffA);
            PG8_WAIT_L(8); PG8_BAR; PG8_WAIT_L(0); PG8_MMA(0, 0, At, B0); PG8_BAR; PG8_SCHED;
            PG8_LDB(B1, 0, 1); PG8_STAGE(PG8_SB(0, 0), b2, voffB);
            PG8_BAR; PG8_WAIT_L(0); PG8_MMA(0, 1, At, B1); PG8_BAR;
            PG8_LDA(At, 0, 1); PG8_STAGE(PG8_SA(0, 0), a2, voffA);
            PG8_BAR; PG8_WAIT_L(0); PG8_MMA(1, 0, At, B0); PG8_BAR; PG8_SCHED;
            PG8_STAGE(PG8_SB(0, 1), b2 + hstep, voffB);
            PG8_WAIT_V(6); PG8_BAR; PG8_MMA(1, 1, At, B1); PG8_BAR;
            PG8_LDB(B0, 1, 0); PG8_SCHED; PG8_LDA(At, 1, 0); PG8_STAGE(PG8_SA(0, 1), a2 + hstep, voffA);
            PG8_WAIT_L(8); PG8_BAR; PG8_WAIT_L(0); PG8_MMA(0, 0, At, B0); PG8_BAR; PG8_SCHED;
            PG8_LDB(B1, 1, 1); PG8_STAGE(PG8_SB(1, 0), b3, voffB);
            PG8_BAR; PG8_WAIT_L(0); PG8_MMA(0, 1, At, B1); PG8_BAR;
            PG8_LDA(At, 1, 1); PG8_STAGE(PG8_SA(1, 0), a3, voffA);
            PG8_BAR; PG8_WAIT_L(0); PG8_MMA(1, 0, At, B0); PG8_BAR; PG8_SCHED;
            PG8_STAGE(PG8_SB(1, 1), b3 + hstep, voffB);
            PG8_WAIT_V(6); PG8_BAR; PG8_MMA(1, 1, At, B1); PG8_BAR;
            }
        }
        if constexpr (ALIGN_EPI) { if (wr == 0) PG8_BAR; }
        if constexpr (!Epi::AFTER_DRAIN) { E(acc, cur, wr, wc, fr, fq); S.done(cur); }
        if (!has_next) break;
#pragma unroll
        for (int a = 0; a < 2; ++a)
#pragma unroll
            for (int b = 0; b < 2; ++b)
#pragma unroll
                for (int m = 0; m < 4; ++m)
#pragma unroll
                    for (int n = 0; n < 2; ++n) acc[a][b][m][n] = (f32x4){0.f, 0.f, 0.f, 0.f};
        cur = nxt; cA = nA; cB = nB; ++ui;
        if constexpr (ALIGN_EPI) { if (wr == 1) PG8_BAR; }
    }
    PG8_WAIT_V(0);
    if constexpr (!ALIGN_EPI) { if (wr == 0) PG8_BAR; }
    PG8_BAR;
    if constexpr (Epi::AFTER_DRAIN) { E.fused(acc, cur, wr, wc, fr, fq, lds, wid, lane); S.done(cur); }
#undef PG8_SA
#undef PG8_SB
#undef PG8_STAGE
#undef PG8_LDA
#undef PG8_LDB
#undef PG8_MMA
#undef PG8_WAIT_V
#undef PG8_WAIT_L
#undef PG8_BAR
#undef PG8_SCHED
}
}
#define LAS __attribute__((address_space(3)))
typedef unsigned short bf16;
typedef unsigned v4u __attribute__((ext_vector_type(4)));
typedef unsigned v2u __attribute__((ext_vector_type(2)));
typedef short v4i16_t __attribute__((ext_vector_type(4)));
using pg8::f32x4; using pg8::bf16x8; using pg8::cvt_pk_bf16;

constexpr int D = 1024, FF = 2816, NLAYER = 4, TG = 16384, NGROUP = 4, NTHR = 512, NWAVES = 8;
constexpr int PA_LD = 5632, PG_LD = 3072;
constexpr int C_HQ = 0, C_HI = 512, C_HZF = 1024, C_HZB = 1536, C_HG = 2048, C_CA = 2560, C_CB = 3072, C_CC = 3584, C_NQ = 4096, C_NK = 4608, C_NV = 5120;
constexpr size_t MiB = 1u << 20;
constexpr size_t WS_CTL = 0, CTL_BYTES = 1 * MiB, WS_W = 1 * MiB, WS_XB = 221 * MiB, WS_SSQ = 285 * MiB, WS_PA = 287 * MiB, WS_PG = 463 * MiB, WS_ONA = 559 * MiB, WS_SCR = 575 * MiB, WS_END = 671 * MiB;
constexpr size_t OFF_GU1 = 0, OFF_D1 = 5767168, OFF_IN = 8650752, OFF_HG = 17563648, OFF_CV = 18087936, OFF_NA = 18612224, OFF_OUT = 19136512, OFF_GU2 = 20185088, OFF_D2 = 25952256, LAYER_EL = 28835840;
constexpr int LDS_BYTES = 147456, LDS_MISC = 147456 - 64;
constexpr int PH_PER_PAIR = 1 + NLAYER * 16 + 1;
constexpr int CW_BAR = 4096;

__device__ __forceinline__ unsigned f2bf(float f) { unsigned u = __float_as_uint(f); return (u + 0x7fffu + ((u >> 16) & 1u)) >> 16; }
__device__ __forceinline__ float bf2f(unsigned b) { return __uint_as_float(b << 16); }
__device__ __forceinline__ float bflo(unsigned w) { return __uint_as_float(w << 16); }
__device__ __forceinline__ float bfhi(unsigned w) { return __uint_as_float(w & 0xffff0000u); }
__device__ __forceinline__ float sigm(float v) { return __builtin_amdgcn_rcpf(1.0f + __expf(-v)); }
__device__ __forceinline__ float wave_sum(float v) {
#pragma unroll
    for (int o = 1; o < 64; o <<= 1) v += __shfl_xor(v, o);
    return v;
}

__device__ __forceinline__ void cvt_item(const float* W, int K, int N, bf16* WT, const float* gain, bool permgu, LAS float* scr, int item, int lane) {
    const int nblk = N / 32, kb = item / nblk, nb = item % nblk, k0 = 64 * kb, n0 = 32 * nb;
#pragma unroll
    for (int i = 0; i < 32; ++i) { const int kk = 2 * i + (lane >> 5); const float g = gain ? gain[k0 + kk] : 1.0f; scr[kk * 33 + (lane & 31)] = W[(size_t)(k0 + kk) * N + n0 + (lane & 31)] * g; }
    asm volatile("s_waitcnt lgkmcnt(0)" ::: "memory");
    int dn0 = n0;
    if (permgu) { const int half = n0 >= FF ? 1 : 0; const int j = n0 - half * FF; dn0 = (j >> 7) * 256 + half * 128 + (j & 127); }
    const int c = lane & 7;
#pragma unroll
    for (int j = 0; j < 4; ++j) { const int n = (lane >> 3) + 8 * j; const LAS float* s = scr + (8 * c) * 33 + n;
        v4u o; o.x = cvt_pk_bf16(s[0 * 33], s[1 * 33]); o.y = cvt_pk_bf16(s[2 * 33], s[3 * 33]); o.z = cvt_pk_bf16(s[4 * 33], s[5 * 33]); o.w = cvt_pk_bf16(s[6 * 33], s[7 * 33]);
        *(v4u*)(WT + (size_t)(dn0 + n) * K + k0 + 8 * c) = o; }
    asm volatile("s_waitcnt lgkmcnt(0)" ::: "memory");
}

template <int K> __device__ __forceinline__ f32x4 mma_lds(f32x4 acc, const LAS bf16* A, int pa, const LAS bf16* B, int pb, int lane) {
    const int r = lane & 15, q = lane >> 4;
#pragma unroll
    for (int ks = 0; ks < K / 32; ++ks) {
        const bf16x8 a = *(const LAS bf16x8*)(A + r * pa + ks * 32 + q * 8);
        const bf16x8 b = *(const LAS bf16x8*)(B + r * pb + ks * 32 + q * 8);
        acc = __builtin_amdgcn_mfma_f32_16x16x32_bf16(a, b, acc, 0, 0, 0);
    }
    return acc;
}

constexpr int HP_QT = 0, HP_KTT = 17408, HP_AM = 35840, HP_ER = 45056, HP_EE = 45568, HP_BLK = 49152;
constexpr int HP_KT = 49152, HP_SEG = 66560;
constexpr int HS_VT = 49152, HS_ST = 53760, HS_BUF = 62464;
__device__ __forceinline__ void hg_prep_items(LAS unsigned char* lds, const bf16* PA, unsigned char* SCR, const float* lb_logits, int layer, int item0, int istride, int nitems, int T, int tid) {
    const int lane = tid & 63, wave = __builtin_amdgcn_readfirstlane(tid >> 6), c16 = lane & 15, quad = lane >> 4;
    const int nchunk = T / 64;
    const int k = tid & 127, tq = tid >> 7;
    LAS bf16* QT = (LAS bf16*)(lds + HP_QT); LAS bf16* KT = (LAS bf16*)(lds + HP_KT); LAS bf16* KTT = (LAS bf16*)(lds + HP_KTT); LAS bf16* AM = (LAS bf16*)(lds + HP_AM);
    LAS float* SEG = (LAS float*)(lds + HP_SEG); LAS float* ER = (LAS float*)(lds + HP_ER); LAS float* EE = (LAS float*)(lds + HP_EE);
    unsigned short zr[16], qr[16];
#define HP_LOAD(it) do { const int it_ = min((it), nitems - 1); const int c_ = it_ % nchunk, sd_ = it_ / nchunk, dir_ = sd_ & 1, h_ = (sd_ >> 1) & 3, base_ = (sd_ >> 3) * T; \
        const bf16* zs = PA + (dir_ ? C_HZB : C_HZF) + h_ * 128 + k; const bf16* qs = PA + C_HQ + h_ * 128 + k; \
        _Pragma("unroll") for (int i = 0; i < 16; ++i) { const int tau = c_ * 64 + 16 * tq + i; const size_t ro = (size_t)(base_ + (dir_ ? (T - 1 - tau) : tau)) * PA_LD; zr[i] = zs[ro]; qr[i] = qs[ro]; } } while (0)
    HP_LOAD(item0);
    for (int item = item0; item < nitems; item += istride) {
        const int sd = item / nchunk, dir = sd & 1, h = (sd >> 1) & 3;
        float lb;
        { float lg[4], mx = -3e38f;
#pragma unroll
          for (int l = 0; l < 4; ++l) { lg[l] = lb_logits[(dir * 4 + l) * 512 + h * 128 + k]; mx = fmaxf(mx, lg[l]); }
          float tot = 0.f, num = 0.f;
#pragma unroll
          for (int l = 0; l < 4; ++l) { const float e = __expf(lg[l] - mx); tot += e; if (l >= 1 && l <= layer) num += e; }
          lb = num / tot; }
        const float oml = 1.0f - lb;
        float b[16], kv[16], qv[16]; float cum = 0.f;
#pragma unroll
        for (int i = 0; i < 16; ++i) { const float zf = bf2f(zr[i]); const float sg = sigm(zf); const float f = lb + oml * sg; cum += __logf(fmaxf(f, 1e-30f)); b[i] = cum; kv[i] = oml * (1.0f - sg); qv[i] = bf2f(qr[i]); }
        HP_LOAD(item + istride);
        SEG[tq * 128 + k] = cum;
        __syncthreads();
        const float s0 = SEG[k], s1 = SEG[128 + k], s2 = SEG[256 + k], s3 = SEG[384 + k];
        const float pre = tq == 0 ? 0.f : (tq == 1 ? s0 : (tq == 2 ? s0 + s1 : (s0 + s1) + s2));
        const float r = s0 + s1, bend = (s0 + s1) + (s2 + s3);
        unsigned kpk[8];
#pragma unroll
        for (int i = 0; i < 16; ++i) {
            const float bt = pre + b[i];
            const float eq = __expf(fminf(bt - r, 80.f)), ek = __expf(fminf(r - bt, 80.f));
            const unsigned qb = f2bf(qv[i] * eq), kb = f2bf(kv[i] * ek);
            const int tau = 16 * tq + i;
            QT[tau * 136 + k] = (bf16)qb; KT[tau * 136 + k] = (bf16)kb;
            if (i & 1) kpk[i >> 1] |= kb << 16; else kpk[i >> 1] = kb;
        }
        *(LAS v4u*)(KTT + k * 72 + 16 * tq) = (v4u){kpk[0], kpk[1], kpk[2], kpk[3]};
        *(LAS v4u*)(KTT + k * 72 + 16 * tq + 8) = (v4u){kpk[4], kpk[5], kpk[6], kpk[7]};
        if (tq == 0) { ER[k] = __expf(r); EE[k] = __expf(bend - r); }
        __syncthreads();
#pragma unroll
        for (int e = 0; e < 2; ++e) { const int id = wave * 2 + e, tt = id >> 2, st = id & 3;
            f32x4 a = (f32x4){0.f, 0.f, 0.f, 0.f};
            if (st <= tt) a = mma_lds<128>(a, QT + tt * 16 * 136, 136, KT + st * 16 * 136, 136, lane);
#pragma unroll
            for (int i = 0; i < 4; ++i) { const int t = tt * 16 + quad * 4 + i, s = st * 16 + c16; const float val = (st <= tt && s <= t) ? a[i] : 0.f; AM[t * 72 + s] = (bf16)f2bf(val); } }
        __syncthreads();
        unsigned char* dst = SCR + (size_t)item * HP_BLK;
#pragma unroll
        for (int j = 0; j < 6; ++j) { const int idx = tid + 512 * j; *(v4u*)(dst + (size_t)idx * 16) = *(const LAS v4u*)(lds + idx * 16); }
        __syncthreads();
    }
#undef HP_LOAD
}

template <int NVT> __device__ __forceinline__ void hg_scan_item(LAS unsigned char* lds, bf16* PA, const unsigned char* SCR, int item, int T, int tid) {
    constexpr int NVS = 8 / NVT, VW = 16 * NVT, VTHR = 128 * NVT, VSH = (NVT == 2) ? 2 : 1;
    const int lane = tid & 63, wave = __builtin_amdgcn_readfirstlane(tid >> 6), c16 = lane & 15, quad = lane >> 4;
    const int vs = item % NVS, sd = item / NVS, dir = sd & 1, h = (sd >> 1) & 3, seq = sd >> 3;
    const int base = seq * T, nchunk = T / 64;
    const unsigned char* blk = SCR + (size_t)sd * nchunk * HP_BLK;
    const bf16* vsrc = PA + C_HI + h * 128 + vs * VW + (tid & (VW / 8 - 1)) * 8;
    bf16* odst = PA + (dir ? C_HZF : C_HQ) + h * 128 + vs * VW;
    v4u preA[6], preB[6]; v4u vrA = {0u, 0u, 0u, 0u}, vrB = vrA; f32x4 ervA, eevA, ervB, eevB;
#define HG_ROW(tau) (base + (dir ? (T - 1 - (tau)) : (tau)))
#define HS_LOAD(c, pre, vr, erv, eev) do { const int c_ = min((c), nchunk - 1); const unsigned char* bp = blk + (size_t)c_ * HP_BLK;     \
        _Pragma("unroll") for (int j = 0; j < 6; ++j) pre[j] = *(const v4u*)(bp + (size_t)(tid + 512 * j) * 16); \
        erv = *(const f32x4*)(bp + HP_ER + (wave * 16 + quad * 4) * 4); eev = *(const f32x4*)(blk + (size_t)max(c_ - 1, 0) * HP_BLK + HP_EE + (wave * 16 + quad * 4) * 4);     \
        vr = *(const v4u*)(vsrc + (size_t)HG_ROW(c_ * 64 + ((tid & (VTHR - 1)) >> VSH)) * PA_LD); } while (0)
    HS_LOAD(0, preA, vrA, ervA, eevA);
    HS_LOAD(1, preB, vrB, ervB, eevB);
    f32x4 accS[NVT];
#pragma unroll
    for (int e = 0; e < NVT; ++e) accS[e] = (f32x4){0.f, 0.f, 0.f, 0.f};
#define HS_STEP(c, BUFI, pre, vr, erv, eev) do { \
        LAS unsigned char* B = lds + (BUFI) * HS_BUF; \
        LAS bf16* QT = (LAS bf16*)(B + HP_QT); LAS bf16* KTT = (LAS bf16*)(B + HP_KTT); LAS bf16* AM = (LAS bf16*)(B + HP_AM); \
        LAS bf16* VT = (LAS bf16*)(B + HS_VT); LAS bf16* STt = (LAS bf16*)(B + HS_ST); \
        _Pragma("unroll") for (int j = 0; j < 6; ++j) *(LAS v4u*)(B + (tid + 512 * j) * 16) = pre[j]; \
        if (tid < VTHR) { const int s_ = tid >> VSH, vq = tid & (VW / 8 - 1); \
            VT[(vq * 8 + 0) * 72 + s_] = (bf16)(vr.x & 0xffffu); VT[(vq * 8 + 1) * 72 + s_] = (bf16)(vr.x >> 16); \
            VT[(vq * 8 + 2) * 72 + s_] = (bf16)(vr.y & 0xffffu); VT[(vq * 8 + 3) * 72 + s_] = (bf16)(vr.y >> 16); \
            VT[(vq * 8 + 4) * 72 + s_] = (bf16)(vr.z & 0xffffu); VT[(vq * 8 + 5) * 72 + s_] = (bf16)(vr.z >> 16); \
            VT[(vq * 8 + 6) * 72 + s_] = (bf16)(vr.w & 0xffffu); VT[(vq * 8 + 7) * 72 + s_] = (bf16)(vr.w >> 16); } \
        f32x4 sp[NVT]; const f32x4 sc_ = erv * eev;     \
        _Pragma("unroll") for (int e = 0; e < NVT; ++e) { sp[e] = accS[e] * sc_; v2u w; w.x = cvt_pk_bf16(sp[e][0], sp[e][1]); w.y = cvt_pk_bf16(sp[e][2], sp[e][3]); \
            *(LAS v2u*)(STt + (e * 16 + c16) * 136 + wave * 16 + quad * 4) = w; } \
        HS_LOAD((c) + 2, pre, vr, erv, eev); \
        __syncthreads(); \
        if ((wave >> 2) < NVT) { const int tt = wave & 3, vt = wave >> 2; f32x4 o = (f32x4){0.f, 0.f, 0.f, 0.f}; \
          o = mma_lds<128>(o, QT + tt * 16 * 136, 136, STt + vt * 16 * 136, 136, lane); \
          o = mma_lds<64>(o, AM + tt * 16 * 72, 72, VT + vt * 16 * 72, 72, lane); \
          _Pragma("unroll") for (int i = 0; i < 4; ++i) { const int tau = (c) * 64 + tt * 16 + quad * 4 + i; odst[(size_t)HG_ROW(tau) * PA_LD + vt * 16 + c16] = (bf16)f2bf(o[i]); } } \
        _Pragma("unroll") for (int e = 0; e < NVT; ++e) { accS[e] = mma_lds<64>(sp[e], KTT + wave * 16 * 72, 72, VT + e * 16 * 72, 72, lane); } \
    } while (0)
    for (int c = 0; c < nchunk; c += 2) {
        HS_STEP(c, 0, preA, vrA, ervA, eevA);
        HS_STEP(c + 1, 1, preB, vrB, ervB, eevB);
    }
    __syncthreads();
#undef HG_ROW
#undef HS_LOAD
#undef HS_STEP
}

__device__ __forceinline__ void na_item(LAS unsigned char* lds, const bf16* PA, const float* rpb, bf16* ONA, int item, int T, int tid) {
    const int lane = tid & 63, h = __builtin_amdgcn_readfirstlane(tid >> 6), c16 = lane & 15, quad = lane >> 4;
    const int ips = T / 16, seq = item / ips, rem = item % ips, r = rem >> 2, j = rem & 3;
    const int rows = T / 64, rs = min(max(r - 4, 0), rows - 8), kstart = (j == 0) ? 0 : (j == 1) ? 8 : (j == 2) ? 24 : 32;
    const int base = seq * T, qtok = base + r * 64 + 16 * j + c16;
    const bf16* qp = PA + (size_t)qtok * PA_LD + C_NQ + h * 64 + quad * 8;
    const bf16x8 Qb0 = *(const bf16x8*)qp, Qb1 = *(const bf16x8*)(qp + 32);
    const int qcol = 16 * j + c16, cs = min(max(qcol - 8, 0), 48);
    v4u vbufA[8], vbufB[8];
#define NA_VLOAD(qd, vbuf) do { _Pragma("unroll") for (int it = 0; it < 8; ++it) { const int idx = it * 64 + lane, key = idx >> 3, dg = idx & 7; \
        const int tok = base + (rs + 2 * (qd) + (key >> 5)) * 64 + kstart + (key & 31); vbuf[it] = *(const v4u*)(PA + (size_t)tok * PA_LD + C_NV + h * 64 + dg * 8); } } while (0)
    NA_VLOAD(0, vbufA); NA_VLOAD(1, vbufB);
    const float* rp = rpb + h * 465;
    f32x4 sacc[16]; float mx = -3e38f;
    int dcv[8]; bool okv[8];
#pragma unroll
    for (int e = 0; e < 8; ++e) { const int kcol = kstart + (e >> 2) * 16 + quad * 4 + (e & 3); okv[e] = (kcol >= cs) && (kcol < cs + 16); dcv[e] = min(max(kcol - qcol + 15, 0), 30); }
#pragma unroll
    for (int a = 0; a < 8; ++a) {
        const float* rpa = rp + (rs + a - r + 7) * 31;
#pragma unroll
        for (int hh = 0; hh < 2; ++hh) {
            const int ktok = base + (rs + a) * 64 + kstart + hh * 16 + c16;
            const bf16* kp = PA + (size_t)ktok * PA_LD + C_NK + h * 64 + quad * 8;
            const bf16x8 Ka0 = *(const bf16x8*)kp, Ka1 = *(const bf16x8*)(kp + 32);
            f32x4 s = (f32x4){0.f, 0.f, 0.f, 0.f};
            s = __builtin_amdgcn_mfma_f32_16x16x32_bf16(Ka0, Qb0, s, 0, 0, 0);
            s = __builtin_amdgcn_mfma_f32_16x16x32_bf16(Ka1, Qb1, s, 0, 0, 0);
#pragma unroll
            for (int i = 0; i < 4; ++i) { const float val = okv[hh * 4 + i] ? s[i] * 0.125f + rpa[dcv[hh * 4 + i]] : -1e30f; s[i] = val; mx = fmaxf(mx, val); }
            sacc[a * 2 + hh] = s;
        }
    }
    mx = fmaxf(mx, __shfl_xor(mx, 16)); mx = fmaxf(mx, __shfl_xor(mx, 32));
    float sum = 0.f;
#pragma unroll
    for (int t = 0; t < 16; ++t)
#pragma unroll
        for (int i = 0; i < 4; ++i) { const float p = __expf(sacc[t][i] - mx); sacc[t][i] = p; sum += p; }
    sum += __shfl_xor(sum, 16); sum += __shfl_xor(sum, 32);
    bf16x8 pb[8];
#pragma unroll
    for (int a = 0; a < 8; ++a) { v4u w; w.x = cvt_pk_bf16(sacc[2 * a][0], sacc[2 * a][1]); w.y = cvt_pk_bf16(sacc[2 * a][2], sacc[2 * a][3]);
        w.z = cvt_pk_bf16(sacc[2 * a + 1][0], sacc[2 * a + 1][1]); w.w = cvt_pk_bf16(sacc[2 * a + 1][2], sacc[2 * a + 1][3]); pb[a] = __builtin_bit_cast(bf16x8, w); }
    LAS bf16* VS = (LAS bf16*)(lds + h * 10240);
    f32x4 oacc[4];
#pragma unroll
    for (int dt = 0; dt < 4; ++dt) oacc[dt] = (f32x4){0.f, 0.f, 0.f, 0.f};
    const int trq = (lane & 15) >> 2, trp = lane & 3;
    const LAS bf16* trbase = VS + (quad * 4 + trq) * 80 + 4 * trp;
#define NA_PV(qd, vbuf) do { \
        _Pragma("unroll") for (int it = 0; it < 8; ++it) { const int idx = it * 64 + lane, key = idx >> 3, dg = idx & 7; *(LAS v4u*)(VS + key * 80 + dg * 8) = vbuf[it]; } \
        if ((qd) + 2 < 4) { NA_VLOAD((qd) + 2, vbuf); } \
        _Pragma("unroll") for (int al = 0; al < 2; ++al) \
            _Pragma("unroll") for (int dt = 0; dt < 4; ++dt) { const LAS bf16* p = trbase + al * 32 * 80 + dt * 16; \
                const v4i16_t lo = __builtin_amdgcn_ds_read_tr16_b64_v4i16((LAS v4i16_t*)p), hi = __builtin_amdgcn_ds_read_tr16_b64_v4i16((LAS v4i16_t*)(p + 16 * 80)); \
                const bf16x8 af = {lo[0], lo[1], lo[2], lo[3], hi[0], hi[1], hi[2], hi[3]}; \
                oacc[dt] = __builtin_amdgcn_mfma_f32_16x16x32_bf16(af, pb[(qd) * 2 + al], oacc[dt], 0, 0, 0); } } while (0)
    NA_PV(0, vbufA); NA_PV(1, vbufB); NA_PV(2, vbufA); NA_PV(3, vbufB);
#undef NA_PV
#undef NA_VLOAD
    const float inv = __builtin_amdgcn_rcpf(sum);
#pragma unroll
    for (int dt = 0; dt < 4; ++dt) { const f32x4 o = oacc[dt] * inv; v2u w; w.x = cvt_pk_bf16(o[0], o[1]); w.y = cvt_pk_bf16(o[2], o[3]);
        *(v2u*)(ONA + (size_t)qtok * 512 + h * 64 + dt * 16 + quad * 4) = w; }
}

#define XB_TMO      128
#define XB_XCNT(j)  (256  + 64 * (j))
#define XB_XSUB(j)  (1280 + 64 * (j))
#define XB_XGEN(j)  (2304 + 64 * (j))
#define XB_TOP      3328
#define XB_TOPGEN   3392
#define XCD_BAR_WORDS 3456
#define XB_SPIN_CAP (1u << 18)

__device__ __forceinline__ unsigned xb_ld(unsigned* p)              { return __hip_atomic_load(p, __ATOMIC_RELAXED, __HIP_MEMORY_SCOPE_AGENT); }
__device__ __forceinline__ unsigned xb_add(unsigned* p, unsigned v) { return __hip_atomic_fetch_add(p, v, __ATOMIC_RELAXED, __HIP_MEMORY_SCOPE_AGENT); }
__device__ __forceinline__ unsigned xb_xcc_id() { return (unsigned)__builtin_amdgcn_s_getreg((3 << 11) | 20) & 0xFu; }
#define XB_SPIN(cond, bar) do { unsigned _sp = 0; while (cond) { __builtin_amdgcn_s_sleep(1); \
    if ((++_sp & 255u) == 0u) { if (xb_ld(&(bar)[XB_TMO])) break; if (_sp > XB_SPIN_CAP) { atomicAdd(&(bar)[XB_TMO], 1u); break; } } } } while (0)

struct XcdBarrier {
    unsigned* bar; unsigned x;
    volatile LAS unsigned* st;
};

__device__ __forceinline__ XcdBarrier xcd_barrier_post(unsigned* bar, volatile LAS unsigned* st) {
    XcdBarrier b; b.bar = bar; b.x = xb_xcc_id(); b.st = st;
    if (threadIdx.x == 0) (void)xb_add(&bar[XB_XCNT(b.x)], 1u);
    return b;
}
__device__ __forceinline__ void xcd_barrier_complete(unsigned* bar, unsigned x, unsigned& nloc, unsigned& nx) {
    const unsigned G = gridDim.x * gridDim.y * gridDim.z;
    unsigned sum, cnt, mine, sp = 0u;
    for (;;) {
        sum = 0u; cnt = 0u; mine = 0u;
#pragma unroll
        for (unsigned j = 0; j < 16; ++j) { const unsigned c = xb_ld(&bar[XB_XCNT(j)]); sum += c; cnt += (c > 0u) ? 1u : 0u; mine = (j == x) ? c : mine; }
        if (sum == G) break;
        __builtin_amdgcn_s_sleep(1);
        if ((++sp & 255u) == 0u) { if (xb_ld(&bar[XB_TMO])) break; if (sp > XB_SPIN_CAP) { atomicAdd(&bar[XB_TMO], 1u); break; } }
    }
    nloc = mine > 0u ? mine : 1u; nx = cnt > 0u ? cnt : 1u;
}

__device__ __forceinline__ void xcd_barrier(const XcdBarrier& b) {
    asm volatile("s_waitcnt vmcnt(0)" ::: "memory");
    __syncthreads();
    if (threadIdx.x == 0) {
        unsigned* bar = b.bar;
        __builtin_amdgcn_s_waitcnt(0);
        unsigned nloc = b.st[0], nx = b.st[1];
        if (nloc == 0u) { xcd_barrier_complete(bar, b.x, nloc, nx); b.st[0] = nloc; b.st[1] = nx; }
        const unsigned old = xb_add(&bar[XB_XSUB(b.x)], 1u);
        const unsigned gen = old / nloc;
        if (old + 1u == (gen + 1u) * nloc) {
            __builtin_amdgcn_fence(__ATOMIC_RELEASE, "agent");
            asm volatile("s_waitcnt vmcnt(0)" ::: "memory");
            const unsigned og = xb_add(&bar[XB_TOP], 1u);
            const unsigned tg = og / nx;
            if (og + 1u == (tg + 1u) * nx) xb_add(&bar[XB_TOPGEN], 1u);
            else XB_SPIN(xb_ld(&bar[XB_TOPGEN]) == tg, bar);
            __builtin_amdgcn_fence(__ATOMIC_ACQUIRE, "agent");
            xb_add(&bar[XB_XGEN(b.x)], 1u);
            asm volatile("s_waitcnt vmcnt(0)" ::: "memory");
        } else {
            XB_SPIN(xb_ld(&bar[XB_XGEN(b.x)]) == gen, bar);
            __builtin_amdgcn_fence(__ATOMIC_ACQUIRE, "agent");
            asm volatile("s_waitcnt vmcnt(0)" ::: "memory");
        }
    }
    __syncthreads();
}
struct Args { const float* in[20]; float* out; unsigned char* ws; int ph_lo, ph_hi; };
enum { K_CVT = 0, K_G0, K_UP, K_RES, K_M1, K_M2A, K_M2B, K_M3, K_M4, K_GF };

__global__ void __launch_bounds__(NTHR, 2) mk_fwd(Args args) {
    extern __shared__ __attribute__((aligned(16))) unsigned char lds_raw[];
    LAS unsigned char* lds = (LAS unsigned char*)lds_raw;
    cg::grid_group grid = cg::this_grid();
    const int hi = args.ph_hi;
    { volatile LAS unsigned* st0 = (volatile LAS unsigned*)(lds + LDS_MISC + 32); if (threadIdx.x < 2) st0[threadIdx.x] = 0u; __syncthreads(); }
    XcdBarrier xbar = xcd_barrier_post((unsigned*)(args.ws + WS_CTL) + CW_BAR, (volatile LAS unsigned*)(lds + LDS_MISC + 32));
#if TPROBE
    unsigned long long tacc = 0ull;
#endif
    for (int ph = args.ph_lo; ph < hi; ++ph) {
#if TPROBE
        const unsigned long long tp0 = __builtin_amdgcn_s_memrealtime();
#endif
        int bid = blockIdx.x, G = gridDim.x; asm volatile("" : "+s"(bid), "+s"(G));
        int tid = threadIdx.x; asm volatile("" : "+v"(tid));
        const int lane = tid & 63, wave = __builtin_amdgcn_readfirstlane(tid >> 6);
        const int gw = bid * NWAVES + wave, NGW = G * NWAVES;
        int kind, pr = 0, l = 0, s = 0, g2 = 0;
        if (ph == 0) kind = K_CVT;
        else { const int q = ph - 1; pr = q / PH_PER_PAIR; const int r = q % PH_PER_PAIR;
            if (r == 0) kind = K_G0; else if (r == PH_PER_PAIR - 1) kind = K_GF;
            else { l = (r - 1) / 16; s = (r - 1) % 16;
                if (s == 0 || s == 14) kind = K_UP; else if (s == 1 || s == 15) kind = K_RES;
                else { g2 = (s - 2) / 6; const int t = (s - 2) % 6; kind = (t == 0) ? K_M1 : (t == 1) ? K_M2A : (t == 2) ? K_M2B : (t == 3) ? K_M3 : (t == 4) ? K_M4 : K_RES; } } }
        const bool mix = (s >= 2 && s <= 13);
        unsigned char* ws = args.ws;
        bf16* XBp = (bf16*)(ws + WS_XB); float* SSQp = (float*)(ws + WS_SSQ);
        bf16* XB = XBp + (size_t)g2 * TG * D; float* SSQ = SSQp + (size_t)g2 * TG * 16;
        bf16* PA = (bf16*)(ws + WS_PA); bf16* PG = (bf16*)(ws + WS_PG);
        bf16* ONA = (bf16*)(ws + WS_ONA); bf16* OHG = ONA + (size_t)TG * 512; bf16* OCV = OHG + (size_t)TG * 512;
        unsigned char* SCR = ws + WS_SCR;
        const bf16* Wl = (const bf16*)(ws + WS_W) + (size_t)l * LAYER_EL;
        const int T = pr == 0 ? 2048 : 4096;
        const int g = pr * 2 + g2;
        float* X = args.out + (size_t)pr * 2 * TG * D;

        if (kind == K_CVT) {
            LAS float* scr = (LAS float*)(lds + wave * 16384);
            constexpr int I_GU = 16 * 176, I_DN = 44 * 32, I_IN = 16 * 272, I_MX = 8 * 32, I_OUT = 16 * 32;
            constexpr int I_LAYER = 2 * I_GU + 2 * I_DN + I_IN + 3 * I_MX + I_OUT;
            for (int it = gw; it < NLAYER * I_LAYER; it += NGW) {
                const int ll = it / I_LAYER; int r = it % I_LAYER; bf16* Wd = (bf16*)(ws + WS_W) + (size_t)ll * LAYER_EL;
                const float* src; const float* gain = nullptr; int K, N; size_t off; bool perm = false;
                if (r < I_GU) { src = args.in[3] + (size_t)ll * D * 2 * FF; K = D; N = 2 * FF; off = OFF_GU1; gain = args.in[2] + ll * D; perm = true; }
                else if ((r -= I_GU) < I_DN) { src = args.in[4] + (size_t)ll * FF * D; K = FF; N = D; off = OFF_D1; }
                else if ((r -= I_DN) < I_IN) { src = args.in[6] + (size_t)ll * D * 8704; K = D; N = 8704; off = OFF_IN; gain = args.in[5] + ll * D; }
                else if ((r -= I_IN) < I_MX) { src = args.in[9] + (size_t)ll * 512 * D; K = 512; N = D; off = OFF_HG; }
                else if ((r -= I_MX) < I_MX) { src = args.in[12] + (size_t)ll * 512 * D; K = 512; N = D; off = OFF_CV; }
                else if ((r -= I_MX) < I_MX) { src = args.in[14] + (size_t)ll * 512 * D; K = 512; N = D; off = OFF_NA; }
                else if ((r -= I_MX) < I_OUT) { src = args.in[15] + (size_t)ll * D * D; K = D; N = D; off = OFF_OUT; }
                else if ((r -= I_OUT) < I_GU) { src = args.in[17] + (size_t)ll * D * 2 * FF; K = D; N = 2 * FF; off = OFF_GU2; gain = args.in[16] + ll * D; perm = true; }
                else { r -= I_GU; src = args.in[18] + (size_t)ll * FF * D; K = FF; N = D; off = OFF_D2; }
                cvt_item(src, K, N, Wd + off, gain, perm, scr, r, lane);
            }
        } else if (kind == K_G0) {
            const float* xin = pr == 0 ? args.in[0] : args.in[1];
#pragma unroll 2
            for (int row = gw; row < 2 * TG; row += NGW) {
                const f32x4* __restrict__ xr = (const f32x4*)(xin + (size_t)row * D) + lane; v2u* bo = (v2u*)(XBp + (size_t)row * D) + lane;
                float ss = 0.f;
#pragma unroll
                for (int j = 0; j < 4; ++j) { const f32x4 v = xr[64 * j]; v2u w; w.x = cvt_pk_bf16(v[0], v[1]); w.y = cvt_pk_bf16(v[2], v[3]); bo[64 * j] = w; ss += (v[0] * v[0] + v[1] * v[1]) + (v[2] * v[2] + v[3] * v[3]); }
                ss = wave_sum(ss);
                if (lane < 16) SSQp[(size_t)row * 16 + lane] = lane == 0 ? ss : 0.f;
            }
        } else if (kind == K_UP) {
            pg8::Gemm gm{XBp, Wl + (s == 14 ? OFF_GU2 : OFF_GU1), 2 * TG, 2 * FF, D}; pg8::StaticOrder S; S.init(2 * TG, 2 * FF, G, bid);
            pg8::EpiSwiGLU E{PA, SSQp};
#ifndef NO_UP
            for (int rep = 0; rep < REP_GEMM; ++rep) pg8::gemm_phase<pg8::EpiSwiGLU, pg8::StaticOrder, PGA, PGS>(lds, gm, S, E);
#endif
        } else if (kind == K_RES) {
            const int K = mix ? D : FF, Mr = mix ? TG : 2 * TG; const size_t off = mix ? OFF_OUT : (s == 1 ? OFF_D1 : OFF_D2);
            pg8::Gemm gm{PA, Wl + off, Mr, D, K}; pg8::StaticOrder S; S.init(Mr, D, G, bid);
            pg8::EpiRes E{mix ? XB : XBp, mix ? SSQ : SSQp, mix ? 1.0f : 0.5f};
#ifndef NO_RES
            for (int rep = 0; rep < REP_RES; ++rep) { if (rep + 1 < REP_RES) { pg8::EpiRes E0 = E; E0.alpha = 0.f; pg8::gemm_phase<pg8::EpiRes, pg8::StaticOrder, PGA, PGS>(lds, gm, S, E0); }
                else pg8::gemm_phase<pg8::EpiRes, pg8::StaticOrder, PGA, PGS>(lds, gm, S, E); }
#endif
        } else if (kind == K_M1) {
            pg8::Gemm gm{XB, Wl + OFF_IN, TG, 8704, D}; pg8::StaticOrder S; S.init(TG, 8704, G, bid);
            pg8::EpiProj E{PA, PG, SSQ};
#ifndef NO_PROJ
            for (int rep = 0; rep < REP_GEMM; ++rep) pg8::gemm_phase<pg8::EpiProj, pg8::StaticOrder, PGA, PGS>(lds, gm, S, E);
#endif
        } else if (kind == K_M2A) {
#ifndef NO_HG
            { const int nP = (TG / 64) * 8;
              for (int rep = 0; rep < REP_HG; ++rep) if (bid < nP) hg_prep_items(lds, PA, SCR, args.in[7], l, bid, G, nP, T, tid); }
#endif
            const float* rpb = args.in[13] + (size_t)l * 8 * 465;
            const int vcu = (G % 8 == 0) ? (bid % 8) * (G / 8) + bid / 8 : bid;
            const int nNA = TG / 16, ipb = (nNA + G - 1) / G;
            for (int rep = 0; rep < REP_NA; ++rep)
                for (int q = 0; q < ipb; ++q) { const int it = vcu * ipb + q; if (it < nNA) {
#ifndef NO_NA
                    na_item(lds, PA, rpb, ONA, it, T, tid);
#endif
                    __syncthreads(); } }
        } else if (kind == K_M2B) {
#ifndef NO_HG
            const int vcu2 = (G % 8 == 0) ? (bid % 8) * (G / 8) + bid / 8 : bid;
            for (int rep = 0; rep < REP_HG; ++rep) {
                if (pr == 0) { for (int it = vcu2; it < 256; it += G) hg_scan_item<2>(lds, PA, SCR, it, T, tid); }
                else       { for (int it = vcu2; it < 256; it += G) hg_scan_item<1>(lds, PA, SCR, it, T, tid); }
            }
#endif
        } else if (kind == K_M3) {
            const float* gno = args.in[8] + l * 512; const float* cw = args.in[10] + l * 3 * 512; const float* cbias = args.in[11] + l * 512;
            const int c0 = lane * 8;
            const bf16* __restrict__ PAr = PA; bf16* __restrict__ OHGr = OHG; bf16* __restrict__ OCVr = OCV;
#pragma unroll 2
            for (int row = gw; row < TG; row += NGW) {
                const bf16* __restrict__ prow = PAr + (size_t)row * PA_LD;
                const v4u fw = *(const v4u*)(prow + C_HQ + c0), bw = *(const v4u*)(prow + C_HZF + c0);
                float o[8] = {bflo(fw.x) + bflo(bw.x), bfhi(fw.x) + bfhi(bw.x), bflo(fw.y) + bflo(bw.y), bfhi(fw.y) + bfhi(bw.y), bflo(fw.z) + bflo(bw.z), bfhi(fw.z) + bfhi(bw.z), bflo(fw.w) + bflo(bw.w), bfhi(fw.w) + bfhi(bw.w)};
                float ss = 0.f;
#pragma unroll
                for (int e = 0; e < 8; ++e) ss += o[e] * o[e];
                ss += __shfl_xor(ss, 1); ss += __shfl_xor(ss, 2); ss += __shfl_xor(ss, 4); ss += __shfl_xor(ss, 8);
                const float rs = __builtin_amdgcn_rsqf(ss * (1.0f / 128.0f) + 1e-6f);
                const v4u hgw = *(const v4u*)(prow + C_HG + c0);
                const float hgv[8] = {bflo(hgw.x), bfhi(hgw.x), bflo(hgw.y), bfhi(hgw.y), bflo(hgw.z), bfhi(hgw.z), bflo(hgw.w), bfhi(hgw.w)};
                const f32x4 gn0 = *(const f32x4*)(gno + c0), gn1 = *(const f32x4*)(gno + c0 + 4);
                const float gn[8] = {gn0[0], gn0[1], gn0[2], gn0[3], gn1[0], gn1[1], gn1[2], gn1[3]};
                float r8[8];
#pragma unroll
                for (int e = 0; e < 8; ++e) r8[e] = o[e] * rs * gn[e] * (hgv[e] * sigm(hgv[e]));
                v4u wo; wo.x = cvt_pk_bf16(r8[0], r8[1]); wo.y = cvt_pk_bf16(r8[2], r8[3]); wo.z = cvt_pk_bf16(r8[4], r8[5]); wo.w = cvt_pk_bf16(r8[6], r8[7]);
                *(v4u*)(OHGr + (size_t)row * 512 + c0) = wo;
                const int tl = row & (T - 1);
                const v4u a1 = *(const v4u*)(prow + C_CA + c0), c1 = *(const v4u*)(prow + C_CC + c0), bb = *(const v4u*)(prow + C_CB + c0);
                v4u a0 = {0u, 0u, 0u, 0u}, cc0 = a0, a2 = a0, cc2 = a0;
                if (tl > 0) { a0 = *(const v4u*)(prow - PA_LD + C_CA + c0); cc0 = *(const v4u*)(prow - PA_LD + C_CC + c0); }
                if (tl < T - 1) { a2 = *(const v4u*)(prow + PA_LD + C_CA + c0); cc2 = *(const v4u*)(prow + PA_LD + C_CC + c0); }
                const float zm[8] = {bflo(a0.x) * bflo(cc0.x), bfhi(a0.x) * bfhi(cc0.x), bflo(a0.y) * bflo(cc0.y), bfhi(a0.y) * bfhi(cc0.y), bflo(a0.z) * bflo(cc0.z), bfhi(a0.z) * bfhi(cc0.z), bflo(a0.w) * bflo(cc0.w), bfhi(a0.w) * bfhi(cc0.w)};
                const float zc[8] = {bflo(a1.x) * bflo(c1.x), bfhi(a1.x) * bfhi(c1.x), bflo(a1.y) * bflo(c1.y), bfhi(a1.y) * bfhi(c1.y), bflo(a1.z) * bflo(c1.z), bfhi(a1.z) * bfhi(c1.z), bflo(a1.w) * bflo(c1.w), bfhi(a1.w) * bfhi(c1.w)};
                const float zp[8] = {bflo(a2.x) * bflo(cc2.x), bfhi(a2.x) * bfhi(cc2.x), bflo(a2.y) * bflo(cc2.y), bfhi(a2.y) * bfhi(cc2.y), bflo(a2.z) * bflo(cc2.z), bfhi(a2.z) * bfhi(cc2.z), bflo(a2.w) * bflo(cc2.w), bfhi(a2.w) * bfhi(cc2.w)};
                const float cbv[8] = {bflo(bb.x), bfhi(bb.x), bflo(bb.y), bfhi(bb.y), bflo(bb.z), bfhi(bb.z), bflo(bb.w), bfhi(bb.w)};
                const f32x4 w00 = *(const f32x4*)(cw + c0), w01 = *(const f32x4*)(cw + c0 + 4), w10 = *(const f32x4*)(cw + 512 + c0), w11 = *(const f32x4*)(cw + 512 + c0 + 4);
                const f32x4 w20 = *(const f32x4*)(cw + 1024 + c0), w21 = *(const f32x4*)(cw + 1024 + c0 + 4), bs0 = *(const f32x4*)(cbias + c0), bs1 = *(const f32x4*)(cbias + c0 + 4);
#pragma unroll
                for (int e = 0; e < 4; ++e) { r8[e] = cbv[e] * (w00[e] * zm[e] + w10[e] * zc[e] + w20[e] * zp[e] + bs0[e]); r8[4 + e] = cbv[4 + e] * (w01[e] * zm[4 + e] + w11[e] * zc[4 + e] + w21[e] * zp[4 + e] + bs1[e]); }
                wo.x = cvt_pk_bf16(r8[0], r8[1]); wo.y = cvt_pk_bf16(r8[2], r8[3]); wo.z = cvt_pk_bf16(r8[4], r8[5]); wo.w = cvt_pk_bf16(r8[6], r8[7]);
                *(v4u*)(OCVr + (size_t)row * 512 + c0) = wo;
            }
        } else if (kind == K_M4) {
            pg8::Gemm gm{ONA, Wl + OFF_HG, 3 * TG, 3 * D, 512}; pg8::MergeOrder S; S.init(TG, D, G, bid);
            pg8::EpiMerge E{PG, PA};
#ifndef NO_MERGE
            for (int rep = 0; rep < REP_MERGE; ++rep) pg8::gemm_phase<pg8::EpiMerge, pg8::MergeOrder, PGA, PGS>(lds, gm, S, E);
#endif
        } else {
            const f32x4* fg = (const f32x4*)args.in[19] + lane;
#pragma unroll 2
            for (int row = gw; row < 2 * TG; row += NGW) {
                const float rs = pg8::row_rs(SSQp, row);
                f32x4* __restrict__ xo = (f32x4*)(X + (size_t)row * D) + lane; const v2u* __restrict__ bi = (const v2u*)(XBp + (size_t)row * D) + lane;
#pragma unroll
                for (int j = 0; j < 4; ++j) { const v2u w = bi[64 * j]; const f32x4 v = {bflo(w.x), bfhi(w.x), bflo(w.y), bfhi(w.y)}; xo[64 * j] = v * fg[64 * j] * rs; }
            }
        }
#if TPROBE
        __syncthreads();
        const unsigned long long tp1 = __builtin_amdgcn_s_memrealtime();
#endif
        if (ph + 1 < hi) { for (int rep = 0; rep < REP_SYNC; ++rep) { if (ph == 0) grid.sync(); else xcd_barrier(xbar); } }
#if TPROBE
        const unsigned long long tp2 = __builtin_amdgcn_s_memrealtime();
        if (TPROBE == 100) tacc += tp2 - tp1;
        else if (kind == TPROBE - 1) tacc += tp1 - tp0;
#endif
    }
#if TPROBE
    if (blockIdx.x == TPROBE_BLOCK) { const unsigned long long te = __builtin_amdgcn_s_memrealtime(); while (__builtin_amdgcn_s_memrealtime() - te < tacc) __builtin_amdgcn_s_sleep(8); }
#endif
}
constexpr int N_PHASES = 1 + 2 * PH_PER_PAIR;

extern "C" void kernel_launch(void* const* d_in, const int* in_sizes, int n_in, void* d_out, int out_size, void* d_ws, size_t ws_size, hipStream_t stream) {
    static int grid = 0;
    if (grid == 0) {
        if (n_in != 20 || ws_size < WS_END) { fprintf(stderr, "kernel_launch: unexpected n_in %d / ws %zu\n", n_in, ws_size); grid = -1; return; }
        int dev = 0, cus = 0, per_cu = 0;
        hipGetDevice(&dev); hipDeviceGetAttribute(&cus, hipDeviceAttributeMultiprocessorCount, dev);
        hipFuncSetAttribute((const void*)mk_fwd, hipFuncAttributeMaxDynamicSharedMemorySize, LDS_BYTES);
        hipOccupancyMaxActiveBlocksPerMultiprocessor(&per_cu, (const void*)mk_fwd, NTHR, LDS_BYTES);
        if (per_cu < 1) per_cu = 1;
        grid = cus * per_cu;
        (void)hipGetLastError();
    }
    if (grid < 0) return;
    hipMemsetAsync((char*)d_ws + WS_CTL, 0, CTL_BYTES, stream);
    Args a{};
    for (int i = 0; i < 20; ++i) a.in[i] = (const float*)d_in[i];
    a.out = (float*)d_out; a.ws = (unsigned char*)d_ws;
#if ONE_LAUNCH
    a.ph_lo = 0; a.ph_hi = N_PHASES;
    void* kargs[] = {&a};
    hipError_t e = hipLaunchCooperativeKernel((const void*)mk_fwd, dim3(grid), dim3(NTHR), kargs, LDS_BYTES, stream);
    if (e != hipSuccess) fprintf(stderr, "cooperative launch failed: %s (grid %d)\n", hipGetErrorString(e), grid);
#else
    for (int p = 0; p < N_PHASES; ++p) { a.ph_lo = p; a.ph_hi = p + 1; hipLaunchKernelGGL(mk_fwd, dim3(grid), dim3(NTHR), LDS_BYTES, stream, a); }
#endif
}
```

```cpp
#include <hip/hip_runtime.h>
#include <hip/hip_cooperative_groups.h>
#include <cstdio>
#include <cstdint>
namespace cg = cooperative_groups;
#ifndef ONE_LAUNCH
#define ONE_LAUNCH 1
#endif
#ifndef REP_HG
#define REP_HG 1
#endif
#ifndef REP_NA
#define REP_NA 1
#endif
#ifndef REP_SYNC
#define REP_SYNC 1
#endif
#ifndef REP_GEMM
#define REP_GEMM 1
#endif
#ifndef REP_M3
#define REP_M3 1
#endif
#ifndef REP_RES
#define REP_RES 1
#endif
#ifndef REP_MERGE
#define REP_MERGE 1
#endif
#ifndef REP_MISC
#define REP_MISC 1
#endif
#ifndef TPROBE
#define TPROBE 0
#endif
#ifndef TPROBE_BLOCK
#define TPROBE_BLOCK 0
#endif
#ifndef PGA
#define PGA true
#endif
#ifndef PGS
#define PGS true
#endif
namespace pg8 {
#define PG8_LAS __attribute__((address_space(3)))
typedef unsigned short bf16_t;
typedef short bf16x8 __attribute__((ext_vector_type(8)));
typedef float f32x4 __attribute__((ext_vector_type(4)));
typedef unsigned u32x4 __attribute__((ext_vector_type(4)));
constexpr int BM = 256, BK = 64, HALF = 128, HTB = HALF * BK * 2  , STAGE_BYTES = 8 * HTB, NXCD = 8, WGM = 8;

__host__ __device__ __forceinline__ int lds_byte(int r, int c) { const int st = (r >> 4) * 2 + (c >> 5), rr = r & 15, cc = c & 31, ob = rr * 64 + cc * 2; return st * 1024 + (ob ^ (((ob >> 9) & 1) << 5)); }
__host__ __device__ __forceinline__ void stage_rc(int b, int& R, int& C) { const int st = b / 1024, sb = b % 1024, swz = sb ^ (((sb >> 9) & 1) << 5); R = (st >> 1) * 16 + swz / 64; C = (st & 1) * 32 + (swz % 64) / 2; }
__host__ __device__ __forceinline__ int perm32(int rho) { const int n = rho >> 4, i = rho & 15; return 8 * (i >> 2) + 4 * n + (i & 3); }

struct Unit { int pm, pn; };
struct Gemm { const bf16_t* A; const bf16_t* Bt; int M, N, K; };

struct StaticOrder {
    int nM, nN, nwg, G, c;
    __host__ __device__ void init(int M, int N, int G_, int c_) { nM = M / BM; nN = N / BM; nwg = nM * nN; G = G_; c = c_; }
    __host__ __device__ bool next(int i, Unit& u) const {
        const long L = (long)i * G + c; if (L >= nwg) return false;
        int wgid = (int)L; { const int q = nwg / NXCD, r = nwg % NXCD, xcd = wgid % NXCD, off = wgid / NXCD; wgid = (xcd < r ? xcd * (q + 1) : r * (q + 1) + (xcd - r) * q) + off; }
        const int nig = WGM * nN, gid = wgid / nig, fm = gid * WGM, gsz = (nM - fm) < WGM ? (nM - fm) : WGM;
        u.pm = fm + ((wgid % nig) % gsz); u.pn = (wgid % nig) / gsz; return true;
    }
    __device__ __forceinline__ void a_ready(const Unit&) const {}
    __device__ __forceinline__ void done(const Unit&) const {}
};

__device__ __forceinline__ unsigned cvt_pk_bf16(float lo, float hi) { unsigned r; asm volatile("v_cvt_pk_bf16_f32 %0, %1, %2" : "=v"(r) : "v"(lo), "v"(hi)); return r; }
__device__ __forceinline__ float row_rs(const float* ssq, int row) {
    const f32x4* p = (const f32x4*)(ssq + (size_t)row * 16);
    const f32x4 a = p[0], b = p[1], c = p[2], d = p[3];
    const float s = (((a[0] + a[1]) + (a[2] + a[3])) + ((b[0] + b[1]) + (b[2] + b[3]))) + (((c[0] + c[1]) + (c[2] + c[3])) + ((d[0] + d[1]) + (d[2] + d[3])));
    return __builtin_amdgcn_rsqf(s * (1.0f / 1024.0f) + 1e-6f);
}
__device__ __forceinline__ void row_rs8(const float* ssq, int row0, float (&rsv)[8]) {
#pragma unroll
    for (int ai = 0; ai < 2; ++ai) {
        f32x4 p[4][4];
#pragma unroll
        for (int m = 0; m < 4; ++m) { const f32x4* q = (const f32x4*)(ssq + (size_t)(row0 + ai * HALF + m * 16) * 16);
#pragma unroll
            for (int j = 0; j < 4; ++j) p[m][j] = q[j]; }
#pragma unroll
        for (int m = 0; m < 4; ++m) { float t = 0.f;
#pragma unroll
            for (int j = 0; j < 4; ++j) t += (p[m][j][0] + p[m][j][1]) + (p[m][j][2] + p[m][j][3]);
            rsv[ai * 4 + m] = __builtin_amdgcn_rsqf(t * (1.0f / 1024.0f) + 1e-6f); }
    }
}
__device__ __forceinline__ float sigm(float v) { return __builtin_amdgcn_rcpf(1.0f + __expf(-v)); }

struct EpiSwiGLU {
    static constexpr bool PERM = true, AFTER_DRAIN = false;
    bf16_t* H; const float* ssq;
    __device__ __forceinline__ void operator()(const f32x4 (&acc)[2][2][4][2], const Unit& u, int wr, int wc, int fr, int fq) const {
        const int row0 = u.pm * BM + wr * 64 + fr, col0 = u.pn * 128 + wc * 32 + 8 * fq;
        float rsv[8]; row_rs8(ssq, row0, rsv);
#pragma unroll
        for (int ai = 0; ai < 2; ++ai)
#pragma unroll
            for (int m = 0; m < 4; ++m) {
                const int row = row0 + ai * HALF + m * 16; const float rs = rsv[ai * 4 + m];
                u32x4 w;
#pragma unroll
                for (int n = 0; n < 2; ++n) {
                    const f32x4 a = acc[ai][0][m][n] * rs, b = acc[ai][1][m][n] * rs; f32x4 h;
#pragma unroll
                    for (int e = 0; e < 4; ++e) h[e] = a[e] * sigm(a[e]) * b[e];
                    w[2 * n] = cvt_pk_bf16(h[0], h[1]); w[2 * n + 1] = cvt_pk_bf16(h[2], h[3]);
                }
                *(u32x4*)(H + (size_t)row * 2816 + col0) = w;
            }
    }
};
__device__ __forceinline__ void unpack8(const u32x4 w, f32x4& lo, f32x4& hi) {
    lo[0] = __uint_as_float(w.x << 16); lo[1] = __uint_as_float(w.x & 0xffff0000u); lo[2] = __uint_as_float(w.y << 16); lo[3] = __uint_as_float(w.y & 0xffff0000u);
    hi[0] = __uint_as_float(w.z << 16); hi[1] = __uint_as_float(w.z & 0xffff0000u); hi[2] = __uint_as_float(w.w << 16); hi[3] = __uint_as_float(w.w & 0xffff0000u);
}
struct EpiRes {
    static constexpr bool PERM = true, AFTER_DRAIN = false;
    bf16_t* XB; float* ssq; float alpha;
    __device__ __forceinline__ void operator()(const f32x4 (&acc)[2][2][4][2], const Unit& u, int wr, int wc, int fr, int fq) const {
        const int row0 = u.pm * BM + wr * 64 + fr, col0 = u.pn * BM + wc * 32 + 8 * fq;
#pragma unroll
        for (int ai = 0; ai < 2; ++ai) {
            u32x4 xin[4][2];
#pragma unroll
            for (int m = 0; m < 4; ++m)
#pragma unroll
                for (int bj = 0; bj < 2; ++bj) xin[m][bj] = *(const u32x4*)(XB + (size_t)(row0 + ai * HALF + m * 16) * 1024 + col0 + bj * HALF);
#pragma unroll
            for (int m = 0; m < 4; ++m) {
                const int row = row0 + ai * HALF + m * 16; float ss = 0.f;
#pragma unroll
                for (int bj = 0; bj < 2; ++bj) {
                    bf16_t* xp = XB + (size_t)row * 1024 + col0 + bj * HALF;
                    f32x4 x0, x1; unpack8(xin[m][bj], x0, x1);
                    x0 = x0 + acc[ai][bj][m][0] * alpha; x1 = x1 + acc[ai][bj][m][1] * alpha;
                    u32x4 w; w.x = cvt_pk_bf16(x0[0], x0[1]); w.y = cvt_pk_bf16(x0[2], x0[3]); w.z = cvt_pk_bf16(x1[0], x1[1]); w.w = cvt_pk_bf16(x1[2], x1[3]);
                    *(u32x4*)xp = w;
                    ss += ((x0[0] * x0[0] + x0[1] * x0[1]) + (x0[2] * x0[2] + x0[3] * x0[3])) + ((x1[0] * x1[0] + x1[1] * x1[1]) + (x1[2] * x1[2] + x1[3] * x1[3]));
                }
                ss += __shfl_xor(ss, 16); ss += __shfl_xor(ss, 32);
                if (fq == 0) ssq[(size_t)row * 16 + u.pn * 4 + wc] = ss;
            }
            asm volatile("" ::: "memory");
        }
    }
};
struct EpiProj {
    static constexpr bool PERM = true, AFTER_DRAIN = false;
    bf16_t* PA; bf16_t* PG; const float* ssq;
    __device__ __forceinline__ void operator()(const f32x4 (&acc)[2][2][4][2], const Unit& u, int wr, int wc, int fr, int fq) const {
        const int row0 = u.pm * BM + wr * 64 + fr;
        bf16_t* base; int ld, colt;
        if (u.pn < 22) { base = PA; ld = 5632; colt = u.pn * BM; } else { base = PG; ld = 3072; colt = (u.pn - 22) * BM; }
        const int col0 = colt + wc * 32 + 8 * fq;
        float rsv[8]; row_rs8(ssq, row0, rsv);
#pragma unroll
        for (int ai = 0; ai < 2; ++ai)
#pragma unroll
            for (int m = 0; m < 4; ++m) {
                const int row = row0 + ai * HALF + m * 16; const float rs = rsv[ai * 4 + m];
#pragma unroll
                for (int bj = 0; bj < 2; ++bj) {
                    const f32x4 v0 = acc[ai][bj][m][0] * rs, v1 = acc[ai][bj][m][1] * rs;
                    u32x4 w; w.x = cvt_pk_bf16(v0[0], v0[1]); w.y = cvt_pk_bf16(v0[2], v0[3]); w.z = cvt_pk_bf16(v1[0], v1[1]); w.w = cvt_pk_bf16(v1[2], v1[3]);
                    *(u32x4*)(base + (size_t)row * ld + col0 + bj * HALF) = w;
                }
            }
    }
};
struct MergeOrder {
    StaticOrder so;
    __device__ void init(int M, int N, int G_, int c_) { so.init(M, N, G_, c_); }
    __device__ bool next(int i, Unit& u) const { Unit b; if (!so.next(i / 3, b)) return false; const int m = i % 3, w = (m == 0) ? 2 : m - 1; u.pm = b.pm + 64 * m; u.pn = b.pn + 4 * w; return true; }
    __device__ __forceinline__ void a_ready(const Unit&) const {}
    __device__ __forceinline__ void done(const Unit&) const {}
};
struct EpiMerge {
    static constexpr bool PERM = true, AFTER_DRAIN = false;
    const bf16_t* PG; bf16_t* MB;
    __device__ __forceinline__ void operator()(const f32x4 (&acc)[2][2][4][2], const Unit& u, int wr, int wc, int fr, int fq) const {
        const int m_ = u.pm >> 6, pm = u.pm & 63, w_ = u.pn >> 2, pn = u.pn & 3;
        const int row0 = pm * BM + wr * 64 + fr, col0 = pn * BM + wc * 32 + 8 * fq;
#pragma unroll
        for (int ai = 0; ai < 2; ++ai) {
            u32x4 gin[4][2], pin[4][2];
#pragma unroll
            for (int m = 0; m < 4; ++m)
#pragma unroll
                for (int bj = 0; bj < 2; ++bj) { const int row = row0 + ai * HALF + m * 16, col = col0 + bj * HALF;
                    gin[m][bj] = *(const u32x4*)(PG + (size_t)row * 3072 + w_ * 1024 + col);
                    pin[m][bj] = (m_ > 0) ? *(const u32x4*)(MB + (size_t)row * 1024 + col) : (u32x4){0u, 0u, 0u, 0u}; }
#pragma unroll
            for (int m = 0; m < 4; ++m)
#pragma unroll
                for (int bj = 0; bj < 2; ++bj) { const int row = row0 + ai * HALF + m * 16, col = col0 + bj * HALF;
                    f32x4 g0, g1, p0, p1; unpack8(gin[m][bj], g0, g1); unpack8(pin[m][bj], p0, p1);
                    f32x4 t0, t1;
#pragma unroll
                    for (int e = 0; e < 4; ++e) { t0[e] = sigm(g0[e]) * acc[ai][bj][m][0][e] + p0[e]; t1[e] = sigm(g1[e]) * acc[ai][bj][m][1][e] + p1[e]; }
                    u32x4 w; w.x = cvt_pk_bf16(t0[0], t0[1]); w.y = cvt_pk_bf16(t0[2], t0[3]); w.z = cvt_pk_bf16(t1[0], t1[1]); w.w = cvt_pk_bf16(t1[2], t1[3]);
                    *(u32x4*)(MB + (size_t)row * 1024 + col) = w; }
            asm volatile("" ::: "memory");
        }
    }
};
template <class Epi, class Sched, bool ALIGN_EPI = false, bool SP2 = false>
__device__ __forceinline__ void gemm_phase(PG8_LAS unsigned char* lds, const Gemm g, const Sched& S, const Epi& E) {
    int tid = threadIdx.x; asm volatile("" : "+v"(tid));
    const int wid = __builtin_amdgcn_readfirstlane(tid >> 6), lane = tid & 63, wr = wid >> 2, wc = wid & 3, fr = lane & 15, fq = lane >> 4;
    const int K = g.K, nt = K / BK;
    unsigned voffA[2], voffB[2];
#pragma unroll
    for (int i = 0; i < 2; ++i) { int R, C; stage_rc(tid * 16 + i * 8192, R, C); const int Rb = Epi::PERM ? ((R & ~31) + perm32(R & 31)) : R;
        voffA[i] = (unsigned)(R * K + C) * 2u; voffB[i] = (unsigned)(Rb * K + C) * 2u; }
    const size_t kstep = (size_t)(BK * 2);
    const size_t hstep = (size_t)HALF * K * 2;
    const size_t tstep = 2 * hstep;
    const unsigned ldsw = (unsigned)wid * 1024u;
    const int aoff = lds_byte(wr * 64 + fr, fq * 8), boff = lds_byte(wc * 32 + fr, fq * 8);
#define PG8_SA(b, h) (((b) * 2 + (h)) * HTB)
#define PG8_SB(b, h) ((4 + (b) * 2 + (h)) * HTB)
#define PG8_STAGE(bufoff, gbase, voff) do { _Pragma("unroll") for (int _i = 0; _i < 2; ++_i) \
        __builtin_amdgcn_global_load_lds((const unsigned*)((const char*)(gbase) + (voff)[_i]), (PG8_LAS unsigned*)(lds + (bufoff) + ldsw + _i * 8192), 16, 0, 0); } while (0)
#define PG8_LDA(dst, b, h) do { _Pragma("unroll") for (int m = 0; m < 4; ++m) _Pragma("unroll") for (int k = 0; k < 2; ++k) dst[m][k] = *(const PG8_LAS bf16x8*)(lds + PG8_SA(b, h) + aoff + m * 2048 + k * 1024); } while (0)
#define PG8_LDB(dst, b, h) do { _Pragma("unroll") for (int n = 0; n < 2; ++n) _Pragma("unroll") for (int k = 0; k < 2; ++k) dst[n][k] = *(const PG8_LAS bf16x8*)(lds + PG8_SB(b, h) + boff + n * 2048 + k * 1024); } while (0)
#define PG8_MMA(ai, bj, At, Bt) do { __builtin_amdgcn_s_setprio(1); _Pragma("unroll") for (int m = 0; m < 4; ++m) _Pragma("unroll") for (int n = 0; n < 2; ++n) _Pragma("unroll") for (int k = 0; k < 2; ++k) \
        acc[ai][bj][m][n] = __builtin_amdgcn_mfma_f32_16x16x32_bf16(Bt[n][k], At[m][k], acc[ai][bj][m][n], 0, 0, 0); __builtin_amdgcn_s_setprio(0); } while (0)
#define PG8_WAIT_V(n) asm volatile("s_waitcnt vmcnt(" #n ")" ::: "memory")
#define PG8_WAIT_L(n) asm volatile("s_waitcnt lgkmcnt(" #n ")" ::: "memory")
#define PG8_BAR __builtin_amdgcn_s_barrier()
#define PG8_SCHED __builtin_amdgcn_sched_barrier(0)
    Unit cur, nxt; int ui = 0;
    if (!S.next(0, cur)) return;
    f32x4 acc[2][2][4][2];
#pragma unroll
    for (int a = 0; a < 2; ++a)
#pragma unroll
        for (int b = 0; b < 2; ++b)
#pragma unroll
            for (int m = 0; m < 4; ++m)
#pragma unroll
                for (int n = 0; n < 2; ++n) acc[a][b][m][n] = (f32x4){0.f, 0.f, 0.f, 0.f};
    bf16x8 At[4][2], B0[2][2], B1[2][2];
    const char* cA = (const char*)g.A + (size_t)cur.pm * tstep; const char* cB = (const char*)g.Bt + (size_t)cur.pn * tstep;
    S.a_ready(cur);
    if constexpr (SP2) {
        PG8_STAGE(PG8_SB(0, 0), cB, voffB); PG8_STAGE(PG8_SB(0, 1), cB + hstep, voffB); PG8_STAGE(PG8_SA(0, 0), cA, voffA); PG8_STAGE(PG8_SA(0, 1), cA + hstep, voffA);
        if (wr == 1) PG8_BAR;
        PG8_WAIT_V(2); PG8_BAR;
        PG8_STAGE(PG8_SB(1, 0), cB + kstep, voffB); PG8_STAGE(PG8_SA(1, 0), cA + kstep, voffA); PG8_STAGE(PG8_SB(1, 1), cB + hstep + kstep, voffB);
        PG8_WAIT_V(6); PG8_BAR;
    } else {
        PG8_STAGE(PG8_SB(0, 0), cB, voffB); PG8_STAGE(PG8_SA(0, 0), cA, voffA); PG8_STAGE(PG8_SB(0, 1), cB + hstep, voffB); PG8_STAGE(PG8_SA(0, 1), cA + hstep, voffA);
        if (wr == 1) PG8_BAR;
        PG8_WAIT_V(4); PG8_BAR;
        PG8_STAGE(PG8_SB(1, 0), cB + kstep, voffB); PG8_STAGE(PG8_SA(1, 0), cA + kstep, voffA); PG8_STAGE(PG8_SB(1, 1), cB + hstep + kstep, voffB);
        PG8_WAIT_V(6); PG8_BAR;
    }
    for (;;) {
        const bool has_next = S.next(ui + 1, nxt);
        const char* nA = has_next ? (const char*)g.A + (size_t)nxt.pm * tstep : cA; const char* nB = has_next ? (const char*)g.Bt + (size_t)nxt.pn * tstep : cB;
        for (int t = 0; t < nt; t += 2) {
            const bool last = (t == nt - 2);
            const char* a1 = cA + (size_t)(t + 1) * kstep;
            const char* a2 = last ? nA : cA + (size_t)(t + 2) * kstep; const char* b2 = last ? nB : cB + (size_t)(t + 2) * kstep;
            const char* a3 = a2 + kstep; const char* b3 = b2 + kstep;
            if (last && has_next) S.a_ready(nxt);
            if constexpr (SP2) {
            PG8_LDB(B0, 0, 0); PG8_LDB(B1, 0, 1); PG8_SCHED; PG8_LDA(At, 0, 0); PG8_STAGE(PG8_SA(1, 1), a1 + hstep, voffA);
            PG8_WAIT_V(8); PG8_WAIT_L(0); PG8_BAR; PG8_MMA(0, 0, At, B0); PG8_MMA(0, 1, At, B1); PG8_BAR; PG8_SCHED;
            PG8_LDA(At, 0, 1); PG8_STAGE(PG8_SB(0, 0), b2, voffB); PG8_STAGE(PG8_SB(0, 1), b2 + hstep, voffB); PG8_STAGE(PG8_SA(0, 0), a2, voffA);
            PG8_WAIT_V(8); PG8_WAIT_L(0); PG8_BAR; PG8_MMA(1, 0, At, B0); PG8_MMA(1, 1, At, B1); PG8_BAR; PG8_SCHED;
            PG8_LDB(B0, 1, 0); PG8_LDB(B1, 1, 1); PG8_SCHED; PG8_LDA(At, 1, 0); PG8_STAGE(PG8_SA(0, 1), a2 + hstep, voffA);
            PG8_WAIT_V(8); PG8_WAIT_L(0); PG8_BAR; PG8_MMA(0, 0, At, B0); PG8_MMA(0, 1, At, B1); PG8_BAR; PG8_SCHED;
            PG8_LDA(At, 1, 1); PG8_STAGE(PG8_SB(1, 0), b3, voffB); PG8_STAGE(PG8_SB(1, 1), b3 + hstep, voffB); PG8_STAGE(PG8_SA(1, 0), a3, voffA);
            PG8_WAIT_V(8); PG8_WAIT_L(0); PG8_BAR; PG8_MMA(1, 0, At, B0); PG8_MMA(1, 1, At, B1); PG8_BAR; PG8_SCHED;
            } else {
            PG8_LDB(B0, 0, 0); PG8_SCHED; PG8_LDA(At, 0, 0); PG8_STAGE(PG8_SA(1, 1), a1 + hstep, voffA);
            PG8_WAIT_L(8); PG8_BAR; PG8_WAIT_L(0); PG8_MMA(0, 0, At, B0); PG8_BAR; PG8_SCHED;
            PG8_LDB(B1, 0, 1); PG8_STAGE(PG8_SB(0, 0), b2, voffB);
            PG8_BAR; PG8_WAIT_L(0); PG8_MMA(0, 1, At, B1); PG8_BAR;
            PG8_LDA(At, 0, 1); PG8_STAGE(PG8_SA(0, 0), a2, voffA);
            PG8_BAR; PG8_WAIT_L(0); PG8_MMA(1, 0, At, B0); PG8_BAR; PG8_SCHED;
            PG8_STAGE(PG8_SB(0, 1), b2 + hstep, voffB);
            PG8_WAIT_V(6); PG8_BAR; PG8_MMA(1, 1, At, B1); PG8_BAR;
            PG8_LDB(B0, 1, 0); PG8_SCHED; PG8_LDA(At, 1, 0); PG8_STAGE(PG8_SA(0, 1), a2 + hstep, voffA);
            PG8_WAIT_L(8); PG8_BAR; PG8_WAIT_L(0); PG8_MMA(0, 0, At, B0); PG8_BAR; PG8_SCHED;
            PG8_LDB(B1, 1, 1); PG8_STAGE(PG8_SB(1, 0), b3, voffB);
            PG8_BAR; PG8_WAIT_L(0); PG8_MMA(0, 1, At, B1); PG8_BAR;
            PG8_LDA(At, 1, 1); PG8_STAGE(PG8_SA(1, 0), a3, voffA);
            PG8_BAR; PG8_WAIT_L(0); PG8_MMA(1, 0, At, B0); PG8_BAR; PG8_SCHED;
            PG8_STAGE(PG8_SB(1, 1), b3 + hstep, voffB);
            PG8_WAIT_V(6); PG8_BAR; PG8_MMA(1, 1, At, B1); PG8_BAR;
            }
        }
        if constexpr (ALIGN_EPI) { if (wr == 0) PG8_BAR; }
        if constexpr (!Epi::AFTER_DRAIN) { E(acc, cur, wr, wc, fr, fq); S.done(cur); }
        if (!has_next) break;
#pragma unroll
        for (int a = 0; a < 2; ++a)
#pragma unroll
            for (int b = 0; b < 2; ++b)
#pragma unroll
                for (int m = 0; m < 4; ++m)
#pragma unroll
                    for (int n = 0; n < 2; ++n) acc[a][b][m][n] = (f32x4){0.f, 0.f, 0.f, 0.f};
        cur = nxt; cA = nA; cB = nB; ++ui;
        if constexpr (ALIGN_EPI) { if (wr == 1) PG8_BAR; }
    }
    PG8_WAIT_V(0);
    if constexpr (!ALIGN_EPI) { if (wr == 0) PG8_BAR; }
    PG8_BAR;
    if constexpr (Epi::AFTER_DRAIN) { E.fused(acc, cur, wr, wc, fr, fq, lds, wid, lane); S.done(cur); }
#undef PG8_SA
#undef PG8_SB
#undef PG8_STAGE
#undef PG8_LDA
#undef PG8_LDB
#undef PG8_MMA
#undef PG8_WAIT_V
#undef PG8_WAIT_L
#undef PG8_BAR
#undef PG8_SCHED
}
}
#define LAS __attribute__((address_space(3)))
typedef unsigned short bf16;
typedef unsigned v4u __attribute__((ext_vector_type(4)));
typedef unsigned v2u __attribute__((ext_vector_type(2)));
typedef short v4i16_t __attribute__((ext_vector_type(4)));
using pg8::f32x4; using pg8::bf16x8; using pg8::cvt_pk_bf16;

constexpr int D = 1024, FF = 2816, NLAYER = 4, TG = 16384, NGROUP = 4, NTHR = 512, NWAVES = 8;
constexpr int PA_LD = 5632, PG_LD = 3072;
constexpr int C_HQ = 0, C_HI = 512, C_HZF = 1024, C_HZB = 1536, C_HG = 2048, C_CA = 2560, C_CB = 3072, C_CC = 3584, C_NQ = 4096, C_NK = 4608, C_NV = 5120;
constexpr size_t MiB = 1u << 20;
constexpr size_t WS_CTL = 0, CTL_BYTES = 1 * MiB, WS_W = 1 * MiB, WS_XB = 221 * MiB, WS_SSQ = 285 * MiB, WS_PA = 287 * MiB, WS_PG = 463 * MiB, WS_ONA = 559 * MiB, WS_SCR = 575 * MiB, WS_END = 671 * MiB;
constexpr size_t OFF_GU1 = 0, OFF_D1 = 5767168, OFF_IN = 8650752, OFF_HG = 17563648, OFF_CV = 18087936, OFF_NA = 18612224, OFF_OUT = 19136512, OFF_GU2 = 20185088, OFF_D2 = 25952256, LAYER_EL = 28835840;
constexpr int LDS_BYTES = 147456, LDS_MISC = 147456 - 64;
constexpr int PH_PER_PAIR = 1 + NLAYER * 16 + 1;
constexpr int CW_BAR = 4096;

__device__ __forceinline__ unsigned f2bf(float f) { unsigned u = __float_as_uint(f); return (u + 0x7fffu + ((u >> 16) & 1u)) >> 16; }
__device__ __forceinline__ float bf2f(unsigned b) { return __uint_as_float(b << 16); }
__device__ __forceinline__ float bflo(unsigned w) { return __uint_as_float(w << 16); }
__device__ __forceinline__ float bfhi(unsigned w) { return __uint_as_float(w & 0xffff0000u); }
__device__ __forceinline__ float sigm(float v) { return __builtin_amdgcn_rcpf(1.0f + __expf(-v)); }
__device__ __forceinline__ float wave_sum(float v) {
#pragma unroll
    for (int o = 1; o < 64; o <<= 1) v += __shfl_xor(v, o);
    return v;
}

__device__ __forceinline__ void cvt_item(const float* W, int K, int N, bf16* WT, const float* gain, bool permgu, LAS float* scr, int item, int lane) {
    const int nblk = N / 32, kb = item / nblk, nb = item % nblk, k0 = 64 * kb, n0 = 32 * nb;
#pragma unroll
    for (int i = 0; i < 32; ++i) { const int kk = 2 * i + (lane >> 5); const float g = gain ? gain[k0 + kk] : 1.0f; scr[kk * 33 + (lane & 31)] = W[(size_t)(k0 + kk) * N + n0 + (lane & 31)] * g; }
    asm volatile("s_waitcnt lgkmcnt(0)" ::: "memory");
    int dn0 = n0;
    if (permgu) { const int half = n0 >= FF ? 1 : 0; const int j = n0 - half * FF; dn0 = (j >> 7) * 256 + half * 128 + (j & 127); }
    const int c = lane & 7;
#pragma unroll
    for (int j = 0; j < 4; ++j) { const int n = (lane >> 3) + 8 * j; const LAS float* s = scr + (8 * c) * 33 + n;
        v4u o; o.x = cvt_pk_bf16(s[0 * 33], s[1 * 33]); o.y = cvt_pk_bf16(s[2 * 33], s[3 * 33]); o.z = cvt_pk_bf16(s[4 * 33], s[5 * 33]); o.w = cvt_pk_bf16(s[6 * 33], s[7 * 33]);
        *(v4u*)(WT + (size_t)(dn0 + n) * K + k0 + 8 * c) = o; }
    asm volatile("s_waitcnt lgkmcnt(0)" ::: "memory");
}

template <int K> __device__ __forceinline__ f32x4 mma_lds(f32x4 acc, const LAS bf16* A, int pa, const LAS bf16* B, int pb, int lane) {
    const int r = lane & 15, q = lane >> 4;
#pragma unroll
    for (int ks = 0; ks < K / 32; ++ks) {
        const bf16x8 a = *(const LAS bf16x8*)(A + r * pa + ks * 32 + q * 8);
        const bf16x8 b = *(const LAS bf16x8*)(B + r * pb + ks * 32 + q * 8);
        acc = __builtin_amdgcn_mfma_f32_16x16x32_bf16(a, b, acc, 0, 0, 0);
    }
    return acc;
}

constexpr int HP_QT = 0, HP_KTT = 17408, HP_AM = 35840, HP_ER = 45056, HP_EE = 45568, HP_BLK = 49152;
constexpr int HP_KT = 49152, HP_SEG = 66560;
constexpr int HS_VT = 49152, HS_ST = 53760, HS_BUF = 62464;
__device__ __forceinline__ void hg_prep_items(LAS unsigned char* lds, const bf16* PA, unsigned char* SCR, const float* lb_logits, int layer, int item0, int istride, int nitems, int T, int tid) {
    const int lane = tid & 63, wave = __builtin_amdgcn_readfirstlane(tid >> 6), c16 = lane & 15, quad = lane >> 4;
    const int nchunk = T / 64;
    const int k = tid & 127, tq = tid >> 7;
    LAS bf16* QT = (LAS bf16*)(lds + HP_QT); LAS bf16* KT = (LAS bf16*)(lds + HP_KT); LAS bf16* KTT = (LAS bf16*)(lds + HP_KTT); LAS bf16* AM = (LAS bf16*)(lds + HP_AM);
    LAS float* SEG = (LAS float*)(lds + HP_SEG); LAS float* ER = (LAS float*)(lds + HP_ER); LAS float* EE = (LAS float*)(lds + HP_EE);
    unsigned short zr[16], qr[16];
#define HP_LOAD(it) do { const int it_ = min((it), nitems - 1); const int c_ = it_ % nchunk, sd_ = it_ / nchunk, dir_ = sd_ & 1, h_ = (sd_ >> 1) & 3, base_ = (sd_ >> 3) * T; \
        const bf16* zs = PA + (dir_ ? C_HZB : C_HZF) + h_ * 128 + k; const bf16* qs = PA + C_HQ + h_ * 128 + k; \
        _Pragma("unroll") for (int i = 0; i < 16; ++i) { const int tau = c_ * 64 + 16 * tq + i; const size_t ro = (size_t)(base_ + (dir_ ? (T - 1 - tau) : tau)) * PA_LD; zr[i] = zs[ro]; qr[i] = qs[ro]; } } while (0)
    HP_LOAD(item0);
    for (int item = item0; item < nitems; item += istride) {
        const int sd = item / nchunk, dir = sd & 1, h = (sd >> 1) & 3;
        float lb;
        { float lg[4], mx = -3e38f;
#pragma unroll
          for (int l = 0; l < 4; ++l) { lg[l] = lb_logits[(dir * 4 + l) * 512 + h * 128 + k]; mx = fmaxf(mx, lg[l]); }
          float tot = 0.f, num = 0.f;
#pragma unroll
          for (int l = 0; l < 4; ++l) { const float e = __expf(lg[l] - mx); tot += e; if (l >= 1 && l <= layer) num += e; }
          lb = num / tot; }
        const float oml = 1.0f - lb;
        float b[16], kv[16], qv[16]; float cum = 0.f;
#pragma unroll
        for (int i = 0; i < 16; ++i) { const float zf = bf2f(zr[i]); const float sg = sigm(zf); const float f = lb + oml * sg; cum += __logf(fmaxf(f, 1e-30f)); b[i] = cum; kv[i] = oml * (1.0f - sg); qv[i] = bf2f(qr[i]); }
        HP_LOAD(item + istride);
        SEG[tq * 128 + k] = cum;
        __syncthreads();
        const float s0 = SEG[k], s1 = SEG[128 + k], s2 = SEG[256 + k], s3 = SEG[384 + k];
        const float pre = tq == 0 ? 0.f : (tq == 1 ? s0 : (tq == 2 ? s0 + s1 : (s0 + s1) + s2));
        const float r = s0 + s1, bend = (s0 + s1) + (s2 + s3);
        unsigned kpk[8];
#pragma unroll
        for (int i = 0; i < 16; ++i) {
            const float bt = pre + b[i];
            const float eq = __expf(fminf(bt - r, 80.f)), ek = __expf(fminf(r - bt, 80.f));
            const unsigned qb = f2bf(qv[i] * eq), kb = f2bf(kv[i] * ek);
            const int tau = 16 * tq + i;
            QT[tau * 136 + k] = (bf16)qb; KT[tau * 136 + k] = (bf16)kb;
            if (i & 1) kpk[i >> 1] |= kb << 16; else kpk[i >> 1] = kb;
        }
        *(LAS v4u*)(KTT + k * 72 + 16 * tq) = (v4u){kpk[0], kpk[1], kpk[2], kpk[3]};
        *(LAS v4u*)(KTT + k * 72 + 16 * tq + 8) = (v4u){kpk[4], kpk[5], kpk[6], kpk[7]};
        if (tq == 0) { ER[k] = __expf(r); EE[k] = __expf(bend - r); }
        __syncthreads();
#pragma unroll
        for (int e = 0; e < 2; ++e) { const int id = wave * 2 + e, tt = id >> 2, st = id & 3;
            f32x4 a = (f32x4){0.f, 0.f, 0.f, 0.f};
            if (st <= tt) a = mma_lds<128>(a, QT + tt * 16 * 136, 136, KT + st * 16 * 136, 136, lane);
#pragma unroll
            for (int i = 0; i < 4; ++i) { const int t = tt * 16 + quad * 4 + i, s = st * 16 + c16; const float val = (st <= tt && s <= t) ? a[i] : 0.f; AM[t * 72 + s] = (bf16)f2bf(val); } }
        __syncthreads();
        unsigned char* dst = SCR + (size_t)item * HP_BLK;
#pragma unroll
        for (int j = 0; j < 6; ++j) { const int idx = tid + 512 * j; *(v4u*)(dst + (size_t)idx * 16) = *(const LAS v4u*)(lds + idx * 16); }
        __syncthreads();
    }
#undef HP_LOAD
}

template <int NVT> __device__ __forceinline__ void hg_scan_item(LAS unsigned char* lds, bf16* PA, const unsigned char* SCR, int item, int T, int tid) {
    constexpr int NVS = 8 / NVT, VW = 16 * NVT, VTHR = 128 * NVT, VSH = (NVT == 2) ? 2 : 1;
    const int lane = tid & 63, wave = __builtin_amdgcn_readfirstlane(tid >> 6), c16 = lane & 15, quad = lane >> 4;
    const int vs = item % NVS, sd = item / NVS, dir = sd & 1, h = (sd >> 1) & 3, seq = sd >> 3;
    const int base = seq * T, nchunk = T / 64;
    const unsigned char* blk = SCR + (size_t)sd * nchunk * HP_BLK;
    const bf16* vsrc = PA + C_HI + h * 128 + vs * VW + (tid & (VW / 8 - 1)) * 8;
    bf16* odst = PA + (dir ? C_HZF : C_HQ) + h * 128 + vs * VW;
    v4u preA[6], preB[6]; v4u vrA = {0u, 0u, 0u, 0u}, vrB = vrA; f32x4 ervA, eevA, ervB, eevB;
#define HG_ROW(tau) (base + (dir ? (T - 1 - (tau)) : (tau)))
#define HS_LOAD(c, pre, vr, erv, eev) do { const int c_ = min((c), nchunk - 1); const unsigned char* bp = blk + (size_t)c_ * HP_BLK;     \
        _Pragma("unroll") for (int j = 0; j < 6; ++j) pre[j] = *(const v4u*)(bp + (size_t)(tid + 512 * j) * 16); \
        erv = *(const f32x4*)(bp + HP_ER + (wave * 16 + quad * 4) * 4); eev = *(const f32x4*)(blk + (size_t)max(c_ - 1, 0) * HP_BLK + HP_EE + (wave * 16 + quad * 4) * 4);     \
        vr = *(const v4u*)(vsrc + (size_t)HG_ROW(c_ * 64 + ((tid & (VTHR - 1)) >> VSH)) * PA_LD); } while (0)
    HS_LOAD(0, preA, vrA, ervA, eevA);
    HS_LOAD(1, preB, vrB, ervB, eevB);
    f32x4 accS[NVT];
#pragma unroll
    for (int e = 0; e < NVT; ++e) accS[e] = (f32x4){0.f, 0.f, 0.f, 0.f};
#define HS_STEP(c, BUFI, pre, vr, erv, eev) do { \
        LAS unsigned char* B = lds + (BUFI) * HS_BUF; \
        LAS bf16* QT = (LAS bf16*)(B + HP_QT); LAS bf16* KTT = (LAS bf16*)(B + HP_KTT); LAS bf16* AM = (LAS bf16*)(B + HP_AM); \
        LAS bf16* VT = (LAS bf16*)(B + HS_VT); LAS bf16* STt = (LAS bf16*)(B + HS_ST); \
        _Pragma("unroll") for (int j = 0; j < 6; ++j) *(LAS v4u*)(B + (tid + 512 * j) * 16) = pre[j]; \
        if (tid < VTHR) { const int s_ = tid >> VSH, vq = tid & (VW / 8 - 1); \
            VT[(vq * 8 + 0) * 72 + s_] = (bf16)(vr.x & 0xffffu); VT[(vq * 8 + 1) * 72 + s_] = (bf16)(vr.x >> 16); \
            VT[(vq * 8 + 2) * 72 + s_] = (bf16)(vr.y & 0xffffu); VT[(vq * 8 + 3) * 72 + s_] = (bf16)(vr.y >> 16); \
            VT[(vq * 8 + 4) * 72 + s_] = (bf16)(vr.z & 0xffffu); VT[(vq * 8 + 5) * 72 + s_] = (bf16)(vr.z >> 16); \
            VT[(vq * 8 + 6) * 72 + s_] = (bf16)(vr.w & 0xffffu); VT[(vq * 8 + 7) * 72 + s_] = (bf16)(vr.w >> 16); } \
        f32x4 sp[NVT]; const f32x4 sc_ = erv * eev;     \
        _Pragma("unroll") for (int e = 0; e < NVT; ++e) { sp[e] = accS[e] * sc_; v2u w; w.x = cvt_pk_bf16(sp[e][0], sp[e][1]); w.y = cvt_pk_bf16(sp[e][2], sp[e][3]); \
            *(LAS v2u*)(STt + (e * 16 + c16) * 136 + wave * 16 + quad * 4) = w; } \
        HS_LOAD((c) + 2, pre, vr, erv, eev); \
        __syncthreads(); \
        if ((wave >> 2) < NVT) { const int tt = wave & 3, vt = wave >> 2; f32x4 o = (f32x4){0.f, 0.f, 0.f, 0.f}; \
          o = mma_lds<128>(o, QT + tt * 16 * 136, 136, STt + vt * 16 * 136, 136, lane); \
          o = mma_lds<64>(o, AM + tt * 16 * 72, 72, VT + vt * 16 * 72, 72, lane); \
          _Pragma("unroll") for (int i = 0; i < 4; ++i) { const int tau = (c) * 64 + tt * 16 + quad * 4 + i; odst[(size_t)HG_ROW(tau) * PA_LD + vt * 16 + c16] = (bf16)f2bf(o[i]); } } \
        _Pragma("unroll") for (int e = 0; e < NVT; ++e) { accS[e] = mma_lds<64>(sp[e], KTT + wave * 16 * 72, 72, VT + e * 16 * 72, 72, lane); } \
    } while (0)
    for (int c = 0; c < nchunk; c += 2) {
        HS_STEP(c, 0, preA, vrA, ervA, eevA);
        HS_STEP(c + 1, 1, preB, vrB, ervB, eevB);
    }
    __syncthreads();
#undef HG_ROW
#undef HS_LOAD
#undef HS_STEP
}

__device__ __forceinline__ void na_item(LAS unsigned char* lds, const bf16* PA, const float* rpb, bf16* ONA, int item, int T, int tid) {
    const int lane = tid & 63, h = __builtin_amdgcn_readfirstlane(tid >> 6), c16 = lane & 15, quad = lane >> 4;
    const int ips = T / 16, seq = item / ips, rem = item % ips, r = rem >> 2, j = rem & 3;
    const int rows = T / 64, rs = min(max(r - 4, 0), rows - 8), kstart = (j == 0) ? 0 : (j == 1) ? 8 : (j == 2) ? 24 : 32;
    const int base = seq * T, qtok = base + r * 64 + 16 * j + c16;
    const bf16* qp = PA + (size_t)qtok * PA_LD + C_NQ + h * 64 + quad * 8;
    const bf16x8 Qb0 = *(const bf16x8*)qp, Qb1 = *(const bf16x8*)(qp + 32);
    const int qcol = 16 * j + c16, cs = min(max(qcol - 8, 0), 48);
    v4u vbufA[8], vbufB[8], vbufC[8], vbufD[8];
#define NA_VLOAD(qd, vbuf) do { _Pragma("unroll") for (int it = 0; it < 8; ++it) { const int idx = it * 64 + lane, key = idx >> 3, dg = idx & 7; \
        const int tok = base + (rs + 2 * (qd) + (key >> 5)) * 64 + kstart + (key & 31); vbuf[it] = *(const v4u*)(PA + (size_t)tok * PA_LD + C_NV + h * 64 + dg * 8); } } while (0)
    NA_VLOAD(0, vbufA); NA_VLOAD(1, vbufB);
    const float* rp = rpb + h * 465;
    f32x4 sacc[16]; float mx = -3e38f;
    int dcv[8]; bool okv[8];
#pragma unroll
    for (int e = 0; e < 8; ++e) { const int kcol = kstart + (e >> 2) * 16 + quad * 4 + (e & 3); okv[e] = (kcol >= cs) && (kcol < cs + 16); dcv[e] = min(max(kcol - qcol + 15, 0), 30); }
#pragma unroll
    for (int a = 0; a < 8; ++a) {
        const float rowv = rp[(rs + a - r + 7) * 31 + min(lane, 30)];
        float bv[8];
#pragma unroll
        for (int e = 0; e < 8; ++e) bv[e] = __builtin_bit_cast(float, __builtin_amdgcn_ds_bpermute(dcv[e] << 2, __builtin_bit_cast(int, rowv)));
#pragma unroll
        for (int hh = 0; hh < 2; ++hh) {
            const int ktok = base + (rs + a) * 64 + kstart + hh * 16 + c16;
            const bf16* kp = PA + (size_t)ktok * PA_LD + C_NK + h * 64 + quad * 8;
            const bf16x8 Ka0 = *(const bf16x8*)kp, Ka1 = *(const bf16x8*)(kp + 32);
            f32x4 s = (f32x4){0.f, 0.f, 0.f, 0.f};
            s = __builtin_amdgcn_mfma_f32_16x16x32_bf16(Ka0, Qb0, s, 0, 0, 0);
            s = __builtin_amdgcn_mfma_f32_16x16x32_bf16(Ka1, Qb1, s, 0, 0, 0);
#pragma unroll
            for (int i = 0; i < 4; ++i) { const float val = okv[hh * 4 + i] ? s[i] * 0.125f + bv[hh * 4 + i] : -1e30f; s[i] = val; mx = fmaxf(mx, val); }
            sacc[a * 2 + hh] = s;
        }
    }
    NA_VLOAD(2, vbufC); NA_VLOAD(3, vbufD);
    mx = fmaxf(mx, __shfl_xor(mx, 16)); mx = fmaxf(mx, __shfl_xor(mx, 32));
    float sum = 0.f;
#pragma unroll
    for (int t = 0; t < 16; ++t)
#pragma unroll
        for (int i = 0; i < 4; ++i) { const float p = __expf(sacc[t][i] - mx); sacc[t][i] = p; sum += p; }
    sum += __shfl_xor(sum, 16); sum += __shfl_xor(sum, 32);
    bf16x8 pb[8];
#pragma unroll
    for (int a = 0; a < 8; ++a) { v4u w; w.x = cvt_pk_bf16(sacc[2 * a][0], sacc[2 * a][1]); w.y = cvt_pk_bf16(sacc[2 * a][2], sacc[2 * a][3]);
        w.z = cvt_pk_bf16(sacc[2 * a + 1][0], sacc[2 * a + 1][1]); w.w = cvt_pk_bf16(sacc[2 * a + 1][2], sacc[2 * a + 1][3]); pb[a] = __builtin_bit_cast(bf16x8, w); }
    LAS bf16* VS = (LAS bf16*)(lds + h * 10240);
    f32x4 oacc[4];
#pragma unroll
    for (int dt = 0; dt < 4; ++dt) oacc[dt] = (f32x4){0.f, 0.f, 0.f, 0.f};
    const int trq = (lane & 15) >> 2, trp = lane & 3;
    const LAS bf16* trbase = VS + (quad * 4 + trq) * 80 + 4 * trp;
#define NA_PV(qd, vbuf) do { \
        _Pragma("unroll") for (int it = 0; it < 8; ++it) { const int idx = it * 64 + lane, key = idx >> 3, dg = idx & 7; *(LAS v4u*)(VS + key * 80 + dg * 8) = vbuf[it]; } \
        _Pragma("unroll") for (int al = 0; al < 2; ++al) \
            _Pragma("unroll") for (int dt = 0; dt < 4; ++dt) { const LAS bf16* p = trbase + al * 32 * 80 + dt * 16; \
                const v4i16_t lo = __builtin_amdgcn_ds_read_tr16_b64_v4i16((LAS v4i16_t*)p), hi = __builtin_amdgcn_ds_read_tr16_b64_v4i16((LAS v4i16_t*)(p + 16 * 80)); \
                const bf16x8 af = {lo[0], lo[1], lo[2], lo[3], hi[0], hi[1], hi[2], hi[3]}; \
                oacc[dt] = __builtin_amdgcn_mfma_f32_16x16x32_bf16(af, pb[(qd) * 2 + al], oacc[dt], 0, 0, 0); } } while (0)
    NA_PV(0, vbufA); NA_PV(1, vbufB); NA_PV(2, vbufC); NA_PV(3, vbufD);
#undef NA_PV
#undef NA_VLOAD
    const float inv = __builtin_amdgcn_rcpf(sum);
#pragma unroll
    for (int dt = 0; dt < 4; ++dt) { const f32x4 o = oacc[dt] * inv; v2u w; w.x = cvt_pk_bf16(o[0], o[1]); w.y = cvt_pk_bf16(o[2], o[3]);
        *(v2u*)(ONA + (size_t)qtok * 512 + h * 64 + dt * 16 + quad * 4) = w; }
}

#define XB_TMO      128
#define XB_XCNT(j)  (256  + 64 * (j))
#define XB_XSUB(j)  (1280 + 64 * (j))
#define XB_XGEN(j)  (2304 + 64 * (j))
#define XB_TOP      3328
#define XB_TOPGEN   3392
#define XCD_BAR_WORDS 3456
#define XB_SPIN_CAP (1u << 18)

__device__ __forceinline__ unsigned xb_ld(unsigned* p)              { return __hip_atomic_load(p, __ATOMIC_RELAXED, __HIP_MEMORY_SCOPE_AGENT); }
__device__ __forceinline__ unsigned xb_add(unsigned* p, unsigned v) { return __hip_atomic_fetch_add(p, v, __ATOMIC_RELAXED, __HIP_MEMORY_SCOPE_AGENT); }
__device__ __forceinline__ unsigned xb_xcc_id() { return (unsigned)__builtin_amdgcn_s_getreg((3 << 11) | 20) & 0xFu; }
#define XB_SPIN(cond, bar) do { unsigned _sp = 0; while (cond) { __builtin_amdgcn_s_sleep(1); \
    if ((++_sp & 255u) == 0u) { if (xb_ld(&(bar)[XB_TMO])) break; if (_sp > XB_SPIN_CAP) { atomicAdd(&(bar)[XB_TMO], 1u); break; } } } } while (0)

struct XcdBarrier {
    unsigned* bar; unsigned x;
    volatile LAS unsigned* st;
};

__device__ __forceinline__ XcdBarrier xcd_barrier_post(unsigned* bar, volatile LAS unsigned* st) {
    XcdBarrier b; b.bar = bar; b.x = xb_xcc_id(); b.st = st;
    if (threadIdx.x == 0) (void)xb_add(&bar[XB_XCNT(b.x)], 1u);
    return b;
}
__device__ __forceinline__ void xcd_barrier_complete(unsigned* bar, unsigned x, unsigned& nloc, unsigned& nx) {
    const unsigned G = gridDim.x * gridDim.y * gridDim.z;
    unsigned sum, cnt, mine, sp = 0u;
    for (;;) {
        sum = 0u; cnt = 0u; mine = 0u;
#pragma unroll
        for (unsigned j = 0; j < 16; ++j) { const unsigned c = xb_ld(&bar[XB_XCNT(j)]); sum += c; cnt += (c > 0u) ? 1u : 0u; mine = (j == x) ? c : mine; }
        if (sum == G) break;
        __builtin_amdgcn_s_sleep(1);
        if ((++sp & 255u) == 0u) { if (xb_ld(&bar[XB_TMO])) break; if (sp > XB_SPIN_CAP) { atomicAdd(&bar[XB_TMO], 1u); break; } }
    }
    nloc = mine > 0u ? mine : 1u; nx = cnt > 0u ? cnt : 1u;
}

__device__ __forceinline__ void xcd_barrier(const XcdBarrier& b) {
    asm volatile("s_waitcnt vmcnt(0)" ::: "memory");
    __syncthreads();
    if (threadIdx.x == 0) {
        unsigned* bar = b.bar;
        __builtin_amdgcn_s_waitcnt(0);
        unsigned nloc = b.st[0], nx = b.st[1];
        if (nloc == 0u) { xcd_barrier_complete(bar, b.x, nloc, nx); b.st[0] = nloc; b.st[1] = nx; }
        const unsigned old = xb_add(&bar[XB_XSUB(b.x)], 1u);
        const unsigned gen = old / nloc;
        if (old + 1u == (gen + 1u) * nloc) {
            __builtin_amdgcn_fence(__ATOMIC_RELEASE, "agent");
            asm volatile("s_waitcnt vmcnt(0)" ::: "memory");
            const unsigned og = xb_add(&bar[XB_TOP], 1u);
            const unsigned tg = og / nx;
            if (og + 1u == (tg + 1u) * nx) xb_add(&bar[XB_TOPGEN], 1u);
            else XB_SPIN(xb_ld(&bar[XB_TOPGEN]) == tg, bar);
            __builtin_amdgcn_fence(__ATOMIC_ACQUIRE, "agent");
            xb_add(&bar[XB_XGEN(b.x)], 1u);
            asm volatile("s_waitcnt vmcnt(0)" ::: "memory");
        } else {
            XB_SPIN(xb_ld(&bar[XB_XGEN(b.x)]) == gen, bar);
            __builtin_amdgcn_fence(__ATOMIC_ACQUIRE, "agent");
            asm volatile("s_waitcnt vmcnt(0)" ::: "memory");
        }
    }
    __syncthreads();
}
struct Args { const float* in[20]; float* out; unsigned char* ws; int ph_lo, ph_hi; };
enum { K_CVT = 0, K_G0, K_UP, K_RES, K_M1, K_M2A, K_M2B, K_M3, K_M4, K_GF };

__global__ void __launch_bounds__(NTHR, 2) mk_fwd(Args args) {
    extern __shared__ __attribute__((aligned(16))) unsigned char lds_raw[];
    LAS unsigned char* lds = (LAS unsigned char*)lds_raw;
    cg::grid_group grid = cg::this_grid();
    const int hi = args.ph_hi;
    { volatile LAS unsigned* st0 = (volatile LAS unsigned*)(lds + LDS_MISC + 32); if (threadIdx.x < 2) st0[threadIdx.x] = 0u; __syncthreads(); }
    XcdBarrier xbar = xcd_barrier_post((unsigned*)(args.ws + WS_CTL) + CW_BAR, (volatile LAS unsigned*)(lds + LDS_MISC + 32));
#if TPROBE
    unsigned long long tacc = 0ull;
#endif
    for (int ph = args.ph_lo; ph < hi; ++ph) {
#if TPROBE
        const unsigned long long tp0 = __builtin_amdgcn_s_memrealtime();
#endif
        int bid = blockIdx.x, G = gridDim.x; asm volatile("" : "+s"(bid), "+s"(G));
        int tid = threadIdx.x; asm volatile("" : "+v"(tid));
        const int lane = tid & 63, wave = __builtin_amdgcn_readfirstlane(tid >> 6);
        const int gw = bid * NWAVES + wave, NGW = G * NWAVES;
        int kind, pr = 0, l = 0, s = 0, g2 = 0;
        if (ph == 0) kind = K_CVT;
        else { const int q = ph - 1; pr = q / PH_PER_PAIR; const int r = q % PH_PER_PAIR;
            if (r == 0) kind = K_G0; else if (r == PH_PER_PAIR - 1) kind = K_GF;
            else { l = (r - 1) / 16; s = (r - 1) % 16;
                if (s == 0 || s == 14) kind = K_UP; else if (s == 1 || s == 15) kind = K_RES;
                else { g2 = (s - 2) / 6; const int t = (s - 2) % 6; kind = (t == 0) ? K_M1 : (t == 1) ? K_M2A : (t == 2) ? K_M2B : (t == 3) ? K_M3 : (t == 4) ? K_M4 : K_RES; } } }
        const bool mix = (s >= 2 && s <= 13);
        unsigned char* ws = args.ws;
        bf16* XBp = (bf16*)(ws + WS_XB); float* SSQp = (float*)(ws + WS_SSQ);
        bf16* XB = XBp + (size_t)g2 * TG * D; float* SSQ = SSQp + (size_t)g2 * TG * 16;
        bf16* PA = (bf16*)(ws + WS_PA); bf16* PG = (bf16*)(ws + WS_PG);
        bf16* ONA = (bf16*)(ws + WS_ONA); bf16* OHG = ONA + (size_t)TG * 512; bf16* OCV = OHG + (size_t)TG * 512;
        unsigned char* SCR = ws + WS_SCR;
        const bf16* Wl = (const bf16*)(ws + WS_W) + (size_t)l * LAYER_EL;
        const int T = pr == 0 ? 2048 : 4096;
        const int g = pr * 2 + g2;
        float* X = args.out + (size_t)pr * 2 * TG * D;

        if (kind == K_CVT) {
            LAS float* scr = (LAS float*)(lds + wave * 16384);
            constexpr int I_GU = 16 * 176, I_DN = 44 * 32, I_IN = 16 * 272, I_MX = 8 * 32, I_OUT = 16 * 32;
            constexpr int I_LAYER = 2 * I_GU + 2 * I_DN + I_IN + 3 * I_MX + I_OUT;
            for (int it = gw; it < NLAYER * I_LAYER; it += NGW) {
                const int ll = it / I_LAYER; int r = it % I_LAYER; bf16* Wd = (bf16*)(ws + WS_W) + (size_t)ll * LAYER_EL;
                const float* src; const float* gain = nullptr; int K, N; size_t off; bool perm = false;
                if (r < I_GU) { src = args.in[3] + (size_t)ll * D * 2 * FF; K = D; N = 2 * FF; off = OFF_GU1; gain = args.in[2] + ll * D; perm = true; }
                else if ((r -= I_GU) < I_DN) { src = args.in[4] + (size_t)ll * FF * D; K = FF; N = D; off = OFF_D1; }
                else if ((r -= I_DN) < I_IN) { src = args.in[6] + (size_t)ll * D * 8704; K = D; N = 8704; off = OFF_IN; gain = args.in[5] + ll * D; }
                else if ((r -= I_IN) < I_MX) { src = args.in[9] + (size_t)ll * 512 * D; K = 512; N = D; off = OFF_HG; }
                else if ((r -= I_MX) < I_MX) { src = args.in[12] + (size_t)ll * 512 * D; K = 512; N = D; off = OFF_CV; }
                else if ((r -= I_MX) < I_MX) { src = args.in[14] + (size_t)ll * 512 * D; K = 512; N = D; off = OFF_NA; }
                else if ((r -= I_MX) < I_OUT) { src = args.in[15] + (size_t)ll * D * D; K = D; N = D; off = OFF_OUT; }
                else if ((r -= I_OUT) < I_GU) { src = args.in[17] + (size_t)ll * D * 2 * FF; K = D; N = 2 * FF; off = OFF_GU2; gain = args.in[16] + ll * D; perm = true; }
                else { r -= I_GU; src = args.in[18] + (size_t)ll * FF * D; K = FF; N = D; off = OFF_D2; }
                cvt_item(src, K, N, Wd + off, gain, perm, scr, r, lane);
            }
        } else if (kind == K_G0) {
            const float* xin = pr == 0 ? args.in[0] : args.in[1];
#pragma unroll 2
            for (int row = gw; row < 2 * TG; row += NGW) {
                const f32x4* __restrict__ xr = (const f32x4*)(xin + (size_t)row * D) + lane; v2u* bo = (v2u*)(XBp + (size_t)row * D) + lane;
                float ss = 0.f;
#pragma unroll
                for (int j = 0; j < 4; ++j) { const f32x4 v = xr[64 * j]; v2u w; w.x = cvt_pk_bf16(v[0], v[1]); w.y = cvt_pk_bf16(v[2], v[3]); bo[64 * j] = w; ss += (v[0] * v[0] + v[1] * v[1]) + (v[2] * v[2] + v[3] * v[3]); }
                ss = wave_sum(ss);
                if (lane < 16) SSQp[(size_t)row * 16 + lane] = lane == 0 ? ss : 0.f;
            }
        } else if (kind == K_UP) {
            pg8::Gemm gm{XBp, Wl + (s == 14 ? OFF_GU2 : OFF_GU1), 2 * TG, 2 * FF, D}; pg8::StaticOrder S; S.init(2 * TG, 2 * FF, G, bid);
            pg8::EpiSwiGLU E{PA, SSQp};
#ifndef NO_UP
            for (int rep = 0; rep < REP_GEMM; ++rep) pg8::gemm_phase<pg8::EpiSwiGLU, pg8::StaticOrder, PGA, PGS>(lds, gm, S, E);
#endif
        } else if (kind == K_RES) {
            const int K = mix ? D : FF, Mr = mix ? TG : 2 * TG; const size_t off = mix ? OFF_OUT : (s == 1 ? OFF_D1 : OFF_D2);
            pg8::Gemm gm{PA, Wl + off, Mr, D, K}; pg8::StaticOrder S; S.init(Mr, D, G, bid);
            pg8::EpiRes E{mix ? XB : XBp, mix ? SSQ : SSQp, mix ? 1.0f : 0.5f};
#ifndef NO_RES
            for (int rep = 0; rep < REP_RES; ++rep) { if (rep + 1 < REP_RES) { pg8::EpiRes E0 = E; E0.alpha = 0.f; pg8::gemm_phase<pg8::EpiRes, pg8::StaticOrder, PGA, PGS>(lds, gm, S, E0); }
                else pg8::gemm_phase<pg8::EpiRes, pg8::StaticOrder, PGA, PGS>(lds, gm, S, E); }
#endif
        } else if (kind == K_M1) {
            pg8::Gemm gm{XB, Wl + OFF_IN, TG, 8704, D}; pg8::StaticOrder S; S.init(TG, 8704, G, bid);
            pg8::EpiProj E{PA, PG, SSQ};
#ifndef NO_PROJ
            for (int rep = 0; rep < REP_GEMM; ++rep) pg8::gemm_phase<pg8::EpiProj, pg8::StaticOrder, PGA, PGS>(lds, gm, S, E);
#endif
        } else if (kind == K_M2A) {
#ifndef NO_HG
            { const int nP = (TG / 64) * 8;
              for (int rep = 0; rep < REP_HG; ++rep) if (bid < nP) hg_prep_items(lds, PA, SCR, args.in[7], l, bid, G, nP, T, tid); }
#endif
            const float* rpb = args.in[13] + (size_t)l * 8 * 465;
            const int vcu = (G % 8 == 0) ? (bid % 8) * (G / 8) + bid / 8 : bid;
            const int nNA = TG / 16, ipb = (nNA + G - 1) / G;
            for (int rep = 0; rep < REP_NA; ++rep)
                for (int q = 0; q < ipb; ++q) { const int it = vcu * ipb + q; if (it < nNA) {
#ifndef NO_NA
                    na_item(lds, PA, rpb, ONA, it, T, tid);
#endif
                    __syncthreads(); } }
        } else if (kind == K_M2B) {
#ifndef NO_HG
            const int vcu2 = (G % 8 == 0) ? (bid % 8) * (G / 8) + bid / 8 : bid;
            for (int rep = 0; rep < REP_HG; ++rep) {
                if (pr == 0) { for (int it = vcu2; it < 256; it += G) hg_scan_item<2>(lds, PA, SCR, it, T, tid); }
                else       { for (int it = vcu2; it < 256; it += G) hg_scan_item<1>(lds, PA, SCR, it, T, tid); }
            }
#endif
        } else if (kind == K_M3) {
            const float* gno = args.in[8] + l * 512; const float* cw = args.in[10] + l * 3 * 512; const float* cbias = args.in[11] + l * 512;
            const int c0 = lane * 8;
            const bf16* __restrict__ PAr = PA; bf16* __restrict__ OHGr = OHG; bf16* __restrict__ OCVr = OCV;
#pragma unroll 2
            for (int row = gw; row < TG; row += NGW) {
                const bf16* __restrict__ prow = PAr + (size_t)row * PA_LD;
                const v4u fw = *(const v4u*)(prow + C_HQ + c0), bw = *(const v4u*)(prow + C_HZF + c0);
                float o[8] = {bflo(fw.x) + bflo(bw.x), bfhi(fw.x) + bfhi(bw.x), bflo(fw.y) + bflo(bw.y), bfhi(fw.y) + bfhi(bw.y), bflo(fw.z) + bflo(bw.z), bfhi(fw.z) + bfhi(bw.z), bflo(fw.w) + bflo(bw.w), bfhi(fw.w) + bfhi(bw.w)};
                float ss = 0.f;
#pragma unroll
                for (int e = 0; e < 8; ++e) ss += o[e] * o[e];
                ss += __shfl_xor(ss, 1); ss += __shfl_xor(ss, 2); ss += __shfl_xor(ss, 4); ss += __shfl_xor(ss, 8);
                const float rs = __builtin_amdgcn_rsqf(ss * (1.0f / 128.0f) + 1e-6f);
                const v4u hgw = *(const v4u*)(prow + C_HG + c0);
                const float hgv[8] = {bflo(hgw.x), bfhi(hgw.x), bflo(hgw.y), bfhi(hgw.y), bflo(hgw.z), bfhi(hgw.z), bflo(hgw.w), bfhi(hgw.w)};
                const f32x4 gn0 = *(const f32x4*)(gno + c0), gn1 = *(const f32x4*)(gno + c0 + 4);
                const float gn[8] = {gn0[0], gn0[1], gn0[2], gn0[3], gn1[0], gn1[1], gn1[2], gn1[3]};
                float r8[8];
#pragma unroll
                for (int e = 0; e < 8; ++e) r8[e] = o[e] * rs * gn[e] * (hgv[e] * sigm(hgv[e]));
                v4u wo; wo.x = cvt_pk_bf16(r8[0], r8[1]); wo.y = cvt_pk_bf16(r8[2], r8[3]); wo.z = cvt_pk_bf16(r8[4], r8[5]); wo.w = cvt_pk_bf16(r8[6], r8[7]);
                *(v4u*)(OHGr + (size_t)row * 512 + c0) = wo;
                const int tl = row & (T - 1);
                const v4u a1 = *(const v4u*)(prow + C_CA + c0), c1 = *(const v4u*)(prow + C_CC + c0), bb = *(const v4u*)(prow + C_CB + c0);
                v4u a0 = {0u, 0u, 0u, 0u}, cc0 = a0, a2 = a0, cc2 = a0;
                if (tl > 0) { a0 = *(const v4u*)(prow - PA_LD + C_CA + c0); cc0 = *(const v4u*)(prow - PA_LD + C_CC + c0); }
                if (tl < T - 1) { a2 = *(const v4u*)(prow + PA_LD + C_CA + c0); cc2 = *(const v4u*)(prow + PA_LD + C_CC + c0); }
                const float zm[8] = {bflo(a0.x) * bflo(cc0.x), bfhi(a0.x) * bfhi(cc0.x), bflo(a0.y) * bflo(cc0.y), bfhi(a0.y) * bfhi(cc0.y), bflo(a0.z) * bflo(cc0.z), bfhi(a0.z) * bfhi(cc0.z), bflo(a0.w) * bflo(cc0.w), bfhi(a0.w) * bfhi(cc0.w)};
                const float zc[8] = {bflo(a1.x) * bflo(c1.x), bfhi(a1.x) * bfhi(c1.x), bflo(a1.y) * bflo(c1.y), bfhi(a1.y) * bfhi(c1.y), bflo(a1.z) * bflo(c1.z), bfhi(a1.z) * bfhi(c1.z), bflo(a1.w) * bflo(c1.w), bfhi(a1.w) * bfhi(c1.w)};
                const float zp[8] = {bflo(a2.x) * bflo(cc2.x), bfhi(a2.x) * bfhi(cc2.x), bflo(a2.y) * bflo(cc2.y), bfhi(a2.y) * bfhi(cc2.y), bflo(a2.z) * bflo(cc2.z), bfhi(a2.z) * bfhi(cc2.z), bflo(a2.w) * bflo(cc2.w), bfhi(a2.w) * bfhi(cc2.w)};
                const float cbv[8] = {bflo(bb.x), bfhi(bb.x), bflo(bb.y), bfhi(bb.y), bflo(bb.z), bfhi(bb.z), bflo(bb.w), bfhi(bb.w)};
                const f32x4 w00 = *(const f32x4*)(cw + c0), w01 = *(const f32x4*)(cw + c0 + 4), w10 = *(const f32x4*)(cw + 512 + c0), w11 = *(const f32x4*)(cw + 512 + c0 + 4);
                const f32x4 w20 = *(const f32x4*)(cw + 1024 + c0), w21 = *(const f32x4*)(cw + 1024 + c0 + 4), bs0 = *(const f32x4*)(cbias + c0), bs1 = *(const f32x4*)(cbias + c0 + 4);
#pragma unroll
                for (int e = 0; e < 4; ++e) { r8[e] = cbv[e] * (w00[e] * zm[e] + w10[e] * zc[e] + w20[e] * zp[e] + bs0[e]); r8[4 + e] = cbv[4 + e] * (w01[e] * zm[4 + e] + w11[e] * zc[4 + e] + w21[e] * zp[4 + e] + bs1[e]); }
                wo.x = cvt_pk_bf16(r8[0], r8[1]); wo.y = cvt_pk_bf16(r8[2], r8[3]); wo.z = cvt_pk_bf16(r8[4], r8[5]); wo.w = cvt_pk_bf16(r8[6], r8[7]);
                *(v4u*)(OCVr + (size_t)row * 512 + c0) = wo;
            }
        } else if (kind == K_M4) {
            pg8::Gemm gm{ONA, Wl + OFF_HG, 3 * TG, 3 * D, 512}; pg8::MergeOrder S; S.init(TG, D, G, bid);
            pg8::EpiMerge E{PG, PA};
#ifndef NO_MERGE
            for (int rep = 0; rep < REP_MERGE; ++rep) pg8::gemm_phase<pg8::EpiMerge, pg8::MergeOrder, PGA, PGS>(lds, gm, S, E);
#endif
        } else {
            const f32x4* fg = (const f32x4*)args.in[19] + lane;
#pragma unroll 2
            for (int row = gw; row < 2 * TG; row += NGW) {
                const float rs = pg8::row_rs(SSQp, row);
                f32x4* __restrict__ xo = (f32x4*)(X + (size_t)row * D) + lane; const v2u* __restrict__ bi = (const v2u*)(XBp + (size_t)row * D) + lane;
#pragma unroll
                for (int j = 0; j < 4; ++j) { const v2u w = bi[64 * j]; const f32x4 v = {bflo(w.x), bfhi(w.x), bflo(w.y), bfhi(w.y)}; xo[64 * j] = v * fg[64 * j] * rs; }
            }
        }
#if TPROBE
        __syncthreads();
        const unsigned long long tp1 = __builtin_amdgcn_s_memrealtime();
#endif
        if (ph + 1 < hi) { for (int rep = 0; rep < REP_SYNC; ++rep) { if (hi < 0) grid.sync(); else xcd_barrier(xbar);     } }
#if TPROBE
        const unsigned long long tp2 = __builtin_amdgcn_s_memrealtime();
        if (TPROBE == 100) tacc += tp2 - tp1;
        else if (kind == TPROBE - 1) tacc += tp1 - tp0;
#endif
    }
#if TPROBE
    if (blockIdx.x == TPROBE_BLOCK) { const unsigned long long te = __builtin_amdgcn_s_memrealtime(); while (__builtin_amdgcn_s_memrealtime() - te < tacc) __builtin_amdgcn_s_sleep(8); }
#endif
}
constexpr int N_PHASES = 1 + 2 * PH_PER_PAIR;

extern "C" void kernel_launch(void* const* d_in, const int* in_sizes, int n_in, void* d_out, int out_size, void* d_ws, size_t ws_size, hipStream_t stream) {
    static int grid = 0;
    if (grid == 0) {
        if (n_in != 20 || ws_size < WS_END) { fprintf(stderr, "kernel_launch: unexpected n_in %d / ws %zu\n", n_in, ws_size); grid = -1; return; }
        int dev = 0, cus = 0, per_cu = 0;
        hipGetDevice(&dev); hipDeviceGetAttribute(&cus, hipDeviceAttributeMultiprocessorCount, dev);
        hipFuncSetAttribute((const void*)mk_fwd, hipFuncAttributeMaxDynamicSharedMemorySize, LDS_BYTES);
        hipOccupancyMaxActiveBlocksPerMultiprocessor(&per_cu, (const void*)mk_fwd, NTHR, LDS_BYTES);
        if (per_cu < 1) per_cu = 1;
        grid = cus * per_cu;
        (void)hipGetLastError();
    }
    if (grid < 0) return;
    hipMemsetAsync((char*)d_ws + WS_CTL, 0, CTL_BYTES, stream);
    Args a{};
    for (int i = 0; i < 20; ++i) a.in[i] = (const float*)d_in[i];
    a.out = (float*)d_out; a.ws = (unsigned char*)d_ws;
#if ONE_LAUNCH
    a.ph_lo = 0; a.ph_hi = N_PHASES;
    void* kargs[] = {&a};
    hipError_t e = hipLaunchCooperativeKernel((const void*)mk_fwd, dim3(grid), dim3(NTHR), kargs, LDS_BYTES, stream);
    if (e != hipSuccess) fprintf(stderr, "cooperative launch failed: %s (grid %d)\n", hipGetErrorString(e), grid);
#else
    for (int p = 0; p < N_PHASES; ++p) { a.ph_lo = p; a.ph_hi = p + 1; hipLaunchKernelGGL(mk_fwd, dim3(grid), dim3(NTHR), LDS_BYTES, stream, a); }
#endif
}
```

```cpp
#include <hip/hip_runtime.h>
#include <hip/hip_cooperative_groups.h>
#include <cstdio>
#include <cstdint>
namespace cg = cooperative_groups;
#ifndef ONE_LAUNCH
#define ONE_LAUNCH 1
#endif
#ifndef REP_HG
#define REP_HG 1
#endif
#ifndef REP_NA
#define REP_NA 1
#endif
#ifndef REP_SYNC
#define REP_SYNC 1
#endif
#ifndef REP_GEMM
#define REP_GEMM 1
#endif
#ifndef REP_M3
#define REP_M3 1
#endif
#ifndef REP_RES
#define REP_RES 1
#endif
#ifndef REP_MERGE
#define REP_MERGE 1
#endif
#ifndef REP_MISC
#define REP_MISC 1
#endif
#ifndef TPROBE
#define TPROBE 0
#endif
#ifndef TPROBE_BLOCK
#define TPROBE_BLOCK 0
#endif
#ifndef PGA
#define PGA true
#endif
#ifndef PGS
#define PGS true
#endif
namespace pg8 {
#define PG8_LAS __attribute__((address_space(3)))
typedef unsigned short bf16_t;
typedef short bf16x8 __attribute__((ext_vector_type(8)));
typedef float f32x4 __attribute__((ext_vector_type(4)));
typedef unsigned u32x4 __attribute__((ext_vector_type(4)));
constexpr int BM = 256, BK = 64, HALF = 128, HTB = HALF * BK * 2  , STAGE_BYTES = 8 * HTB, NXCD = 8, WGM = 8;

__host__ __device__ __forceinline__ int lds_byte(int r, int c) { const int st = (r >> 4) * 2 + (c >> 5), rr = r & 15, cc = c & 31, ob = rr * 64 + cc * 2; return st * 1024 + (ob ^ (((ob >> 9) & 1) << 5)); }
__host__ __device__ __forceinline__ void stage_rc(int b, int& R, int& C) { const int st = b / 1024, sb = b % 1024, swz = sb ^ (((sb >> 9) & 1) << 5); R = (st >> 1) * 16 + swz / 64; C = (st & 1) * 32 + (swz % 64) / 2; }
__host__ __device__ __forceinline__ int perm32(int rho) { const int n = rho >> 4, i = rho & 15; return 8 * (i >> 2) + 4 * n + (i & 3); }

struct Unit { int pm, pn; };
struct Gemm { const bf16_t* A; const bf16_t* Bt; int M, N, K; };

struct StaticOrder {
    int nM, nN, nwg, G, c;
    __host__ __device__ void init(int M, int N, int G_, int c_) { nM = M / BM; nN = N / BM; nwg = nM * nN; G = G_; c = c_; }
    __host__ __device__ bool next(int i, Unit& u) const {
        const long L = (long)i * G + c; if (L >= nwg) return false;
        int wgid = (int)L; { const int q = nwg / NXCD, r = nwg % NXCD, xcd = wgid % NXCD, off = wgid / NXCD; wgid = (xcd < r ? xcd * (q + 1) : r * (q + 1) + (xcd - r) * q) + off; }
        const int nig = WGM * nN, gid = wgid / nig, fm = gid * WGM, gsz = (nM - fm) < WGM ? (nM - fm) : WGM;
        u.pm = fm + ((wgid % nig) % gsz); u.pn = (wgid % nig) / gsz; return true;
    }
    __device__ __forceinline__ void a_ready(const Unit&) const {}
    __device__ __forceinline__ void done(const Unit&) const {}
};

__device__ __forceinline__ unsigned cvt_pk_bf16(float lo, float hi) { unsigned r; asm volatile("v_cvt_pk_bf16_f32 %0, %1, %2" : "=v"(r) : "v"(lo), "v"(hi)); return r; }
__device__ __forceinline__ float row_rs(const float* ssq, int row) {
    const f32x4* p = (const f32x4*)(ssq + (size_t)row * 16);
    const f32x4 a = p[0], b = p[1], c = p[2], d = p[3];
    const float s = (((a[0] + a[1]) + (a[2] + a[3])) + ((b[0] + b[1]) + (b[2] + b[3]))) + (((c[0] + c[1]) + (c[2] + c[3])) + ((d[0] + d[1]) + (d[2] + d[3])));
    return __builtin_amdgcn_rsqf(s * (1.0f / 1024.0f) + 1e-6f);
}
__device__ __forceinline__ void row_rs8(const float* ssq, int row0, float (&rsv)[8]) {
#pragma unroll
    for (int ai = 0; ai < 2; ++ai) {
        f32x4 p[4][4];
#pragma unroll
        for (int m = 0; m < 4; ++m) { const f32x4* q = (const f32x4*)(ssq + (size_t)(row0 + ai * HALF + m * 16) * 16);
#pragma unroll
            for (int j = 0; j < 4; ++j) p[m][j] = q[j]; }
#pragma unroll
        for (int m = 0; m < 4; ++m) { float t = 0.f;
#pragma unroll
            for (int j = 0; j < 4; ++j) t += (p[m][j][0] + p[m][j][1]) + (p[m][j][2] + p[m][j][3]);
            rsv[ai * 4 + m] = __builtin_amdgcn_rsqf(t * (1.0f / 1024.0f) + 1e-6f); }
    }
}
__device__ __forceinline__ float sigm(float v) { return __builtin_amdgcn_rcpf(1.0f + __expf(-v)); }

struct EpiSwiGLU {
    static constexpr bool PERM = true, AFTER_DRAIN = false;
    bf16_t* H; const float* ssq;
    __device__ __forceinline__ void operator()(const f32x4 (&acc)[2][2][4][2], const Unit& u, int wr, int wc, int fr, int fq) const {
        const int row0 = u.pm * BM + wr * 64 + fr, col0 = u.pn * 128 + wc * 32 + 8 * fq;
        float rsv[8]; row_rs8(ssq, row0, rsv);
#pragma unroll
        for (int ai = 0; ai < 2; ++ai)
#pragma unroll
            for (int m = 0; m < 4; ++m) {
                const int row = row0 + ai * HALF + m * 16; const float rs = rsv[ai * 4 + m];
                u32x4 w;
#pragma unroll
                for (int n = 0; n < 2; ++n) {
                    const f32x4 a = acc[ai][0][m][n] * rs, b = acc[ai][1][m][n] * rs; f32x4 h;
#pragma unroll
                    for (int e = 0; e < 4; ++e) h[e] = a[e] * sigm(a[e]) * b[e];
                    w[2 * n] = cvt_pk_bf16(h[0], h[1]); w[2 * n + 1] = cvt_pk_bf16(h[2], h[3]);
                }
                *(u32x4*)(H + (size_t)row * 2816 + col0) = w;
            }
    }
};
__device__ __forceinline__ void unpack8(const u32x4 w, f32x4& lo, f32x4& hi) {
    lo[0] = __uint_as_float(w.x << 16); lo[1] = __uint_as_float(w.x & 0xffff0000u); lo[2] = __uint_as_float(w.y << 16); lo[3] = __uint_as_float(w.y & 0xffff0000u);
    hi[0] = __uint_as_float(w.z << 16); hi[1] = __uint_as_float(w.z & 0xffff0000u); hi[2] = __uint_as_float(w.w << 16); hi[3] = __uint_as_float(w.w & 0xffff0000u);
}
struct EpiRes {
    static constexpr bool PERM = true, AFTER_DRAIN = false;
    bf16_t* XB; float* ssq; float alpha;
    __device__ __forceinline__ void operator()(const f32x4 (&acc)[2][2][4][2], const Unit& u, int wr, int wc, int fr, int fq) const {
        const int row0 = u.pm * BM + wr * 64 + fr, col0 = u.pn * BM + wc * 32 + 8 * fq;
#pragma unroll
        for (int ai = 0; ai < 2; ++ai) {
            u32x4 xin[4][2];
#pragma unroll
            for (int m = 0; m < 4; ++m)
#pragma unroll
                for (int bj = 0; bj < 2; ++bj) xin[m][bj] = *(const u32x4*)(XB + (size_t)(row0 + ai * HALF + m * 16) * 1024 + col0 + bj * HALF);
#pragma unroll
            for (int m = 0; m < 4; ++m) {
                const int row = row0 + ai * HALF + m * 16; float ss = 0.f;
#pragma unroll
                for (int bj = 0; bj < 2; ++bj) {
                    bf16_t* xp = XB + (size_t)row * 1024 + col0 + bj * HALF;
                    f32x4 x0, x1; unpack8(xin[m][bj], x0, x1);
                    x0 = x0 + acc[ai][bj][m][0] * alpha; x1 = x1 + acc[ai][bj][m][1] * alpha;
                    u32x4 w; w.x = cvt_pk_bf16(x0[0], x0[1]); w.y = cvt_pk_bf16(x0[2], x0[3]); w.z = cvt_pk_bf16(x1[0], x1[1]); w.w = cvt_pk_bf16(x1[2], x1[3]);
                    *(u32x4*)xp = w;
                    ss += ((x0[0] * x0[0] + x0[1] * x0[1]) + (x0[2] * x0[2] + x0[3] * x0[3])) + ((x1[0] * x1[0] + x1[1] * x1[1]) + (x1[2] * x1[2] + x1[3] * x1[3]));
                }
                ss += __shfl_xor(ss, 16); ss += __shfl_xor(ss, 32);
                if (fq == 0) ssq[(size_t)row * 16 + u.pn * 4 + wc] = ss;
            }
            asm volatile("" ::: "memory");
        }
    }
};
struct EpiProj {
    static constexpr bool PERM = true, AFTER_DRAIN = false;
    bf16_t* PA; unsigned char* PG8; const float* ssq;
    __device__ __forceinline__ void operator()(const f32x4 (&acc)[2][2][4][2], const Unit& u, int wr, int wc, int fr, int fq) const {
        const int row0 = u.pm * BM + wr * 64 + fr;
        float rsv[8]; row_rs8(ssq, row0, rsv);
        if (u.pn < 22) {
            const int col0 = u.pn * BM + wc * 32 + 8 * fq;
#pragma unroll
            for (int ai = 0; ai < 2; ++ai)
#pragma unroll
                for (int m = 0; m < 4; ++m) {
                    const int row = row0 + ai * HALF + m * 16; const float rs = rsv[ai * 4 + m];
#pragma unroll
                    for (int bj = 0; bj < 2; ++bj) {
                        const f32x4 v0 = acc[ai][bj][m][0] * rs, v1 = acc[ai][bj][m][1] * rs;
                        u32x4 w; w.x = cvt_pk_bf16(v0[0], v0[1]); w.y = cvt_pk_bf16(v0[2], v0[3]); w.z = cvt_pk_bf16(v1[0], v1[1]); w.w = cvt_pk_bf16(v1[2], v1[3]);
                        *(u32x4*)(PA + (size_t)row * 5632 + col0 + bj * HALF) = w;
                    }
                }
        } else {
            const int col0 = (u.pn - 22) * BM + wc * 32 + 8 * fq;
#pragma unroll
            for (int ai = 0; ai < 2; ++ai)
#pragma unroll
                for (int m = 0; m < 4; ++m) {
                    const int row = row0 + ai * HALF + m * 16; const float rs = rsv[ai * 4 + m];
#pragma unroll
                    for (int bj = 0; bj < 2; ++bj) {
                        unsigned q[8];
#pragma unroll
                        for (int e = 0; e < 4; ++e) { q[e] = (unsigned)(sigm(acc[ai][bj][m][0][e] * rs) * 255.0f + 0.5f); q[4 + e] = (unsigned)(sigm(acc[ai][bj][m][1][e] * rs) * 255.0f + 0.5f); }
                        typedef unsigned u32x2_ __attribute__((ext_vector_type(2)));
                        u32x2_ w; w.x = q[0] | (q[1] << 8) | (q[2] << 16) | (q[3] << 24); w.y = q[4] | (q[5] << 8) | (q[6] << 16) | (q[7] << 24);
                        *(u32x2_*)(PG8 + (size_t)row * 3072 + col0 + bj * HALF) = w;
                    }
                }
        }
    }
};
struct MergeOrder {
    StaticOrder so;
    __device__ void init(int M, int N, int G_, int c_) { so.init(M, N, G_, c_); }
    __device__ bool next(int i, Unit& u) const { Unit b; if (!so.next(i / 3, b)) return false; const int m = i % 3, w = (m == 0) ? 2 : m - 1; u.pm = b.pm + 64 * m; u.pn = b.pn + 4 * w; return true; }
    __device__ __forceinline__ void a_ready(const Unit&) const {}
    __device__ __forceinline__ void done(const Unit&) const {}
};
struct EpiMerge {
    static constexpr bool PERM = true, AFTER_DRAIN = false;
    const unsigned char* PG8; bf16_t* MB;
    __device__ __forceinline__ void operator()(const f32x4 (&acc)[2][2][4][2], const Unit& u, int wr, int wc, int fr, int fq) const {
        typedef unsigned u32x2_ __attribute__((ext_vector_type(2)));
        const int m_ = u.pm >> 6, pm = u.pm & 63, w_ = u.pn >> 2, pn = u.pn & 3;
        const int row0 = pm * BM + wr * 64 + fr, col0 = pn * BM + wc * 32 + 8 * fq;
#pragma unroll
        for (int ai = 0; ai < 2; ++ai) {
            u32x2_ gin[4][2]; u32x4 pin[4][2];
#pragma unroll
            for (int m = 0; m < 4; ++m)
#pragma unroll
                for (int bj = 0; bj < 2; ++bj) { const int row = row0 + ai * HALF + m * 16, col = col0 + bj * HALF;
                    gin[m][bj] = *(const u32x2_*)(PG8 + (size_t)row * 3072 + w_ * 1024 + col);
                    pin[m][bj] = (m_ > 0) ? *(const u32x4*)(MB + (size_t)row * 1024 + col) : (u32x4){0u, 0u, 0u, 0u}; }
#pragma unroll
            for (int m = 0; m < 4; ++m)
#pragma unroll
                for (int bj = 0; bj < 2; ++bj) { const int row = row0 + ai * HALF + m * 16, col = col0 + bj * HALF;
                    f32x4 g0, g1, p0, p1; unpack8(pin[m][bj], p0, p1);
                    { const unsigned a = gin[m][bj].x, b = gin[m][bj].y; const float k = 1.0f / 255.0f;
                      g0[0] = (float)(a & 255u) * k; g0[1] = (float)((a >> 8) & 255u) * k; g0[2] = (float)((a >> 16) & 255u) * k; g0[3] = (float)(a >> 24) * k;
                      g1[0] = (float)(b & 255u) * k; g1[1] = (float)((b >> 8) & 255u) * k; g1[2] = (float)((b >> 16) & 255u) * k; g1[3] = (float)(b >> 24) * k; }
                    f32x4 t0, t1;
#pragma unroll
                    for (int e = 0; e < 4; ++e) { t0[e] = g0[e] * acc[ai][bj][m][0][e] + p0[e]; t1[e] = g1[e] * acc[ai][bj][m][1][e] + p1[e]; }
                    u32x4 w; w.x = cvt_pk_bf16(t0[0], t0[1]); w.y = cvt_pk_bf16(t0[2], t0[3]); w.z = cvt_pk_bf16(t1[0], t1[1]); w.w = cvt_pk_bf16(t1[2], t1[3]);
                    *(u32x4*)(MB + (size_t)row * 1024 + col) = w; }
            asm volatile("" ::: "memory");
        }
    }
};
template <class Epi, class Sched, bool ALIGN_EPI = false, bool SP2 = false>
__device__ __forceinline__ void gemm_phase(PG8_LAS unsigned char* lds, const Gemm g, const Sched& S, const Epi& E) {
    int tid = threadIdx.x; asm volatile("" : "+v"(tid));
    const int wid = __builtin_amdgcn_readfirstlane(tid >> 6), lane = tid & 63, wr = wid >> 2, wc = wid & 3, fr = lane & 15, fq = lane >> 4;
    const int K = g.K, nt = K / BK;
    unsigned voffA[2], voffB[2];
#pragma unroll
    for (int i = 0; i < 2; ++i) { int R, C; stage_rc(tid * 16 + i * 8192, R, C); const int Rb = Epi::PERM ? ((R & ~31) + perm32(R & 31)) : R;
        voffA[i] = (unsigned)(R * K + C) * 2u; voffB[i] = (unsigned)(Rb * K + C) * 2u; }
    const size_t kstep = (size_t)(BK * 2);
    const size_t hstep = (size_t)HALF * K * 2;
    const size_t tstep = 2 * hstep;
    const unsigned ldsw = (unsigned)wid * 1024u;
    const int aoff = lds_byte(wr * 64 + fr, fq * 8), boff = lds_byte(wc * 32 + fr, fq * 8);
#define PG8_SA(b, h) (((b) * 2 + (h)) * HTB)
#define PG8_SB(b, h) ((4 + (b) * 2 + (h)) * HTB)
#define PG8_STAGE(bufoff, gbase, voff) do { _Pragma("unroll") for (int _i = 0; _i < 2; ++_i) \
        __builtin_amdgcn_global_load_lds((const unsigned*)((const char*)(gbase) + (voff)[_i]), (PG8_LAS unsigned*)(lds + (bufoff) + ldsw + _i * 8192), 16, 0, 0); } while (0)
#define PG8_LDA(dst, b, h) do { _Pragma("unroll") for (int m = 0; m < 4; ++m) _Pragma("unroll") for (int k = 0; k < 2; ++k) dst[m][k] = *(const PG8_LAS bf16x8*)(lds + PG8_SA(b, h) + aoff + m * 2048 + k * 1024); } while (0)
#define PG8_LDB(dst, b, h) do { _Pragma("unroll") for (int n = 0; n < 2; ++n) _Pragma("unroll") for (int k = 0; k < 2; ++k) dst[n][k] = *(const PG8_LAS bf16x8*)(lds + PG8_SB(b, h) + boff + n * 2048 + k * 1024); } while (0)
#define PG8_MMA(ai, bj, At, Bt) do { __builtin_amdgcn_s_setprio(1); _Pragma("unroll") for (int m = 0; m < 4; ++m) _Pragma("unroll") for (int n = 0; n < 2; ++n) _Pragma("unroll") for (int k = 0; k < 2; ++k) \
        acc[ai][bj][m][n] = __builtin_amdgcn_mfma_f32_16x16x32_bf16(Bt[n][k], At[m][k], acc[ai][bj][m][n], 0, 0, 0); __builtin_amdgcn_s_setprio(0); } while (0)
#define PG8_WAIT_V(n) asm volatile("s_waitcnt vmcnt(" #n ")" ::: "memory")
#define PG8_WAIT_L(n) asm volatile("s_waitcnt lgkmcnt(" #n ")" ::: "memory")
#define PG8_BAR __builtin_amdgcn_s_barrier()
#define PG8_SCHED __builtin_amdgcn_sched_barrier(0)
    Unit cur, nxt; int ui = 0;
    if (!S.next(0, cur)) return;
    f32x4 acc[2][2][4][2];
#pragma unroll
    for (int a = 0; a < 2; ++a)
#pragma unroll
        for (int b = 0; b < 2; ++b)
#pragma unroll
            for (int m = 0; m < 4; ++m)
#pragma unroll
                for (int n = 0; n < 2; ++n) acc[a][b][m][n] = (f32x4){0.f, 0.f, 0.f, 0.f};
    bf16x8 At[4][2], B0[2][2], B1[2][2];
    const char* cA = (const char*)g.A + (size_t)cur.pm * tstep; const char* cB = (const char*)g.Bt + (size_t)cur.pn * tstep;
    S.a_ready(cur);
    if constexpr (SP2) {
        PG8_STAGE(PG8_SB(0, 0), cB, voffB); PG8_STAGE(PG8_SB(0, 1), cB + hstep, voffB); PG8_STAGE(PG8_SA(0, 0), cA, voffA); PG8_STAGE(PG8_SA(0, 1), cA + hstep, voffA);
        if (wr == 1) PG8_BAR;
        PG8_WAIT_V(2); PG8_BAR;
        PG8_STAGE(PG8_SB(1, 0), cB + kstep, voffB); PG8_STAGE(PG8_SA(1, 0), cA + kstep, voffA); PG8_STAGE(PG8_SB(1, 1), cB + hstep + kstep, voffB);
        PG8_WAIT_V(6); PG8_BAR;
    } else {
        PG8_STAGE(PG8_SB(0, 0), cB, voffB); PG8_STAGE(PG8_SA(0, 0), cA, voffA); PG8_STAGE(PG8_SB(0, 1), cB + hstep, voffB); PG8_STAGE(PG8_SA(0, 1), cA + hstep, voffA);
        if (wr == 1) PG8_BAR;
        PG8_WAIT_V(4); PG8_BAR;
        PG8_STAGE(PG8_SB(1, 0), cB + kstep, voffB); PG8_STAGE(PG8_SA(1, 0), cA + kstep, voffA); PG8_STAGE(PG8_SB(1, 1), cB + hstep + kstep, voffB);
        PG8_WAIT_V(6); PG8_BAR;
    }
    for (;;) {
        const bool has_next = S.next(ui + 1, nxt);
        const char* nA = has_next ? (const char*)g.A + (size_t)nxt.pm * tstep : cA; const char* nB = has_next ? (const char*)g.Bt + (size_t)nxt.pn * tstep : cB;
        for (int t = 0; t < nt; t += 2) {
            const bool last = (t == nt - 2);
            const char* a1 = cA + (size_t)(t + 1) * kstep;
            const char* a2 = last ? nA : cA + (size_t)(t + 2) * kstep; const char* b2 = last ? nB : cB + (size_t)(t + 2) * kstep;
            const char* a3 = a2 + kstep; const char* b3 = b2 + kstep;
            if (last && has_next) S.a_ready(nxt);
            if constexpr (SP2) {
            PG8_LDB(B0, 0, 0); PG8_LDB(B1, 0, 1); PG8_SCHED; PG8_LDA(At, 0, 0); PG8_STAGE(PG8_SA(1, 1), a1 + hstep, voffA);
            PG8_WAIT_V(8); PG8_WAIT_L(0); PG8_BAR; PG8_MMA(0, 0, At, B0); PG8_MMA(0, 1, At, B1); PG8_BAR; PG8_SCHED;
            PG8_LDA(At, 0, 1); PG8_STAGE(PG8_SB(0, 0), b2, voffB); PG8_STAGE(PG8_SB(0, 1), b2 + hstep, voffB); PG8_STAGE(PG8_SA(0, 0), a2, voffA);
            PG8_WAIT_V(8); PG8_WAIT_L(0); PG8_BAR; PG8_MMA(1, 0, At, B0); PG8_MMA(1, 1, At, B1); PG8_BAR; PG8_SCHED;
            PG8_LDB(B0, 1, 0); PG8_LDB(B1, 1, 1); PG8_SCHED; PG8_LDA(At, 1, 0); PG8_STAGE(PG8_SA(0, 1), a2 + hstep, voffA);
            PG8_WAIT_V(8); PG8_WAIT_L(0); PG8_BAR; PG8_MMA(0, 0, At, B0); PG8_MMA(0, 1, At, B1); PG8_BAR; PG8_SCHED;
            PG8_LDA(At, 1, 1); PG8_STAGE(PG8_SB(1, 0), b3, voffB); PG8_STAGE(PG8_SB(1, 1), b3 + hstep, voffB); PG8_STAGE(PG8_SA(1, 0), a3, voffA);
            PG8_WAIT_V(8); PG8_WAIT_L(0); PG8_BAR; PG8_MMA(1, 0, At, B0); PG8_MMA(1, 1, At, B1); PG8_BAR; PG8_SCHED;
            } else {
            PG8_LDB(B0, 0, 0); PG8_SCHED; PG8_LDA(At, 0, 0); PG8_STAGE(PG8_SA(1, 1), a1 + hstep, voffA);
            PG8_WAIT_L(8); PG8_BAR; PG8_WAIT_L(0); PG8_MMA(0, 0, At, B0); PG8_BAR; PG8_SCHED;
            PG8_LDB(B1, 0, 1); PG8_STAGE(PG8_SB(0, 0), b2, voffB);
            PG8_BAR; PG8_WAIT_L(0); PG8_MMA(0, 1, At, B1); PG8_BAR;
            PG8_LDA(At, 0, 1); PG8_STAGE(PG8_SA(0, 0), a2, voffA);
            PG8_BAR; PG8_WAIT_L(0); PG8_MMA(1, 0, At, B0); PG8_BAR; PG8_SCHED;
            PG8_STAGE(PG8_SB(0, 1), b2 + hstep, voffB);
            PG8_WAIT_V(6); PG8_BAR; PG8_MMA(1, 1, At, B1); PG8_BAR;
            PG8_LDB(B0, 1, 0); PG8_SCHED; PG8_LDA(At, 1, 0); PG8_STAGE(PG8_SA(0, 1), a2 + hstep, voffA);
            PG8_WAIT_L(8); PG8_BAR; PG8_WAIT_L(0); PG8_MMA(0, 0, At, B0); PG8_BAR; PG8_SCHED;
            PG8_LDB(B1, 1, 1); PG8_STAGE(PG8_SB(1, 0), b3, voffB);
            PG8_BAR; PG8_WAIT_L(0); PG8_MMA(0, 1, At, B1); PG8_BAR;
            PG8_LDA(At, 1, 1); PG8_STAGE(PG8_SA(1, 0), a3, voffA);
            PG8_BAR; PG8_WAIT_L(0); PG8_MMA(1, 0, At, B0); PG8_BAR; PG8_SCHED;
            PG8_STAGE(PG8_SB(1, 1), b3 + hstep, voffB);
            PG8_WAIT_V(6); PG8_BAR; PG8_MMA(1, 1, At, B1); PG8_BAR;
            }
        }
        if constexpr (ALIGN_EPI) { if (wr == 0) PG8_BAR; }
        if constexpr (!Epi::AFTER_DRAIN) { E(acc, cur, wr, wc, fr, fq); S.done(cur); }
        if (!has_next) break;
#pragma unroll
        for (int a = 0; a < 2; ++a)
#pragma unroll
            for (int b = 0; b < 2; ++b)
#pragma unroll
                for (int m = 0; m < 4; ++m)
#pragma unroll
                    for (int n = 0; n < 2; ++n) acc[a][b][m][n] = (f32x4){0.f, 0.f, 0.f, 0.f};
        cur = nxt; cA = nA; cB = nB; ++ui;
        if constexpr (ALIGN_EPI) { if (wr == 1) PG8_BAR; }
    }
    PG8_WAIT_V(0);
    if constexpr (!ALIGN_EPI) { if (wr == 0) PG8_BAR; }
    PG8_BAR;
    if constexpr (Epi::AFTER_DRAIN) { E.fused(acc, cur, wr, wc, fr, fq, lds, wid, lane); S.done(cur); }
#undef PG8_SA
#undef PG8_SB
#undef PG8_STAGE
#undef PG8_LDA
#undef PG8_LDB
#undef PG8_MMA
#undef PG8_WAIT_V
#undef PG8_WAIT_L
#undef PG8_BAR
#undef PG8_SCHED
}
}
#define LAS __attribute__((address_space(3)))
typedef unsigned short bf16;
typedef unsigned v4u __attribute__((ext_vector_type(4)));
typedef unsigned v2u __attribute__((ext_vector_type(2)));
typedef short v4i16_t __attribute__((ext_vector_type(4)));
using pg8::f32x4; using pg8::bf16x8; using pg8::cvt_pk_bf16;

constexpr int D = 1024, FF = 2816, NLAYER = 4, TG = 16384, NGROUP = 4, NTHR = 512, NWAVES = 8;
constexpr int PA_LD = 5632, PG_LD = 3072;
constexpr int C_HQ = 0, C_HI = 512, C_HZF = 1024, C_HZB = 1536, C_HG = 2048, C_CA = 2560, C_CB = 3072, C_CC = 3584, C_NQ = 4096, C_NK = 4608, C_NV = 5120;
constexpr size_t MiB = 1u << 20;
constexpr size_t WS_CTL = 0, CTL_BYTES = 1 * MiB, WS_W = 1 * MiB, WS_XB = 221 * MiB, WS_SSQ = 285 * MiB, WS_PA = 287 * MiB, WS_PG = 463 * MiB, WS_ONA = 559 * MiB, WS_SCR = 575 * MiB, WS_END = 671 * MiB;
constexpr size_t OFF_GU1 = 0, OFF_D1 = 5767168, OFF_IN = 8650752, OFF_HG = 17563648, OFF_CV = 18087936, OFF_NA = 18612224, OFF_OUT = 19136512, OFF_GU2 = 20185088, OFF_D2 = 25952256, LAYER_EL = 28835840;
constexpr int LDS_BYTES = 147456, LDS_MISC = 147456 - 64;
constexpr int PH_PER_PAIR = 1 + NLAYER * 16 + 1;
constexpr int CW_BAR = 4096;

__device__ __forceinline__ unsigned f2bf(float f) { unsigned u = __float_as_uint(f); return (u + 0x7fffu + ((u >> 16) & 1u)) >> 16; }
__device__ __forceinline__ float bf2f(unsigned b) { return __uint_as_float(b << 16); }
__device__ __forceinline__ float bflo(unsigned w) { return __uint_as_float(w << 16); }
__device__ __forceinline__ float bfhi(unsigned w) { return __uint_as_float(w & 0xffff0000u); }
__device__ __forceinline__ float sigm(float v) { return __builtin_amdgcn_rcpf(1.0f + __expf(-v)); }
__device__ __forceinline__ float wave_sum(float v) {
#pragma unroll
    for (int o = 1; o < 64; o <<= 1) v += __shfl_xor(v, o);
    return v;
}

__device__ __forceinline__ void cvt_item(const float* W, int K, int N, bf16* WT, const float* gain, bool permgu, LAS float* scr, int item, int lane) {
    const int nblk = N / 32, kb = item / nblk, nb = item % nblk, k0 = 64 * kb, n0 = 32 * nb;
#pragma unroll
    for (int i = 0; i < 32; ++i) { const int kk = 2 * i + (lane >> 5); const float g = gain ? gain[k0 + kk] : 1.0f; scr[kk * 33 + (lane & 31)] = W[(size_t)(k0 + kk) * N + n0 + (lane & 31)] * g; }
    asm volatile("s_waitcnt lgkmcnt(0)" ::: "memory");
    int dn0 = n0;
    if (permgu) { const int half = n0 >= FF ? 1 : 0; const int j = n0 - half * FF; dn0 = (j >> 7) * 256 + half * 128 + (j & 127); }
    const int c = lane & 7;
#pragma unroll
    for (int j = 0; j < 4; ++j) { const int n = (lane >> 3) + 8 * j; const LAS float* s = scr + (8 * c) * 33 + n;
        v4u o; o.x = cvt_pk_bf16(s[0 * 33], s[1 * 33]); o.y = cvt_pk_bf16(s[2 * 33], s[3 * 33]); o.z = cvt_pk_bf16(s[4 * 33], s[5 * 33]); o.w = cvt_pk_bf16(s[6 * 33], s[7 * 33]);
        *(v4u*)(WT + (size_t)(dn0 + n) * K + k0 + 8 * c) = o; }
    asm volatile("s_waitcnt lgkmcnt(0)" ::: "memory");
}

template <int K> __device__ __forceinline__ f32x4 mma_lds(f32x4 acc, const LAS bf16* A, int pa, const LAS bf16* B, int pb, int lane) {
    const int r = lane & 15, q = lane >> 4;
#pragma unroll
    for (int ks = 0; ks < K / 32; ++ks) {
        const bf16x8 a = *(const LAS bf16x8*)(A + r * pa + ks * 32 + q * 8);
        const bf16x8 b = *(const LAS bf16x8*)(B + r * pb + ks * 32 + q * 8);
        acc = __builtin_amdgcn_mfma_f32_16x16x32_bf16(a, b, acc, 0, 0, 0);
    }
    return acc;
}

constexpr int HP_QT = 0, HP_KTT = 17408, HP_AM = 35840, HP_ER = 45056, HP_EE = 45568, HP_BLK = 49152;
constexpr int HP_KT = 49152, HP_SEG = 66560;
constexpr int HS_VT = 49152, HS_ST = 53760, HS_BUF = 62464;
__device__ __forceinline__ void hg_prep_items(LAS unsigned char* lds, const bf16* PA, unsigned char* SCR, const float* lb_logits, int layer, int item0, int istride, int nitems, int T, int tid) {
    const int lane = tid & 63, wave = __builtin_amdgcn_readfirstlane(tid >> 6), c16 = lane & 15, quad = lane >> 4;
    const int nchunk = T / 64;
    const int k = tid & 127, tq = tid >> 7;
    LAS bf16* QT = (LAS bf16*)(lds + HP_QT); LAS bf16* KT = (LAS bf16*)(lds + HP_KT); LAS bf16* KTT = (LAS bf16*)(lds + HP_KTT); LAS bf16* AM = (LAS bf16*)(lds + HP_AM);
    LAS float* SEG = (LAS float*)(lds + HP_SEG); LAS float* ER = (LAS float*)(lds + HP_ER); LAS float* EE = (LAS float*)(lds + HP_EE);
    unsigned short zr[16], qr[16];
#define HP_LOAD(it) do { const int it_ = min((it), nitems - 1); const int c_ = it_ % nchunk, sd_ = it_ / nchunk, dir_ = sd_ & 1, h_ = (sd_ >> 1) & 3, base_ = (sd_ >> 3) * T; \
        const bf16* zs = PA + (dir_ ? C_HZB : C_HZF) + h_ * 128 + k; const bf16* qs = PA + C_HQ + h_ * 128 + k; \
        _Pragma("unroll") for (int i = 0; i < 16; ++i) { const int tau = c_ * 64 + 16 * tq + i; const size_t ro = (size_t)(base_ + (dir_ ? (T - 1 - tau) : tau)) * PA_LD; zr[i] = zs[ro]; qr[i] = qs[ro]; } } while (0)
    HP_LOAD(item0);
    for (int item = item0; item < nitems; item += istride) {
        const int sd = item / nchunk, dir = sd & 1, h = (sd >> 1) & 3;
        float lb;
        { float lg[4], mx = -3e38f;
#pragma unroll
          for (int l = 0; l < 4; ++l) { lg[l] = lb_logits[(dir * 4 + l) * 512 + h * 128 + k]; mx = fmaxf(mx, lg[l]); }
          float tot = 0.f, num = 0.f;
#pragma unroll
          for (int l = 0; l < 4; ++l) { const float e = __expf(lg[l] - mx); tot += e; if (l >= 1 && l <= layer) num += e; }
          lb = num / tot; }
        const float oml = 1.0f - lb;
        float b[16], kv[16], qv[16]; float cum = 0.f;
#pragma unroll
        for (int i = 0; i < 16; ++i) { const float zf = bf2f(zr[i]); const float sg = sigm(zf); const float f = lb + oml * sg; cum += __logf(fmaxf(f, 1e-30f)); b[i] = cum; kv[i] = oml * (1.0f - sg); qv[i] = bf2f(qr[i]); }
        HP_LOAD(item + istride);
        SEG[tq * 128 + k] = cum;
        __syncthreads();
        const float s0 = SEG[k], s1 = SEG[128 + k], s2 = SEG[256 + k], s3 = SEG[384 + k];
        const float pre = tq == 0 ? 0.f : (tq == 1 ? s0 : (tq == 2 ? s0 + s1 : (s0 + s1) + s2));
        const float r = s0 + s1, bend = (s0 + s1) + (s2 + s3);
        unsigned kpk[8];
#pragma unroll
        for (int i = 0; i < 16; ++i) {
            const float bt = pre + b[i];
            const float eq = __expf(fminf(bt - r, 80.f)), ek = __expf(fminf(r - bt, 80.f));
            const unsigned qb = f2bf(qv[i] * eq), kb = f2bf(kv[i] * ek);
            const int tau = 16 * tq + i;
            QT[tau * 136 + k] = (bf16)qb; KT[tau * 136 + k] = (bf16)kb;
            if (i & 1) kpk[i >> 1] |= kb << 16; else kpk[i >> 1] = kb;
        }
        *(LAS v4u*)(KTT + k * 72 + 16 * tq) = (v4u){kpk[0], kpk[1], kpk[2], kpk[3]};
        *(LAS v4u*)(KTT + k * 72 + 16 * tq + 8) = (v4u){kpk[4], kpk[5], kpk[6], kpk[7]};
        if (tq == 0) { ER[k] = __expf(r); EE[k] = __expf(bend - r); }
        __syncthreads();
#pragma unroll
        for (int e = 0; e < 2; ++e) { const int id = wave * 2 + e, tt = id >> 2, st = id & 3;
            f32x4 a = (f32x4){0.f, 0.f, 0.f, 0.f};
            if (st <= tt) a = mma_lds<128>(a, QT + tt * 16 * 136, 136, KT + st * 16 * 136, 136, lane);
#pragma unroll
            for (int i = 0; i < 4; ++i) { const int t = tt * 16 + quad * 4 + i, s = st * 16 + c16; const float val = (st <= tt && s <= t) ? a[i] : 0.f; AM[t * 72 + s] = (bf16)f2bf(val); } }
        __syncthreads();
        unsigned char* dst = SCR + (size_t)item * HP_BLK;
#pragma unroll
        for (int j = 0; j < 6; ++j) { const int idx = tid + 512 * j; *(v4u*)(dst + (size_t)idx * 16) = *(const LAS v4u*)(lds + idx * 16); }
        __syncthreads();
    }
#undef HP_LOAD
}

template <int NVT> __device__ __forceinline__ void hg_scan_item(LAS unsigned char* lds, bf16* PA, const unsigned char* SCR, int item, int T, int tid) {
    constexpr int NVS = 8 / NVT, VW = 16 * NVT, VTHR = 128 * NVT, VSH = (NVT == 2) ? 2 : 1;
    const int lane = tid & 63, wave = __builtin_amdgcn_readfirstlane(tid >> 6), c16 = lane & 15, quad = lane >> 4;
    const int vs = item % NVS, sd = item / NVS, dir = sd & 1, h = (sd >> 1) & 3, seq = sd >> 3;
    const int base = seq * T, nchunk = T / 64;
    const unsigned char* blk = SCR + (size_t)sd * nchunk * HP_BLK;
    const bf16* vsrc = PA + C_HI + h * 128 + vs * VW + (tid & (VW / 8 - 1)) * 8;
    bf16* odst = PA + (dir ? C_HZF : C_HQ) + h * 128 + vs * VW;
    v4u preA[6], preB[6]; v4u vrA = {0u, 0u, 0u, 0u}, vrB = vrA; f32x4 ervA, eevA, ervB, eevB;
#define HG_ROW(tau) (base + (dir ? (T - 1 - (tau)) : (tau)))
#define HS_LOAD(c, pre, vr, erv, eev) do { const int c_ = min((c), nchunk - 1); const unsigned char* bp = blk + (size_t)c_ * HP_BLK;     \
        _Pragma("unroll") for (int j = 0; j < 6; ++j) pre[j] = *(const v4u*)(bp + (size_t)(tid + 512 * j) * 16); \
        erv = *(const f32x4*)(bp + HP_ER + (wave * 16 + quad * 4) * 4); eev = *(const f32x4*)(blk + (size_t)max(c_ - 1, 0) * HP_BLK + HP_EE + (wave * 16 + quad * 4) * 4);     \
        vr = *(const v4u*)(vsrc + (size_t)HG_ROW(c_ * 64 + ((tid & (VTHR - 1)) >> VSH)) * PA_LD); } while (0)
    HS_LOAD(0, preA, vrA, ervA, eevA);
    HS_LOAD(1, preB, vrB, ervB, eevB);
    f32x4 accS[NVT];
#pragma unroll
    for (int e = 0; e < NVT; ++e) accS[e] = (f32x4){0.f, 0.f, 0.f, 0.f};
#define HS_STEP(c, BUFI, pre, vr, erv, eev) do { \
        LAS unsigned char* B = lds + (BUFI) * HS_BUF; \
        LAS bf16* QT = (LAS bf16*)(B + HP_QT); LAS bf16* KTT = (LAS bf16*)(B + HP_KTT); LAS bf16* AM = (LAS bf16*)(B + HP_AM); \
        LAS bf16* VT = (LAS bf16*)(B + HS_VT); LAS bf16* STt = (LAS bf16*)(B + HS_ST); \
        _Pragma("unroll") for (int j = 0; j < 6; ++j) *(LAS v4u*)(B + (tid + 512 * j) * 16) = pre[j]; \
        if (tid < VTHR) { const int s_ = tid >> VSH, vq = tid & (VW / 8 - 1); \
            VT[(vq * 8 + 0) * 72 + s_] = (bf16)(vr.x & 0xffffu); VT[(vq * 8 + 1) * 72 + s_] = (bf16)(vr.x >> 16); \
            VT[(vq * 8 + 2) * 72 + s_] = (bf16)(vr.y & 0xffffu); VT[(vq * 8 + 3) * 72 + s_] = (bf16)(vr.y >> 16); \
            VT[(vq * 8 + 4) * 72 + s_] = (bf16)(vr.z & 0xffffu); VT[(vq * 8 + 5) * 72 + s_] = (bf16)(vr.z >> 16); \
            VT[(vq * 8 + 6) * 72 + s_] = (bf16)(vr.w & 0xffffu); VT[(vq * 8 + 7) * 72 + s_] = (bf16)(vr.w >> 16); } \
        f32x4 sp[NVT]; const f32x4 sc_ = erv * eev;     \
        _Pragma("unroll") for (int e = 0; e < NVT; ++e) { sp[e] = accS[e] * sc_; v2u w; w.x = cvt_pk_bf16(sp[e][0], sp[e][1]); w.y = cvt_pk_bf16(sp[e][2], sp[e][3]); \
            *(LAS v2u*)(STt + (e * 16 + c16) * 136 + wave * 16 + quad * 4) = w; } \
        HS_LOAD((c) + 2, pre, vr, erv, eev); \
        __syncthreads(); \
        if ((wave >> 2) < NVT) { const int tt = wave & 3, vt = wave >> 2; f32x4 o = (f32x4){0.f, 0.f, 0.f, 0.f}; \
          o = mma_lds<128>(o, QT + tt * 16 * 136, 136, STt + vt * 16 * 136, 136, lane); \
          o = mma_lds<64>(o, AM + tt * 16 * 72, 72, VT + vt * 16 * 72, 72, lane); \
          _Pragma("unroll") for (int i = 0; i < 4; ++i) { const int tau = (c) * 64 + tt * 16 + quad * 4 + i; odst[(size_t)HG_ROW(tau) * PA_LD + vt * 16 + c16] = (bf16)f2bf(o[i]); } } \
        _Pragma("unroll") for (int e = 0; e < NVT; ++e) { accS[e] = mma_lds<64>(sp[e], KTT + wave * 16 * 72, 72, VT + e * 16 * 72, 72, lane); } \
    } while (0)
    for (int c = 0; c < nchunk; c += 2) {
        HS_STEP(c, 0, preA, vrA, ervA, eevA);
        HS_STEP(c + 1, 1, preB, vrB, ervB, eevB);
    }
    __syncthreads();
#undef HG_ROW
#undef HS_LOAD
#undef HS_STEP
}

__device__ __forceinline__ void na_item(LAS unsigned char* lds, const bf16* PA, const float* rpb, bf16* ONA, int item, int T, int tid) {
    const int lane = tid & 63, h = __builtin_amdgcn_readfirstlane(tid >> 6), c16 = lane & 15, quad = lane >> 4;
    const int ips = T / 16, seq = item / ips, rem = item % ips, r = rem >> 2, j = rem & 3;
    const int rows = T / 64, rs = min(max(r - 4, 0), rows - 8), kstart = (j == 0) ? 0 : (j == 1) ? 8 : (j == 2) ? 24 : 32;
    const int base = seq * T, qtok = base + r * 64 + 16 * j + c16;
    const bf16* qp = PA + (size_t)qtok * PA_LD + C_NQ + h * 64 + quad * 8;
    const bf16x8 Qb0 = *(const bf16x8*)qp, Qb1 = *(const bf16x8*)(qp + 32);
    const int qcol = 16 * j + c16, cs = min(max(qcol - 8, 0), 48);
    v4u vbufA[8], vbufB[8], vbufC[8], vbufD[8];
#define NA_VLOAD(qd, vbuf) do { _Pragma("unroll") for (int it = 0; it < 8; ++it) { const int idx = it * 64 + lane, key = idx >> 3, dg = idx & 7; \
        const int tok = base + (rs + 2 * (qd) + (key >> 5)) * 64 + kstart + (key & 31); vbuf[it] = *(const v4u*)(PA + (size_t)tok * PA_LD + C_NV + h * 64 + dg * 8); } } while (0)
    NA_VLOAD(0, vbufA); NA_VLOAD(1, vbufB);
    const float* rp = rpb + h * 465;
    f32x4 sacc[16]; float mx = -3e38f;
    int dcv[8]; bool okv[8];
#pragma unroll
    for (int e = 0; e < 8; ++e) { const int kcol = kstart + (e >> 2) * 16 + quad * 4 + (e & 3); okv[e] = (kcol >= cs) && (kcol < cs + 16); dcv[e] = min(max(kcol - qcol + 15, 0), 30); }
#pragma unroll
    for (int a = 0; a < 8; ++a) {
        const float rowv = rp[(rs + a - r + 7) * 31 + min(lane, 30)];
        float bv[8];
#pragma unroll
        for (int e = 0; e < 8; ++e) bv[e] = __builtin_bit_cast(float, __builtin_amdgcn_ds_bpermute(dcv[e] << 2, __builtin_bit_cast(int, rowv)));
#pragma unroll
        for (int hh = 0; hh < 2; ++hh) {
            const int ktok = base + (rs + a) * 64 + kstart + hh * 16 + c16;
            const bf16* kp = PA + (size_t)ktok * PA_LD + C_NK + h * 64 + quad * 8;
            const bf16x8 Ka0 = *(const bf16x8*)kp, Ka1 = *(const bf16x8*)(kp + 32);
            f32x4 s = (f32x4){0.f, 0.f, 0.f, 0.f};
            s = __builtin_amdgcn_mfma_f32_16x16x32_bf16(Ka0, Qb0, s, 0, 0, 0);
            s = __builtin_amdgcn_mfma_f32_16x16x32_bf16(Ka1, Qb1, s, 0, 0, 0);
#pragma unroll
            for (int i = 0; i < 4; ++i) { const float val = okv[hh * 4 + i] ? s[i] * 0.125f + bv[hh * 4 + i] : -1e30f; s[i] = val; mx = fmaxf(mx, val); }
            sacc[a * 2 + hh] = s;
        }
    }
    NA_VLOAD(2, vbufC); NA_VLOAD(3, vbufD);
    mx = fmaxf(mx, __shfl_xor(mx, 16)); mx = fmaxf(mx, __shfl_xor(mx, 32));
    float sum = 0.f;
#pragma unroll
    for (int t = 0; t < 16; ++t)
#pragma unroll
        for (int i = 0; i < 4; ++i) { const float p = __expf(sacc[t][i] - mx); sacc[t][i] = p; sum += p; }
    sum += __shfl_xor(sum, 16); sum += __shfl_xor(sum, 32);
    bf16x8 pb[8];
#pragma unroll
    for (int a = 0; a < 8; ++a) { v4u w; w.x = cvt_pk_bf16(sacc[2 * a][0], sacc[2 * a][1]); w.y = cvt_pk_bf16(sacc[2 * a][2], sacc[2 * a][3]);
        w.z = cvt_pk_bf16(sacc[2 * a + 1][0], sacc[2 * a + 1][1]); w.w = cvt_pk_bf16(sacc[2 * a + 1][2], sacc[2 * a + 1][3]); pb[a] = __builtin_bit_cast(bf16x8, w); }
    LAS bf16* VS = (LAS bf16*)(lds + h * 10240);
    f32x4 oacc[4];
#pragma unroll
    for (int dt = 0; dt < 4; ++dt) oacc[dt] = (f32x4){0.f, 0.f, 0.f, 0.f};
    const int trq = (lane & 15) >> 2, trp = lane & 3;
    const LAS bf16* trbase = VS + (quad * 4 + trq) * 80 + 4 * trp;
#define NA_PV(qd, vbuf) do { \
        _Pragma("unroll") for (int it = 0; it < 8; ++it) { const int idx = it * 64 + lane, key = idx >> 3, dg = idx & 7; *(LAS v4u*)(VS + key * 80 + dg * 8) = vbuf[it]; } \
        _Pragma("unroll") for (int al = 0; al < 2; ++al) \
            _Pragma("unroll") for (int dt = 0; dt < 4; ++dt) { const LAS bf16* p = trbase + al * 32 * 80 + dt * 16; \
                const v4i16_t lo = __builtin_amdgcn_ds_read_tr16_b64_v4i16((LAS v4i16_t*)p), hi = __builtin_amdgcn_ds_read_tr16_b64_v4i16((LAS v4i16_t*)(p + 16 * 80)); \
                const bf16x8 af = {lo[0], lo[1], lo[2], lo[3], hi[0], hi[1], hi[2], hi[3]}; \
                oacc[dt] = __builtin_amdgcn_mfma_f32_16x16x32_bf16(af, pb[(qd) * 2 + al], oacc[dt], 0, 0, 0); } } while (0)
    NA_PV(0, vbufA); NA_PV(1, vbufB); NA_PV(2, vbufC); NA_PV(3, vbufD);
#undef NA_PV
#undef NA_VLOAD
    const float inv = __builtin_amdgcn_rcpf(sum);
#pragma unroll
    for (int dt = 0; dt < 4; ++dt) { const f32x4 o = oacc[dt] * inv; v2u w; w.x = cvt_pk_bf16(o[0], o[1]); w.y = cvt_pk_bf16(o[2], o[3]);
        *(v2u*)(ONA + (size_t)qtok * 512 + h * 64 + dt * 16 + quad * 4) = w; }
}

#define XB_TMO      128
#define XB_XCNT(j)  (256  + 64 * (j))
#define XB_XSUB(j)  (1280 + 64 * (j))
#define XB_XGEN(j)  (2304 + 64 * (j))
#define XB_TOP      3328
#define XB_TOPGEN   3392
#define XCD_BAR_WORDS 3456
#define XB_SPIN_CAP (1u << 18)

__device__ __forceinline__ unsigned xb_ld(unsigned* p)              { return __hip_atomic_load(p, __ATOMIC_RELAXED, __HIP_MEMORY_SCOPE_AGENT); }
__device__ __forceinline__ unsigned xb_add(unsigned* p, unsigned v) { return __hip_atomic_fetch_add(p, v, __ATOMIC_RELAXED, __HIP_MEMORY_SCOPE_AGENT); }
__device__ __forceinline__ unsigned xb_xcc_id() { return (unsigned)__builtin_amdgcn_s_getreg((3 << 11) | 20) & 0xFu; }
#define XB_SPIN(cond, bar) do { unsigned _sp = 0; while (cond) { __builtin_amdgcn_s_sleep(1); \
    if ((++_sp & 255u) == 0u) { if (xb_ld(&(bar)[XB_TMO])) break; if (_sp > XB_SPIN_CAP) { atomicAdd(&(bar)[XB_TMO], 1u); break; } } } } while (0)

struct XcdBarrier {
    unsigned* bar; unsigned x;
    volatile LAS unsigned* st;
};

__device__ __forceinline__ XcdBarrier xcd_barrier_post(unsigned* bar, volatile LAS unsigned* st) {
    XcdBarrier b; b.bar = bar; b.x = xb_xcc_id(); b.st = st;
    if (threadIdx.x == 0) (void)xb_add(&bar[XB_XCNT(b.x)], 1u);
    return b;
}
__device__ __forceinline__ void xcd_barrier_complete(unsigned* bar, unsigned x, unsigned& nloc, unsigned& nx) {
    const unsigned G = gridDim.x * gridDim.y * gridDim.z;
    unsigned sum, cnt, mine, sp = 0u;
    for (;;) {
        sum = 0u; cnt = 0u; mine = 0u;
#pragma unroll
        for (unsigned j = 0; j < 16; ++j) { const unsigned c = xb_ld(&bar[XB_XCNT(j)]); sum += c; cnt += (c > 0u) ? 1u : 0u; mine = (j == x) ? c : mine; }
        if (sum == G) break;
        __builtin_amdgcn_s_sleep(1);
        if ((++sp & 255u) == 0u) { if (xb_ld(&bar[XB_TMO])) break; if (sp > XB_SPIN_CAP) { atomicAdd(&bar[XB_TMO], 1u); break; } }
    }
    nloc = mine > 0u ? mine : 1u; nx = cnt > 0u ? cnt : 1u;
}

__device__ __forceinline__ void xcd_barrier(const XcdBarrier& b) {
    asm volatile("s_waitcnt vmcnt(0)" ::: "memory");
    __syncthreads();
    if (threadIdx.x == 0) {
        unsigned* bar = b.bar;
        __builtin_amdgcn_s_waitcnt(0);
        unsigned nloc = b.st[0], nx = b.st[1];
        if (nloc == 0u) { xcd_barrier_complete(bar, b.x, nloc, nx); b.st[0] = nloc; b.st[1] = nx; }
        const unsigned old = xb_add(&bar[XB_XSUB(b.x)], 1u);
        const unsigned gen = old / nloc;
        if (old + 1u == (gen + 1u) * nloc) {
            __builtin_amdgcn_fence(__ATOMIC_RELEASE, "agent");
            asm volatile("s_waitcnt vmcnt(0)" ::: "memory");
            const unsigned og = xb_add(&bar[XB_TOP], 1u);
            const unsigned tg = og / nx;
            if (og + 1u == (tg + 1u) * nx) xb_add(&bar[XB_TOPGEN], 1u);
            else XB_SPIN(xb_ld(&bar[XB_TOPGEN]) == tg, bar);
            __builtin_amdgcn_fence(__ATOMIC_ACQUIRE, "agent");
            xb_add(&bar[XB_XGEN(b.x)], 1u);
            asm volatile("s_waitcnt vmcnt(0)" ::: "memory");
        } else {
            XB_SPIN(xb_ld(&bar[XB_XGEN(b.x)]) == gen, bar);
            __builtin_amdgcn_fence(__ATOMIC_ACQUIRE, "agent");
            asm volatile("s_waitcnt vmcnt(0)" ::: "memory");
        }
    }
    __syncthreads();
}
struct Args { const float* in[20]; float* out; unsigned char* ws; int ph_lo, ph_hi; };
enum { K_CVT = 0, K_G0, K_UP, K_RES, K_M1, K_M2A, K_M2B, K_M3, K_M4, K_GF };

__global__ void __launch_bounds__(NTHR, 2) mk_fwd(Args args) {
    extern __shared__ __attribute__((aligned(16))) unsigned char lds_raw[];
    LAS unsigned char* lds = (LAS unsigned char*)lds_raw;
    cg::grid_group grid = cg::this_grid();
    const int hi = args.ph_hi;
    { volatile LAS unsigned* st0 = (volatile LAS unsigned*)(lds + LDS_MISC + 32); if (threadIdx.x < 2) st0[threadIdx.x] = 0u; __syncthreads(); }
    XcdBarrier xbar = xcd_barrier_post((unsigned*)(args.ws + WS_CTL) + CW_BAR, (volatile LAS unsigned*)(lds + LDS_MISC + 32));
#if TPROBE
    unsigned long long tacc = 0ull;
#endif
    for (int ph = args.ph_lo; ph < hi; ++ph) {
#if TPROBE
        const unsigned long long tp0 = __builtin_amdgcn_s_memrealtime();
#endif
        int bid = blockIdx.x, G = gridDim.x; asm volatile("" : "+s"(bid), "+s"(G));
        int tid = threadIdx.x; asm volatile("" : "+v"(tid));
        const int lane = tid & 63, wave = __builtin_amdgcn_readfirstlane(tid >> 6);
        const int gw = bid * NWAVES + wave, NGW = G * NWAVES;
        int kind, pr = 0, l = 0, s = 0, g2 = 0;
        if (ph == 0) kind = K_CVT;
        else { const int q = ph - 1; pr = q / PH_PER_PAIR; const int r = q % PH_PER_PAIR;
            if (r == 0) kind = K_G0; else if (r == PH_PER_PAIR - 1) kind = K_GF;
            else { l = (r - 1) / 16; s = (r - 1) % 16;
                if (s == 0 || s == 14) kind = K_UP; else if (s == 1 || s == 15) kind = K_RES;
                else { g2 = (s - 2) / 6; const int t = (s - 2) % 6; kind = (t == 0) ? K_M1 : (t == 1) ? K_M2A : (t == 2) ? K_M2B : (t == 3) ? K_M3 : (t == 4) ? K_M4 : K_RES; } } }
        const bool mix = (s >= 2 && s <= 13);
        unsigned char* ws = args.ws;
        bf16* XBp = (bf16*)(ws + WS_XB); float* SSQp = (float*)(ws + WS_SSQ);
        bf16* XB = XBp + (size_t)g2 * TG * D; float* SSQ = SSQp + (size_t)g2 * TG * 16;
        bf16* PA = (bf16*)(ws + WS_PA); bf16* PG = (bf16*)(ws + WS_PG);
        bf16* ONA = (bf16*)(ws + WS_ONA); bf16* OHG = ONA + (size_t)TG * 512; bf16* OCV = OHG + (size_t)TG * 512;
        unsigned char* SCR = ws + WS_SCR;
        const bf16* Wl = (const bf16*)(ws + WS_W) + (size_t)l * LAYER_EL;
        const int T = pr == 0 ? 2048 : 4096;
        const int g = pr * 2 + g2;
        float* X = args.out + (size_t)pr * 2 * TG * D;

        if (kind == K_CVT) {
            LAS float* scr = (LAS float*)(lds + wave * 16384);
            constexpr int I_GU = 16 * 176, I_DN = 44 * 32, I_IN = 16 * 272, I_MX = 8 * 32, I_OUT = 16 * 32;
            constexpr int I_LAYER = 2 * I_GU + 2 * I_DN + I_IN + 3 * I_MX + I_OUT;
            for (int it = gw; it < NLAYER * I_LAYER; it += NGW) {
                const int ll = it / I_LAYER; int r = it % I_LAYER; bf16* Wd = (bf16*)(ws + WS_W) + (size_t)ll * LAYER_EL;
                const float* src; const float* gain = nullptr; int K, N; size_t off; bool perm = false;
                if (r < I_GU) { src = args.in[3] + (size_t)ll * D * 2 * FF; K = D; N = 2 * FF; off = OFF_GU1; gain = args.in[2] + ll * D; perm = true; }
                else if ((r -= I_GU) < I_DN) { src = args.in[4] + (size_t)ll * FF * D; K = FF; N = D; off = OFF_D1; }
                else if ((r -= I_DN) < I_IN) { src = args.in[6] + (size_t)ll * D * 8704; K = D; N = 8704; off = OFF_IN; gain = args.in[5] + ll * D; }
                else if ((r -= I_IN) < I_MX) { src = args.in[9] + (size_t)ll * 512 * D; K = 512; N = D; off = OFF_HG; }
                else if ((r -= I_MX) < I_MX) { src = args.in[12] + (size_t)ll * 512 * D; K = 512; N = D; off = OFF_CV; }
                else if ((r -= I_MX) < I_MX) { src = args.in[14] + (size_t)ll * 512 * D; K = 512; N = D; off = OFF_NA; }
                else if ((r -= I_MX) < I_OUT) { src = args.in[15] + (size_t)ll * D * D; K = D; N = D; off = OFF_OUT; }
                else if ((r -= I_OUT) < I_GU) { src = args.in[17] + (size_t)ll * D * 2 * FF; K = D; N = 2 * FF; off = OFF_GU2; gain = args.in[16] + ll * D; perm = true; }
                else { r -= I_GU; src = args.in[18] + (size_t)ll * FF * D; K = FF; N = D; off = OFF_D2; }
                cvt_item(src, K, N, Wd + off, gain, perm, scr, r, lane);
            }
        } else if (kind == K_G0) {
            const float* xin = pr == 0 ? args.in[0] : args.in[1];
#pragma unroll 2
            for (int row = gw; row < 2 * TG; row += NGW) {
                const f32x4* __restrict__ xr = (const f32x4*)(xin + (size_t)row * D) + lane; v2u* bo = (v2u*)(XBp + (size_t)row * D) + lane;
                float ss = 0.f;
#pragma unroll
                for (int j = 0; j < 4; ++j) { const f32x4 v = xr[64 * j]; v2u w; w.x = cvt_pk_bf16(v[0], v[1]); w.y = cvt_pk_bf16(v[2], v[3]); bo[64 * j] = w; ss += (v[0] * v[0] + v[1] * v[1]) + (v[2] * v[2] + v[3] * v[3]); }
                ss = wave_sum(ss);
                if (lane < 16) SSQp[(size_t)row * 16 + lane] = lane == 0 ? ss : 0.f;
            }
        } else if (kind == K_UP) {
            pg8::Gemm gm{XBp, Wl + (s == 14 ? OFF_GU2 : OFF_GU1), 2 * TG, 2 * FF, D}; pg8::StaticOrder S; S.init(2 * TG, 2 * FF, G, bid);
            pg8::EpiSwiGLU E{PA, SSQp};
#ifndef NO_UP
            for (int rep = 0; rep < REP_GEMM; ++rep) pg8::gemm_phase<pg8::EpiSwiGLU, pg8::StaticOrder, PGA, PGS>(lds, gm, S, E);
#endif
        } else if (kind == K_RES) {
            const int K = mix ? D : FF, Mr = mix ? TG : 2 * TG; const size_t off = mix ? OFF_OUT : (s == 1 ? OFF_D1 : OFF_D2);
            pg8::Gemm gm{PA, Wl + off, Mr, D, K}; pg8::StaticOrder S; S.init(Mr, D, G, bid);
            pg8::EpiRes E{mix ? XB : XBp, mix ? SSQ : SSQp, mix ? 1.0f : 0.5f};
#ifndef NO_RES
            for (int rep = 0; rep < REP_RES; ++rep) { if (rep + 1 < REP_RES) { pg8::EpiRes E0 = E; E0.alpha = 0.f; pg8::gemm_phase<pg8::EpiRes, pg8::StaticOrder, PGA, PGS>(lds, gm, S, E0); }
                else pg8::gemm_phase<pg8::EpiRes, pg8::StaticOrder, PGA, PGS>(lds, gm, S, E); }
#endif
        } else if (kind == K_M1) {
            pg8::Gemm gm{XB, Wl + OFF_IN, TG, 8704, D}; pg8::StaticOrder S; S.init(TG, 8704, G, bid);
            pg8::EpiProj E{PA, (unsigned char*)PG, SSQ};
#ifndef NO_PROJ
            for (int rep = 0; rep < REP_GEMM; ++rep) pg8::gemm_phase<pg8::EpiProj, pg8::StaticOrder, PGA, PGS>(lds, gm, S, E);
#endif
        } else if (kind == K_M2A) {
#ifndef NO_HG
            { const int nP = (TG / 64) * 8;
              for (int rep = 0; rep < REP_HG; ++rep) if (bid < nP) hg_prep_items(lds, PA, SCR, args.in[7], l, bid, G, nP, T, tid); }
#endif
            const float* rpb = args.in[13] + (size_t)l * 8 * 465;
            const int vcu = (G % 8 == 0) ? (bid % 8) * (G / 8) + bid / 8 : bid;
            const int nNA = TG / 16, ipb = (nNA + G - 1) / G;
            for (int rep = 0; rep < REP_NA; ++rep)
                for (int q = 0; q < ipb; ++q) { const int it = vcu * ipb + q; if (it < nNA) {
#ifndef NO_NA
                    na_item(lds, PA, rpb, ONA, it, T, tid);
#endif
                    __syncthreads(); } }
        } else if (kind == K_M2B) {
#ifndef NO_HG
            const int vcu2 = (G % 8 == 0) ? (bid % 8) * (G / 8) + bid / 8 : bid;
            for (int rep = 0; rep < REP_HG; ++rep) {
                if (pr == 0) { for (int it = vcu2; it < 256; it += G) hg_scan_item<2>(lds, PA, SCR, it, T, tid); }
                else       { for (int it = vcu2; it < 256; it += G) hg_scan_item<1>(lds, PA, SCR, it, T, tid); }
            }
#endif
        } else if (kind == K_M3) {
            const float* gno = args.in[8] + l * 512; const float* cw = args.in[10] + l * 3 * 512; const float* cbias = args.in[11] + l * 512;
            const int c0 = lane * 8;
            const bf16* __restrict__ PAr = PA; bf16* __restrict__ OHGr = OHG; bf16* __restrict__ OCVr = OCV;
#pragma unroll 2
            for (int row = gw; row < TG; row += NGW) {
                const bf16* __restrict__ prow = PAr + (size_t)row * PA_LD;
                const v4u fw = *(const v4u*)(prow + C_HQ + c0), bw = *(const v4u*)(prow + C_HZF + c0);
                float o[8] = {bflo(fw.x) + bflo(bw.x), bfhi(fw.x) + bfhi(bw.x), bflo(fw.y) + bflo(bw.y), bfhi(fw.y) + bfhi(bw.y), bflo(fw.z) + bflo(bw.z), bfhi(fw.z) + bfhi(bw.z), bflo(fw.w) + bflo(bw.w), bfhi(fw.w) + bfhi(bw.w)};
                float ss = 0.f;
#pragma unroll
                for (int e = 0; e < 8; ++e) ss += o[e] * o[e];
                ss += __shfl_xor(ss, 1); ss += __shfl_xor(ss, 2); ss += __shfl_xor(ss, 4); ss += __shfl_xor(ss, 8);
                const float rs = __builtin_amdgcn_rsqf(ss * (1.0f / 128.0f) + 1e-6f);
                const v4u hgw = *(const v4u*)(prow + C_HG + c0);
                const float hgv[8] = {bflo(hgw.x), bfhi(hgw.x), bflo(hgw.y), bfhi(hgw.y), bflo(hgw.z), bfhi(hgw.z), bflo(hgw.w), bfhi(hgw.w)};
                const f32x4 gn0 = *(const f32x4*)(gno + c0), gn1 = *(const f32x4*)(gno + c0 + 4);
                const float gn[8] = {gn0[0], gn0[1], gn0[2], gn0[3], gn1[0], gn1[1], gn1[2], gn1[3]};
                float r8[8];
#pragma unroll
                for (int e = 0; e < 8; ++e) r8[e] = o[e] * rs * gn[e] * (hgv[e] * sigm(hgv[e]));
                v4u wo; wo.x = cvt_pk_bf16(r8[0], r8[1]); wo.y = cvt_pk_bf16(r8[2], r8[3]); wo.z = cvt_pk_bf16(r8[4], r8[5]); wo.w = cvt_pk_bf16(r8[6], r8[7]);
                *(v4u*)(OHGr + (size_t)row * 512 + c0) = wo;
                const int tl = row & (T - 1);
                const v4u a1 = *(const v4u*)(prow + C_CA + c0), c1 = *(const v4u*)(prow + C_CC + c0), bb = *(const v4u*)(prow + C_CB + c0);
                v4u a0 = {0u, 0u, 0u, 0u}, cc0 = a0, a2 = a0, cc2 = a0;
                if (tl > 0) { a0 = *(const v4u*)(prow - PA_LD + C_CA + c0); cc0 = *(const v4u*)(prow - PA_LD + C_CC + c0); }
                if (tl < T - 1) { a2 = *(const v4u*)(prow + PA_LD + C_CA + c0); cc2 = *(const v4u*)(prow + PA_LD + C_CC + c0); }
                const float zm[8] = {bflo(a0.x) * bflo(cc0.x), bfhi(a0.x) * bfhi(cc0.x), bflo(a0.y) * bflo(cc0.y), bfhi(a0.y) * bfhi(cc0.y), bflo(a0.z) * bflo(cc0.z), bfhi(a0.z) * bfhi(cc0.z), bflo(a0.w) * bflo(cc0.w), bfhi(a0.w) * bfhi(cc0.w)};
                const float zc[8] = {bflo(a1.x) * bflo(c1.x), bfhi(a1.x) * bfhi(c1.x), bflo(a1.y) * bflo(c1.y), bfhi(a1.y) * bfhi(c1.y), bflo(a1.z) * bflo(c1.z), bfhi(a1.z) * bfhi(c1.z), bflo(a1.w) * bflo(c1.w), bfhi(a1.w) * bfhi(c1.w)};
                const float zp[8] = {bflo(a2.x) * bflo(cc2.x), bfhi(a2.x) * bfhi(cc2.x), bflo(a2.y) * bflo(cc2.y), bfhi(a2.y) * bfhi(cc2.y), bflo(a2.z) * bflo(cc2.z), bfhi(a2.z) * bfhi(cc2.z), bflo(a2.w) * bflo(cc2.w), bfhi(a2.w) * bfhi(cc2.w)};
                const float cbv[8] = {bflo(bb.x), bfhi(bb.x), bflo(bb.y), bfhi(bb.y), bflo(bb.z), bfhi(bb.z), bflo(bb.w), bfhi(bb.w)};
                const f32x4 w00 = *(const f32x4*)(cw + c0), w01 = *(const f32x4*)(cw + c0 + 4), w10 = *(const f32x4*)(cw + 512 + c0), w11 = *(const f32x4*)(cw + 512 + c0 + 4);
                const f32x4 w20 = *(const f32x4*)(cw + 1024 + c0), w21 = *(const f32x4*)(cw + 1024 + c0 + 4), bs0 = *(const f32x4*)(cbias + c0), bs1 = *(const f32x4*)(cbias + c0 + 4);
#pragma unroll
                for (int e = 0; e < 4; ++e) { r8[e] = cbv[e] * (w00[e] * zm[e] + w10[e] * zc[e] + w20[e] * zp[e] + bs0[e]); r8[4 + e] = cbv[4 + e] * (w01[e] * zm[4 + e] + w11[e] * zc[4 + e] + w21[e] * zp[4 + e] + bs1[e]); }
                wo.x = cvt_pk_bf16(r8[0], r8[1]); wo.y = cvt_pk_bf16(r8[2], r8[3]); wo.z = cvt_pk_bf16(r8[4], r8[5]); wo.w = cvt_pk_bf16(r8[6], r8[7]);
                *(v4u*)(OCVr + (size_t)row * 512 + c0) = wo;
            }
        } else if (kind == K_M4) {
            pg8::Gemm gm{ONA, Wl + OFF_HG, 3 * TG, 3 * D, 512}; pg8::MergeOrder S; S.init(TG, D, G, bid);
            pg8::EpiMerge E{(const unsigned char*)PG, PA};
#ifndef NO_MERGE
            for (int rep = 0; rep < REP_MERGE; ++rep) pg8::gemm_phase<pg8::EpiMerge, pg8::MergeOrder, PGA, PGS>(lds, gm, S, E);
#endif
        } else {
            const f32x4* fg = (const f32x4*)args.in[19] + lane;
#pragma unroll 2
            for (int row = gw; row < 2 * TG; row += NGW) {
                const float rs = pg8::row_rs(SSQp, row);
                f32x4* __restrict__ xo = (f32x4*)(X + (size_t)row * D) + lane; const v2u* __restrict__ bi = (const v2u*)(XBp + (size_t)row * D) + lane;
#pragma unroll
                for (int j = 0; j < 4; ++j) { const v2u w = bi[64 * j]; const f32x4 v = {bflo(w.x), bfhi(w.x), bflo(w.y), bfhi(w.y)}; xo[64 * j] = v * fg[64 * j] * rs; }
            }
        }
#if TPROBE
        __syncthreads();
        const unsigned long long tp1 = __builtin_amdgcn_s_memrealtime();
#endif
        if (ph + 1 < hi) { for (int rep = 0; rep < REP_SYNC; ++rep) { if (hi < 0) grid.sync(); else xcd_barrier(xbar);     } }
#if TPROBE
        const unsigned long long tp2 = __builtin_amdgcn_s_memrealtime();
        if (TPROBE == 100) tacc += tp2 - tp1;
        else if (kind == TPROBE - 1) tacc += tp1 - tp0;
#endif
    }
#if TPROBE
    if (blockIdx.x == TPROBE_BLOCK) { const unsigned long long te = __builtin_amdgcn_s_memrealtime(); while (__builtin_amdgcn_s_memrealtime() - te < tacc) __builtin_amdgcn_s_sleep(8); }
#endif
}
constexpr int N_PHASES = 1 + 2 * PH_PER_PAIR;

extern "C" void kernel_launch(void* const* d_in, const int* in_sizes, int n_in, void* d_out, int out_size, void* d_ws, size_t ws_size, hipStream_t stream) {
    static int grid = 0;
    if (grid == 0) {
        if (n_in != 20 || ws_size < WS_END) { fprintf(stderr, "kernel_launch: unexpected n_in %d / ws %zu\n", n_in, ws_size); grid = -1; return; }
        int dev = 0, cus = 0, per_cu = 0;
        hipGetDevice(&dev); hipDeviceGetAttribute(&cus, hipDeviceAttributeMultiprocessorCount, dev);
        hipFuncSetAttribute((const void*)mk_fwd, hipFuncAttributeMaxDynamicSharedMemorySize, LDS_BYTES);
        hipOccupancyMaxActiveBlocksPerMultiprocessor(&per_cu, (const void*)mk_fwd, NTHR, LDS_BYTES);
        if (per_cu < 1) per_cu = 1;
        grid = cus * per_cu;
        (void)hipGetLastError();
    }
    if (grid < 0) return;
    hipMemsetAsync((char*)d_ws + WS_CTL, 0, CTL_BYTES, stream);
    Args a{};
    for (int i = 0; i < 20; ++i) a.in[i] = (const float*)d_in[i];
    a.out = (float*)d_out; a.ws = (unsigned char*)d_ws;
#if ONE_LAUNCH
    a.ph_lo = 0; a.ph_hi = N_PHASES;
    void* kargs[] = {&a};
    hipError_t e = hipLaunchCooperativeKernel((const void*)mk_fwd, dim3(grid), dim3(NTHR), kargs, LDS_BYTES, stream);
    if (e != hipSuccess) fprintf(stderr, "cooperative launch failed: %s (grid %d)\n", hipGetErrorString(e), grid);
#else
    for (int p = 0; p < N_PHASES; ++p) { a.ph_lo = p; a.ph_hi = p + 1; hipLaunchKernelGGL(mk_fwd, dim3(grid), dim3(NTHR), LDS_BYTES, stream, a); }
#endif
}
```

```cpp
#include <hip/hip_runtime.h>
#include <hip/hip_cooperative_groups.h>
#include <cstdio>
#include <cstdint>
namespace cg = cooperative_groups;
#ifndef ONE_LAUNCH
#define ONE_LAUNCH 1
#endif
#ifndef REP_HG
#define REP_HG 1
#endif
#ifndef REP_NA
#define REP_NA 1
#endif
#ifndef REP_SYNC
#define REP_SYNC 1
#endif
#ifndef REP_GEMM
#define REP_GEMM 1
#endif
#ifndef REP_M3
#define REP_M3 1
#endif
#ifndef REP_RES
#define REP_RES 1
#endif
#ifndef REP_MERGE
#define REP_MERGE 1
#endif
#ifndef REP_MISC
#define REP_MISC 1
#endif
#ifndef TPROBE
#define TPROBE 0
#endif
#ifndef TPROBE_BLOCK
#define TPROBE_BLOCK 0
#endif
#ifndef PGA
#define PGA true
#endif
#ifndef PGS
#define PGS true
#endif
namespace pg8 {
#define PG8_LAS __attribute__((address_space(3)))
typedef unsigned short bf16_t;
typedef short bf16x8 __attribute__((ext_vector_type(8)));
typedef float f32x4 __attribute__((ext_vector_type(4)));
typedef unsigned u32x4 __attribute__((ext_vector_type(4)));
constexpr int BM = 256, BK = 64, HALF = 128, HTB = HALF * BK * 2  , STAGE_BYTES = 8 * HTB, NXCD = 8, WGM = 8;

__host__ __device__ __forceinline__ int lds_byte(int r, int c) { const int st = (r >> 4) * 2 + (c >> 5), rr = r & 15, cc = c & 31, ob = rr * 64 + cc * 2; return st * 1024 + (ob ^ (((ob >> 9) & 1) << 5)); }
__host__ __device__ __forceinline__ void stage_rc(int b, int& R, int& C) { const int st = b / 1024, sb = b % 1024, swz = sb ^ (((sb >> 9) & 1) << 5); R = (st >> 1) * 16 + swz / 64; C = (st & 1) * 32 + (swz % 64) / 2; }
__host__ __device__ __forceinline__ int perm32(int rho) { const int n = rho >> 4, i = rho & 15; return 8 * (i >> 2) + 4 * n + (i & 3); }

struct Unit { int pm, pn; };
struct Gemm { const bf16_t* A; const bf16_t* Bt; int M, N, K; };

struct StaticOrder {
    int nM, nN, nwg, G, c;
    __host__ __device__ void init(int M, int N, int G_, int c_) { nM = M / BM; nN = N / BM; nwg = nM * nN; G = G_; c = c_; }
    __host__ __device__ bool next(int i, Unit& u) const {
        const long L = (long)i * G + c; if (L >= nwg) return false;
        int wgid = (int)L; { const int q = nwg / NXCD, r = nwg % NXCD, xcd = wgid % NXCD, off = wgid / NXCD; wgid = (xcd < r ? xcd * (q + 1) : r * (q + 1) + (xcd - r) * q) + off; }
        const int nig = WGM * nN, gid = wgid / nig, fm = gid * WGM, gsz = (nM - fm) < WGM ? (nM - fm) : WGM;
        u.pm = fm + ((wgid % nig) % gsz); u.pn = (wgid % nig) / gsz; return true;
    }
    __device__ __forceinline__ void a_ready(const Unit&) const {}
    __device__ __forceinline__ void done(const Unit&) const {}
};

__device__ __forceinline__ unsigned cvt_pk_bf16(float lo, float hi) { unsigned r; asm volatile("v_cvt_pk_bf16_f32 %0, %1, %2" : "=v"(r) : "v"(lo), "v"(hi)); return r; }
__device__ __forceinline__ float row_rs(const float* ssq, int row) {
    const f32x4* p = (const f32x4*)(ssq + (size_t)row * 16);
    const f32x4 a = p[0], b = p[1], c = p[2], d = p[3];
    const float s = (((a[0] + a[1]) + (a[2] + a[3])) + ((b[0] + b[1]) + (b[2] + b[3]))) + (((c[0] + c[1]) + (c[2] + c[3])) + ((d[0] + d[1]) + (d[2] + d[3])));
    return __builtin_amdgcn_rsqf(s * (1.0f / 1024.0f) + 1e-6f);
}
__device__ __forceinline__ void row_rs8(const float* ssq, int row0, float (&rsv)[8]) {
#pragma unroll
    for (int ai = 0; ai < 2; ++ai) {
        f32x4 p[4][4];
#pragma unroll
        for (int m = 0; m < 4; ++m) { const f32x4* q = (const f32x4*)(ssq + (size_t)(row0 + ai * HALF + m * 16) * 16);
#pragma unroll
            for (int j = 0; j < 4; ++j) p[m][j] = q[j]; }
#pragma unroll
        for (int m = 0; m < 4; ++m) { float t = 0.f;
#pragma unroll
            for (int j = 0; j < 4; ++j) t += (p[m][j][0] + p[m][j][1]) + (p[m][j][2] + p[m][j][3]);
            rsv[ai * 4 + m] = __builtin_amdgcn_rsqf(t * (1.0f / 1024.0f) + 1e-6f); }
    }
}
__device__ __forceinline__ float sigm(float v) { return __builtin_amdgcn_rcpf(1.0f + __expf(-v)); }

struct EpiSwiGLU {
    static constexpr bool PERM = true, AFTER_DRAIN = false;
    bf16_t* H; const float* ssq;
    __device__ __forceinline__ void operator()(const f32x4 (&acc)[2][2][4][2], const Unit& u, int wr, int wc, int fr, int fq) const {
        const int row0 = u.pm * BM + wr * 64 + fr, col0 = u.pn * 128 + wc * 32 + 8 * fq;
        float rsv[8]; row_rs8(ssq, row0, rsv);
#pragma unroll
        for (int ai = 0; ai < 2; ++ai)
#pragma unroll
            for (int m = 0; m < 4; ++m) {
                const int row = row0 + ai * HALF + m * 16; const float rs = rsv[ai * 4 + m];
                u32x4 w;
#pragma unroll
                for (int n = 0; n < 2; ++n) {
                    const f32x4 a = acc[ai][0][m][n] * rs, b = acc[ai][1][m][n] * rs; f32x4 h;
#pragma unroll
                    for (int e = 0; e < 4; ++e) h[e] = a[e] * sigm(a[e]) * b[e];
                    w[2 * n] = cvt_pk_bf16(h[0], h[1]); w[2 * n + 1] = cvt_pk_bf16(h[2], h[3]);
                }
                *(u32x4*)(H + (size_t)row * 2816 + col0) = w;
            }
    }
};
__device__ __forceinline__ void unpack8(const u32x4 w, f32x4& lo, f32x4& hi) {
    lo[0] = __uint_as_float(w.x << 16); lo[1] = __uint_as_float(w.x & 0xffff0000u); lo[2] = __uint_as_float(w.y << 16); lo[3] = __uint_as_float(w.y & 0xffff0000u);
    hi[0] = __uint_as_float(w.z << 16); hi[1] = __uint_as_float(w.z & 0xffff0000u); hi[2] = __uint_as_float(w.w << 16); hi[3] = __uint_as_float(w.w & 0xffff0000u);
}
struct EpiRes {
    static constexpr bool PERM = true, AFTER_DRAIN = false;
    bf16_t* XB; float* ssq; float alpha;
    __device__ __forceinline__ void operator()(const f32x4 (&acc)[2][2][4][2], const Unit& u, int wr, int wc, int fr, int fq) const {
        const int row0 = u.pm * BM + wr * 64 + fr, col0 = u.pn * BM + wc * 32 + 8 * fq;
#pragma unroll
        for (int ai = 0; ai < 2; ++ai) {
            u32x4 xin[4][2];
#pragma unroll
            for (int m = 0; m < 4; ++m)
#pragma unroll
                for (int bj = 0; bj < 2; ++bj) xin[m][bj] = *(const u32x4*)(XB + (size_t)(row0 + ai * HALF + m * 16) * 1024 + col0 + bj * HALF);
#pragma unroll
            for (int m = 0; m < 4; ++m) {
                const int row = row0 + ai * HALF + m * 16; float ss = 0.f;
#pragma unroll
                for (int bj = 0; bj < 2; ++bj) {
                    bf16_t* xp = XB + (size_t)row * 1024 + col0 + bj * HALF;
                    f32x4 x0, x1; unpack8(xin[m][bj], x0, x1);
                    x0 = x0 + acc[ai][bj][m][0] * alpha; x1 = x1 + acc[ai][bj][m][1] * alpha;
                    u32x4 w; w.x = cvt_pk_bf16(x0[0], x0[1]); w.y = cvt_pk_bf16(x0[2], x0[3]); w.z = cvt_pk_bf16(x1[0], x1[1]); w.w = cvt_pk_bf16(x1[2], x1[3]);
                    *(u32x4*)xp = w;
                    ss += ((x0[0] * x0[0] + x0[1] * x0[1]) + (x0[2] * x0[2] + x0[3] * x0[3])) + ((x1[0] * x1[0] + x1[1] * x1[1]) + (x1[2] * x1[2] + x1[3] * x1[3]));
                }
                ss += __shfl_xor(ss, 16); ss += __shfl_xor(ss, 32);
                if (fq == 0) ssq[(size_t)row * 16 + u.pn * 4 + wc] = ss;
            }
            asm volatile("" ::: "memory");
        }
    }
};
struct M1Order {
    StaticOrder so; int second, G, c;
    __device__ void init(int G_, int c_, int second_) { second = second_; G = G_; c = c_; so.init(16384, second_ ? 8192 : 8704, G_, c_); }
    __device__ bool next(int i, Unit& u) const {
        if (!second) { if (so.next(i, u)) return true;
            const long L = (long)i * G + c - 2176; if (L < 0 || L >= 128) return false; u.pm = 64 + (int)(L >> 1); u.pn = 22 + (int)(L & 1); return true; }
        Unit b; if (!so.next(i, b)) return false; u.pm = b.pm + 64; u.pn = b.pn < 22 ? b.pn : b.pn + 2; return true;
    }
    __device__ __forceinline__ void a_ready(const Unit&) const {}
    __device__ __forceinline__ void done(const Unit&) const {}
};
struct EpiProj {
    static constexpr bool PERM = true, AFTER_DRAIN = false;
    bf16_t* PA; unsigned char* PGa; unsigned char* PGb; const float* ssq;
    __device__ __forceinline__ void operator()(const f32x4 (&acc)[2][2][4][2], const Unit& u, int wr, int wc, int fr, int fq) const {
        unsigned char* PG8 = u.pm < 64 ? PGa : PGb;
        const int prow0 = u.pm * BM + wr * 64 + fr, row0 = prow0 & 16383;
        float rsv[8]; row_rs8(ssq, prow0, rsv);
        if (u.pn < 22) {
            const int col0 = u.pn * BM + wc * 32 + 8 * fq;
#pragma unroll
            for (int ai = 0; ai < 2; ++ai)
#pragma unroll
                for (int m = 0; m < 4; ++m) {
                    const int row = row0 + ai * HALF + m * 16; const float rs = rsv[ai * 4 + m];
#pragma unroll
                    for (int bj = 0; bj < 2; ++bj) {
                        const f32x4 v0 = acc[ai][bj][m][0] * rs, v1 = acc[ai][bj][m][1] * rs;
                        u32x4 w; w.x = cvt_pk_bf16(v0[0], v0[1]); w.y = cvt_pk_bf16(v0[2], v0[3]); w.z = cvt_pk_bf16(v1[0], v1[1]); w.w = cvt_pk_bf16(v1[2], v1[3]);
                        *(u32x4*)(PA + (size_t)row * 5632 + col0 + bj * HALF) = w;
                    }
                }
        } else {
            const int col0 = (u.pn - 22) * BM + wc * 32 + 8 * fq;
#pragma unroll
            for (int ai = 0; ai < 2; ++ai)
#pragma unroll
                for (int m = 0; m < 4; ++m) {
                    const int row = row0 + ai * HALF + m * 16; const float rs = rsv[ai * 4 + m];
#pragma unroll
                    for (int bj = 0; bj < 2; ++bj) {
                        unsigned q[8];
#pragma unroll
                        for (int e = 0; e < 4; ++e) { q[e] = (unsigned)(sigm(acc[ai][bj][m][0][e] * rs) * 255.0f + 0.5f); q[4 + e] = (unsigned)(sigm(acc[ai][bj][m][1][e] * rs) * 255.0f + 0.5f); }
                        typedef unsigned u32x2_ __attribute__((ext_vector_type(2)));
                        u32x2_ w; w.x = q[0] | (q[1] << 8) | (q[2] << 16) | (q[3] << 24); w.y = q[4] | (q[5] << 8) | (q[6] << 16) | (q[7] << 24);
                        *(u32x2_*)(PG8 + (size_t)row * 3072 + col0 + bj * HALF) = w;
                    }
                }
        }
    }
};
struct MergeOrder {
    StaticOrder so;
    __device__ void init(int M, int N, int G_, int c_) { so.init(M, N, G_, c_); }
    __device__ bool next(int i, Unit& u) const { Unit b; if (!so.next(i / 3, b)) return false; const int m = i % 3, w = (m == 0) ? 2 : m - 1; u.pm = b.pm + 64 * m; u.pn = b.pn + 4 * w; return true; }
    __device__ __forceinline__ void a_ready(const Unit&) const {}
    __device__ __forceinline__ void done(const Unit&) const {}
};
struct EpiMerge {
    static constexpr bool PERM = true, AFTER_DRAIN = false;
    const unsigned char* PG8; bf16_t* MB;
    __device__ __forceinline__ void operator()(const f32x4 (&acc)[2][2][4][2], const Unit& u, int wr, int wc, int fr, int fq) const {
        typedef unsigned u32x2_ __attribute__((ext_vector_type(2)));
        const int m_ = u.pm >> 6, pm = u.pm & 63, w_ = u.pn >> 2, pn = u.pn & 3;
        const int row0 = pm * BM + wr * 64 + fr, col0 = pn * BM + wc * 32 + 8 * fq;
#pragma unroll
        for (int ai = 0; ai < 2; ++ai) {
            u32x2_ gin[4][2]; u32x4 pin[4][2];
#pragma unroll
            for (int m = 0; m < 4; ++m)
#pragma unroll
                for (int bj = 0; bj < 2; ++bj) { const int row = row0 + ai * HALF + m * 16, col = col0 + bj * HALF;
                    gin[m][bj] = *(const u32x2_*)(PG8 + (size_t)row * 3072 + w_ * 1024 + col);
                    pin[m][bj] = (m_ > 0) ? *(const u32x4*)(MB + (size_t)row * 1024 + col) : (u32x4){0u, 0u, 0u, 0u}; }
#pragma unroll
            for (int m = 0; m < 4; ++m)
#pragma unroll
                for (int bj = 0; bj < 2; ++bj) { const int row = row0 + ai * HALF + m * 16, col = col0 + bj * HALF;
                    f32x4 g0, g1, p0, p1; unpack8(pin[m][bj], p0, p1);
                    { const unsigned a = gin[m][bj].x, b = gin[m][bj].y; const float k = 1.0f / 255.0f;
                      g0[0] = (float)(a & 255u) * k; g0[1] = (float)((a >> 8) & 255u) * k; g0[2] = (float)((a >> 16) & 255u) * k; g0[3] = (float)(a >> 24) * k;
                      g1[0] = (float)(b & 255u) * k; g1[1] = (float)((b >> 8) & 255u) * k; g1[2] = (float)((b >> 16) & 255u) * k; g1[3] = (float)(b >> 24) * k; }
                    f32x4 t0, t1;
#pragma unroll
                    for (int e = 0; e < 4; ++e) { t0[e] = g0[e] * acc[ai][bj][m][0][e] + p0[e]; t1[e] = g1[e] * acc[ai][bj][m][1][e] + p1[e]; }
                    u32x4 w; w.x = cvt_pk_bf16(t0[0], t0[1]); w.y = cvt_pk_bf16(t0[2], t0[3]); w.z = cvt_pk_bf16(t1[0], t1[1]); w.w = cvt_pk_bf16(t1[2], t1[3]);
                    *(u32x4*)(MB + (size_t)row * 1024 + col) = w; }
            asm volatile("" ::: "memory");
        }
    }
};
template <class Epi, class Sched, bool ALIGN_EPI = false, bool SP2 = false>
__device__ __forceinline__ void gemm_phase(PG8_LAS unsigned char* lds, const Gemm g, const Sched& S, const Epi& E) {
    int tid = threadIdx.x; asm volatile("" : "+v"(tid));
    const int wid = __builtin_amdgcn_readfirstlane(tid >> 6), lane = tid & 63, wr = wid >> 2, wc = wid & 3, fr = lane & 15, fq = lane >> 4;
    const int K = g.K, nt = K / BK;
    unsigned voffA[2], voffB[2];
#pragma unroll
    for (int i = 0; i < 2; ++i) { int R, C; stage_rc(tid * 16 + i * 8192, R, C); const int Rb = Epi::PERM ? ((R & ~31) + perm32(R & 31)) : R;
        voffA[i] = (unsigned)(R * K + C) * 2u; voffB[i] = (unsigned)(Rb * K + C) * 2u; }
    const size_t kstep = (size_t)(BK * 2);
    const size_t hstep = (size_t)HALF * K * 2;
    const size_t tstep = 2 * hstep;
    const unsigned ldsw = (unsigned)wid * 1024u;
    const int aoff = lds_byte(wr * 64 + fr, fq * 8), boff = lds_byte(wc * 32 + fr, fq * 8);
#define PG8_SA(b, h) (((b) * 2 + (h)) * HTB)
#define PG8_SB(b, h) ((4 + (b) * 2 + (h)) * HTB)
#define PG8_STAGE(bufoff, gbase, voff) do { _Pragma("unroll") for (int _i = 0; _i < 2; ++_i) \
        __builtin_amdgcn_global_load_lds((const unsigned*)((const char*)(gbase) + (voff)[_i]), (PG8_LAS unsigned*)(lds + (bufoff) + ldsw + _i * 8192), 16, 0, 0); } while (0)
#define PG8_LDA(dst, b, h) do { _Pragma("unroll") for (int m = 0; m < 4; ++m) _Pragma("unroll") for (int k = 0; k < 2; ++k) dst[m][k] = *(const PG8_LAS bf16x8*)(lds + PG8_SA(b, h) + aoff + m * 2048 + k * 1024); } while (0)
#define PG8_LDB(dst, b, h) do { _Pragma("unroll") for (int n = 0; n < 2; ++n) _Pragma("unroll") for (int k = 0; k < 2; ++k) dst[n][k] = *(const PG8_LAS bf16x8*)(lds + PG8_SB(b, h) + boff + n * 2048 + k * 1024); } while (0)
#define PG8_MMA(ai, bj, At, Bt) do { __builtin_amdgcn_s_setprio(1); _Pragma("unroll") for (int m = 0; m < 4; ++m) _Pragma("unroll") for (int n = 0; n < 2; ++n) _Pragma("unroll") for (int k = 0; k < 2; ++k) \
        acc[ai][bj][m][n] = __builtin_amdgcn_mfma_f32_16x16x32_bf16(Bt[n][k], At[m][k], acc[ai][bj][m][n], 0, 0, 0); __builtin_amdgcn_s_setprio(0); } while (0)
#define PG8_WAIT_V(n) asm volatile("s_waitcnt vmcnt(" #n ")" ::: "memory")
#define PG8_WAIT_L(n) asm volatile("s_waitcnt lgkmcnt(" #n ")" ::: "memory")
#define PG8_BAR __builtin_amdgcn_s_barrier()
#define PG8_SCHED __builtin_amdgcn_sched_barrier(0)
    Unit cur, nxt; int ui = 0;
    if (!S.next(0, cur)) return;
    f32x4 acc[2][2][4][2];
#pragma unroll
    for (int a = 0; a < 2; ++a)
#pragma unroll
        for (int b = 0; b < 2; ++b)
#pragma unroll
            for (int m = 0; m < 4; ++m)
#pragma unroll
                for (int n = 0; n < 2; ++n) acc[a][b][m][n] = (f32x4){0.f, 0.f, 0.f, 0.f};
    bf16x8 At[4][2], B0[2][2], B1[2][2];
    const char* cA = (const char*)g.A + (size_t)cur.pm * tstep; const char* cB = (const char*)g.Bt + (size_t)cur.pn * tstep;
    S.a_ready(cur);
    if constexpr (SP2) {
        PG8_STAGE(PG8_SB(0, 0), cB, voffB); PG8_STAGE(PG8_SB(0, 1), cB + hstep, voffB); PG8_STAGE(PG8_SA(0, 0), cA, voffA); PG8_STAGE(PG8_SA(0, 1), cA + hstep, voffA);
        if (wr == 1) PG8_BAR;
        PG8_WAIT_V(2); PG8_BAR;
        PG8_STAGE(PG8_SB(1, 0), cB + kstep, voffB); PG8_STAGE(PG8_SA(1, 0), cA + kstep, voffA); PG8_STAGE(PG8_SB(1, 1), cB + hstep + kstep, voffB);
        PG8_WAIT_V(6); PG8_BAR;
    } else {
        PG8_STAGE(PG8_SB(0, 0), cB, voffB); PG8_STAGE(PG8_SA(0, 0), cA, voffA); PG8_STAGE(PG8_SB(0, 1), cB + hstep, voffB); PG8_STAGE(PG8_SA(0, 1), cA + hstep, voffA);
        if (wr == 1) PG8_BAR;
        PG8_WAIT_V(4); PG8_BAR;
        PG8_STAGE(PG8_SB(1, 0), cB + kstep, voffB); PG8_STAGE(PG8_SA(1, 0), cA + kstep, voffA); PG8_STAGE(PG8_SB(1, 1), cB + hstep + kstep, voffB);
        PG8_WAIT_V(6); PG8_BAR;
    }
    for (;;) {
        const bool has_next = S.next(ui + 1, nxt);
        const char* nA = has_next ? (const char*)g.A + (size_t)nxt.pm * tstep : cA; const char* nB = has_next ? (const char*)g.Bt + (size_t)nxt.pn * tstep : cB;
        for (int t = 0; t < nt; t += 2) {
            const bool last = (t == nt - 2);
            const char* a1 = cA + (size_t)(t + 1) * kstep;
            const char* a2 = last ? nA : cA + (size_t)(t + 2) * kstep; const char* b2 = last ? nB : cB + (size_t)(t + 2) * kstep;
            const char* a3 = a2 + kstep; const char* b3 = b2 + kstep;
            if (last && has_next) S.a_ready(nxt);
            if constexpr (SP2) {
            PG8_LDB(B0, 0, 0); PG8_LDB(B1, 0, 1); PG8_SCHED; PG8_LDA(At, 0, 0); PG8_STAGE(PG8_SA(1, 1), a1 + hstep, voffA);
            PG8_WAIT_V(8); PG8_WAIT_L(0); PG8_BAR; PG8_MMA(0, 0, At, B0); PG8_MMA(0, 1, At, B1); PG8_BAR; PG8_SCHED;
            PG8_LDA(At, 0, 1); PG8_STAGE(PG8_SB(0, 0), b2, voffB); PG8_STAGE(PG8_SB(0, 1), b2 + hstep, voffB); PG8_STAGE(PG8_SA(0, 0), a2, voffA);
            PG8_WAIT_V(8); PG8_WAIT_L(0); PG8_BAR; PG8_MMA(1, 0, At, B0); PG8_MMA(1, 1, At, B1); PG8_BAR; PG8_SCHED;
            PG8_LDB(B0, 1, 0); PG8_LDB(B1, 1, 1); PG8_SCHED; PG8_LDA(At, 1, 0); PG8_STAGE(PG8_SA(0, 1), a2 + hstep, voffA);
            PG8_WAIT_V(8); PG8_WAIT_L(0); PG8_BAR; PG8_MMA(0, 0, At, B0); PG8_MMA(0, 1, At, B1); PG8_BAR; PG8_SCHED;
            PG8_LDA(At, 1, 1); PG8_STAGE(PG8_SB(1, 0), b3, voffB); PG8_STAGE(PG8_SB(1, 1), b3 + hstep, voffB); PG8_STAGE(PG8_SA(1, 0), a3, voffA);
            PG8_WAIT_V(8); PG8_WAIT_L(0); PG8_BAR; PG8_MMA(1, 0, At, B0); PG8_MMA(1, 1, At, B1); PG8_BAR; PG8_SCHED;
            } else {
            PG8_LDB(B0, 0, 0); PG8_SCHED; PG8_LDA(At, 0, 0); PG8_STAGE(PG8_SA(1, 1), a1 + hstep, voffA);
            PG8_WAIT_L(8); PG8_BAR; PG8_WAIT_L(0); PG8_MMA(0, 0, At, B0); PG8_BAR; PG8_SCHED;
            PG8_LDB(B1, 0, 1); PG8_STAGE(PG8_SB(0, 0), b2, voffB);
            PG8_BAR; PG8_WAIT_L(0); PG8_MMA(0, 1, At, B1); PG8_BAR;
            PG8_LDA(At, 0, 1); PG8_STAGE(PG8_SA(0, 0), a2, voffA);
            PG8_BAR; PG8_WAIT_L(0); PG8_MMA(1, 0, At, B0); PG8_BAR; PG8_SCHED;
            PG8_STAGE(PG8_SB(0, 1), b2 + hstep, voffB);
            PG8_WAIT_V(6); PG8_BAR; PG8_MMA(1, 1, At, B1); PG8_BAR;
            PG8_LDB(B0, 1, 0); PG8_SCHED; PG8_LDA(At, 1, 0); PG8_STAGE(PG8_SA(0, 1), a2 + hstep, voffA);
            PG8_WAIT_L(8); PG8_BAR; PG8_WAIT_L(0); PG8_MMA(0, 0, At, B0); PG8_BAR; PG8_SCHED;
            PG8_LDB(B1, 1, 1); PG8_STAGE(PG8_SB(1, 0), b3, voffB);
            PG8_BAR; PG8_WAIT_L(0); PG8_MMA(0, 1, At, B1); PG8_BAR;
            PG8_LDA(At, 1, 1); PG8_STAGE(PG8_SA(1, 0), a3, voffA);
            PG8_BAR; PG8_WAIT_L(0); PG8_MMA(1, 0, At, B0); PG8_BAR; PG8_SCHED;
            PG8_STAGE(PG8_SB(1, 1), b3 + hstep, voffB);
            PG8_WAIT_V(6); PG8_BAR; PG8_MMA(1, 1, At, B1); PG8_BAR;
            }
        }
        if constexpr (ALIGN_EPI) { if (wr == 0) PG8_BAR; }
        if constexpr (!Epi::AFTER_DRAIN) { E(acc, cur, wr, wc, fr, fq); S.done(cur); }
        if (!has_next) break;
#pragma unroll
        for (int a = 0; a < 2; ++a)
#pragma unroll
            for (int b = 0; b < 2; ++b)
#pragma unroll
                for (int m = 0; m < 4; ++m)
#pragma unroll
                    for (int n = 0; n < 2; ++n) acc[a][b][m][n] = (f32x4){0.f, 0.f, 0.f, 0.f};
        cur = nxt; cA = nA; cB = nB; ++ui;
        if constexpr (ALIGN_EPI) { if (wr == 1) PG8_BAR; }
    }
    PG8_WAIT_V(0);
    if constexpr (!ALIGN_EPI) { if (wr == 0) PG8_BAR; }
    PG8_BAR;
    if constexpr (Epi::AFTER_DRAIN) { E.fused(acc, cur, wr, wc, fr, fq, lds, wid, lane); S.done(cur); }
#undef PG8_SA
#undef PG8_SB
#undef PG8_STAGE
#undef PG8_LDA
#undef PG8_LDB
#undef PG8_MMA
#undef PG8_WAIT_V
#undef PG8_WAIT_L
#undef PG8_BAR
#undef PG8_SCHED
}
}
#define LAS __attribute__((address_space(3)))
typedef unsigned short bf16;
typedef unsigned v4u __attribute__((ext_vector_type(4)));
typedef unsigned v2u __attribute__((ext_vector_type(2)));
typedef short v4i16_t __attribute__((ext_vector_type(4)));
using pg8::f32x4; using pg8::bf16x8; using pg8::cvt_pk_bf16;

constexpr int D = 1024, FF = 2816, NLAYER = 4, TG = 16384, NGROUP = 4, NTHR = 512, NWAVES = 8;
constexpr int PA_LD = 5632, PG_LD = 3072;
constexpr int C_HQ = 0, C_HI = 512, C_HZF = 1024, C_HZB = 1536, C_HG = 2048, C_CA = 2560, C_CB = 3072, C_CC = 3584, C_NQ = 4096, C_NK = 4608, C_NV = 5120;
constexpr size_t MiB = 1u << 20;
constexpr size_t WS_CTL = 0, CTL_BYTES = 1 * MiB, WS_W = 1 * MiB, WS_XB = 221 * MiB, WS_SSQ = 285 * MiB, WS_PA = 287 * MiB, WS_PG = 463 * MiB, WS_ONA = 559 * MiB, WS_SCR = 575 * MiB, WS_END = 671 * MiB;
constexpr size_t OFF_GU1 = 0, OFF_D1 = 5767168, OFF_IN = 8650752, OFF_HG = 17563648, OFF_CV = 18087936, OFF_NA = 18612224, OFF_OUT = 19136512, OFF_GU2 = 20185088, OFF_D2 = 25952256, LAYER_EL = 28835840;
constexpr int LDS_BYTES = 147456, LDS_MISC = 147456 - 64;
constexpr int PH_PER_PAIR = 1 + NLAYER * 16 + 1;
constexpr int CW_BAR = 4096;

__device__ __forceinline__ unsigned f2bf(float f) { unsigned u = __float_as_uint(f); return (u + 0x7fffu + ((u >> 16) & 1u)) >> 16; }
__device__ __forceinline__ float bf2f(unsigned b) { return __uint_as_float(b << 16); }
__device__ __forceinline__ float bflo(unsigned w) { return __uint_as_float(w << 16); }
__device__ __forceinline__ float bfhi(unsigned w) { return __uint_as_float(w & 0xffff0000u); }
__device__ __forceinline__ float sigm(float v) { return __builtin_amdgcn_rcpf(1.0f + __expf(-v)); }
__device__ __forceinline__ float wave_sum(float v) {
#pragma unroll
    for (int o = 1; o < 64; o <<= 1) v += __shfl_xor(v, o);
    return v;
}

__device__ __forceinline__ void cvt_item(const float* W, int K, int N, bf16* WT, const float* gain, bool permgu, LAS float* scr, int item, int lane) {
    const int nblk = N / 32, kb = item / nblk, nb = item % nblk, k0 = 64 * kb, n0 = 32 * nb;
#pragma unroll
    for (int i = 0; i < 32; ++i) { const int kk = 2 * i + (lane >> 5); const float g = gain ? gain[k0 + kk] : 1.0f; scr[kk * 33 + (lane & 31)] = W[(size_t)(k0 + kk) * N + n0 + (lane & 31)] * g; }
    asm volatile("s_waitcnt lgkmcnt(0)" ::: "memory");
    int dn0 = n0;
    if (permgu) { const int half = n0 >= FF ? 1 : 0; const int j = n0 - half * FF; dn0 = (j >> 7) * 256 + half * 128 + (j & 127); }
    const int c = lane & 7;
#pragma unroll
    for (int j = 0; j < 4; ++j) { const int n = (lane >> 3) + 8 * j; const LAS float* s = scr + (8 * c) * 33 + n;
        v4u o; o.x = cvt_pk_bf16(s[0 * 33], s[1 * 33]); o.y = cvt_pk_bf16(s[2 * 33], s[3 * 33]); o.z = cvt_pk_bf16(s[4 * 33], s[5 * 33]); o.w = cvt_pk_bf16(s[6 * 33], s[7 * 33]);
        *(v4u*)(WT + (size_t)(dn0 + n) * K + k0 + 8 * c) = o; }
    asm volatile("s_waitcnt lgkmcnt(0)" ::: "memory");
}

template <int K> __device__ __forceinline__ f32x4 mma_lds(f32x4 acc, const LAS bf16* A, int pa, const LAS bf16* B, int pb, int lane) {
    const int r = lane & 15, q = lane >> 4;
#pragma unroll
    for (int ks = 0; ks < K / 32; ++ks) {
        const bf16x8 a = *(const LAS bf16x8*)(A + r * pa + ks * 32 + q * 8);
        const bf16x8 b = *(const LAS bf16x8*)(B + r * pb + ks * 32 + q * 8);
        acc = __builtin_amdgcn_mfma_f32_16x16x32_bf16(a, b, acc, 0, 0, 0);
    }
    return acc;
}

constexpr int HP_QT = 0, HP_KTT = 17408, HP_AM = 35840, HP_ER = 45056, HP_EE = 45568, HP_BLK = 49152;
constexpr int HP_KT = 49152, HP_SEG = 66560;
constexpr int HS_VT = 49152, HS_ST = 53760, HS_BUF = 62464;
__device__ __forceinline__ void hg_prep_items(LAS unsigned char* lds, const bf16* PA, unsigned char* SCR, const float* lb_logits, int layer, int item0, int istride, int nitems, int T, int tid) {
    const int lane = tid & 63, wave = __builtin_amdgcn_readfirstlane(tid >> 6), c16 = lane & 15, quad = lane >> 4;
    const int nchunk = T / 64;
    const int k = tid & 127, tq = tid >> 7;
    LAS bf16* QT = (LAS bf16*)(lds + HP_QT); LAS bf16* KT = (LAS bf16*)(lds + HP_KT); LAS bf16* KTT = (LAS bf16*)(lds + HP_KTT); LAS bf16* AM = (LAS bf16*)(lds + HP_AM);
    LAS float* SEG = (LAS float*)(lds + HP_SEG); LAS float* ER = (LAS float*)(lds + HP_ER); LAS float* EE = (LAS float*)(lds + HP_EE);
    unsigned short zr[16], qr[16];
#define HP_LOAD(it) do { const int it_ = min((it), nitems - 1); const int c_ = it_ % nchunk, sd_ = it_ / nchunk, dir_ = sd_ & 1, h_ = (sd_ >> 1) & 3, base_ = (sd_ >> 3) * T; \
        const bf16* zs = PA + (dir_ ? C_HZB : C_HZF) + h_ * 128 + k; const bf16* qs = PA + C_HQ + h_ * 128 + k; \
        _Pragma("unroll") for (int i = 0; i < 16; ++i) { const int tau = c_ * 64 + 16 * tq + i; const size_t ro = (size_t)(base_ + (dir_ ? (T - 1 - tau) : tau)) * PA_LD; zr[i] = zs[ro]; qr[i] = qs[ro]; } } while (0)
    HP_LOAD(item0);
    for (int item = item0; item < nitems; item += istride) {
        const int sd = item / nchunk, dir = sd & 1, h = (sd >> 1) & 3;
        float lb;
        { float lg[4], mx = -3e38f;
#pragma unroll
          for (int l = 0; l < 4; ++l) { lg[l] = lb_logits[(dir * 4 + l) * 512 + h * 128 + k]; mx = fmaxf(mx, lg[l]); }
          float tot = 0.f, num = 0.f;
#pragma unroll
          for (int l = 0; l < 4; ++l) { const float e = __expf(lg[l] - mx); tot += e; if (l >= 1 && l <= layer) num += e; }
          lb = num / tot; }
        const float oml = 1.0f - lb;
        float b[16], kv[16], qv[16]; float cum = 0.f;
#pragma unroll
        for (int i = 0; i < 16; ++i) { const float zf = bf2f(zr[i]); const float sg = sigm(zf); const float f = lb + oml * sg; cum += __logf(fmaxf(f, 1e-30f)); b[i] = cum; kv[i] = oml * (1.0f - sg); qv[i] = bf2f(qr[i]); }
        HP_LOAD(item + istride);
        SEG[tq * 128 + k] = cum;
        __syncthreads();
        const float s0 = SEG[k], s1 = SEG[128 + k], s2 = SEG[256 + k], s3 = SEG[384 + k];
        const float pre = tq == 0 ? 0.f : (tq == 1 ? s0 : (tq == 2 ? s0 + s1 : (s0 + s1) + s2));
        const float r = s0 + s1, bend = (s0 + s1) + (s2 + s3);
        unsigned kpk[8];
#pragma unroll
        for (int i = 0; i < 16; ++i) {
            const float bt = pre + b[i];
            const float eq = __expf(fminf(bt - r, 80.f)), ek = __expf(fminf(r - bt, 80.f));
            const unsigned qb = f2bf(qv[i] * eq), kb = f2bf(kv[i] * ek);
            const int tau = 16 * tq + i;
            QT[tau * 136 + k] = (bf16)qb; KT[tau * 136 + k] = (bf16)kb;
            if (i & 1) kpk[i >> 1] |= kb << 16; else kpk[i >> 1] = kb;
        }
        *(LAS v4u*)(KTT + k * 72 + 16 * tq) = (v4u){kpk[0], kpk[1], kpk[2], kpk[3]};
        *(LAS v4u*)(KTT + k * 72 + 16 * tq + 8) = (v4u){kpk[4], kpk[5], kpk[6], kpk[7]};
        if (tq == 0) { ER[k] = __expf(r); EE[k] = __expf(bend - r); }
        __syncthreads();
#pragma unroll
        for (int e = 0; e < 2; ++e) { const int id = wave * 2 + e, tt = id >> 2, st = id & 3;
            f32x4 a = (f32x4){0.f, 0.f, 0.f, 0.f};
            if (st <= tt) a = mma_lds<128>(a, QT + tt * 16 * 136, 136, KT + st * 16 * 136, 136, lane);
#pragma unroll
            for (int i = 0; i < 4; ++i) { const int t = tt * 16 + quad * 4 + i, s = st * 16 + c16; const float val = (st <= tt && s <= t) ? a[i] : 0.f; AM[t * 72 + s] = (bf16)f2bf(val); } }
        __syncthreads();
        unsigned char* dst = SCR + (size_t)item * HP_BLK;
#pragma unroll
        for (int j = 0; j < 6; ++j) { const int idx = tid + 512 * j; *(v4u*)(dst + (size_t)idx * 16) = *(const LAS v4u*)(lds + idx * 16); }
        __syncthreads();
    }
#undef HP_LOAD
}

template <int NVT> __device__ __forceinline__ void hg_scan_item(LAS unsigned char* lds, bf16* PA, const unsigned char* SCR, int item, int T, int tid) {
    constexpr int NVS = 8 / NVT, VW = 16 * NVT, VTHR = 128 * NVT, VSH = (NVT == 2) ? 2 : 1;
    const int lane = tid & 63, wave = __builtin_amdgcn_readfirstlane(tid >> 6), c16 = lane & 15, quad = lane >> 4;
    const int vs = item % NVS, sd = item / NVS, dir = sd & 1, h = (sd >> 1) & 3, seq = sd >> 3;
    const int base = seq * T, nchunk = T / 64;
    const unsigned char* blk = SCR + (size_t)sd * nchunk * HP_BLK;
    const bf16* vsrc = PA + C_HI + h * 128 + vs * VW + (tid & (VW / 8 - 1)) * 8;
    bf16* odst = PA + (dir ? C_HZF : C_HQ) + h * 128 + vs * VW;
    v4u preA[6], preB[6]; v4u vrA = {0u, 0u, 0u, 0u}, vrB = vrA; f32x4 ervA, eevA, ervB, eevB;
#define HG_ROW(tau) (base + (dir ? (T - 1 - (tau)) : (tau)))
#define HS_LOAD(c, pre, vr, erv, eev) do { const int c_ = min((c), nchunk - 1); const unsigned char* bp = blk + (size_t)c_ * HP_BLK;     \
        _Pragma("unroll") for (int j = 0; j < 6; ++j) pre[j] = *(const v4u*)(bp + (size_t)(tid + 512 * j) * 16); \
        erv = *(const f32x4*)(bp + HP_ER + (wave * 16 + quad * 4) * 4); eev = *(const f32x4*)(blk + (size_t)max(c_ - 1, 0) * HP_BLK + HP_EE + (wave * 16 + quad * 4) * 4);     \
        vr = *(const v4u*)(vsrc + (size_t)HG_ROW(c_ * 64 + ((tid & (VTHR - 1)) >> VSH)) * PA_LD); } while (0)
    HS_LOAD(0, preA, vrA, ervA, eevA);
    HS_LOAD(1, preB, vrB, ervB, eevB);
    f32x4 accS[NVT];
#pragma unroll
    for (int e = 0; e < NVT; ++e) accS[e] = (f32x4){0.f, 0.f, 0.f, 0.f};
#define HS_STEP(c, BUFI, pre, vr, erv, eev) do { \
        LAS unsigned char* B = lds + (BUFI) * HS_BUF; \
        LAS bf16* QT = (LAS bf16*)(B + HP_QT); LAS bf16* KTT = (LAS bf16*)(B + HP_KTT); LAS bf16* AM = (LAS bf16*)(B + HP_AM); \
        LAS bf16* VT = (LAS bf16*)(B + HS_VT); LAS bf16* STt = (LAS bf16*)(B + HS_ST); \
        _Pragma("unroll") for (int j = 0; j < 6; ++j) *(LAS v4u*)(B + (tid + 512 * j) * 16) = pre[j]; \
        if (tid < VTHR) { const int s_ = tid >> VSH, vq = tid & (VW / 8 - 1); \
            VT[(vq * 8 + 0) * 72 + s_] = (bf16)(vr.x & 0xffffu); VT[(vq * 8 + 1) * 72 + s_] = (bf16)(vr.x >> 16); \
            VT[(vq * 8 + 2) * 72 + s_] = (bf16)(vr.y & 0xffffu); VT[(vq * 8 + 3) * 72 + s_] = (bf16)(vr.y >> 16); \
            VT[(vq * 8 + 4) * 72 + s_] = (bf16)(vr.z & 0xffffu); VT[(vq * 8 + 5) * 72 + s_] = (bf16)(vr.z >> 16); \
            VT[(vq * 8 + 6) * 72 + s_] = (bf16)(vr.w & 0xffffu); VT[(vq * 8 + 7) * 72 + s_] = (bf16)(vr.w >> 16); } \
        f32x4 sp[NVT]; const f32x4 sc_ = erv * eev;     \
        _Pragma("unroll") for (int e = 0; e < NVT; ++e) { sp[e] = accS[e] * sc_; v2u w; w.x = cvt_pk_bf16(sp[e][0], sp[e][1]); w.y = cvt_pk_bf16(sp[e][2], sp[e][3]); \
            *(LAS v2u*)(STt + (e * 16 + c16) * 136 + wave * 16 + quad * 4) = w; } \
        HS_LOAD((c) + 2, pre, vr, erv, eev); \
        __syncthreads(); \
        if ((wave >> 2) < NVT) { const int tt = wave & 3, vt = wave >> 2; f32x4 o = (f32x4){0.f, 0.f, 0.f, 0.f}; \
          o = mma_lds<128>(o, QT + tt * 16 * 136, 136, STt + vt * 16 * 136, 136, lane); \
          o = mma_lds<64>(o, AM + tt * 16 * 72, 72, VT + vt * 16 * 72, 72, lane); \
          _Pragma("unroll") for (int i = 0; i < 4; ++i) { const int tau = (c) * 64 + tt * 16 + quad * 4 + i; odst[(size_t)HG_ROW(tau) * PA_LD + vt * 16 + c16] = (bf16)f2bf(o[i]); } } \
        _Pragma("unroll") for (int e = 0; e < NVT; ++e) { accS[e] = mma_lds<64>(sp[e], KTT + wave * 16 * 72, 72, VT + e * 16 * 72, 72, lane); } \
    } while (0)
    for (int c = 0; c < nchunk; c += 2) {
        HS_STEP(c, 0, preA, vrA, ervA, eevA);
        HS_STEP(c + 1, 1, preB, vrB, ervB, eevB);
    }
    __syncthreads();
#undef HG_ROW
#undef HS_LOAD
#undef HS_STEP
}

__device__ __forceinline__ void na_item(LAS unsigned char* lds, const bf16* PA, const float* rpb, bf16* ONA, int item, int T, int tid) {
    const int lane = tid & 63, h = __builtin_amdgcn_readfirstlane(tid >> 6), c16 = lane & 15, quad = lane >> 4;
    const int ips = T / 16, seq = item / ips, rem = item % ips, r = rem >> 2, j = rem & 3;
    const int rows = T / 64, rs = min(max(r - 4, 0), rows - 8), kstart = (j == 0) ? 0 : (j == 1) ? 8 : (j == 2) ? 24 : 32;
    const int base = seq * T, qtok = base + r * 64 + 16 * j + c16;
    const bf16* qp = PA + (size_t)qtok * PA_LD + C_NQ + h * 64 + quad * 8;
    const bf16x8 Qb0 = *(const bf16x8*)qp, Qb1 = *(const bf16x8*)(qp + 32);
    const int qcol = 16 * j + c16, cs = min(max(qcol - 8, 0), 48);
    v4u vbufA[8], vbufB[8], vbufC[8], vbufD[8];
#define NA_VLOAD(qd, vbuf) do { _Pragma("unroll") for (int it = 0; it < 8; ++it) { const int idx = it * 64 + lane, key = idx >> 3, dg = idx & 7; \
        const int tok = base + (rs + 2 * (qd) + (key >> 5)) * 64 + kstart + (key & 31); vbuf[it] = *(const v4u*)(PA + (size_t)tok * PA_LD + C_NV + h * 64 + dg * 8); } } while (0)
    NA_VLOAD(0, vbufA); NA_VLOAD(1, vbufB);
    const float* rp = rpb + h * 465;
    f32x4 sacc[16]; float mx = -3e38f;
    int dcv[8]; bool okv[8];
#pragma unroll
    for (int e = 0; e < 8; ++e) { const int kcol = kstart + (e >> 2) * 16 + quad * 4 + (e & 3); okv[e] = (kcol >= cs) && (kcol < cs + 16); dcv[e] = min(max(kcol - qcol + 15, 0), 30); }
#pragma unroll
    for (int a = 0; a < 8; ++a) {
        const float rowv = rp[(rs + a - r + 7) * 31 + min(lane, 30)];
        float bv[8];
#pragma unroll
        for (int e = 0; e < 8; ++e) bv[e] = __builtin_bit_cast(float, __builtin_amdgcn_ds_bpermute(dcv[e] << 2, __builtin_bit_cast(int, rowv)));
#pragma unroll
        for (int hh = 0; hh < 2; ++hh) {
            const int ktok = base + (rs + a) * 64 + kstart + hh * 16 + c16;
            const bf16* kp = PA + (size_t)ktok * PA_LD + C_NK + h * 64 + quad * 8;
            const bf16x8 Ka0 = *(const bf16x8*)kp, Ka1 = *(const bf16x8*)(kp + 32);
            f32x4 s = (f32x4){0.f, 0.f, 0.f, 0.f};
            s = __builtin_amdgcn_mfma_f32_16x16x32_bf16(Ka0, Qb0, s, 0, 0, 0);
            s = __builtin_amdgcn_mfma_f32_16x16x32_bf16(Ka1, Qb1, s, 0, 0, 0);
#pragma unroll
            for (int i = 0; i < 4; ++i) { const float val = okv[hh * 4 + i] ? s[i] * 0.125f + bv[hh * 4 + i] : -1e30f; s[i] = val; mx = fmaxf(mx, val); }
            sacc[a * 2 + hh] = s;
        }
    }
    NA_VLOAD(2, vbufC); NA_VLOAD(3, vbufD);
    mx = fmaxf(mx, __shfl_xor(mx, 16)); mx = fmaxf(mx, __shfl_xor(mx, 32));
    float sum = 0.f;
#pragma unroll
    for (int t = 0; t < 16; ++t)
#pragma unroll
        for (int i = 0; i < 4; ++i) { const float p = __expf(sacc[t][i] - mx); sacc[t][i] = p; sum += p; }
    sum += __shfl_xor(sum, 16); sum += __shfl_xor(sum, 32);
    bf16x8 pb[8];
#pragma unroll
    for (int a = 0; a < 8; ++a) { v4u w; w.x = cvt_pk_bf16(sacc[2 * a][0], sacc[2 * a][1]); w.y = cvt_pk_bf16(sacc[2 * a][2], sacc[2 * a][3]);
        w.z = cvt_pk_bf16(sacc[2 * a + 1][0], sacc[2 * a + 1][1]); w.w = cvt_pk_bf16(sacc[2 * a + 1][2], sacc[2 * a + 1][3]); pb[a] = __builtin_bit_cast(bf16x8, w); }
    LAS bf16* VS = (LAS bf16*)(lds + h * 10240);
    f32x4 oacc[4];
#pragma unroll
    for (int dt = 0; dt < 4; ++dt) oacc[dt] = (f32x4){0.f, 0.f, 0.f, 0.f};
    const int trq = (lane & 15) >> 2, trp = lane & 3;
    const LAS bf16* trbase = VS + (quad * 4 + trq) * 80 + 4 * trp;
#define NA_PV(qd, vbuf) do { \
        _Pragma("unroll") for (int it = 0; it < 8; ++it) { const int idx = it * 64 + lane, key = idx >> 3, dg = idx & 7; *(LAS v4u*)(VS + key * 80 + dg * 8) = vbuf[it]; } \
        _Pragma("unroll") for (int al = 0; al < 2; ++al) \
            _Pragma("unroll") for (int dt = 0; dt < 4; ++dt) { const LAS bf16* p = trbase + al * 32 * 80 + dt * 16; \
                const v4i16_t lo = __builtin_amdgcn_ds_read_tr16_b64_v4i16((LAS v4i16_t*)p), hi = __builtin_amdgcn_ds_read_tr16_b64_v4i16((LAS v4i16_t*)(p + 16 * 80)); \
                const bf16x8 af = {lo[0], lo[1], lo[2], lo[3], hi[0], hi[1], hi[2], hi[3]}; \
                oacc[dt] = __builtin_amdgcn_mfma_f32_16x16x32_bf16(af, pb[(qd) * 2 + al], oacc[dt], 0, 0, 0); } } while (0)
    NA_PV(0, vbufA); NA_PV(1, vbufB); NA_PV(2, vbufC); NA_PV(3, vbufD);
#undef NA_PV
#undef NA_VLOAD
    const float inv = __builtin_amdgcn_rcpf(sum);
#pragma unroll
    for (int dt = 0; dt < 4; ++dt) { const f32x4 o = oacc[dt] * inv; v2u w; w.x = cvt_pk_bf16(o[0], o[1]); w.y = cvt_pk_bf16(o[2], o[3]);
        *(v2u*)(ONA + (size_t)qtok * 512 + h * 64 + dt * 16 + quad * 4) = w; }
}

#define XB_TMO      128
#define XB_XCNT(j)  (256  + 64 * (j))
#define XB_XSUB(j)  (1280 + 64 * (j))
#define XB_XGEN(j)  (2304 + 64 * (j))
#define XB_TOP      3328
#define XB_TOPGEN   3392
#define XCD_BAR_WORDS 3456
#define XB_SPIN_CAP (1u << 18)

__device__ __forceinline__ unsigned xb_ld(unsigned* p)              { return __hip_atomic_load(p, __ATOMIC_RELAXED, __HIP_MEMORY_SCOPE_AGENT); }
__device__ __forceinline__ unsigned xb_add(unsigned* p, unsigned v) { return __hip_atomic_fetch_add(p, v, __ATOMIC_RELAXED, __HIP_MEMORY_SCOPE_AGENT); }
__device__ __forceinline__ unsigned xb_xcc_id() { return (unsigned)__builtin_amdgcn_s_getreg((3 << 11) | 20) & 0xFu; }
#define XB_SPIN(cond, bar) do { unsigned _sp = 0; while (cond) { __builtin_amdgcn_s_sleep(1); \
    if ((++_sp & 255u) == 0u) { if (xb_ld(&(bar)[XB_TMO])) break; if (_sp > XB_SPIN_CAP) { atomicAdd(&(bar)[XB_TMO], 1u); break; } } } } while (0)

struct XcdBarrier {
    unsigned* bar; unsigned x;
    volatile LAS unsigned* st;
};

__device__ __forceinline__ XcdBarrier xcd_barrier_post(unsigned* bar, volatile LAS unsigned* st) {
    XcdBarrier b; b.bar = bar; b.x = xb_xcc_id(); b.st = st;
    if (threadIdx.x == 0) (void)xb_add(&bar[XB_XCNT(b.x)], 1u);
    return b;
}
__device__ __forceinline__ void xcd_barrier_complete(unsigned* bar, unsigned x, unsigned& nloc, unsigned& nx) {
    const unsigned G = gridDim.x * gridDim.y * gridDim.z;
    unsigned sum, cnt, mine, sp = 0u;
    for (;;) {
        sum = 0u; cnt = 0u; mine = 0u;
#pragma unroll
        for (unsigned j = 0; j < 16; ++j) { const unsigned c = xb_ld(&bar[XB_XCNT(j)]); sum += c; cnt += (c > 0u) ? 1u : 0u; mine = (j == x) ? c : mine; }
        if (sum == G) break;
        __builtin_amdgcn_s_sleep(1);
        if ((++sp & 255u) == 0u) { if (xb_ld(&bar[XB_TMO])) break; if (sp > XB_SPIN_CAP) { atomicAdd(&bar[XB_TMO], 1u); break; } }
    }
    nloc = mine > 0u ? mine : 1u; nx = cnt > 0u ? cnt : 1u;
}

__device__ __forceinline__ void xcd_barrier(const XcdBarrier& b) {
    asm volatile("s_waitcnt vmcnt(0)" ::: "memory");
    __syncthreads();
    if (threadIdx.x == 0) {
        unsigned* bar = b.bar;
        __builtin_amdgcn_s_waitcnt(0);
        unsigned nloc = b.st[0], nx = b.st[1];
        if (nloc == 0u) { xcd_barrier_complete(bar, b.x, nloc, nx); b.st[0] = nloc; b.st[1] = nx; }
        const unsigned old = xb_add(&bar[XB_XSUB(b.x)], 1u);
        const unsigned gen = old / nloc;
        if (old + 1u == (gen + 1u) * nloc) {
            __builtin_amdgcn_fence(__ATOMIC_RELEASE, "agent");
            asm volatile("s_waitcnt vmcnt(0)" ::: "memory");
            const unsigned og = xb_add(&bar[XB_TOP], 1u);
            const unsigned tg = og / nx;
            if (og + 1u == (tg + 1u) * nx) xb_add(&bar[XB_TOPGEN], 1u);
            else XB_SPIN(xb_ld(&bar[XB_TOPGEN]) == tg, bar);
            __builtin_amdgcn_fence(__ATOMIC_ACQUIRE, "agent");
            xb_add(&bar[XB_XGEN(b.x)], 1u);
            asm volatile("s_waitcnt vmcnt(0)" ::: "memory");
        } else {
            XB_SPIN(xb_ld(&bar[XB_XGEN(b.x)]) == gen, bar);
            __builtin_amdgcn_fence(__ATOMIC_ACQUIRE, "agent");
            asm volatile("s_waitcnt vmcnt(0)" ::: "memory");
        }
    }
    __syncthreads();
}
struct Args { const float* in[20]; float* out; unsigned char* ws; int ph_lo, ph_hi; };
enum { K_CVT = 0, K_G0, K_UP, K_RES, K_M1, K_M2A, K_M2B, K_M3, K_M4, K_GF };

__global__ void __launch_bounds__(NTHR, 2) mk_fwd(Args args) {
    extern __shared__ __attribute__((aligned(16))) unsigned char lds_raw[];
    LAS unsigned char* lds = (LAS unsigned char*)lds_raw;
    cg::grid_group grid = cg::this_grid();
    const int hi = args.ph_hi;
    { volatile LAS unsigned* st0 = (volatile LAS unsigned*)(lds + LDS_MISC + 32); if (threadIdx.x < 2) st0[threadIdx.x] = 0u; __syncthreads(); }
    XcdBarrier xbar = xcd_barrier_post((unsigned*)(args.ws + WS_CTL) + CW_BAR, (volatile LAS unsigned*)(lds + LDS_MISC + 32));
#if TPROBE
    unsigned long long tacc = 0ull;
#endif
    for (int ph = args.ph_lo; ph < hi; ++ph) {
#if TPROBE
        const unsigned long long tp0 = __builtin_amdgcn_s_memrealtime();
#endif
        int bid = blockIdx.x, G = gridDim.x; asm volatile("" : "+s"(bid), "+s"(G));
        int tid = threadIdx.x; asm volatile("" : "+v"(tid));
        const int lane = tid & 63, wave = __builtin_amdgcn_readfirstlane(tid >> 6);
        const int gw = bid * NWAVES + wave, NGW = G * NWAVES;
        int kind, pr = 0, l = 0, s = 0, g2 = 0;
        if (ph == 0) kind = K_CVT;
        else { const int q = ph - 1; pr = q / PH_PER_PAIR; const int r = q % PH_PER_PAIR;
            if (r == 0) kind = K_G0; else if (r == PH_PER_PAIR - 1) kind = K_GF;
            else { l = (r - 1) / 16; s = (r - 1) % 16;
                if (s == 0 || s == 14) kind = K_UP; else if (s == 1 || s == 15) kind = K_RES;
                else { g2 = (s - 2) / 6; const int t = (s - 2) % 6; kind = (t == 0) ? K_M1 : (t == 1) ? K_M2A : (t == 2) ? K_M2B : (t == 3) ? K_M3 : (t == 4) ? K_M4 : K_RES; } } }
        const bool mix = (s >= 2 && s <= 13);
        unsigned char* ws = args.ws;
        bf16* XBp = (bf16*)(ws + WS_XB); float* SSQp = (float*)(ws + WS_SSQ);
        bf16* XB = XBp + (size_t)g2 * TG * D; float* SSQ = SSQp + (size_t)g2 * TG * 16;
        bf16* PA = (bf16*)(ws + WS_PA); bf16* PG = (bf16*)(ws + WS_PG);
        bf16* ONA = (bf16*)(ws + WS_ONA); bf16* OHG = ONA + (size_t)TG * 512; bf16* OCV = OHG + (size_t)TG * 512;
        unsigned char* SCR = ws + WS_SCR;
        const bf16* Wl = (const bf16*)(ws + WS_W) + (size_t)l * LAYER_EL;
        const int T = pr == 0 ? 2048 : 4096;
        const int g = pr * 2 + g2;
        float* X = args.out + (size_t)pr * 2 * TG * D;

        if (kind == K_CVT) {
            LAS float* scr = (LAS float*)(lds + wave * 16384);
            constexpr int I_GU = 16 * 176, I_DN = 44 * 32, I_IN = 16 * 272, I_MX = 8 * 32, I_OUT = 16 * 32;
            constexpr int I_LAYER = 2 * I_GU + 2 * I_DN + I_IN + 3 * I_MX + I_OUT;
            for (int it = gw; it < NLAYER * I_LAYER; it += NGW) {
                const int ll = it / I_LAYER; int r = it % I_LAYER; bf16* Wd = (bf16*)(ws + WS_W) + (size_t)ll * LAYER_EL;
                const float* src; const float* gain = nullptr; int K, N; size_t off; bool perm = false;
                if (r < I_GU) { src = args.in[3] + (size_t)ll * D * 2 * FF; K = D; N = 2 * FF; off = OFF_GU1; gain = args.in[2] + ll * D; perm = true; }
                else if ((r -= I_GU) < I_DN) { src = args.in[4] + (size_t)ll * FF * D; K = FF; N = D; off = OFF_D1; }
                else if ((r -= I_DN) < I_IN) { src = args.in[6] + (size_t)ll * D * 8704; K = D; N = 8704; off = OFF_IN; gain = args.in[5] + ll * D; }
                else if ((r -= I_IN) < I_MX) { src = args.in[9] + (size_t)ll * 512 * D; K = 512; N = D; off = OFF_HG; }
                else if ((r -= I_MX) < I_MX) { src = args.in[12] + (size_t)ll * 512 * D; K = 512; N = D; off = OFF_CV; }
                else if ((r -= I_MX) < I_MX) { src = args.in[14] + (size_t)ll * 512 * D; K = 512; N = D; off = OFF_NA; }
                else if ((r -= I_MX) < I_OUT) { src = args.in[15] + (size_t)ll * D * D; K = D; N = D; off = OFF_OUT; }
                else if ((r -= I_OUT) < I_GU) { src = args.in[17] + (size_t)ll * D * 2 * FF; K = D; N = 2 * FF; off = OFF_GU2; gain = args.in[16] + ll * D; perm = true; }
                else { r -= I_GU; src = args.in[18] + (size_t)ll * FF * D; K = FF; N = D; off = OFF_D2; }
                cvt_item(src, K, N, Wd + off, gain, perm, scr, r, lane);
            }
        } else if (kind == K_G0) {
            const float* xin = pr == 0 ? args.in[0] : args.in[1];
#pragma unroll 2
            for (int row = gw; row < 2 * TG; row += NGW) {
                const f32x4* __restrict__ xr = (const f32x4*)(xin + (size_t)row * D) + lane; v2u* bo = (v2u*)(XBp + (size_t)row * D) + lane;
                float ss = 0.f;
#pragma unroll
                for (int j = 0; j < 4; ++j) { const f32x4 v = xr[64 * j]; v2u w; w.x = cvt_pk_bf16(v[0], v[1]); w.y = cvt_pk_bf16(v[2], v[3]); bo[64 * j] = w; ss += (v[0] * v[0] + v[1] * v[1]) + (v[2] * v[2] + v[3] * v[3]); }
                ss = wave_sum(ss);
                if (lane < 16) SSQp[(size_t)row * 16 + lane] = lane == 0 ? ss : 0.f;
            }
        } else if (kind == K_UP) {
            pg8::Gemm gm{XBp, Wl + (s == 14 ? OFF_GU2 : OFF_GU1), 2 * TG, 2 * FF, D}; pg8::StaticOrder S; S.init(2 * TG, 2 * FF, G, bid);
            pg8::EpiSwiGLU E{PA, SSQp};
#ifndef NO_UP
            for (int rep = 0; rep < REP_GEMM; ++rep) pg8::gemm_phase<pg8::EpiSwiGLU, pg8::StaticOrder, PGA, PGS>(lds, gm, S, E);
#endif
        } else if (kind == K_RES) {
            const int K = mix ? D : FF, Mr = mix ? TG : 2 * TG; const size_t off = mix ? OFF_OUT : (s == 1 ? OFF_D1 : OFF_D2);
            pg8::Gemm gm{PA, Wl + off, Mr, D, K}; pg8::StaticOrder S; S.init(Mr, D, G, bid);
            pg8::EpiRes E{mix ? XB : XBp, mix ? SSQ : SSQp, mix ? 1.0f : 0.5f};
#ifndef NO_RES
            for (int rep = 0; rep < REP_RES; ++rep) { if (rep + 1 < REP_RES) { pg8::EpiRes E0 = E; E0.alpha = 0.f; pg8::gemm_phase<pg8::EpiRes, pg8::StaticOrder, PGA, PGS>(lds, gm, S, E0); }
                else pg8::gemm_phase<pg8::EpiRes, pg8::StaticOrder, PGA, PGS>(lds, gm, S, E); }
#endif
        } else if (kind == K_M1) {
            pg8::Gemm gm{XBp, Wl + OFF_IN, 2 * TG, 8704, D}; pg8::M1Order S; S.init(G, bid, g2);
            pg8::EpiProj E{PA, (unsigned char*)PG, (unsigned char*)PG + (size_t)TG * 3072, SSQp};
#ifndef NO_PROJ
            for (int rep = 0; rep < REP_GEMM; ++rep) pg8::gemm_phase<pg8::EpiProj, pg8::M1Order, PGA, PGS>(lds, gm, S, E);
#endif
        } else if (kind == K_M2A) {
#ifndef NO_HG
            { const int nP = (TG / 64) * 8;
              for (int rep = 0; rep < REP_HG; ++rep) if (bid < nP) hg_prep_items(lds, PA, SCR, args.in[7], l, bid, G, nP, T, tid); }
#endif
            const float* rpb = args.in[13] + (size_t)l * 8 * 465;
            const int vcu = (G % 8 == 0) ? (bid % 8) * (G / 8) + bid / 8 : bid;
            const int nNA = TG / 16, ipb = (nNA + G - 1) / G;
            for (int rep = 0; rep < REP_NA; ++rep)
                for (int q = 0; q < ipb; ++q) { const int it = vcu * ipb + q; if (it < nNA) {
#ifndef NO_NA
                    na_item(lds, PA, rpb, ONA, it, T, tid);
#endif
                    __syncthreads(); } }
        } else if (kind == K_M2B) {
#ifndef NO_HG
            const int vcu2 = (G % 8 == 0) ? (bid % 8) * (G / 8) + bid / 8 : bid;
            for (int rep = 0; rep < REP_HG; ++rep) {
                if (pr == 0) { for (int it = vcu2; it < 256; it += G) hg_scan_item<2>(lds, PA, SCR, it, T, tid); }
                else       { for (int it = vcu2; it < 256; it += G) hg_scan_item<1>(lds, PA, SCR, it, T, tid); }
            }
#endif
        } else if (kind == K_M3) {
            const float* gno = args.in[8] + l * 512; const float* cw = args.in[10] + l * 3 * 512; const float* cbias = args.in[11] + l * 512;
            const int c0 = lane * 8;
            const bf16* __restrict__ PAr = PA; bf16* __restrict__ OHGr = OHG; bf16* __restrict__ OCVr = OCV;
#pragma unroll 2
            for (int row = gw; row < TG; row += NGW) {
                const bf16* __restrict__ prow = PAr + (size_t)row * PA_LD;
                const v4u fw = *(const v4u*)(prow + C_HQ + c0), bw = *(const v4u*)(prow + C_HZF + c0);
                float o[8] = {bflo(fw.x) + bflo(bw.x), bfhi(fw.x) + bfhi(bw.x), bflo(fw.y) + bflo(bw.y), bfhi(fw.y) + bfhi(bw.y), bflo(fw.z) + bflo(bw.z), bfhi(fw.z) + bfhi(bw.z), bflo(fw.w) + bflo(bw.w), bfhi(fw.w) + bfhi(bw.w)};
                float ss = 0.f;
#pragma unroll
                for (int e = 0; e < 8; ++e) ss += o[e] * o[e];
                ss += __shfl_xor(ss, 1); ss += __shfl_xor(ss, 2); ss += __shfl_xor(ss, 4); ss += __shfl_xor(ss, 8);
                const float rs = __builtin_amdgcn_rsqf(ss * (1.0f / 128.0f) + 1e-6f);
                const v4u hgw = *(const v4u*)(prow + C_HG + c0);
                const float hgv[8] = {bflo(hgw.x), bfhi(hgw.x), bflo(hgw.y), bfhi(hgw.y), bflo(hgw.z), bfhi(hgw.z), bflo(hgw.w), bfhi(hgw.w)};
                const f32x4 gn0 = *(const f32x4*)(gno + c0), gn1 = *(const f32x4*)(gno + c0 + 4);
                const float gn[8] = {gn0[0], gn0[1], gn0[2], gn0[3], gn1[0], gn1[1], gn1[2], gn1[3]};
                float r8[8];
#pragma unroll
                for (int e = 0; e < 8; ++e) r8[e] = o[e] * rs * gn[e] * (hgv[e] * sigm(hgv[e]));
                v4u wo; wo.x = cvt_pk_bf16(r8[0], r8[1]); wo.y = cvt_pk_bf16(r8[2], r8[3]); wo.z = cvt_pk_bf16(r8[4], r8[5]); wo.w = cvt_pk_bf16(r8[6], r8[7]);
                *(v4u*)(OHGr + (size_t)row * 512 + c0) = wo;
                const int tl = row & (T - 1);
                const v4u a1 = *(const v4u*)(prow + C_CA + c0), c1 = *(const v4u*)(prow + C_CC + c0), bb = *(const v4u*)(prow + C_CB + c0);
                v4u a0 = {0u, 0u, 0u, 0u}, cc0 = a0, a2 = a0, cc2 = a0;
                if (tl > 0) { a0 = *(const v4u*)(prow - PA_LD + C_CA + c0); cc0 = *(const v4u*)(prow - PA_LD + C_CC + c0); }
                if (tl < T - 1) { a2 = *(const v4u*)(prow + PA_LD + C_CA + c0); cc2 = *(const v4u*)(prow + PA_LD + C_CC + c0); }
                const float zm[8] = {bflo(a0.x) * bflo(cc0.x), bfhi(a0.x) * bfhi(cc0.x), bflo(a0.y) * bflo(cc0.y), bfhi(a0.y) * bfhi(cc0.y), bflo(a0.z) * bflo(cc0.z), bfhi(a0.z) * bfhi(cc0.z), bflo(a0.w) * bflo(cc0.w), bfhi(a0.w) * bfhi(cc0.w)};
                const float zc[8] = {bflo(a1.x) * bflo(c1.x), bfhi(a1.x) * bfhi(c1.x), bflo(a1.y) * bflo(c1.y), bfhi(a1.y) * bfhi(c1.y), bflo(a1.z) * bflo(c1.z), bfhi(a1.z) * bfhi(c1.z), bflo(a1.w) * bflo(c1.w), bfhi(a1.w) * bfhi(c1.w)};
                const float zp[8] = {bflo(a2.x) * bflo(cc2.x), bfhi(a2.x) * bfhi(cc2.x), bflo(a2.y) * bflo(cc2.y), bfhi(a2.y) * bfhi(cc2.y), bflo(a2.z) * bflo(cc2.z), bfhi(a2.z) * bfhi(cc2.z), bflo(a2.w) * bflo(cc2.w), bfhi(a2.w) * bfhi(cc2.w)};
                const float cbv[8] = {bflo(bb.x), bfhi(bb.x), bflo(bb.y), bfhi(bb.y), bflo(bb.z), bfhi(bb.z), bflo(bb.w), bfhi(bb.w)};
                const f32x4 w00 = *(const f32x4*)(cw + c0), w01 = *(const f32x4*)(cw + c0 + 4), w10 = *(const f32x4*)(cw + 512 + c0), w11 = *(const f32x4*)(cw + 512 + c0 + 4);
                const f32x4 w20 = *(const f32x4*)(cw + 1024 + c0), w21 = *(const f32x4*)(cw + 1024 + c0 + 4), bs0 = *(const f32x4*)(cbias + c0), bs1 = *(const f32x4*)(cbias + c0 + 4);
#pragma unroll
                for (int e = 0; e < 4; ++e) { r8[e] = cbv[e] * (w00[e] * zm[e] + w10[e] * zc[e] + w20[e] * zp[e] + bs0[e]); r8[4 + e] = cbv[4 + e] * (w01[e] * zm[4 + e] + w11[e] * zc[4 + e] + w21[e] * zp[4 + e] + bs1[e]); }
                wo.x = cvt_pk_bf16(r8[0], r8[1]); wo.y = cvt_pk_bf16(r8[2], r8[3]); wo.z = cvt_pk_bf16(r8[4], r8[5]); wo.w = cvt_pk_bf16(r8[6], r8[7]);
                *(v4u*)(OCVr + (size_t)row * 512 + c0) = wo;
            }
        } else if (kind == K_M4) {
            pg8::Gemm gm{ONA, Wl + OFF_HG, 3 * TG, 3 * D, 512}; pg8::MergeOrder S; S.init(TG, D, G, bid);
            pg8::EpiMerge E{(const unsigned char*)PG + (size_t)g2 * TG * 3072, PA};
#ifndef NO_MERGE
            for (int rep = 0; rep < REP_MERGE; ++rep) pg8::gemm_phase<pg8::EpiMerge, pg8::MergeOrder, PGA, PGS>(lds, gm, S, E);
#endif
        } else {
            const f32x4* fg = (const f32x4*)args.in[19] + lane;
#pragma unroll 2
            for (int row = gw; row < 2 * TG; row += NGW) {
                const float rs = pg8::row_rs(SSQp, row);
                f32x4* __restrict__ xo = (f32x4*)(X + (size_t)row * D) + lane; const v2u* __restrict__ bi = (const v2u*)(XBp + (size_t)row * D) + lane;
#pragma unroll
                for (int j = 0; j < 4; ++j) { const v2u w = bi[64 * j]; const f32x4 v = {bflo(w.x), bfhi(w.x), bflo(w.y), bfhi(w.y)}; xo[64 * j] = v * fg[64 * j] * rs; }
            }
        }
#if TPROBE
        __syncthreads();
        const unsigned long long tp1 = __builtin_amdgcn_s_memrealtime();
#endif
        if (ph + 1 < hi) { for (int rep = 0; rep < REP_SYNC; ++rep) { if (hi < 0) grid.sync(); else xcd_barrier(xbar);     } }
#if TPROBE
        const unsigned long long tp2 = __builtin_amdgcn_s_memrealtime();
        if (TPROBE == 100) tacc += tp2 - tp1;
        else if (kind == TPROBE - 1) tacc += tp1 - tp0;
#endif
    }
#if TPROBE
    if (blockIdx.x == TPROBE_BLOCK) { const unsigned long long te = __builtin_amdgcn_s_memrealtime(); while (__builtin_amdgcn_s_memrealtime() - te < tacc) __builtin_amdgcn_s_sleep(8); }
#endif
}
constexpr int N_PHASES = 1 + 2 * PH_PER_PAIR;

extern "C" void kernel_launch(void* const* d_in, const int* in_sizes, int n_in, void* d_out, int out_size, void* d_ws, size_t ws_size, hipStream_t stream) {
    static int grid = 0;
    if (grid == 0) {
        if (n_in != 20 || ws_size < WS_END) { fprintf(stderr, "kernel_launch: unexpected n_in %d / ws %zu\n", n_in, ws_size); grid = -1; return; }
        int dev = 0, cus = 0, per_cu = 0;
        hipGetDevice(&dev); hipDeviceGetAttribute(&cus, hipDeviceAttributeMultiprocessorCount, dev);
        hipFuncSetAttribute((const void*)mk_fwd, hipFuncAttributeMaxDynamicSharedMemorySize, LDS_BYTES);
        hipOccupancyMaxActiveBlocksPerMultiprocessor(&per_cu, (const void*)mk_fwd, NTHR, LDS_BYTES);
        if (per_cu < 1) per_cu = 1;
        grid = cus * per_cu;
        (void)hipGetLastError();
    }
    if (grid < 0) return;
    hipMemsetAsync((char*)d_ws + WS_CTL, 0, CTL_BYTES, stream);
    Args a{};
    for (int i = 0; i < 20; ++i) a.in[i] = (const float*)d_in[i];
    a.out = (float*)d_out; a.ws = (unsigned char*)d_ws;
#if ONE_LAUNCH
    a.ph_lo = 0; a.ph_hi = N_PHASES;
    void* kargs[] = {&a};
    hipError_t e = hipLaunchCooperativeKernel((const void*)mk_fwd, dim3(grid), dim3(NTHR), kargs, LDS_BYTES, stream);
    if (e != hipSuccess) fprintf(stderr, "cooperative launch failed: %s (grid %d)\n", hipGetErrorString(e), grid);
#else
    for (int p = 0; p < N_PHASES; ++p) { a.ph_lo = p; a.ph_hi = p + 1; hipLaunchKernelGGL(mk_fwd, dim3(grid), dim3(NTHR), LDS_BYTES, stream, a); }
#endif
}
```

```cpp
#include <hip/hip_runtime.h>
#include <hip/hip_cooperative_groups.h>
#include <cstdio>
#include <cstdint>
namespace cg = cooperative_groups;
#ifndef ONE_LAUNCH
#define ONE_LAUNCH 1
#endif
#ifndef REP_HG
#define REP_HG 1
#endif
#ifndef REP_NA
#define REP_NA 1
#endif
#ifndef REP_SYNC
#define REP_SYNC 1
#endif
#ifndef REP_GEMM
#define REP_GEMM 1
#endif
#ifndef REP_M3
#define REP_M3 1
#endif
#ifndef REP_RES
#define REP_RES 1
#endif
#ifndef REP_MERGE
#define REP_MERGE 1
#endif
#ifndef REP_MISC
#define REP_MISC 1
#endif
#ifndef TPROBE
#define TPROBE 0
#endif
#ifndef TPROBE_BLOCK
#define TPROBE_BLOCK 0
#endif
#ifndef PGA
#define PGA true
#endif
#ifndef PGS
#define PGS true
#endif
#ifndef RS_PROBE
#define RS_PROBE 0
#endif
namespace pg8 {
#define PG8_LAS __attribute__((address_space(3)))
typedef unsigned short bf16_t;
typedef short bf16x8 __attribute__((ext_vector_type(8)));
typedef float f32x4 __attribute__((ext_vector_type(4)));
typedef unsigned u32x4 __attribute__((ext_vector_type(4)));
constexpr int BM = 256, BK = 64, HALF = 128, HTB = HALF * BK * 2  , STAGE_BYTES = 8 * HTB, NXCD = 8, WGM = 8;

__host__ __device__ __forceinline__ int lds_byte(int r, int c) { const int st = (r >> 4) * 2 + (c >> 5), rr = r & 15, cc = c & 31, ob = rr * 64 + cc * 2; return st * 1024 + (ob ^ (((ob >> 9) & 1) << 5)); }
__host__ __device__ __forceinline__ void stage_rc(int b, int& R, int& C) { const int st = b / 1024, sb = b % 1024, swz = sb ^ (((sb >> 9) & 1) << 5); R = (st >> 1) * 16 + swz / 64; C = (st & 1) * 32 + (swz % 64) / 2; }
__host__ __device__ __forceinline__ int perm32(int rho) { const int n = rho >> 4, i = rho & 15; return 8 * (i >> 2) + 4 * n + (i & 3); }

struct Unit { int pm, pn; };
struct Gemm { const bf16_t* A; const bf16_t* Bt; int M, N, K; };

struct StaticOrder {
    int nM, nN, nwg, G, c;
    __host__ __device__ void init(int M, int N, int G_, int c_) { nM = M / BM; nN = N / BM; nwg = nM * nN; G = G_; c = c_; }
    __host__ __device__ bool next(int i, Unit& u) const {
        const long L = (long)i * G + c; if (L >= nwg) return false;
        int wgid = (int)L; { const int q = nwg / NXCD, r = nwg % NXCD, xcd = wgid % NXCD, off = wgid / NXCD; wgid = (xcd < r ? xcd * (q + 1) : r * (q + 1) + (xcd - r) * q) + off; }
        const int nig = WGM * nN, gid = wgid / nig, fm = gid * WGM, gsz = (nM - fm) < WGM ? (nM - fm) : WGM;
        u.pm = fm + ((wgid % nig) % gsz); u.pn = (wgid % nig) / gsz; return true;
    }
    __device__ __forceinline__ void a_ready(const Unit&) const {}
    __device__ __forceinline__ void done(const Unit&) const {}
};

__device__ __forceinline__ unsigned cvt_pk_bf16(float lo, float hi) { unsigned r; asm volatile("v_cvt_pk_bf16_f32 %0, %1, %2" : "=v"(r) : "v"(lo), "v"(hi)); return r; }
__device__ __forceinline__ float row_rs(const float* ssq, int row) {
    const f32x4* p = (const f32x4*)(ssq + (size_t)row * 16);
    const f32x4 a = p[0], b = p[1], c = p[2], d = p[3];
    const float s = (((a[0] + a[1]) + (a[2] + a[3])) + ((b[0] + b[1]) + (b[2] + b[3]))) + (((c[0] + c[1]) + (c[2] + c[3])) + ((d[0] + d[1]) + (d[2] + d[3])));
    return __builtin_amdgcn_rsqf(s * (1.0f / 1024.0f) + 1e-6f);
}
__device__ __forceinline__ void row_rs8_impl(const float* ssq, int row0, float (&rsv)[8]) {
#pragma unroll
    for (int ai = 0; ai < 2; ++ai) {
        f32x4 p[4][4];
#pragma unroll
        for (int m = 0; m < 4; ++m) { const f32x4* q = (const f32x4*)(ssq + (size_t)(row0 + ai * HALF + m * 16) * 16);
#pragma unroll
            for (int j = 0; j < 4; ++j) p[m][j] = q[j]; }
#pragma unroll
        for (int m = 0; m < 4; ++m) { float t = 0.f;
#pragma unroll
            for (int j = 0; j < 4; ++j) t += (p[m][j][0] + p[m][j][1]) + (p[m][j][2] + p[m][j][3]);
            rsv[ai * 4 + m] = __builtin_amdgcn_rsqf(t * (1.0f / 1024.0f) + 1e-6f); }
    }
}
__device__ __forceinline__ void row_rs8(const float* ssq, int row0, float (&rsv)[8]) {
#if RS_PROBE
    { const float* ssq2 = ssq; asm volatile("" : "+s"(ssq2)); float t2[8]; row_rs8_impl(ssq2, row0, t2); row_rs8_impl(ssq, row0, rsv);
#pragma unroll
      for (int i = 0; i < 8; ++i) rsv[i] = 0.5f * (rsv[i] + t2[i]); return; }
#endif
    row_rs8_impl(ssq, row0, rsv);
}
__device__ __forceinline__ void row_rs8_lds(const PG8_LAS float* rst, const PG8_LAS int* pml, int pm, int wr, int fr, float (&rsv)[8]) {
    const int n = pml[15]; int slot = 0;
#pragma unroll
    for (int s_ = 0; s_ < 12; ++s_) if (s_ < n && pml[s_] == pm) slot = s_;
    const PG8_LAS float* t = rst + slot * 256 + wr * 64 + fr;
#pragma unroll
    for (int ai = 0; ai < 2; ++ai)
#pragma unroll
        for (int m = 0; m < 4; ++m) rsv[ai * 4 + m] = t[ai * HALF + m * 16];
}
__device__ __forceinline__ float sigm(float v) { return __builtin_amdgcn_rcpf(1.0f + __expf(-v)); }

struct EpiSwiGLU {
    static constexpr bool PERM = true, AFTER_DRAIN = false;
    bf16_t* H; const PG8_LAS float* rst; const PG8_LAS int* pml;
    __device__ __forceinline__ void operator()(const f32x4 (&acc)[2][2][4][2], const Unit& u, int wr, int wc, int fr, int fq) const {
        const int row0 = u.pm * BM + wr * 64 + fr, col0 = u.pn * 128 + wc * 32 + 8 * fq;
        float rsv[8]; row_rs8_lds(rst, pml, u.pm, wr, fr, rsv);
#pragma unroll
        for (int ai = 0; ai < 2; ++ai)
#pragma unroll
            for (int m = 0; m < 4; ++m) {
                const int row = row0 + ai * HALF + m * 16; const float rs = rsv[ai * 4 + m];
                u32x4 w;
#pragma unroll
                for (int n = 0; n < 2; ++n) {
                    const f32x4 a = acc[ai][0][m][n] * rs, b = acc[ai][1][m][n] * rs; f32x4 h;
#pragma unroll
                    for (int e = 0; e < 4; ++e) h[e] = a[e] * sigm(a[e]) * b[e];
                    w[2 * n] = cvt_pk_bf16(h[0], h[1]); w[2 * n + 1] = cvt_pk_bf16(h[2], h[3]);
                }
                *(u32x4*)(H + (size_t)row * 2816 + col0) = w;
            }
    }
};
__device__ __forceinline__ void unpack8(const u32x4 w, f32x4& lo, f32x4& hi) {
    lo[0] = __uint_as_float(w.x << 16); lo[1] = __uint_as_float(w.x & 0xffff0000u); lo[2] = __uint_as_float(w.y << 16); lo[3] = __uint_as_float(w.y & 0xffff0000u);
    hi[0] = __uint_as_float(w.z << 16); hi[1] = __uint_as_float(w.z & 0xffff0000u); hi[2] = __uint_as_float(w.w << 16); hi[3] = __uint_as_float(w.w & 0xffff0000u);
}
struct EpiRes {
    static constexpr bool PERM = true, AFTER_DRAIN = false;
    bf16_t* XB; float* ssq; float alpha;
    __device__ __forceinline__ void operator()(const f32x4 (&acc)[2][2][4][2], const Unit& u, int wr, int wc, int fr, int fq) const {
        const int row0 = u.pm * BM + wr * 64 + fr, col0 = u.pn * BM + wc * 32 + 8 * fq;
#pragma unroll
        for (int ai = 0; ai < 2; ++ai) {
            u32x4 xin[4][2];
#pragma unroll
            for (int m = 0; m < 4; ++m)
#pragma unroll
                for (int bj = 0; bj < 2; ++bj) xin[m][bj] = *(const u32x4*)(XB + (size_t)(row0 + ai * HALF + m * 16) * 1024 + col0 + bj * HALF);
#pragma unroll
            for (int m = 0; m < 4; ++m) {
                const int row = row0 + ai * HALF + m * 16; float ss = 0.f;
#pragma unroll
                for (int bj = 0; bj < 2; ++bj) {
                    bf16_t* xp = XB + (size_t)row * 1024 + col0 + bj * HALF;
                    f32x4 x0, x1; unpack8(xin[m][bj], x0, x1);
                    x0 = x0 + acc[ai][bj][m][0] * alpha; x1 = x1 + acc[ai][bj][m][1] * alpha;
                    u32x4 w; w.x = cvt_pk_bf16(x0[0], x0[1]); w.y = cvt_pk_bf16(x0[2], x0[3]); w.z = cvt_pk_bf16(x1[0], x1[1]); w.w = cvt_pk_bf16(x1[2], x1[3]);
                    *(u32x4*)xp = w;
                    ss += ((x0[0] * x0[0] + x0[1] * x0[1]) + (x0[2] * x0[2] + x0[3] * x0[3])) + ((x1[0] * x1[0] + x1[1] * x1[1]) + (x1[2] * x1[2] + x1[3] * x1[3]));
                }
                ss += __shfl_xor(ss, 16); ss += __shfl_xor(ss, 32);
                if (fq == 0) ssq[(size_t)row * 16 + u.pn * 4 + wc] = ss;
            }
            asm volatile("" ::: "memory");
        }
    }
};
struct M1Order {
    StaticOrder so; int second, G, c;
    __device__ void init(int G_, int c_, int second_) { second = second_; G = G_; c = c_; so.init(16384, second_ ? 8192 : 8704, G_, c_); }
    __device__ bool next(int i, Unit& u) const {
        if (!second) { if (so.next(i, u)) return true;
            const long L = (long)i * G + c - 2176; if (L < 0 || L >= 128) return false; u.pm = 64 + (int)(L >> 1); u.pn = 22 + (int)(L & 1); return true; }
        Unit b; if (!so.next(i, b)) return false; u.pm = b.pm + 64; u.pn = b.pn < 22 ? b.pn : b.pn + 2; return true;
    }
    __device__ __forceinline__ void a_ready(const Unit&) const {}
    __device__ __forceinline__ void done(const Unit&) const {}
};
struct EpiProj {
    static constexpr bool PERM = true, AFTER_DRAIN = false;
    bf16_t* PA; unsigned char* PGa; unsigned char* PGb; const PG8_LAS float* rst; const PG8_LAS int* pml;
    __device__ __forceinline__ void operator()(const f32x4 (&acc)[2][2][4][2], const Unit& u, int wr, int wc, int fr, int fq) const {
        unsigned char* PG8 = u.pm < 64 ? PGa : PGb;
        const int prow0 = u.pm * BM + wr * 64 + fr, row0 = prow0 & 16383;
        float rsv[8]; row_rs8_lds(rst, pml, u.pm, wr, fr, rsv);
        if (u.pn < 22) {
            const int col0 = u.pn * BM + wc * 32 + 8 * fq;
#pragma unroll
            for (int ai = 0; ai < 2; ++ai)
#pragma unroll
                for (int m = 0; m < 4; ++m) {
                    const int row = row0 + ai * HALF + m * 16; const float rs = rsv[ai * 4 + m];
#pragma unroll
                    for (int bj = 0; bj < 2; ++bj) {
                        const f32x4 v0 = acc[ai][bj][m][0] * rs, v1 = acc[ai][bj][m][1] * rs;
                        u32x4 w; w.x = cvt_pk_bf16(v0[0], v0[1]); w.y = cvt_pk_bf16(v0[2], v0[3]); w.z = cvt_pk_bf16(v1[0], v1[1]); w.w = cvt_pk_bf16(v1[2], v1[3]);
                        *(u32x4*)(PA + (size_t)row * 5632 + col0 + bj * HALF) = w;
                    }
                }
        } else {
            const int col0 = (u.pn - 22) * BM + wc * 32 + 8 * fq;
#pragma unroll
            for (int ai = 0; ai < 2; ++ai)
#pragma unroll
                for (int m = 0; m < 4; ++m) {
                    const int row = row0 + ai * HALF + m * 16; const float rs = rsv[ai * 4 + m];
#pragma unroll
                    for (int bj = 0; bj < 2; ++bj) {
                        unsigned q[8];
#pragma unroll
                        for (int e = 0; e < 4; ++e) { q[e] = (unsigned)(sigm(acc[ai][bj][m][0][e] * rs) * 255.0f + 0.5f); q[4 + e] = (unsigned)(sigm(acc[ai][bj][m][1][e] * rs) * 255.0f + 0.5f); }
                        typedef unsigned u32x2_ __attribute__((ext_vector_type(2)));
                        u32x2_ w; w.x = q[0] | (q[1] << 8) | (q[2] << 16) | (q[3] << 24); w.y = q[4] | (q[5] << 8) | (q[6] << 16) | (q[7] << 24);
                        *(u32x2_*)(PG8 + (size_t)row * 3072 + col0 + bj * HALF) = w;
                    }
                }
        }
    }
};
struct MergeOrder {
    StaticOrder so;
    __device__ void init(int M, int N, int G_, int c_) { so.init(M, N, G_, c_); }
    __device__ bool next(int i, Unit& u) const { Unit b; if (!so.next(i / 3, b)) return false; const int m = i % 3, w = (m == 0) ? 2 : m - 1; u.pm = b.pm + 64 * m; u.pn = b.pn + 4 * w; return true; }
    __device__ __forceinline__ void a_ready(const Unit&) const {}
    __device__ __forceinline__ void done(const Unit&) const {}
};
struct EpiMerge {
    static constexpr bool PERM = true, AFTER_DRAIN = false;
    const unsigned char* PG8; bf16_t* MB;
    __device__ __forceinline__ void operator()(const f32x4 (&acc)[2][2][4][2], const Unit& u, int wr, int wc, int fr, int fq) const {
        typedef unsigned u32x2_ __attribute__((ext_vector_type(2)));
        const int m_ = u.pm >> 6, pm = u.pm & 63, w_ = u.pn >> 2, pn = u.pn & 3;
        const int row0 = pm * BM + wr * 64 + fr, col0 = pn * BM + wc * 32 + 8 * fq;
#pragma unroll
        for (int ai = 0; ai < 2; ++ai) {
            u32x2_ gin[4][2]; u32x4 pin[4][2];
#pragma unroll
            for (int m = 0; m < 4; ++m)
#pragma unroll
                for (int bj = 0; bj < 2; ++bj) { const int row = row0 + ai * HALF + m * 16, col = col0 + bj * HALF;
                    gin[m][bj] = *(const u32x2_*)(PG8 + (size_t)row * 3072 + w_ * 1024 + col);
                    pin[m][bj] = (m_ > 0) ? *(const u32x4*)(MB + (size_t)row * 1024 + col) : (u32x4){0u, 0u, 0u, 0u}; }
#pragma unroll
            for (int m = 0; m < 4; ++m)
#pragma unroll
                for (int bj = 0; bj < 2; ++bj) { const int row = row0 + ai * HALF + m * 16, col = col0 + bj * HALF;
                    f32x4 g0, g1, p0, p1; unpack8(pin[m][bj], p0, p1);
                    { const unsigned a = gin[m][bj].x, b = gin[m][bj].y; const float k = 1.0f / 255.0f;
                      g0[0] = (float)(a & 255u) * k; g0[1] = (float)((a >> 8) & 255u) * k; g0[2] = (float)((a >> 16) & 255u) * k; g0[3] = (float)(a >> 24) * k;
                      g1[0] = (float)(b & 255u) * k; g1[1] = (float)((b >> 8) & 255u) * k; g1[2] = (float)((b >> 16) & 255u) * k; g1[3] = (float)(b >> 24) * k; }
                    f32x4 t0, t1;
#pragma unroll
                    for (int e = 0; e < 4; ++e) { t0[e] = g0[e] * acc[ai][bj][m][0][e] + p0[e]; t1[e] = g1[e] * acc[ai][bj][m][1][e] + p1[e]; }
                    u32x4 w; w.x = cvt_pk_bf16(t0[0], t0[1]); w.y = cvt_pk_bf16(t0[2], t0[3]); w.z = cvt_pk_bf16(t1[0], t1[1]); w.w = cvt_pk_bf16(t1[2], t1[3]);
                    *(u32x4*)(MB + (size_t)row * 1024 + col) = w; }
            asm volatile("" ::: "memory");
        }
    }
};
template <class Epi, class Sched, bool ALIGN_EPI = false, bool SP2 = false>
__device__ __forceinline__ void gemm_phase(PG8_LAS unsigned char* lds, const Gemm g, const Sched& S, const Epi& E) {
    int tid = threadIdx.x; asm volatile("" : "+v"(tid));
    const int wid = __builtin_amdgcn_readfirstlane(tid >> 6), lane = tid & 63, wr = wid >> 2, wc = wid & 3, fr = lane & 15, fq = lane >> 4;
    const int K = g.K, nt = K / BK;
    unsigned voffA[2], voffB[2];
#pragma unroll
    for (int i = 0; i < 2; ++i) { int R, C; stage_rc(tid * 16 + i * 8192, R, C); const int Rb = Epi::PERM ? ((R & ~31) + perm32(R & 31)) : R;
        voffA[i] = (unsigned)(R * K + C) * 2u; voffB[i] = (unsigned)(Rb * K + C) * 2u; }
    const size_t kstep = (size_t)(BK * 2);
    const size_t hstep = (size_t)HALF * K * 2;
    const size_t tstep = 2 * hstep;
    const unsigned ldsw = (unsigned)wid * 1024u;
    const int aoff = lds_byte(wr * 64 + fr, fq * 8), boff = lds_byte(wc * 32 + fr, fq * 8);
#define PG8_SA(b, h) (((b) * 2 + (h)) * HTB)
#define PG8_SB(b, h) ((4 + (b) * 2 + (h)) * HTB)
#define PG8_STAGE(bufoff, gbase, voff) do { _Pragma("unroll") for (int _i = 0; _i < 2; ++_i) \
        __builtin_amdgcn_global_load_lds((const unsigned*)((const char*)(gbase) + (voff)[_i]), (PG8_LAS unsigned*)(lds + (bufoff) + ldsw + _i * 8192), 16, 0, 0); } while (0)
#define PG8_LDA(dst, b, h) do { _Pragma("unroll") for (int m = 0; m < 4; ++m) _Pragma("unroll") for (int k = 0; k < 2; ++k) dst[m][k] = *(const PG8_LAS bf16x8*)(lds + PG8_SA(b, h) + aoff + m * 2048 + k * 1024); } while (0)
#define PG8_LDB(dst, b, h) do { _Pragma("unroll") for (int n = 0; n < 2; ++n) _Pragma("unroll") for (int k = 0; k < 2; ++k) dst[n][k] = *(const PG8_LAS bf16x8*)(lds + PG8_SB(b, h) + boff + n * 2048 + k * 1024); } while (0)
#define PG8_MMA(ai, bj, At, Bt) do { __builtin_amdgcn_s_setprio(1); _Pragma("unroll") for (int m = 0; m < 4; ++m) _Pragma("unroll") for (int n = 0; n < 2; ++n) _Pragma("unroll") for (int k = 0; k < 2; ++k) \
        acc[ai][bj][m][n] = __builtin_amdgcn_mfma_f32_16x16x32_bf16(Bt[n][k], At[m][k], acc[ai][bj][m][n], 0, 0, 0); __builtin_amdgcn_s_setprio(0); } while (0)
#define PG8_WAIT_V(n) asm volatile("s_waitcnt vmcnt(" #n ")" ::: "memory")
#define PG8_WAIT_L(n) asm volatile("s_waitcnt lgkmcnt(" #n ")" ::: "memory")
#define PG8_BAR __builtin_amdgcn_s_barrier()
#define PG8_SCHED __builtin_amdgcn_sched_barrier(0)
    Unit cur, nxt; int ui = 0;
    if (!S.next(0, cur)) return;
    f32x4 acc[2][2][4][2];
#pragma unroll
    for (int a = 0; a < 2; ++a)
#pragma unroll
        for (int b = 0; b < 2; ++b)
#pragma unroll
            for (int m = 0; m < 4; ++m)
#pragma unroll
                for (int n = 0; n < 2; ++n) acc[a][b][m][n] = (f32x4){0.f, 0.f, 0.f, 0.f};
    bf16x8 At[4][2], B0[2][2], B1[2][2];
    const char* cA = (const char*)g.A + (size_t)cur.pm * tstep; const char* cB = (const char*)g.Bt + (size_t)cur.pn * tstep;
    S.a_ready(cur);
    if constexpr (SP2) {
        PG8_STAGE(PG8_SB(0, 0), cB, voffB); PG8_STAGE(PG8_SB(0, 1), cB + hstep, voffB); PG8_STAGE(PG8_SA(0, 0), cA, voffA); PG8_STAGE(PG8_SA(0, 1), cA + hstep, voffA);
        if (wr == 1) PG8_BAR;
        PG8_WAIT_V(2); PG8_BAR;
        PG8_STAGE(PG8_SB(1, 0), cB + kstep, voffB); PG8_STAGE(PG8_SA(1, 0), cA + kstep, voffA); PG8_STAGE(PG8_SB(1, 1), cB + hstep + kstep, voffB);
        PG8_WAIT_V(6); PG8_BAR;
    } else {
        PG8_STAGE(PG8_SB(0, 0), cB, voffB); PG8_STAGE(PG8_SA(0, 0), cA, voffA); PG8_STAGE(PG8_SB(0, 1), cB + hstep, voffB); PG8_STAGE(PG8_SA(0, 1), cA + hstep, voffA);
        if (wr == 1) PG8_BAR;
        PG8_WAIT_V(4); PG8_BAR;
        PG8_STAGE(PG8_SB(1, 0), cB + kstep, voffB); PG8_STAGE(PG8_SA(1, 0), cA + kstep, voffA); PG8_STAGE(PG8_SB(1, 1), cB + hstep + kstep, voffB);
        PG8_WAIT_V(6); PG8_BAR;
    }
    for (;;) {
        const bool has_next = S.next(ui + 1, nxt);
        const char* nA = has_next ? (const char*)g.A + (size_t)nxt.pm * tstep : cA; const char* nB = has_next ? (const char*)g.Bt + (size_t)nxt.pn * tstep : cB;
        for (int t = 0; t < nt; t += 2) {
            const bool last = (t == nt - 2);
            const char* a1 = cA + (size_t)(t + 1) * kstep;
            const char* a2 = last ? nA : cA + (size_t)(t + 2) * kstep; const char* b2 = last ? nB : cB + (size_t)(t + 2) * kstep;
            const char* a3 = a2 + kstep; const char* b3 = b2 + kstep;
            if (last && has_next) S.a_ready(nxt);
            if constexpr (SP2) {
            PG8_LDB(B0, 0, 0); PG8_LDB(B1, 0, 1); PG8_SCHED; PG8_LDA(At, 0, 0); PG8_STAGE(PG8_SA(1, 1), a1 + hstep, voffA);
            PG8_WAIT_V(8); PG8_WAIT_L(0); PG8_BAR; PG8_MMA(0, 0, At, B0); PG8_MMA(0, 1, At, B1); PG8_BAR; PG8_SCHED;
            PG8_LDA(At, 0, 1); PG8_STAGE(PG8_SB(0, 0), b2, voffB); PG8_STAGE(PG8_SB(0, 1), b2 + hstep, voffB); PG8_STAGE(PG8_SA(0, 0), a2, voffA);
            PG8_WAIT_V(8); PG8_WAIT_L(0); PG8_BAR; PG8_MMA(1, 0, At, B0); PG8_MMA(1, 1, At, B1); PG8_BAR; PG8_SCHED;
            PG8_LDB(B0, 1, 0); PG8_LDB(B1, 1, 1); PG8_SCHED; PG8_LDA(At, 1, 0); PG8_STAGE(PG8_SA(0, 1), a2 + hstep, voffA);
            PG8_WAIT_V(8); PG8_WAIT_L(0); PG8_BAR; PG8_MMA(0, 0, At, B0); PG8_MMA(0, 1, At, B1); PG8_BAR; PG8_SCHED;
            PG8_LDA(At, 1, 1); PG8_STAGE(PG8_SB(1, 0), b3, voffB); PG8_STAGE(PG8_SB(1, 1), b3 + hstep, voffB); PG8_STAGE(PG8_SA(1, 0), a3, voffA);
            PG8_WAIT_V(8); PG8_WAIT_L(0); PG8_BAR; PG8_MMA(1, 0, At, B0); PG8_MMA(1, 1, At, B1); PG8_BAR; PG8_SCHED;
            } else {
            PG8_LDB(B0, 0, 0); PG8_SCHED; PG8_LDA(At, 0, 0); PG8_STAGE(PG8_SA(1, 1), a1 + hstep, voffA);
            PG8_WAIT_L(8); PG8_BAR; PG8_WAIT_L(0); PG8_MMA(0, 0, At, B0); PG8_BAR; PG8_SCHED;
            PG8_LDB(B1, 0, 1); PG8_STAGE(PG8_SB(0, 0), b2, voffB);
            PG8_BAR; PG8_WAIT_L(0); PG8_MMA(0, 1, At, B1); PG8_BAR;
            PG8_LDA(At, 0, 1); PG8_STAGE(PG8_SA(0, 0), a2, voffA);
            PG8_BAR; PG8_WAIT_L(0); PG8_MMA(1, 0, At, B0); PG8_BAR; PG8_SCHED;
            PG8_STAGE(PG8_SB(0, 1), b2 + hstep, voffB);
            PG8_WAIT_V(6); PG8_BAR; PG8_MMA(1, 1, At, B1); PG8_BAR;
            PG8_LDB(B0, 1, 0); PG8_SCHED; PG8_LDA(At, 1, 0); PG8_STAGE(PG8_SA(0, 1), a2 + hstep, voffA);
            PG8_WAIT_L(8); PG8_BAR; PG8_WAIT_L(0); PG8_MMA(0, 0, At, B0); PG8_BAR; PG8_SCHED;
            PG8_LDB(B1, 1, 1); PG8_STAGE(PG8_SB(1, 0), b3, voffB);
            PG8_BAR; PG8_WAIT_L(0); PG8_MMA(0, 1, At, B1); PG8_BAR;
            PG8_LDA(At, 1, 1); PG8_STAGE(PG8_SA(1, 0), a3, voffA);
            PG8_BAR; PG8_WAIT_L(0); PG8_MMA(1, 0, At, B0); PG8_BAR; PG8_SCHED;
            PG8_STAGE(PG8_SB(1, 1), b3 + hstep, voffB);
            PG8_WAIT_V(6); PG8_BAR; PG8_MMA(1, 1, At, B1); PG8_BAR;
            }
        }
        if constexpr (ALIGN_EPI) { if (wr == 0) PG8_BAR; }
        if constexpr (!Epi::AFTER_DRAIN) { E(acc, cur, wr, wc, fr, fq); S.done(cur); }
        if (!has_next) break;
#pragma unroll
        for (int a = 0; a < 2; ++a)
#pragma unroll
            for (int b = 0; b < 2; ++b)
#pragma unroll
                for (int m = 0; m < 4; ++m)
#pragma unroll
                    for (int n = 0; n < 2; ++n) acc[a][b][m][n] = (f32x4){0.f, 0.f, 0.f, 0.f};
        cur = nxt; cA = nA; cB = nB; ++ui;
        if constexpr (ALIGN_EPI) { if (wr == 1) PG8_BAR; }
    }
    PG8_WAIT_V(0);
    if constexpr (!ALIGN_EPI) { if (wr == 0) PG8_BAR; }
    PG8_BAR;
    if constexpr (Epi::AFTER_DRAIN) { E.fused(acc, cur, wr, wc, fr, fq, lds, wid, lane); S.done(cur); }
#undef PG8_SA
#undef PG8_SB
#undef PG8_STAGE
#undef PG8_LDA
#undef PG8_LDB
#undef PG8_MMA
#undef PG8_WAIT_V
#undef PG8_WAIT_L
#undef PG8_BAR
#undef PG8_SCHED
}
}
#define LAS __attribute__((address_space(3)))
typedef unsigned short bf16;
typedef unsigned v4u __attribute__((ext_vector_type(4)));
typedef unsigned v2u __attribute__((ext_vector_type(2)));
typedef short v4i16_t __attribute__((ext_vector_type(4)));
using pg8::f32x4; using pg8::bf16x8; using pg8::cvt_pk_bf16;

constexpr int D = 1024, FF = 2816, NLAYER = 4, TG = 16384, NGROUP = 4, NTHR = 512, NWAVES = 8;
constexpr int PA_LD = 5632, PG_LD = 3072;
constexpr int C_HQ = 0, C_HI = 512, C_HZF = 1024, C_HZB = 1536, C_HG = 2048, C_CA = 2560, C_CB = 3072, C_CC = 3584, C_NQ = 4096, C_NK = 4608, C_NV = 5120;
constexpr size_t MiB = 1u << 20;
constexpr size_t WS_CTL = 0, CTL_BYTES = 1 * MiB, WS_W = 1 * MiB, WS_XB = 221 * MiB, WS_SSQ = 285 * MiB, WS_PA = 287 * MiB, WS_PG = 463 * MiB, WS_ONA = 559 * MiB, WS_SCR = 575 * MiB, WS_END = 671 * MiB;
constexpr size_t OFF_GU1 = 0, OFF_D1 = 5767168, OFF_IN = 8650752, OFF_HG = 17563648, OFF_CV = 18087936, OFF_NA = 18612224, OFF_OUT = 19136512, OFF_GU2 = 20185088, OFF_D2 = 25952256, LAYER_EL = 28835840;
constexpr int LDS_BYTES = 147456, LDS_MISC = 147456 - 64;
constexpr int PH_PER_PAIR = 1 + NLAYER * 16 + 1;
constexpr int CW_BAR = 4096;

__device__ __forceinline__ unsigned f2bf(float f) { unsigned u = __float_as_uint(f); return (u + 0x7fffu + ((u >> 16) & 1u)) >> 16; }
__device__ __forceinline__ float bf2f(unsigned b) { return __uint_as_float(b << 16); }
__device__ __forceinline__ float bflo(unsigned w) { return __uint_as_float(w << 16); }
__device__ __forceinline__ float bfhi(unsigned w) { return __uint_as_float(w & 0xffff0000u); }
__device__ __forceinline__ float sigm(float v) { return __builtin_amdgcn_rcpf(1.0f + __expf(-v)); }
__device__ __forceinline__ float wave_sum(float v) {
#pragma unroll
    for (int o = 1; o < 64; o <<= 1) v += __shfl_xor(v, o);
    return v;
}

__device__ __forceinline__ void cvt_item(const float* W, int K, int N, bf16* WT, const float* gain, bool permgu, LAS float* scr, int item, int lane) {
    const int nblk = N / 32, kb = item / nblk, nb = item % nblk, k0 = 64 * kb, n0 = 32 * nb;
#pragma unroll
    for (int i = 0; i < 32; ++i) { const int kk = 2 * i + (lane >> 5); const float g = gain ? gain[k0 + kk] : 1.0f; scr[kk * 33 + (lane & 31)] = W[(size_t)(k0 + kk) * N + n0 + (lane & 31)] * g; }
    asm volatile("s_waitcnt lgkmcnt(0)" ::: "memory");
    int dn0 = n0;
    if (permgu) { const int half = n0 >= FF ? 1 : 0; const int j = n0 - half * FF; dn0 = (j >> 7) * 256 + half * 128 + (j & 127); }
    const int c = lane & 7;
#pragma unroll
    for (int j = 0; j < 4; ++j) { const int n = (lane >> 3) + 8 * j; const LAS float* s = scr + (8 * c) * 33 + n;
        v4u o; o.x = cvt_pk_bf16(s[0 * 33], s[1 * 33]); o.y = cvt_pk_bf16(s[2 * 33], s[3 * 33]); o.z = cvt_pk_bf16(s[4 * 33], s[5 * 33]); o.w = cvt_pk_bf16(s[6 * 33], s[7 * 33]);
        *(v4u*)(WT + (size_t)(dn0 + n) * K + k0 + 8 * c) = o; }
    asm volatile("s_waitcnt lgkmcnt(0)" ::: "memory");
}

template <int K> __device__ __forceinline__ f32x4 mma_lds(f32x4 acc, const LAS bf16* A, int pa, const LAS bf16* B, int pb, int lane) {
    const int r = lane & 15, q = lane >> 4;
#pragma unroll
    for (int ks = 0; ks < K / 32; ++ks) {
        const bf16x8 a = *(const LAS bf16x8*)(A + r * pa + ks * 32 + q * 8);
        const bf16x8 b = *(const LAS bf16x8*)(B + r * pb + ks * 32 + q * 8);
        acc = __builtin_amdgcn_mfma_f32_16x16x32_bf16(a, b, acc, 0, 0, 0);
    }
    return acc;
}

constexpr int HP_QT = 0, HP_KTT = 17408, HP_AM = 35840, HP_ER = 45056, HP_EE = 45568, HP_BLK = 49152;
constexpr int HP_KT = 49152, HP_SEG = 66560;
constexpr int HS_VT = 49152, HS_ST = 53760, HS_BUF = 62464;
__device__ __forceinline__ void hg_prep_items(LAS unsigned char* lds, const bf16* PA, unsigned char* SCR, const float* lb_logits, int layer, int item0, int istride, int nitems, int T, int tid) {
    const int lane = tid & 63, wave = __builtin_amdgcn_readfirstlane(tid >> 6), c16 = lane & 15, quad = lane >> 4;
    const int nchunk = T / 64;
    const int k = tid & 127, tq = tid >> 7;
    LAS bf16* QT = (LAS bf16*)(lds + HP_QT); LAS bf16* KT = (LAS bf16*)(lds + HP_KT); LAS bf16* KTT = (LAS bf16*)(lds + HP_KTT); LAS bf16* AM = (LAS bf16*)(lds + HP_AM);
    LAS float* SEG = (LAS float*)(lds + HP_SEG); LAS float* ER = (LAS float*)(lds + HP_ER); LAS float* EE = (LAS float*)(lds + HP_EE);
    unsigned short zr[16], qr[16];
#define HP_LOAD(it) do { const int it_ = min((it), nitems - 1); const int c_ = it_ % nchunk, sd_ = it_ / nchunk, dir_ = sd_ & 1, h_ = (sd_ >> 1) & 3, base_ = (sd_ >> 3) * T; \
        const bf16* zs = PA + (dir_ ? C_HZB : C_HZF) + h_ * 128 + k; const bf16* qs = PA + C_HQ + h_ * 128 + k; \
        _Pragma("unroll") for (int i = 0; i < 16; ++i) { const int tau = c_ * 64 + 16 * tq + i; const size_t ro = (size_t)(base_ + (dir_ ? (T - 1 - tau) : tau)) * PA_LD; zr[i] = zs[ro]; qr[i] = qs[ro]; } } while (0)
    HP_LOAD(item0);
    for (int item = item0; item < nitems; item += istride) {
        const int sd = item / nchunk, dir = sd & 1, h = (sd >> 1) & 3;
        float lb;
        { float lg[4], mx = -3e38f;
#pragma unroll
          for (int l = 0; l < 4; ++l) { lg[l] = lb_logits[(dir * 4 + l) * 512 + h * 128 + k]; mx = fmaxf(mx, lg[l]); }
          float tot = 0.f, num = 0.f;
#pragma unroll
          for (int l = 0; l < 4; ++l) { const float e = __expf(lg[l] - mx); tot += e; if (l >= 1 && l <= layer) num += e; }
          lb = num / tot; }
        const float oml = 1.0f - lb;
        float b[16], kv[16], qv[16]; float cum = 0.f;
#pragma unroll
        for (int i = 0; i < 16; ++i) { const float zf = bf2f(zr[i]); const float sg = sigm(zf); const float f = lb + oml * sg; cum += __logf(fmaxf(f, 1e-30f)); b[i] = cum; kv[i] = oml * (1.0f - sg); qv[i] = bf2f(qr[i]); }
        HP_LOAD(item + istride);
        SEG[tq * 128 + k] = cum;
        __syncthreads();
        const float s0 = SEG[k], s1 = SEG[128 + k], s2 = SEG[256 + k], s3 = SEG[384 + k];
        const float pre = tq == 0 ? 0.f : (tq == 1 ? s0 : (tq == 2 ? s0 + s1 : (s0 + s1) + s2));
        const float r = s0 + s1, bend = (s0 + s1) + (s2 + s3);
        unsigned kpk[8];
#pragma unroll
        for (int i = 0; i < 16; ++i) {
            const float bt = pre + b[i];
            const float eq = __expf(fminf(bt - r, 80.f)), ek = __expf(fminf(r - bt, 80.f));
            const unsigned qb = f2bf(qv[i] * eq), kb = f2bf(kv[i] * ek);
            const int tau = 16 * tq + i;
            QT[tau * 136 + k] = (bf16)qb; KT[tau * 136 + k] = (bf16)kb;
            if (i & 1) kpk[i >> 1] |= kb << 16; else kpk[i >> 1] = kb;
        }
        *(LAS v4u*)(KTT + k * 72 + 16 * tq) = (v4u){kpk[0], kpk[1], kpk[2], kpk[3]};
        *(LAS v4u*)(KTT + k * 72 + 16 * tq + 8) = (v4u){kpk[4], kpk[5], kpk[6], kpk[7]};
        if (tq == 0) { ER[k] = __expf(r); EE[k] = __expf(bend - r); }
        __syncthreads();
#pragma unroll
        for (int e = 0; e < 2; ++e) { const int id = wave * 2 + e, tt = id >> 2, st = id & 3;
            f32x4 a = (f32x4){0.f, 0.f, 0.f, 0.f};
            if (st <= tt) a = mma_lds<128>(a, QT + tt * 16 * 136, 136, KT + st * 16 * 136, 136, lane);
#pragma unroll
            for (int i = 0; i < 4; ++i) { const int t = tt * 16 + quad * 4 + i, s = st * 16 + c16; const float val = (st <= tt && s <= t) ? a[i] : 0.f; AM[t * 72 + s] = (bf16)f2bf(val); } }
        __syncthreads();
        unsigned char* dst = SCR + (size_t)item * HP_BLK;
#pragma unroll
        for (int j = 0; j < 6; ++j) { const int idx = tid + 512 * j; *(v4u*)(dst + (size_t)idx * 16) = *(const LAS v4u*)(lds + idx * 16); }
        __syncthreads();
    }
#undef HP_LOAD
}

template <int NVT> __device__ __forceinline__ void hg_scan_item(LAS unsigned char* lds, bf16* PA, const unsigned char* SCR, int item, int T, int tid) {
    constexpr int NVS = 8 / NVT, VW = 16 * NVT, VTHR = 128 * NVT, VSH = (NVT == 2) ? 2 : 1;
    const int lane = tid & 63, wave = __builtin_amdgcn_readfirstlane(tid >> 6), c16 = lane & 15, quad = lane >> 4;
    const int vs = item % NVS, sd = item / NVS, dir = sd & 1, h = (sd >> 1) & 3, seq = sd >> 3;
    const int base = seq * T, nchunk = T / 64;
    const unsigned char* blk = SCR + (size_t)sd * nchunk * HP_BLK;
    const bf16* vsrc = PA + C_HI + h * 128 + vs * VW + (tid & (VW / 8 - 1)) * 8;
    bf16* odst = PA + (dir ? C_HZF : C_HQ) + h * 128 + vs * VW;
    v4u preA[6], preB[6]; v4u vrA = {0u, 0u, 0u, 0u}, vrB = vrA; f32x4 ervA, eevA, ervB, eevB;
#define HG_ROW(tau) (base + (dir ? (T - 1 - (tau)) : (tau)))
#define HS_LOAD(c, pre, vr, erv, eev) do { const int c_ = min((c), nchunk - 1); const unsigned char* bp = blk + (size_t)c_ * HP_BLK;     \
        _Pragma("unroll") for (int j = 0; j < 6; ++j) pre[j] = *(const v4u*)(bp + (size_t)(tid + 512 * j) * 16); \
        erv = *(const f32x4*)(bp + HP_ER + (wave * 16 + quad * 4) * 4); eev = *(const f32x4*)(blk + (size_t)max(c_ - 1, 0) * HP_BLK + HP_EE + (wave * 16 + quad * 4) * 4);     \
        vr = *(const v4u*)(vsrc + (size_t)HG_ROW(c_ * 64 + ((tid & (VTHR - 1)) >> VSH)) * PA_LD); } while (0)
    HS_LOAD(0, preA, vrA, ervA, eevA);
    HS_LOAD(1, preB, vrB, ervB, eevB);
    f32x4 accS[NVT];
#pragma unroll
    for (int e = 0; e < NVT; ++e) accS[e] = (f32x4){0.f, 0.f, 0.f, 0.f};
#define HS_STEP(c, BUFI, pre, vr, erv, eev) do { \
        LAS unsigned char* B = lds + (BUFI) * HS_BUF; \
        LAS bf16* QT = (LAS bf16*)(B + HP_QT); LAS bf16* KTT = (LAS bf16*)(B + HP_KTT); LAS bf16* AM = (LAS bf16*)(B + HP_AM); \
        LAS bf16* VT = (LAS bf16*)(B + HS_VT); LAS bf16* STt = (LAS bf16*)(B + HS_ST); \
        _Pragma("unroll") for (int j = 0; j < 6; ++j) *(LAS v4u*)(B + (tid + 512 * j) * 16) = pre[j]; \
        if (tid < VTHR) { const int s_ = tid >> VSH, vq = tid & (VW / 8 - 1); \
            VT[(vq * 8 + 0) * 72 + s_] = (bf16)(vr.x & 0xffffu); VT[(vq * 8 + 1) * 72 + s_] = (bf16)(vr.x >> 16); \
            VT[(vq * 8 + 2) * 72 + s_] = (bf16)(vr.y & 0xffffu); VT[(vq * 8 + 3) * 72 + s_] = (bf16)(vr.y >> 16); \
            VT[(vq * 8 + 4) * 72 + s_] = (bf16)(vr.z & 0xffffu); VT[(vq * 8 + 5) * 72 + s_] = (bf16)(vr.z >> 16); \
            VT[(vq * 8 + 6) * 72 + s_] = (bf16)(vr.w & 0xffffu); VT[(vq * 8 + 7) * 72 + s_] = (bf16)(vr.w >> 16); } \
        f32x4 sp[NVT]; const f32x4 sc_ = erv * eev;     \
        _Pragma("unroll") for (int e = 0; e < NVT; ++e) { sp[e] = accS[e] * sc_; v2u w; w.x = cvt_pk_bf16(sp[e][0], sp[e][1]); w.y = cvt_pk_bf16(sp[e][2], sp[e][3]); \
            *(LAS v2u*)(STt + (e * 16 + c16) * 136 + wave * 16 + quad * 4) = w; } \
        HS_LOAD((c) + 2, pre, vr, erv, eev); \
        __syncthreads(); \
        if ((wave >> 2) < NVT) { const int tt = wave & 3, vt = wave >> 2; f32x4 o = (f32x4){0.f, 0.f, 0.f, 0.f}; \
          o = mma_lds<128>(o, QT + tt * 16 * 136, 136, STt + vt * 16 * 136, 136, lane); \
          o = mma_lds<64>(o, AM + tt * 16 * 72, 72, VT + vt * 16 * 72, 72, lane); \
          _Pragma("unroll") for (int i = 0; i < 4; ++i) { const int tau = (c) * 64 + tt * 16 + quad * 4 + i; odst[(size_t)HG_ROW(tau) * PA_LD + vt * 16 + c16] = (bf16)f2bf(o[i]); } } \
        _Pragma("unroll") for (int e = 0; e < NVT; ++e) { accS[e] = mma_lds<64>(sp[e], KTT + wave * 16 * 72, 72, VT + e * 16 * 72, 72, lane); } \
    } while (0)
    for (int c = 0; c < nchunk; c += 2) {
        HS_STEP(c, 0, preA, vrA, ervA, eevA);
        HS_STEP(c + 1, 1, preB, vrB, ervB, eevB);
    }
    __syncthreads();
#undef HG_ROW
#undef HS_LOAD
#undef HS_STEP
}

__device__ __forceinline__ void na_item(LAS unsigned char* lds, const bf16* PA, const float* rpb, bf16* ONA, int item, int T, int tid) {
    const int lane = tid & 63, h = __builtin_amdgcn_readfirstlane(tid >> 6), c16 = lane & 15, quad = lane >> 4;
    const int ips = T / 16, seq = item / ips, rem = item % ips, r = rem >> 2, j = rem & 3;
    const int rows = T / 64, rs = min(max(r - 4, 0), rows - 8), kstart = (j == 0) ? 0 : (j == 1) ? 8 : (j == 2) ? 24 : 32;
    const int base = seq * T, qtok = base + r * 64 + 16 * j + c16;
    const bf16* qp = PA + (size_t)qtok * PA_LD + C_NQ + h * 64 + quad * 8;
    const bf16x8 Qb0 = *(const bf16x8*)qp, Qb1 = *(const bf16x8*)(qp + 32);
    const int qcol = 16 * j + c16, cs = min(max(qcol - 8, 0), 48);
    v4u vbufA[8], vbufB[8], vbufC[8], vbufD[8];
#define NA_VLOAD(qd, vbuf) do { _Pragma("unroll") for (int it = 0; it < 8; ++it) { const int idx = it * 64 + lane, key = idx >> 3, dg = idx & 7; \
        const int tok = base + (rs + 2 * (qd) + (key >> 5)) * 64 + kstart + (key & 31); vbuf[it] = *(const v4u*)(PA + (size_t)tok * PA_LD + C_NV + h * 64 + dg * 8); } } while (0)
    NA_VLOAD(0, vbufA); NA_VLOAD(1, vbufB);
    const float* rp = rpb + h * 465;
    f32x4 sacc[16]; float mx = -3e38f;
    int dcv[8]; bool okv[8];
#pragma unroll
    for (int e = 0; e < 8; ++e) { const int kcol = kstart + (e >> 2) * 16 + quad * 4 + (e & 3); okv[e] = (kcol >= cs) && (kcol < cs + 16); dcv[e] = min(max(kcol - qcol + 15, 0), 30); }
#pragma unroll
    for (int a = 0; a < 8; ++a) {
        const float rowv = rp[(rs + a - r + 7) * 31 + min(lane, 30)];
        float bv[8];
#pragma unroll
        for (int e = 0; e < 8; ++e) bv[e] = __builtin_bit_cast(float, __builtin_amdgcn_ds_bpermute(dcv[e] << 2, __builtin_bit_cast(int, rowv)));
#pragma unroll
        for (int hh = 0; hh < 2; ++hh) {
            const int ktok = base + (rs + a) * 64 + kstart + hh * 16 + c16;
            const bf16* kp = PA + (size_t)ktok * PA_LD + C_NK + h * 64 + quad * 8;
            const bf16x8 Ka0 = *(const bf16x8*)kp, Ka1 = *(const bf16x8*)(kp + 32);
            f32x4 s = (f32x4){0.f, 0.f, 0.f, 0.f};
            s = __builtin_amdgcn_mfma_f32_16x16x32_bf16(Ka0, Qb0, s, 0, 0, 0);
            s = __builtin_amdgcn_mfma_f32_16x16x32_bf16(Ka1, Qb1, s, 0, 0, 0);
#pragma unroll
            for (int i = 0; i < 4; ++i) { const float val = okv[hh * 4 + i] ? s[i] * 0.125f + bv[hh * 4 + i] : -1e30f; s[i] = val; mx = fmaxf(mx, val); }
            sacc[a * 2 + hh] = s;
        }
    }
    NA_VLOAD(2, vbufC); NA_VLOAD(3, vbufD);
    mx = fmaxf(mx, __shfl_xor(mx, 16)); mx = fmaxf(mx, __shfl_xor(mx, 32));
    float sum = 0.f;
#pragma unroll
    for (int t = 0; t < 16; ++t)
#pragma unroll
        for (int i = 0; i < 4; ++i) { const float p = __expf(sacc[t][i] - mx); sacc[t][i] = p; sum += p; }
    sum += __shfl_xor(sum, 16); sum += __shfl_xor(sum, 32);
    bf16x8 pb[8];
#pragma unroll
    for (int a = 0; a < 8; ++a) { v4u w; w.x = cvt_pk_bf16(sacc[2 * a][0], sacc[2 * a][1]); w.y = cvt_pk_bf16(sacc[2 * a][2], sacc[2 * a][3]);
        w.z = cvt_pk_bf16(sacc[2 * a + 1][0], sacc[2 * a + 1][1]); w.w = cvt_pk_bf16(sacc[2 * a + 1][2], sacc[2 * a + 1][3]); pb[a] = __builtin_bit_cast(bf16x8, w); }
    LAS bf16* VS = (LAS bf16*)(lds + h * 10240);
    f32x4 oacc[4];
#pragma unroll
    for (int dt = 0; dt < 4; ++dt) oacc[dt] = (f32x4){0.f, 0.f, 0.f, 0.f};
    const int trq = (lane & 15) >> 2, trp = lane & 3;
    const LAS bf16* trbase = VS + (quad * 4 + trq) * 80 + 4 * trp;
#define NA_PV(qd, vbuf) do { \
        _Pragma("unroll") for (int it = 0; it < 8; ++it) { const int idx = it * 64 + lane, key = idx >> 3, dg = idx & 7; *(LAS v4u*)(VS + key * 80 + dg * 8) = vbuf[it]; } \
        _Pragma("unroll") for (int al = 0; al < 2; ++al) \
            _Pragma("unroll") for (int dt = 0; dt < 4; ++dt) { const LAS bf16* p = trbase + al * 32 * 80 + dt * 16; \
                const v4i16_t lo = __builtin_amdgcn_ds_read_tr16_b64_v4i16((LAS v4i16_t*)p), hi = __builtin_amdgcn_ds_read_tr16_b64_v4i16((LAS v4i16_t*)(p + 16 * 80)); \
                const bf16x8 af = {lo[0], lo[1], lo[2], lo[3], hi[0], hi[1], hi[2], hi[3]}; \
                oacc[dt] = __builtin_amdgcn_mfma_f32_16x16x32_bf16(af, pb[(qd) * 2 + al], oacc[dt], 0, 0, 0); } } while (0)
    NA_PV(0, vbufA); NA_PV(1, vbufB); NA_PV(2, vbufC); NA_PV(3, vbufD);
#undef NA_PV
#undef NA_VLOAD
    const float inv = __builtin_amdgcn_rcpf(sum);
#pragma unroll
    for (int dt = 0; dt < 4; ++dt) { const f32x4 o = oacc[dt] * inv; v2u w; w.x = cvt_pk_bf16(o[0], o[1]); w.y = cvt_pk_bf16(o[2], o[3]);
        *(v2u*)(ONA + (size_t)qtok * 512 + h * 64 + dt * 16 + quad * 4) = w; }
}

#define XB_TMO      128
#define XB_XCNT(j)  (256  + 64 * (j))
#define XB_XSUB(j)  (1280 + 64 * (j))
#define XB_XGEN(j)  (2304 + 64 * (j))
#define XB_TOP      3328
#define XB_TOPGEN   3392
#define XCD_BAR_WORDS 3456
#define XB_SPIN_CAP (1u << 18)

__device__ __forceinline__ unsigned xb_ld(unsigned* p)              { return __hip_atomic_load(p, __ATOMIC_RELAXED, __HIP_MEMORY_SCOPE_AGENT); }
__device__ __forceinline__ unsigned xb_add(unsigned* p, unsigned v) { return __hip_atomic_fetch_add(p, v, __ATOMIC_RELAXED, __HIP_MEMORY_SCOPE_AGENT); }
__device__ __forceinline__ unsigned xb_xcc_id() { return (unsigned)__builtin_amdgcn_s_getreg((3 << 11) | 20) & 0xFu; }
#define XB_SPIN(cond, bar) do { unsigned _sp = 0; while (cond) { __builtin_amdgcn_s_sleep(1); \
    if ((++_sp & 255u) == 0u) { if (xb_ld(&(bar)[XB_TMO])) break; if (_sp > XB_SPIN_CAP) { atomicAdd(&(bar)[XB_TMO], 1u); break; } } } } while (0)

struct XcdBarrier {
    unsigned* bar; unsigned x;
    volatile LAS unsigned* st;
};

__device__ __forceinline__ XcdBarrier xcd_barrier_post(unsigned* bar, volatile LAS unsigned* st) {
    XcdBarrier b; b.bar = bar; b.x = xb_xcc_id(); b.st = st;
    if (threadIdx.x == 0) (void)xb_add(&bar[XB_XCNT(b.x)], 1u);
    return b;
}
__device__ __forceinline__ void xcd_barrier_complete(unsigned* bar, unsigned x, unsigned& nloc, unsigned& nx) {
    const unsigned G = gridDim.x * gridDim.y * gridDim.z;
    unsigned sum, cnt, mine, sp = 0u;
    for (;;) {
        sum = 0u; cnt = 0u; mine = 0u;
#pragma unroll
        for (unsigned j = 0; j < 16; ++j) { const unsigned c = xb_ld(&bar[XB_XCNT(j)]); sum += c; cnt += (c > 0u) ? 1u : 0u; mine = (j == x) ? c : mine; }
        if (sum == G) break;
        __builtin_amdgcn_s_sleep(1);
        if ((++sp & 255u) == 0u) { if (xb_ld(&bar[XB_TMO])) break; if (sp > XB_SPIN_CAP) { atomicAdd(&bar[XB_TMO], 1u); break; } }
    }
    nloc = mine > 0u ? mine : 1u; nx = cnt > 0u ? cnt : 1u;
}

__device__ __forceinline__ void xcd_barrier(const XcdBarrier& b) {
    asm volatile("s_waitcnt vmcnt(0)" ::: "memory");
    __syncthreads();
    if (threadIdx.x == 0) {
        unsigned* bar = b.bar;
        __builtin_amdgcn_s_waitcnt(0);
        unsigned nloc = b.st[0], nx = b.st[1];
        if (nloc == 0u) { xcd_barrier_complete(bar, b.x, nloc, nx); b.st[0] = nloc; b.st[1] = nx; }
        const unsigned old = xb_add(&bar[XB_XSUB(b.x)], 1u);
        const unsigned gen = old / nloc;
        if (old + 1u == (gen + 1u) * nloc) {
            __builtin_amdgcn_fence(__ATOMIC_RELEASE, "agent");
            asm volatile("s_waitcnt vmcnt(0)" ::: "memory");
            const unsigned og = xb_add(&bar[XB_TOP], 1u);
            const unsigned tg = og / nx;
            if (og + 1u == (tg + 1u) * nx) xb_add(&bar[XB_TOPGEN], 1u);
            else XB_SPIN(xb_ld(&bar[XB_TOPGEN]) == tg, bar);
            __builtin_amdgcn_fence(__ATOMIC_ACQUIRE, "agent");
            xb_add(&bar[XB_XGEN(b.x)], 1u);
            asm volatile("s_waitcnt vmcnt(0)" ::: "memory");
        } else {
            XB_SPIN(xb_ld(&bar[XB_XGEN(b.x)]) == gen, bar);
            __builtin_amdgcn_fence(__ATOMIC_ACQUIRE, "agent");
            asm volatile("s_waitcnt vmcnt(0)" ::: "memory");
        }
    }
    __syncthreads();
}
struct Args { const float* in[20]; float* out; unsigned char* ws; int ph_lo, ph_hi; };
enum { K_CVT = 0, K_G0, K_UP, K_RES, K_M1, K_M2A, K_M2B, K_M3, K_M4, K_GF };

__global__ void __launch_bounds__(NTHR, 2) mk_fwd(Args args) {
    extern __shared__ __attribute__((aligned(16))) unsigned char lds_raw[];
    LAS unsigned char* lds = (LAS unsigned char*)lds_raw;
    cg::grid_group grid = cg::this_grid();
    const int hi = args.ph_hi;
    { volatile LAS unsigned* st0 = (volatile LAS unsigned*)(lds + LDS_MISC + 32); if (threadIdx.x < 2) st0[threadIdx.x] = 0u; __syncthreads(); }
    XcdBarrier xbar = xcd_barrier_post((unsigned*)(args.ws + WS_CTL) + CW_BAR, (volatile LAS unsigned*)(lds + LDS_MISC + 32));
#if TPROBE
    unsigned long long tacc = 0ull;
#endif
    for (int ph = args.ph_lo; ph < hi; ++ph) {
#if TPROBE
        const unsigned long long tp0 = __builtin_amdgcn_s_memrealtime();
#endif
        int bid = blockIdx.x, G = gridDim.x; asm volatile("" : "+s"(bid), "+s"(G));
        int tid = threadIdx.x; asm volatile("" : "+v"(tid));
        const int lane = tid & 63, wave = __builtin_amdgcn_readfirstlane(tid >> 6);
        const int gw = bid * NWAVES + wave, NGW = G * NWAVES;
        int kind, pr = 0, l = 0, s = 0, g2 = 0;
        if (ph == 0) kind = K_CVT;
        else { const int q = ph - 1; pr = q / PH_PER_PAIR; const int r = q % PH_PER_PAIR;
            if (r == 0) kind = K_G0; else if (r == PH_PER_PAIR - 1) kind = K_GF;
            else { l = (r - 1) / 16; s = (r - 1) % 16;
                if (s == 0 || s == 14) kind = K_UP; else if (s == 1 || s == 15) kind = K_RES;
                else { g2 = (s - 2) / 6; const int t = (s - 2) % 6; kind = (t == 0) ? K_M1 : (t == 1) ? K_M2A : (t == 2) ? K_M2B : (t == 3) ? K_M3 : (t == 4) ? K_M4 : K_RES; } } }
        const bool mix = (s >= 2 && s <= 13);
        unsigned char* ws = args.ws;
        bf16* XBp = (bf16*)(ws + WS_XB); float* SSQp = (float*)(ws + WS_SSQ);
        bf16* XB = XBp + (size_t)g2 * TG * D; float* SSQ = SSQp + (size_t)g2 * TG * 16;
        bf16* PA = (bf16*)(ws + WS_PA); bf16* PG = (bf16*)(ws + WS_PG);
        bf16* ONA = (bf16*)(ws + WS_ONA); bf16* OHG = ONA + (size_t)TG * 512; bf16* OCV = OHG + (size_t)TG * 512;
        unsigned char* SCR = ws + WS_SCR;
        const bf16* Wl = (const bf16*)(ws + WS_W) + (size_t)l * LAYER_EL;
        const int T = pr == 0 ? 2048 : 4096;
        const int g = pr * 2 + g2;
        float* X = args.out + (size_t)pr * 2 * TG * D;

        if (kind == K_CVT) {
            LAS float* scr = (LAS float*)(lds + wave * 16384);
            constexpr int I_GU = 16 * 176, I_DN = 44 * 32, I_IN = 16 * 272, I_MX = 8 * 32, I_OUT = 16 * 32;
            constexpr int I_LAYER = 2 * I_GU + 2 * I_DN + I_IN + 3 * I_MX + I_OUT;
            for (int it = gw; it < NLAYER * I_LAYER; it += NGW) {
                const int ll = it / I_LAYER; int r = it % I_LAYER; bf16* Wd = (bf16*)(ws + WS_W) + (size_t)ll * LAYER_EL;
                const float* src; const float* gain = nullptr; int K, N; size_t off; bool perm = false;
                if (r < I_GU) { src = args.in[3] + (size_t)ll * D * 2 * FF; K = D; N = 2 * FF; off = OFF_GU1; gain = args.in[2] + ll * D; perm = true; }
                else if ((r -= I_GU) < I_DN) { src = args.in[4] + (size_t)ll * FF * D; K = FF; N = D; off = OFF_D1; }
                else if ((r -= I_DN) < I_IN) { src = args.in[6] + (size_t)ll * D * 8704; K = D; N = 8704; off = OFF_IN; gain = args.in[5] + ll * D; }
                else if ((r -= I_IN) < I_MX) { src = args.in[9] + (size_t)ll * 512 * D; K = 512; N = D; off = OFF_HG; }
                else if ((r -= I_MX) < I_MX) { src = args.in[12] + (size_t)ll * 512 * D; K = 512; N = D; off = OFF_CV; }
                else if ((r -= I_MX) < I_MX) { src = args.in[14] + (size_t)ll * 512 * D; K = 512; N = D; off = OFF_NA; }
                else if ((r -= I_MX) < I_OUT) { src = args.in[15] + (size_t)ll * D * D; K = D; N = D; off = OFF_OUT; }
                else if ((r -= I_OUT) < I_GU) { src = args.in[17] + (size_t)ll * D * 2 * FF; K = D; N = 2 * FF; off = OFF_GU2; gain = args.in[16] + ll * D; perm = true; }
                else { r -= I_GU; src = args.in[18] + (size_t)ll * FF * D; K = FF; N = D; off = OFF_D2; }
                cvt_item(src, K, N, Wd + off, gain, perm, scr, r, lane);
            }
        } else if (kind == K_G0) {
            const float* xin = pr == 0 ? args.in[0] : args.in[1];
#pragma unroll 2
            for (int row = gw; row < 2 * TG; row += NGW) {
                const f32x4* __restrict__ xr = (const f32x4*)(xin + (size_t)row * D) + lane; v2u* bo = (v2u*)(XBp + (size_t)row * D) + lane;
                float ss = 0.f;
#pragma unroll
                for (int j = 0; j < 4; ++j) { const f32x4 v = xr[64 * j]; v2u w; w.x = cvt_pk_bf16(v[0], v[1]); w.y = cvt_pk_bf16(v[2], v[3]); bo[64 * j] = w; ss += (v[0] * v[0] + v[1] * v[1]) + (v[2] * v[2] + v[3] * v[3]); }
                ss = wave_sum(ss);
                if (lane < 16) SSQp[(size_t)row * 16 + lane] = lane == 0 ? ss : 0.f;
            }
        } else if (kind == K_UP) {
            pg8::Gemm gm{XBp, Wl + (s == 14 ? OFF_GU2 : OFF_GU1), 2 * TG, 2 * FF, D}; pg8::StaticOrder S; S.init(2 * TG, 2 * FF, G, bid);
            LAS float* rst = (LAS float*)(lds + 131072); LAS int* pml = (LAS int*)(lds + 131072 + 12288);
            __syncthreads();
            if (tid == 0) { int n = 0; pg8::Unit uu;
                for (int i = 0; S.next(i, uu); ++i) { bool f = false; for (int q = 0; q < n; ++q) f = f || (pml[q] == uu.pm); if (!f && n < 12) pml[n++] = uu.pm; }
                pml[15] = n; }
            __syncthreads();
            { const int n = pml[15];
              for (int idx = tid; idx < n * 256; idx += NTHR) { const int row = pml[idx >> 8] * 256 + (idx & 255); rst[idx] = pg8::row_rs(SSQp, row); } }
            __syncthreads();
            pg8::EpiSwiGLU E{PA, rst, pml};
#ifndef NO_UP
            for (int rep = 0; rep < REP_GEMM; ++rep) pg8::gemm_phase<pg8::EpiSwiGLU, pg8::StaticOrder, PGA, PGS>(lds, gm, S, E);
#endif
        } else if (kind == K_RES) {
            const int K = mix ? D : FF, Mr = mix ? TG : 2 * TG; const size_t off = mix ? OFF_OUT : (s == 1 ? OFF_D1 : OFF_D2);
            pg8::Gemm gm{PA, Wl + off, Mr, D, K}; pg8::StaticOrder S; S.init(Mr, D, G, bid);
            pg8::EpiRes E{mix ? XB : XBp, mix ? SSQ : SSQp, mix ? 1.0f : 0.5f};
#ifndef NO_RES
            for (int rep = 0; rep < REP_RES; ++rep) { if (rep + 1 < REP_RES) { pg8::EpiRes E0 = E; E0.alpha = 0.f; pg8::gemm_phase<pg8::EpiRes, pg8::StaticOrder, PGA, PGS>(lds, gm, S, E0); }
                else pg8::gemm_phase<pg8::EpiRes, pg8::StaticOrder, PGA, PGS>(lds, gm, S, E); }
#endif
        } else if (kind == K_M1) {
            pg8::Gemm gm{XBp, Wl + OFF_IN, 2 * TG, 8704, D}; pg8::M1Order S; S.init(G, bid, g2);
            LAS float* rst = (LAS float*)(lds + 131072); LAS int* pml = (LAS int*)(lds + 131072 + 12288);
            __syncthreads();
            if (tid == 0) { int n = 0; pg8::Unit uu;
                for (int i = 0; S.next(i, uu); ++i) { bool f = false; for (int q = 0; q < n; ++q) f = f || (pml[q] == uu.pm); if (!f && n < 12) pml[n++] = uu.pm; }
                pml[15] = n; }
            __syncthreads();
            { const int n = pml[15];
              for (int idx = tid; idx < n * 256; idx += NTHR) { const int row = pml[idx >> 8] * 256 + (idx & 255); rst[idx] = pg8::row_rs(SSQp, row); } }
            __syncthreads();
            pg8::EpiProj E{PA, (unsigned char*)PG, (unsigned char*)PG + (size_t)TG * 3072, rst, pml};
#ifndef NO_PROJ
            for (int rep = 0; rep < REP_GEMM; ++rep) pg8::gemm_phase<pg8::EpiProj, pg8::M1Order, PGA, PGS>(lds, gm, S, E);
#endif
        } else if (kind == K_M2A) {
#ifndef NO_HG
            { const int nP = (TG / 64) * 8;
              for (int rep = 0; rep < REP_HG; ++rep) if (bid < nP) hg_prep_items(lds, PA, SCR, args.in[7], l, bid, G, nP, T, tid); }
#endif
            const float* rpb = args.in[13] + (size_t)l * 8 * 465;
            const int vcu = (G % 8 == 0) ? (bid % 8) * (G / 8) + bid / 8 : bid;
            const int nNA = TG / 16, ipb = (nNA + G - 1) / G;
            for (int rep = 0; rep < REP_NA; ++rep)
                for (int q = 0; q < ipb; ++q) { const int it = vcu * ipb + q; if (it < nNA) {
#ifndef NO_NA
                    na_item(lds, PA, rpb, ONA, it, T, tid);
#endif
                    __syncthreads(); } }
        } else if (kind == K_M2B) {
#ifndef NO_HG
            const int vcu2 = (G % 8 == 0) ? (bid % 8) * (G / 8) + bid / 8 : bid;
            for (int rep = 0; rep < REP_HG; ++rep) {
                if (pr == 0) { for (int it = vcu2; it < 256; it += G) hg_scan_item<2>(lds, PA, SCR, it, T, tid); }
                else       { for (int it = vcu2; it < 256; it += G) hg_scan_item<1>(lds, PA, SCR, it, T, tid); }
            }
#endif
        } else if (kind == K_M3) {
            const float* gno = args.in[8] + l * 512; const float* cw = args.in[10] + l * 3 * 512; const float* cbias = args.in[11] + l * 512;
            const int c0 = lane * 8;
            const bf16* __restrict__ PAr = PA; bf16* __restrict__ OHGr = OHG; bf16* __restrict__ OCVr = OCV;
            const f32x4 gn0 = *(const f32x4*)(gno + c0), gn1 = *(const f32x4*)(gno + c0 + 4);
            const f32x4 w00 = *(const f32x4*)(cw + c0), w01 = *(const f32x4*)(cw + c0 + 4), w10 = *(const f32x4*)(cw + 512 + c0), w11 = *(const f32x4*)(cw + 512 + c0 + 4);
            const f32x4 w20 = *(const f32x4*)(cw + 1024 + c0), w21 = *(const f32x4*)(cw + 1024 + c0 + 4), bs0 = *(const f32x4*)(cbias + c0), bs1 = *(const f32x4*)(cbias + c0 + 4);
#pragma unroll 2
            for (int row = gw; row < TG; row += NGW) {
                const bf16* __restrict__ prow = PAr + (size_t)row * PA_LD;
                const v4u fw = *(const v4u*)(prow + C_HQ + c0), bw = *(const v4u*)(prow + C_HZF + c0);
                float o[8] = {bflo(fw.x) + bflo(bw.x), bfhi(fw.x) + bfhi(bw.x), bflo(fw.y) + bflo(bw.y), bfhi(fw.y) + bfhi(bw.y), bflo(fw.z) + bflo(bw.z), bfhi(fw.z) + bfhi(bw.z), bflo(fw.w) + bflo(bw.w), bfhi(fw.w) + bfhi(bw.w)};
                float ss = 0.f;
#pragma unroll
                for (int e = 0; e < 8; ++e) ss += o[e] * o[e];
                ss += __shfl_xor(ss, 1); ss += __shfl_xor(ss, 2); ss += __shfl_xor(ss, 4); ss += __shfl_xor(ss, 8);
                const float rs = __builtin_amdgcn_rsqf(ss * (1.0f / 128.0f) + 1e-6f);
                const v4u hgw = *(const v4u*)(prow + C_HG + c0);
                const float hgv[8] = {bflo(hgw.x), bfhi(hgw.x), bflo(hgw.y), bfhi(hgw.y), bflo(hgw.z), bfhi(hgw.z), bflo(hgw.w), bfhi(hgw.w)};
                const float gn[8] = {gn0[0], gn0[1], gn0[2], gn0[3], gn1[0], gn1[1], gn1[2], gn1[3]};
                float r8[8];
#pragma unroll
                for (int e = 0; e < 8; ++e) r8[e] = o[e] * rs * gn[e] * (hgv[e] * sigm(hgv[e]));
                v4u wo; wo.x = cvt_pk_bf16(r8[0], r8[1]); wo.y = cvt_pk_bf16(r8[2], r8[3]); wo.z = cvt_pk_bf16(r8[4], r8[5]); wo.w = cvt_pk_bf16(r8[6], r8[7]);
                *(v4u*)(OHGr + (size_t)row * 512 + c0) = wo;
                const int tl = row & (T - 1);
                const v4u a1 = *(const v4u*)(prow + C_CA + c0), c1 = *(const v4u*)(prow + C_CC + c0), bb = *(const v4u*)(prow + C_CB + c0);
                v4u a0 = {0u, 0u, 0u, 0u}, cc0 = a0, a2 = a0, cc2 = a0;
                if (tl > 0) { a0 = *(const v4u*)(prow - PA_LD + C_CA + c0); cc0 = *(const v4u*)(prow - PA_LD + C_CC + c0); }
                if (tl < T - 1) { a2 = *(const v4u*)(prow + PA_LD + C_CA + c0); cc2 = *(const v4u*)(prow + PA_LD + C_CC + c0); }
                const float zm[8] = {bflo(a0.x) * bflo(cc0.x), bfhi(a0.x) * bfhi(cc0.x), bflo(a0.y) * bflo(cc0.y), bfhi(a0.y) * bfhi(cc0.y), bflo(a0.z) * bflo(cc0.z), bfhi(a0.z) * bfhi(cc0.z), bflo(a0.w) * bflo(cc0.w), bfhi(a0.w) * bfhi(cc0.w)};
                const float zc[8] = {bflo(a1.x) * bflo(c1.x), bfhi(a1.x) * bfhi(c1.x), bflo(a1.y) * bflo(c1.y), bfhi(a1.y) * bfhi(c1.y), bflo(a1.z) * bflo(c1.z), bfhi(a1.z) * bfhi(c1.z), bflo(a1.w) * bflo(c1.w), bfhi(a1.w) * bfhi(c1.w)};
                const float zp[8] = {bflo(a2.x) * bflo(cc2.x), bfhi(a2.x) * bfhi(cc2.x), bflo(a2.y) * bflo(cc2.y), bfhi(a2.y) * bfhi(cc2.y), bflo(a2.z) * bflo(cc2.z), bfhi(a2.z) * bfhi(cc2.z), bflo(a2.w) * bflo(cc2.w), bfhi(a2.w) * bfhi(cc2.w)};
                const float cbv[8] = {bflo(bb.x), bfhi(bb.x), bflo(bb.y), bfhi(bb.y), bflo(bb.z), bfhi(bb.z), bflo(bb.w), bfhi(bb.w)};
#pragma unroll
                for (int e = 0; e < 4; ++e) { r8[e] = cbv[e] * (w00[e] * zm[e] + w10[e] * zc[e] + w20[e] * zp[e] + bs0[e]); r8[4 + e] = cbv[4 + e] * (w01[e] * zm[4 + e] + w11[e] * zc[4 + e] + w21[e] * zp[4 + e] + bs1[e]); }
                wo.x = cvt_pk_bf16(r8[0], r8[1]); wo.y = cvt_pk_bf16(r8[2], r8[3]); wo.z = cvt_pk_bf16(r8[4], r8[5]); wo.w = cvt_pk_bf16(r8[6], r8[7]);
                *(v4u*)(OCVr + (size_t)row * 512 + c0) = wo;
            }
        } else if (kind == K_M4) {
            pg8::Gemm gm{ONA, Wl + OFF_HG, 3 * TG, 3 * D, 512}; pg8::MergeOrder S; S.init(TG, D, G, bid);
            pg8::EpiMerge E{(const unsigned char*)PG + (size_t)g2 * TG * 3072, PA};
#ifndef NO_MERGE
            for (int rep = 0; rep < REP_MERGE; ++rep) pg8::gemm_phase<pg8::EpiMerge, pg8::MergeOrder, PGA, PGS>(lds, gm, S, E);
#endif
        } else {
            const f32x4* fg = (const f32x4*)args.in[19] + lane;
#pragma unroll 2
            for (int row = gw; row < 2 * TG; row += NGW) {
                const float rs = pg8::row_rs(SSQp, row);
                f32x4* __restrict__ xo = (f32x4*)(X + (size_t)row * D) + lane; const v2u* __restrict__ bi = (const v2u*)(XBp + (size_t)row * D) + lane;
#pragma unroll
                for (int j = 0; j < 4; ++j) { const v2u w = bi[64 * j]; const f32x4 v = {bflo(w.x), bfhi(w.x), bflo(w.y), bfhi(w.y)}; xo[64 * j] = v * fg[64 * j] * rs; }
            }
        }
#if TPROBE
        __syncthreads();
        const unsigned long long tp1 = __builtin_amdgcn_s_memrealtime();
#endif
        if (ph + 1 < hi) { for (int rep = 0; rep < REP_SYNC; ++rep) { if (hi < 0) grid.sync(); else xcd_barrier(xbar);     } }
#if TPROBE
        const unsigned long long tp2 = __builtin_amdgcn_s_memrealtime();
        if (TPROBE == 100) tacc += tp2 - tp1;
        else if (kind == TPROBE - 1) tacc += tp1 - tp0;
#endif
    }
#if TPROBE
    if (blockIdx.x == TPROBE_BLOCK) { const unsigned long long te = __builtin_amdgcn_s_memrealtime(); while (__builtin_amdgcn_s_memrealtime() - te < tacc) __builtin_amdgcn_s_sleep(8); }
#endif
}
constexpr int N_PHASES = 1 + 2 * PH_PER_PAIR;

extern "C" void kernel_launch(void* const* d_in, const int* in_sizes, int n_in, void* d_out, int out_size, void* d_ws, size_t ws_size, hipStream_t stream) {
    static int grid = 0;
    if (grid == 0) {
        if (n_in != 20 || ws_size < WS_END) { fprintf(stderr, "kernel_launch: unexpected n_in %d / ws %zu\n", n_in, ws_size); grid = -1; return; }
        int dev = 0, cus = 0, per_cu = 0;
        hipGetDevice(&dev); hipDeviceGetAttribute(&cus, hipDeviceAttributeMultiprocessorCount, dev);
        hipFuncSetAttribute((const void*)mk_fwd, hipFuncAttributeMaxDynamicSharedMemorySize, LDS_BYTES);
        hipOccupancyMaxActiveBlocksPerMultiprocessor(&per_cu, (const void*)mk_fwd, NTHR, LDS_BYTES);
        if (per_cu < 1) per_cu = 1;
        grid = cus * per_cu;
        (void)hipGetLastError();
    }
    if (grid < 0) return;
    hipMemsetAsync((char*)d_ws + WS_CTL, 0, CTL_BYTES, stream);
    Args a{};
    for (int i = 0; i < 20; ++i) a.in[i] = (const float*)d_in[i];
    a.out = (float*)d_out; a.ws = (unsigned char*)d_ws;
#if ONE_LAUNCH
    a.ph_lo = 0; a.ph_hi = N_PHASES;
    void* kargs[] = {&a};
    hipError_t e = hipLaunchCooperativeKernel((const void*)mk_fwd, dim3(grid), dim3(NTHR), kargs, LDS_BYTES, stream);
    if (e != hipSuccess) fprintf(stderr, "cooperative launch failed: %s (grid %d)\n", hipGetErrorString(e), grid);
#else
    for (int p = 0; p < N_PHASES; ++p) { a.ph_lo = p; a.ph_hi = p + 1; hipLaunchKernelGGL(mk_fwd, dim3(grid), dim3(NTHR), LDS_BYTES, stream, a); }
#endif
}
```

```cpp
#include <hip/hip_runtime.h>
#include <hip/hip_cooperative_groups.h>
#include <cstdio>
#include <cstdint>
namespace cg = cooperative_groups;
#ifndef ONE_LAUNCH
#define ONE_LAUNCH 1
#endif
#ifndef REP_HG
#define REP_HG 1
#endif
#ifndef REP_NA
#define REP_NA 1
#endif
#ifndef REP_SYNC
#define REP_SYNC 1
#endif
#ifndef REP_GEMM
#define REP_GEMM 1
#endif
#ifndef REP_M3
#define REP_M3 1
#endif
#ifndef REP_RES
#define REP_RES 1
#endif
#ifndef REP_MERGE
#define REP_MERGE 1
#endif
#ifndef REP_MISC
#define REP_MISC 1
#endif
#ifndef TPROBE
#define TPROBE 0
#endif
#ifndef TPROBE_BLOCK
#define TPROBE_BLOCK 0
#endif
#ifndef PGA
#define PGA true
#endif
#ifndef PGS
#define PGS true
#endif
#ifndef RS_PROBE
#define RS_PROBE 0
#endif
namespace pg8 {
#define PG8_LAS __attribute__((address_space(3)))
typedef unsigned short bf16_t;
typedef short bf16x8 __attribute__((ext_vector_type(8)));
typedef float f32x4 __attribute__((ext_vector_type(4)));
typedef unsigned u32x4 __attribute__((ext_vector_type(4)));
constexpr int BM = 256, BK = 64, HALF = 128, HTB = HALF * BK * 2  , STAGE_BYTES = 8 * HTB, NXCD = 8, WGM = 8;

__host__ __device__ __forceinline__ int lds_byte(int r, int c) { const int st = (r >> 4) * 2 + (c >> 5), rr = r & 15, cc = c & 31, ob = rr * 64 + cc * 2; return st * 1024 + (ob ^ (((ob >> 9) & 1) << 5)); }
__host__ __device__ __forceinline__ void stage_rc(int b, int& R, int& C) { const int st = b / 1024, sb = b % 1024, swz = sb ^ (((sb >> 9) & 1) << 5); R = (st >> 1) * 16 + swz / 64; C = (st & 1) * 32 + (swz % 64) / 2; }
__host__ __device__ __forceinline__ int perm32(int rho) { const int n = rho >> 4, i = rho & 15; return 8 * (i >> 2) + 4 * n + (i & 3); }

struct Unit { int pm, pn; };
struct Gemm { const bf16_t* A; const bf16_t* Bt; int M, N, K; };

struct StaticOrder {
    int nM, nN, nwg, G, c;
    __host__ __device__ void init(int M, int N, int G_, int c_) { nM = M / BM; nN = N / BM; nwg = nM * nN; G = G_; c = c_; }
    __host__ __device__ bool next(int i, Unit& u) const {
        const long L = (long)i * G + c; if (L >= nwg) return false;
        int wgid = (int)L; { const int q = nwg / NXCD, r = nwg % NXCD, xcd = wgid % NXCD, off = wgid / NXCD; wgid = (xcd < r ? xcd * (q + 1) : r * (q + 1) + (xcd - r) * q) + off; }
        const int nig = WGM * nN, gid = wgid / nig, fm = gid * WGM, gsz = (nM - fm) < WGM ? (nM - fm) : WGM;
        u.pm = fm + ((wgid % nig) % gsz); u.pn = (wgid % nig) / gsz; return true;
    }
    __device__ __forceinline__ void a_ready(const Unit&) const {}
    __device__ __forceinline__ void done(const Unit&) const {}
};

__device__ __forceinline__ unsigned cvt_pk_bf16(float lo, float hi) { unsigned r; asm volatile("v_cvt_pk_bf16_f32 %0, %1, %2" : "=v"(r) : "v"(lo), "v"(hi)); return r; }
__device__ __forceinline__ float row_rs(const float* ssq, int row) {
    const f32x4* p = (const f32x4*)(ssq + (size_t)row * 16);
    const f32x4 a = p[0], b = p[1], c = p[2], d = p[3];
    const float s = (((a[0] + a[1]) + (a[2] + a[3])) + ((b[0] + b[1]) + (b[2] + b[3]))) + (((c[0] + c[1]) + (c[2] + c[3])) + ((d[0] + d[1]) + (d[2] + d[3])));
    return __builtin_amdgcn_rsqf(s * (1.0f / 1024.0f) + 1e-6f);
}
__device__ __forceinline__ void row_rs8_impl(const float* ssq, int row0, float (&rsv)[8]) {
#pragma unroll
    for (int ai = 0; ai < 2; ++ai) {
        f32x4 p[4][4];
#pragma unroll
        for (int m = 0; m < 4; ++m) { const f32x4* q = (const f32x4*)(ssq + (size_t)(row0 + ai * HALF + m * 16) * 16);
#pragma unroll
            for (int j = 0; j < 4; ++j) p[m][j] = q[j]; }
#pragma unroll
        for (int m = 0; m < 4; ++m) { float t = 0.f;
#pragma unroll
            for (int j = 0; j < 4; ++j) t += (p[m][j][0] + p[m][j][1]) + (p[m][j][2] + p[m][j][3]);
            rsv[ai * 4 + m] = __builtin_amdgcn_rsqf(t * (1.0f / 1024.0f) + 1e-6f); }
    }
}
__device__ __forceinline__ void row_rs8(const float* ssq, int row0, float (&rsv)[8]) {
#if RS_PROBE
    { const float* ssq2 = ssq; asm volatile("" : "+s"(ssq2)); float t2[8]; row_rs8_impl(ssq2, row0, t2); row_rs8_impl(ssq, row0, rsv);
#pragma unroll
      for (int i = 0; i < 8; ++i) rsv[i] = 0.5f * (rsv[i] + t2[i]); return; }
#endif
    row_rs8_impl(ssq, row0, rsv);
}
__device__ __forceinline__ void row_rs8_lds(const PG8_LAS float* rst, const PG8_LAS int* pml, const float* ssq, int pm, int wr, int fr, float (&rsv)[8]) {
    const int n = pml[15]; int slot = -1;
#pragma unroll
    for (int s_ = 0; s_ < 12; ++s_) if (s_ < n && pml[s_] == pm) slot = s_;
    if (slot < 0) { row_rs8(ssq, pm * BM + wr * 64 + fr, rsv); return; }
    const PG8_LAS float* t = rst + slot * 256 + wr * 64 + fr;
#pragma unroll
    for (int ai = 0; ai < 2; ++ai)
#pragma unroll
        for (int m = 0; m < 4; ++m) rsv[ai * 4 + m] = t[ai * HALF + m * 16];
}
__device__ __forceinline__ float sigm(float v) { return __builtin_amdgcn_rcpf(1.0f + __expf(-v)); }

struct EpiSwiGLU {
    static constexpr bool PERM = true, AFTER_DRAIN = false, CARRY = false;
    bf16_t* H; const PG8_LAS float* rst; const PG8_LAS int* pml; const float* ssq;
    __device__ __forceinline__ void operator()(const f32x4 (&acc)[2][2][4][2], const Unit& u, int wr, int wc, int fr, int fq) const {
        const int row0 = u.pm * BM + wr * 64 + fr, col0 = u.pn * 128 + wc * 32 + 8 * fq;
        float rsv[8]; row_rs8_lds(rst, pml, ssq, u.pm, wr, fr, rsv);
#pragma unroll
        for (int ai = 0; ai < 2; ++ai)
#pragma unroll
            for (int m = 0; m < 4; ++m) {
                const int row = row0 + ai * HALF + m * 16; const float rs = rsv[ai * 4 + m];
                const float c1 = rs * -1.4426950408889634f, rs2 = rs * rs;
                u32x4 w;
#pragma unroll
                for (int n = 0; n < 2; ++n) {
                    const f32x4 na = acc[ai][0][m][n] * c1, p = acc[ai][0][m][n] * acc[ai][1][m][n]; f32x4 d;
#pragma unroll
                    for (int e = 0; e < 4; ++e) d[e] = __builtin_amdgcn_rcpf(1.0f + __builtin_amdgcn_exp2f(na[e]));
                    const f32x4 h = p * (d * rs2);
                    w[2 * n] = cvt_pk_bf16(h[0], h[1]); w[2 * n + 1] = cvt_pk_bf16(h[2], h[3]);
                }
                *(u32x4*)(H + (size_t)row * 2816 + col0) = w;
            }
    }
};
__device__ __forceinline__ void unpack8(const u32x4 w, f32x4& lo, f32x4& hi) {
    lo[0] = __uint_as_float(w.x << 16); lo[1] = __uint_as_float(w.x & 0xffff0000u); lo[2] = __uint_as_float(w.y << 16); lo[3] = __uint_as_float(w.y & 0xffff0000u);
    hi[0] = __uint_as_float(w.z << 16); hi[1] = __uint_as_float(w.z & 0xffff0000u); hi[2] = __uint_as_float(w.w << 16); hi[3] = __uint_as_float(w.w & 0xffff0000u);
}
struct EpiRes {
    static constexpr bool PERM = true, AFTER_DRAIN = false, CARRY = false;
    bf16_t* XB; float* ssq; float alpha;
    __device__ __forceinline__ void operator()(const f32x4 (&acc)[2][2][4][2], const Unit& u, int wr, int wc, int fr, int fq) const {
        const int row0 = u.pm * BM + wr * 64 + fr, col0 = u.pn * BM + wc * 32 + 8 * fq;
#pragma unroll
        for (int ai = 0; ai < 2; ++ai) {
            u32x4 xin[4][2];
#pragma unroll
            for (int m = 0; m < 4; ++m)
#pragma unroll
                for (int bj = 0; bj < 2; ++bj) xin[m][bj] = *(const u32x4*)(XB + (size_t)(row0 + ai * HALF + m * 16) * 1024 + col0 + bj * HALF);
#pragma unroll
            for (int m = 0; m < 4; ++m) {
                const int row = row0 + ai * HALF + m * 16; float ss = 0.f;
#pragma unroll
                for (int bj = 0; bj < 2; ++bj) {
                    bf16_t* xp = XB + (size_t)row * 1024 + col0 + bj * HALF;
                    f32x4 x0, x1; unpack8(xin[m][bj], x0, x1);
                    x0 = x0 + acc[ai][bj][m][0] * alpha; x1 = x1 + acc[ai][bj][m][1] * alpha;
                    u32x4 w; w.x = cvt_pk_bf16(x0[0], x0[1]); w.y = cvt_pk_bf16(x0[2], x0[3]); w.z = cvt_pk_bf16(x1[0], x1[1]); w.w = cvt_pk_bf16(x1[2], x1[3]);
                    *(u32x4*)xp = w;
                    ss += ((x0[0] * x0[0] + x0[1] * x0[1]) + (x0[2] * x0[2] + x0[3] * x0[3])) + ((x1[0] * x1[0] + x1[1] * x1[1]) + (x1[2] * x1[2] + x1[3] * x1[3]));
                }
                ss += __shfl_xor(ss, 16); ss += __shfl_xor(ss, 32);
                if (fq == 0) ssq[(size_t)row * 16 + u.pn * 4 + wc] = ss;
            }
            asm volatile("" ::: "memory");
        }
    }
};
struct M1Order {
    StaticOrder so; int second, G, c;
    __device__ void init(int G_, int c_, int second_) { second = second_; G = G_; c = c_; so.init(16384, second_ ? 8192 : 8704, G_, c_); }
    __device__ bool next(int i, Unit& u) const {
        if (!second) { if (so.next(i, u)) return true;
            const long L = (long)i * G + c - 2176; if (L < 0 || L >= 128) return false; u.pm = 64 + (int)(L >> 1); u.pn = 22 + (int)(L & 1); return true; }
        Unit b; if (!so.next(i, b)) return false; u.pm = b.pm + 64; u.pn = b.pn < 22 ? b.pn : b.pn + 2; return true;
    }
    __device__ __forceinline__ void a_ready(const Unit&) const {}
    __device__ __forceinline__ void done(const Unit&) const {}
};
struct EpiProj {
    static constexpr bool PERM = true, AFTER_DRAIN = false, CARRY = false;
    bf16_t* PA; unsigned char* PGa; unsigned char* PGb; const PG8_LAS float* rst; const PG8_LAS int* pml; const float* ssq;
    __device__ __forceinline__ void operator()(const f32x4 (&acc)[2][2][4][2], const Unit& u, int wr, int wc, int fr, int fq) const {
        unsigned char* PG8 = u.pm < 64 ? PGa : PGb;
        const int prow0 = u.pm * BM + wr * 64 + fr, row0 = prow0 & 16383;
        float rsv[8]; row_rs8_lds(rst, pml, ssq, u.pm, wr, fr, rsv);
        if (u.pn < 22) {
            const int col0 = u.pn * BM + wc * 32 + 8 * fq;
#pragma unroll
            for (int ai = 0; ai < 2; ++ai)
#pragma unroll
                for (int m = 0; m < 4; ++m) {
                    const int row = row0 + ai * HALF + m * 16; const float rs = rsv[ai * 4 + m];
#pragma unroll
                    for (int bj = 0; bj < 2; ++bj) {
                        const f32x4 v0 = acc[ai][bj][m][0] * rs, v1 = acc[ai][bj][m][1] * rs;
                        u32x4 w; w.x = cvt_pk_bf16(v0[0], v0[1]); w.y = cvt_pk_bf16(v0[2], v0[3]); w.z = cvt_pk_bf16(v1[0], v1[1]); w.w = cvt_pk_bf16(v1[2], v1[3]);
                        *(u32x4*)(PA + (size_t)row * 5632 + col0 + bj * HALF) = w;
                    }
                }
        } else {
            const int col0 = (u.pn - 22) * BM + wc * 32 + 8 * fq;
#pragma unroll
            for (int ai = 0; ai < 2; ++ai)
#pragma unroll
                for (int m = 0; m < 4; ++m) {
                    const int row = row0 + ai * HALF + m * 16; const float rs = rsv[ai * 4 + m];
#pragma unroll
                    for (int bj = 0; bj < 2; ++bj) {
                        unsigned q[8];
#pragma unroll
                        for (int e = 0; e < 4; ++e) { q[e] = (unsigned)(sigm(acc[ai][bj][m][0][e] * rs) * 255.0f + 0.5f); q[4 + e] = (unsigned)(sigm(acc[ai][bj][m][1][e] * rs) * 255.0f + 0.5f); }
                        typedef unsigned u32x2_ __attribute__((ext_vector_type(2)));
                        u32x2_ w; w.x = q[0] | (q[1] << 8) | (q[2] << 16) | (q[3] << 24); w.y = q[4] | (q[5] << 8) | (q[6] << 16) | (q[7] << 24);
                        *(u32x2_*)(PG8 + (size_t)row * 3072 + col0 + bj * HALF) = w;
                    }
                }
        }
    }
};
struct MergeOrder {
    StaticOrder so;
    __device__ void init(int M, int N, int G_, int c_) { so.init(M, N, G_, c_); }
    __device__ bool next(int i, Unit& u) const { Unit b; if (!so.next(i / 3, b)) return false; const int m = i % 3, w = (m == 0) ? 2 : m - 1; u.pm = b.pm + 64 * m; u.pn = b.pn + 4 * w; return true; }
    __device__ __forceinline__ void a_ready(const Unit&) const {}
    __device__ __forceinline__ void done(const Unit&) const {}
};
struct EpiMerge {
    static constexpr bool PERM = true, AFTER_DRAIN = false, CARRY = true;
    const unsigned char* PG8; bf16_t* MB;
    __device__ __forceinline__ void operator()(const f32x4 (&)[2][2][4][2], const Unit&, int, int, int, int) const {}
    __device__ __forceinline__ bool carry(f32x4 (&acc)[2][2][4][2], const Unit& u, int wr, int wc, int fr, int fq) const {
        typedef unsigned u32x2_ __attribute__((ext_vector_type(2)));
        const int m_ = u.pm >> 6, pm = u.pm & 63, w_ = u.pn >> 2, pn = u.pn & 3;
        const int wn = (m_ == 0) ? 0 : 1;
        const bool last = (m_ == 2);
        const int row0 = pm * BM + wr * 64 + fr, col0 = pn * BM + wc * 32 + 8 * fq;
#pragma unroll
        for (int ai = 0; ai < 2; ++ai) {
            u32x2_ gc[4][2], gn[4][2];
#pragma unroll
            for (int m = 0; m < 4; ++m)
#pragma unroll
                for (int bj = 0; bj < 2; ++bj) { const size_t o = (size_t)(row0 + ai * HALF + m * 16) * 3072 + col0 + bj * HALF;
                    gc[m][bj] = *(const u32x2_*)(PG8 + o + w_ * 1024);
                    gn[m][bj] = last ? (u32x2_){0x01010101u, 0x01010101u} : *(const u32x2_*)(PG8 + o + wn * 1024); }
#pragma unroll
            for (int m = 0; m < 4; ++m)
#pragma unroll
                for (int bj = 0; bj < 2; ++bj) {
                    float f[8];
#pragma unroll
                    for (int e = 0; e < 8; ++e) { const unsigned wc_ = e < 4 ? gc[m][bj].x : gc[m][bj].y, wn_ = e < 4 ? gn[m][bj].x : gn[m][bj].y; const int sh = 8 * (e & 3);
                        const float qc = (float)max((wc_ >> sh) & 255u, 1u), qn = (float)max((wn_ >> sh) & 255u, 1u);
                        f[e] = last ? qc * (1.0f / 255.0f) : qc * __builtin_amdgcn_rcpf(qn); }
#pragma unroll
                    for (int e = 0; e < 4; ++e) { acc[ai][bj][m][0][e] *= f[e]; acc[ai][bj][m][1][e] *= f[4 + e]; }
                    if (last) { const f32x4 t0 = acc[ai][bj][m][0], t1 = acc[ai][bj][m][1];
                        u32x4 w; w.x = cvt_pk_bf16(t0[0], t0[1]); w.y = cvt_pk_bf16(t0[2], t0[3]); w.z = cvt_pk_bf16(t1[0], t1[1]); w.w = cvt_pk_bf16(t1[2], t1[3]);
                        *(u32x4*)(MB + (size_t)(row0 + ai * HALF + m * 16) * 1024 + col0 + bj * HALF) = w; }
                }
            asm volatile("" ::: "memory");
        }
        return !last;
    }
};
template <class Epi, class Sched, bool ALIGN_EPI = false, bool SP2 = false>
__device__ __forceinline__ void gemm_phase(PG8_LAS unsigned char* lds, const Gemm g, const Sched& S, const Epi& E) {
    int tid = threadIdx.x; asm volatile("" : "+v"(tid));
    const int wid = __builtin_amdgcn_readfirstlane(tid >> 6), lane = tid & 63, wr = wid >> 2, wc = wid & 3, fr = lane & 15, fq = lane >> 4;
    const int K = g.K, nt = K / BK;
    unsigned voffA[2], voffB[2];
#pragma unroll
    for (int i = 0; i < 2; ++i) { int R, C; stage_rc(tid * 16 + i * 8192, R, C); const int Rb = Epi::PERM ? ((R & ~31) + perm32(R & 31)) : R;
        voffA[i] = (unsigned)(R * K + C) * 2u; voffB[i] = (unsigned)(Rb * K + C) * 2u; }
    const size_t kstep = (size_t)(BK * 2);
    const size_t hstep = (size_t)HALF * K * 2;
    const size_t tstep = 2 * hstep;
    const unsigned ldsw = (unsigned)wid * 1024u;
    const int aoff = lds_byte(wr * 64 + fr, fq * 8), boff = lds_byte(wc * 32 + fr, fq * 8);
#define PG8_SA(b, h) (((b) * 2 + (h)) * HTB)
#define PG8_SB(b, h) ((4 + (b) * 2 + (h)) * HTB)
#define PG8_STAGE(bufoff, gbase, voff) do { _Pragma("unroll") for (int _i = 0; _i < 2; ++_i) \
        __builtin_amdgcn_global_load_lds((const unsigned*)((const char*)(gbase) + (voff)[_i]), (PG8_LAS unsigned*)(lds + (bufoff) + ldsw + _i * 8192), 16, 0, 0); } while (0)
#define PG8_LDA(dst, b, h) do { _Pragma("unroll") for (int m = 0; m < 4; ++m) _Pragma("unroll") for (int k = 0; k < 2; ++k) dst[m][k] = *(const PG8_LAS bf16x8*)(lds + PG8_SA(b, h) + aoff + m * 2048 + k * 1024); } while (0)
#define PG8_LDB(dst, b, h) do { _Pragma("unroll") for (int n = 0; n < 2; ++n) _Pragma("unroll") for (int k = 0; k < 2; ++k) dst[n][k] = *(const PG8_LAS bf16x8*)(lds + PG8_SB(b, h) + boff + n * 2048 + k * 1024); } while (0)
#define PG8_MMA(ai, bj, At, Bt) do { __builtin_amdgcn_s_setprio(1); _Pragma("unroll") for (int m = 0; m < 4; ++m) _Pragma("unroll") for (int n = 0; n < 2; ++n) _Pragma("unroll") for (int k = 0; k < 2; ++k) \
        acc[ai][bj][m][n] = __builtin_amdgcn_mfma_f32_16x16x32_bf16(Bt[n][k], At[m][k], acc[ai][bj][m][n], 0, 0, 0); __builtin_amdgcn_s_setprio(0); } while (0)
#define PG8_WAIT_V(n) asm volatile("s_waitcnt vmcnt(" #n ")" ::: "memory")
#define PG8_WAIT_L(n) asm volatile("s_waitcnt lgkmcnt(" #n ")" ::: "memory")
#define PG8_BAR __builtin_amdgcn_s_barrier()
#define PG8_SCHED __builtin_amdgcn_sched_barrier(0)
    Unit cur, nxt; int ui = 0;
    if (!S.next(0, cur)) return;
    f32x4 acc[2][2][4][2];
#pragma unroll
    for (int a = 0; a < 2; ++a)
#pragma unroll
        for (int b = 0; b < 2; ++b)
#pragma unroll
            for (int m = 0; m < 4; ++m)
#pragma unroll
                for (int n = 0; n < 2; ++n) acc[a][b][m][n] = (f32x4){0.f, 0.f, 0.f, 0.f};
    bf16x8 At[4][2], B0[2][2], B1[2][2];
    const char* cA = (const char*)g.A + (size_t)cur.pm * tstep; const char* cB = (const char*)g.Bt + (size_t)cur.pn * tstep;
    S.a_ready(cur);
    if constexpr (SP2) {
        PG8_STAGE(PG8_SB(0, 0), cB, voffB); PG8_STAGE(PG8_SB(0, 1), cB + hstep, voffB); PG8_STAGE(PG8_SA(0, 0), cA, voffA); PG8_STAGE(PG8_SA(0, 1), cA + hstep, voffA);
        if (wr == 1) PG8_BAR;
        PG8_WAIT_V(2); PG8_BAR;
        PG8_STAGE(PG8_SB(1, 0), cB + kstep, voffB); PG8_STAGE(PG8_SA(1, 0), cA + kstep, voffA); PG8_STAGE(PG8_SB(1, 1), cB + hstep + kstep, voffB);
        PG8_WAIT_V(6); PG8_BAR;
    } else {
        PG8_STAGE(PG8_SB(0, 0), cB, voffB); PG8_STAGE(PG8_SA(0, 0), cA, voffA); PG8_STAGE(PG8_SB(0, 1), cB + hstep, voffB); PG8_STAGE(PG8_SA(0, 1), cA + hstep, voffA);
        if (wr == 1) PG8_BAR;
        PG8_WAIT_V(4); PG8_BAR;
        PG8_STAGE(PG8_SB(1, 0), cB + kstep, voffB); PG8_STAGE(PG8_SA(1, 0), cA + kstep, voffA); PG8_STAGE(PG8_SB(1, 1), cB + hstep + kstep, voffB);
        PG8_WAIT_V(6); PG8_BAR;
    }
    for (;;) {
        const bool has_next = S.next(ui + 1, nxt);
        const char* nA = has_next ? (const char*)g.A + (size_t)nxt.pm * tstep : cA; const char* nB = has_next ? (const char*)g.Bt + (size_t)nxt.pn * tstep : cB;
        for (int t = 0; t < nt; t += 2) {
            const bool last = (t == nt - 2);
            const char* a1 = cA + (size_t)(t + 1) * kstep;
            const char* a2 = last ? nA : cA + (size_t)(t + 2) * kstep; const char* b2 = last ? nB : cB + (size_t)(t + 2) * kstep;
            const char* a3 = a2 + kstep; const char* b3 = b2 + kstep;
            if (last && has_next) S.a_ready(nxt);
            if constexpr (SP2) {
            PG8_LDB(B0, 0, 0); PG8_LDB(B1, 0, 1); PG8_SCHED; PG8_LDA(At, 0, 0); PG8_STAGE(PG8_SA(1, 1), a1 + hstep, voffA);
            PG8_WAIT_V(8); PG8_WAIT_L(0); PG8_BAR; PG8_MMA(0, 0, At, B0); PG8_MMA(0, 1, At, B1); PG8_BAR; PG8_SCHED;
            PG8_LDA(At, 0, 1); PG8_STAGE(PG8_SB(0, 0), b2, voffB); PG8_STAGE(PG8_SB(0, 1), b2 + hstep, voffB); PG8_STAGE(PG8_SA(0, 0), a2, voffA);
            PG8_WAIT_V(8); PG8_WAIT_L(0); PG8_BAR; PG8_MMA(1, 0, At, B0); PG8_MMA(1, 1, At, B1); PG8_BAR; PG8_SCHED;
            PG8_LDB(B0, 1, 0); PG8_LDB(B1, 1, 1); PG8_SCHED; PG8_LDA(At, 1, 0); PG8_STAGE(PG8_SA(0, 1), a2 + hstep, voffA);
            PG8_WAIT_V(8); PG8_WAIT_L(0); PG8_BAR; PG8_MMA(0, 0, At, B0); PG8_MMA(0, 1, At, B1); PG8_BAR; PG8_SCHED;
            PG8_LDA(At, 1, 1); PG8_STAGE(PG8_SB(1, 0), b3, voffB); PG8_STAGE(PG8_SB(1, 1), b3 + hstep, voffB); PG8_STAGE(PG8_SA(1, 0), a3, voffA);
            PG8_WAIT_V(8); PG8_WAIT_L(0); PG8_BAR; PG8_MMA(1, 0, At, B0); PG8_MMA(1, 1, At, B1); PG8_BAR; PG8_SCHED;
            } else {
            PG8_LDB(B0, 0, 0); PG8_SCHED; PG8_LDA(At, 0, 0); PG8_STAGE(PG8_SA(1, 1), a1 + hstep, voffA);
            PG8_WAIT_L(8); PG8_BAR; PG8_WAIT_L(0); PG8_MMA(0, 0, At, B0); PG8_BAR; PG8_SCHED;
            PG8_LDB(B1, 0, 1); PG8_STAGE(PG8_SB(0, 0), b2, voffB);
            PG8_BAR; PG8_WAIT_L(0); PG8_MMA(0, 1, At, B1); PG8_BAR;
            PG8_LDA(At, 0, 1); PG8_STAGE(PG8_SA(0, 0), a2, voffA);
            PG8_BAR; PG8_WAIT_L(0); PG8_MMA(1, 0, At, B0); PG8_BAR; PG8_SCHED;
            PG8_STAGE(PG8_SB(0, 1), b2 + hstep, voffB);
            PG8_WAIT_V(6); PG8_BAR; PG8_MMA(1, 1, At, B1); PG8_BAR;
            PG8_LDB(B0, 1, 0); PG8_SCHED; PG8_LDA(At, 1, 0); PG8_STAGE(PG8_SA(0, 1), a2 + hstep, voffA);
            PG8_WAIT_L(8); PG8_BAR; PG8_WAIT_L(0); PG8_MMA(0, 0, At, B0); PG8_BAR; PG8_SCHED;
            PG8_LDB(B1, 1, 1); PG8_STAGE(PG8_SB(1, 0), b3, voffB);
            PG8_BAR; PG8_WAIT_L(0); PG8_MMA(0, 1, At, B1); PG8_BAR;
            PG8_LDA(At, 1, 1); PG8_STAGE(PG8_SA(1, 0), a3, voffA);
            PG8_BAR; PG8_WAIT_L(0); PG8_MMA(1, 0, At, B0); PG8_BAR; PG8_SCHED;
            PG8_STAGE(PG8_SB(1, 1), b3 + hstep, voffB);
            PG8_WAIT_V(6); PG8_BAR; PG8_MMA(1, 1, At, B1); PG8_BAR;
            }
        }
        if constexpr (ALIGN_EPI) { if (wr == 0) PG8_BAR; }
        bool keep = false;
        if constexpr (Epi::CARRY) { keep = E.carry(acc, cur, wr, wc, fr, fq); S.done(cur); }
        else if constexpr (!Epi::AFTER_DRAIN) { E(acc, cur, wr, wc, fr, fq); S.done(cur); }
        if (!has_next) break;
        if (!keep) {
#pragma unroll
        for (int a = 0; a < 2; ++a)
#pragma unroll
            for (int b = 0; b < 2; ++b)
#pragma unroll
                for (int m = 0; m < 4; ++m)
#pragma unroll
                    for (int n = 0; n < 2; ++n) acc[a][b][m][n] = (f32x4){0.f, 0.f, 0.f, 0.f};
        }
        cur = nxt; cA = nA; cB = nB; ++ui;
        if constexpr (ALIGN_EPI) { if (wr == 1) PG8_BAR; }
    }
    PG8_WAIT_V(0);
    if constexpr (!ALIGN_EPI) { if (wr == 0) PG8_BAR; }
    PG8_BAR;
    if constexpr (Epi::AFTER_DRAIN) { E.fused(acc, cur, wr, wc, fr, fq, lds, wid, lane); S.done(cur); }
#undef PG8_SA
#undef PG8_SB
#undef PG8_STAGE
#undef PG8_LDA
#undef PG8_LDB
#undef PG8_MMA
#undef PG8_WAIT_V
#undef PG8_WAIT_L
#undef PG8_BAR
#undef PG8_SCHED
}
}
#define LAS __attribute__((address_space(3)))
typedef unsigned short bf16;
typedef unsigned v4u __attribute__((ext_vector_type(4)));
typedef unsigned v2u __attribute__((ext_vector_type(2)));
typedef short v4i16_t __attribute__((ext_vector_type(4)));
using pg8::f32x4; using pg8::bf16x8; using pg8::cvt_pk_bf16;

constexpr int D = 1024, FF = 2816, NLAYER = 4, TG = 16384, NGROUP = 4, NTHR = 512, NWAVES = 8;
constexpr int PA_LD = 5632, PG_LD = 3072;
constexpr int C_HQ = 0, C_HI = 512, C_HZF = 1024, C_HZB = 1536, C_HG = 2048, C_CA = 2560, C_CB = 3072, C_CC = 3584, C_NQ = 4096, C_NK = 4608, C_NV = 5120;
constexpr size_t MiB = 1u << 20;
constexpr size_t WS_CTL = 0, CTL_BYTES = 1 * MiB, WS_W = 1 * MiB, WS_XB = 221 * MiB, WS_SSQ = 285 * MiB, WS_PA = 287 * MiB, WS_PG = 463 * MiB, WS_ONA = 559 * MiB, WS_SCR = 575 * MiB, WS_END = 671 * MiB;
constexpr size_t OFF_GU1 = 0, OFF_D1 = 5767168, OFF_IN = 8650752, OFF_HG = 17563648, OFF_CV = 18087936, OFF_NA = 18612224, OFF_OUT = 19136512, OFF_GU2 = 20185088, OFF_D2 = 25952256, LAYER_EL = 28835840;
constexpr int LDS_BYTES = 147456, LDS_MISC = 147456 - 64;
constexpr int PH_PER_PAIR = 1 + NLAYER * 16 + 1;
constexpr int CW_BAR = 4096;

__device__ __forceinline__ unsigned f2bf(float f) { unsigned u = __float_as_uint(f); return (u + 0x7fffu + ((u >> 16) & 1u)) >> 16; }
__device__ __forceinline__ float bf2f(unsigned b) { return __uint_as_float(b << 16); }
__device__ __forceinline__ float bflo(unsigned w) { return __uint_as_float(w << 16); }
__device__ __forceinline__ float bfhi(unsigned w) { return __uint_as_float(w & 0xffff0000u); }
__device__ __forceinline__ float sigm(float v) { return __builtin_amdgcn_rcpf(1.0f + __expf(-v)); }
__device__ __forceinline__ float wave_sum(float v) {
#pragma unroll
    for (int o = 1; o < 64; o <<= 1) v += __shfl_xor(v, o);
    return v;
}

__device__ __forceinline__ void cvt_item(const float* W, int K, int N, bf16* WT, const float* gain, bool permgu, LAS float* scr, int item, int lane) {
    const int nblk = N / 32, kb = item / nblk, nb = item % nblk, k0 = 64 * kb, n0 = 32 * nb;
#pragma unroll
    for (int i = 0; i < 32; ++i) { const int kk = 2 * i + (lane >> 5); const float g = gain ? gain[k0 + kk] : 1.0f; scr[kk * 33 + (lane & 31)] = W[(size_t)(k0 + kk) * N + n0 + (lane & 31)] * g; }
    asm volatile("s_waitcnt lgkmcnt(0)" ::: "memory");
    int dn0 = n0;
    if (permgu) { const int half = n0 >= FF ? 1 : 0; const int j = n0 - half * FF; dn0 = (j >> 7) * 256 + half * 128 + (j & 127); }
    const int c = lane & 7;
#pragma unroll
    for (int j = 0; j < 4; ++j) { const int n = (lane >> 3) + 8 * j; const LAS float* s = scr + (8 * c) * 33 + n;
        v4u o; o.x = cvt_pk_bf16(s[0 * 33], s[1 * 33]); o.y = cvt_pk_bf16(s[2 * 33], s[3 * 33]); o.z = cvt_pk_bf16(s[4 * 33], s[5 * 33]); o.w = cvt_pk_bf16(s[6 * 33], s[7 * 33]);
        *(v4u*)(WT + (size_t)(dn0 + n) * K + k0 + 8 * c) = o; }
    asm volatile("s_waitcnt lgkmcnt(0)" ::: "memory");
}

template <int K> __device__ __forceinline__ f32x4 mma_lds(f32x4 acc, const LAS bf16* A, int pa, const LAS bf16* B, int pb, int lane) {
    const int r = lane & 15, q = lane >> 4;
#pragma unroll
    for (int ks = 0; ks < K / 32; ++ks) {
        const bf16x8 a = *(const LAS bf16x8*)(A + r * pa + ks * 32 + q * 8);
        const bf16x8 b = *(const LAS bf16x8*)(B + r * pb + ks * 32 + q * 8);
        acc = __builtin_amdgcn_mfma_f32_16x16x32_bf16(a, b, acc, 0, 0, 0);
    }
    return acc;
}

constexpr int HP_QT = 0, HP_KTT = 17408, HP_AM = 35840, HP_ER = 45056, HP_EE = 45568, HP_BLK = 49152;
constexpr int HP_KT = 49152, HP_SEG = 66560;
constexpr int HS_VT = 49152, HS_ST = 53760, HS_BUF = 62464;
__device__ __forceinline__ void hg_prep_items(LAS unsigned char* lds, const bf16* PA, unsigned char* SCR, const float* lb_logits, int layer, int item0, int istride, int nitems, int T, int tid) {
    const int lane = tid & 63, wave = __builtin_amdgcn_readfirstlane(tid >> 6), c16 = lane & 15, quad = lane >> 4;
    const int nchunk = T / 64;
    const int kp = tid & 63, ts = tid >> 6;
    LAS bf16* QT = (LAS bf16*)(lds + HP_QT); LAS bf16* KT = (LAS bf16*)(lds + HP_KT); LAS bf16* KTT = (LAS bf16*)(lds + HP_KTT); LAS bf16* AM = (LAS bf16*)(lds + HP_AM);
    LAS float* SEG = (LAS float*)(lds + HP_SEG); LAS float* ER = (LAS float*)(lds + HP_ER); LAS float* EE = (LAS float*)(lds + HP_EE);
    unsigned zz[8], qq[8];
#define HP_LOAD(it) do { const int it_ = min((it), nitems - 1); const int c_ = it_ % nchunk, sd_ = it_ / nchunk, dir_ = sd_ & 1, h_ = (sd_ >> 1) & 3, base_ = (sd_ >> 3) * T; \
        const bf16* zs = PA + (dir_ ? C_HZB : C_HZF) + h_ * 128 + 2 * kp; const bf16* qs = PA + C_HQ + h_ * 128 + 2 * kp; \
        _Pragma("unroll") for (int i = 0; i < 8; ++i) { const int tau = c_ * 64 + 8 * ts + i; const size_t ro = (size_t)(base_ + (dir_ ? (T - 1 - tau) : tau)) * PA_LD; zz[i] = *(const unsigned*)(zs + ro); qq[i] = *(const unsigned*)(qs + ro); } } while (0)
    HP_LOAD(item0);
    for (int item = item0; item < nitems; item += istride) {
        const int sd = item / nchunk, dir = sd & 1, h = (sd >> 1) & 3;
        float lb[2];
#pragma unroll
        for (int j = 0; j < 2; ++j) { float lg[4], mx = -3e38f;
#pragma unroll
          for (int l = 0; l < 4; ++l) { lg[l] = lb_logits[(dir * 4 + l) * 512 + h * 128 + 2 * kp + j]; mx = fmaxf(mx, lg[l]); }
          float tot = 0.f, num = 0.f;
#pragma unroll
          for (int l = 0; l < 4; ++l) { const float e = __expf(lg[l] - mx); tot += e; if (l >= 1 && l <= layer) num += e; }
          lb[j] = num / tot; }
        float b[2][8], kv[2][8], qv[2][8]; float cum[2] = {0.f, 0.f};
#pragma unroll
        for (int i = 0; i < 8; ++i)
#pragma unroll
            for (int j = 0; j < 2; ++j) { const float zf = j ? bfhi(zz[i]) : bflo(zz[i]); const float sg = sigm(zf); const float oml = 1.0f - lb[j]; const float f = lb[j] + oml * sg;
                cum[j] += __logf(fmaxf(f, 1e-30f)); b[j][i] = cum[j]; kv[j][i] = oml * (1.0f - sg); qv[j][i] = j ? bfhi(qq[i]) : bflo(qq[i]); }
        HP_LOAD(item + istride);
        SEG[ts * 128 + 2 * kp] = cum[0]; SEG[ts * 128 + 2 * kp + 1] = cum[1];
        __syncthreads();
        float pre[2], r[2], bend[2];
#pragma unroll
        for (int j = 0; j < 2; ++j) { float p = 0.f, rr = 0.f, be = 0.f;
#pragma unroll
            for (int q = 0; q < 8; ++q) { const float v = SEG[q * 128 + 2 * kp + j]; if (q < ts) p += v; if (q < 4) rr += v; be += v; }
            pre[j] = p; r[j] = rr; bend[j] = be; }
        unsigned kpk[2][4];
#pragma unroll
        for (int i = 0; i < 8; ++i) {
            unsigned qb[2], kb[2];
#pragma unroll
            for (int j = 0; j < 2; ++j) { const float bt = pre[j] + b[j][i];
                const float eq = __expf(fminf(bt - r[j], 80.f)), ek = __expf(fminf(r[j] - bt, 80.f));
                qb[j] = f2bf(qv[j][i] * eq); kb[j] = f2bf(kv[j][i] * ek);
                if (i & 1) kpk[j][i >> 1] |= kb[j] << 16; else kpk[j][i >> 1] = kb[j]; }
            const int tau = 8 * ts + i;
            *(LAS unsigned*)(QT + tau * 136 + 2 * kp) = qb[0] | (qb[1] << 16);
            *(LAS unsigned*)(KT + tau * 136 + 2 * kp) = kb[0] | (kb[1] << 16);
        }
#pragma unroll
        for (int j = 0; j < 2; ++j) *(LAS v4u*)(KTT + (2 * kp + j) * 72 + 8 * ts) = (v4u){kpk[j][0], kpk[j][1], kpk[j][2], kpk[j][3]};
        if (ts == 0) {
#pragma unroll
            for (int j = 0; j < 2; ++j) { ER[2 * kp + j] = __expf(r[j]); EE[2 * kp + j] = __expf(bend[j] - r[j]); } }
        __syncthreads();
#pragma unroll
        for (int e = 0; e < 2; ++e) { const int id = wave * 2 + e, tt = id >> 2, st = id & 3;
            f32x4 a = (f32x4){0.f, 0.f, 0.f, 0.f};
            if (st <= tt) a = mma_lds<128>(a, QT + tt * 16 * 136, 136, KT + st * 16 * 136, 136, lane);
#pragma unroll
            for (int i = 0; i < 4; ++i) { const int t = tt * 16 + quad * 4 + i, s = st * 16 + c16; const float val = (st <= tt && s <= t) ? a[i] : 0.f; AM[t * 72 + s] = (bf16)f2bf(val); } }
        __syncthreads();
        unsigned char* dst = SCR + (size_t)item * HP_BLK;
#pragma unroll
        for (int j = 0; j < 6; ++j) { const int idx = tid + 512 * j; *(v4u*)(dst + (size_t)idx * 16) = *(const LAS v4u*)(lds + idx * 16); }
        __syncthreads();
    }
#undef HP_LOAD
}

template <int NVT> __device__ __forceinline__ void hg_scan_item(LAS unsigned char* lds, bf16* PA, const unsigned char* SCR, int item, int T, int tid) {
    constexpr int NVS = 8 / NVT, VW = 16 * NVT, VTHR = 128 * NVT, VSH = (NVT == 2) ? 2 : 1;
    const int lane = tid & 63, wave = __builtin_amdgcn_readfirstlane(tid >> 6), c16 = lane & 15, quad = lane >> 4;
    const int vs = item % NVS, sd = item / NVS, dir = sd & 1, h = (sd >> 1) & 3, seq = sd >> 3;
    const int base = seq * T, nchunk = T / 64;
    const unsigned char* blk = SCR + (size_t)sd * nchunk * HP_BLK;
    const bf16* vsrc = PA + C_HI + h * 128 + vs * VW + (tid & (VW / 8 - 1)) * 8;
    bf16* odst = PA + (dir ? C_HZF : C_HQ) + h * 128 + vs * VW;
    v4u preA[6], preB[6]; v4u vrA = {0u, 0u, 0u, 0u}, vrB = vrA; f32x4 ervA, eevA, ervB, eevB;
#define HG_ROW(tau) (base + (dir ? (T - 1 - (tau)) : (tau)))
#define HS_LOAD(c, pre, vr, erv, eev) do { const int c_ = min((c), nchunk - 1); const unsigned char* bp = blk + (size_t)c_ * HP_BLK;     \
        _Pragma("unroll") for (int j = 0; j < 6; ++j) pre[j] = *(const v4u*)(bp + (size_t)(tid + 512 * j) * 16); \
        erv = *(const f32x4*)(bp + HP_ER + (wave * 16 + quad * 4) * 4); eev = *(const f32x4*)(blk + (size_t)max(c_ - 1, 0) * HP_BLK + HP_EE + (wave * 16 + quad * 4) * 4);     \
        vr = *(const v4u*)(vsrc + (size_t)HG_ROW(c_ * 64 + ((tid & (VTHR - 1)) >> VSH)) * PA_LD); } while (0)
    HS_LOAD(0, preA, vrA, ervA, eevA);
    HS_LOAD(1, preB, vrB, ervB, eevB);
    f32x4 accS[NVT];
#pragma unroll
    for (int e = 0; e < NVT; ++e) accS[e] = (f32x4){0.f, 0.f, 0.f, 0.f};
#define HS_STEP(c, BUFI, pre, vr, erv, eev) do { \
        LAS unsigned char* B = lds + (BUFI) * HS_BUF; \
        LAS bf16* QT = (LAS bf16*)(B + HP_QT); LAS bf16* KTT = (LAS bf16*)(B + HP_KTT); LAS bf16* AM = (LAS bf16*)(B + HP_AM); \
        LAS bf16* VT = (LAS bf16*)(B + HS_VT); LAS bf16* STt = (LAS bf16*)(B + HS_ST); \
        _Pragma("unroll") for (int j = 0; j < 6; ++j) *(LAS v4u*)(B + (tid + 512 * j) * 16) = pre[j]; \
        if (tid < VTHR) { const int s_ = tid >> VSH, vq = tid & (VW / 8 - 1); \
            VT[(vq * 8 + 0) * 72 + s_] = (bf16)(vr.x & 0xffffu); VT[(vq * 8 + 1) * 72 + s_] = (bf16)(vr.x >> 16); \
            VT[(vq * 8 + 2) * 72 + s_] = (bf16)(vr.y & 0xffffu); VT[(vq * 8 + 3) * 72 + s_] = (bf16)(vr.y >> 16); \
            VT[(vq * 8 + 4) * 72 + s_] = (bf16)(vr.z & 0xffffu); VT[(vq * 8 + 5) * 72 + s_] = (bf16)(vr.z >> 16); \
            VT[(vq * 8 + 6) * 72 + s_] = (bf16)(vr.w & 0xffffu); VT[(vq * 8 + 7) * 72 + s_] = (bf16)(vr.w >> 16); } \
        f32x4 sp[NVT]; const f32x4 sc_ = erv * eev;     \
        _Pragma("unroll") for (int e = 0; e < NVT; ++e) { sp[e] = accS[e] * sc_; v2u w; w.x = cvt_pk_bf16(sp[e][0], sp[e][1]); w.y = cvt_pk_bf16(sp[e][2], sp[e][3]); \
            *(LAS v2u*)(STt + (e * 16 + c16) * 136 + wave * 16 + quad * 4) = w; } \
        HS_LOAD((c) + 2, pre, vr, erv, eev); \
        __syncthreads(); \
        if ((wave >> 2) < NVT) { const int tt = wave & 3, vt = wave >> 2; f32x4 o = (f32x4){0.f, 0.f, 0.f, 0.f}; \
          o = mma_lds<128>(o, QT + tt * 16 * 136, 136, STt + vt * 16 * 136, 136, lane); \
          o = mma_lds<64>(o, AM + tt * 16 * 72, 72, VT + vt * 16 * 72, 72, lane); \
          _Pragma("unroll") for (int i = 0; i < 4; ++i) { const int tau = (c) * 64 + tt * 16 + quad * 4 + i; odst[(size_t)HG_ROW(tau) * PA_LD + vt * 16 + c16] = (bf16)f2bf(o[i]); } } \
        _Pragma("unroll") for (int e = 0; e < NVT; ++e) { accS[e] = mma_lds<64>(sp[e], KTT + wave * 16 * 72, 72, VT + e * 16 * 72, 72, lane); } \
    } while (0)
    for (int c = 0; c < nchunk; c += 2) {
        HS_STEP(c, 0, preA, vrA, ervA, eevA);
        HS_STEP(c + 1, 1, preB, vrB, ervB, eevB);
    }
    __syncthreads();
#undef HG_ROW
#undef HS_LOAD
#undef HS_STEP
}

__device__ __forceinline__ void na_item(LAS unsigned char* lds, const bf16* PA, const float* rpb, bf16* ONA, int item, int T, int tid) {
    const int lane = tid & 63, h = __builtin_amdgcn_readfirstlane(tid >> 6), c16 = lane & 15, quad = lane >> 4;
    const int ips = T / 16, seq = item / ips, rem = item % ips, r = rem >> 2, j = rem & 3;
    const int rows = T / 64, rs = min(max(r - 4, 0), rows - 8), kstart = (j == 0) ? 0 : (j == 1) ? 8 : (j == 2) ? 24 : 32;
    const int base = seq * T, qtok = base + r * 64 + 16 * j + c16;
    const bf16* qp = PA + (size_t)qtok * PA_LD + C_NQ + h * 64 + quad * 8;
    const bf16x8 Qb0 = *(const bf16x8*)qp, Qb1 = *(const bf16x8*)(qp + 32);
    const int qcol = 16 * j + c16, cs = min(max(qcol - 8, 0), 48);
    v4u vbufA[8], vbufB[8], vbufC[8], vbufD[8];
#define NA_VLOAD(qd, vbuf) do { _Pragma("unroll") for (int it = 0; it < 8; ++it) { const int idx = it * 64 + lane, key = idx >> 3, dg = idx & 7; \
        const int tok = base + (rs + 2 * (qd) + (key >> 5)) * 64 + kstart + (key & 31); vbuf[it] = *(const v4u*)(PA + (size_t)tok * PA_LD + C_NV + h * 64 + dg * 8); } } while (0)
    NA_VLOAD(0, vbufA); NA_VLOAD(1, vbufB);
    const float* rp = rpb + h * 465;
    f32x4 sacc[16]; float mx = -3e38f;
    int dcv[8]; bool okv[8];
#pragma unroll
    for (int e = 0; e < 8; ++e) { const int kcol = kstart + (e >> 2) * 16 + quad * 4 + (e & 3); okv[e] = (kcol >= cs) && (kcol < cs + 16); dcv[e] = min(max(kcol - qcol + 15, 0), 30); }
#pragma unroll
    for (int a = 0; a < 8; ++a) {
        const float rowv = rp[(rs + a - r + 7) * 31 + min(lane, 30)];
        float bv[8];
#pragma unroll
        for (int e = 0; e < 8; ++e) bv[e] = __builtin_bit_cast(float, __builtin_amdgcn_ds_bpermute(dcv[e] << 2, __builtin_bit_cast(int, rowv)));
#pragma unroll
        for (int hh = 0; hh < 2; ++hh) {
            const int ktok = base + (rs + a) * 64 + kstart + hh * 16 + c16;
            const bf16* kp = PA + (size_t)ktok * PA_LD + C_NK + h * 64 + quad * 8;
            const bf16x8 Ka0 = *(const bf16x8*)kp, Ka1 = *(const bf16x8*)(kp + 32);
            f32x4 s = (f32x4){0.f, 0.f, 0.f, 0.f};
            s = __builtin_amdgcn_mfma_f32_16x16x32_bf16(Ka0, Qb0, s, 0, 0, 0);
            s = __builtin_amdgcn_mfma_f32_16x16x32_bf16(Ka1, Qb1, s, 0, 0, 0);
#pragma unroll
            for (int i = 0; i < 4; ++i) { const float val = okv[hh * 4 + i] ? s[i] * 0.125f + bv[hh * 4 + i] : -1e30f; s[i] = val; mx = fmaxf(mx, val); }
            sacc[a * 2 + hh] = s;
        }
    }
    NA_VLOAD(2, vbufC); NA_VLOAD(3, vbufD);
    mx = fmaxf(mx, __shfl_xor(mx, 16)); mx = fmaxf(mx, __shfl_xor(mx, 32));
    float sum = 0.f;
#pragma unroll
    for (int t = 0; t < 16; ++t)
#pragma unroll
        for (int i = 0; i < 4; ++i) { const float p = __expf(sacc[t][i] - mx); sacc[t][i] = p; sum += p; }
    sum += __shfl_xor(sum, 16); sum += __shfl_xor(sum, 32);
    bf16x8 pb[8];
#pragma unroll
    for (int a = 0; a < 8; ++a) { v4u w; w.x = cvt_pk_bf16(sacc[2 * a][0], sacc[2 * a][1]); w.y = cvt_pk_bf16(sacc[2 * a][2], sacc[2 * a][3]);
        w.z = cvt_pk_bf16(sacc[2 * a + 1][0], sacc[2 * a + 1][1]); w.w = cvt_pk_bf16(sacc[2 * a + 1][2], sacc[2 * a + 1][3]); pb[a] = __builtin_bit_cast(bf16x8, w); }
    LAS bf16* VS = (LAS bf16*)(lds + h * 10240);
    f32x4 oacc[4];
#pragma unroll
    for (int dt = 0; dt < 4; ++dt) oacc[dt] = (f32x4){0.f, 0.f, 0.f, 0.f};
    const int trq = (lane & 15) >> 2, trp = lane & 3;
    const LAS bf16* trbase = VS + (quad * 4 + trq) * 80 + 4 * trp;
#define NA_PV(qd, vbuf) do { \
        _Pragma("unroll") for (int it = 0; it < 8; ++it) { const int idx = it * 64 + lane, key = idx >> 3, dg = idx & 7; *(LAS v4u*)(VS + key * 80 + dg * 8) = vbuf[it]; } \
        _Pragma("unroll") for (int al = 0; al < 2; ++al) \
            _Pragma("unroll") for (int dt = 0; dt < 4; ++dt) { const LAS bf16* p = trbase + al * 32 * 80 + dt * 16; \
                const v4i16_t lo = __builtin_amdgcn_ds_read_tr16_b64_v4i16((LAS v4i16_t*)p), hi = __builtin_amdgcn_ds_read_tr16_b64_v4i16((LAS v4i16_t*)(p + 16 * 80)); \
                const bf16x8 af = {lo[0], lo[1], lo[2], lo[3], hi[0], hi[1], hi[2], hi[3]}; \
                oacc[dt] = __builtin_amdgcn_mfma_f32_16x16x32_bf16(af, pb[(qd) * 2 + al], oacc[dt], 0, 0, 0); } } while (0)
    NA_PV(0, vbufA); NA_PV(1, vbufB); NA_PV(2, vbufC); NA_PV(3, vbufD);
#undef NA_PV
#undef NA_VLOAD
    const float inv = __builtin_amdgcn_rcpf(sum);
#pragma unroll
    for (int dt = 0; dt < 4; ++dt) { const f32x4 o = oacc[dt] * inv; v2u w; w.x = cvt_pk_bf16(o[0], o[1]); w.y = cvt_pk_bf16(o[2], o[3]);
        *(v2u*)(ONA + (size_t)qtok * 512 + h * 64 + dt * 16 + quad * 4) = w; }
}

#define XB_TMO      128
#define XB_XCNT(j)  (256  + 64 * (j))
#define XB_XSUB(j)  (1280 + 64 * (j))
#define XB_XGEN(j)  (2304 + 64 * (j))
#define XB_TOP      3328
#define XB_TOPGEN   3392
#define XCD_BAR_WORDS 3456
#define XB_SPIN_CAP (1u << 18)

__device__ __forceinline__ unsigned xb_ld(unsigned* p)              { return __hip_atomic_load(p, __ATOMIC_RELAXED, __HIP_MEMORY_SCOPE_AGENT); }
__device__ __forceinline__ unsigned xb_add(unsigned* p, unsigned v) { return __hip_atomic_fetch_add(p, v, __ATOMIC_RELAXED, __HIP_MEMORY_SCOPE_AGENT); }
__device__ __forceinline__ unsigned xb_xcc_id() { return (unsigned)__builtin_amdgcn_s_getreg((3 << 11) | 20) & 0xFu; }
#define XB_SPIN(cond, bar) do { unsigned _sp = 0; while (cond) { __builtin_amdgcn_s_sleep(1); \
    if ((++_sp & 255u) == 0u) { if (xb_ld(&(bar)[XB_TMO])) break; if (_sp > XB_SPIN_CAP) { atomicAdd(&(bar)[XB_TMO], 1u); break; } } } } while (0)

struct XcdBarrier {
    unsigned* bar; unsigned x;
    volatile LAS unsigned* st;
};

__device__ __forceinline__ XcdBarrier xcd_barrier_post(unsigned* bar, volatile LAS unsigned* st) {
    XcdBarrier b; b.bar = bar; b.x = xb_xcc_id(); b.st = st;
    if (threadIdx.x == 0) (void)xb_add(&bar[XB_XCNT(b.x)], 1u);
    return b;
}
__device__ __forceinline__ void xcd_barrier_complete(unsigned* bar, unsigned x, unsigned& nloc, unsigned& nx) {
    const unsigned G = gridDim.x * gridDim.y * gridDim.z;
    unsigned sum, cnt, mine, sp = 0u;
    for (;;) {
        sum = 0u; cnt = 0u; mine = 0u;
#pragma unroll
        for (unsigned j = 0; j < 16; ++j) { const unsigned c = xb_ld(&bar[XB_XCNT(j)]); sum += c; cnt += (c > 0u) ? 1u : 0u; mine = (j == x) ? c : mine; }
        if (sum == G) break;
        __builtin_amdgcn_s_sleep(1);
        if ((++sp & 255u) == 0u) { if (xb_ld(&bar[XB_TMO])) break; if (sp > XB_SPIN_CAP) { atomicAdd(&bar[XB_TMO], 1u); break; } }
    }
    nloc = mine > 0u ? mine : 1u; nx = cnt > 0u ? cnt : 1u;
}

__device__ __forceinline__ void xcd_barrier(const XcdBarrier& b) {
    asm volatile("s_waitcnt vmcnt(0)" ::: "memory");
    __syncthreads();
    if (threadIdx.x == 0) {
        unsigned* bar = b.bar;
        __builtin_amdgcn_s_waitcnt(0);
        unsigned nloc = b.st[0], nx = b.st[1];
        if (nloc == 0u) { xcd_barrier_complete(bar, b.x, nloc, nx); b.st[0] = nloc; b.st[1] = nx; }
        const unsigned old = xb_add(&bar[XB_XSUB(b.x)], 1u);
        const unsigned gen = old / nloc;
        if (old + 1u == (gen + 1u) * nloc) {
            __builtin_amdgcn_fence(__ATOMIC_RELEASE, "agent");
            asm volatile("s_waitcnt vmcnt(0)" ::: "memory");
            const unsigned og = xb_add(&bar[XB_TOP], 1u);
            const unsigned tg = og / nx;
            if (og + 1u == (tg + 1u) * nx) xb_add(&bar[XB_TOPGEN], 1u);
            else XB_SPIN(xb_ld(&bar[XB_TOPGEN]) == tg, bar);
            __builtin_amdgcn_fence(__ATOMIC_ACQUIRE, "agent");
            xb_add(&bar[XB_XGEN(b.x)], 1u);
            asm volatile("s_waitcnt vmcnt(0)" ::: "memory");
        } else {
            XB_SPIN(xb_ld(&bar[XB_XGEN(b.x)]) == gen, bar);
            __builtin_amdgcn_fence(__ATOMIC_ACQUIRE, "agent");
            asm volatile("s_waitcnt vmcnt(0)" ::: "memory");
        }
    }
    __syncthreads();
}
struct Args { const float* in[20]; float* out; unsigned char* ws; int ph_lo, ph_hi; };
enum { K_CVT = 0, K_G0, K_UP, K_RES, K_M1, K_M2A, K_M2B, K_M3, K_M4, K_GF };

__global__ void __launch_bounds__(NTHR, 2) mk_fwd(Args args) {
    extern __shared__ __attribute__((aligned(16))) unsigned char lds_raw[];
    LAS unsigned char* lds = (LAS unsigned char*)lds_raw;
    cg::grid_group grid = cg::this_grid();
    const int hi = args.ph_hi;
    { volatile LAS unsigned* st0 = (volatile LAS unsigned*)(lds + LDS_MISC + 32); if (threadIdx.x < 2) st0[threadIdx.x] = 0u; __syncthreads(); }
    XcdBarrier xbar = xcd_barrier_post((unsigned*)(args.ws + WS_CTL) + CW_BAR, (volatile LAS unsigned*)(lds + LDS_MISC + 32));
#if TPROBE
    unsigned long long tacc = 0ull;
#endif
    for (int ph = args.ph_lo; ph < hi; ++ph) {
#if TPROBE
        const unsigned long long tp0 = __builtin_amdgcn_s_memrealtime();
#endif
        int bid = blockIdx.x, G = gridDim.x; asm volatile("" : "+s"(bid), "+s"(G));
        int tid = threadIdx.x; asm volatile("" : "+v"(tid));
        const int lane = tid & 63, wave = __builtin_amdgcn_readfirstlane(tid >> 6);
        const int gw = bid * NWAVES + wave, NGW = G * NWAVES;
        int kind, pr = 0, l = 0, s = 0, g2 = 0;
        if (ph == 0) kind = K_CVT;
        else { const int q = ph - 1; pr = q / PH_PER_PAIR; const int r = q % PH_PER_PAIR;
            if (r == 0) kind = K_G0; else if (r == PH_PER_PAIR - 1) kind = K_GF;
            else { l = (r - 1) / 16; s = (r - 1) % 16;
                if (s == 0 || s == 14) kind = K_UP; else if (s == 1 || s == 15) kind = K_RES;
                else { g2 = (s - 2) / 6; const int t = (s - 2) % 6; kind = (t == 0) ? K_M1 : (t == 1) ? K_M2A : (t == 2) ? K_M2B : (t == 3) ? K_M3 : (t == 4) ? K_M4 : K_RES; } } }
        const bool mix = (s >= 2 && s <= 13);
        unsigned char* ws = args.ws;
        bf16* XBp = (bf16*)(ws + WS_XB); float* SSQp = (float*)(ws + WS_SSQ);
        bf16* XB = XBp + (size_t)g2 * TG * D; float* SSQ = SSQp + (size_t)g2 * TG * 16;
        bf16* PA = (bf16*)(ws + WS_PA); bf16* PG = (bf16*)(ws + WS_PG);
        bf16* ONA = (bf16*)(ws + WS_ONA); bf16* OHG = ONA + (size_t)TG * 512; bf16* OCV = OHG + (size_t)TG * 512;
        unsigned char* SCR = ws + WS_SCR;
        const bf16* Wl = (const bf16*)(ws + WS_W) + (size_t)l * LAYER_EL;
        const int T = pr == 0 ? 2048 : 4096;
        const int g = pr * 2 + g2;
        float* X = args.out + (size_t)pr * 2 * TG * D;

        if (kind == K_CVT) {
            LAS float* scr = (LAS float*)(lds + wave * 16384);
            constexpr int I_GU = 16 * 176, I_DN = 44 * 32, I_IN = 16 * 272, I_MX = 8 * 32, I_OUT = 16 * 32;
            constexpr int I_LAYER = 2 * I_GU + 2 * I_DN + I_IN + 3 * I_MX + I_OUT;
            for (int it = gw; it < NLAYER * I_LAYER; it += NGW) {
                const int ll = it / I_LAYER; int r = it % I_LAYER; bf16* Wd = (bf16*)(ws + WS_W) + (size_t)ll * LAYER_EL;
                const float* src; const float* gain = nullptr; int K, N; size_t off; bool perm = false;
                if (r < I_GU) { src = args.in[3] + (size_t)ll * D * 2 * FF; K = D; N = 2 * FF; off = OFF_GU1; gain = args.in[2] + ll * D; perm = true; }
                else if ((r -= I_GU) < I_DN) { src = args.in[4] + (size_t)ll * FF * D; K = FF; N = D; off = OFF_D1; }
                else if ((r -= I_DN) < I_IN) { src = args.in[6] + (size_t)ll * D * 8704; K = D; N = 8704; off = OFF_IN; gain = args.in[5] + ll * D; }
                else if ((r -= I_IN) < I_MX) { src = args.in[9] + (size_t)ll * 512 * D; K = 512; N = D; off = OFF_HG; }
                else if ((r -= I_MX) < I_MX) { src = args.in[12] + (size_t)ll * 512 * D; K = 512; N = D; off = OFF_CV; }
                else if ((r -= I_MX) < I_MX) { src = args.in[14] + (size_t)ll * 512 * D; K = 512; N = D; off = OFF_NA; }
                else if ((r -= I_MX) < I_OUT) { src = args.in[15] + (size_t)ll * D * D; K = D; N = D; off = OFF_OUT; }
                else if ((r -= I_OUT) < I_GU) { src = args.in[17] + (size_t)ll * D * 2 * FF; K = D; N = 2 * FF; off = OFF_GU2; gain = args.in[16] + ll * D; perm = true; }
                else { r -= I_GU; src = args.in[18] + (size_t)ll * FF * D; K = FF; N = D; off = OFF_D2; }
                cvt_item(src, K, N, Wd + off, gain, perm, scr, r, lane);
            }
        } else if (kind == K_G0) {
            const float* xin = pr == 0 ? args.in[0] : args.in[1];
#pragma unroll 2
            for (int row = gw; row < 2 * TG; row += NGW) {
                const f32x4* __restrict__ xr = (const f32x4*)(xin + (size_t)row * D) + lane; v2u* bo = (v2u*)(XBp + (size_t)row * D) + lane;
                float ss = 0.f;
#pragma unroll
                for (int j = 0; j < 4; ++j) { const f32x4 v = xr[64 * j]; v2u w; w.x = cvt_pk_bf16(v[0], v[1]); w.y = cvt_pk_bf16(v[2], v[3]); bo[64 * j] = w; ss += (v[0] * v[0] + v[1] * v[1]) + (v[2] * v[2] + v[3] * v[3]); }
                ss = wave_sum(ss);
                if (lane < 16) SSQp[(size_t)row * 16 + lane] = lane == 0 ? ss : 0.f;
            }
        } else if (kind == K_UP) {
            pg8::Gemm gm{XBp, Wl + (s == 14 ? OFF_GU2 : OFF_GU1), 2 * TG, 2 * FF, D}; pg8::StaticOrder S; S.init(2 * TG, 2 * FF, G, bid);
            LAS float* rst = (LAS float*)(lds + 131072); LAS int* pml = (LAS int*)(lds + 131072 + 12288);
            __syncthreads();
            if (tid == 0) { int n = 0; pg8::Unit uu;
                for (int i = 0; S.next(i, uu); ++i) { bool f = false; for (int q = 0; q < n; ++q) f = f || (pml[q] == uu.pm); if (!f && n < 12) pml[n++] = uu.pm; }
                pml[15] = n; }
            __syncthreads();
            { const int n = pml[15];
              for (int idx = tid; idx < n * 256; idx += NTHR) { const int row = pml[idx >> 8] * 256 + (idx & 255); rst[idx] = pg8::row_rs(SSQp, row); } }
            __syncthreads();
            pg8::EpiSwiGLU E{PA, rst, pml, SSQp};
#ifndef NO_UP
            for (int rep = 0; rep < REP_GEMM; ++rep) pg8::gemm_phase<pg8::EpiSwiGLU, pg8::StaticOrder, PGA, PGS>(lds, gm, S, E);
#endif
        } else if (kind == K_RES) {
            const int K = mix ? D : FF, Mr = mix ? TG : 2 * TG; const size_t off = mix ? OFF_OUT : (s == 1 ? OFF_D1 : OFF_D2);
            pg8::Gemm gm{PA, Wl + off, Mr, D, K}; pg8::StaticOrder S; S.init(Mr, D, G, bid);
            pg8::EpiRes E{mix ? XB : XBp, mix ? SSQ : SSQp, mix ? 1.0f : 0.5f};
#ifndef NO_RES
            for (int rep = 0; rep < REP_RES; ++rep) { if (rep + 1 < REP_RES) { pg8::EpiRes E0 = E; E0.alpha = 0.f; pg8::gemm_phase<pg8::EpiRes, pg8::StaticOrder, PGA, PGS>(lds, gm, S, E0); }
                else pg8::gemm_phase<pg8::EpiRes, pg8::StaticOrder, PGA, PGS>(lds, gm, S, E); }
#endif
        } else if (kind == K_M1) {
            pg8::Gemm gm{XBp, Wl + OFF_IN, 2 * TG, 8704, D}; pg8::M1Order S; S.init(G, bid, g2);
            LAS float* rst = (LAS float*)(lds + 131072); LAS int* pml = (LAS int*)(lds + 131072 + 12288);
            __syncthreads();
            if (tid == 0) { int n = 0; pg8::Unit uu;
                for (int i = 0; S.next(i, uu); ++i) { bool f = false; for (int q = 0; q < n; ++q) f = f || (pml[q] == uu.pm); if (!f && n < 12) pml[n++] = uu.pm; }
                pml[15] = n; }
            __syncthreads();
            { const int n = pml[15];
              for (int idx = tid; idx < n * 256; idx += NTHR) { const int row = pml[idx >> 8] * 256 + (idx & 255); rst[idx] = pg8::row_rs(SSQp, row); } }
            __syncthreads();
            pg8::EpiProj E{PA, (unsigned char*)PG, (unsigned char*)PG + (size_t)TG * 3072, rst, pml, SSQp};
#ifndef NO_PROJ
            for (int rep = 0; rep < REP_GEMM; ++rep) pg8::gemm_phase<pg8::EpiProj, pg8::M1Order, PGA, PGS>(lds, gm, S, E);
#endif
        } else if (kind == K_M2A) {
#ifndef NO_HG
            { const int nP = (TG / 64) * 8;
              if (G == 256) { const int vcu1 = (bid % 8) * 32 + bid / 8; for (int rep = 0; rep < REP_HG; ++rep) hg_prep_items(lds, PA, SCR, args.in[7], l, vcu1 * (nP / 256), 1, (vcu1 + 1) * (nP / 256), T, tid); }
              else { for (int rep = 0; rep < REP_HG; ++rep) if (bid < nP) hg_prep_items(lds, PA, SCR, args.in[7], l, bid, G, nP, T, tid); } }
#endif
            const float* rpb = args.in[13] + (size_t)l * 8 * 465;
            const int vcu = (G % 8 == 0) ? (bid % 8) * (G / 8) + bid / 8 : bid;
            const int nNA = TG / 16, ipb = (nNA + G - 1) / G;
            for (int rep = 0; rep < REP_NA; ++rep)
                for (int q = 0; q < ipb; ++q) { const int it = vcu * ipb + q; if (it < nNA) {
#ifndef NO_NA
                    na_item(lds, PA, rpb, ONA, it, T, tid);
#endif
                    __syncthreads(); } }
        } else if (kind == K_M2B) {
#ifndef NO_HG
            const int vcu2 = (G % 8 == 0) ? (bid % 8) * (G / 8) + bid / 8 : bid;
            for (int rep = 0; rep < REP_HG; ++rep) {
                if (pr == 0) { for (int it = vcu2; it < 256; it += G) hg_scan_item<2>(lds, PA, SCR, it, T, tid); }
                else       { for (int it = vcu2; it < 256; it += G) hg_scan_item<1>(lds, PA, SCR, it, T, tid); }
            }
#endif
        } else if (kind == K_M3) {
            const float* gno = args.in[8] + l * 512; const float* cw = args.in[10] + l * 3 * 512; const float* cbias = args.in[11] + l * 512;
            const int c0 = lane * 8;
            const bf16* __restrict__ PAr = PA; bf16* __restrict__ OHGr = OHG; bf16* __restrict__ OCVr = OCV;
            const f32x4 gn0 = *(const f32x4*)(gno + c0), gn1 = *(const f32x4*)(gno + c0 + 4);
            const f32x4 w00 = *(const f32x4*)(cw + c0), w01 = *(const f32x4*)(cw + c0 + 4), w10 = *(const f32x4*)(cw + 512 + c0), w11 = *(const f32x4*)(cw + 512 + c0 + 4);
            const f32x4 w20 = *(const f32x4*)(cw + 1024 + c0), w21 = *(const f32x4*)(cw + 1024 + c0 + 4), bs0 = *(const f32x4*)(cbias + c0), bs1 = *(const f32x4*)(cbias + c0 + 4);
#pragma unroll 2
            for (int row = gw; row < TG; row += NGW) {
                const bf16* __restrict__ prow = PAr + (size_t)row * PA_LD;
                const v4u fw = *(const v4u*)(prow + C_HQ + c0), bw = *(const v4u*)(prow + C_HZF + c0);
                float o[8] = {bflo(fw.x) + bflo(bw.x), bfhi(fw.x) + bfhi(bw.x), bflo(fw.y) + bflo(bw.y), bfhi(fw.y) + bfhi(bw.y), bflo(fw.z) + bflo(bw.z), bfhi(fw.z) + bfhi(bw.z), bflo(fw.w) + bflo(bw.w), bfhi(fw.w) + bfhi(bw.w)};
                float ss = 0.f;
#pragma unroll
                for (int e = 0; e < 8; ++e) ss += o[e] * o[e];
                ss += __shfl_xor(ss, 1); ss += __shfl_xor(ss, 2); ss += __shfl_xor(ss, 4); ss += __shfl_xor(ss, 8);
                const float rs = __builtin_amdgcn_rsqf(ss * (1.0f / 128.0f) + 1e-6f);
                const v4u hgw = *(const v4u*)(prow + C_HG + c0);
                const float hgv[8] = {bflo(hgw.x), bfhi(hgw.x), bflo(hgw.y), bfhi(hgw.y), bflo(hgw.z), bfhi(hgw.z), bflo(hgw.w), bfhi(hgw.w)};
                const float gn[8] = {gn0[0], gn0[1], gn0[2], gn0[3], gn1[0], gn1[1], gn1[2], gn1[3]};
                float r8[8];
#pragma unroll
                for (int e = 0; e < 8; ++e) r8[e] = o[e] * rs * gn[e] * (hgv[e] * sigm(hgv[e]));
                v4u wo; wo.x = cvt_pk_bf16(r8[0], r8[1]); wo.y = cvt_pk_bf16(r8[2], r8[3]); wo.z = cvt_pk_bf16(r8[4], r8[5]); wo.w = cvt_pk_bf16(r8[6], r8[7]);
                *(v4u*)(OHGr + (size_t)row * 512 + c0) = wo;
                const int tl = row & (T - 1);
                const v4u a1 = *(const v4u*)(prow + C_CA + c0), c1 = *(const v4u*)(prow + C_CC + c0), bb = *(const v4u*)(prow + C_CB + c0);
                v4u a0 = {0u, 0u, 0u, 0u}, cc0 = a0, a2 = a0, cc2 = a0;
                if (tl > 0) { a0 = *(const v4u*)(prow - PA_LD + C_CA + c0); cc0 = *(const v4u*)(prow - PA_LD + C_CC + c0); }
                if (tl < T - 1) { a2 = *(const v4u*)(prow + PA_LD + C_CA + c0); cc2 = *(const v4u*)(prow + PA_LD + C_CC + c0); }
                const float zm[8] = {bflo(a0.x) * bflo(cc0.x), bfhi(a0.x) * bfhi(cc0.x), bflo(a0.y) * bflo(cc0.y), bfhi(a0.y) * bfhi(cc0.y), bflo(a0.z) * bflo(cc0.z), bfhi(a0.z) * bfhi(cc0.z), bflo(a0.w) * bflo(cc0.w), bfhi(a0.w) * bfhi(cc0.w)};
                const float zc[8] = {bflo(a1.x) * bflo(c1.x), bfhi(a1.x) * bfhi(c1.x), bflo(a1.y) * bflo(c1.y), bfhi(a1.y) * bfhi(c1.y), bflo(a1.z) * bflo(c1.z), bfhi(a1.z) * bfhi(c1.z), bflo(a1.w) * bflo(c1.w), bfhi(a1.w) * bfhi(c1.w)};
                const float zp[8] = {bflo(a2.x) * bflo(cc2.x), bfhi(a2.x) * bfhi(cc2.x), bflo(a2.y) * bflo(cc2.y), bfhi(a2.y) * bfhi(cc2.y), bflo(a2.z) * bflo(cc2.z), bfhi(a2.z) * bfhi(cc2.z), bflo(a2.w) * bflo(cc2.w), bfhi(a2.w) * bfhi(cc2.w)};
                const float cbv[8] = {bflo(bb.x), bfhi(bb.x), bflo(bb.y), bfhi(bb.y), bflo(bb.z), bfhi(bb.z), bflo(bb.w), bfhi(bb.w)};
#pragma unroll
                for (int e = 0; e < 4; ++e) { r8[e] = cbv[e] * (w00[e] * zm[e] + w10[e] * zc[e] + w20[e] * zp[e] + bs0[e]); r8[4 + e] = cbv[4 + e] * (w01[e] * zm[4 + e] + w11[e] * zc[4 + e] + w21[e] * zp[4 + e] + bs1[e]); }
                wo.x = cvt_pk_bf16(r8[0], r8[1]); wo.y = cvt_pk_bf16(r8[2], r8[3]); wo.z = cvt_pk_bf16(r8[4], r8[5]); wo.w = cvt_pk_bf16(r8[6], r8[7]);
                *(v4u*)(OCVr + (size_t)row * 512 + c0) = wo;
            }
        } else if (kind == K_M4) {
            pg8::Gemm gm{ONA, Wl + OFF_HG, 3 * TG, 3 * D, 512}; pg8::MergeOrder S; S.init(TG, D, G, bid);
            pg8::EpiMerge E{(const unsigned char*)PG + (size_t)g2 * TG * 3072, PA};
#ifndef NO_MERGE
            for (int rep = 0; rep < REP_MERGE; ++rep) pg8::gemm_phase<pg8::EpiMerge, pg8::MergeOrder, PGA, PGS>(lds, gm, S, E);
#endif
        } else {
            const f32x4* fg = (const f32x4*)args.in[19] + lane;
#pragma unroll 2
            for (int row = gw; row < 2 * TG; row += NGW) {
                const float rs = pg8::row_rs(SSQp, row);
                f32x4* __restrict__ xo = (f32x4*)(X + (size_t)row * D) + lane; const v2u* __restrict__ bi = (const v2u*)(XBp + (size_t)row * D) + lane;
#pragma unroll
                for (int j = 0; j < 4; ++j) { const v2u w = bi[64 * j]; const f32x4 v = {bflo(w.x), bfhi(w.x), bflo(w.y), bfhi(w.y)}; xo[64 * j] = v * fg[64 * j] * rs; }
            }
        }
#if TPROBE
        __syncthreads();
        const unsigned long long tp1 = __builtin_amdgcn_s_memrealtime();
#endif
        if (ph + 1 < hi) { for (int rep = 0; rep < REP_SYNC; ++rep) { if (hi < 0) grid.sync(); else xcd_barrier(xbar);     } }
#if TPROBE
        const unsigned long long tp2 = __builtin_amdgcn_s_memrealtime();
        if (TPROBE == 100) tacc += tp2 - tp1;
        else if (kind == TPROBE - 1) tacc += tp1 - tp0;
#endif
    }
#if TPROBE
    if (blockIdx.x == TPROBE_BLOCK) { const unsigned long long te = __builtin_amdgcn_s_memrealtime(); while (__builtin_amdgcn_s_memrealtime() - te < tacc) __builtin_amdgcn_s_sleep(8); }
#endif
}
constexpr int N_PHASES = 1 + 2 * PH_PER_PAIR;

extern "C" void kernel_launch(void* const* d_in, const int* in_sizes, int n_in, void* d_out, int out_size, void* d_ws, size_t ws_size, hipStream_t stream) {
    static int grid = 0;
    if (grid == 0) {
        if (n_in != 20 || ws_size < WS_END) { fprintf(stderr, "kernel_launch: unexpected n_in %d / ws %zu\n", n_in, ws_size); grid = -1; return; }
        int dev = 0, cus = 0, per_cu = 0;
        hipGetDevice(&dev); hipDeviceGetAttribute(&cus, hipDeviceAttributeMultiprocessorCount, dev);
        hipFuncSetAttribute((const void*)mk_fwd, hipFuncAttributeMaxDynamicSharedMemorySize, LDS_BYTES);
        hipOccupancyMaxActiveBlocksPerMultiprocessor(&per_cu, (const void*)mk_fwd, NTHR, LDS_BYTES);
        if (per_cu < 1) per_cu = 1;
        grid = cus * per_cu;
        (void)hipGetLastError();
    }
    if (grid < 0) return;
    hipMemsetAsync((char*)d_ws + WS_CTL, 0, CTL_BYTES, stream);
    Args a{};
    for (int i = 0; i < 20; ++i) a.in[i] = (const float*)d_in[i];
    a.out = (float*)d_out; a.ws = (unsigned char*)d_ws;
#if ONE_LAUNCH
    a.ph_lo = 0; a.ph_hi = N_PHASES;
    void* kargs[] = {&a};
    hipError_t e = hipLaunchCooperativeKernel((const void*)mk_fwd, dim3(grid), dim3(NTHR), kargs, LDS_BYTES, stream);
    if (e != hipSuccess) fprintf(stderr, "cooperative launch failed: %s (grid %d)\n", hipGetErrorString(e), grid);
#else
    for (int p = 0; p < N_PHASES; ++p) { a.ph_lo = p; a.ph_hi = p + 1; hipLaunchKernelGGL(mk_fwd, dim3(grid), dim3(NTHR), LDS_BYTES, stream, a); }
#endif
}
```

```cpp
#include <hip/hip_runtime.h>
#include <hip/hip_cooperative_groups.h>
#include <cstdio>
#include <cstdint>
namespace cg = cooperative_groups;
#ifndef ONE_LAUNCH
#define ONE_LAUNCH 1
#endif
#ifndef REP_HG
#define REP_HG 1
#endif
#ifndef REP_NA
#define REP_NA 1
#endif
#ifndef REP_SYNC
#define REP_SYNC 1
#endif
#ifndef REP_GEMM
#define REP_GEMM 1
#endif
#ifndef REP_M3
#define REP_M3 1
#endif
#ifndef REP_RES
#define REP_RES 1
#endif
#ifndef REP_MERGE
#define REP_MERGE 1
#endif
#ifndef REP_MISC
#define REP_MISC 1
#endif
#ifndef TPROBE
#define TPROBE 0
#endif
#ifndef TPROBE_BLOCK
#define TPROBE_BLOCK 0
#endif
#ifndef PGA
#define PGA true
#endif
#ifndef PGS
#define PGS true
#endif
#ifndef RS_PROBE
#define RS_PROBE 0
#endif
namespace pg8 {
#define PG8_LAS __attribute__((address_space(3)))
typedef unsigned short bf16_t;
typedef short bf16x8 __attribute__((ext_vector_type(8)));
typedef float f32x4 __attribute__((ext_vector_type(4)));
typedef unsigned u32x4 __attribute__((ext_vector_type(4)));
constexpr int BM = 256, BK = 64, HALF = 128, HTB = HALF * BK * 2  , STAGE_BYTES = 8 * HTB, NXCD = 8, WGM = 8;

__host__ __device__ __forceinline__ int lds_byte(int r, int c) { const int st = (r >> 4) * 2 + (c >> 5), rr = r & 15, cc = c & 31, ob = rr * 64 + cc * 2; return st * 1024 + (ob ^ (((ob >> 9) & 1) << 5)); }
__host__ __device__ __forceinline__ void stage_rc(int b, int& R, int& C) { const int st = b / 1024, sb = b % 1024, swz = sb ^ (((sb >> 9) & 1) << 5); R = (st >> 1) * 16 + swz / 64; C = (st & 1) * 32 + (swz % 64) / 2; }
__host__ __device__ __forceinline__ int perm32(int rho) { const int n = rho >> 4, i = rho & 15; return 8 * (i >> 2) + 4 * n + (i & 3); }

struct Unit { int pm, pn; };
struct Gemm { const bf16_t* A; const bf16_t* Bt; int M, N, K; };

struct StaticOrder {
    int nM, nN, nwg, G, c;
    __host__ __device__ void init(int M, int N, int G_, int c_) { nM = M / BM; nN = N / BM; nwg = nM * nN; G = G_; c = c_; }
    __host__ __device__ bool next(int i, Unit& u) const {
        const long L = (long)i * G + c; if (L >= nwg) return false;
        int wgid = (int)L; { const int q = nwg / NXCD, r = nwg % NXCD, xcd = wgid % NXCD, off = wgid / NXCD; wgid = (xcd < r ? xcd * (q + 1) : r * (q + 1) + (xcd - r) * q) + off; }
        const int nig = WGM * nN, gid = wgid / nig, fm = gid * WGM, gsz = (nM - fm) < WGM ? (nM - fm) : WGM;
        u.pm = fm + ((wgid % nig) % gsz); u.pn = (wgid % nig) / gsz; return true;
    }
    __device__ __forceinline__ void a_ready(const Unit&) const {}
    __device__ __forceinline__ void done(const Unit&) const {}
};

__device__ __forceinline__ unsigned cvt_pk_bf16(float lo, float hi) { unsigned r; asm volatile("v_cvt_pk_bf16_f32 %0, %1, %2" : "=v"(r) : "v"(lo), "v"(hi)); return r; }
__device__ __forceinline__ float row_rs(const float* ssq, int row) {
    const f32x4* p = (const f32x4*)(ssq + (size_t)row * 16);
    const f32x4 a = p[0], b = p[1], c = p[2], d = p[3];
    const float s = (((a[0] + a[1]) + (a[2] + a[3])) + ((b[0] + b[1]) + (b[2] + b[3]))) + (((c[0] + c[1]) + (c[2] + c[3])) + ((d[0] + d[1]) + (d[2] + d[3])));
    return __builtin_amdgcn_rsqf(s * (1.0f / 1024.0f) + 1e-6f);
}
__device__ __forceinline__ void row_rs8_impl(const float* ssq, int row0, float (&rsv)[8]) {
#pragma unroll
    for (int ai = 0; ai < 2; ++ai) {
        f32x4 p[4][4];
#pragma unroll
        for (int m = 0; m < 4; ++m) { const f32x4* q = (const f32x4*)(ssq + (size_t)(row0 + ai * HALF + m * 16) * 16);
#pragma unroll
            for (int j = 0; j < 4; ++j) p[m][j] = q[j]; }
#pragma unroll
        for (int m = 0; m < 4; ++m) { float t = 0.f;
#pragma unroll
            for (int j = 0; j < 4; ++j) t += (p[m][j][0] + p[m][j][1]) + (p[m][j][2] + p[m][j][3]);
            rsv[ai * 4 + m] = __builtin_amdgcn_rsqf(t * (1.0f / 1024.0f) + 1e-6f); }
    }
}
__device__ __forceinline__ void row_rs8(const float* ssq, int row0, float (&rsv)[8]) {
#if RS_PROBE
    { const float* ssq2 = ssq; asm volatile("" : "+s"(ssq2)); float t2[8]; row_rs8_impl(ssq2, row0, t2); row_rs8_impl(ssq, row0, rsv);
#pragma unroll
      for (int i = 0; i < 8; ++i) rsv[i] = 0.5f * (rsv[i] + t2[i]); return; }
#endif
    row_rs8_impl(ssq, row0, rsv);
}
__device__ __forceinline__ void row_rs8_lds(const PG8_LAS float* rst, const PG8_LAS int* pml, const float* ssq, int pm, int wr, int fr, float (&rsv)[8]) {
    const int n = pml[15]; int slot = -1;
#pragma unroll
    for (int s_ = 0; s_ < 12; ++s_) if (s_ < n && pml[s_] == pm) slot = s_;
    if (slot < 0) { row_rs8(ssq, pm * BM + wr * 64 + fr, rsv); return; }
    const PG8_LAS float* t = rst + slot * 256 + wr * 64 + fr;
#pragma unroll
    for (int ai = 0; ai < 2; ++ai)
#pragma unroll
        for (int m = 0; m < 4; ++m) rsv[ai * 4 + m] = t[ai * HALF + m * 16];
}
__device__ __forceinline__ float sigm(float v) { return __builtin_amdgcn_rcpf(1.0f + __expf(-v)); }

struct EpiSwiGLU {
    static constexpr bool PERM = true, AFTER_DRAIN = false, CARRY = false;
    bf16_t* H; const PG8_LAS float* rst; const PG8_LAS int* pml; const float* ssq;
    __device__ __forceinline__ void operator()(const f32x4 (&acc)[2][2][4][2], const Unit& u, int wr, int wc, int fr, int fq) const {
        const int row0 = u.pm * BM + wr * 64 + fr, col0 = u.pn * 128 + wc * 32 + 8 * fq;
        float rsv[8]; row_rs8_lds(rst, pml, ssq, u.pm, wr, fr, rsv);
#pragma unroll
        for (int ai = 0; ai < 2; ++ai)
#pragma unroll
            for (int m = 0; m < 4; ++m) {
                const int row = row0 + ai * HALF + m * 16; const float rs = rsv[ai * 4 + m];
                u32x4 w;
#pragma unroll
                for (int n = 0; n < 2; ++n) {
                    const f32x4 a = acc[ai][0][m][n] * rs, b = acc[ai][1][m][n] * rs; f32x4 h;
#pragma unroll
                    for (int e = 0; e < 4; ++e) h[e] = a[e] * sigm(a[e]) * b[e];
                    w[2 * n] = cvt_pk_bf16(h[0], h[1]); w[2 * n + 1] = cvt_pk_bf16(h[2], h[3]);
                }
                *(u32x4*)(H + (size_t)row * 2816 + col0) = w;
            }
    }
};
__device__ __forceinline__ void unpack8(const u32x4 w, f32x4& lo, f32x4& hi) {
    lo[0] = __uint_as_float(w.x << 16); lo[1] = __uint_as_float(w.x & 0xffff0000u); lo[2] = __uint_as_float(w.y << 16); lo[3] = __uint_as_float(w.y & 0xffff0000u);
    hi[0] = __uint_as_float(w.z << 16); hi[1] = __uint_as_float(w.z & 0xffff0000u); hi[2] = __uint_as_float(w.w << 16); hi[3] = __uint_as_float(w.w & 0xffff0000u);
}
struct EpiRes {
    static constexpr bool PERM = true, AFTER_DRAIN = false, CARRY = false;
    bf16_t* XB; float* ssq; float alpha;
    __device__ __forceinline__ void operator()(const f32x4 (&acc)[2][2][4][2], const Unit& u, int wr, int wc, int fr, int fq) const {
        const int row0 = u.pm * BM + wr * 64 + fr, col0 = u.pn * BM + wc * 32 + 8 * fq;
#pragma unroll
        for (int ai = 0; ai < 2; ++ai) {
            u32x4 xin[4][2];
#pragma unroll
            for (int m = 0; m < 4; ++m)
#pragma unroll
                for (int bj = 0; bj < 2; ++bj) xin[m][bj] = *(const u32x4*)(XB + (size_t)(row0 + ai * HALF + m * 16) * 1024 + col0 + bj * HALF);
#pragma unroll
            for (int m = 0; m < 4; ++m) {
                const int row = row0 + ai * HALF + m * 16; float ss = 0.f;
#pragma unroll
                for (int bj = 0; bj < 2; ++bj) {
                    bf16_t* xp = XB + (size_t)row * 1024 + col0 + bj * HALF;
                    f32x4 x0, x1; unpack8(xin[m][bj], x0, x1);
                    x0 = x0 + acc[ai][bj][m][0] * alpha; x1 = x1 + acc[ai][bj][m][1] * alpha;
                    u32x4 w; w.x = cvt_pk_bf16(x0[0], x0[1]); w.y = cvt_pk_bf16(x0[2], x0[3]); w.z = cvt_pk_bf16(x1[0], x1[1]); w.w = cvt_pk_bf16(x1[2], x1[3]);
                    *(u32x4*)xp = w;
                    ss += ((x0[0] * x0[0] + x0[1] * x0[1]) + (x0[2] * x0[2] + x0[3] * x0[3])) + ((x1[0] * x1[0] + x1[1] * x1[1]) + (x1[2] * x1[2] + x1[3] * x1[3]));
                }
                ss += __shfl_xor(ss, 16); ss += __shfl_xor(ss, 32);
                if (fq == 0) ssq[(size_t)row * 16 + u.pn * 4 + wc] = ss;
            }
            asm volatile("" ::: "memory");
        }
    }
};
struct M1Order {
    StaticOrder so; int second, G, c;
    __device__ void init(int G_, int c_, int second_) { second = second_; G = G_; c = c_; so.init(16384, second_ ? 8192 : 8704, G_, c_); }
    __device__ bool next(int i, Unit& u) const {
        if (!second) { if (so.next(i, u)) return true;
            const long L = (long)i * G + c - 2176; if (L < 0 || L >= 128) return false; u.pm = 64 + (int)(L >> 1); u.pn = 22 + (int)(L & 1); return true; }
        Unit b; if (!so.next(i, b)) return false; u.pm = b.pm + 64; u.pn = b.pn < 22 ? b.pn : b.pn + 2; return true;
    }
    __device__ __forceinline__ void a_ready(const Unit&) const {}
    __device__ __forceinline__ void done(const Unit&) const {}
};
struct EpiProj {
    static constexpr bool PERM = true, AFTER_DRAIN = false, CARRY = false;
    bf16_t* PA; unsigned char* PGa; unsigned char* PGb; const PG8_LAS float* rst; const PG8_LAS int* pml; const float* ssq;
    __device__ __forceinline__ void operator()(const f32x4 (&acc)[2][2][4][2], const Unit& u, int wr, int wc, int fr, int fq) const {
        unsigned char* PG8 = u.pm < 64 ? PGa : PGb;
        const int prow0 = u.pm * BM + wr * 64 + fr, row0 = prow0 & 16383;
        float rsv[8]; row_rs8_lds(rst, pml, ssq, u.pm, wr, fr, rsv);
        if (u.pn < 22) {
            const int col0 = u.pn * BM + wc * 32 + 8 * fq;
#pragma unroll
            for (int ai = 0; ai < 2; ++ai)
#pragma unroll
                for (int m = 0; m < 4; ++m) {
                    const int row = row0 + ai * HALF + m * 16; const float rs = rsv[ai * 4 + m];
#pragma unroll
                    for (int bj = 0; bj < 2; ++bj) {
                        const f32x4 v0 = acc[ai][bj][m][0] * rs, v1 = acc[ai][bj][m][1] * rs;
                        u32x4 w; w.x = cvt_pk_bf16(v0[0], v0[1]); w.y = cvt_pk_bf16(v0[2], v0[3]); w.z = cvt_pk_bf16(v1[0], v1[1]); w.w = cvt_pk_bf16(v1[2], v1[3]);
                        *(u32x4*)(PA + (size_t)row * 5632 + col0 + bj * HALF) = w;
                    }
                }
        } else {
            const int col0 = (u.pn - 22) * BM + wc * 32 + 8 * fq;
#pragma unroll
            for (int ai = 0; ai < 2; ++ai)
#pragma unroll
                for (int m = 0; m < 4; ++m) {
                    const int row = row0 + ai * HALF + m * 16; const float rs = rsv[ai * 4 + m];
#pragma unroll
                    for (int bj = 0; bj < 2; ++bj) {
                        unsigned q[8];
#pragma unroll
                        for (int e = 0; e < 4; ++e) { q[e] = (unsigned)(sigm(acc[ai][bj][m][0][e] * rs) * 255.0f + 0.5f); q[4 + e] = (unsigned)(sigm(acc[ai][bj][m][1][e] * rs) * 255.0f + 0.5f); }
                        typedef unsigned u32x2_ __attribute__((ext_vector_type(2)));
                        u32x2_ w; w.x = q[0] | (q[1] << 8) | (q[2] << 16) | (q[3] << 24); w.y = q[4] | (q[5] << 8) | (q[6] << 16) | (q[7] << 24);
                        *(u32x2_*)(PG8 + (size_t)row * 3072 + col0 + bj * HALF) = w;
                    }
                }
        }
    }
};
struct MergeOrder {
    StaticOrder so;
    __device__ void init(int M, int N, int G_, int c_) { so.init(M, N, G_, c_); }
    __device__ bool next(int i, Unit& u) const { Unit b; if (!so.next(i / 3, b)) return false; const int m = i % 3, w = (m == 0) ? 2 : m - 1; u.pm = b.pm + 64 * m; u.pn = b.pn + 4 * w; return true; }
    __device__ __forceinline__ void a_ready(const Unit&) const {}
    __device__ __forceinline__ void done(const Unit&) const {}
};
struct EpiMerge {
    static constexpr bool PERM = true, AFTER_DRAIN = false, CARRY = true;
    const unsigned char* PG8; bf16_t* MB;
    __device__ __forceinline__ void operator()(const f32x4 (&)[2][2][4][2], const Unit&, int, int, int, int) const {}
    __device__ __forceinline__ bool carry(f32x4 (&acc)[2][2][4][2], const Unit& u, int wr, int wc, int fr, int fq) const {
        typedef unsigned u32x2_ __attribute__((ext_vector_type(2)));
        const int m_ = u.pm >> 6, pm = u.pm & 63, w_ = u.pn >> 2, pn = u.pn & 3;
        const int wn = (m_ == 0) ? 0 : 1;
        const bool last = (m_ == 2);
        const int row0 = pm * BM + wr * 64 + fr, col0 = pn * BM + wc * 32 + 8 * fq;
#pragma unroll
        for (int ai = 0; ai < 2; ++ai) {
            u32x2_ gc[4][2], gn[4][2];
#pragma unroll
            for (int m = 0; m < 4; ++m)
#pragma unroll
                for (int bj = 0; bj < 2; ++bj) { const size_t o = (size_t)(row0 + ai * HALF + m * 16) * 3072 + col0 + bj * HALF;
                    gc[m][bj] = *(const u32x2_*)(PG8 + o + w_ * 1024);
                    gn[m][bj] = last ? (u32x2_){0x01010101u, 0x01010101u} : *(const u32x2_*)(PG8 + o + wn * 1024); }
#pragma unroll
            for (int m = 0; m < 4; ++m)
#pragma unroll
                for (int bj = 0; bj < 2; ++bj) {
                    float f[8];
#pragma unroll
                    for (int e = 0; e < 8; ++e) { const unsigned wc_ = e < 4 ? gc[m][bj].x : gc[m][bj].y, wn_ = e < 4 ? gn[m][bj].x : gn[m][bj].y; const int sh = 8 * (e & 3);
                        const float qc = (float)max((wc_ >> sh) & 255u, 1u), qn = (float)max((wn_ >> sh) & 255u, 1u);
                        f[e] = last ? qc * (1.0f / 255.0f) : qc * __builtin_amdgcn_rcpf(qn); }
#pragma unroll
                    for (int e = 0; e < 4; ++e) { acc[ai][bj][m][0][e] *= f[e]; acc[ai][bj][m][1][e] *= f[4 + e]; }
                    if (last) { const f32x4 t0 = acc[ai][bj][m][0], t1 = acc[ai][bj][m][1];
                        u32x4 w; w.x = cvt_pk_bf16(t0[0], t0[1]); w.y = cvt_pk_bf16(t0[2], t0[3]); w.z = cvt_pk_bf16(t1[0], t1[1]); w.w = cvt_pk_bf16(t1[2], t1[3]);
                        *(u32x4*)(MB + (size_t)(row0 + ai * HALF + m * 16) * 1024 + col0 + bj * HALF) = w; }
                }
            asm volatile("" ::: "memory");
        }
        return !last;
    }
};
template <class Epi, class Sched, bool ALIGN_EPI = false, bool SP2 = false>
__device__ __forceinline__ void gemm_phase(PG8_LAS unsigned char* lds, const Gemm g, const Sched& S, const Epi& E) {
    int tid = threadIdx.x; asm volatile("" : "+v"(tid));
    const int wid = __builtin_amdgcn_readfirstlane(tid >> 6), lane = tid & 63, wr = wid >> 2, wc = wid & 3, fr = lane & 15, fq = lane >> 4;
    const int K = g.K, nt = K / BK;
    unsigned voffA[2], voffB[2];
#pragma unroll
    for (int i = 0; i < 2; ++i) { int R, C; stage_rc(tid * 16 + i * 8192, R, C); const int Rb = Epi::PERM ? ((R & ~31) + perm32(R & 31)) : R;
        voffA[i] = (unsigned)(R * K + C) * 2u; voffB[i] = (unsigned)(Rb * K + C) * 2u; }
    const size_t kstep = (size_t)(BK * 2);
    const size_t hstep = (size_t)HALF * K * 2;
    const size_t tstep = 2 * hstep;
    const unsigned ldsw = (unsigned)wid * 1024u;
    const int aoff = lds_byte(wr * 64 + fr, fq * 8), boff = lds_byte(wc * 32 + fr, fq * 8);
#define PG8_SA(b, h) (((b) * 2 + (h)) * HTB)
#define PG8_SB(b, h) ((4 + (b) * 2 + (h)) * HTB)
#define PG8_STAGE(bufoff, gbase, voff) do { _Pragma("unroll") for (int _i = 0; _i < 2; ++_i) \
        __builtin_amdgcn_global_load_lds((const unsigned*)((const char*)(gbase) + (voff)[_i]), (PG8_LAS unsigned*)(lds + (bufoff) + ldsw + _i * 8192), 16, 0, 0); } while (0)
#define PG8_LDA(dst, b, h) do { _Pragma("unroll") for (int m = 0; m < 4; ++m) _Pragma("unroll") for (int k = 0; k < 2; ++k) dst[m][k] = *(const PG8_LAS bf16x8*)(lds + PG8_SA(b, h) + aoff + m * 2048 + k * 1024); } while (0)
#define PG8_LDB(dst, b, h) do { _Pragma("unroll") for (int n = 0; n < 2; ++n) _Pragma("unroll") for (int k = 0; k < 2; ++k) dst[n][k] = *(const PG8_LAS bf16x8*)(lds + PG8_SB(b, h) + boff + n * 2048 + k * 1024); } while (0)
#define PG8_MMA(ai, bj, At, Bt) do { __builtin_amdgcn_s_setprio(1); _Pragma("unroll") for (int m = 0; m < 4; ++m) _Pragma("unroll") for (int n = 0; n < 2; ++n) _Pragma("unroll") for (int k = 0; k < 2; ++k) \
        acc[ai][bj][m][n] = __builtin_amdgcn_mfma_f32_16x16x32_bf16(Bt[n][k], At[m][k], acc[ai][bj][m][n], 0, 0, 0); __builtin_amdgcn_s_setprio(0); } while (0)
#define PG8_WAIT_V(n) asm volatile("s_waitcnt vmcnt(" #n ")" ::: "memory")
#define PG8_WAIT_L(n) asm volatile("s_waitcnt lgkmcnt(" #n ")" ::: "memory")
#define PG8_BAR __builtin_amdgcn_s_barrier()
#define PG8_SCHED __builtin_amdgcn_sched_barrier(0)
    Unit cur, nxt; int ui = 0;
    if (!S.next(0, cur)) return;
    f32x4 acc[2][2][4][2];
#pragma unroll
    for (int a = 0; a < 2; ++a)
#pragma unroll
        for (int b = 0; b < 2; ++b)
#pragma unroll
            for (int m = 0; m < 4; ++m)
#pragma unroll
                for (int n = 0; n < 2; ++n) acc[a][b][m][n] = (f32x4){0.f, 0.f, 0.f, 0.f};
    bf16x8 At[4][2], B0[2][2], B1[2][2];
    const char* cA = (const char*)g.A + (size_t)cur.pm * tstep; const char* cB = (const char*)g.Bt + (size_t)cur.pn * tstep;
    S.a_ready(cur);
    if constexpr (SP2) {
        PG8_STAGE(PG8_SB(0, 0), cB, voffB); PG8_STAGE(PG8_SB(0, 1), cB + hstep, voffB); PG8_STAGE(PG8_SA(0, 0), cA, voffA); PG8_STAGE(PG8_SA(0, 1), cA + hstep, voffA);
        if (wr == 1) PG8_BAR;
        PG8_WAIT_V(2); PG8_BAR;
        PG8_STAGE(PG8_SB(1, 0), cB + kstep, voffB); PG8_STAGE(PG8_SA(1, 0), cA + kstep, voffA); PG8_STAGE(PG8_SB(1, 1), cB + hstep + kstep, voffB);
        PG8_WAIT_V(6); PG8_BAR;
    } else {
        PG8_STAGE(PG8_SB(0, 0), cB, voffB); PG8_STAGE(PG8_SA(0, 0), cA, voffA); PG8_STAGE(PG8_SB(0, 1), cB + hstep, voffB); PG8_STAGE(PG8_SA(0, 1), cA + hstep, voffA);
        if (wr == 1) PG8_BAR;
        PG8_WAIT_V(4); PG8_BAR;
        PG8_STAGE(PG8_SB(1, 0), cB + kstep, voffB); PG8_STAGE(PG8_SA(1, 0), cA + kstep, voffA); PG8_STAGE(PG8_SB(1, 1), cB + hstep + kstep, voffB);
        PG8_WAIT_V(6); PG8_BAR;
    }
    for (;;) {
        const bool has_next = S.next(ui + 1, nxt);
        const char* nA = has_next ? (const char*)g.A + (size_t)nxt.pm * tstep : cA; const char* nB = has_next ? (const char*)g.Bt + (size_t)nxt.pn * tstep : cB;
        for (int t = 0; t < nt; t += 2) {
            const bool last = (t == nt - 2);
            const char* a1 = cA + (size_t)(t + 1) * kstep;
            const char* a2 = last ? nA : cA + (size_t)(t + 2) * kstep; const char* b2 = last ? nB : cB + (size_t)(t + 2) * kstep;
            const char* a3 = a2 + kstep; const char* b3 = b2 + kstep;
            if (last && has_next) S.a_ready(nxt);
            if constexpr (SP2) {
            PG8_LDB(B0, 0, 0); PG8_LDB(B1, 0, 1); PG8_SCHED; PG8_LDA(At, 0, 0); PG8_STAGE(PG8_SA(1, 1), a1 + hstep, voffA);
            PG8_WAIT_V(8); PG8_WAIT_L(0); PG8_BAR; PG8_MMA(0, 0, At, B0); PG8_MMA(0, 1, At, B1); PG8_BAR; PG8_SCHED;
            PG8_LDA(At, 0, 1); PG8_STAGE(PG8_SB(0, 0), b2, voffB); PG8_STAGE(PG8_SB(0, 1), b2 + hstep, voffB); PG8_STAGE(PG8_SA(0, 0), a2, voffA);
            PG8_WAIT_V(8); PG8_WAIT_L(0); PG8_BAR; PG8_MMA(1, 0, At, B0); PG8_MMA(1, 1, At, B1); PG8_BAR; PG8_SCHED;
            PG8_LDB(B0, 1, 0); PG8_LDB(B1, 1, 1); PG8_SCHED; PG8_LDA(At, 1, 0); PG8_STAGE(PG8_SA(0, 1), a2 + hstep, voffA);
            PG8_WAIT_V(8); PG8_WAIT_L(0); PG8_BAR; PG8_MMA(0, 0, At, B0); PG8_MMA(0, 1, At, B1); PG8_BAR; PG8_SCHED;
            PG8_LDA(At, 1, 1); PG8_STAGE(PG8_SB(1, 0), b3, voffB); PG8_STAGE(PG8_SB(1, 1), b3 + hstep, voffB); PG8_STAGE(PG8_SA(1, 0), a3, voffA);
            PG8_WAIT_V(8); PG8_WAIT_L(0); PG8_BAR; PG8_MMA(1, 0, At, B0); PG8_MMA(1, 1, At, B1); PG8_BAR; PG8_SCHED;
            } else {
            PG8_LDB(B0, 0, 0); PG8_SCHED; PG8_LDA(At, 0, 0); PG8_STAGE(PG8_SA(1, 1), a1 + hstep, voffA);
            PG8_WAIT_L(8); PG8_BAR; PG8_WAIT_L(0); PG8_MMA(0, 0, At, B0); PG8_BAR; PG8_SCHED;
            PG8_LDB(B1, 0, 1); PG8_STAGE(PG8_SB(0, 0), b2, voffB);
            PG8_BAR; PG8_WAIT_L(0); PG8_MMA(0, 1, At, B1); PG8_BAR;
            PG8_LDA(At, 0, 1); PG8_STAGE(PG8_SA(0, 0), a2, voffA);
            PG8_BAR; PG8_WAIT_L(0); PG8_MMA(1, 0, At, B0); PG8_BAR; PG8_SCHED;
            PG8_STAGE(PG8_SB(0, 1), b2 + hstep, voffB);
            PG8_WAIT_V(6); PG8_BAR; PG8_MMA(1, 1, At, B1); PG8_BAR;
            PG8_LDB(B0, 1, 0); PG8_SCHED; PG8_LDA(At, 1, 0); PG8_STAGE(PG8_SA(0, 1), a2 + hstep, voffA);
            PG8_WAIT_L(8); PG8_BAR; PG8_WAIT_L(0); PG8_MMA(0, 0, At, B0); PG8_BAR; PG8_SCHED;
            PG8_LDB(B1, 1, 1); PG8_STAGE(PG8_SB(1, 0), b3, voffB);
            PG8_BAR; PG8_WAIT_L(0); PG8_MMA(0, 1, At, B1); PG8_BAR;
            PG8_LDA(At, 1, 1); PG8_STAGE(PG8_SA(1, 0), a3, voffA);
            PG8_BAR; PG8_WAIT_L(0); PG8_MMA(1, 0, At, B0); PG8_BAR; PG8_SCHED;
            PG8_STAGE(PG8_SB(1, 1), b3 + hstep, voffB);
            PG8_WAIT_V(6); PG8_BAR; PG8_MMA(1, 1, At, B1); PG8_BAR;
            }
        }
        if constexpr (ALIGN_EPI) { if (wr == 0) PG8_BAR; }
        bool keep = false;
        if constexpr (Epi::CARRY) { keep = E.carry(acc, cur, wr, wc, fr, fq); S.done(cur); }
        else if constexpr (!Epi::AFTER_DRAIN) { E(acc, cur, wr, wc, fr, fq); S.done(cur); }
        if (!has_next) break;
        if (!keep) {
#pragma unroll
        for (int a = 0; a < 2; ++a)
#pragma unroll
            for (int b = 0; b < 2; ++b)
#pragma unroll
                for (int m = 0; m < 4; ++m)
#pragma unroll
                    for (int n = 0; n < 2; ++n) acc[a][b][m][n] = (f32x4){0.f, 0.f, 0.f, 0.f};
        }
        cur = nxt; cA = nA; cB = nB; ++ui;
        if constexpr (ALIGN_EPI) { if (wr == 1) PG8_BAR; }
    }
    PG8_WAIT_V(0);
    if constexpr (!ALIGN_EPI) { if (wr == 0) PG8_BAR; }
    PG8_BAR;
    if constexpr (Epi::AFTER_DRAIN) { E.fused(acc, cur, wr, wc, fr, fq, lds, wid, lane); S.done(cur); }
#undef PG8_SA
#undef PG8_SB
#undef PG8_STAGE
#undef PG8_LDA
#undef PG8_LDB
#undef PG8_MMA
#undef PG8_WAIT_V
#undef PG8_WAIT_L
#undef PG8_BAR
#undef PG8_SCHED
}
}
#define LAS __attribute__((address_space(3)))
typedef unsigned short bf16;
typedef unsigned v4u __attribute__((ext_vector_type(4)));
typedef unsigned v2u __attribute__((ext_vector_type(2)));
typedef short v4i16_t __attribute__((ext_vector_type(4)));
using pg8::f32x4; using pg8::bf16x8; using pg8::cvt_pk_bf16;

constexpr int D = 1024, FF = 2816, NLAYER = 4, TG = 16384, NGROUP = 4, NTHR = 512, NWAVES = 8;
constexpr int PA_LD = 5632, PG_LD = 3072;
constexpr int C_HQ = 0, C_HI = 512, C_HZF = 1024, C_HZB = 1536, C_HG = 2048, C_CA = 2560, C_CB = 3072, C_CC = 3584, C_NQ = 4096, C_NK = 4608, C_NV = 5120;
constexpr size_t MiB = 1u << 20;
constexpr size_t WS_CTL = 0, CTL_BYTES = 1 * MiB, WS_W = 1 * MiB, WS_XB = 221 * MiB, WS_SSQ = 285 * MiB, WS_PA = 287 * MiB, WS_PG = 463 * MiB, WS_ONA = 559 * MiB, WS_SCR = 575 * MiB, WS_END = 671 * MiB;
constexpr size_t OFF_GU1 = 0, OFF_D1 = 5767168, OFF_IN = 8650752, OFF_HG = 17563648, OFF_CV = 18087936, OFF_NA = 18612224, OFF_OUT = 19136512, OFF_GU2 = 20185088, OFF_D2 = 25952256, LAYER_EL = 28835840;
constexpr int LDS_BYTES = 147456, LDS_MISC = 147456 - 64;
constexpr int PH_PER_PAIR = 1 + NLAYER * 16 + 1;
constexpr int CW_BAR = 4096;

__device__ __forceinline__ unsigned f2bf(float f) { unsigned u = __float_as_uint(f); return (u + 0x7fffu + ((u >> 16) & 1u)) >> 16; }
__device__ __forceinline__ float bf2f(unsigned b) { return __uint_as_float(b << 16); }
__device__ __forceinline__ float bflo(unsigned w) { return __uint_as_float(w << 16); }
__device__ __forceinline__ float bfhi(unsigned w) { return __uint_as_float(w & 0xffff0000u); }
__device__ __forceinline__ float sigm(float v) { return __builtin_amdgcn_rcpf(1.0f + __expf(-v)); }
__device__ __forceinline__ float wave_sum(float v) {
#pragma unroll
    for (int o = 1; o < 64; o <<= 1) v += __shfl_xor(v, o);
    return v;
}

__device__ __forceinline__ void cvt_item(const float* W, int K, int N, bf16* WT, const float* gain, bool permgu, LAS float* scr, int item, int lane) {
    const int nblk = N / 32, kb = item / nblk, nb = item % nblk, k0 = 64 * kb, n0 = 32 * nb;
#pragma unroll
    for (int i = 0; i < 32; ++i) { const int kk = 2 * i + (lane >> 5); const float g = gain ? gain[k0 + kk] : 1.0f; scr[kk * 33 + (lane & 31)] = W[(size_t)(k0 + kk) * N + n0 + (lane & 31)] * g; }
    asm volatile("s_waitcnt lgkmcnt(0)" ::: "memory");
    int dn0 = n0;
    if (permgu) { const int half = n0 >= FF ? 1 : 0; const int j = n0 - half * FF; dn0 = (j >> 7) * 256 + half * 128 + (j & 127); }
    const int c = lane & 7;
#pragma unroll
    for (int j = 0; j < 4; ++j) { const int n = (lane >> 3) + 8 * j; const LAS float* s = scr + (8 * c) * 33 + n;
        v4u o; o.x = cvt_pk_bf16(s[0 * 33], s[1 * 33]); o.y = cvt_pk_bf16(s[2 * 33], s[3 * 33]); o.z = cvt_pk_bf16(s[4 * 33], s[5 * 33]); o.w = cvt_pk_bf16(s[6 * 33], s[7 * 33]);
        *(v4u*)(WT + (size_t)(dn0 + n) * K + k0 + 8 * c) = o; }
    asm volatile("s_waitcnt lgkmcnt(0)" ::: "memory");
}

template <int K> __device__ __forceinline__ f32x4 mma_lds(f32x4 acc, const LAS bf16* A, int pa, const LAS bf16* B, int pb, int lane) {
    const int r = lane & 15, q = lane >> 4;
#pragma unroll
    for (int ks = 0; ks < K / 32; ++ks) {
        const bf16x8 a = *(const LAS bf16x8*)(A + r * pa + ks * 32 + q * 8);
        const bf16x8 b = *(const LAS bf16x8*)(B + r * pb + ks * 32 + q * 8);
        acc = __builtin_amdgcn_mfma_f32_16x16x32_bf16(a, b, acc, 0, 0, 0);
    }
    return acc;
}

constexpr int HP_QT = 0, HP_KTT = 17408, HP_AM = 35840, HP_ER = 45056, HP_EE = 45568, HP_BLK = 49152;
constexpr int HP_KT = 49152, HP_SEG = 66560;
constexpr int HS_VT = 49152, HS_ST = 53760, HS_BUF = 62464;
__device__ __forceinline__ void hg_prep_items(LAS unsigned char* lds, const bf16* PA, unsigned char* SCR, const float* lb_logits, int layer, int item0, int istride, int nitems, int T, int tid) {
    const int lane = tid & 63, wave = __builtin_amdgcn_readfirstlane(tid >> 6), c16 = lane & 15, quad = lane >> 4;
    const int nchunk = T / 64;
    const int kp = tid & 63, ts = tid >> 6;
    LAS bf16* QT = (LAS bf16*)(lds + HP_QT); LAS bf16* KT = (LAS bf16*)(lds + HP_KT); LAS bf16* KTT = (LAS bf16*)(lds + HP_KTT); LAS bf16* AM = (LAS bf16*)(lds + HP_AM);
    LAS float* SEG = (LAS float*)(lds + HP_SEG); LAS float* ER = (LAS float*)(lds + HP_ER); LAS float* EE = (LAS float*)(lds + HP_EE);
    unsigned zz[8], qq[8];
#define HP_LOAD(it) do { const int it_ = min((it), nitems - 1); const int c_ = it_ % nchunk, sd_ = it_ / nchunk, dir_ = sd_ & 1, h_ = (sd_ >> 1) & 3, base_ = (sd_ >> 3) * T; \
        const bf16* zs = PA + (dir_ ? C_HZB : C_HZF) + h_ * 128 + 2 * kp; const bf16* qs = PA + C_HQ + h_ * 128 + 2 * kp; \
        _Pragma("unroll") for (int i = 0; i < 8; ++i) { const int tau = c_ * 64 + 8 * ts + i; const size_t ro = (size_t)(base_ + (dir_ ? (T - 1 - tau) : tau)) * PA_LD; zz[i] = *(const unsigned*)(zs + ro); qq[i] = *(const unsigned*)(qs + ro); } } while (0)
    HP_LOAD(item0);
    for (int item = item0; item < nitems; item += istride) {
        const int sd = item / nchunk, dir = sd & 1, h = (sd >> 1) & 3;
        float lb[2];
#pragma unroll
        for (int j = 0; j < 2; ++j) { float lg[4], mx = -3e38f;
#pragma unroll
          for (int l = 0; l < 4; ++l) { lg[l] = lb_logits[(dir * 4 + l) * 512 + h * 128 + 2 * kp + j]; mx = fmaxf(mx, lg[l]); }
          float tot = 0.f, num = 0.f;
#pragma unroll
          for (int l = 0; l < 4; ++l) { const float e = __expf(lg[l] - mx); tot += e; if (l >= 1 && l <= layer) num += e; }
          lb[j] = num / tot; }
        float b[2][8], kv[2][8], qv[2][8]; float cum[2] = {0.f, 0.f};
#pragma unroll
        for (int i = 0; i < 8; ++i)
#pragma unroll
            for (int j = 0; j < 2; ++j) { const float zf = j ? bfhi(zz[i]) : bflo(zz[i]); const float sg = sigm(zf); const float oml = 1.0f - lb[j]; const float f = lb[j] + oml * sg;
                cum[j] += __logf(fmaxf(f, 1e-30f)); b[j][i] = cum[j]; kv[j][i] = oml * (1.0f - sg); qv[j][i] = j ? bfhi(qq[i]) : bflo(qq[i]); }
        HP_LOAD(item + istride);
        SEG[ts * 128 + 2 * kp] = cum[0]; SEG[ts * 128 + 2 * kp + 1] = cum[1];
        __syncthreads();
        float pre[2], r[2], bend[2];
#pragma unroll
        for (int j = 0; j < 2; ++j) { float p = 0.f, rr = 0.f, be = 0.f;
#pragma unroll
            for (int q = 0; q < 8; ++q) { const float v = SEG[q * 128 + 2 * kp + j]; if (q < ts) p += v; if (q < 4) rr += v; be += v; }
            pre[j] = p; r[j] = rr; bend[j] = be; }
        unsigned kpk[2][4];
#pragma unroll
        for (int i = 0; i < 8; ++i) {
            unsigned qb[2], kb[2];
#pragma unroll
            for (int j = 0; j < 2; ++j) { const float bt = pre[j] + b[j][i];
                const float eq = __expf(fminf(bt - r[j], 80.f)), ek = __expf(fminf(r[j] - bt, 80.f));
                qb[j] = f2bf(qv[j][i] * eq); kb[j] = f2bf(kv[j][i] * ek);
                if (i & 1) kpk[j][i >> 1] |= kb[j] << 16; else kpk[j][i >> 1] = kb[j]; }
            const int tau = 8 * ts + i;
            *(LAS unsigned*)(QT + tau * 136 + 2 * kp) = qb[0] | (qb[1] << 16);
            *(LAS unsigned*)(KT + tau * 136 + 2 * kp) = kb[0] | (kb[1] << 16);
        }
#pragma unroll
        for (int j = 0; j < 2; ++j) *(LAS v4u*)(KTT + (2 * kp + j) * 72 + 8 * ts) = (v4u){kpk[j][0], kpk[j][1], kpk[j][2], kpk[j][3]};
        if (ts == 0) {
#pragma unroll
            for (int j = 0; j < 2; ++j) { ER[2 * kp + j] = __expf(r[j]); EE[2 * kp + j] = __expf(bend[j] - r[j]); } }
        __syncthreads();
#pragma unroll
        for (int e = 0; e < 2; ++e) { const int id = wave * 2 + e, tt = id >> 2, st = id & 3;
            f32x4 a = (f32x4){0.f, 0.f, 0.f, 0.f};
            if (st <= tt) a = mma_lds<128>(a, QT + tt * 16 * 136, 136, KT + st * 16 * 136, 136, lane);
#pragma unroll
            for (int i = 0; i < 4; ++i) { const int t = tt * 16 + quad * 4 + i, s = st * 16 + c16; const float val = (st <= tt && s <= t) ? a[i] : 0.f; AM[t * 72 + s] = (bf16)f2bf(val); } }
        __syncthreads();
        unsigned char* dst = SCR + (size_t)item * HP_BLK;
#pragma unroll
        for (int j = 0; j < 6; ++j) { const int idx = tid + 512 * j; *(v4u*)(dst + (size_t)idx * 16) = *(const LAS v4u*)(lds + idx * 16); }
        __syncthreads();
    }
#undef HP_LOAD
}

template <int NVT> __device__ __forceinline__ void hg_scan_item(LAS unsigned char* lds, bf16* PA, const unsigned char* SCR, int item, int T, int tid) {
    constexpr int NVS = 8 / NVT, VW = 16 * NVT, VTHR = 128 * NVT, VSH = (NVT == 2) ? 2 : 1;
    const int lane = tid & 63, wave = __builtin_amdgcn_readfirstlane(tid >> 6), c16 = lane & 15, quad = lane >> 4;
    const int vs = item % NVS, sd = item / NVS, dir = sd & 1, h = (sd >> 1) & 3, seq = sd >> 3;
    const int base = seq * T, nchunk = T / 64;
    const unsigned char* blk = SCR + (size_t)sd * nchunk * HP_BLK;
    const bf16* vsrc = PA + C_HI + h * 128 + vs * VW + (tid & (VW / 8 - 1)) * 8;
    bf16* odst = PA + (dir ? C_HZF : C_HQ) + h * 128 + vs * VW;
    v4u preA[6], preB[6]; v4u vrA = {0u, 0u, 0u, 0u}, vrB = vrA; f32x4 ervA, eevA, ervB, eevB;
#define HG_ROW(tau) (base + (dir ? (T - 1 - (tau)) : (tau)))
#define HS_LOAD(c, pre, vr, erv, eev) do { const int c_ = min((c), nchunk - 1); const unsigned char* bp = blk + (size_t)c_ * HP_BLK;     \
        _Pragma("unroll") for (int j = 0; j < 6; ++j) pre[j] = *(const v4u*)(bp + (size_t)(tid + 512 * j) * 16); \
        erv = *(const f32x4*)(bp + HP_ER + (wave * 16 + quad * 4) * 4); eev = *(const f32x4*)(blk + (size_t)max(c_ - 1, 0) * HP_BLK + HP_EE + (wave * 16 + quad * 4) * 4);     \
        vr = *(const v4u*)(vsrc + (size_t)HG_ROW(c_ * 64 + ((tid & (VTHR - 1)) >> VSH)) * PA_LD); } while (0)
    HS_LOAD(0, preA, vrA, ervA, eevA);
    HS_LOAD(1, preB, vrB, ervB, eevB);
    f32x4 accS[NVT];
#pragma unroll
    for (int e = 0; e < NVT; ++e) accS[e] = (f32x4){0.f, 0.f, 0.f, 0.f};
#define HS_STEP(c, BUFI, pre, vr, erv, eev) do { \
        LAS unsigned char* B = lds + (BUFI) * HS_BUF; \
        LAS bf16* QT = (LAS bf16*)(B + HP_QT); LAS bf16* KTT = (LAS bf16*)(B + HP_KTT); LAS bf16* AM = (LAS bf16*)(B + HP_AM); \
        LAS bf16* VT = (LAS bf16*)(B + HS_VT); LAS bf16* STt = (LAS bf16*)(B + HS_ST); \
        _Pragma("unroll") for (int j = 0; j < 6; ++j) *(LAS v4u*)(B + (tid + 512 * j) * 16) = pre[j]; \
        if (tid < VTHR) { const int s_ = tid >> VSH, vq = tid & (VW / 8 - 1); \
            VT[(vq * 8 + 0) * 72 + s_] = (bf16)(vr.x & 0xffffu); VT[(vq * 8 + 1) * 72 + s_] = (bf16)(vr.x >> 16); \
            VT[(vq * 8 + 2) * 72 + s_] = (bf16)(vr.y & 0xffffu); VT[(vq * 8 + 3) * 72 + s_] = (bf16)(vr.y >> 16); \
            VT[(vq * 8 + 4) * 72 + s_] = (bf16)(vr.z & 0xffffu); VT[(vq * 8 + 5) * 72 + s_] = (bf16)(vr.z >> 16); \
            VT[(vq * 8 + 6) * 72 + s_] = (bf16)(vr.w & 0xffffu); VT[(vq * 8 + 7) * 72 + s_] = (bf16)(vr.w >> 16); } \
        f32x4 sp[NVT]; const f32x4 sc_ = erv * eev;     \
        _Pragma("unroll") for (int e = 0; e < NVT; ++e) { sp[e] = accS[e] * sc_; v2u w; w.x = cvt_pk_bf16(sp[e][0], sp[e][1]); w.y = cvt_pk_bf16(sp[e][2], sp[e][3]); \
            *(LAS v2u*)(STt + (e * 16 + c16) * 136 + wave * 16 + quad * 4) = w; } \
        HS_LOAD((c) + 2, pre, vr, erv, eev); \
        __syncthreads(); \
        if ((wave >> 2) < NVT) { const int tt = wave & 3, vt = wave >> 2; f32x4 o = (f32x4){0.f, 0.f, 0.f, 0.f}; \
          o = mma_lds<128>(o, QT + tt * 16 * 136, 136, STt + vt * 16 * 136, 136, lane); \
          o = mma_lds<64>(o, AM + tt * 16 * 72, 72, VT + vt * 16 * 72, 72, lane); \
          _Pragma("unroll") for (int i = 0; i < 4; ++i) { const int tau = (c) * 64 + tt * 16 + quad * 4 + i; odst[(size_t)HG_ROW(tau) * PA_LD + vt * 16 + c16] = (bf16)f2bf(o[i]); } } \
        _Pragma("unroll") for (int e = 0; e < NVT; ++e) { accS[e] = mma_lds<64>(sp[e], KTT + wave * 16 * 72, 72, VT + e * 16 * 72, 72, lane); } \
    } while (0)
    for (int c = 0; c < nchunk; c += 2) {
        HS_STEP(c, 0, preA, vrA, ervA, eevA);
        HS_STEP(c + 1, 1, preB, vrB, ervB, eevB);
    }
    __syncthreads();
#undef HG_ROW
#undef HS_LOAD
#undef HS_STEP
}

__device__ __forceinline__ void na_item(LAS unsigned char* lds, const bf16* PA, const float* rpb, bf16* ONA, int item, int T, int tid) {
    const int lane = tid & 63, h = __builtin_amdgcn_readfirstlane(tid >> 6), c16 = lane & 15, quad = lane >> 4;
    const int ips = T / 16, seq = item / ips, rem = item % ips, r = rem >> 2, j = rem & 3;
    const int rows = T / 64, rs = min(max(r - 4, 0), rows - 8), kstart = (j == 0) ? 0 : (j == 1) ? 8 : (j == 2) ? 24 : 32;
    const int base = seq * T, qtok = base + r * 64 + 16 * j + c16;
    const bf16* qp = PA + (size_t)qtok * PA_LD + C_NQ + h * 64 + quad * 8;
    const bf16x8 Qb0 = *(const bf16x8*)qp, Qb1 = *(const bf16x8*)(qp + 32);
    const int qcol = 16 * j + c16, cs = min(max(qcol - 8, 0), 48);
    v4u vbufA[8], vbufB[8], vbufC[8], vbufD[8];
#define NA_VLOAD(qd, vbuf) do { _Pragma("unroll") for (int it = 0; it < 8; ++it) { const int idx = it * 64 + lane, key = idx >> 3, dg = idx & 7; \
        const int tok = base + (rs + 2 * (qd) + (key >> 5)) * 64 + kstart + (key & 31); vbuf[it] = *(const v4u*)(PA + (size_t)tok * PA_LD + C_NV + h * 64 + dg * 8); } } while (0)
    NA_VLOAD(0, vbufA); NA_VLOAD(1, vbufB);
    const float* rp = rpb + h * 465;
    f32x4 sacc[16]; float mx = -3e38f;
    int dcv[8]; bool okv[8];
#pragma unroll
    for (int e = 0; e < 8; ++e) { const int kcol = kstart + (e >> 2) * 16 + quad * 4 + (e & 3); okv[e] = (kcol >= cs) && (kcol < cs + 16); dcv[e] = min(max(kcol - qcol + 15, 0), 30); }
#pragma unroll
    for (int a = 0; a < 8; ++a) {
        const float rowv = rp[(rs + a - r + 7) * 31 + min(lane, 30)];
        float bv[8];
#pragma unroll
        for (int e = 0; e < 8; ++e) bv[e] = __builtin_bit_cast(float, __builtin_amdgcn_ds_bpermute(dcv[e] << 2, __builtin_bit_cast(int, rowv)));
#pragma unroll
        for (int hh = 0; hh < 2; ++hh) {
            const int ktok = base + (rs + a) * 64 + kstart + hh * 16 + c16;
            const bf16* kp = PA + (size_t)ktok * PA_LD + C_NK + h * 64 + quad * 8;
            const bf16x8 Ka0 = *(const bf16x8*)kp, Ka1 = *(const bf16x8*)(kp + 32);
            f32x4 s = (f32x4){0.f, 0.f, 0.f, 0.f};
            s = __builtin_amdgcn_mfma_f32_16x16x32_bf16(Ka0, Qb0, s, 0, 0, 0);
            s = __builtin_amdgcn_mfma_f32_16x16x32_bf16(Ka1, Qb1, s, 0, 0, 0);
#pragma unroll
            for (int i = 0; i < 4; ++i) { const float val = okv[hh * 4 + i] ? s[i] * 0.125f + bv[hh * 4 + i] : -1e30f; s[i] = val; mx = fmaxf(mx, val); }
            sacc[a * 2 + hh] = s;
        }
    }
    NA_VLOAD(2, vbufC); NA_VLOAD(3, vbufD);
    mx = fmaxf(mx, __shfl_xor(mx, 16)); mx = fmaxf(mx, __shfl_xor(mx, 32));
    float sum = 0.f;
#pragma unroll
    for (int t = 0; t < 16; ++t)
#pragma unroll
        for (int i = 0; i < 4; ++i) { const float p = __expf(sacc[t][i] - mx); sacc[t][i] = p; sum += p; }
    sum += __shfl_xor(sum, 16); sum += __shfl_xor(sum, 32);
    bf16x8 pb[8];
#pragma unroll
    for (int a = 0; a < 8; ++a) { v4u w; w.x = cvt_pk_bf16(sacc[2 * a][0], sacc[2 * a][1]); w.y = cvt_pk_bf16(sacc[2 * a][2], sacc[2 * a][3]);
        w.z = cvt_pk_bf16(sacc[2 * a + 1][0], sacc[2 * a + 1][1]); w.w = cvt_pk_bf16(sacc[2 * a + 1][2], sacc[2 * a + 1][3]); pb[a] = __builtin_bit_cast(bf16x8, w); }
    LAS bf16* VS = (LAS bf16*)(lds + h * 10240);
    f32x4 oacc[4];
#pragma unroll
    for (int dt = 0; dt < 4; ++dt) oacc[dt] = (f32x4){0.f, 0.f, 0.f, 0.f};
    const int trq = (lane & 15) >> 2, trp = lane & 3;
    const LAS bf16* trbase = VS + (quad * 4 + trq) * 80 + 4 * trp;
#define NA_PV(qd, vbuf) do { \
        _Pragma("unroll") for (int it = 0; it < 8; ++it) { const int idx = it * 64 + lane, key = idx >> 3, dg = idx & 7; *(LAS v4u*)(VS + key * 80 + dg * 8) = vbuf[it]; } \
        _Pragma("unroll") for (int al = 0; al < 2; ++al) \
            _Pragma("unroll") for (int dt = 0; dt < 4; ++dt) { const LAS bf16* p = trbase + al * 32 * 80 + dt * 16; \
                const v4i16_t lo = __builtin_amdgcn_ds_read_tr16_b64_v4i16((LAS v4i16_t*)p), hi = __builtin_amdgcn_ds_read_tr16_b64_v4i16((LAS v4i16_t*)(p + 16 * 80)); \
                const bf16x8 af = {lo[0], lo[1], lo[2], lo[3], hi[0], hi[1], hi[2], hi[3]}; \
                oacc[dt] = __builtin_amdgcn_mfma_f32_16x16x32_bf16(af, pb[(qd) * 2 + al], oacc[dt], 0, 0, 0); } } while (0)
    NA_PV(0, vbufA); NA_PV(1, vbufB); NA_PV(2, vbufC); NA_PV(3, vbufD);
#undef NA_PV
#undef NA_VLOAD
    const float inv = __builtin_amdgcn_rcpf(sum);
#pragma unroll
    for (int dt = 0; dt < 4; ++dt) { const f32x4 o = oacc[dt] * inv; v2u w; w.x = cvt_pk_bf16(o[0], o[1]); w.y = cvt_pk_bf16(o[2], o[3]);
        *(v2u*)(ONA + (size_t)qtok * 512 + h * 64 + dt * 16 + quad * 4) = w; }
}

#define XB_TMO      128
#define XB_XCNT(j)  (256  + 64 * (j))
#define XB_XSUB(j)  (1280 + 64 * (j))
#define XB_XGEN(j)  (2304 + 64 * (j))
#define XB_TOP      3328
#define XB_TOPGEN   3392
#define XCD_BAR_WORDS 3456
#define XB_SPIN_CAP (1u << 18)

__device__ __forceinline__ unsigned xb_ld(unsigned* p)              { return __hip_atomic_load(p, __ATOMIC_RELAXED, __HIP_MEMORY_SCOPE_AGENT); }
__device__ __forceinline__ unsigned xb_add(unsigned* p, unsigned v) { return __hip_atomic_fetch_add(p, v, __ATOMIC_RELAXED, __HIP_MEMORY_SCOPE_AGENT); }
__device__ __forceinline__ unsigned xb_xcc_id() { return (unsigned)__builtin_amdgcn_s_getreg((3 << 11) | 20) & 0xFu; }
#define XB_SPIN(cond, bar) do { unsigned _sp = 0; while (cond) { __builtin_amdgcn_s_sleep(1); \
    if ((++_sp & 255u) == 0u) { if (xb_ld(&(bar)[XB_TMO])) break; if (_sp > XB_SPIN_CAP) { atomicAdd(&(bar)[XB_TMO], 1u); break; } } } } while (0)

struct XcdBarrier {
    unsigned* bar; unsigned x;
    volatile LAS unsigned* st;
};

__device__ __forceinline__ XcdBarrier xcd_barrier_post(unsigned* bar, volatile LAS unsigned* st) {
    XcdBarrier b; b.bar = bar; b.x = xb_xcc_id(); b.st = st;
    if (threadIdx.x == 0) (void)xb_add(&bar[XB_XCNT(b.x)], 1u);
    return b;
}
__device__ __forceinline__ void xcd_barrier_complete(unsigned* bar, unsigned x, unsigned& nloc, unsigned& nx) {
    const unsigned G = gridDim.x * gridDim.y * gridDim.z;
    unsigned sum, cnt, mine, sp = 0u;
    for (;;) {
        sum = 0u; cnt = 0u; mine = 0u;
#pragma unroll
        for (unsigned j = 0; j < 16; ++j) { const unsigned c = xb_ld(&bar[XB_XCNT(j)]); sum += c; cnt += (c > 0u) ? 1u : 0u; mine = (j == x) ? c : mine; }
        if (sum == G) break;
        __builtin_amdgcn_s_sleep(1);
        if ((++sp & 255u) == 0u) { if (xb_ld(&bar[XB_TMO])) break; if (sp > XB_SPIN_CAP) { atomicAdd(&bar[XB_TMO], 1u); break; } }
    }
    nloc = mine > 0u ? mine : 1u; nx = cnt > 0u ? cnt : 1u;
}

__device__ __forceinline__ void xcd_barrier(const XcdBarrier& b) {
    asm volatile("s_waitcnt vmcnt(0)" ::: "memory");
    __syncthreads();
    if (threadIdx.x == 0) {
        unsigned* bar = b.bar;
        __builtin_amdgcn_s_waitcnt(0);
        unsigned nloc = b.st[0], nx = b.st[1];
        if (nloc == 0u) { xcd_barrier_complete(bar, b.x, nloc, nx); b.st[0] = nloc; b.st[1] = nx; }
        const unsigned old = xb_add(&bar[XB_XSUB(b.x)], 1u);
        const unsigned gen = old / nloc;
        if (old + 1u == (gen + 1u) * nloc) {
            __builtin_amdgcn_fence(__ATOMIC_RELEASE, "agent");
            asm volatile("s_waitcnt vmcnt(0)" ::: "memory");
            const unsigned og = xb_add(&bar[XB_TOP], 1u);
            const unsigned tg = og / nx;
            if (og + 1u == (tg + 1u) * nx) xb_add(&bar[XB_TOPGEN], 1u);
            else XB_SPIN(xb_ld(&bar[XB_TOPGEN]) == tg, bar);
            __builtin_amdgcn_fence(__ATOMIC_ACQUIRE, "agent");
            xb_add(&bar[XB_XGEN(b.x)], 1u);
            asm volatile("s_waitcnt vmcnt(0)" ::: "memory");
        } else {
            XB_SPIN(xb_ld(&bar[XB_XGEN(b.x)]) == gen, bar);
            __builtin_amdgcn_fence(__ATOMIC_ACQUIRE, "agent");
            asm volatile("s_waitcnt vmcnt(0)" ::: "memory");
        }
    }
    __syncthreads();
}
struct Args { const float* in[20]; float* out; unsigned char* ws; int ph_lo, ph_hi; };
enum { K_CVT = 0, K_G0, K_UP, K_RES, K_M1, K_M2A, K_M2B, K_M3, K_M4, K_GF };

__global__ void __launch_bounds__(NTHR, 2) mk_fwd(Args args) {
    extern __shared__ __attribute__((aligned(16))) unsigned char lds_raw[];
    LAS unsigned char* lds = (LAS unsigned char*)lds_raw;
    cg::grid_group grid = cg::this_grid();
    const int hi = args.ph_hi;
    { volatile LAS unsigned* st0 = (volatile LAS unsigned*)(lds + LDS_MISC + 32); if (threadIdx.x < 2) st0[threadIdx.x] = 0u; __syncthreads(); }
    XcdBarrier xbar = xcd_barrier_post((unsigned*)(args.ws + WS_CTL) + CW_BAR, (volatile LAS unsigned*)(lds + LDS_MISC + 32));
#if TPROBE
    unsigned long long tacc = 0ull;
#endif
    for (int ph = args.ph_lo; ph < hi; ++ph) {
#if TPROBE
        const unsigned long long tp0 = __builtin_amdgcn_s_memrealtime();
#endif
        int bid = blockIdx.x, G = gridDim.x; asm volatile("" : "+s"(bid), "+s"(G));
        int tid = threadIdx.x; asm volatile("" : "+v"(tid));
        const int lane = tid & 63, wave = __builtin_amdgcn_readfirstlane(tid >> 6);
        const int gw = bid * NWAVES + wave, NGW = G * NWAVES;
        int kind, pr = 0, l = 0, s = 0, g2 = 0;
        if (ph == 0) kind = K_CVT;
        else { const int q = ph - 1; pr = q / PH_PER_PAIR; const int r = q % PH_PER_PAIR;
            if (r == 0) kind = K_G0; else if (r == PH_PER_PAIR - 1) kind = K_GF;
            else { l = (r - 1) / 16; s = (r - 1) % 16;
                if (s == 0 || s == 14) kind = K_UP; else if (s == 1 || s == 15) kind = K_RES;
                else { g2 = (s - 2) / 6; const int t = (s - 2) % 6; kind = (t == 0) ? K_M1 : (t == 1) ? K_M2A : (t == 2) ? K_M2B : (t == 3) ? K_M3 : (t == 4) ? K_M4 : K_RES; } } }
        const bool mix = (s >= 2 && s <= 13);
        unsigned char* ws = args.ws;
        bf16* XBp = (bf16*)(ws + WS_XB); float* SSQp = (float*)(ws + WS_SSQ);
        bf16* XB = XBp + (size_t)g2 * TG * D; float* SSQ = SSQp + (size_t)g2 * TG * 16;
        bf16* PA = (bf16*)(ws + WS_PA); bf16* PG = (bf16*)(ws + WS_PG);
        bf16* ONA = (bf16*)(ws + WS_ONA); bf16* OHG = ONA + (size_t)TG * 512; bf16* OCV = OHG + (size_t)TG * 512;
        unsigned char* SCR = ws + WS_SCR;
        const bf16* Wl = (const bf16*)(ws + WS_W) + (size_t)l * LAYER_EL;
        const int T = pr == 0 ? 2048 : 4096;
        const int g = pr * 2 + g2;
        float* X = args.out + (size_t)pr * 2 * TG * D;

        if (kind == K_CVT) {
            LAS float* scr = (LAS float*)(lds + wave * 16384);
            constexpr int I_GU = 16 * 176, I_DN = 44 * 32, I_IN = 16 * 272, I_MX = 8 * 32, I_OUT = 16 * 32;
            constexpr int I_LAYER = 2 * I_GU + 2 * I_DN + I_IN + 3 * I_MX + I_OUT, I_TOT = NLAYER * I_LAYER;
#define CVT_DECODE(it_) const int ll = (it_) / I_LAYER; int r = (it_) % I_LAYER; \
                const float* src; const float* gain = nullptr; int K, N; size_t off; bool perm = false; \
                if (r < I_GU) { src = args.in[3] + (size_t)ll * D * 2 * FF; K = D; N = 2 * FF; off = OFF_GU1; gain = args.in[2] + ll * D; perm = true; } \
                else if ((r -= I_GU) < I_DN) { src = args.in[4] + (size_t)ll * FF * D; K = FF; N = D; off = OFF_D1; } \
                else if ((r -= I_DN) < I_IN) { src = args.in[6] + (size_t)ll * D * 8704; K = D; N = 8704; off = OFF_IN; gain = args.in[5] + ll * D; } \
                else if ((r -= I_IN) < I_MX) { src = args.in[9] + (size_t)ll * 512 * D; K = 512; N = D; off = OFF_HG; } \
                else if ((r -= I_MX) < I_MX) { src = args.in[12] + (size_t)ll * 512 * D; K = 512; N = D; off = OFF_CV; } \
                else if ((r -= I_MX) < I_MX) { src = args.in[14] + (size_t)ll * 512 * D; K = 512; N = D; off = OFF_NA; } \
                else if ((r -= I_MX) < I_OUT) { src = args.in[15] + (size_t)ll * D * D; K = D; N = D; off = OFF_OUT; } \
                else if ((r -= I_OUT) < I_GU) { src = args.in[17] + (size_t)ll * D * 2 * FF; K = D; N = 2 * FF; off = OFF_GU2; gain = args.in[16] + ll * D; perm = true; } \
                else { r -= I_GU; src = args.in[18] + (size_t)ll * FF * D; K = FF; N = D; off = OFF_D2; } \
                const int nblk = N / 32, kb = r / nblk, nb = r % nblk, k0 = 64 * kb, n0 = 32 * nb;
#define CVT_LOAD(it_, wv) do { CVT_DECODE(min((it_), I_TOT - 1)) (void)off; (void)perm; \
                _Pragma("unroll") for (int i = 0; i < 32; ++i) { const int kk = 2 * i + (lane >> 5); wv[i] = src[(size_t)(k0 + kk) * N + n0 + (lane & 31)] * (gain ? gain[k0 + kk] : 1.0f); } } while (0)
#define CVT_PROC(it_, wv) do { CVT_DECODE(it_) (void)src; (void)gain; \
                _Pragma("unroll") for (int i = 0; i < 32; ++i) { const int kk = 2 * i + (lane >> 5); scr[kk * 33 + (lane & 31)] = wv[i]; } \
                asm volatile("s_waitcnt lgkmcnt(0)" ::: "memory"); \
                int dn0 = n0; if (perm) { const int half = n0 >= FF ? 1 : 0; const int j_ = n0 - half * FF; dn0 = (j_ >> 7) * 256 + half * 128 + (j_ & 127); } \
                bf16* WT = (bf16*)(ws + WS_W) + (size_t)ll * LAYER_EL + off; const int c_ = lane & 7; \
                _Pragma("unroll") for (int j = 0; j < 4; ++j) { const int n = (lane >> 3) + 8 * j; const LAS float* sp_ = scr + (8 * c_) * 33 + n; \
                    v4u o; o.x = cvt_pk_bf16(sp_[0 * 33], sp_[1 * 33]); o.y = cvt_pk_bf16(sp_[2 * 33], sp_[3 * 33]); o.z = cvt_pk_bf16(sp_[4 * 33], sp_[5 * 33]); o.w = cvt_pk_bf16(sp_[6 * 33], sp_[7 * 33]); \
                    *(v4u*)(WT + (size_t)(dn0 + n) * K + k0 + 8 * c_) = o; } \
                asm volatile("s_waitcnt lgkmcnt(0)" ::: "memory"); } while (0)
            float wa[32], wb[32];
            int it = gw;
            CVT_LOAD(it, wa);
            while (it < I_TOT) {
                CVT_LOAD(it + NGW, wb);
                CVT_PROC(it, wa);
                it += NGW;
                CVT_LOAD(it + NGW, wa);
                if (it < I_TOT) CVT_PROC(it, wb);
                it += NGW;
            }
#undef CVT_DECODE
#undef CVT_LOAD
#undef CVT_PROC
        } else if (kind == K_G0) {
            const float* xin = pr == 0 ? args.in[0] : args.in[1];
#pragma unroll 2
            for (int row = gw; row < 2 * TG; row += NGW) {
                const f32x4* __restrict__ xr = (const f32x4*)(xin + (size_t)row * D) + lane; v2u* bo = (v2u*)(XBp + (size_t)row * D) + lane;
                float ss = 0.f;
#pragma unroll
                for (int j = 0; j < 4; ++j) { const f32x4 v = xr[64 * j]; v2u w; w.x = cvt_pk_bf16(v[0], v[1]); w.y = cvt_pk_bf16(v[2], v[3]); bo[64 * j] = w; ss += (v[0] * v[0] + v[1] * v[1]) + (v[2] * v[2] + v[3] * v[3]); }
                ss = wave_sum(ss);
                if (lane < 16) SSQp[(size_t)row * 16 + lane] = lane == 0 ? ss : 0.f;
            }
        } else if (kind == K_UP) {
            pg8::Gemm gm{XBp, Wl + (s == 14 ? OFF_GU2 : OFF_GU1), 2 * TG, 2 * FF, D}; pg8::StaticOrder S; S.init(2 * TG, 2 * FF, G, bid);
            LAS float* rst = (LAS float*)(lds + 131072); LAS int* pml = (LAS int*)(lds + 131072 + 12288);
            __syncthreads();
            if (tid == 0) { int n = 0; pg8::Unit uu;
                for (int i = 0; S.next(i, uu); ++i) { bool f = false; for (int q = 0; q < n; ++q) f = f || (pml[q] == uu.pm); if (!f && n < 12) pml[n++] = uu.pm; }
                pml[15] = n; }
            __syncthreads();
            { const int n = pml[15];
              for (int idx = tid; idx < n * 256; idx += NTHR) { const int row = pml[idx >> 8] * 256 + (idx & 255); rst[idx] = pg8::row_rs(SSQp, row); } }
            __syncthreads();
            pg8::EpiSwiGLU E{PA, rst, pml, SSQp};
#ifndef NO_UP
            for (int rep = 0; rep < REP_GEMM; ++rep) pg8::gemm_phase<pg8::EpiSwiGLU, pg8::StaticOrder, PGA, PGS>(lds, gm, S, E);
#endif
        } else if (kind == K_RES) {
            const int K = mix ? D : FF, Mr = mix ? TG : 2 * TG; const size_t off = mix ? OFF_OUT : (s == 1 ? OFF_D1 : OFF_D2);
            pg8::Gemm gm{PA, Wl + off, Mr, D, K}; pg8::StaticOrder S; S.init(Mr, D, G, bid);
            pg8::EpiRes E{mix ? XB : XBp, mix ? SSQ : SSQp, mix ? 1.0f : 0.5f};
#ifndef NO_RES
            for (int rep = 0; rep < REP_RES; ++rep) { if (rep + 1 < REP_RES) { pg8::EpiRes E0 = E; E0.alpha = 0.f; pg8::gemm_phase<pg8::EpiRes, pg8::StaticOrder, PGA, PGS>(lds, gm, S, E0); }
                else pg8::gemm_phase<pg8::EpiRes, pg8::StaticOrder, PGA, PGS>(lds, gm, S, E); }
#endif
        } else if (kind == K_M1) {
            pg8::Gemm gm{XBp, Wl + OFF_IN, 2 * TG, 8704, D}; pg8::M1Order S; S.init(G, bid, g2);
            LAS float* rst = (LAS float*)(lds + 131072); LAS int* pml = (LAS int*)(lds + 131072 + 12288);
            __syncthreads();
            if (tid == 0) { int n = 0; pg8::Unit uu;
                for (int i = 0; S.next(i, uu); ++i) { bool f = false; for (int q = 0; q < n; ++q) f = f || (pml[q] == uu.pm); if (!f && n < 12) pml[n++] = uu.pm; }
                pml[15] = n; }
            __syncthreads();
            { const int n = pml[15];
              for (int idx = tid; idx < n * 256; idx += NTHR) { const int row = pml[idx >> 8] * 256 + (idx & 255); rst[idx] = pg8::row_rs(SSQp, row); } }
            __syncthreads();
            pg8::EpiProj E{PA, (unsigned char*)PG, (unsigned char*)PG + (size_t)TG * 3072, rst, pml, SSQp};
#ifndef NO_PROJ
            for (int rep = 0; rep < REP_GEMM; ++rep) pg8::gemm_phase<pg8::EpiProj, pg8::M1Order, PGA, PGS>(lds, gm, S, E);
#endif
        } else if (kind == K_M2A) {
#ifndef NO_HG
            { const int nP = (TG / 64) * 8;
              if (G == 256) { const int vcu1 = (bid % 8) * 32 + bid / 8; for (int rep = 0; rep < REP_HG; ++rep) hg_prep_items(lds, PA, SCR, args.in[7], l, vcu1 * (nP / 256), 1, (vcu1 + 1) * (nP / 256), T, tid); }
              else { for (int rep = 0; rep < REP_HG; ++rep) if (bid < nP) hg_prep_items(lds, PA, SCR, args.in[7], l, bid, G, nP, T, tid); } }
#endif
            const float* rpb = args.in[13] + (size_t)l * 8 * 465;
            const int vcu = (G % 8 == 0) ? (bid % 8) * (G / 8) + bid / 8 : bid;
            const int nNA = TG / 16, ipb = (nNA + G - 1) / G;
            for (int rep = 0; rep < REP_NA; ++rep)
                for (int q = 0; q < ipb; ++q) { const int it = vcu * ipb + q; if (it < nNA) {
#ifndef NO_NA
                    na_item(lds, PA, rpb, ONA, it, T, tid);
#endif
                    __syncthreads(); } }
        } else if (kind == K_M2B) {
#ifndef NO_HG
            const int vcu2 = (G % 8 == 0) ? (bid % 8) * (G / 8) + bid / 8 : bid;
            for (int rep = 0; rep < REP_HG; ++rep) {
                if (pr == 0) { for (int it = vcu2; it < 256; it += G) hg_scan_item<2>(lds, PA, SCR, it, T, tid); }
                else       { for (int it = vcu2; it < 256; it += G) hg_scan_item<1>(lds, PA, SCR, it, T, tid); }
            }
#endif
        } else if (kind == K_M3) {
            const float* gno = args.in[8] + l * 512; const float* cw = args.in[10] + l * 3 * 512; const float* cbias = args.in[11] + l * 512;
            const int c0 = lane * 8;
            const bf16* __restrict__ PAr = PA; bf16* __restrict__ OHGr = OHG; bf16* __restrict__ OCVr = OCV;
            const f32x4 gn0 = *(const f32x4*)(gno + c0), gn1 = *(const f32x4*)(gno + c0 + 4);
            const f32x4 w00 = *(const f32x4*)(cw + c0), w01 = *(const f32x4*)(cw + c0 + 4), w10 = *(const f32x4*)(cw + 512 + c0), w11 = *(const f32x4*)(cw + 512 + c0 + 4);
            const f32x4 w20 = *(const f32x4*)(cw + 1024 + c0), w21 = *(const f32x4*)(cw + 1024 + c0 + 4), bs0 = *(const f32x4*)(cbias + c0), bs1 = *(const f32x4*)(cbias + c0 + 4);
#pragma unroll 2
            for (int row = gw; row < TG; row += NGW) {
                const bf16* __restrict__ prow = PAr + (size_t)row * PA_LD;
                const v4u fw = *(const v4u*)(prow + C_HQ + c0), bw = *(const v4u*)(prow + C_HZF + c0);
                float o[8] = {bflo(fw.x) + bflo(bw.x), bfhi(fw.x) + bfhi(bw.x), bflo(fw.y) + bflo(bw.y), bfhi(fw.y) + bfhi(bw.y), bflo(fw.z) + bflo(bw.z), bfhi(fw.z) + bfhi(bw.z), bflo(fw.w) + bflo(bw.w), bfhi(fw.w) + bfhi(bw.w)};
                float ss = 0.f;
#pragma unroll
                for (int e = 0; e < 8; ++e) ss += o[e] * o[e];
                ss += __shfl_xor(ss, 1); ss += __shfl_xor(ss, 2); ss += __shfl_xor(ss, 4); ss += __shfl_xor(ss, 8);
                const float rs = __builtin_amdgcn_rsqf(ss * (1.0f / 128.0f) + 1e-6f);
                const v4u hgw = *(const v4u*)(prow + C_HG + c0);
                const float hgv[8] = {bflo(hgw.x), bfhi(hgw.x), bflo(hgw.y), bfhi(hgw.y), bflo(hgw.z), bfhi(hgw.z), bflo(hgw.w), bfhi(hgw.w)};
                const float gn[8] = {gn0[0], gn0[1], gn0[2], gn0[3], gn1[0], gn1[1], gn1[2], gn1[3]};
                float r8[8];
#pragma unroll
                for (int e = 0; e < 8; ++e) r8[e] = o[e] * rs * gn[e] * (hgv[e] * sigm(hgv[e]));
                v4u wo; wo.x = cvt_pk_bf16(r8[0], r8[1]); wo.y = cvt_pk_bf16(r8[2], r8[3]); wo.z = cvt_pk_bf16(r8[4], r8[5]); wo.w = cvt_pk_bf16(r8[6], r8[7]);
                *(v4u*)(OHGr + (size_t)row * 512 + c0) = wo;
                const int tl = row & (T - 1);
                const v4u a1 = *(const v4u*)(prow + C_CA + c0), c1 = *(const v4u*)(prow + C_CC + c0), bb = *(const v4u*)(prow + C_CB + c0);
                v4u a0 = {0u, 0u, 0u, 0u}, cc0 = a0, a2 = a0, cc2 = a0;
                if (tl > 0) { a0 = *(const v4u*)(prow - PA_LD + C_CA + c0); cc0 = *(const v4u*)(prow - PA_LD + C_CC + c0); }
                if (tl < T - 1) { a2 = *(const v4u*)(prow + PA_LD + C_CA + c0); cc2 = *(const v4u*)(prow + PA_LD + C_CC + c0); }
                const float zm[8] = {bflo(a0.x) * bflo(cc0.x), bfhi(a0.x) * bfhi(cc0.x), bflo(a0.y) * bflo(cc0.y), bfhi(a0.y) * bfhi(cc0.y), bflo(a0.z) * bflo(cc0.z), bfhi(a0.z) * bfhi(cc0.z), bflo(a0.w) * bflo(cc0.w), bfhi(a0.w) * bfhi(cc0.w)};
                const float zc[8] = {bflo(a1.x) * bflo(c1.x), bfhi(a1.x) * bfhi(c1.x), bflo(a1.y) * bflo(c1.y), bfhi(a1.y) * bfhi(c1.y), bflo(a1.z) * bflo(c1.z), bfhi(a1.z) * bfhi(c1.z), bflo(a1.w) * bflo(c1.w), bfhi(a1.w) * bfhi(c1.w)};
                const float zp[8] = {bflo(a2.x) * bflo(cc2.x), bfhi(a2.x) * bfhi(cc2.x), bflo(a2.y) * bflo(cc2.y), bfhi(a2.y) * bfhi(cc2.y), bflo(a2.z) * bflo(cc2.z), bfhi(a2.z) * bfhi(cc2.z), bflo(a2.w) * bflo(cc2.w), bfhi(a2.w) * bfhi(cc2.w)};
                const float cbv[8] = {bflo(bb.x), bfhi(bb.x), bflo(bb.y), bfhi(bb.y), bflo(bb.z), bfhi(bb.z), bflo(bb.w), bfhi(bb.w)};
#pragma unroll
                for (int e = 0; e < 4; ++e) { r8[e] = cbv[e] * (w00[e] * zm[e] + w10[e] * zc[e] + w20[e] * zp[e] + bs0[e]); r8[4 + e] = cbv[4 + e] * (w01[e] * zm[4 + e] + w11[e] * zc[4 + e] + w21[e] * zp[4 + e] + bs1[e]); }
                wo.x = cvt_pk_bf16(r8[0], r8[1]); wo.y = cvt_pk_bf16(r8[2], r8[3]); wo.z = cvt_pk_bf16(r8[4], r8[5]); wo.w = cvt_pk_bf16(r8[6], r8[7]);
                *(v4u*)(OCVr + (size_t)row * 512 + c0) = wo;
            }
        } else if (kind == K_M4) {
            pg8::Gemm gm{ONA, Wl + OFF_HG, 3 * TG, 3 * D, 512}; pg8::MergeOrder S; S.init(TG, D, G, bid);
            pg8::EpiMerge E{(const unsigned char*)PG + (size_t)g2 * TG * 3072, PA};
#ifndef NO_MERGE
            for (int rep = 0; rep < REP_MERGE; ++rep) pg8::gemm_phase<pg8::EpiMerge, pg8::MergeOrder, PGA, PGS>(lds, gm, S, E);
#endif
        } else {
            const f32x4* fg = (const f32x4*)args.in[19] + lane;
#pragma unroll 2
            for (int row = gw; row < 2 * TG; row += NGW) {
                const float rs = pg8::row_rs(SSQp, row);
                f32x4* __restrict__ xo = (f32x4*)(X + (size_t)row * D) + lane; const v2u* __restrict__ bi = (const v2u*)(XBp + (size_t)row * D) + lane;
#pragma unroll
                for (int j = 0; j < 4; ++j) { const v2u w = bi[64 * j]; const f32x4 v = {bflo(w.x), bfhi(w.x), bflo(w.y), bfhi(w.y)}; xo[64 * j] = v * fg[64 * j] * rs; }
            }
        }
#if TPROBE
        __syncthreads();
        const unsigned long long tp1 = __builtin_amdgcn_s_memrealtime();
#endif
        if (ph + 1 < hi) { for (int rep = 0; rep < REP_SYNC; ++rep) { if (hi < 0) grid.sync(); else xcd_barrier(xbar);     } }
#if TPROBE
        const unsigned long long tp2 = __builtin_amdgcn_s_memrealtime();
        if (TPROBE == 100) tacc += tp2 - tp1;
        else if (kind == TPROBE - 1) tacc += tp1 - tp0;
#endif
    }
#if TPROBE
    if (blockIdx.x == TPROBE_BLOCK) { const unsigned long long te = __builtin_amdgcn_s_memrealtime(); while (__builtin_amdgcn_s_memrealtime() - te < tacc) __builtin_amdgcn_s_sleep(8); }
#endif
}
constexpr int N_PHASES = 1 + 2 * PH_PER_PAIR;

extern "C" void kernel_launch(void* const* d_in, const int* in_sizes, int n_in, void* d_out, int out_size, void* d_ws, size_t ws_size, hipStream_t stream) {
    static int grid = 0;
    if (grid == 0) {
        if (n_in != 20 || ws_size < WS_END) { fprintf(stderr, "kernel_launch: unexpected n_in %d / ws %zu\n", n_in, ws_size); grid = -1; return; }
        int dev = 0, cus = 0, per_cu = 0;
        hipGetDevice(&dev); hipDeviceGetAttribute(&cus, hipDeviceAttributeMultiprocessorCount, dev);
        hipFuncSetAttribute((const void*)mk_fwd, hipFuncAttributeMaxDynamicSharedMemorySize, LDS_BYTES);
        hipOccupancyMaxActiveBlocksPerMultiprocessor(&per_cu, (const void*)mk_fwd, NTHR, LDS_BYTES);
        if (per_cu < 1) per_cu = 1;
        grid = cus * per_cu;
        (void)hipGetLastError();
    }
    if (grid < 0) return;
    hipMemsetAsync((char*)d_ws + WS_CTL, 0, CTL_BYTES, stream);
    Args a{};
    for (int i = 0; i < 20; ++i) a.in[i] = (const float*)d_in[i];
    a.out = (float*)d_out; a.ws = (unsigned char*)d_ws;
#if ONE_LAUNCH
    a.ph_lo = 0; a.ph_hi = N_PHASES;
    void* kargs[] = {&a};
    hipError_t e = hipLaunchCooperativeKernel((const void*)mk_fwd, dim3(grid), dim3(NTHR), kargs, LDS_BYTES, stream);
    if (e != hipSuccess) fprintf(stderr, "cooperative launch failed: %s (grid %d)\n", hipGetErrorString(e), grid);
#else
    for (int p = 0; p < N_PHASES; ++p) { a.ph_lo = p; a.ph_hi = p + 1; hipLaunchKernelGGL(mk_fwd, dim3(grid), dim3(NTHR), LDS_BYTES, stream, a); }
#endif
}
```

```cpp
#include <hip/hip_runtime.h>
#include <hip/hip_cooperative_groups.h>
#include <cstdio>
#include <cstdint>
namespace cg = cooperative_groups;
#ifndef ONE_LAUNCH
#define ONE_LAUNCH 1
#endif
#ifndef REP_HG
#define REP_HG 1
#endif
#ifndef REP_NA
#define REP_NA 1
#endif
#ifndef REP_SYNC
#define REP_SYNC 1
#endif
#ifndef REP_GEMM
#define REP_GEMM 1
#endif
#ifndef REP_M3
#define REP_M3 1
#endif
#ifndef REP_RES
#define REP_RES 1
#endif
#ifndef REP_MERGE
#define REP_MERGE 1
#endif
#ifndef REP_MISC
#define REP_MISC 1
#endif
#ifndef TPROBE
#define TPROBE 0
#endif
#ifndef TPROBE_BLOCK
#define TPROBE_BLOCK 0
#endif
#ifndef PGA
#define PGA true
#endif
#ifndef PGS
#define PGS true
#endif
#ifndef RS_PROBE
#define RS_PROBE 0
#endif
namespace pg8 {
#define PG8_LAS __attribute__((address_space(3)))
typedef unsigned short bf16_t;
typedef short bf16x8 __attribute__((ext_vector_type(8)));
typedef float f32x4 __attribute__((ext_vector_type(4)));
typedef unsigned u32x4 __attribute__((ext_vector_type(4)));
constexpr int BM = 256, BK = 64, HALF = 128, HTB = HALF * BK * 2  , STAGE_BYTES = 8 * HTB, NXCD = 8, WGM = 8;

__host__ __device__ __forceinline__ int lds_byte(int r, int c) { const int st = (r >> 4) * 2 + (c >> 5), rr = r & 15, cc = c & 31, ob = rr * 64 + cc * 2; return st * 1024 + (ob ^ (((ob >> 9) & 1) << 5)); }
__host__ __device__ __forceinline__ void stage_rc(int b, int& R, int& C) { const int st = b / 1024, sb = b % 1024, swz = sb ^ (((sb >> 9) & 1) << 5); R = (st >> 1) * 16 + swz / 64; C = (st & 1) * 32 + (swz % 64) / 2; }
__host__ __device__ __forceinline__ int perm32(int rho) { const int n = rho >> 4, i = rho & 15; return 8 * (i >> 2) + 4 * n + (i & 3); }

struct Unit { int pm, pn; };
struct Gemm { const bf16_t* A; const bf16_t* Bt; int M, N, K; };

struct StaticOrder {
    int nM, nN, nwg, G, c;
    __host__ __device__ void init(int M, int N, int G_, int c_) { nM = M / BM; nN = N / BM; nwg = nM * nN; G = G_; c = c_; }
    __host__ __device__ bool next(int i, Unit& u) const {
        const long L = (long)i * G + c; if (L >= nwg) return false;
        int wgid = (int)L; { const int q = nwg / NXCD, r = nwg % NXCD, xcd = wgid % NXCD, off = wgid / NXCD; wgid = (xcd < r ? xcd * (q + 1) : r * (q + 1) + (xcd - r) * q) + off; }
        const int nig = WGM * nN, gid = wgid / nig, fm = gid * WGM, gsz = (nM - fm) < WGM ? (nM - fm) : WGM;
        u.pm = fm + ((wgid % nig) % gsz); u.pn = (wgid % nig) / gsz; return true;
    }
    __device__ __forceinline__ void a_ready(const Unit&) const {}
    __device__ __forceinline__ void done(const Unit&) const {}
};

__device__ __forceinline__ unsigned cvt_pk_bf16(float lo, float hi) { unsigned r; asm volatile("v_cvt_pk_bf16_f32 %0, %1, %2" : "=v"(r) : "v"(lo), "v"(hi)); return r; }
__device__ __forceinline__ float row_rs(const float* ssq, int row) {
    const f32x4* p = (const f32x4*)(ssq + (size_t)row * 16);
    const f32x4 a = p[0], b = p[1], c = p[2], d = p[3];
    const float s = (((a[0] + a[1]) + (a[2] + a[3])) + ((b[0] + b[1]) + (b[2] + b[3]))) + (((c[0] + c[1]) + (c[2] + c[3])) + ((d[0] + d[1]) + (d[2] + d[3])));
    return __builtin_amdgcn_rsqf(s * (1.0f / 1024.0f) + 1e-6f);
}
__device__ __forceinline__ void row_rs8_impl(const float* ssq, int row0, float (&rsv)[8]) {
#pragma unroll
    for (int ai = 0; ai < 2; ++ai) {
        f32x4 p[4][4];
#pragma unroll
        for (int m = 0; m < 4; ++m) { const f32x4* q = (const f32x4*)(ssq + (size_t)(row0 + ai * HALF + m * 16) * 16);
#pragma unroll
            for (int j = 0; j < 4; ++j) p[m][j] = q[j]; }
#pragma unroll
        for (int m = 0; m < 4; ++m) { float t = 0.f;
#pragma unroll
            for (int j = 0; j < 4; ++j) t += (p[m][j][0] + p[m][j][1]) + (p[m][j][2] + p[m][j][3]);
            rsv[ai * 4 + m] = __builtin_amdgcn_rsqf(t * (1.0f / 1024.0f) + 1e-6f); }
    }
}
__device__ __forceinline__ void row_rs8(const float* ssq, int row0, float (&rsv)[8]) {
#if RS_PROBE
    { const float* ssq2 = ssq; asm volatile("" : "+s"(ssq2)); float t2[8]; row_rs8_impl(ssq2, row0, t2); row_rs8_impl(ssq, row0, rsv);
#pragma unroll
      for (int i = 0; i < 8; ++i) rsv[i] = 0.5f * (rsv[i] + t2[i]); return; }
#endif
    row_rs8_impl(ssq, row0, rsv);
}
__device__ __forceinline__ void row_rs8_lds(const PG8_LAS float* rst, const PG8_LAS int* pml, const float* ssq, int pm, int wr, int fr, float (&rsv)[8]) {
    const int n = pml[15]; int slot = -1;
#pragma unroll
    for (int s_ = 0; s_ < 12; ++s_) if (s_ < n && pml[s_] == pm) slot = s_;
    if (slot < 0) { row_rs8(ssq, pm * BM + wr * 64 + fr, rsv); return; }
    const PG8_LAS float* t = rst + slot * 256 + wr * 64 + fr;
#pragma unroll
    for (int ai = 0; ai < 2; ++ai)
#pragma unroll
        for (int m = 0; m < 4; ++m) rsv[ai * 4 + m] = t[ai * HALF + m * 16];
}
__device__ __forceinline__ float sigm(float v) { return __builtin_amdgcn_rcpf(1.0f + __expf(-v)); }

struct EpiSwiGLU {
    static constexpr bool PERM = true, AFTER_DRAIN = false, CARRY = false;
    bf16_t* H; const PG8_LAS float* rst; const PG8_LAS int* pml; const float* ssq;
    __device__ __forceinline__ void operator()(const f32x4 (&acc)[2][2][4][2], const Unit& u, int wr, int wc, int fr, int fq) const {
        const int row0 = u.pm * BM + wr * 64 + fr, col0 = u.pn * 128 + wc * 32 + 8 * fq;
        float rsv[8]; row_rs8_lds(rst, pml, ssq, u.pm, wr, fr, rsv);
#pragma unroll
        for (int ai = 0; ai < 2; ++ai)
#pragma unroll
            for (int m = 0; m < 4; ++m) {
                const int row = row0 + ai * HALF + m * 16; const float rs = rsv[ai * 4 + m];
                u32x4 w;
#pragma unroll
                for (int n = 0; n < 2; ++n) {
                    const f32x4 a = acc[ai][0][m][n] * rs, b = acc[ai][1][m][n] * rs; f32x4 h;
#pragma unroll
                    for (int e = 0; e < 4; ++e) h[e] = a[e] * sigm(a[e]) * b[e];
                    w[2 * n] = cvt_pk_bf16(h[0], h[1]); w[2 * n + 1] = cvt_pk_bf16(h[2], h[3]);
                }
                *(u32x4*)(H + (size_t)row * 2816 + col0) = w;
            }
    }
};
__device__ __forceinline__ void unpack8(const u32x4 w, f32x4& lo, f32x4& hi) {
    lo[0] = __uint_as_float(w.x << 16); lo[1] = __uint_as_float(w.x & 0xffff0000u); lo[2] = __uint_as_float(w.y << 16); lo[3] = __uint_as_float(w.y & 0xffff0000u);
    hi[0] = __uint_as_float(w.z << 16); hi[1] = __uint_as_float(w.z & 0xffff0000u); hi[2] = __uint_as_float(w.w << 16); hi[3] = __uint_as_float(w.w & 0xffff0000u);
}
struct EpiRes {
    static constexpr bool PERM = true, AFTER_DRAIN = false, CARRY = false;
    bf16_t* XB; float* ssq; float alpha;
    __device__ __forceinline__ void operator()(const f32x4 (&acc)[2][2][4][2], const Unit& u, int wr, int wc, int fr, int fq) const {
        const int row0 = u.pm * BM + wr * 64 + fr, col0 = u.pn * BM + wc * 32 + 8 * fq;
#pragma unroll
        for (int ai = 0; ai < 2; ++ai) {
            u32x4 xin[4][2];
#pragma unroll
            for (int m = 0; m < 4; ++m)
#pragma unroll
                for (int bj = 0; bj < 2; ++bj) xin[m][bj] = *(const u32x4*)(XB + (size_t)(row0 + ai * HALF + m * 16) * 1024 + col0 + bj * HALF);
#pragma unroll
            for (int m = 0; m < 4; ++m) {
                const int row = row0 + ai * HALF + m * 16; float ss = 0.f;
#pragma unroll
                for (int bj = 0; bj < 2; ++bj) {
                    bf16_t* xp = XB + (size_t)row * 1024 + col0 + bj * HALF;
                    f32x4 x0, x1; unpack8(xin[m][bj], x0, x1);
                    x0 = x0 + acc[ai][bj][m][0] * alpha; x1 = x1 + acc[ai][bj][m][1] * alpha;
                    u32x4 w; w.x = cvt_pk_bf16(x0[0], x0[1]); w.y = cvt_pk_bf16(x0[2], x0[3]); w.z = cvt_pk_bf16(x1[0], x1[1]); w.w = cvt_pk_bf16(x1[2], x1[3]);
                    *(u32x4*)xp = w;
                    ss += ((x0[0] * x0[0] + x0[1] * x0[1]) + (x0[2] * x0[2] + x0[3] * x0[3])) + ((x1[0] * x1[0] + x1[1] * x1[1]) + (x1[2] * x1[2] + x1[3] * x1[3]));
                }
                ss += __shfl_xor(ss, 16); ss += __shfl_xor(ss, 32);
                if (fq == 0) ssq[(size_t)row * 16 + u.pn * 4 + wc] = ss;
            }
            asm volatile("" ::: "memory");
        }
    }
};
struct M1Order {
    StaticOrder so; int second, G, c;
    __device__ void init(int G_, int c_, int second_) { second = second_; G = G_; c = c_; so.init(16384, second_ ? 8192 : 8704, G_, c_); }
    __device__ bool next(int i, Unit& u) const {
        if (!second) { if (so.next(i, u)) return true;
            const long L = (long)i * G + c - 2176; if (L < 0 || L >= 128) return false; u.pm = 64 + (int)(L >> 1); u.pn = 22 + (int)(L & 1); return true; }
        Unit b; if (!so.next(i, b)) return false; u.pm = b.pm + 64; u.pn = b.pn < 22 ? b.pn : b.pn + 2; return true;
    }
    __device__ __forceinline__ void a_ready(const Unit&) const {}
    __device__ __forceinline__ void done(const Unit&) const {}
};
struct EpiProj {
    static constexpr bool PERM = true, AFTER_DRAIN = false, CARRY = false;
    bf16_t* PA; unsigned char* PGa; unsigned char* PGb; const PG8_LAS float* rst; const PG8_LAS int* pml; const float* ssq;
    __device__ __forceinline__ void operator()(const f32x4 (&acc)[2][2][4][2], const Unit& u, int wr, int wc, int fr, int fq) const {
        unsigned char* PG8 = u.pm < 64 ? PGa : PGb;
        const int prow0 = u.pm * BM + wr * 64 + fr, row0 = prow0 & 16383;
        float rsv[8]; row_rs8_lds(rst, pml, ssq, u.pm, wr, fr, rsv);
        if (u.pn < 22) {
            const int col0 = u.pn * BM + wc * 32 + 8 * fq;
#pragma unroll
            for (int ai = 0; ai < 2; ++ai)
#pragma unroll
                for (int m = 0; m < 4; ++m) {
                    const int row = row0 + ai * HALF + m * 16; const float rs = rsv[ai * 4 + m];
#pragma unroll
                    for (int bj = 0; bj < 2; ++bj) {
                        const f32x4 v0 = acc[ai][bj][m][0] * rs, v1 = acc[ai][bj][m][1] * rs;
                        u32x4 w; w.x = cvt_pk_bf16(v0[0], v0[1]); w.y = cvt_pk_bf16(v0[2], v0[3]); w.z = cvt_pk_bf16(v1[0], v1[1]); w.w = cvt_pk_bf16(v1[2], v1[3]);
                        *(u32x4*)(PA + (size_t)row * 5632 + col0 + bj * HALF) = w;
                    }
                }
        } else {
            const int col0 = (u.pn - 22) * BM + wc * 32 + 8 * fq;
#pragma unroll
            for (int ai = 0; ai < 2; ++ai)
#pragma unroll
                for (int m = 0; m < 4; ++m) {
                    const int row = row0 + ai * HALF + m * 16; const float rs = rsv[ai * 4 + m];
#pragma unroll
                    for (int bj = 0; bj < 2; ++bj) {
                        unsigned q[8];
#pragma unroll
                        for (int e = 0; e < 4; ++e) { q[e] = (unsigned)(sigm(acc[ai][bj][m][0][e] * rs) * 255.0f + 0.5f); q[4 + e] = (unsigned)(sigm(acc[ai][bj][m][1][e] * rs) * 255.0f + 0.5f); }
                        typedef unsigned u32x2_ __attribute__((ext_vector_type(2)));
                        u32x2_ w; w.x = q[0] | (q[1] << 8) | (q[2] << 16) | (q[3] << 24); w.y = q[4] | (q[5] << 8) | (q[6] << 16) | (q[7] << 24);
                        *(u32x2_*)(PG8 + (size_t)row * 3072 + col0 + bj * HALF) = w;
                    }
                }
        }
    }
};
struct MergeOrder {
    StaticOrder so;
    __device__ void init(int M, int N, int G_, int c_) { so.init(M, N, G_, c_); }
    __device__ bool next(int i, Unit& u) const { Unit b; if (!so.next(i / 3, b)) return false; const int m = i % 3, w = (m == 0) ? 2 : m - 1; u.pm = b.pm + 64 * m; u.pn = b.pn + 4 * w; return true; }
    __device__ __forceinline__ void a_ready(const Unit&) const {}
    __device__ __forceinline__ void done(const Unit&) const {}
};
struct EpiMerge {
    static constexpr bool PERM = true, AFTER_DRAIN = false, CARRY = true;
    const unsigned char* PG8; bf16_t* MB;
    __device__ __forceinline__ void operator()(const f32x4 (&)[2][2][4][2], const Unit&, int, int, int, int) const {}
    __device__ __forceinline__ bool carry(f32x4 (&acc)[2][2][4][2], const Unit& u, int wr, int wc, int fr, int fq) const {
        typedef unsigned u32x2_ __attribute__((ext_vector_type(2)));
        const int m_ = u.pm >> 6, pm = u.pm & 63, w_ = u.pn >> 2, pn = u.pn & 3;
        const int wn = (m_ == 0) ? 0 : 1;
        const bool last = (m_ == 2);
        const int row0 = pm * BM + wr * 64 + fr, col0 = pn * BM + wc * 32 + 8 * fq;
#pragma unroll
        for (int ai = 0; ai < 2; ++ai) {
            u32x2_ gc[4][2], gn[4][2];
#pragma unroll
            for (int m = 0; m < 4; ++m)
#pragma unroll
                for (int bj = 0; bj < 2; ++bj) { const size_t o = (size_t)(row0 + ai * HALF + m * 16) * 3072 + col0 + bj * HALF;
                    gc[m][bj] = *(const u32x2_*)(PG8 + o + w_ * 1024);
                    gn[m][bj] = last ? (u32x2_){0x01010101u, 0x01010101u} : *(const u32x2_*)(PG8 + o + wn * 1024); }
#pragma unroll
            for (int m = 0; m < 4; ++m)
#pragma unroll
                for (int bj = 0; bj < 2; ++bj) {
                    float f[8];
#pragma unroll
                    for (int e = 0; e < 8; ++e) { const unsigned wc_ = e < 4 ? gc[m][bj].x : gc[m][bj].y, wn_ = e < 4 ? gn[m][bj].x : gn[m][bj].y; const int sh = 8 * (e & 3);
                        const float qc = (float)max((wc_ >> sh) & 255u, 1u), qn = (float)max((wn_ >> sh) & 255u, 1u);
                        f[e] = last ? qc * (1.0f / 255.0f) : qc * __builtin_amdgcn_rcpf(qn); }
#pragma unroll
                    for (int e = 0; e < 4; ++e) { acc[ai][bj][m][0][e] *= f[e]; acc[ai][bj][m][1][e] *= f[4 + e]; }
                    if (last) { const f32x4 t0 = acc[ai][bj][m][0], t1 = acc[ai][bj][m][1];
                        u32x4 w; w.x = cvt_pk_bf16(t0[0], t0[1]); w.y = cvt_pk_bf16(t0[2], t0[3]); w.z = cvt_pk_bf16(t1[0], t1[1]); w.w = cvt_pk_bf16(t1[2], t1[3]);
                        *(u32x4*)(MB + (size_t)(row0 + ai * HALF + m * 16) * 1024 + col0 + bj * HALF) = w; }
                }
            asm volatile("" ::: "memory");
        }
        return !last;
    }
};
template <class Epi, class Sched, bool ALIGN_EPI = false, bool SP2 = false>
__device__ __forceinline__ void gemm_phase(PG8_LAS unsigned char* lds, const Gemm g, const Sched& S, const Epi& E) {
    int tid = threadIdx.x; asm volatile("" : "+v"(tid));
    const int wid = __builtin_amdgcn_readfirstlane(tid >> 6), lane = tid & 63, wr = wid >> 2, wc = wid & 3, fr = lane & 15, fq = lane >> 4;
    const int K = g.K, nt = K / BK;
    unsigned voffA[2], voffB[2];
#pragma unroll
    for (int i = 0; i < 2; ++i) { int R, C; stage_rc(tid * 16 + i * 8192, R, C); const int Rb = Epi::PERM ? ((R & ~31) + perm32(R & 31)) : R;
        voffA[i] = (unsigned)(R * K + C) * 2u; voffB[i] = (unsigned)(Rb * K + C) * 2u; }
    const size_t kstep = (size_t)(BK * 2);
    const size_t hstep = (size_t)HALF * K * 2;
    const size_t tstep = 2 * hstep;
    const unsigned ldsw = (unsigned)wid * 1024u;
    const int aoff = lds_byte(wr * 64 + fr, fq * 8), boff = lds_byte(wc * 32 + fr, fq * 8);
#define PG8_SA(b, h) (((b) * 2 + (h)) * HTB)
#define PG8_SB(b, h) ((4 + (b) * 2 + (h)) * HTB)
#define PG8_STAGE(bufoff, gbase, voff) do { _Pragma("unroll") for (int _i = 0; _i < 2; ++_i) \
        __builtin_amdgcn_global_load_lds((const unsigned*)((const char*)(gbase) + (voff)[_i]), (PG8_LAS unsigned*)(lds + (bufoff) + ldsw + _i * 8192), 16, 0, 0); } while (0)
#define PG8_LDA(dst, b, h) do { _Pragma("unroll") for (int m = 0; m < 4; ++m) _Pragma("unroll") for (int k = 0; k < 2; ++k) dst[m][k] = *(const PG8_LAS bf16x8*)(lds + PG8_SA(b, h) + aoff + m * 2048 + k * 1024); } while (0)
#define PG8_LDB(dst, b, h) do { _Pragma("unroll") for (int n = 0; n < 2; ++n) _Pragma("unroll") for (int k = 0; k < 2; ++k) dst[n][k] = *(const PG8_LAS bf16x8*)(lds + PG8_SB(b, h) + boff + n * 2048 + k * 1024); } while (0)
#define PG8_MMA(ai, bj, At, Bt) do { __builtin_amdgcn_s_setprio(1); _Pragma("unroll") for (int m = 0; m < 4; ++m) _Pragma("unroll") for (int n = 0; n < 2; ++n) _Pragma("unroll") for (int k = 0; k < 2; ++k) \
        acc[ai][bj][m][n] = __builtin_amdgcn_mfma_f32_16x16x32_bf16(Bt[n][k], At[m][k], acc[ai][bj][m][n], 0, 0, 0); __builtin_amdgcn_s_setprio(0); } while (0)
#define PG8_WAIT_V(n) asm volatile("s_waitcnt vmcnt(" #n ")" ::: "memory")
#define PG8_WAIT_L(n) asm volatile("s_waitcnt lgkmcnt(" #n ")" ::: "memory")
#define PG8_BAR __builtin_amdgcn_s_barrier()
#define PG8_SCHED __builtin_amdgcn_sched_barrier(0)
    Unit cur, nxt; int ui = 0;
    if (!S.next(0, cur)) return;
    f32x4 acc[2][2][4][2];
#pragma unroll
    for (int a = 0; a < 2; ++a)
#pragma unroll
        for (int b = 0; b < 2; ++b)
#pragma unroll
            for (int m = 0; m < 4; ++m)
#pragma unroll
                for (int n = 0; n < 2; ++n) acc[a][b][m][n] = (f32x4){0.f, 0.f, 0.f, 0.f};
    bf16x8 At[4][2], B0[2][2], B1[2][2];
    const char* cA = (const char*)g.A + (size_t)cur.pm * tstep; const char* cB = (const char*)g.Bt + (size_t)cur.pn * tstep;
    S.a_ready(cur);
    if constexpr (SP2) {
        PG8_STAGE(PG8_SB(0, 0), cB, voffB); PG8_STAGE(PG8_SB(0, 1), cB + hstep, voffB); PG8_STAGE(PG8_SA(0, 0), cA, voffA); PG8_STAGE(PG8_SA(0, 1), cA + hstep, voffA);
        if (wr == 1) PG8_BAR;
        PG8_WAIT_V(2); PG8_BAR;
        PG8_STAGE(PG8_SB(1, 0), cB + kstep, voffB); PG8_STAGE(PG8_SA(1, 0), cA + kstep, voffA); PG8_STAGE(PG8_SB(1, 1), cB + hstep + kstep, voffB);
        PG8_WAIT_V(6); PG8_BAR;
    } else {
        PG8_STAGE(PG8_SB(0, 0), cB, voffB); PG8_STAGE(PG8_SA(0, 0), cA, voffA); PG8_STAGE(PG8_SB(0, 1), cB + hstep, voffB); PG8_STAGE(PG8_SA(0, 1), cA + hstep, voffA);
        if (wr == 1) PG8_BAR;
        PG8_WAIT_V(4); PG8_BAR;
        PG8_STAGE(PG8_SB(1, 0), cB + kstep, voffB); PG8_STAGE(PG8_SA(1, 0), cA + kstep, voffA); PG8_STAGE(PG8_SB(1, 1), cB + hstep + kstep, voffB);
        PG8_WAIT_V(6); PG8_BAR;
    }
    for (;;) {
        const bool has_next = S.next(ui + 1, nxt);
        const char* nA = has_next ? (const char*)g.A + (size_t)nxt.pm * tstep : cA; const char* nB = has_next ? (const char*)g.Bt + (size_t)nxt.pn * tstep : cB;
        for (int t = 0; t < nt; t += 2) {
            const bool last = (t == nt - 2);
            const char* a1 = cA + (size_t)(t + 1) * kstep;
            const char* a2 = last ? nA : cA + (size_t)(t + 2) * kstep; const char* b2 = last ? nB : cB + (size_t)(t + 2) * kstep;
            const char* a3 = a2 + kstep; const char* b3 = b2 + kstep;
            if (last && has_next) S.a_ready(nxt);
            if constexpr (SP2) {
            PG8_LDB(B0, 0, 0); PG8_LDB(B1, 0, 1); PG8_SCHED; PG8_LDA(At, 0, 0); PG8_STAGE(PG8_SA(1, 1), a1 + hstep, voffA);
            PG8_WAIT_V(8); PG8_WAIT_L(0); PG8_BAR; PG8_MMA(0, 0, At, B0); PG8_MMA(0, 1, At, B1); PG8_BAR; PG8_SCHED;
            PG8_LDA(At, 0, 1); PG8_STAGE(PG8_SB(0, 0), b2, voffB); PG8_STAGE(PG8_SB(0, 1), b2 + hstep, voffB); PG8_STAGE(PG8_SA(0, 0), a2, voffA);
            PG8_WAIT_V(8); PG8_WAIT_L(0); PG8_BAR; PG8_MMA(1, 0, At, B0); PG8_MMA(1, 1, At, B1); PG8_BAR; PG8_SCHED;
            PG8_LDB(B0, 1, 0); PG8_LDB(B1, 1, 1); PG8_SCHED; PG8_LDA(At, 1, 0); PG8_STAGE(PG8_SA(0, 1), a2 + hstep, voffA);
            PG8_WAIT_V(8); PG8_WAIT_L(0); PG8_BAR; PG8_MMA(0, 0, At, B0); PG8_MMA(0, 1, At, B1); PG8_BAR; PG8_SCHED;
            PG8_LDA(At, 1, 1); PG8_STAGE(PG8_SB(1, 0), b3, voffB); PG8_STAGE(PG8_SB(1, 1), b3 + hstep, voffB); PG8_STAGE(PG8_SA(1, 0), a3, voffA);
            PG8_WAIT_V(8); PG8_WAIT_L(0); PG8_BAR; PG8_MMA(1, 0, At, B0); PG8_MMA(1, 1, At, B1); PG8_BAR; PG8_SCHED;
            } else {
            PG8_LDB(B0, 0, 0); PG8_SCHED; PG8_LDA(At, 0, 0); PG8_STAGE(PG8_SA(1, 1), a1 + hstep, voffA);
            PG8_WAIT_L(8); PG8_BAR; PG8_WAIT_L(0); PG8_MMA(0, 0, At, B0); PG8_BAR; PG8_SCHED;
            PG8_LDB(B1, 0, 1); PG8_STAGE(PG8_SB(0, 0), b2, voffB);
            PG8_BAR; PG8_WAIT_L(0); PG8_MMA(0, 1, At, B1); PG8_BAR;
            PG8_LDA(At, 0, 1); PG8_STAGE(PG8_SA(0, 0), a2, voffA);
            PG8_BAR; PG8_WAIT_L(0); PG8_MMA(1, 0, At, B0); PG8_BAR; PG8_SCHED;
            PG8_STAGE(PG8_SB(0, 1), b2 + hstep, voffB);
            PG8_WAIT_V(6); PG8_BAR; PG8_MMA(1, 1, At, B1); PG8_BAR;
            PG8_LDB(B0, 1, 0); PG8_SCHED; PG8_LDA(At, 1, 0); PG8_STAGE(PG8_SA(0, 1), a2 + hstep, voffA);
            PG8_WAIT_L(8); PG8_BAR; PG8_WAIT_L(0); PG8_MMA(0, 0, At, B0); PG8_BAR; PG8_SCHED;
            PG8_LDB(B1, 1, 1); PG8_STAGE(PG8_SB(1, 0), b3, voffB);
            PG8_BAR; PG8_WAIT_L(0); PG8_MMA(0, 1, At, B1); PG8_BAR;
            PG8_LDA(At, 1, 1); PG8_STAGE(PG8_SA(1, 0), a3, voffA);
            PG8_BAR; PG8_WAIT_L(0); PG8_MMA(1, 0, At, B0); PG8_BAR; PG8_SCHED;
            PG8_STAGE(PG8_SB(1, 1), b3 + hstep, voffB);
            PG8_WAIT_V(6); PG8_BAR; PG8_MMA(1, 1, At, B1); PG8_BAR;
            }
        }
        if constexpr (ALIGN_EPI) { if (wr == 0) PG8_BAR; }
        bool keep = false;
        if constexpr (Epi::CARRY) { keep = E.carry(acc, cur, wr, wc, fr, fq); S.done(cur); }
        else if constexpr (!Epi::AFTER_DRAIN) { E(acc, cur, wr, wc, fr, fq); S.done(cur); }
        if (!has_next) break;
        if (!keep) {
#pragma unroll
        for (int a = 0; a < 2; ++a)
#pragma unroll
            for (int b = 0; b < 2; ++b)
#pragma unroll
                for (int m = 0; m < 4; ++m)
#pragma unroll
                    for (int n = 0; n < 2; ++n) acc[a][b][m][n] = (f32x4){0.f, 0.f, 0.f, 0.f};
        }
        cur = nxt; cA = nA; cB = nB; ++ui;
        if constexpr (ALIGN_EPI) { if (wr == 1) PG8_BAR; }
    }
    PG8_WAIT_V(0);
    if constexpr (!ALIGN_EPI) { if (wr == 0) PG8_BAR; }
    PG8_BAR;
    if constexpr (Epi::AFTER_DRAIN) { E.fused(acc, cur, wr, wc, fr, fq, lds, wid, lane); S.done(cur); }
#undef PG8_SA
#undef PG8_SB
#undef PG8_STAGE
#undef PG8_LDA
#undef PG8_LDB
#undef PG8_MMA
#undef PG8_WAIT_V
#undef PG8_WAIT_L
#undef PG8_BAR
#undef PG8_SCHED
}
}
#define LAS __attribute__((address_space(3)))
typedef unsigned short bf16;
typedef unsigned v4u __attribute__((ext_vector_type(4)));
typedef unsigned v2u __attribute__((ext_vector_type(2)));
typedef short v4i16_t __attribute__((ext_vector_type(4)));
using pg8::f32x4; using pg8::bf16x8; using pg8::cvt_pk_bf16;

constexpr int D = 1024, FF = 2816, NLAYER = 4, TG = 16384, NGROUP = 4, NTHR = 512, NWAVES = 8;
constexpr int PA_LD = 5632, PG_LD = 3072;
constexpr int C_HQ = 0, C_HI = 512, C_HZF = 1024, C_HZB = 1536, C_HG = 2048, C_CA = 2560, C_CB = 3072, C_CC = 3584, C_NQ = 4096, C_NK = 4608, C_NV = 5120;
constexpr size_t MiB = 1u << 20;
constexpr size_t WS_CTL = 0, CTL_BYTES = 1 * MiB, WS_W = 1 * MiB, WS_XB = 221 * MiB, WS_SSQ = 285 * MiB, WS_PA = 287 * MiB, WS_PG = 463 * MiB, WS_ONA = 559 * MiB, WS_SCR = 575 * MiB, WS_END = 671 * MiB;
constexpr size_t OFF_GU1 = 0, OFF_D1 = 5767168, OFF_IN = 8650752, OFF_HG = 17563648, OFF_CV = 18087936, OFF_NA = 18612224, OFF_OUT = 19136512, OFF_GU2 = 20185088, OFF_D2 = 25952256, LAYER_EL = 28835840;
constexpr int LDS_BYTES = 147456, LDS_MISC = 147456 - 64;
constexpr int PH_PER_PAIR = 1 + NLAYER * 16 + 1;
constexpr int CW_BAR = 4096;

__device__ __forceinline__ unsigned f2bf(float f) { unsigned u = __float_as_uint(f); return (u + 0x7fffu + ((u >> 16) & 1u)) >> 16; }
__device__ __forceinline__ float bf2f(unsigned b) { return __uint_as_float(b << 16); }
__device__ __forceinline__ float bflo(unsigned w) { return __uint_as_float(w << 16); }
__device__ __forceinline__ float bfhi(unsigned w) { return __uint_as_float(w & 0xffff0000u); }
__device__ __forceinline__ float sigm(float v) { return __builtin_amdgcn_rcpf(1.0f + __expf(-v)); }
__device__ __forceinline__ float wave_sum(float v) {
#pragma unroll
    for (int o = 1; o < 64; o <<= 1) v += __shfl_xor(v, o);
    return v;
}

__device__ __forceinline__ void cvt_item(const float* W, int K, int N, bf16* WT, const float* gain, bool permgu, LAS float* scr, int item, int lane) {
    const int nblk = N / 32, kb = item / nblk, nb = item % nblk, k0 = 64 * kb, n0 = 32 * nb;
#pragma unroll
    for (int i = 0; i < 32; ++i) { const int kk = 2 * i + (lane >> 5); const float g = gain ? gain[k0 + kk] : 1.0f; scr[kk * 33 + (lane & 31)] = W[(size_t)(k0 + kk) * N + n0 + (lane & 31)] * g; }
    asm volatile("s_waitcnt lgkmcnt(0)" ::: "memory");
    int dn0 = n0;
    if (permgu) { const int half = n0 >= FF ? 1 : 0; const int j = n0 - half * FF; dn0 = (j >> 7) * 256 + half * 128 + (j & 127); }
    const int c = lane & 7;
#pragma unroll
    for (int j = 0; j < 4; ++j) { const int n = (lane >> 3) + 8 * j; const LAS float* s = scr + (8 * c) * 33 + n;
        v4u o; o.x = cvt_pk_bf16(s[0 * 33], s[1 * 33]); o.y = cvt_pk_bf16(s[2 * 33], s[3 * 33]); o.z = cvt_pk_bf16(s[4 * 33], s[5 * 33]); o.w = cvt_pk_bf16(s[6 * 33], s[7 * 33]);
        *(v4u*)(WT + (size_t)(dn0 + n) * K + k0 + 8 * c) = o; }
    asm volatile("s_waitcnt lgkmcnt(0)" ::: "memory");
}

template <int K> __device__ __forceinline__ f32x4 mma_lds(f32x4 acc, const LAS bf16* A, int pa, const LAS bf16* B, int pb, int lane) {
    const int r = lane & 15, q = lane >> 4;
#pragma unroll
    for (int ks = 0; ks < K / 32; ++ks) {
        const bf16x8 a = *(const LAS bf16x8*)(A + r * pa + ks * 32 + q * 8);
        const bf16x8 b = *(const LAS bf16x8*)(B + r * pb + ks * 32 + q * 8);
        acc = __builtin_amdgcn_mfma_f32_16x16x32_bf16(a, b, acc, 0, 0, 0);
    }
    return acc;
}

constexpr int HP_QT = 0, HP_KTT = 17408, HP_AM = 35840, HP_ER = 45056, HP_EE = 45568, HP_BLK = 49152;
constexpr int HP_KT = 49152, HP_SEG = 66560;
constexpr int HS_VT = 49152, HS_ST = 53760, HS_BUF = 62464;
__device__ __forceinline__ void hg_prep_items(LAS unsigned char* lds, const bf16* PA, unsigned char* SCR, const float* lb_logits, int layer, int item0, int istride, int nitems, int T, int tid) {
    const int lane = tid & 63, wave = __builtin_amdgcn_readfirstlane(tid >> 6), c16 = lane & 15, quad = lane >> 4;
    const int nchunk = T / 64;
    const int kp = tid & 63, ts = tid >> 6;
    LAS bf16* QT = (LAS bf16*)(lds + HP_QT); LAS bf16* KT = (LAS bf16*)(lds + HP_KT); LAS bf16* KTT = (LAS bf16*)(lds + HP_KTT); LAS bf16* AM = (LAS bf16*)(lds + HP_AM);
    LAS float* SEG = (LAS float*)(lds + HP_SEG); LAS float* ER = (LAS float*)(lds + HP_ER); LAS float* EE = (LAS float*)(lds + HP_EE);
    unsigned zz[8], qq[8];
#define HP_LOAD(it) do { const int it_ = min((it), nitems - 1); const int c_ = it_ % nchunk, sd_ = it_ / nchunk, dir_ = sd_ & 1, h_ = (sd_ >> 1) & 3, base_ = (sd_ >> 3) * T; \
        const bf16* zs = PA + (dir_ ? C_HZB : C_HZF) + h_ * 128 + 2 * kp; const bf16* qs = PA + C_HQ + h_ * 128 + 2 * kp; \
        _Pragma("unroll") for (int i = 0; i < 8; ++i) { const int tau = c_ * 64 + 8 * ts + i; const size_t ro = (size_t)(base_ + (dir_ ? (T - 1 - tau) : tau)) * PA_LD; zz[i] = *(const unsigned*)(zs + ro); qq[i] = *(const unsigned*)(qs + ro); } } while (0)
    HP_LOAD(item0);
    for (int item = item0; item < nitems; item += istride) {
        const int sd = item / nchunk, dir = sd & 1, h = (sd >> 1) & 3;
        float lb[2];
#pragma unroll
        for (int j = 0; j < 2; ++j) { float lg[4], mx = -3e38f;
#pragma unroll
          for (int l = 0; l < 4; ++l) { lg[l] = lb_logits[(dir * 4 + l) * 512 + h * 128 + 2 * kp + j]; mx = fmaxf(mx, lg[l]); }
          float tot = 0.f, num = 0.f;
#pragma unroll
          for (int l = 0; l < 4; ++l) { const float e = __expf(lg[l] - mx); tot += e; if (l >= 1 && l <= layer) num += e; }
          lb[j] = num / tot; }
        float b[2][8], kv[2][8], qv[2][8]; float cum[2] = {0.f, 0.f};
#pragma unroll
        for (int i = 0; i < 8; ++i)
#pragma unroll
            for (int j = 0; j < 2; ++j) { const float zf = j ? bfhi(zz[i]) : bflo(zz[i]); const float sg = sigm(zf); const float oml = 1.0f - lb[j]; const float f = lb[j] + oml * sg;
                cum[j] += __logf(fmaxf(f, 1e-30f)); b[j][i] = cum[j]; kv[j][i] = oml * (1.0f - sg); qv[j][i] = j ? bfhi(qq[i]) : bflo(qq[i]); }
        HP_LOAD(item + istride);
        SEG[ts * 128 + 2 * kp] = cum[0]; SEG[ts * 128 + 2 * kp + 1] = cum[1];
        __syncthreads();
        float pre[2], r[2], bend[2];
#pragma unroll
        for (int j = 0; j < 2; ++j) { float p = 0.f, rr = 0.f, be = 0.f;
#pragma unroll
            for (int q = 0; q < 8; ++q) { const float v = SEG[q * 128 + 2 * kp + j]; if (q < ts) p += v; if (q < 4) rr += v; be += v; }
            pre[j] = p; r[j] = rr; bend[j] = be; }
        unsigned kpk[2][4];
#pragma unroll
        for (int i = 0; i < 8; ++i) {
            unsigned qb[2], kb[2];
#pragma unroll
            for (int j = 0; j < 2; ++j) { const float bt = pre[j] + b[j][i];
                const float eq = __expf(fminf(bt - r[j], 80.f)), ek = __expf(fminf(r[j] - bt, 80.f));
                qb[j] = f2bf(qv[j][i] * eq); kb[j] = f2bf(kv[j][i] * ek);
                if (i & 1) kpk[j][i >> 1] |= kb[j] << 16; else kpk[j][i >> 1] = kb[j]; }
            const int tau = 8 * ts + i;
            *(LAS unsigned*)(QT + tau * 136 + 2 * kp) = qb[0] | (qb[1] << 16);
            *(LAS unsigned*)(KT + tau * 136 + 2 * kp) = kb[0] | (kb[1] << 16);
        }
#pragma unroll
        for (int j = 0; j < 2; ++j) *(LAS v4u*)(KTT + (2 * kp + j) * 72 + 8 * ts) = (v4u){kpk[j][0], kpk[j][1], kpk[j][2], kpk[j][3]};
        if (ts == 0) {
#pragma unroll
            for (int j = 0; j < 2; ++j) { ER[2 * kp + j] = __expf(r[j]); EE[2 * kp + j] = __expf(bend[j] - r[j]); } }
        __syncthreads();
#pragma unroll
        for (int e = 0; e < 2; ++e) { const int id = wave * 2 + e, tt = id >> 2, st = id & 3;
            f32x4 a = (f32x4){0.f, 0.f, 0.f, 0.f};
            if (st <= tt) a = mma_lds<128>(a, QT + tt * 16 * 136, 136, KT + st * 16 * 136, 136, lane);
#pragma unroll
            for (int i = 0; i < 4; ++i) { const int t = tt * 16 + quad * 4 + i, s = st * 16 + c16; const float val = (st <= tt && s <= t) ? a[i] : 0.f; AM[t * 72 + s] = (bf16)f2bf(val); } }
        __syncthreads();
        unsigned char* dst = SCR + (size_t)item * HP_BLK;
#pragma unroll
        for (int j = 0; j < 6; ++j) { const int idx = tid + 512 * j; *(v4u*)(dst + (size_t)idx * 16) = *(const LAS v4u*)(lds + idx * 16); }
        __syncthreads();
    }
#undef HP_LOAD
}

template <int NVT> __device__ __forceinline__ void hg_scan_item(LAS unsigned char* lds, bf16* PA, const unsigned char* SCR, int item, int T, int tid) {
    constexpr int NVS = 8 / NVT, VW = 16 * NVT, VTHR = 128 * NVT, VSH = (NVT == 2) ? 2 : 1;
    const int lane = tid & 63, wave = __builtin_amdgcn_readfirstlane(tid >> 6), c16 = lane & 15, quad = lane >> 4;
    const int vs = item % NVS, sd = item / NVS, dir = sd & 1, h = (sd >> 1) & 3, seq = sd >> 3;
    const int base = seq * T, nchunk = T / 64;
    const unsigned char* blk = SCR + (size_t)sd * nchunk * HP_BLK;
    const bf16* vsrc = PA + C_HI + h * 128 + vs * VW + (tid & (VW / 8 - 1)) * 8;
    bf16* odst = PA + (dir ? C_HZF : C_HQ) + h * 128 + vs * VW;
    v4u preA[6], preB[6]; v4u vrA = {0u, 0u, 0u, 0u}, vrB = vrA; f32x4 ervA, eevA, ervB, eevB;
#define HG_ROW(tau) (base + (dir ? (T - 1 - (tau)) : (tau)))
#define HS_LOAD(c, pre, vr, erv, eev) do { const int c_ = min((c), nchunk - 1); const unsigned char* bp = blk + (size_t)c_ * HP_BLK;     \
        _Pragma("unroll") for (int j = 0; j < 6; ++j) pre[j] = *(const v4u*)(bp + (size_t)(tid + 512 * j) * 16); \
        erv = *(const f32x4*)(bp + HP_ER + (wave * 16 + quad * 4) * 4); eev = *(const f32x4*)(blk + (size_t)max(c_ - 1, 0) * HP_BLK + HP_EE + (wave * 16 + quad * 4) * 4);     \
        vr = *(const v4u*)(vsrc + (size_t)HG_ROW(c_ * 64 + ((tid & (VTHR - 1)) >> VSH)) * PA_LD); } while (0)
    HS_LOAD(0, preA, vrA, ervA, eevA);
    HS_LOAD(1, preB, vrB, ervB, eevB);
    f32x4 accS[NVT];
#pragma unroll
    for (int e = 0; e < NVT; ++e) accS[e] = (f32x4){0.f, 0.f, 0.f, 0.f};
#define HS_STEP(c, BUFI, pre, vr, erv, eev) do { \
        LAS unsigned char* B = lds + (BUFI) * HS_BUF; \
        LAS bf16* QT = (LAS bf16*)(B + HP_QT); LAS bf16* KTT = (LAS bf16*)(B + HP_KTT); LAS bf16* AM = (LAS bf16*)(B + HP_AM); \
        LAS bf16* VT = (LAS bf16*)(B + HS_VT); LAS bf16* STt = (LAS bf16*)(B + HS_ST); \
        _Pragma("unroll") for (int j = 0; j < 6; ++j) *(LAS v4u*)(B + (tid + 512 * j) * 16) = pre[j]; \
        if (tid < VTHR) { const int s_ = tid >> VSH, vq = tid & (VW / 8 - 1); \
            VT[(vq * 8 + 0) * 72 + s_] = (bf16)(vr.x & 0xffffu); VT[(vq * 8 + 1) * 72 + s_] = (bf16)(vr.x >> 16); \
            VT[(vq * 8 + 2) * 72 + s_] = (bf16)(vr.y & 0xffffu); VT[(vq * 8 + 3) * 72 + s_] = (bf16)(vr.y >> 16); \
            VT[(vq * 8 + 4) * 72 + s_] = (bf16)(vr.z & 0xffffu); VT[(vq * 8 + 5) * 72 + s_] = (bf16)(vr.z >> 16); \
            VT[(vq * 8 + 6) * 72 + s_] = (bf16)(vr.w & 0xffffu); VT[(vq * 8 + 7) * 72 + s_] = (bf16)(vr.w >> 16); } \
        f32x4 sp[NVT]; const f32x4 sc_ = erv * eev;     \
        _Pragma("unroll") for (int e = 0; e < NVT; ++e) { sp[e] = accS[e] * sc_; v2u w; w.x = cvt_pk_bf16(sp[e][0], sp[e][1]); w.y = cvt_pk_bf16(sp[e][2], sp[e][3]); \
            *(LAS v2u*)(STt + (e * 16 + c16) * 136 + wave * 16 + quad * 4) = w; } \
        HS_LOAD((c) + 2, pre, vr, erv, eev); \
        __syncthreads(); \
        if ((wave >> 2) < NVT) { const int tt = wave & 3, vt = wave >> 2; f32x4 o = (f32x4){0.f, 0.f, 0.f, 0.f}; \
          o = mma_lds<128>(o, QT + tt * 16 * 136, 136, STt + vt * 16 * 136, 136, lane); \
          o = mma_lds<64>(o, AM + tt * 16 * 72, 72, VT + vt * 16 * 72, 72, lane); \
          _Pragma("unroll") for (int i = 0; i < 4; ++i) { const int tau = (c) * 64 + tt * 16 + quad * 4 + i; odst[(size_t)HG_ROW(tau) * PA_LD + vt * 16 + c16] = (bf16)f2bf(o[i]); } } \
        _Pragma("unroll") for (int e = 0; e < NVT; ++e) { accS[e] = mma_lds<64>(sp[e], KTT + wave * 16 * 72, 72, VT + e * 16 * 72, 72, lane); } \
    } while (0)
    for (int c = 0; c < nchunk; c += 2) {
        HS_STEP(c, 0, preA, vrA, ervA, eevA);
        HS_STEP(c + 1, 1, preB, vrB, ervB, eevB);
    }
    __syncthreads();
#undef HG_ROW
#undef HS_LOAD
#undef HS_STEP
}

__device__ __forceinline__ void na_item(LAS unsigned char* lds, const bf16* PA, const float* rpb, bf16* ONA, int item, int T, int tid) {
    const int lane = tid & 63, h = __builtin_amdgcn_readfirstlane(tid >> 6), c16 = lane & 15, quad = lane >> 4;
    const int ips = T / 16, seq = item / ips, rem = item % ips, r = rem >> 2, j = rem & 3;
    const int rows = T / 64, rs = min(max(r - 4, 0), rows - 8), kstart = (j == 0) ? 0 : (j == 1) ? 8 : (j == 2) ? 24 : 32;
    const int base = seq * T, qtok = base + r * 64 + 16 * j + c16;
    const bf16* qp = PA + (size_t)qtok * PA_LD + C_NQ + h * 64 + quad * 8;
    const bf16x8 Qb0 = *(const bf16x8*)qp, Qb1 = *(const bf16x8*)(qp + 32);
    const int qcol = 16 * j + c16, cs = min(max(qcol - 8, 0), 48);
    v4u vbufA[8], vbufB[8], vbufC[8], vbufD[8];
#define NA_VLOAD(qd, vbuf) do { _Pragma("unroll") for (int it = 0; it < 8; ++it) { const int idx = it * 64 + lane, key = idx >> 3, dg = idx & 7; \
        const int tok = base + (rs + 2 * (qd) + (key >> 5)) * 64 + kstart + (key & 31); vbuf[it] = *(const v4u*)(PA + (size_t)tok * PA_LD + C_NV + h * 64 + dg * 8); } } while (0)
    NA_VLOAD(0, vbufA); NA_VLOAD(1, vbufB);
    const float* rp = rpb + h * 465;
    f32x4 sacc[16]; float mx = -3e38f;
    int dcv[8]; bool okv[8];
#pragma unroll
    for (int e = 0; e < 8; ++e) { const int kcol = kstart + (e >> 2) * 16 + quad * 4 + (e & 3); okv[e] = (kcol >= cs) && (kcol < cs + 16); dcv[e] = min(max(kcol - qcol + 15, 0), 30); }
#pragma unroll
    for (int a = 0; a < 8; ++a) {
        const float rowv = rp[(rs + a - r + 7) * 31 + min(lane, 30)];
        float bv[8];
#pragma unroll
        for (int e = 0; e < 8; ++e) bv[e] = __builtin_bit_cast(float, __builtin_amdgcn_ds_bpermute(dcv[e] << 2, __builtin_bit_cast(int, rowv)));
#pragma unroll
        for (int hh = 0; hh < 2; ++hh) {
            const int ktok = base + (rs + a) * 64 + kstart + hh * 16 + c16;
            const bf16* kp = PA + (size_t)ktok * PA_LD + C_NK + h * 64 + quad * 8;
            const bf16x8 Ka0 = *(const bf16x8*)kp, Ka1 = *(const bf16x8*)(kp + 32);
            f32x4 s = (f32x4){0.f, 0.f, 0.f, 0.f};
            s = __builtin_amdgcn_mfma_f32_16x16x32_bf16(Ka0, Qb0, s, 0, 0, 0);
            s = __builtin_amdgcn_mfma_f32_16x16x32_bf16(Ka1, Qb1, s, 0, 0, 0);
#pragma unroll
            for (int i = 0; i < 4; ++i) { const float val = okv[hh * 4 + i] ? s[i] * 0.125f + bv[hh * 4 + i] : -1e30f; s[i] = val; mx = fmaxf(mx, val); }
            sacc[a * 2 + hh] = s;
        }
    }
    NA_VLOAD(2, vbufC); NA_VLOAD(3, vbufD);
    mx = fmaxf(mx, __shfl_xor(mx, 16)); mx = fmaxf(mx, __shfl_xor(mx, 32));
    float sum = 0.f;
#pragma unroll
    for (int t = 0; t < 16; ++t)
#pragma unroll
        for (int i = 0; i < 4; ++i) { const float p = __expf(sacc[t][i] - mx); sacc[t][i] = p; sum += p; }
    sum += __shfl_xor(sum, 16); sum += __shfl_xor(sum, 32);
    bf16x8 pb[8];
#pragma unroll
    for (int a = 0; a < 8; ++a) { v4u w; w.x = cvt_pk_bf16(sacc[2 * a][0], sacc[2 * a][1]); w.y = cvt_pk_bf16(sacc[2 * a][2], sacc[2 * a][3]);
        w.z = cvt_pk_bf16(sacc[2 * a + 1][0], sacc[2 * a + 1][1]); w.w = cvt_pk_bf16(sacc[2 * a + 1][2], sacc[2 * a + 1][3]); pb[a] = __builtin_bit_cast(bf16x8, w); }
    LAS bf16* VS = (LAS bf16*)(lds + h * 10240);
    f32x4 oacc[4];
#pragma unroll
    for (int dt = 0; dt < 4; ++dt) oacc[dt] = (f32x4){0.f, 0.f, 0.f, 0.f};
    const int trq = (lane & 15) >> 2, trp = lane & 3;
    const LAS bf16* trbase = VS + (quad * 4 + trq) * 80 + 4 * trp;
#define NA_PV(qd, vbuf) do { \
        _Pragma("unroll") for (int it = 0; it < 8; ++it) { const int idx = it * 64 + lane, key = idx >> 3, dg = idx & 7; *(LAS v4u*)(VS + key * 80 + dg * 8) = vbuf[it]; } \
        _Pragma("unroll") for (int al = 0; al < 2; ++al) \
            _Pragma("unroll") for (int dt = 0; dt < 4; ++dt) { const LAS bf16* p = trbase + al * 32 * 80 + dt * 16; \
                const v4i16_t lo = __builtin_amdgcn_ds_read_tr16_b64_v4i16((LAS v4i16_t*)p), hi = __builtin_amdgcn_ds_read_tr16_b64_v4i16((LAS v4i16_t*)(p + 16 * 80)); \
                const bf16x8 af = {lo[0], lo[1], lo[2], lo[3], hi[0], hi[1], hi[2], hi[3]}; \
                oacc[dt] = __builtin_amdgcn_mfma_f32_16x16x32_bf16(af, pb[(qd) * 2 + al], oacc[dt], 0, 0, 0); } } while (0)
    NA_PV(0, vbufA); NA_PV(1, vbufB); NA_PV(2, vbufC); NA_PV(3, vbufD);
#undef NA_PV
#undef NA_VLOAD
    const float inv = __builtin_amdgcn_rcpf(sum);
#pragma unroll
    for (int dt = 0; dt < 4; ++dt) { const f32x4 o = oacc[dt] * inv; v2u w; w.x = cvt_pk_bf16(o[0], o[1]); w.y = cvt_pk_bf16(o[2], o[3]);
        *(v2u*)(ONA + (size_t)qtok * 512 + h * 64 + dt * 16 + quad * 4) = w; }
}

#define XB_TMO      128
#define XB_XCNT(j)  (256  + 64 * (j))
#define XB_XSUB(j)  (1280 + 64 * (j))
#define XB_XGEN(j)  (2304 + 64 * (j))
#define XB_TOP      3328
#define XB_TOPGEN   3392
#define XCD_BAR_WORDS 3456
#define XB_SPIN_CAP (1u << 18)

__device__ __forceinline__ unsigned xb_ld(unsigned* p)              { return __hip_atomic_load(p, __ATOMIC_RELAXED, __HIP_MEMORY_SCOPE_AGENT); }
__device__ __forceinline__ unsigned xb_add(unsigned* p, unsigned v) { return __hip_atomic_fetch_add(p, v, __ATOMIC_RELAXED, __HIP_MEMORY_SCOPE_AGENT); }
__device__ __forceinline__ unsigned xb_xcc_id() { return (unsigned)__builtin_amdgcn_s_getreg((3 << 11) | 20) & 0xFu; }
#define XB_SPIN(cond, bar) do { unsigned _sp = 0; while (cond) { __builtin_amdgcn_s_sleep(1); \
    if ((++_sp & 255u) == 0u) { if (xb_ld(&(bar)[XB_TMO])) break; if (_sp > XB_SPIN_CAP) { atomicAdd(&(bar)[XB_TMO], 1u); break; } } } } while (0)

struct XcdBarrier {
    unsigned* bar; unsigned x;
    volatile LAS unsigned* st;
};

__device__ __forceinline__ XcdBarrier xcd_barrier_post(unsigned* bar, volatile LAS unsigned* st) {
    XcdBarrier b; b.bar = bar; b.x = xb_xcc_id(); b.st = st;
    if (threadIdx.x == 0) (void)xb_add(&bar[XB_XCNT(b.x)], 1u);
    return b;
}
__device__ __forceinline__ void xcd_barrier_complete(unsigned* bar, unsigned x, unsigned& nloc, unsigned& nx) {
    const unsigned G = gridDim.x * gridDim.y * gridDim.z;
    unsigned sum, cnt, mine, sp = 0u;
    for (;;) {
        sum = 0u; cnt = 0u; mine = 0u;
#pragma unroll
        for (unsigned j = 0; j < 16; ++j) { const unsigned c = xb_ld(&bar[XB_XCNT(j)]); sum += c; cnt += (c > 0u) ? 1u : 0u; mine = (j == x) ? c : mine; }
        if (sum == G) break;
        __builtin_amdgcn_s_sleep(1);
        if ((++sp & 255u) == 0u) { if (xb_ld(&bar[XB_TMO])) break; if (sp > XB_SPIN_CAP) { atomicAdd(&bar[XB_TMO], 1u); break; } }
    }
    nloc = mine > 0u ? mine : 1u; nx = cnt > 0u ? cnt : 1u;
}

__device__ __forceinline__ void xcd_barrier(const XcdBarrier& b) {
    asm volatile("s_waitcnt vmcnt(0)" ::: "memory");
    __syncthreads();
    if (threadIdx.x == 0) {
        unsigned* bar = b.bar;
        __builtin_amdgcn_s_waitcnt(0);
        unsigned nloc = b.st[0], nx = b.st[1];
        if (nloc == 0u) { xcd_barrier_complete(bar, b.x, nloc, nx); b.st[0] = nloc; b.st[1] = nx; }
        const unsigned old = xb_add(&bar[XB_XSUB(b.x)], 1u);
        const unsigned gen = old / nloc;
        if (old + 1u == (gen + 1u) * nloc) {
            __builtin_amdgcn_fence(__ATOMIC_RELEASE, "agent");
            asm volatile("s_waitcnt vmcnt(0)" ::: "memory");
            const unsigned og = xb_add(&bar[XB_TOP], 1u);
            const unsigned tg = og / nx;
            if (og + 1u == (tg + 1u) * nx) xb_add(&bar[XB_TOPGEN], 1u);
            else XB_SPIN(xb_ld(&bar[XB_TOPGEN]) == tg, bar);
            __builtin_amdgcn_fence(__ATOMIC_ACQUIRE, "agent");
            xb_add(&bar[XB_XGEN(b.x)], 1u);
            asm volatile("s_waitcnt vmcnt(0)" ::: "memory");
        } else {
            XB_SPIN(xb_ld(&bar[XB_XGEN(b.x)]) == gen, bar);
            __builtin_amdgcn_fence(__ATOMIC_ACQUIRE, "agent");
            asm volatile("s_waitcnt vmcnt(0)" ::: "memory");
        }
    }
    __syncthreads();
}
struct Args { const float* in[20]; float* out; unsigned char* ws; int ph_lo, ph_hi; };
enum { K_CVT = 0, K_G0, K_UP, K_RES, K_M1, K_M2A, K_M2B, K_M3, K_M4, K_GF };

__global__ void __launch_bounds__(NTHR, 2) mk_fwd(Args args) {
    extern __shared__ __attribute__((aligned(16))) unsigned char lds_raw[];
    LAS unsigned char* lds = (LAS unsigned char*)lds_raw;
    cg::grid_group grid = cg::this_grid();
    const int hi = args.ph_hi;
    { volatile LAS unsigned* st0 = (volatile LAS unsigned*)(lds + LDS_MISC + 32); if (threadIdx.x < 2) st0[threadIdx.x] = 0u; __syncthreads(); }
    XcdBarrier xbar = xcd_barrier_post((unsigned*)(args.ws + WS_CTL) + CW_BAR, (volatile LAS unsigned*)(lds + LDS_MISC + 32));
#if TPROBE
    unsigned long long tacc = 0ull;
#endif
    for (int ph = args.ph_lo; ph < hi; ++ph) {
#if TPROBE
        const unsigned long long tp0 = __builtin_amdgcn_s_memrealtime();
#endif
        int bid = blockIdx.x, G = gridDim.x; asm volatile("" : "+s"(bid), "+s"(G));
        int tid = threadIdx.x; asm volatile("" : "+v"(tid));
        const int lane = tid & 63, wave = __builtin_amdgcn_readfirstlane(tid >> 6);
        const int gw = bid * NWAVES + wave, NGW = G * NWAVES;
        int kind, pr = 0, l = 0, s = 0, g2 = 0;
        if (ph == 0) kind = K_CVT;
        else { const int q = ph - 1; pr = q / PH_PER_PAIR; const int r = q % PH_PER_PAIR;
            if (r == 0) kind = K_G0; else if (r == PH_PER_PAIR - 1) kind = K_GF;
            else { l = (r - 1) / 16; s = (r - 1) % 16;
                if (s == 0 || s == 14) kind = K_UP; else if (s == 1 || s == 15) kind = K_RES;
                else { g2 = (s - 2) / 6; const int t = (s - 2) % 6; kind = (t == 0) ? K_M1 : (t == 1) ? K_M2A : (t == 2) ? K_M2B : (t == 3) ? K_M3 : (t == 4) ? K_M4 : K_RES; } } }
        const bool mix = (s >= 2 && s <= 13);
        unsigned char* ws = args.ws;
        bf16* XBp = (bf16*)(ws + WS_XB); float* SSQp = (float*)(ws + WS_SSQ);
        bf16* XB = XBp + (size_t)g2 * TG * D; float* SSQ = SSQp + (size_t)g2 * TG * 16;
        bf16* PA = (bf16*)(ws + WS_PA); bf16* PG = (bf16*)(ws + WS_PG);
        bf16* ONA = (bf16*)(ws + WS_ONA); bf16* OHG = ONA + (size_t)TG * 512; bf16* OCV = OHG + (size_t)TG * 512;
        unsigned char* SCR = ws + WS_SCR;
        const bf16* Wl = (const bf16*)(ws + WS_W) + (size_t)l * LAYER_EL;
        const int T = pr == 0 ? 2048 : 4096;
        const int g = pr * 2 + g2;
        float* X = args.out + (size_t)pr * 2 * TG * D;

        if (kind == K_CVT) {
            LAS float* scr = (LAS float*)(lds + wave * 16384);
            constexpr int I_GU = 16 * 176, I_DN = 44 * 32, I_IN = 16 * 272, I_MX = 8 * 32, I_OUT = 16 * 32;
            constexpr int I_LAYER = 2 * I_GU + 2 * I_DN + I_IN + 3 * I_MX + I_OUT, I_TOT = NLAYER * I_LAYER;
#define CVT_DECODE(it_) const int ll = (it_) / I_LAYER; int r = (it_) % I_LAYER; \
                const float* src; const float* gain = nullptr; int K, N; size_t off; bool perm = false; \
                if (r < I_GU) { src = args.in[3] + (size_t)ll * D * 2 * FF; K = D; N = 2 * FF; off = OFF_GU1; gain = args.in[2] + ll * D; perm = true; } \
                else if ((r -= I_GU) < I_DN) { src = args.in[4] + (size_t)ll * FF * D; K = FF; N = D; off = OFF_D1; } \
                else if ((r -= I_DN) < I_IN) { src = args.in[6] + (size_t)ll * D * 8704; K = D; N = 8704; off = OFF_IN; gain = args.in[5] + ll * D; } \
                else if ((r -= I_IN) < I_MX) { src = args.in[9] + (size_t)ll * 512 * D; K = 512; N = D; off = OFF_HG; } \
                else if ((r -= I_MX) < I_MX) { src = args.in[12] + (size_t)ll * 512 * D; K = 512; N = D; off = OFF_CV; } \
                else if ((r -= I_MX) < I_MX) { src = args.in[14] + (size_t)ll * 512 * D; K = 512; N = D; off = OFF_NA; } \
                else if ((r -= I_MX) < I_OUT) { src = args.in[15] + (size_t)ll * D * D; K = D; N = D; off = OFF_OUT; } \
                else if ((r -= I_OUT) < I_GU) { src = args.in[17] + (size_t)ll * D * 2 * FF; K = D; N = 2 * FF; off = OFF_GU2; gain = args.in[16] + ll * D; perm = true; } \
                else { r -= I_GU; src = args.in[18] + (size_t)ll * FF * D; K = FF; N = D; off = OFF_D2; } \
                const int nblk = N / 32, kb = r / nblk, nb = r % nblk, k0 = 64 * kb, n0 = 32 * nb;
#define CVT_LOAD(it_, wv) do { CVT_DECODE(min((it_), I_TOT - 1)) (void)off; (void)perm; \
                _Pragma("unroll") for (int i = 0; i < 32; ++i) { const int kk = 2 * i + (lane >> 5); wv[i] = src[(size_t)(k0 + kk) * N + n0 + (lane & 31)] * (gain ? gain[k0 + kk] : 1.0f); } } while (0)
#define CVT_PROC(it_, wv) do { CVT_DECODE(it_) (void)src; (void)gain; \
                _Pragma("unroll") for (int i = 0; i < 32; ++i) { const int kk = 2 * i + (lane >> 5); scr[kk * 33 + (lane & 31)] = wv[i]; } \
                asm volatile("s_waitcnt lgkmcnt(0)" ::: "memory"); \
                int dn0 = n0; if (perm) { const int half = n0 >= FF ? 1 : 0; const int j_ = n0 - half * FF; dn0 = (j_ >> 7) * 256 + half * 128 + (j_ & 127); } \
                bf16* WT = (bf16*)(ws + WS_W) + (size_t)ll * LAYER_EL + off; const int c_ = lane & 7; \
                _Pragma("unroll") for (int j = 0; j < 4; ++j) { const int n = (lane >> 3) + 8 * j; const LAS float* sp_ = scr + (8 * c_) * 33 + n; \
                    v4u o; o.x = cvt_pk_bf16(sp_[0 * 33], sp_[1 * 33]); o.y = cvt_pk_bf16(sp_[2 * 33], sp_[3 * 33]); o.z = cvt_pk_bf16(sp_[4 * 33], sp_[5 * 33]); o.w = cvt_pk_bf16(sp_[6 * 33], sp_[7 * 33]); \
                    *(v4u*)(WT + (size_t)(dn0 + n) * K + k0 + 8 * c_) = o; } \
                asm volatile("s_waitcnt lgkmcnt(0)" ::: "memory"); } while (0)
            float wa[32], wb[32];
            int it = gw;
            CVT_LOAD(it, wa);
            while (it < I_TOT) {
                CVT_LOAD(it + NGW, wb);
                CVT_PROC(it, wa);
                it += NGW;
                CVT_LOAD(it + NGW, wa);
                if (it < I_TOT) CVT_PROC(it, wb);
                it += NGW;
            }
#undef CVT_DECODE
#undef CVT_LOAD
#undef CVT_PROC
        } else if (kind == K_G0) {
            const float* xin = pr == 0 ? args.in[0] : args.in[1];
#pragma unroll 2
            for (int row = gw; row < 2 * TG; row += NGW) {
                const f32x4* __restrict__ xr = (const f32x4*)(xin + (size_t)row * D) + lane; v2u* bo = (v2u*)(XBp + (size_t)row * D) + lane;
                float ss = 0.f;
#pragma unroll
                for (int j = 0; j < 4; ++j) { const f32x4 v = xr[64 * j]; v2u w; w.x = cvt_pk_bf16(v[0], v[1]); w.y = cvt_pk_bf16(v[2], v[3]); bo[64 * j] = w; ss += (v[0] * v[0] + v[1] * v[1]) + (v[2] * v[2] + v[3] * v[3]); }
                ss = wave_sum(ss);
                if (lane < 16) SSQp[(size_t)row * 16 + lane] = lane == 0 ? ss : 0.f;
            }
        } else if (kind == K_UP) {
            pg8::Gemm gm{XBp, Wl + (s == 14 ? OFF_GU2 : OFF_GU1), 2 * TG, 2 * FF, D}; pg8::StaticOrder S; S.init(2 * TG, 2 * FF, G, bid);
            LAS float* rst = (LAS float*)(lds + 131072); LAS int* pml = (LAS int*)(lds + 131072 + 12288);
            __syncthreads();
            if (tid == 0) { int n = 0; pg8::Unit uu;
                for (int i = 0; S.next(i, uu); ++i) { bool f = false; for (int q = 0; q < n; ++q) f = f || (pml[q] == uu.pm); if (!f && n < 12) pml[n++] = uu.pm; }
                pml[15] = n; }
            __syncthreads();
            { const int n = pml[15];
              for (int idx = tid; idx < n * 256; idx += NTHR) { const int row = pml[idx >> 8] * 256 + (idx & 255); rst[idx] = pg8::row_rs(SSQp, row); } }
            __syncthreads();
            pg8::EpiSwiGLU E{PA, rst, pml, SSQp};
#ifndef NO_UP
            for (int rep = 0; rep < REP_GEMM; ++rep) pg8::gemm_phase<pg8::EpiSwiGLU, pg8::StaticOrder, PGA, PGS>(lds, gm, S, E);
#endif
        } else if (kind == K_RES) {
            const int K = mix ? D : FF, Mr = mix ? TG : 2 * TG; const size_t off = mix ? OFF_OUT : (s == 1 ? OFF_D1 : OFF_D2);
            pg8::Gemm gm{PA, Wl + off, Mr, D, K}; pg8::StaticOrder S; S.init(Mr, D, G, bid);
            pg8::EpiRes E{mix ? XB : XBp, mix ? SSQ : SSQp, mix ? 1.0f : 0.5f};
#ifndef NO_RES
            for (int rep = 0; rep < REP_RES; ++rep) { if (rep + 1 < REP_RES) { pg8::EpiRes E0 = E; E0.alpha = 0.f; pg8::gemm_phase<pg8::EpiRes, pg8::StaticOrder, PGA, PGS>(lds, gm, S, E0); }
                else pg8::gemm_phase<pg8::EpiRes, pg8::StaticOrder, PGA, PGS>(lds, gm, S, E); }
#endif
        } else if (kind == K_M1) {
            pg8::Gemm gm{XBp, Wl + OFF_IN, 2 * TG, 8704, D}; pg8::M1Order S; S.init(G, bid, g2);
            LAS float* rst = (LAS float*)(lds + 131072); LAS int* pml = (LAS int*)(lds + 131072 + 12288);
            __syncthreads();
            if (tid == 0) { int n = 0; pg8::Unit uu;
                for (int i = 0; S.next(i, uu); ++i) { bool f = false; for (int q = 0; q < n; ++q) f = f || (pml[q] == uu.pm); if (!f && n < 12) pml[n++] = uu.pm; }
                pml[15] = n; }
            __syncthreads();
            { const int n = pml[15];
              for (int idx = tid; idx < n * 256; idx += NTHR) { const int row = pml[idx >> 8] * 256 + (idx & 255); rst[idx] = pg8::row_rs(SSQp, row); } }
            __syncthreads();
            pg8::EpiProj E{PA, (unsigned char*)PG, (unsigned char*)PG + (size_t)TG * 3072, rst, pml, SSQp};
#ifndef NO_PROJ
            for (int rep = 0; rep < REP_GEMM; ++rep) pg8::gemm_phase<pg8::EpiProj, pg8::M1Order, PGA, PGS>(lds, gm, S, E);
#endif
        } else if (kind == K_M2A) {
#ifndef NO_HG
            { const int nP = (TG / 64) * 8;
              if (G == 256) { const int vcu1 = (bid % 8) * 32 + bid / 8; for (int rep = 0; rep < REP_HG; ++rep) hg_prep_items(lds, PA, SCR, args.in[7], l, vcu1 * (nP / 256), 1, (vcu1 + 1) * (nP / 256), T, tid); }
              else { for (int rep = 0; rep < REP_HG; ++rep) if (bid < nP) hg_prep_items(lds, PA, SCR, args.in[7], l, bid, G, nP, T, tid); } }
#endif
            const float* rpb = args.in[13] + (size_t)l * 8 * 465;
            const int vcu = (G % 8 == 0) ? (bid % 8) * (G / 8) + bid / 8 : bid;
            const int nNA = TG / 16, ipb = (nNA + G - 1) / G;
            for (int rep = 0; rep < REP_NA; ++rep)
                for (int q = 0; q < ipb; ++q) { const int it = vcu * ipb + q; if (it < nNA) {
#ifndef NO_NA
                    na_item(lds, PA, rpb, ONA, it, T, tid);
#endif
                    __syncthreads(); } }
        } else if (kind == K_M2B) {
#ifndef NO_HG
            const int vcu2 = (G % 8 == 0) ? (bid % 8) * (G / 8) + bid / 8 : bid;
            for (int rep = 0; rep < REP_HG; ++rep) {
                if (pr == 0) { for (int it = vcu2; it < 256; it += G) hg_scan_item<2>(lds, PA, SCR, it, T, tid); }
                else       { for (int it = vcu2; it < 256; it += G) hg_scan_item<1>(lds, PA, SCR, it, T, tid); }
            }
#endif
        } else if (kind == K_M3) {
            const float* gno = args.in[8] + l * 512; const float* cw = args.in[10] + l * 3 * 512; const float* cbias = args.in[11] + l * 512;
            const int c0 = lane * 8;
            const bf16* __restrict__ PAr = PA; bf16* __restrict__ OHGr = OHG; bf16* __restrict__ OCVr = OCV;
            const f32x4 gn0 = *(const f32x4*)(gno + c0), gn1 = *(const f32x4*)(gno + c0 + 4);
            const f32x4 w00 = *(const f32x4*)(cw + c0), w01 = *(const f32x4*)(cw + c0 + 4), w10 = *(const f32x4*)(cw + 512 + c0), w11 = *(const f32x4*)(cw + 512 + c0 + 4);
            const f32x4 w20 = *(const f32x4*)(cw + 1024 + c0), w21 = *(const f32x4*)(cw + 1024 + c0 + 4), bs0 = *(const f32x4*)(cbias + c0), bs1 = *(const f32x4*)(cbias + c0 + 4);
#define M3_DECL(S) v4u fw##S, bw##S, hg##S, a1##S, c1##S, bb##S, a0##S, q0##S, a2##S, q2##S
#define M3_LOAD(row_, S) do { const int r_ = min((row_), TG - 1); const bf16* pr_ = PAr + (size_t)r_ * PA_LD + c0; \
                const bf16* pm_ = PAr + (size_t)max(r_ - 1, 0) * PA_LD + c0; const bf16* pp_ = PAr + (size_t)min(r_ + 1, TG - 1) * PA_LD + c0; \
                fw##S = *(const v4u*)(pr_ + C_HQ); bw##S = *(const v4u*)(pr_ + C_HZF); hg##S = *(const v4u*)(pr_ + C_HG); \
                a1##S = *(const v4u*)(pr_ + C_CA); c1##S = *(const v4u*)(pr_ + C_CC); bb##S = *(const v4u*)(pr_ + C_CB); \
                a0##S = *(const v4u*)(pm_ + C_CA); q0##S = *(const v4u*)(pm_ + C_CC); a2##S = *(const v4u*)(pp_ + C_CA); q2##S = *(const v4u*)(pp_ + C_CC); } while (0)
#define M3_MUL8(A, B) {bflo(A.x) * bflo(B.x), bfhi(A.x) * bfhi(B.x), bflo(A.y) * bflo(B.y), bfhi(A.y) * bfhi(B.y), bflo(A.z) * bflo(B.z), bfhi(A.z) * bfhi(B.z), bflo(A.w) * bflo(B.w), bfhi(A.w) * bfhi(B.w)}
#define M3_PROC(row_, S) do { const int rw_ = (row_);     \
                float o[8] = {bflo(fw##S.x) + bflo(bw##S.x), bfhi(fw##S.x) + bfhi(bw##S.x), bflo(fw##S.y) + bflo(bw##S.y), bfhi(fw##S.y) + bfhi(bw##S.y), bflo(fw##S.z) + bflo(bw##S.z), bfhi(fw##S.z) + bfhi(bw##S.z), bflo(fw##S.w) + bflo(bw##S.w), bfhi(fw##S.w) + bfhi(bw##S.w)}; \
                float ss = 0.f; \
                _Pragma("unroll") for (int e = 0; e < 8; ++e) ss += o[e] * o[e]; \
                ss += __shfl_xor(ss, 1); ss += __shfl_xor(ss, 2); ss += __shfl_xor(ss, 4); ss += __shfl_xor(ss, 8); \
                const float rs = __builtin_amdgcn_rsqf(ss * (1.0f / 128.0f) + 1e-6f); \
                const float hgv[8] = {bflo(hg##S.x), bfhi(hg##S.x), bflo(hg##S.y), bfhi(hg##S.y), bflo(hg##S.z), bfhi(hg##S.z), bflo(hg##S.w), bfhi(hg##S.w)}; \
                const float gn[8] = {gn0[0], gn0[1], gn0[2], gn0[3], gn1[0], gn1[1], gn1[2], gn1[3]}; \
                float r8[8]; \
                _Pragma("unroll") for (int e = 0; e < 8; ++e) r8[e] = o[e] * rs * gn[e] * (hgv[e] * sigm(hgv[e])); \
                v4u wo; wo.x = cvt_pk_bf16(r8[0], r8[1]); wo.y = cvt_pk_bf16(r8[2], r8[3]); wo.z = cvt_pk_bf16(r8[4], r8[5]); wo.w = cvt_pk_bf16(r8[6], r8[7]); \
                *(v4u*)(OHGr + (size_t)rw_ * 512 + c0) = wo; \
                const int tl = rw_ & (T - 1); const float m0 = tl > 0 ? 1.f : 0.f, m2 = tl < T - 1 ? 1.f : 0.f; \
                const float zm[8] = M3_MUL8(a0##S, q0##S); const float zc[8] = M3_MUL8(a1##S, c1##S); const float zp[8] = M3_MUL8(a2##S, q2##S); \
                const float cbv[8] = {bflo(bb##S.x), bfhi(bb##S.x), bflo(bb##S.y), bfhi(bb##S.y), bflo(bb##S.z), bfhi(bb##S.z), bflo(bb##S.w), bfhi(bb##S.w)}; \
                _Pragma("unroll") for (int e = 0; e < 4; ++e) { r8[e] = cbv[e] * (w00[e] * (m0 * zm[e]) + w10[e] * zc[e] + w20[e] * (m2 * zp[e]) + bs0[e]); \
                    r8[4 + e] = cbv[4 + e] * (w01[e] * (m0 * zm[4 + e]) + w11[e] * zc[4 + e] + w21[e] * (m2 * zp[4 + e]) + bs1[e]); } \
                wo.x = cvt_pk_bf16(r8[0], r8[1]); wo.y = cvt_pk_bf16(r8[2], r8[3]); wo.z = cvt_pk_bf16(r8[4], r8[5]); wo.w = cvt_pk_bf16(r8[6], r8[7]); \
                *(v4u*)(OCVr + (size_t)rw_ * 512 + c0) = wo; } while (0)
            M3_DECL(A); M3_DECL(B);
            { int row = gw;
              M3_LOAD(row, A);
              while (row < TG) {
                  M3_LOAD(row + NGW, B);
                  M3_PROC(row, A);
                  row += NGW;
                  M3_LOAD(row + NGW, A);
                  if (row < TG) M3_PROC(row, B);
                  row += NGW;
              } }
#undef M3_DECL
#undef M3_LOAD
#undef M3_MUL8
#undef M3_PROC
        } else if (kind == K_M4) {
            pg8::Gemm gm{ONA, Wl + OFF_HG, 3 * TG, 3 * D, 512}; pg8::MergeOrder S; S.init(TG, D, G, bid);
            pg8::EpiMerge E{(const unsigned char*)PG + (size_t)g2 * TG * 3072, PA};
#ifndef NO_MERGE
            for (int rep = 0; rep < REP_MERGE; ++rep) pg8::gemm_phase<pg8::EpiMerge, pg8::MergeOrder, PGA, PGS>(lds, gm, S, E);
#endif
        } else {
            const f32x4* fg = (const f32x4*)args.in[19] + lane;
#pragma unroll 2
            for (int row = gw; row < 2 * TG; row += NGW) {
                const float rs = pg8::row_rs(SSQp, row);
                f32x4* __restrict__ xo = (f32x4*)(X + (size_t)row * D) + lane; const v2u* __restrict__ bi = (const v2u*)(XBp + (size_t)row * D) + lane;
#pragma unroll
                for (int j = 0; j < 4; ++j) { const v2u w = bi[64 * j]; const f32x4 v = {bflo(w.x), bfhi(w.x), bflo(w.y), bfhi(w.y)}; xo[64 * j] = v * fg[64 * j] * rs; }
            }
        }
#if TPROBE
        __syncthreads();
        const unsigned long long tp1 = __builtin_amdgcn_s_memrealtime();
#endif
        if (ph + 1 < hi) { for (int rep = 0; rep < REP_SYNC; ++rep) { if (hi < 0) grid.sync(); else xcd_barrier(xbar);     } }
#if TPROBE
        const unsigned long long tp2 = __builtin_amdgcn_s_memrealtime();
        if (TPROBE == 100) tacc += tp2 - tp1;
        else if (kind == TPROBE - 1) tacc += tp1 - tp0;
#endif
    }
#if TPROBE
    if (blockIdx.x == TPROBE_BLOCK) { const unsigned long long te = __builtin_amdgcn_s_memrealtime(); while (__builtin_amdgcn_s_memrealtime() - te < tacc) __builtin_amdgcn_s_sleep(8); }
#endif
}
constexpr int N_PHASES = 1 + 2 * PH_PER_PAIR;

extern "C" void kernel_launch(void* const* d_in, const int* in_sizes, int n_in, void* d_out, int out_size, void* d_ws, size_t ws_size, hipStream_t stream) {
    static int grid = 0;
    if (grid == 0) {
        if (n_in != 20 || ws_size < WS_END) { fprintf(stderr, "kernel_launch: unexpected n_in %d / ws %zu\n", n_in, ws_size); grid = -1; return; }
        int dev = 0, cus = 0, per_cu = 0;
        hipGetDevice(&dev); hipDeviceGetAttribute(&cus, hipDeviceAttributeMultiprocessorCount, dev);
        hipFuncSetAttribute((const void*)mk_fwd, hipFuncAttributeMaxDynamicSharedMemorySize, LDS_BYTES);
        hipOccupancyMaxActiveBlocksPerMultiprocessor(&per_cu, (const void*)mk_fwd, NTHR, LDS_BYTES);
        if (per_cu < 1) per_cu = 1;
        grid = cus * per_cu;
        (void)hipGetLastError();
    }
    if (grid < 0) return;
    hipMemsetAsync((char*)d_ws + WS_CTL, 0, CTL_BYTES, stream);
    Args a{};
    for (int i = 0; i < 20; ++i) a.in[i] = (const float*)d_in[i];
    a.out = (float*)d_out; a.ws = (unsigned char*)d_ws;
#if ONE_LAUNCH
    a.ph_lo = 0; a.ph_hi = N_PHASES;
    void* kargs[] = {&a};
    hipError_t e = hipLaunchCooperativeKernel((const void*)mk_fwd, dim3(grid), dim3(NTHR), kargs, LDS_BYTES, stream);
    if (e != hipSuccess) fprintf(stderr, "cooperative launch failed: %s (grid %d)\n", hipGetErrorString(e), grid);
#else
    for (int p = 0; p < N_PHASES; ++p) { a.ph_lo = p; a.ph_hi = p + 1; hipLaunchKernelGGL(mk_fwd, dim3(grid), dim3(NTHR), LDS_BYTES, stream, a); }
#endif
}
```

```cpp
#include <hip/hip_runtime.h>
#include <hip/hip_cooperative_groups.h>
#include <cstdio>
#include <cstdint>
namespace cg = cooperative_groups;
#ifndef ONE_LAUNCH
#define ONE_LAUNCH 1
#endif
#ifndef REP_HG
#define REP_HG 1
#endif
#ifndef REP_NA
#define REP_NA 1
#endif
#ifndef REP_SYNC
#define REP_SYNC 1
#endif
#ifndef REP_GEMM
#define REP_GEMM 1
#endif
#ifndef REP_M3
#define REP_M3 1
#endif
#ifndef REP_RES
#define REP_RES 1
#endif
#ifndef REP_MERGE
#define REP_MERGE 1
#endif
#ifndef REP_MISC
#define REP_MISC 1
#endif
#ifndef TPROBE
#define TPROBE 0
#endif
#ifndef TPROBE_BLOCK
#define TPROBE_BLOCK 0
#endif
#ifndef PGA
#define PGA true
#endif
#ifndef PGS
#define PGS true
#endif
#ifndef RS_PROBE
#define RS_PROBE 0
#endif
namespace pg8 {
#define PG8_LAS __attribute__((address_space(3)))
typedef unsigned short bf16_t;
typedef short bf16x8 __attribute__((ext_vector_type(8)));
typedef float f32x4 __attribute__((ext_vector_type(4)));
typedef unsigned u32x4 __attribute__((ext_vector_type(4)));
constexpr int BM = 256, BK = 64, HALF = 128, HTB = HALF * BK * 2  , STAGE_BYTES = 8 * HTB, NXCD = 8, WGM = 8;

__host__ __device__ __forceinline__ int lds_byte(int r, int c) { const int st = (r >> 4) * 2 + (c >> 5), rr = r & 15, cc = c & 31, ob = rr * 64 + cc * 2; return st * 1024 + (ob ^ (((ob >> 9) & 1) << 5)); }
__host__ __device__ __forceinline__ void stage_rc(int b, int& R, int& C) { const int st = b / 1024, sb = b % 1024, swz = sb ^ (((sb >> 9) & 1) << 5); R = (st >> 1) * 16 + swz / 64; C = (st & 1) * 32 + (swz % 64) / 2; }
__host__ __device__ __forceinline__ int perm32(int rho) { const int n = rho >> 4, i = rho & 15; return 8 * (i >> 2) + 4 * n + (i & 3); }

struct Unit { int pm, pn; };
struct Gemm { const bf16_t* A; const bf16_t* Bt; int M, N, K; };

struct StaticOrder {
    int nM, nN, nwg, G, c;
    __host__ __device__ void init(int M, int N, int G_, int c_) { nM = M / BM; nN = N / BM; nwg = nM * nN; G = G_; c = c_; }
    __host__ __device__ bool next(int i, Unit& u) const {
        const long L = (long)i * G + c; if (L >= nwg) return false;
        int wgid = (int)L; { const int q = nwg / NXCD, r = nwg % NXCD, xcd = wgid % NXCD, off = wgid / NXCD; wgid = (xcd < r ? xcd * (q + 1) : r * (q + 1) + (xcd - r) * q) + off; }
        const int nig = WGM * nN, gid = wgid / nig, fm = gid * WGM, gsz = (nM - fm) < WGM ? (nM - fm) : WGM;
        u.pm = fm + ((wgid % nig) % gsz); u.pn = (wgid % nig) / gsz; return true;
    }
    __device__ __forceinline__ void a_ready(const Unit&) const {}
    __device__ __forceinline__ void done(const Unit&) const {}
};

__device__ __forceinline__ unsigned cvt_pk_bf16(float lo, float hi) { unsigned r; asm volatile("v_cvt_pk_bf16_f32 %0, %1, %2" : "=v"(r) : "v"(lo), "v"(hi)); return r; }
__device__ __forceinline__ float row_rs(const float* ssq, int row) {
    const f32x4* p = (const f32x4*)(ssq + (size_t)row * 16);
    const f32x4 a = p[0], b = p[1], c = p[2], d = p[3];
    const float s = (((a[0] + a[1]) + (a[2] + a[3])) + ((b[0] + b[1]) + (b[2] + b[3]))) + (((c[0] + c[1]) + (c[2] + c[3])) + ((d[0] + d[1]) + (d[2] + d[3])));
    return __builtin_amdgcn_rsqf(s * (1.0f / 1024.0f) + 1e-6f);
}
__device__ __forceinline__ void row_rs8_impl(const float* ssq, int row0, float (&rsv)[8]) {
#pragma unroll
    for (int ai = 0; ai < 2; ++ai) {
        f32x4 p[4][4];
#pragma unroll
        for (int m = 0; m < 4; ++m) { const f32x4* q = (const f32x4*)(ssq + (size_t)(row0 + ai * HALF + m * 16) * 16);
#pragma unroll
            for (int j = 0; j < 4; ++j) p[m][j] = q[j]; }
#pragma unroll
        for (int m = 0; m < 4; ++m) { float t = 0.f;
#pragma unroll
            for (int j = 0; j < 4; ++j) t += (p[m][j][0] + p[m][j][1]) + (p[m][j][2] + p[m][j][3]);
            rsv[ai * 4 + m] = __builtin_amdgcn_rsqf(t * (1.0f / 1024.0f) + 1e-6f); }
    }
}
__device__ __forceinline__ void row_rs8(const float* ssq, int row0, float (&rsv)[8]) {
#if RS_PROBE
    { const float* ssq2 = ssq; asm volatile("" : "+s"(ssq2)); float t2[8]; row_rs8_impl(ssq2, row0, t2); row_rs8_impl(ssq, row0, rsv);
#pragma unroll
      for (int i = 0; i < 8; ++i) rsv[i] = 0.5f * (rsv[i] + t2[i]); return; }
#endif
    row_rs8_impl(ssq, row0, rsv);
}
__device__ __forceinline__ void row_rs8_lds(const PG8_LAS float* rst, const PG8_LAS int* pml, const float* ssq, int pm, int wr, int fr, float (&rsv)[8]) {
    const int n = pml[15]; int slot = -1;
#pragma unroll
    for (int s_ = 0; s_ < 12; ++s_) if (s_ < n && pml[s_] == pm) slot = s_;
    if (slot < 0) { row_rs8(ssq, pm * BM + wr * 64 + fr, rsv); return; }
    const PG8_LAS float* t = rst + slot * 256 + wr * 64 + fr;
#pragma unroll
    for (int ai = 0; ai < 2; ++ai)
#pragma unroll
        for (int m = 0; m < 4; ++m) rsv[ai * 4 + m] = t[ai * HALF + m * 16];
}
__device__ __forceinline__ float sigm(float v) { return __builtin_amdgcn_rcpf(1.0f + __expf(-v)); }

struct EpiSwiGLU {
    static constexpr bool PERM = true, AFTER_DRAIN = false, CARRY = false;
    bf16_t* H; const PG8_LAS float* rst; const PG8_LAS int* pml; const float* ssq;
    __device__ __forceinline__ void operator()(const f32x4 (&acc)[2][2][4][2], const Unit& u, int wr, int wc, int fr, int fq) const {
        const int row0 = u.pm * BM + wr * 64 + fr, col0 = u.pn * 128 + wc * 32 + 8 * fq;
        float rsv[8]; row_rs8_lds(rst, pml, ssq, u.pm, wr, fr, rsv);
#pragma unroll
        for (int ai = 0; ai < 2; ++ai)
#pragma unroll
            for (int m = 0; m < 4; ++m) {
                const int row = row0 + ai * HALF + m * 16; const float rs = rsv[ai * 4 + m];
                u32x4 w;
#pragma unroll
                for (int n = 0; n < 2; ++n) {
                    const f32x4 a = acc[ai][0][m][n] * rs, b = acc[ai][1][m][n] * rs; f32x4 h;
#pragma unroll
                    for (int e = 0; e < 4; ++e) h[e] = a[e] * sigm(a[e]) * b[e];
                    w[2 * n] = cvt_pk_bf16(h[0], h[1]); w[2 * n + 1] = cvt_pk_bf16(h[2], h[3]);
                }
                *(u32x4*)(H + (size_t)row * 2816 + col0) = w;
            }
    }
};
__device__ __forceinline__ void unpack8(const u32x4 w, f32x4& lo, f32x4& hi) {
    lo[0] = __uint_as_float(w.x << 16); lo[1] = __uint_as_float(w.x & 0xffff0000u); lo[2] = __uint_as_float(w.y << 16); lo[3] = __uint_as_float(w.y & 0xffff0000u);
    hi[0] = __uint_as_float(w.z << 16); hi[1] = __uint_as_float(w.z & 0xffff0000u); hi[2] = __uint_as_float(w.w << 16); hi[3] = __uint_as_float(w.w & 0xffff0000u);
}
struct EpiRes {
    static constexpr bool PERM = true, AFTER_DRAIN = false, CARRY = false;
    bf16_t* XB; float* ssq; float alpha;
    __device__ __forceinline__ void operator()(const f32x4 (&acc)[2][2][4][2], const Unit& u, int wr, int wc, int fr, int fq) const {
        const int row0 = u.pm * BM + wr * 64 + fr, col0 = u.pn * BM + wc * 32 + 8 * fq;
#pragma unroll
        for (int ai = 0; ai < 2; ++ai) {
            u32x4 xin[4][2];
#pragma unroll
            for (int m = 0; m < 4; ++m)
#pragma unroll
                for (int bj = 0; bj < 2; ++bj) xin[m][bj] = *(const u32x4*)(XB + (size_t)(row0 + ai * HALF + m * 16) * 1024 + col0 + bj * HALF);
#pragma unroll
            for (int m = 0; m < 4; ++m) {
                const int row = row0 + ai * HALF + m * 16; float ss = 0.f;
#pragma unroll
                for (int bj = 0; bj < 2; ++bj) {
                    bf16_t* xp = XB + (size_t)row * 1024 + col0 + bj * HALF;
                    f32x4 x0, x1; unpack8(xin[m][bj], x0, x1);
                    x0 = x0 + acc[ai][bj][m][0] * alpha; x1 = x1 + acc[ai][bj][m][1] * alpha;
                    u32x4 w; w.x = cvt_pk_bf16(x0[0], x0[1]); w.y = cvt_pk_bf16(x0[2], x0[3]); w.z = cvt_pk_bf16(x1[0], x1[1]); w.w = cvt_pk_bf16(x1[2], x1[3]);
                    *(u32x4*)xp = w;
                    ss += ((x0[0] * x0[0] + x0[1] * x0[1]) + (x0[2] * x0[2] + x0[3] * x0[3])) + ((x1[0] * x1[0] + x1[1] * x1[1]) + (x1[2] * x1[2] + x1[3] * x1[3]));
                }
                ss += __shfl_xor(ss, 16); ss += __shfl_xor(ss, 32);
                if (fq == 0) ssq[(size_t)row * 16 + u.pn * 4 + wc] = ss;
            }
            asm volatile("" ::: "memory");
        }
    }
};
struct M1Order {
    StaticOrder so; int second, G, c;
    __device__ void init(int G_, int c_, int second_) { second = second_; G = G_; c = c_; so.init(16384, second_ ? 8192 : 8704, G_, c_); }
    __device__ bool next(int i, Unit& u) const {
        if (!second) { if (so.next(i, u)) return true;
            const long L = (long)i * G + c - 2176; if (L < 0 || L >= 128) return false; u.pm = 64 + (int)(L >> 1); u.pn = 22 + (int)(L & 1); return true; }
        Unit b; if (!so.next(i, b)) return false; u.pm = b.pm + 64; u.pn = b.pn < 22 ? b.pn : b.pn + 2; return true;
    }
    __device__ __forceinline__ void a_ready(const Unit&) const {}
    __device__ __forceinline__ void done(const Unit&) const {}
};
struct EpiProj {
    static constexpr bool PERM = true, AFTER_DRAIN = false, CARRY = false;
    bf16_t* PA; unsigned char* PGa; unsigned char* PGb; const PG8_LAS float* rst; const PG8_LAS int* pml; const float* ssq;
    __device__ __forceinline__ void operator()(const f32x4 (&acc)[2][2][4][2], const Unit& u, int wr, int wc, int fr, int fq) const {
        unsigned char* PG8 = u.pm < 64 ? PGa : PGb;
        const int prow0 = u.pm * BM + wr * 64 + fr, row0 = prow0 & 16383;
        float rsv[8]; row_rs8_lds(rst, pml, ssq, u.pm, wr, fr, rsv);
        if (u.pn < 22) {
            const int col0 = u.pn * BM + wc * 32 + 8 * fq;
#pragma unroll
            for (int ai = 0; ai < 2; ++ai)
#pragma unroll
                for (int m = 0; m < 4; ++m) {
                    const int row = row0 + ai * HALF + m * 16; const float rs = rsv[ai * 4 + m];
#pragma unroll
                    for (int bj = 0; bj < 2; ++bj) {
                        const f32x4 v0 = acc[ai][bj][m][0] * rs, v1 = acc[ai][bj][m][1] * rs;
                        u32x4 w; w.x = cvt_pk_bf16(v0[0], v0[1]); w.y = cvt_pk_bf16(v0[2], v0[3]); w.z = cvt_pk_bf16(v1[0], v1[1]); w.w = cvt_pk_bf16(v1[2], v1[3]);
                        *(u32x4*)(PA + (size_t)row * 5632 + col0 + bj * HALF) = w;
                    }
                }
        } else {
            const int col0 = (u.pn - 22) * BM + wc * 32 + 8 * fq;
#pragma unroll
            for (int ai = 0; ai < 2; ++ai)
#pragma unroll
                for (int m = 0; m < 4; ++m) {
                    const int row = row0 + ai * HALF + m * 16; const float rs = rsv[ai * 4 + m];
#pragma unroll
                    for (int bj = 0; bj < 2; ++bj) {
                        unsigned q[8];
#pragma unroll
                        for (int e = 0; e < 4; ++e) { q[e] = (unsigned)(sigm(acc[ai][bj][m][0][e] * rs) * 255.0f + 0.5f); q[4 + e] = (unsigned)(sigm(acc[ai][bj][m][1][e] * rs) * 255.0f + 0.5f); }
                        typedef unsigned u32x2_ __attribute__((ext_vector_type(2)));
                        u32x2_ w; w.x = q[0] | (q[1] << 8) | (q[2] << 16) | (q[3] << 24); w.y = q[4] | (q[5] << 8) | (q[6] << 16) | (q[7] << 24);
                        *(u32x2_*)(PG8 + (size_t)row * 3072 + col0 + bj * HALF) = w;
                    }
                }
        }
    }
};
struct MergeOrder {
    StaticOrder so;
    __device__ void init(int M, int N, int G_, int c_) { so.init(M, N, G_, c_); }
    __device__ bool next(int i, Unit& u) const { Unit b; if (!so.next(i / 3, b)) return false; const int m = i % 3, w = (m == 0) ? 2 : m - 1; u.pm = b.pm + 64 * m; u.pn = b.pn + 4 * w; return true; }
    __device__ __forceinline__ void a_ready(const Unit&) const {}
    __device__ __forceinline__ void done(const Unit&) const {}
};
struct EpiMerge {
    static constexpr bool PERM = true, AFTER_DRAIN = false, CARRY = true;
    const unsigned char* PG8; bf16_t* MB;
    __device__ __forceinline__ void operator()(const f32x4 (&)[2][2][4][2], const Unit&, int, int, int, int) const {}
    __device__ __forceinline__ bool carry(f32x4 (&acc)[2][2][4][2], const Unit& u, int wr, int wc, int fr, int fq) const {
        typedef unsigned u32x2_ __attribute__((ext_vector_type(2)));
        const int m_ = u.pm >> 6, pm = u.pm & 63, w_ = u.pn >> 2, pn = u.pn & 3;
        const int wn = (m_ == 0) ? 0 : 1;
        const bool last = (m_ == 2);
        const int row0 = pm * BM + wr * 64 + fr, col0 = pn * BM + wc * 32 + 8 * fq;
#pragma unroll
        for (int ai = 0; ai < 2; ++ai) {
            u32x2_ gc[4][2], gn[4][2];
#pragma unroll
            for (int m = 0; m < 4; ++m)
#pragma unroll
                for (int bj = 0; bj < 2; ++bj) { const size_t o = (size_t)(row0 + ai * HALF + m * 16) * 3072 + col0 + bj * HALF;
                    gc[m][bj] = *(const u32x2_*)(PG8 + o + w_ * 1024);
                    gn[m][bj] = last ? (u32x2_){0x01010101u, 0x01010101u} : *(const u32x2_*)(PG8 + o + wn * 1024); }
#pragma unroll
            for (int m = 0; m < 4; ++m)
#pragma unroll
                for (int bj = 0; bj < 2; ++bj) {
                    float f[8];
#pragma unroll
                    for (int e = 0; e < 8; ++e) { const unsigned wc_ = e < 4 ? gc[m][bj].x : gc[m][bj].y, wn_ = e < 4 ? gn[m][bj].x : gn[m][bj].y; const int sh = 8 * (e & 3);
                        const float qc = (float)max((wc_ >> sh) & 255u, 1u), qn = (float)max((wn_ >> sh) & 255u, 1u);
                        f[e] = last ? qc * (1.0f / 255.0f) : qc * __builtin_amdgcn_rcpf(qn); }
#pragma unroll
                    for (int e = 0; e < 4; ++e) { acc[ai][bj][m][0][e] *= f[e]; acc[ai][bj][m][1][e] *= f[4 + e]; }
                    if (last) { const f32x4 t0 = acc[ai][bj][m][0], t1 = acc[ai][bj][m][1];
                        u32x4 w; w.x = cvt_pk_bf16(t0[0], t0[1]); w.y = cvt_pk_bf16(t0[2], t0[3]); w.z = cvt_pk_bf16(t1[0], t1[1]); w.w = cvt_pk_bf16(t1[2], t1[3]);
                        *(u32x4*)(MB + (size_t)(row0 + ai * HALF + m * 16) * 1024 + col0 + bj * HALF) = w; }
                }
            asm volatile("" ::: "memory");
        }
        return !last;
    }
};
template <class Epi, class Sched, bool ALIGN_EPI = false, bool SP2 = false>
__device__ __forceinline__ void gemm_phase(PG8_LAS unsigned char* lds, const Gemm g, const Sched& S, const Epi& E) {
    int tid = threadIdx.x; asm volatile("" : "+v"(tid));
    const int wid = __builtin_amdgcn_readfirstlane(tid >> 6), lane = tid & 63, wr = wid >> 2, wc = wid & 3, fr = lane & 15, fq = lane >> 4;
    const int K = g.K, nt = K / BK;
    unsigned voffA[2], voffB[2];
#pragma unroll
    for (int i = 0; i < 2; ++i) { int R, C; stage_rc(tid * 16 + i * 8192, R, C); const int Rb = Epi::PERM ? ((R & ~31) + perm32(R & 31)) : R;
        voffA[i] = (unsigned)(R * K + C) * 2u; voffB[i] = (unsigned)(Rb * K + C) * 2u; }
    const size_t kstep = (size_t)(BK * 2);
    const size_t hstep = (size_t)HALF * K * 2;
    const size_t tstep = 2 * hstep;
    const unsigned ldsw = (unsigned)wid * 1024u;
    const int aoff = lds_byte(wr * 64 + fr, fq * 8), boff = lds_byte(wc * 32 + fr, fq * 8);
#define PG8_SA(b, h) (((b) * 2 + (h)) * HTB)
#define PG8_SB(b, h) ((4 + (b) * 2 + (h)) * HTB)
#define PG8_STAGE(bufoff, gbase, voff) do { _Pragma("unroll") for (int _i = 0; _i < 2; ++_i) \
        __builtin_amdgcn_global_load_lds((const unsigned*)((const char*)(gbase) + (voff)[_i]), (PG8_LAS unsigned*)(lds + (bufoff) + ldsw + _i * 8192), 16, 0, 0); } while (0)
#define PG8_LDA(dst, b, h) do { _Pragma("unroll") for (int m = 0; m < 4; ++m) _Pragma("unroll") for (int k = 0; k < 2; ++k) dst[m][k] = *(const PG8_LAS bf16x8*)(lds + PG8_SA(b, h) + aoff + m * 2048 + k * 1024); } while (0)
#define PG8_LDB(dst, b, h) do { _Pragma("unroll") for (int n = 0; n < 2; ++n) _Pragma("unroll") for (int k = 0; k < 2; ++k) dst[n][k] = *(const PG8_LAS bf16x8*)(lds + PG8_SB(b, h) + boff + n * 2048 + k * 1024); } while (0)
#define PG8_MMA(ai, bj, At, Bt) do { __builtin_amdgcn_s_setprio(1); _Pragma("unroll") for (int m = 0; m < 4; ++m) _Pragma("unroll") for (int n = 0; n < 2; ++n) _Pragma("unroll") for (int k = 0; k < 2; ++k) \
        acc[ai][bj][m][n] = __builtin_amdgcn_mfma_f32_16x16x32_bf16(Bt[n][k], At[m][k], acc[ai][bj][m][n], 0, 0, 0); __builtin_amdgcn_s_setprio(0); } while (0)
#define PG8_WAIT_V(n) asm volatile("s_waitcnt vmcnt(" #n ")" ::: "memory")
#define PG8_WAIT_L(n) asm volatile("s_waitcnt lgkmcnt(" #n ")" ::: "memory")
#define PG8_BAR __builtin_amdgcn_s_barrier()
#define PG8_SCHED __builtin_amdgcn_sched_barrier(0)
    Unit cur, nxt; int ui = 0;
    if (!S.next(0, cur)) return;
    f32x4 acc[2][2][4][2];
#pragma unroll
    for (int a = 0; a < 2; ++a)
#pragma unroll
        for (int b = 0; b < 2; ++b)
#pragma unroll
            for (int m = 0; m < 4; ++m)
#pragma unroll
                for (int n = 0; n < 2; ++n) acc[a][b][m][n] = (f32x4){0.f, 0.f, 0.f, 0.f};
    bf16x8 At[4][2], B0[2][2], B1[2][2];
    const char* cA = (const char*)g.A + (size_t)cur.pm * tstep; const char* cB = (const char*)g.Bt + (size_t)cur.pn * tstep;
    S.a_ready(cur);
    if constexpr (SP2) {
        PG8_STAGE(PG8_SB(0, 0), cB, voffB); PG8_STAGE(PG8_SB(0, 1), cB + hstep, voffB); PG8_STAGE(PG8_SA(0, 0), cA, voffA); PG8_STAGE(PG8_SA(0, 1), cA + hstep, voffA);
        if (wr == 1) PG8_BAR;
        PG8_WAIT_V(2); PG8_BAR;
        PG8_STAGE(PG8_SB(1, 0), cB + kstep, voffB); PG8_STAGE(PG8_SA(1, 0), cA + kstep, voffA); PG8_STAGE(PG8_SB(1, 1), cB + hstep + kstep, voffB);
        PG8_WAIT_V(6); PG8_BAR;
    } else {
        PG8_STAGE(PG8_SB(0, 0), cB, voffB); PG8_STAGE(PG8_SA(0, 0), cA, voffA); PG8_STAGE(PG8_SB(0, 1), cB + hstep, voffB); PG8_STAGE(PG8_SA(0, 1), cA + hstep, voffA);
        if (wr == 1) PG8_BAR;
        PG8_WAIT_V(4); PG8_BAR;
        PG8_STAGE(PG8_SB(1, 0), cB + kstep, voffB); PG8_STAGE(PG8_SA(1, 0), cA + kstep, voffA); PG8_STAGE(PG8_SB(1, 1), cB + hstep + kstep, voffB);
        PG8_WAIT_V(6); PG8_BAR;
    }
    for (;;) {
        const bool has_next = S.next(ui + 1, nxt);
        const char* nA = has_next ? (const char*)g.A + (size_t)nxt.pm * tstep : cA; const char* nB = has_next ? (const char*)g.Bt + (size_t)nxt.pn * tstep : cB;
        for (int t = 0; t < nt; t += 2) {
            const bool last = (t == nt - 2);
            const char* a1 = cA + (size_t)(t + 1) * kstep;
            const char* a2 = last ? nA : cA + (size_t)(t + 2) * kstep; const char* b2 = last ? nB : cB + (size_t)(t + 2) * kstep;
            const char* a3 = a2 + kstep; const char* b3 = b2 + kstep;
            if (last && has_next) S.a_ready(nxt);
            if constexpr (SP2) {
            PG8_LDB(B0, 0, 0); PG8_LDB(B1, 0, 1); PG8_SCHED; PG8_LDA(At, 0, 0); PG8_STAGE(PG8_SA(1, 1), a1 + hstep, voffA);
            PG8_WAIT_V(8); PG8_WAIT_L(0); PG8_BAR; PG8_MMA(0, 0, At, B0); PG8_MMA(0, 1, At, B1); PG8_BAR; PG8_SCHED;
            PG8_LDA(At, 0, 1); PG8_STAGE(PG8_SB(0, 0), b2, voffB); PG8_STAGE(PG8_SB(0, 1), b2 + hstep, voffB); PG8_STAGE(PG8_SA(0, 0), a2, voffA);
            PG8_WAIT_V(8); PG8_WAIT_L(0); PG8_BAR; PG8_MMA(1, 0, At, B0); PG8_MMA(1, 1, At, B1); PG8_BAR; PG8_SCHED;
            PG8_LDB(B0, 1, 0); PG8_LDB(B1, 1, 1); PG8_SCHED; PG8_LDA(At, 1, 0); PG8_STAGE(PG8_SA(0, 1), a2 + hstep, voffA);
            PG8_WAIT_V(8); PG8_WAIT_L(0); PG8_BAR; PG8_MMA(0, 0, At, B0); PG8_MMA(0, 1, At, B1); PG8_BAR; PG8_SCHED;
            PG8_LDA(At, 1, 1); PG8_STAGE(PG8_SB(1, 0), b3, voffB); PG8_STAGE(PG8_SB(1, 1), b3 + hstep, voffB); PG8_STAGE(PG8_SA(1, 0), a3, voffA);
            PG8_WAIT_V(8); PG8_WAIT_L(0); PG8_BAR; PG8_MMA(1, 0, At, B0); PG8_MMA(1, 1, At, B1); PG8_BAR; PG8_SCHED;
            } else {
            PG8_LDB(B0, 0, 0); PG8_SCHED; PG8_LDA(At, 0, 0); PG8_STAGE(PG8_SA(1, 1), a1 + hstep, voffA);
            PG8_WAIT_L(8); PG8_BAR; PG8_WAIT_L(0); PG8_MMA(0, 0, At, B0); PG8_BAR; PG8_SCHED;
            PG8_LDB(B1, 0, 1); PG8_STAGE(PG8_SB(0, 0), b2, voffB);
            PG8_BAR; PG8_WAIT_L(0); PG8_MMA(0, 1, At, B1); PG8_BAR;
            PG8_LDA(At, 0, 1); PG8_STAGE(PG8_SA(0, 0), a2, voffA);
            PG8_BAR; PG8_WAIT_L(0); PG8_MMA(1, 0, At, B0); PG8_BAR; PG8_SCHED;
            PG8_STAGE(PG8_SB(0, 1), b2 + hstep, voffB);
            PG8_WAIT_V(6); PG8_BAR; PG8_MMA(1, 1, At, B1); PG8_BAR;
            PG8_LDB(B0, 1, 0); PG8_SCHED; PG8_LDA(At, 1, 0); PG8_STAGE(PG8_SA(0, 1), a2 + hstep, voffA);
            PG8_WAIT_L(8); PG8_BAR; PG8_WAIT_L(0); PG8_MMA(0, 0, At, B0); PG8_BAR; PG8_SCHED;
            PG8_LDB(B1, 1, 1); PG8_STAGE(PG8_SB(1, 0), b3, voffB);
            PG8_BAR; PG8_WAIT_L(0); PG8_MMA(0, 1, At, B1); PG8_BAR;
            PG8_LDA(At, 1, 1); PG8_STAGE(PG8_SA(1, 0), a3, voffA);
            PG8_BAR; PG8_WAIT_L(0); PG8_MMA(1, 0, At, B0); PG8_BAR; PG8_SCHED;
            PG8_STAGE(PG8_SB(1, 1), b3 + hstep, voffB);
            PG8_WAIT_V(6); PG8_BAR; PG8_MMA(1, 1, At, B1); PG8_BAR;
            }
        }
        if constexpr (ALIGN_EPI) { if (wr == 0) PG8_BAR; }
        bool keep = false;
        if constexpr (Epi::CARRY) { keep = E.carry(acc, cur, wr, wc, fr, fq); S.done(cur); }
        else if constexpr (!Epi::AFTER_DRAIN) { E(acc, cur, wr, wc, fr, fq); S.done(cur); }
        if (!has_next) break;
        if (!keep) {
#pragma unroll
        for (int a = 0; a < 2; ++a)
#pragma unroll
            for (int b = 0; b < 2; ++b)
#pragma unroll
                for (int m = 0; m < 4; ++m)
#pragma unroll
                    for (int n = 0; n < 2; ++n) acc[a][b][m][n] = (f32x4){0.f, 0.f, 0.f, 0.f};
        }
        cur = nxt; cA = nA; cB = nB; ++ui;
        if constexpr (ALIGN_EPI) { if (wr == 1) PG8_BAR; }
    }
    PG8_WAIT_V(0);
    if constexpr (!ALIGN_EPI) { if (wr == 0) PG8_BAR; }
    PG8_BAR;
    if constexpr (Epi::AFTER_DRAIN) { E.fused(acc, cur, wr, wc, fr, fq, lds, wid, lane); S.done(cur); }
#undef PG8_SA
#undef PG8_SB
#undef PG8_STAGE
#undef PG8_LDA
#undef PG8_LDB
#undef PG8_MMA
#undef PG8_WAIT_V
#undef PG8_WAIT_L
#undef PG8_BAR
#undef PG8_SCHED
}
}
#define LAS __attribute__((address_space(3)))
typedef unsigned short bf16;
typedef unsigned v4u __attribute__((ext_vector_type(4)));
typedef unsigned v2u __attribute__((ext_vector_type(2)));
typedef short v4i16_t __attribute__((ext_vector_type(4)));
using pg8::f32x4; using pg8::bf16x8; using pg8::cvt_pk_bf16;

constexpr int D = 1024, FF = 2816, NLAYER = 4, TG = 16384, NGROUP = 4, NTHR = 512, NWAVES = 8;
constexpr int PA_LD = 5632, PG_LD = 3072;
constexpr int C_HQ = 0, C_HI = 512, C_HZF = 1024, C_HZB = 1536, C_HG = 2048, C_CA = 2560, C_CB = 3072, C_CC = 3584, C_NQ = 4096, C_NK = 4608, C_NV = 5120;
constexpr size_t MiB = 1u << 20;
constexpr size_t WS_CTL = 0, CTL_BYTES = 1 * MiB, WS_W = 1 * MiB, WS_XB = 221 * MiB, WS_SSQ = 285 * MiB, WS_PA = 287 * MiB, WS_PG = 463 * MiB, WS_ONA = 559 * MiB, WS_SCR = 575 * MiB, WS_END = 671 * MiB;
constexpr size_t OFF_GU1 = 0, OFF_D1 = 5767168, OFF_IN = 8650752, OFF_HG = 17563648, OFF_CV = 18087936, OFF_NA = 18612224, OFF_OUT = 19136512, OFF_GU2 = 20185088, OFF_D2 = 25952256, LAYER_EL = 28835840;
constexpr int LDS_BYTES = 147456, LDS_MISC = 147456 - 64;
constexpr int PH_PER_PAIR = 1 + NLAYER * 16 + 1;
constexpr int CW_BAR = 4096;

__device__ __forceinline__ unsigned f2bf(float f) { unsigned u = __float_as_uint(f); return (u + 0x7fffu + ((u >> 16) & 1u)) >> 16; }
__device__ __forceinline__ float bf2f(unsigned b) { return __uint_as_float(b << 16); }
__device__ __forceinline__ float bflo(unsigned w) { return __uint_as_float(w << 16); }
__device__ __forceinline__ float bfhi(unsigned w) { return __uint_as_float(w & 0xffff0000u); }
__device__ __forceinline__ float sigm(float v) { return __builtin_amdgcn_rcpf(1.0f + __expf(-v)); }
__device__ __forceinline__ float wave_sum(float v) {
#pragma unroll
    for (int o = 1; o < 64; o <<= 1) v += __shfl_xor(v, o);
    return v;
}

__device__ __forceinline__ void cvt_item(const float* W, int K, int N, bf16* WT, const float* gain, bool permgu, LAS float* scr, int item, int lane) {
    const int nblk = N / 32, kb = item / nblk, nb = item % nblk, k0 = 64 * kb, n0 = 32 * nb;
#pragma unroll
    for (int i = 0; i < 32; ++i) { const int kk = 2 * i + (lane >> 5); const float g = gain ? gain[k0 + kk] : 1.0f; scr[kk * 33 + (lane & 31)] = W[(size_t)(k0 + kk) * N + n0 + (lane & 31)] * g; }
    asm volatile("s_waitcnt lgkmcnt(0)" ::: "memory");
    int dn0 = n0;
    if (permgu) { const int half = n0 >= FF ? 1 : 0; const int j = n0 - half * FF; dn0 = (j >> 7) * 256 + half * 128 + (j & 127); }
    const int c = lane & 7;
#pragma unroll
    for (int j = 0; j < 4; ++j) { const int n = (lane >> 3) + 8 * j; const LAS float* s = scr + (8 * c) * 33 + n;
        v4u o; o.x = cvt_pk_bf16(s[0 * 33], s[1 * 33]); o.y = cvt_pk_bf16(s[2 * 33], s[3 * 33]); o.z = cvt_pk_bf16(s[4 * 33], s[5 * 33]); o.w = cvt_pk_bf16(s[6 * 33], s[7 * 33]);
        *(v4u*)(WT + (size_t)(dn0 + n) * K + k0 + 8 * c) = o; }
    asm volatile("s_waitcnt lgkmcnt(0)" ::: "memory");
}

template <int K> __device__ __forceinline__ f32x4 mma_lds(f32x4 acc, const LAS bf16* A, int pa, const LAS bf16* B, int pb, int lane) {
    const int r = lane & 15, q = lane >> 4;
#pragma unroll
    for (int ks = 0; ks < K / 32; ++ks) {
        const bf16x8 a = *(const LAS bf16x8*)(A + r * pa + ks * 32 + q * 8);
        const bf16x8 b = *(const LAS bf16x8*)(B + r * pb + ks * 32 + q * 8);
        acc = __builtin_amdgcn_mfma_f32_16x16x32_bf16(a, b, acc, 0, 0, 0);
    }
    return acc;
}

constexpr int HP_QT = 0, HP_KTT = 17408, HP_AM = 35840, HP_ER = 45056, HP_EE = 45568, HP_BLK = 49152;
constexpr int HP_KT = 49152, HP_SEG = 66560;
constexpr int HS_VT = 49152, HS_ST = 53760, HS_BUF = 62464;
__device__ __forceinline__ void hg_prep_items(LAS unsigned char* lds, const bf16* PA, unsigned char* SCR, const float* lb_logits, int layer, int item0, int istride, int nitems, int T, int tid) {
    const int lane = tid & 63, wave = __builtin_amdgcn_readfirstlane(tid >> 6), c16 = lane & 15, quad = lane >> 4;
    const int nchunk = T / 64;
    const int kp = tid & 63, ts = tid >> 6;
    LAS bf16* QT = (LAS bf16*)(lds + HP_QT); LAS bf16* KT = (LAS bf16*)(lds + HP_KT); LAS bf16* KTT = (LAS bf16*)(lds + HP_KTT); LAS bf16* AM = (LAS bf16*)(lds + HP_AM);
    LAS float* SEG = (LAS float*)(lds + HP_SEG); LAS float* ER = (LAS float*)(lds + HP_ER); LAS float* EE = (LAS float*)(lds + HP_EE);
    unsigned zz[8], qq[8];
#define HP_LOAD(it) do { const int it_ = min((it), nitems - 1); const int c_ = it_ % nchunk, sd_ = it_ / nchunk, dir_ = sd_ & 1, h_ = (sd_ >> 1) & 3, base_ = (sd_ >> 3) * T; \
        const bf16* zs = PA + (dir_ ? C_HZB : C_HZF) + h_ * 128 + 2 * kp; const bf16* qs = PA + C_HQ + h_ * 128 + 2 * kp; \
        _Pragma("unroll") for (int i = 0; i < 8; ++i) { const int tau = c_ * 64 + 8 * ts + i; const size_t ro = (size_t)(base_ + (dir_ ? (T - 1 - tau) : tau)) * PA_LD; zz[i] = *(const unsigned*)(zs + ro); qq[i] = *(const unsigned*)(qs + ro); } } while (0)
    HP_LOAD(item0);
    for (int item = item0; item < nitems; item += istride) {
        const int sd = item / nchunk, dir = sd & 1, h = (sd >> 1) & 3;
        float lb[2];
#pragma unroll
        for (int j = 0; j < 2; ++j) { float lg[4], mx = -3e38f;
#pragma unroll
          for (int l = 0; l < 4; ++l) { lg[l] = lb_logits[(dir * 4 + l) * 512 + h * 128 + 2 * kp + j]; mx = fmaxf(mx, lg[l]); }
          float tot = 0.f, num = 0.f;
#pragma unroll
          for (int l = 0; l < 4; ++l) { const float e = __expf(lg[l] - mx); tot += e; if (l >= 1 && l <= layer) num += e; }
          lb[j] = num / tot; }
        float b[2][8], kv[2][8], qv[2][8]; float cum[2] = {0.f, 0.f};
#pragma unroll
        for (int i = 0; i < 8; ++i)
#pragma unroll
            for (int j = 0; j < 2; ++j) { const float zf = j ? bfhi(zz[i]) : bflo(zz[i]); const float sg = sigm(zf); const float oml = 1.0f - lb[j]; const float f = lb[j] + oml * sg;
                cum[j] += __logf(fmaxf(f, 1e-30f)); b[j][i] = cum[j]; kv[j][i] = oml * (1.0f - sg); qv[j][i] = j ? bfhi(qq[i]) : bflo(qq[i]); }
        HP_LOAD(item + istride);
        SEG[ts * 128 + 2 * kp] = cum[0]; SEG[ts * 128 + 2 * kp + 1] = cum[1];
        __syncthreads();
        float pre[2], r[2], bend[2];
#pragma unroll
        for (int j = 0; j < 2; ++j) { float p = 0.f, rr = 0.f, be = 0.f;
#pragma unroll
            for (int q = 0; q < 8; ++q) { const float v = SEG[q * 128 + 2 * kp + j]; if (q < ts) p += v; if (q < 4) rr += v; be += v; }
            pre[j] = p; r[j] = rr; bend[j] = be; }
        unsigned kpk[2][4];
#pragma unroll
        for (int i = 0; i < 8; ++i) {
            unsigned qb[2], kb[2];
#pragma unroll
            for (int j = 0; j < 2; ++j) { const float bt = pre[j] + b[j][i];
                const float eq = __expf(fminf(bt - r[j], 80.f)), ek = __expf(fminf(r[j] - bt, 80.f));
                qb[j] = f2bf(qv[j][i] * eq); kb[j] = f2bf(kv[j][i] * ek);
                if (i & 1) kpk[j][i >> 1] |= kb[j] << 16; else kpk[j][i >> 1] = kb[j]; }
            const int tau = 8 * ts + i;
            *(LAS unsigned*)(QT + tau * 136 + 2 * kp) = qb[0] | (qb[1] << 16);
            *(LAS unsigned*)(KT + tau * 136 + 2 * kp) = kb[0] | (kb[1] << 16);
        }
#pragma unroll
        for (int j = 0; j < 2; ++j) *(LAS v4u*)(KTT + (2 * kp + j) * 72 + 8 * ts) = (v4u){kpk[j][0], kpk[j][1], kpk[j][2], kpk[j][3]};
        if (ts == 0) {
#pragma unroll
            for (int j = 0; j < 2; ++j) { ER[2 * kp + j] = __expf(r[j]); EE[2 * kp + j] = __expf(bend[j] - r[j]); } }
        __syncthreads();
#pragma unroll
        for (int e = 0; e < 2; ++e) { const int id = wave * 2 + e, tt = id >> 2, st = id & 3;
            f32x4 a = (f32x4){0.f, 0.f, 0.f, 0.f};
            if (st <= tt) a = mma_lds<128>(a, QT + tt * 16 * 136, 136, KT + st * 16 * 136, 136, lane);
#pragma unroll
            for (int i = 0; i < 4; ++i) { const int t = tt * 16 + quad * 4 + i, s = st * 16 + c16; const float val = (st <= tt && s <= t) ? a[i] : 0.f; AM[t * 72 + s] = (bf16)f2bf(val); } }
        __syncthreads();
        unsigned char* dst = SCR + (size_t)item * HP_BLK;
#pragma unroll
        for (int j = 0; j < 6; ++j) { const int idx = tid + 512 * j; *(v4u*)(dst + (size_t)idx * 16) = *(const LAS v4u*)(lds + idx * 16); }
        __syncthreads();
    }
#undef HP_LOAD
}

template <int NVT> __device__ __forceinline__ void hg_scan_item(LAS unsigned char* lds, bf16* PA, const unsigned char* SCR, int item, int T, int tid) {
    constexpr int NVS = 8 / NVT, VW = 16 * NVT, VTHR = 128 * NVT, VSH = (NVT == 2) ? 2 : 1;
    const int lane = tid & 63, wave = __builtin_amdgcn_readfirstlane(tid >> 6), c16 = lane & 15, quad = lane >> 4;
    const int vs = item % NVS, sd = item / NVS, dir = sd & 1, h = (sd >> 1) & 3, seq = sd >> 3;
    const int base = seq * T, nchunk = T / 64;
    const unsigned char* blk = SCR + (size_t)sd * nchunk * HP_BLK;
    const bf16* vsrc = PA + C_HI + h * 128 + vs * VW + (tid & (VW / 8 - 1)) * 8;
    bf16* odst = PA + (dir ? C_HZF : C_HQ) + h * 128 + vs * VW;
    v4u preA[6], preB[6]; v4u vrA = {0u, 0u, 0u, 0u}, vrB = vrA; f32x4 ervA, eevA, ervB, eevB;
#define HG_ROW(tau) (base + (dir ? (T - 1 - (tau)) : (tau)))
#define HS_LOAD(c, pre, vr, erv, eev) do { const int c_ = min((c), nchunk - 1); const unsigned char* bp = blk + (size_t)c_ * HP_BLK;     \
        _Pragma("unroll") for (int j = 0; j < 6; ++j) pre[j] = *(const v4u*)(bp + (size_t)(tid + 512 * j) * 16); \
        erv = *(const f32x4*)(bp + HP_ER + (wave * 16 + quad * 4) * 4); eev = *(const f32x4*)(blk + (size_t)max(c_ - 1, 0) * HP_BLK + HP_EE + (wave * 16 + quad * 4) * 4);     \
        vr = *(const v4u*)(vsrc + (size_t)HG_ROW(c_ * 64 + ((tid & (VTHR - 1)) >> VSH)) * PA_LD); } while (0)
    HS_LOAD(0, preA, vrA, ervA, eevA);
    HS_LOAD(1, preB, vrB, ervB, eevB);
    f32x4 accS[NVT];
#pragma unroll
    for (int e = 0; e < NVT; ++e) accS[e] = (f32x4){0.f, 0.f, 0.f, 0.f};
#define HS_STEP(c, BUFI, pre, vr, erv, eev) do { \
        LAS unsigned char* B = lds + (BUFI) * HS_BUF; \
        LAS bf16* QT = (LAS bf16*)(B + HP_QT); LAS bf16* KTT = (LAS bf16*)(B + HP_KTT); LAS bf16* AM = (LAS bf16*)(B + HP_AM); \
        LAS bf16* VT = (LAS bf16*)(B + HS_VT); LAS bf16* STt = (LAS bf16*)(B + HS_ST); \
        _Pragma("unroll") for (int j = 0; j < 6; ++j) *(LAS v4u*)(B + (tid + 512 * j) * 16) = pre[j]; \
        if (tid < VTHR) { const int s_ = tid >> VSH, vq = tid & (VW / 8 - 1); \
            VT[(vq * 8 + 0) * 72 + s_] = (bf16)(vr.x & 0xffffu); VT[(vq * 8 + 1) * 72 + s_] = (bf16)(vr.x >> 16); \
            VT[(vq * 8 + 2) * 72 + s_] = (bf16)(vr.y & 0xffffu); VT[(vq * 8 + 3) * 72 + s_] = (bf16)(vr.y >> 16); \
            VT[(vq * 8 + 4) * 72 + s_] = (bf16)(vr.z & 0xffffu); VT[(vq * 8 + 5) * 72 + s_] = (bf16)(vr.z >> 16); \
            VT[(vq * 8 + 6) * 72 + s_] = (bf16)(vr.w & 0xffffu); VT[(vq * 8 + 7) * 72 + s_] = (bf16)(vr.w >> 16); } \
        f32x4 sp[NVT]; const f32x4 sc_ = erv * eev;     \
        _Pragma("unroll") for (int e = 0; e < NVT; ++e) { sp[e] = accS[e] * sc_; v2u w; w.x = cvt_pk_bf16(sp[e][0], sp[e][1]); w.y = cvt_pk_bf16(sp[e][2], sp[e][3]); \
            *(LAS v2u*)(STt + (e * 16 + c16) * 136 + wave * 16 + quad * 4) = w; } \
        HS_LOAD((c) + 2, pre, vr, erv, eev); \
        __syncthreads(); \
        if ((wave >> 2) < NVT) { const int tt = wave & 3, vt = wave >> 2; f32x4 o = (f32x4){0.f, 0.f, 0.f, 0.f}; \
          o = mma_lds<128>(o, QT + tt * 16 * 136, 136, STt + vt * 16 * 136, 136, lane); \
          o = mma_lds<64>(o, AM + tt * 16 * 72, 72, VT + vt * 16 * 72, 72, lane); \
          _Pragma("unroll") for (int i = 0; i < 4; ++i) { const int tau = (c) * 64 + tt * 16 + quad * 4 + i; odst[(size_t)HG_ROW(tau) * PA_LD + vt * 16 + c16] = (bf16)f2bf(o[i]); } } \
        _Pragma("unroll") for (int e = 0; e < NVT; ++e) { accS[e] = mma_lds<64>(sp[e], KTT + wave * 16 * 72, 72, VT + e * 16 * 72, 72, lane); } \
    } while (0)
    for (int c = 0; c < nchunk; c += 2) {
        HS_STEP(c, 0, preA, vrA, ervA, eevA);
        HS_STEP(c + 1, 1, preB, vrB, ervB, eevB);
    }
    __syncthreads();
#undef HG_ROW
#undef HS_LOAD
#undef HS_STEP
}

__device__ __forceinline__ void na_item(LAS unsigned char* lds, const bf16* PA, const float* rpb, bf16* ONA, int item, int T, int tid) {
    const int lane = tid & 63, h = __builtin_amdgcn_readfirstlane(tid >> 6), c16 = lane & 15, quad = lane >> 4;
    const int ips = T / 16, seq = item / ips, rem = item % ips, r = rem >> 2, j = rem & 3;
    const int rows = T / 64, rs = min(max(r - 4, 0), rows - 8), kstart = (j == 0) ? 0 : (j == 1) ? 8 : (j == 2) ? 24 : 32;
    const int base = seq * T, qtok = base + r * 64 + 16 * j + c16;
    const bf16* qp = PA + (size_t)qtok * PA_LD + C_NQ + h * 64 + quad * 8;
    const bf16x8 Qb0 = *(const bf16x8*)qp, Qb1 = *(const bf16x8*)(qp + 32);
    const int qcol = 16 * j + c16, cs = min(max(qcol - 8, 0), 48);
    v4u vbufA[8], vbufB[8], vbufC[8], vbufD[8];
#define NA_VLOAD(qd, vbuf) do { _Pragma("unroll") for (int it = 0; it < 8; ++it) { const int idx = it * 64 + lane, key = idx >> 3, dg = idx & 7; \
        const int tok = base + (rs + 2 * (qd) + (key >> 5)) * 64 + kstart + (key & 31); vbuf[it] = *(const v4u*)(PA + (size_t)tok * PA_LD + C_NV + h * 64 + dg * 8); } } while (0)
    NA_VLOAD(0, vbufA); NA_VLOAD(1, vbufB);
    const float* rp = rpb + h * 465;
    f32x4 sacc[16]; float mx = -3e38f;
    int dcv[8]; bool okv[8];
#pragma unroll
    for (int e = 0; e < 8; ++e) { const int kcol = kstart + (e >> 2) * 16 + quad * 4 + (e & 3); okv[e] = (kcol >= cs) && (kcol < cs + 16); dcv[e] = min(max(kcol - qcol + 15, 0), 30); }
#pragma unroll
    for (int a = 0; a < 8; ++a) {
        const float rowv = rp[(rs + a - r + 7) * 31 + min(lane, 30)];
        float bv[8];
#pragma unroll
        for (int e = 0; e < 8; ++e) bv[e] = __builtin_bit_cast(float, __builtin_amdgcn_ds_bpermute(dcv[e] << 2, __builtin_bit_cast(int, rowv)));
#pragma unroll
        for (int hh = 0; hh < 2; ++hh) {
            const int ktok = base + (rs + a) * 64 + kstart + hh * 16 + c16;
            const bf16* kp = PA + (size_t)ktok * PA_LD + C_NK + h * 64 + quad * 8;
            const bf16x8 Ka0 = *(const bf16x8*)kp, Ka1 = *(const bf16x8*)(kp + 32);
            f32x4 s = (f32x4){0.f, 0.f, 0.f, 0.f};
            s = __builtin_amdgcn_mfma_f32_16x16x32_bf16(Ka0, Qb0, s, 0, 0, 0);
            s = __builtin_amdgcn_mfma_f32_16x16x32_bf16(Ka1, Qb1, s, 0, 0, 0);
#pragma unroll
            for (int i = 0; i < 4; ++i) { const float val = okv[hh * 4 + i] ? s[i] * 0.125f + bv[hh * 4 + i] : -1e30f; s[i] = val; mx = fmaxf(mx, val); }
            sacc[a * 2 + hh] = s;
        }
    }
    NA_VLOAD(2, vbufC); NA_VLOAD(3, vbufD);
    mx = fmaxf(mx, __shfl_xor(mx, 16)); mx = fmaxf(mx, __shfl_xor(mx, 32));
    float sum = 0.f;
#pragma unroll
    for (int t = 0; t < 16; ++t)
#pragma unroll
        for (int i = 0; i < 4; ++i) { const float p = __expf(sacc[t][i] - mx); sacc[t][i] = p; sum += p; }
    sum += __shfl_xor(sum, 16); sum += __shfl_xor(sum, 32);
    bf16x8 pb[8];
#pragma unroll
    for (int a = 0; a < 8; ++a) { v4u w; w.x = cvt_pk_bf16(sacc[2 * a][0], sacc[2 * a][1]); w.y = cvt_pk_bf16(sacc[2 * a][2], sacc[2 * a][3]);
        w.z = cvt_pk_bf16(sacc[2 * a + 1][0], sacc[2 * a + 1][1]); w.w = cvt_pk_bf16(sacc[2 * a + 1][2], sacc[2 * a + 1][3]); pb[a] = __builtin_bit_cast(bf16x8, w); }
    LAS bf16* VS = (LAS bf16*)(lds + h * 10240);
    f32x4 oacc[4];
#pragma unroll
    for (int dt = 0; dt < 4; ++dt) oacc[dt] = (f32x4){0.f, 0.f, 0.f, 0.f};
    const int trq = (lane & 15) >> 2, trp = lane & 3;
    const LAS bf16* trbase = VS + (quad * 4 + trq) * 80 + 4 * trp;
#define NA_PV(qd, vbuf) do { \
        _Pragma("unroll") for (int it = 0; it < 8; ++it) { const int idx = it * 64 + lane, key = idx >> 3, dg = idx & 7; *(LAS v4u*)(VS + key * 80 + dg * 8) = vbuf[it]; } \
        _Pragma("unroll") for (int al = 0; al < 2; ++al) \
            _Pragma("unroll") for (int dt = 0; dt < 4; ++dt) { const LAS bf16* p = trbase + al * 32 * 80 + dt * 16; \
                const v4i16_t lo = __builtin_amdgcn_ds_read_tr16_b64_v4i16((LAS v4i16_t*)p), hi = __builtin_amdgcn_ds_read_tr16_b64_v4i16((LAS v4i16_t*)(p + 16 * 80)); \
                const bf16x8 af = {lo[0], lo[1], lo[2], lo[3], hi[0], hi[1], hi[2], hi[3]}; \
                oacc[dt] = __builtin_amdgcn_mfma_f32_16x16x32_bf16(af, pb[(qd) * 2 + al], oacc[dt], 0, 0, 0); } } while (0)
    NA_PV(0, vbufA); NA_PV(1, vbufB); NA_PV(2, vbufC); NA_PV(3, vbufD);
#undef NA_PV
#undef NA_VLOAD
    const float inv = __builtin_amdgcn_rcpf(sum);
#pragma unroll
    for (int dt = 0; dt < 4; ++dt) { const f32x4 o = oacc[dt] * inv; v2u w; w.x = cvt_pk_bf16(o[0], o[1]); w.y = cvt_pk_bf16(o[2], o[3]);
        *(v2u*)(ONA + (size_t)qtok * 512 + h * 64 + dt * 16 + quad * 4) = w; }
}

#define XB_TMO      128
#define XB_XCNT(j)  (256  + 64 * (j))
#define XB_XSUB(j)  (1280 + 64 * (j))
#define XB_XGEN(j)  (2304 + 64 * (j))
#define XB_TOP      3328
#define XB_TOPGEN   3392
#define XCD_BAR_WORDS 3456
#define XB_SPIN_CAP (1u << 18)

__device__ __forceinline__ unsigned xb_ld(unsigned* p)              { return __hip_atomic_load(p, __ATOMIC_RELAXED, __HIP_MEMORY_SCOPE_AGENT); }
__device__ __forceinline__ unsigned xb_add(unsigned* p, unsigned v) { return __hip_atomic_fetch_add(p, v, __ATOMIC_RELAXED, __HIP_MEMORY_SCOPE_AGENT); }
__device__ __forceinline__ unsigned xb_xcc_id() { return (unsigned)__builtin_amdgcn_s_getreg((3 << 11) | 20) & 0xFu; }
#define XB_SPIN(cond, bar) do { unsigned _sp = 0; while (cond) { __builtin_amdgcn_s_sleep(1); \
    if ((++_sp & 255u) == 0u) { if (xb_ld(&(bar)[XB_TMO])) break; if (_sp > XB_SPIN_CAP) { atomicAdd(&(bar)[XB_TMO], 1u); break; } } } } while (0)

struct XcdBarrier {
    unsigned* bar; unsigned x;
    volatile LAS unsigned* st;
};

__device__ __forceinline__ XcdBarrier xcd_barrier_post(unsigned* bar, volatile LAS unsigned* st) {
    XcdBarrier b; b.bar = bar; b.x = xb_xcc_id(); b.st = st;
    if (threadIdx.x == 0) (void)xb_add(&bar[XB_XCNT(b.x)], 1u);
    return b;
}
__device__ __forceinline__ void xcd_barrier_complete(unsigned* bar, unsigned x, unsigned& nloc, unsigned& nx) {
    const unsigned G = gridDim.x * gridDim.y * gridDim.z;
    unsigned sum, cnt, mine, sp = 0u;
    for (;;) {
        sum = 0u; cnt = 0u; mine = 0u;
#pragma unroll
        for (unsigned j = 0; j < 16; ++j) { const unsigned c = xb_ld(&bar[XB_XCNT(j)]); sum += c; cnt += (c > 0u) ? 1u : 0u; mine = (j == x) ? c : mine; }
        if (sum == G) break;
        __builtin_amdgcn_s_sleep(1);
        if ((++sp & 255u) == 0u) { if (xb_ld(&bar[XB_TMO])) break; if (sp > XB_SPIN_CAP) { atomicAdd(&bar[XB_TMO], 1u); break; } }
    }
    nloc = mine > 0u ? mine : 1u; nx = cnt > 0u ? cnt : 1u;
}

__device__ __forceinline__ void xcd_barrier(const XcdBarrier& b) {
    asm volatile("s_waitcnt vmcnt(0)" ::: "memory");
    __syncthreads();
    if (threadIdx.x == 0) {
        unsigned* bar = b.bar;
        __builtin_amdgcn_s_waitcnt(0);
        unsigned nloc = b.st[0], nx = b.st[1];
        if (nloc == 0u) { xcd_barrier_complete(bar, b.x, nloc, nx); b.st[0] = nloc; b.st[1] = nx; }
        const unsigned old = xb_add(&bar[XB_XSUB(b.x)], 1u);
        const unsigned gen = old / nloc;
        if (old + 1u == (gen + 1u) * nloc) {
            __builtin_amdgcn_fence(__ATOMIC_RELEASE, "agent");
            asm volatile("s_waitcnt vmcnt(0)" ::: "memory");
            const unsigned og = xb_add(&bar[XB_TOP], 1u);
            const unsigned tg = og / nx;
            if (og + 1u == (tg + 1u) * nx) xb_add(&bar[XB_TOPGEN], 1u);
            else XB_SPIN(xb_ld(&bar[XB_TOPGEN]) == tg, bar);
            __builtin_amdgcn_fence(__ATOMIC_ACQUIRE, "agent");
            xb_add(&bar[XB_XGEN(b.x)], 1u);
            asm volatile("s_waitcnt vmcnt(0)" ::: "memory");
        } else {
            XB_SPIN(xb_ld(&bar[XB_XGEN(b.x)]) == gen, bar);
            __builtin_amdgcn_fence(__ATOMIC_ACQUIRE, "agent");
            asm volatile("s_waitcnt vmcnt(0)" ::: "memory");
        }
    }
    __syncthreads();
}
struct Args { const float* in[20]; float* out; unsigned char* ws; int ph_lo, ph_hi; };
enum { K_CVT = 0, K_G0, K_UP, K_RES, K_M1, K_M2A, K_M2B, K_M3, K_M4, K_GF };

__global__ void __launch_bounds__(NTHR, 2) mk_fwd(Args args) {
    extern __shared__ __attribute__((aligned(16))) unsigned char lds_raw[];
    LAS unsigned char* lds = (LAS unsigned char*)lds_raw;
    cg::grid_group grid = cg::this_grid();
    const int hi = args.ph_hi;
    { volatile LAS unsigned* st0 = (volatile LAS unsigned*)(lds + LDS_MISC + 32); if (threadIdx.x < 2) st0[threadIdx.x] = 0u; __syncthreads(); }
    XcdBarrier xbar = xcd_barrier_post((unsigned*)(args.ws + WS_CTL) + CW_BAR, (volatile LAS unsigned*)(lds + LDS_MISC + 32));
#if TPROBE
    unsigned long long tacc = 0ull;
#endif
    for (int ph = args.ph_lo; ph < hi; ++ph) {
#if TPROBE
        const unsigned long long tp0 = __builtin_amdgcn_s_memrealtime();
#endif
        int bid = blockIdx.x, G = gridDim.x; asm volatile("" : "+s"(bid), "+s"(G));
        int tid = threadIdx.x; asm volatile("" : "+v"(tid));
        const int lane = tid & 63, wave = __builtin_amdgcn_readfirstlane(tid >> 6);
        const int gw = bid * NWAVES + wave, NGW = G * NWAVES;
        int kind, pr = 0, l = 0, s = 0, g2 = 0;
        if (ph == 0) kind = K_CVT;
        else { const int q = ph - 1; pr = q / PH_PER_PAIR; const int r = q % PH_PER_PAIR;
            if (r == 0) kind = K_G0; else if (r == PH_PER_PAIR - 1) kind = K_GF;
            else { l = (r - 1) / 16; s = (r - 1) % 16;
                if (s == 0 || s == 14) kind = K_UP; else if (s == 1 || s == 15) kind = K_RES;
                else { g2 = (s - 2) / 6; const int t = (s - 2) % 6; kind = (t == 0) ? K_M1 : (t == 1) ? K_M2A : (t == 2) ? K_M2B : (t == 3) ? K_M3 : (t == 4) ? K_M4 : K_RES; } } }
        const bool mix = (s >= 2 && s <= 13);
        unsigned char* ws = args.ws;
        bf16* XBp = (bf16*)(ws + WS_XB); float* SSQp = (float*)(ws + WS_SSQ);
        bf16* XB = XBp + (size_t)g2 * TG * D; float* SSQ = SSQp + (size_t)g2 * TG * 16;
        bf16* PA = (bf16*)(ws + WS_PA); bf16* PG = (bf16*)(ws + WS_PG);
        bf16* ONA = (bf16*)(ws + WS_ONA); bf16* OHG = ONA + (size_t)TG * 512; bf16* OCV = OHG + (size_t)TG * 512;
        unsigned char* SCR = ws + WS_SCR;
        const bf16* Wl = (const bf16*)(ws + WS_W) + (size_t)l * LAYER_EL;
        const int T = pr == 0 ? 2048 : 4096;
        const int g = pr * 2 + g2;
        float* X = args.out + (size_t)pr * 2 * TG * D;

        if (kind == K_CVT) {
            LAS float* scr = (LAS float*)(lds + wave * 16384);
            constexpr int I_GU = 16 * 176, I_DN = 44 * 32, I_IN = 16 * 272, I_MX = 8 * 32, I_OUT = 16 * 32;
            constexpr int I_LAYER = 2 * I_GU + 2 * I_DN + I_IN + 3 * I_MX + I_OUT, I_TOT = NLAYER * I_LAYER;
#define CVT_DECODE(it_) const int ll = (it_) / I_LAYER; int r = (it_) % I_LAYER; \
                const float* src; const float* gain = nullptr; int K, N; size_t off; bool perm = false; \
                if (r < I_GU) { src = args.in[3] + (size_t)ll * D * 2 * FF; K = D; N = 2 * FF; off = OFF_GU1; gain = args.in[2] + ll * D; perm = true; } \
                else if ((r -= I_GU) < I_DN) { src = args.in[4] + (size_t)ll * FF * D; K = FF; N = D; off = OFF_D1; } \
                else if ((r -= I_DN) < I_IN) { src = args.in[6] + (size_t)ll * D * 8704; K = D; N = 8704; off = OFF_IN; gain = args.in[5] + ll * D; } \
                else if ((r -= I_IN) < I_MX) { src = args.in[9] + (size_t)ll * 512 * D; K = 512; N = D; off = OFF_HG; } \
                else if ((r -= I_MX) < I_MX) { src = args.in[12] + (size_t)ll * 512 * D; K = 512; N = D; off = OFF_CV; } \
                else if ((r -= I_MX) < I_MX) { src = args.in[14] + (size_t)ll * 512 * D; K = 512; N = D; off = OFF_NA; } \
                else if ((r -= I_MX) < I_OUT) { src = args.in[15] + (size_t)ll * D * D; K = D; N = D; off = OFF_OUT; } \
                else if ((r -= I_OUT) < I_GU) { src = args.in[17] + (size_t)ll * D * 2 * FF; K = D; N = 2 * FF; off = OFF_GU2; gain = args.in[16] + ll * D; perm = true; } \
                else { r -= I_GU; src = args.in[18] + (size_t)ll * FF * D; K = FF; N = D; off = OFF_D2; } \
                const int nblk = N / 32, kb = r / nblk, nb = r % nblk, k0 = 64 * kb, n0 = 32 * nb;
#define CVT_LOAD(it_, wv) do { CVT_DECODE(min((it_), I_TOT - 1)) (void)off; (void)perm; \
                _Pragma("unroll") for (int i = 0; i < 32; ++i) { const int kk = 2 * i + (lane >> 5); wv[i] = src[(size_t)(k0 + kk) * N + n0 + (lane & 31)] * (gain ? gain[k0 + kk] : 1.0f); } } while (0)
#define CVT_PROC(it_, wv) do { CVT_DECODE(it_) (void)src; (void)gain; \
                _Pragma("unroll") for (int i = 0; i < 32; ++i) { const int kk = 2 * i + (lane >> 5); scr[kk * 33 + (lane & 31)] = wv[i]; } \
                asm volatile("s_waitcnt lgkmcnt(0)" ::: "memory"); \
                int dn0 = n0; if (perm) { const int half = n0 >= FF ? 1 : 0; const int j_ = n0 - half * FF; dn0 = (j_ >> 7) * 256 + half * 128 + (j_ & 127); } \
                bf16* WT = (bf16*)(ws + WS_W) + (size_t)ll * LAYER_EL + off; const int c_ = lane & 7; \
                _Pragma("unroll") for (int j = 0; j < 4; ++j) { const int n = (lane >> 3) + 8 * j; const LAS float* sp_ = scr + (8 * c_) * 33 + n; \
                    v4u o; o.x = cvt_pk_bf16(sp_[0 * 33], sp_[1 * 33]); o.y = cvt_pk_bf16(sp_[2 * 33], sp_[3 * 33]); o.z = cvt_pk_bf16(sp_[4 * 33], sp_[5 * 33]); o.w = cvt_pk_bf16(sp_[6 * 33], sp_[7 * 33]); \
                    *(v4u*)(WT + (size_t)(dn0 + n) * K + k0 + 8 * c_) = o; } \
                asm volatile("s_waitcnt lgkmcnt(0)" ::: "memory"); } while (0)
            float wa[32], wb[32];
            int it = gw;
            CVT_LOAD(it, wa);
            while (it < I_TOT) {
                CVT_LOAD(it + NGW, wb);
                CVT_PROC(it, wa);
                it += NGW;
                CVT_LOAD(it + NGW, wa);
                if (it < I_TOT) CVT_PROC(it, wb);
                it += NGW;
            }
#undef CVT_DECODE
#undef CVT_LOAD
#undef CVT_PROC
        } else if (kind == K_G0) {
            const float* xin = pr == 0 ? args.in[0] : args.in[1];
#define G0_LOAD(rowx_, S) do { const int r_ = min((rowx_), 2 * TG - 1); const f32x4* xr_ = (const f32x4*)(xin + (size_t)r_ * D) + lane; \
                _Pragma("unroll") for (int j = 0; j < 4; ++j) gx##S[j] = xr_[64 * j]; } while (0)
#define G0_PROC(rowx_, S) do { const int rw_ = (rowx_); v2u* bo_ = (v2u*)(XBp + (size_t)rw_ * D) + lane; float ss_ = 0.f; \
                _Pragma("unroll") for (int j = 0; j < 4; ++j) { const f32x4 v = gx##S[j]; v2u w_; w_.x = cvt_pk_bf16(v[0], v[1]); w_.y = cvt_pk_bf16(v[2], v[3]); bo_[64 * j] = w_; ss_ += (v[0] * v[0] + v[1] * v[1]) + (v[2] * v[2] + v[3] * v[3]); } \
                ss_ = wave_sum(ss_); if (lane < 16) SSQp[(size_t)rw_ * 16 + lane] = lane == 0 ? ss_ : 0.f; } while (0)
            f32x4 gxA[4], gxB[4];
            { int rowi = gw;
              G0_LOAD(rowi, A);
              while (rowi < 2 * TG) {
                  G0_LOAD(rowi + NGW, B); G0_PROC(rowi, A); rowi += NGW;
                  G0_LOAD(rowi + NGW, A); if (rowi < 2 * TG) G0_PROC(rowi, B); rowi += NGW;
              } }
#undef G0_LOAD
#undef G0_PROC
        } else if (kind == K_UP) {
            pg8::Gemm gm{XBp, Wl + (s == 14 ? OFF_GU2 : OFF_GU1), 2 * TG, 2 * FF, D}; pg8::StaticOrder S; S.init(2 * TG, 2 * FF, G, bid);
            LAS float* rst = (LAS float*)(lds + 131072); LAS int* pml = (LAS int*)(lds + 131072 + 12288);
            __syncthreads();
            if (tid == 0) { int n = 0; pg8::Unit uu;
                for (int i = 0; S.next(i, uu); ++i) { bool f = false; for (int q = 0; q < n; ++q) f = f || (pml[q] == uu.pm); if (!f && n < 12) pml[n++] = uu.pm; }
                pml[15] = n; }
            __syncthreads();
            { const int n = pml[15];
              for (int idx = tid; idx < n * 256; idx += NTHR) { const int row = pml[idx >> 8] * 256 + (idx & 255); rst[idx] = pg8::row_rs(SSQp, row); } }
            __syncthreads();
            pg8::EpiSwiGLU E{PA, rst, pml, SSQp};
#ifndef NO_UP
            for (int rep = 0; rep < REP_GEMM; ++rep) pg8::gemm_phase<pg8::EpiSwiGLU, pg8::StaticOrder, PGA, PGS>(lds, gm, S, E);
#endif
        } else if (kind == K_RES) {
            const int K = mix ? D : FF, Mr = mix ? TG : 2 * TG; const size_t off = mix ? OFF_OUT : (s == 1 ? OFF_D1 : OFF_D2);
            pg8::Gemm gm{PA, Wl + off, Mr, D, K}; pg8::StaticOrder S; S.init(Mr, D, G, bid);
            pg8::EpiRes E{mix ? XB : XBp, mix ? SSQ : SSQp, mix ? 1.0f : 0.5f};
#ifndef NO_RES
            for (int rep = 0; rep < REP_RES; ++rep) { if (rep + 1 < REP_RES) { pg8::EpiRes E0 = E; E0.alpha = 0.f; pg8::gemm_phase<pg8::EpiRes, pg8::StaticOrder, PGA, PGS>(lds, gm, S, E0); }
                else pg8::gemm_phase<pg8::EpiRes, pg8::StaticOrder, PGA, PGS>(lds, gm, S, E); }
#endif
        } else if (kind == K_M1) {
            pg8::Gemm gm{XBp, Wl + OFF_IN, 2 * TG, 8704, D}; pg8::M1Order S; S.init(G, bid, g2);
            LAS float* rst = (LAS float*)(lds + 131072); LAS int* pml = (LAS int*)(lds + 131072 + 12288);
            __syncthreads();
            if (tid == 0) { int n = 0; pg8::Unit uu;
                for (int i = 0; S.next(i, uu); ++i) { bool f = false; for (int q = 0; q < n; ++q) f = f || (pml[q] == uu.pm); if (!f && n < 12) pml[n++] = uu.pm; }
                pml[15] = n; }
            __syncthreads();
            { const int n = pml[15];
              for (int idx = tid; idx < n * 256; idx += NTHR) { const int row = pml[idx >> 8] * 256 + (idx & 255); rst[idx] = pg8::row_rs(SSQp, row); } }
            __syncthreads();
            pg8::EpiProj E{PA, (unsigned char*)PG, (unsigned char*)PG + (size_t)TG * 3072, rst, pml, SSQp};
#ifndef NO_PROJ
            for (int rep = 0; rep < REP_GEMM; ++rep) pg8::gemm_phase<pg8::EpiProj, pg8::M1Order, PGA, PGS>(lds, gm, S, E);
#endif
        } else if (kind == K_M2A) {
#ifndef NO_HG
            { const int nP = (TG / 64) * 8;
              if (G == 256) { const int vcu1 = (bid % 8) * 32 + bid / 8; for (int rep = 0; rep < REP_HG; ++rep) hg_prep_items(lds, PA, SCR, args.in[7], l, vcu1 * (nP / 256), 1, (vcu1 + 1) * (nP / 256), T, tid); }
              else { for (int rep = 0; rep < REP_HG; ++rep) if (bid < nP) hg_prep_items(lds, PA, SCR, args.in[7], l, bid, G, nP, T, tid); } }
#endif
            const float* rpb = args.in[13] + (size_t)l * 8 * 465;
            const int vcu = (G % 8 == 0) ? (bid % 8) * (G / 8) + bid / 8 : bid;
            const int nNA = TG / 16, ipb = (nNA + G - 1) / G;
            for (int rep = 0; rep < REP_NA; ++rep)
                for (int q = 0; q < ipb; ++q) { const int it = vcu * ipb + q; if (it < nNA) {
#ifndef NO_NA
                    na_item(lds, PA, rpb, ONA, it, T, tid);
#endif
                    __syncthreads(); } }
        } else if (kind == K_M2B) {
#ifndef NO_HG
            const int vcu2 = (G % 8 == 0) ? (bid % 8) * (G / 8) + bid / 8 : bid;
            for (int rep = 0; rep < REP_HG; ++rep) {
                if (pr == 0) { for (int it = vcu2; it < 256; it += G) hg_scan_item<2>(lds, PA, SCR, it, T, tid); }
                else       { for (int it = vcu2; it < 256; it += G) hg_scan_item<1>(lds, PA, SCR, it, T, tid); }
            }
#endif
        } else if (kind == K_M3) {
            const float* gno = args.in[8] + l * 512; const float* cw = args.in[10] + l * 3 * 512; const float* cbias = args.in[11] + l * 512;
            const int c0 = lane * 8;
            const bf16* __restrict__ PAr = PA; bf16* __restrict__ OHGr = OHG; bf16* __restrict__ OCVr = OCV;
            const f32x4 gn0 = *(const f32x4*)(gno + c0), gn1 = *(const f32x4*)(gno + c0 + 4);
            const f32x4 w00 = *(const f32x4*)(cw + c0), w01 = *(const f32x4*)(cw + c0 + 4), w10 = *(const f32x4*)(cw + 512 + c0), w11 = *(const f32x4*)(cw + 512 + c0 + 4);
            const f32x4 w20 = *(const f32x4*)(cw + 1024 + c0), w21 = *(const f32x4*)(cw + 1024 + c0 + 4), bs0 = *(const f32x4*)(cbias + c0), bs1 = *(const f32x4*)(cbias + c0 + 4);
#define M3_DECL(S) v4u fw##S, bw##S, hg##S, a1##S, c1##S, bb##S, a0##S, q0##S, a2##S, q2##S
#define M3_LOAD(row_, S) do { const int r_ = min((row_), TG - 1); const bf16* pr_ = PAr + (size_t)r_ * PA_LD + c0; \
                const bf16* pm_ = PAr + (size_t)max(r_ - 1, 0) * PA_LD + c0; const bf16* pp_ = PAr + (size_t)min(r_ + 1, TG - 1) * PA_LD + c0; \
                fw##S = *(const v4u*)(pr_ + C_HQ); bw##S = *(const v4u*)(pr_ + C_HZF); hg##S = *(const v4u*)(pr_ + C_HG); \
                a1##S = *(const v4u*)(pr_ + C_CA); c1##S = *(const v4u*)(pr_ + C_CC); bb##S = *(const v4u*)(pr_ + C_CB); \
                a0##S = *(const v4u*)(pm_ + C_CA); q0##S = *(const v4u*)(pm_ + C_CC); a2##S = *(const v4u*)(pp_ + C_CA); q2##S = *(const v4u*)(pp_ + C_CC); } while (0)
#define M3_MUL8(A, B) {bflo(A.x) * bflo(B.x), bfhi(A.x) * bfhi(B.x), bflo(A.y) * bflo(B.y), bfhi(A.y) * bfhi(B.y), bflo(A.z) * bflo(B.z), bfhi(A.z) * bfhi(B.z), bflo(A.w) * bflo(B.w), bfhi(A.w) * bfhi(B.w)}
#define M3_PROC(row_, S) do { const int rw_ = (row_);     \
                float o[8] = {bflo(fw##S.x) + bflo(bw##S.x), bfhi(fw##S.x) + bfhi(bw##S.x), bflo(fw##S.y) + bflo(bw##S.y), bfhi(fw##S.y) + bfhi(bw##S.y), bflo(fw##S.z) + bflo(bw##S.z), bfhi(fw##S.z) + bfhi(bw##S.z), bflo(fw##S.w) + bflo(bw##S.w), bfhi(fw##S.w) + bfhi(bw##S.w)}; \
                float ss = 0.f; \
                _Pragma("unroll") for (int e = 0; e < 8; ++e) ss += o[e] * o[e]; \
                ss += __shfl_xor(ss, 1); ss += __shfl_xor(ss, 2); ss += __shfl_xor(ss, 4); ss += __shfl_xor(ss, 8); \
                const float rs = __builtin_amdgcn_rsqf(ss * (1.0f / 128.0f) + 1e-6f); \
                const float hgv[8] = {bflo(hg##S.x), bfhi(hg##S.x), bflo(hg##S.y), bfhi(hg##S.y), bflo(hg##S.z), bfhi(hg##S.z), bflo(hg##S.w), bfhi(hg##S.w)}; \
                const float gn[8] = {gn0[0], gn0[1], gn0[2], gn0[3], gn1[0], gn1[1], gn1[2], gn1[3]}; \
                float r8[8]; \
                _Pragma("unroll") for (int e = 0; e < 8; ++e) r8[e] = o[e] * rs * gn[e] * (hgv[e] * sigm(hgv[e])); \
                v4u wo; wo.x = cvt_pk_bf16(r8[0], r8[1]); wo.y = cvt_pk_bf16(r8[2], r8[3]); wo.z = cvt_pk_bf16(r8[4], r8[5]); wo.w = cvt_pk_bf16(r8[6], r8[7]); \
                *(v4u*)(OHGr + (size_t)rw_ * 512 + c0) = wo; \
                const int tl = rw_ & (T - 1); const float m0 = tl > 0 ? 1.f : 0.f, m2 = tl < T - 1 ? 1.f : 0.f; \
                const float zm[8] = M3_MUL8(a0##S, q0##S); const float zc[8] = M3_MUL8(a1##S, c1##S); const float zp[8] = M3_MUL8(a2##S, q2##S); \
                const float cbv[8] = {bflo(bb##S.x), bfhi(bb##S.x), bflo(bb##S.y), bfhi(bb##S.y), bflo(bb##S.z), bfhi(bb##S.z), bflo(bb##S.w), bfhi(bb##S.w)}; \
                _Pragma("unroll") for (int e = 0; e < 4; ++e) { r8[e] = cbv[e] * (w00[e] * (m0 * zm[e]) + w10[e] * zc[e] + w20[e] * (m2 * zp[e]) + bs0[e]); \
                    r8[4 + e] = cbv[4 + e] * (w01[e] * (m0 * zm[4 + e]) + w11[e] * zc[4 + e] + w21[e] * (m2 * zp[4 + e]) + bs1[e]); } \
                wo.x = cvt_pk_bf16(r8[0], r8[1]); wo.y = cvt_pk_bf16(r8[2], r8[3]); wo.z = cvt_pk_bf16(r8[4], r8[5]); wo.w = cvt_pk_bf16(r8[6], r8[7]); \
                *(v4u*)(OCVr + (size_t)rw_ * 512 + c0) = wo; } while (0)
            M3_DECL(A); M3_DECL(B);
            { int row = gw;
              M3_LOAD(row, A);
              while (row < TG) {
                  M3_LOAD(row + NGW, B);
                  M3_PROC(row, A);
                  row += NGW;
                  M3_LOAD(row + NGW, A);
                  if (row < TG) M3_PROC(row, B);
                  row += NGW;
              } }
#undef M3_DECL
#undef M3_LOAD
#undef M3_MUL8
#undef M3_PROC
        } else if (kind == K_M4) {
            pg8::Gemm gm{ONA, Wl + OFF_HG, 3 * TG, 3 * D, 512}; pg8::MergeOrder S; S.init(TG, D, G, bid);
            pg8::EpiMerge E{(const unsigned char*)PG + (size_t)g2 * TG * 3072, PA};
#ifndef NO_MERGE
            for (int rep = 0; rep < REP_MERGE; ++rep) pg8::gemm_phase<pg8::EpiMerge, pg8::MergeOrder, PGA, PGS>(lds, gm, S, E);
#endif
        } else {
            const f32x4* fgp = (const f32x4*)args.in[19] + lane;
            const f32x4 fg0 = fgp[0], fg1 = fgp[64], fg2 = fgp[128], fg3 = fgp[192];
#define GF_LOAD(rowx_, S) do { const int r_ = min((rowx_), 2 * TG - 1); const v2u* bi_ = (const v2u*)(XBp + (size_t)r_ * D) + lane; const f32x4* sq_ = (const f32x4*)(SSQp + (size_t)r_ * 16); \
                _Pragma("unroll") for (int j = 0; j < 4; ++j) { fb##S[j] = bi_[64 * j]; fs##S[j] = sq_[j]; } } while (0)
#define GF_PROC(rowx_, S) do { const int rw_ = (rowx_); float t_ = 0.f; \
                _Pragma("unroll") for (int j = 0; j < 4; ++j) t_ += (fs##S[j][0] + fs##S[j][1]) + (fs##S[j][2] + fs##S[j][3]); \
                const float rs_ = __builtin_amdgcn_rsqf(t_ * (1.0f / 1024.0f) + 1e-6f); f32x4* xo_ = (f32x4*)(X + (size_t)rw_ * D) + lane; \
                { const v2u w_ = fb##S[0]; const f32x4 v = {bflo(w_.x), bfhi(w_.x), bflo(w_.y), bfhi(w_.y)}; xo_[0] = v * fg0 * rs_; } \
                { const v2u w_ = fb##S[1]; const f32x4 v = {bflo(w_.x), bfhi(w_.x), bflo(w_.y), bfhi(w_.y)}; xo_[64] = v * fg1 * rs_; } \
                { const v2u w_ = fb##S[2]; const f32x4 v = {bflo(w_.x), bfhi(w_.x), bflo(w_.y), bfhi(w_.y)}; xo_[128] = v * fg2 * rs_; } \
                { const v2u w_ = fb##S[3]; const f32x4 v = {bflo(w_.x), bfhi(w_.x), bflo(w_.y), bfhi(w_.y)}; xo_[192] = v * fg3 * rs_; } } while (0)
            v2u fbA[4], fbB[4]; f32x4 fsA[4], fsB[4];
            { int rowi = gw;
              GF_LOAD(rowi, A);
              while (rowi < 2 * TG) {
                  GF_LOAD(rowi + NGW, B); GF_PROC(rowi, A); rowi += NGW;
                  GF_LOAD(rowi + NGW, A); if (rowi < 2 * TG) GF_PROC(rowi, B); rowi += NGW;
              } }
#undef GF_LOAD
#undef GF_PROC
        }
#if TPROBE
        __syncthreads();
        const unsigned long long tp1 = __builtin_amdgcn_s_memrealtime();
#endif
        if (ph + 1 < hi) { for (int rep = 0; rep < REP_SYNC; ++rep) { if (hi < 0) grid.sync(); else xcd_barrier(xbar);     } }
#if TPROBE
        const unsigned long long tp2 = __builtin_amdgcn_s_memrealtime();
        if (TPROBE == 100) tacc += tp2 - tp1;
        else if (kind == TPROBE - 1) tacc += tp1 - tp0;
#endif
    }
#if TPROBE
    if (blockIdx.x == TPROBE_BLOCK) { const unsigned long long te = __builtin_amdgcn_s_memrealtime(); while (__builtin_amdgcn_s_memrealtime() - te < tacc) __builtin_amdgcn_s_sleep(8); }
#endif
}
constexpr int N_PHASES = 1 + 2 * PH_PER_PAIR;

extern "C" void kernel_launch(void* const* d_in, const int* in_sizes, int n_in, void* d_out, int out_size, void* d_ws, size_t ws_size, hipStream_t stream) {
    static int grid = 0;
    if (grid == 0) {
        if (n_in != 20 || ws_size < WS_END) { fprintf(stderr, "kernel_launch: unexpected n_in %d / ws %zu\n", n_in, ws_size); grid = -1; return; }
        int dev = 0, cus = 0, per_cu = 0;
        hipGetDevice(&dev); hipDeviceGetAttribute(&cus, hipDeviceAttributeMultiprocessorCount, dev);
        hipFuncSetAttribute((const void*)mk_fwd, hipFuncAttributeMaxDynamicSharedMemorySize, LDS_BYTES);
        hipOccupancyMaxActiveBlocksPerMultiprocessor(&per_cu, (const void*)mk_fwd, NTHR, LDS_BYTES);
        if (per_cu < 1) per_cu = 1;
        grid = cus * per_cu;
        (void)hipGetLastError();
    }
    if (grid < 0) return;
    hipMemsetAsync((char*)d_ws + WS_CTL, 0, CTL_BYTES, stream);
    Args a{};
    for (int i = 0; i < 20; ++i) a.in[i] = (const float*)d_in[i];
    a.out = (float*)d_out; a.ws = (unsigned char*)d_ws;
#if ONE_LAUNCH
    a.ph_lo = 0; a.ph_hi = N_PHASES;
    void* kargs[] = {&a};
    hipError_t e = hipLaunchCooperativeKernel((const void*)mk_fwd, dim3(grid), dim3(NTHR), kargs, LDS_BYTES, stream);
    if (e != hipSuccess) fprintf(stderr, "cooperative launch failed: %s (grid %d)\n", hipGetErrorString(e), grid);
#else
    for (int p = 0; p < N_PHASES; ++p) { a.ph_lo = p; a.ph_hi = p + 1; hipLaunchKernelGGL(mk_fwd, dim3(grid), dim3(NTHR), LDS_BYTES, stream, a); }
#endif
}
```

```cpp
#include <hip/hip_runtime.h>
#include <hip/hip_cooperative_groups.h>
#include <cstdio>
#include <cstdint>
namespace cg = cooperative_groups;
#ifndef ONE_LAUNCH
#define ONE_LAUNCH 1
#endif
#ifndef REP_HG
#define REP_HG 1
#endif
#ifndef REP_NA
#define REP_NA 1
#endif
#ifndef REP_SYNC
#define REP_SYNC 1
#endif
#ifndef REP_GEMM
#define REP_GEMM 1
#endif
#ifndef REP_M3
#define REP_M3 1
#endif
#ifndef REP_RES
#define REP_RES 1
#endif
#ifndef REP_MERGE
#define REP_MERGE 1
#endif
#ifndef REP_MISC
#define REP_MISC 1
#endif
#ifndef TPROBE
#define TPROBE 0
#endif
#ifndef TPROBE_BLOCK
#define TPROBE_BLOCK 0
#endif
#ifndef PGA
#define PGA true
#endif
#ifndef PGS
#define PGS true
#endif
#ifndef RS_PROBE
#define RS_PROBE 0
#endif
namespace pg8 {
#define PG8_LAS __attribute__((address_space(3)))
typedef unsigned short bf16_t;
typedef short bf16x8 __attribute__((ext_vector_type(8)));
typedef float f32x4 __attribute__((ext_vector_type(4)));
typedef unsigned u32x4 __attribute__((ext_vector_type(4)));
constexpr int BM = 256, BK = 64, HALF = 128, HTB = HALF * BK * 2  , STAGE_BYTES = 8 * HTB, NXCD = 8, WGM = 8;

__host__ __device__ __forceinline__ int lds_byte(int r, int c) { const int st = (r >> 4) * 2 + (c >> 5), rr = r & 15, cc = c & 31, ob = rr * 64 + cc * 2; return st * 1024 + (ob ^ (((ob >> 9) & 1) << 5)); }
__host__ __device__ __forceinline__ void stage_rc(int b, int& R, int& C) { const int st = b / 1024, sb = b % 1024, swz = sb ^ (((sb >> 9) & 1) << 5); R = (st >> 1) * 16 + swz / 64; C = (st & 1) * 32 + (swz % 64) / 2; }
__host__ __device__ __forceinline__ int perm32(int rho) { const int n = rho >> 4, i = rho & 15; return 8 * (i >> 2) + 4 * n + (i & 3); }

struct Unit { int pm, pn; };
struct Gemm { const bf16_t* A; const bf16_t* Bt; int M, N, K; };

struct StaticOrder {
    int nM, nN, nwg, G, c;
    __host__ __device__ void init(int M, int N, int G_, int c_) { nM = M / BM; nN = N / BM; nwg = nM * nN; G = G_; c = c_; }
    __host__ __device__ bool next(int i, Unit& u) const {
        const long L = (long)i * G + c; if (L >= nwg) return false;
        int wgid = (int)L; { const int q = nwg / NXCD, r = nwg % NXCD, xcd = wgid % NXCD, off = wgid / NXCD; wgid = (xcd < r ? xcd * (q + 1) : r * (q + 1) + (xcd - r) * q) + off; }
        const int nig = WGM * nN, gid = wgid / nig, fm = gid * WGM, gsz = (nM - fm) < WGM ? (nM - fm) : WGM;
        u.pm = fm + ((wgid % nig) % gsz); u.pn = (wgid % nig) / gsz; return true;
    }
    __device__ __forceinline__ void a_ready(const Unit&) const {}
    __device__ __forceinline__ void done(const Unit&) const {}
};

__device__ __forceinline__ unsigned cvt_pk_bf16(float lo, float hi) { unsigned r; asm volatile("v_cvt_pk_bf16_f32 %0, %1, %2" : "=v"(r) : "v"(lo), "v"(hi)); return r; }
__device__ __forceinline__ float row_rs(const float* ssq, int row) {
    const f32x4* p = (const f32x4*)(ssq + (size_t)row * 16);
    const f32x4 a = p[0], b = p[1], c = p[2], d = p[3];
    const float s = (((a[0] + a[1]) + (a[2] + a[3])) + ((b[0] + b[1]) + (b[2] + b[3]))) + (((c[0] + c[1]) + (c[2] + c[3])) + ((d[0] + d[1]) + (d[2] + d[3])));
    return __builtin_amdgcn_rsqf(s * (1.0f / 1024.0f) + 1e-6f);
}
__device__ __forceinline__ void row_rs8_impl(const float* ssq, int row0, float (&rsv)[8]) {
#pragma unroll
    for (int ai = 0; ai < 2; ++ai) {
        f32x4 p[4][4];
#pragma unroll
        for (int m = 0; m < 4; ++m) { const f32x4* q = (const f32x4*)(ssq + (size_t)(row0 + ai * HALF + m * 16) * 16);
#pragma unroll
            for (int j = 0; j < 4; ++j) p[m][j] = q[j]; }
#pragma unroll
        for (int m = 0; m < 4; ++m) { float t = 0.f;
#pragma unroll
            for (int j = 0; j < 4; ++j) t += (p[m][j][0] + p[m][j][1]) + (p[m][j][2] + p[m][j][3]);
            rsv[ai * 4 + m] = __builtin_amdgcn_rsqf(t * (1.0f / 1024.0f) + 1e-6f); }
    }
}
__device__ __forceinline__ void row_rs8(const float* ssq, int row0, float (&rsv)[8]) {
#if RS_PROBE
    { const float* ssq2 = ssq; asm volatile("" : "+s"(ssq2)); float t2[8]; row_rs8_impl(ssq2, row0, t2); row_rs8_impl(ssq, row0, rsv);
#pragma unroll
      for (int i = 0; i < 8; ++i) rsv[i] = 0.5f * (rsv[i] + t2[i]); return; }
#endif
    row_rs8_impl(ssq, row0, rsv);
}
__device__ __forceinline__ void row_rs8_lds(const PG8_LAS float* rst, const PG8_LAS int* pml, const float* ssq, int pm, int wr, int fr, float (&rsv)[8]) {
    const int n = pml[15]; int slot = -1;
#pragma unroll
    for (int s_ = 0; s_ < 12; ++s_) if (s_ < n && pml[s_] == pm) slot = s_;
    if (slot < 0) { row_rs8(ssq, pm * BM + wr * 64 + fr, rsv); return; }
    const PG8_LAS float* t = rst + slot * 256 + wr * 64 + fr;
#pragma unroll
    for (int ai = 0; ai < 2; ++ai)
#pragma unroll
        for (int m = 0; m < 4; ++m) rsv[ai * 4 + m] = t[ai * HALF + m * 16];
}
__device__ __forceinline__ float sigm(float v) { return __builtin_amdgcn_rcpf(1.0f + __expf(-v)); }

struct EpiSwiGLU {
    static constexpr bool PERM = true, AFTER_DRAIN = false, CARRY = false;
    bf16_t* H; const PG8_LAS float* rst; const PG8_LAS int* pml; const float* ssq;
    __device__ __forceinline__ void operator()(const f32x4 (&acc)[2][2][4][2], const Unit& u, int wr, int wc, int fr, int fq) const {
        const int row0 = u.pm * BM + wr * 64 + fr, col0 = u.pn * 128 + wc * 32 + 8 * fq;
        float rsv[8]; row_rs8_lds(rst, pml, ssq, u.pm, wr, fr, rsv);
#pragma unroll
        for (int ai = 0; ai < 2; ++ai)
#pragma unroll
            for (int m = 0; m < 4; ++m) {
                const int row = row0 + ai * HALF + m * 16; const float rs = rsv[ai * 4 + m];
                const float c1 = rs * -1.4426950408889634f, rs2 = rs * rs;
                u32x4 w;
#pragma unroll
                for (int n = 0; n < 2; ++n) {
                    const f32x4 na = acc[ai][0][m][n] * c1, p = acc[ai][0][m][n] * acc[ai][1][m][n]; f32x4 d;
#pragma unroll
                    for (int e = 0; e < 4; ++e) d[e] = __builtin_amdgcn_rcpf(1.0f + __builtin_amdgcn_exp2f(na[e]));
                    const f32x4 h = p * (d * rs2);
                    w[2 * n] = cvt_pk_bf16(h[0], h[1]); w[2 * n + 1] = cvt_pk_bf16(h[2], h[3]);
                }
                *(u32x4*)(H + (size_t)row * 2816 + col0) = w;
            }
    }
};
__device__ __forceinline__ void unpack8(const u32x4 w, f32x4& lo, f32x4& hi) {
    lo[0] = __uint_as_float(w.x << 16); lo[1] = __uint_as_float(w.x & 0xffff0000u); lo[2] = __uint_as_float(w.y << 16); lo[3] = __uint_as_float(w.y & 0xffff0000u);
    hi[0] = __uint_as_float(w.z << 16); hi[1] = __uint_as_float(w.z & 0xffff0000u); hi[2] = __uint_as_float(w.w << 16); hi[3] = __uint_as_float(w.w & 0xffff0000u);
}
struct EpiRes {
    static constexpr bool PERM = true, AFTER_DRAIN = false, CARRY = false;
    bf16_t* XB; float* ssq; float alpha;
    __device__ __forceinline__ void operator()(const f32x4 (&acc)[2][2][4][2], const Unit& u, int wr, int wc, int fr, int fq) const {
        const int row0 = u.pm * BM + wr * 64 + fr, col0 = u.pn * BM + wc * 32 + 8 * fq;
#pragma unroll
        for (int ai = 0; ai < 2; ++ai) {
            u32x4 xin[4][2];
#pragma unroll
            for (int m = 0; m < 4; ++m)
#pragma unroll
                for (int bj = 0; bj < 2; ++bj) xin[m][bj] = *(const u32x4*)(XB + (size_t)(row0 + ai * HALF + m * 16) * 1024 + col0 + bj * HALF);
#pragma unroll
            for (int m = 0; m < 4; ++m) {
                const int row = row0 + ai * HALF + m * 16; float ss = 0.f;
#pragma unroll
                for (int bj = 0; bj < 2; ++bj) {
                    bf16_t* xp = XB + (size_t)row * 1024 + col0 + bj * HALF;
                    f32x4 x0, x1; unpack8(xin[m][bj], x0, x1);
                    x0 = x0 + acc[ai][bj][m][0] * alpha; x1 = x1 + acc[ai][bj][m][1] * alpha;
                    u32x4 w; w.x = cvt_pk_bf16(x0[0], x0[1]); w.y = cvt_pk_bf16(x0[2], x0[3]); w.z = cvt_pk_bf16(x1[0], x1[1]); w.w = cvt_pk_bf16(x1[2], x1[3]);
                    *(u32x4*)xp = w;
                    ss += ((x0[0] * x0[0] + x0[1] * x0[1]) + (x0[2] * x0[2] + x0[3] * x0[3])) + ((x1[0] * x1[0] + x1[1] * x1[1]) + (x1[2] * x1[2] + x1[3] * x1[3]));
                }
                ss += __shfl_xor(ss, 16); ss += __shfl_xor(ss, 32);
                if (fq == 0) ssq[(size_t)row * 16 + u.pn * 4 + wc] = ss;
            }
            asm volatile("" ::: "memory");
        }
    }
};
struct M1Order {
    StaticOrder so; int second, G, c;
    __device__ void init(int G_, int c_, int second_) { second = second_; G = G_; c = c_; so.init(16384, second_ ? 8192 : 8704, G_, c_); }
    __device__ bool next(int i, Unit& u) const {
        if (!second) { if (so.next(i, u)) return true;
            const long L = (long)i * G + c - 2176; if (L < 0 || L >= 128) return false; u.pm = 64 + (int)(L >> 1); u.pn = 22 + (int)(L & 1); return true; }
        Unit b; if (!so.next(i, b)) return false; u.pm = b.pm + 64; u.pn = b.pn < 22 ? b.pn : b.pn + 2; return true;
    }
    __device__ __forceinline__ void a_ready(const Unit&) const {}
    __device__ __forceinline__ void done(const Unit&) const {}
};
struct EpiProj {
    static constexpr bool PERM = true, AFTER_DRAIN = false, CARRY = false;
    bf16_t* PA; unsigned char* PGa; unsigned char* PGb; const PG8_LAS float* rst; const PG8_LAS int* pml; const float* ssq;
    __device__ __forceinline__ void operator()(const f32x4 (&acc)[2][2][4][2], const Unit& u, int wr, int wc, int fr, int fq) const {
        unsigned char* PG8 = u.pm < 64 ? PGa : PGb;
        const int prow0 = u.pm * BM + wr * 64 + fr, row0 = prow0 & 16383;
        float rsv[8]; row_rs8_lds(rst, pml, ssq, u.pm, wr, fr, rsv);
        if (u.pn < 22) {
            const int col0 = u.pn * BM + wc * 32 + 8 * fq;
#pragma unroll
            for (int ai = 0; ai < 2; ++ai)
#pragma unroll
                for (int m = 0; m < 4; ++m) {
                    const int row = row0 + ai * HALF + m * 16; const float rs = rsv[ai * 4 + m];
#pragma unroll
                    for (int bj = 0; bj < 2; ++bj) {
                        const f32x4 v0 = acc[ai][bj][m][0] * rs, v1 = acc[ai][bj][m][1] * rs;
                        u32x4 w; w.x = cvt_pk_bf16(v0[0], v0[1]); w.y = cvt_pk_bf16(v0[2], v0[3]); w.z = cvt_pk_bf16(v1[0], v1[1]); w.w = cvt_pk_bf16(v1[2], v1[3]);
                        *(u32x4*)(PA + (size_t)row * 5632 + col0 + bj * HALF) = w;
                    }
                }
        } else {
            const int col0 = (u.pn - 22) * BM + wc * 32 + 8 * fq;
#pragma unroll
            for (int ai = 0; ai < 2; ++ai)
#pragma unroll
                for (int m = 0; m < 4; ++m) {
                    const int row = row0 + ai * HALF + m * 16; const float c1 = rsv[ai * 4 + m] * -1.4426950408889634f;
#pragma unroll
                    for (int bj = 0; bj < 2; ++bj) {
                        unsigned q[8];
#pragma unroll
                        for (int e = 0; e < 4; ++e) { q[e] = (unsigned)(__builtin_amdgcn_rcpf(1.0f + __builtin_amdgcn_exp2f(acc[ai][bj][m][0][e] * c1)) * 255.0f + 0.5f); q[4 + e] = (unsigned)(__builtin_amdgcn_rcpf(1.0f + __builtin_amdgcn_exp2f(acc[ai][bj][m][1][e] * c1)) * 255.0f + 0.5f); }
                        typedef unsigned u32x2_ __attribute__((ext_vector_type(2)));
                        u32x2_ w; w.x = q[0] | (q[1] << 8) | (q[2] << 16) | (q[3] << 24); w.y = q[4] | (q[5] << 8) | (q[6] << 16) | (q[7] << 24);
                        *(u32x2_*)(PG8 + (size_t)row * 3072 + col0 + bj * HALF) = w;
                    }
                }
        }
    }
};
struct MergeOrder {
    StaticOrder so;
    __device__ void init(int M, int N, int G_, int c_) { so.init(M, N, G_, c_); }
    __device__ bool next(int i, Unit& u) const { Unit b; if (!so.next(i / 3, b)) return false; const int m = i % 3, w = (m == 0) ? 2 : m - 1; u.pm = b.pm + 64 * m; u.pn = b.pn + 4 * w; return true; }
    __device__ __forceinline__ void a_ready(const Unit&) const {}
    __device__ __forceinline__ void done(const Unit&) const {}
};
struct EpiMerge {
    static constexpr bool PERM = true, AFTER_DRAIN = false, CARRY = true;
    const unsigned char* PG8; bf16_t* MB;
    __device__ __forceinline__ void operator()(const f32x4 (&)[2][2][4][2], const Unit&, int, int, int, int) const {}
    __device__ __forceinline__ bool carry(f32x4 (&acc)[2][2][4][2], const Unit& u, int wr, int wc, int fr, int fq) const {
        typedef unsigned u32x2_ __attribute__((ext_vector_type(2)));
        const int m_ = u.pm >> 6, pm = u.pm & 63, w_ = u.pn >> 2, pn = u.pn & 3;
        const int wn = (m_ == 0) ? 0 : 1;
        const bool last = (m_ == 2);
        const int row0 = pm * BM + wr * 64 + fr, col0 = pn * BM + wc * 32 + 8 * fq;
#pragma unroll
        for (int ai = 0; ai < 2; ++ai) {
            u32x2_ gc[4][2], gn[4][2];
#pragma unroll
            for (int m = 0; m < 4; ++m)
#pragma unroll
                for (int bj = 0; bj < 2; ++bj) { const size_t o = (size_t)(row0 + ai * HALF + m * 16) * 3072 + col0 + bj * HALF;
                    gc[m][bj] = *(const u32x2_*)(PG8 + o + w_ * 1024);
                    gn[m][bj] = last ? (u32x2_){0x01010101u, 0x01010101u} : *(const u32x2_*)(PG8 + o + wn * 1024); }
#pragma unroll
            for (int m = 0; m < 4; ++m)
#pragma unroll
                for (int bj = 0; bj < 2; ++bj) {
                    float f[8];
#pragma unroll
                    for (int e = 0; e < 8; ++e) { const unsigned wc_ = e < 4 ? gc[m][bj].x : gc[m][bj].y, wn_ = e < 4 ? gn[m][bj].x : gn[m][bj].y; const int sh = 8 * (e & 3);
                        const float qc = (float)max((wc_ >> sh) & 255u, 1u), qn = (float)max((wn_ >> sh) & 255u, 1u);
                        f[e] = last ? qc * (1.0f / 255.0f) : qc * __builtin_amdgcn_rcpf(qn); }
#pragma unroll
                    for (int e = 0; e < 4; ++e) { acc[ai][bj][m][0][e] *= f[e]; acc[ai][bj][m][1][e] *= f[4 + e]; }
                    if (last) { const f32x4 t0 = acc[ai][bj][m][0], t1 = acc[ai][bj][m][1];
                        u32x4 w; w.x = cvt_pk_bf16(t0[0], t0[1]); w.y = cvt_pk_bf16(t0[2], t0[3]); w.z = cvt_pk_bf16(t1[0], t1[1]); w.w = cvt_pk_bf16(t1[2], t1[3]);
                        *(u32x4*)(MB + (size_t)(row0 + ai * HALF + m * 16) * 1024 + col0 + bj * HALF) = w; }
                }
            asm volatile("" ::: "memory");
        }
        return !last;
    }
};
template <class Epi, class Sched, bool ALIGN_EPI = false, bool SP2 = false>
__device__ __forceinline__ void gemm_phase(PG8_LAS unsigned char* lds, const Gemm g, const Sched& S, const Epi& E) {
    int tid = threadIdx.x; asm volatile("" : "+v"(tid));
    const int wid = __builtin_amdgcn_readfirstlane(tid >> 6), lane = tid & 63, wr = wid >> 2, wc = wid & 3, fr = lane & 15, fq = lane >> 4;
    const int K = g.K, nt = K / BK;
    unsigned voffA[2], voffB[2];
#pragma unroll
    for (int i = 0; i < 2; ++i) { int R, C; stage_rc(tid * 16 + i * 8192, R, C); const int Rb = Epi::PERM ? ((R & ~31) + perm32(R & 31)) : R;
        voffA[i] = (unsigned)(R * K + C) * 2u; voffB[i] = (unsigned)(Rb * K + C) * 2u; }
    const size_t kstep = (size_t)(BK * 2);
    const size_t hstep = (size_t)HALF * K * 2;
    const size_t tstep = 2 * hstep;
    const unsigned ldsw = (unsigned)wid * 1024u;
    const int aoff = lds_byte(wr * 64 + fr, fq * 8), boff = lds_byte(wc * 32 + fr, fq * 8);
#define PG8_SA(b, h) (((b) * 2 + (h)) * HTB)
#define PG8_SB(b, h) ((4 + (b) * 2 + (h)) * HTB)
#define PG8_STAGE(bufoff, gbase, voff) do { _Pragma("unroll") for (int _i = 0; _i < 2; ++_i) \
        __builtin_amdgcn_global_load_lds((const unsigned*)((const char*)(gbase) + (voff)[_i]), (PG8_LAS unsigned*)(lds + (bufoff) + ldsw + _i * 8192), 16, 0, 0); } while (0)
#define PG8_LDA(dst, b, h) do { _Pragma("unroll") for (int m = 0; m < 4; ++m) _Pragma("unroll") for (int k = 0; k < 2; ++k) dst[m][k] = *(const PG8_LAS bf16x8*)(lds + PG8_SA(b, h) + aoff + m * 2048 + k * 1024); } while (0)
#define PG8_LDB(dst, b, h) do { _Pragma("unroll") for (int n = 0; n < 2; ++n) _Pragma("unroll") for (int k = 0; k < 2; ++k) dst[n][k] = *(const PG8_LAS bf16x8*)(lds + PG8_SB(b, h) + boff + n * 2048 + k * 1024); } while (0)
#define PG8_MMA(ai, bj, At, Bt) do { __builtin_amdgcn_s_setprio(1); _Pragma("unroll") for (int m = 0; m < 4; ++m) _Pragma("unroll") for (int n = 0; n < 2; ++n) _Pragma("unroll") for (int k = 0; k < 2; ++k) \
        acc[ai][bj][m][n] = __builtin_amdgcn_mfma_f32_16x16x32_bf16(Bt[n][k], At[m][k], acc[ai][bj][m][n], 0, 0, 0); __builtin_amdgcn_s_setprio(0); } while (0)
#define PG8_WAIT_V(n) asm volatile("s_waitcnt vmcnt(" #n ")" ::: "memory")
#define PG8_WAIT_L(n) asm volatile("s_waitcnt lgkmcnt(" #n ")" ::: "memory")
#define PG8_BAR __builtin_amdgcn_s_barrier()
#define PG8_SCHED __builtin_amdgcn_sched_barrier(0)
    Unit cur, nxt; int ui = 0;
    if (!S.next(0, cur)) return;
    f32x4 acc[2][2][4][2];
#pragma unroll
    for (int a = 0; a < 2; ++a)
#pragma unroll
        for (int b = 0; b < 2; ++b)
#pragma unroll
            for (int m = 0; m < 4; ++m)
#pragma unroll
                for (int n = 0; n < 2; ++n) acc[a][b][m][n] = (f32x4){0.f, 0.f, 0.f, 0.f};
    bf16x8 At[4][2], B0[2][2], B1[2][2];
    const char* cA = (const char*)g.A + (size_t)cur.pm * tstep; const char* cB = (const char*)g.Bt + (size_t)cur.pn * tstep;
    S.a_ready(cur);
    if constexpr (SP2) {
        PG8_STAGE(PG8_SB(0, 0), cB, voffB); PG8_STAGE(PG8_SB(0, 1), cB + hstep, voffB); PG8_STAGE(PG8_SA(0, 0), cA, voffA); PG8_STAGE(PG8_SA(0, 1), cA + hstep, voffA);
        if (wr == 1) PG8_BAR;
        PG8_WAIT_V(2); PG8_BAR;
        PG8_STAGE(PG8_SB(1, 0), cB + kstep, voffB); PG8_STAGE(PG8_SA(1, 0), cA + kstep, voffA); PG8_STAGE(PG8_SB(1, 1), cB + hstep + kstep, voffB);
        PG8_WAIT_V(6); PG8_BAR;
    } else {
        PG8_STAGE(PG8_SB(0, 0), cB, voffB); PG8_STAGE(PG8_SA(0, 0), cA, voffA); PG8_STAGE(PG8_SB(0, 1), cB + hstep, voffB); PG8_STAGE(PG8_SA(0, 1), cA + hstep, voffA);
        if (wr == 1) PG8_BAR;
        PG8_WAIT_V(4); PG8_BAR;
        PG8_STAGE(PG8_SB(1, 0), cB + kstep, voffB); PG8_STAGE(PG8_SA(1, 0), cA + kstep, voffA); PG8_STAGE(PG8_SB(1, 1), cB + hstep + kstep, voffB);
        PG8_WAIT_V(6); PG8_BAR;
    }
    for (;;) {
        const bool has_next = S.next(ui + 1, nxt);
        const char* nA = has_next ? (const char*)g.A + (size_t)nxt.pm * tstep : cA; const char* nB = has_next ? (const char*)g.Bt + (size_t)nxt.pn * tstep : cB;
        for (int t = 0; t < nt; t += 2) {
            const bool last = (t == nt - 2);
            const char* a1 = cA + (size_t)(t + 1) * kstep;
            const char* a2 = last ? nA : cA + (size_t)(t + 2) * kstep; const char* b2 = last ? nB : cB + (size_t)(t + 2) * kstep;
            const char* a3 = a2 + kstep; const char* b3 = b2 + kstep;
            if (last && has_next) S.a_ready(nxt);
            if constexpr (SP2) {
            PG8_LDB(B0, 0, 0); PG8_LDB(B1, 0, 1); PG8_SCHED; PG8_LDA(At, 0, 0); PG8_STAGE(PG8_SA(1, 1), a1 + hstep, voffA);
            PG8_WAIT_V(8); PG8_WAIT_L(0); PG8_BAR; PG8_MMA(0, 0, At, B0); PG8_MMA(0, 1, At, B1); PG8_BAR; PG8_SCHED;
            PG8_LDA(At, 0, 1); PG8_STAGE(PG8_SB(0, 0), b2, voffB); PG8_STAGE(PG8_SB(0, 1), b2 + hstep, voffB); PG8_STAGE(PG8_SA(0, 0), a2, voffA);
            PG8_WAIT_V(8); PG8_WAIT_L(0); PG8_BAR; PG8_MMA(1, 0, At, B0); PG8_MMA(1, 1, At, B1); PG8_BAR; PG8_SCHED;
            PG8_LDB(B0, 1, 0); PG8_LDB(B1, 1, 1); PG8_SCHED; PG8_LDA(At, 1, 0); PG8_STAGE(PG8_SA(0, 1), a2 + hstep, voffA);
            PG8_WAIT_V(8); PG8_WAIT_L(0); PG8_BAR; PG8_MMA(0, 0, At, B0); PG8_MMA(0, 1, At, B1); PG8_BAR; PG8_SCHED;
            PG8_LDA(At, 1, 1); PG8_STAGE(PG8_SB(1, 0), b3, voffB); PG8_STAGE(PG8_SB(1, 1), b3 + hstep, voffB); PG8_STAGE(PG8_SA(1, 0), a3, voffA);
            PG8_WAIT_V(8); PG8_WAIT_L(0); PG8_BAR; PG8_MMA(1, 0, At, B0); PG8_MMA(1, 1, At, B1); PG8_BAR; PG8_SCHED;
            } else {
            PG8_LDB(B0, 0, 0); PG8_SCHED; PG8_LDA(At, 0, 0); PG8_STAGE(PG8_SA(1, 1), a1 + hstep, voffA);
            PG8_WAIT_L(8); PG8_BAR; PG8_WAIT_L(0); PG8_MMA(0, 0, At, B0); PG8_BAR; PG8_SCHED;
            PG8_LDB(B1, 0, 1); PG8_STAGE(PG8_SB(0, 0), b2, voffB);
            PG8_BAR; PG8_WAIT_L(0); PG8_MMA(0, 1, At, B1); PG8_BAR;
            PG8_LDA(At, 0, 1); PG8_STAGE(PG8_SA(0, 0), a2, voffA);
            PG8_BAR; PG8_WAIT_L(0); PG8_MMA(1, 0, At, B0); PG8_BAR; PG8_SCHED;
            PG8_STAGE(PG8_SB(0, 1), b2 + hstep, voffB);
            PG8_WAIT_V(6); PG8_BAR; PG8_MMA(1, 1, At, B1); PG8_BAR;
            PG8_LDB(B0, 1, 0); PG8_SCHED; PG8_LDA(At, 1, 0); PG8_STAGE(PG8_SA(0, 1), a2 + hstep, voffA);
            PG8_WAIT_L(8); PG8_BAR; PG8_WAIT_L(0); PG8_MMA(0, 0, At, B0); PG8_BAR; PG8_SCHED;
            PG8_LDB(B1, 1, 1); PG8_STAGE(PG8_SB(1, 0), b3, voffB);
            PG8_BAR; PG8_WAIT_L(0); PG8_MMA(0, 1, At, B1); PG8_BAR;
            PG8_LDA(At, 1, 1); PG8_STAGE(PG8_SA(1, 0), a3, voffA);
            PG8_BAR; PG8_WAIT_L(0); PG8_MMA(1, 0, At, B0); PG8_BAR; PG8_SCHED;
            PG8_STAGE(PG8_SB(1, 1), b3 + hstep, voffB);
            PG8_WAIT_V(6); PG8_BAR; PG8_MMA(1, 1, At, B1); PG8_BAR;
            }
        }
        if constexpr (ALIGN_EPI) { if (wr == 0) PG8_BAR; }
        bool keep = false;
        if constexpr (Epi::CARRY) { keep = E.carry(acc, cur, wr, wc, fr, fq); S.done(cur); }
        else if constexpr (!Epi::AFTER_DRAIN) { E(acc, cur, wr, wc, fr, fq); S.done(cur); }
        if (!has_next) break;
        if (!keep) {
#pragma unroll
        for (int a = 0; a < 2; ++a)
#pragma unroll
            for (int b = 0; b < 2; ++b)
#pragma unroll
                for (int m = 0; m < 4; ++m)
#pragma unroll
                    for (int n = 0; n < 2; ++n) acc[a][b][m][n] = (f32x4){0.f, 0.f, 0.f, 0.f};
        }
        cur = nxt; cA = nA; cB = nB; ++ui;
        if constexpr (ALIGN_EPI) { if (wr == 1) PG8_BAR; }
    }
    PG8_WAIT_V(0);
    if constexpr (!ALIGN_EPI) { if (wr == 0) PG8_BAR; }
    PG8_BAR;
    if constexpr (Epi::AFTER_DRAIN) { E.fused(acc, cur, wr, wc, fr, fq, lds, wid, lane); S.done(cur); }
#undef PG8_SA
#undef PG8_SB
#undef PG8_STAGE
#undef PG8_LDA
#undef PG8_LDB
#undef PG8_MMA
#undef PG8_WAIT_V
#undef PG8_WAIT_L
#undef PG8_BAR
#undef PG8_SCHED
}
}
#define LAS __attribute__((address_space(3)))
typedef unsigned short bf16;
typedef unsigned v4u __attribute__((ext_vector_type(4)));
typedef unsigned v2u __attribute__((ext_vector_type(2)));
typedef short v4i16_t __attribute__((ext_vector_type(4)));
using pg8::f32x4; using pg8::bf16x8; using pg8::cvt_pk_bf16;

constexpr int D = 1024, FF = 2816, NLAYER = 4, TG = 16384, NGROUP = 4, NTHR = 512, NWAVES = 8;
constexpr int PA_LD = 5632, PG_LD = 3072;
constexpr int C_HQ = 0, C_HI = 512, C_HZF = 1024, C_HZB = 1536, C_HG = 2048, C_CA = 2560, C_CB = 3072, C_CC = 3584, C_NQ = 4096, C_NK = 4608, C_NV = 5120;
constexpr size_t MiB = 1u << 20;
constexpr size_t WS_CTL = 0, CTL_BYTES = 1 * MiB, WS_W = 1 * MiB, WS_XB = 221 * MiB, WS_SSQ = 285 * MiB, WS_PA = 287 * MiB, WS_PG = 463 * MiB, WS_ONA = 559 * MiB, WS_SCR = 575 * MiB, WS_END = 671 * MiB;
constexpr size_t OFF_GU1 = 0, OFF_D1 = 5767168, OFF_IN = 8650752, OFF_HG = 17563648, OFF_CV = 18087936, OFF_NA = 18612224, OFF_OUT = 19136512, OFF_GU2 = 20185088, OFF_D2 = 25952256, LAYER_EL = 28835840;
constexpr int LDS_BYTES = 147456, LDS_MISC = 147456 - 64;
constexpr int PH_PER_PAIR = 1 + NLAYER * 16 + 1;
constexpr int CW_BAR = 4096;

__device__ __forceinline__ unsigned f2bf(float f) { unsigned u = __float_as_uint(f); return (u + 0x7fffu + ((u >> 16) & 1u)) >> 16; }
__device__ __forceinline__ float bf2f(unsigned b) { return __uint_as_float(b << 16); }
__device__ __forceinline__ float bflo(unsigned w) { return __uint_as_float(w << 16); }
__device__ __forceinline__ float bfhi(unsigned w) { return __uint_as_float(w & 0xffff0000u); }
__device__ __forceinline__ float sigm(float v) { return __builtin_amdgcn_rcpf(1.0f + __expf(-v)); }
__device__ __forceinline__ float wave_sum(float v) {
#pragma unroll
    for (int o = 1; o < 64; o <<= 1) v += __shfl_xor(v, o);
    return v;
}

__device__ __forceinline__ void cvt_item(const float* W, int K, int N, bf16* WT, const float* gain, bool permgu, LAS float* scr, int item, int lane) {
    const int nblk = N / 32, kb = item / nblk, nb = item % nblk, k0 = 64 * kb, n0 = 32 * nb;
#pragma unroll
    for (int i = 0; i < 32; ++i) { const int kk = 2 * i + (lane >> 5); const float g = gain ? gain[k0 + kk] : 1.0f; scr[kk * 33 + (lane & 31)] = W[(size_t)(k0 + kk) * N + n0 + (lane & 31)] * g; }
    asm volatile("s_waitcnt lgkmcnt(0)" ::: "memory");
    int dn0 = n0;
    if (permgu) { const int half = n0 >= FF ? 1 : 0; const int j = n0 - half * FF; dn0 = (j >> 7) * 256 + half * 128 + (j & 127); }
    const int c = lane & 7;
#pragma unroll
    for (int j = 0; j < 4; ++j) { const int n = (lane >> 3) + 8 * j; const LAS float* s = scr + (8 * c) * 33 + n;
        v4u o; o.x = cvt_pk_bf16(s[0 * 33], s[1 * 33]); o.y = cvt_pk_bf16(s[2 * 33], s[3 * 33]); o.z = cvt_pk_bf16(s[4 * 33], s[5 * 33]); o.w = cvt_pk_bf16(s[6 * 33], s[7 * 33]);
        *(v4u*)(WT + (size_t)(dn0 + n) * K + k0 + 8 * c) = o; }
    asm volatile("s_waitcnt lgkmcnt(0)" ::: "memory");
}

template <int K> __device__ __forceinline__ f32x4 mma_lds(f32x4 acc, const LAS bf16* A, int pa, const LAS bf16* B, int pb, int lane) {
    const int r = lane & 15, q = lane >> 4;
#pragma unroll
    for (int ks = 0; ks < K / 32; ++ks) {
        const bf16x8 a = *(const LAS bf16x8*)(A + r * pa + ks * 32 + q * 8);
        const bf16x8 b = *(const LAS bf16x8*)(B + r * pb + ks * 32 + q * 8);
        acc = __builtin_amdgcn_mfma_f32_16x16x32_bf16(a, b, acc, 0, 0, 0);
    }
    return acc;
}

constexpr int HP_QT = 0, HP_KTT = 17408, HP_AM = 35840, HP_ER = 45056, HP_EE = 45568, HP_BLK = 49152;
constexpr int HP_KT = 49152, HP_SEG = 66560;
constexpr int HS_VT = 49152, HS_ST = 53760, HS_BUF = 62464;
__device__ __forceinline__ void hg_prep_items(LAS unsigned char* lds, const bf16* PA, unsigned char* SCR, const float* lb_logits, int layer, int item0, int istride, int nitems, int T, int tid) {
    const int lane = tid & 63, wave = __builtin_amdgcn_readfirstlane(tid >> 6), c16 = lane & 15, quad = lane >> 4;
    const int nchunk = T / 64;
    const int kp = tid & 63, ts = tid >> 6;
    LAS bf16* QT = (LAS bf16*)(lds + HP_QT); LAS bf16* KT = (LAS bf16*)(lds + HP_KT); LAS bf16* KTT = (LAS bf16*)(lds + HP_KTT); LAS bf16* AM = (LAS bf16*)(lds + HP_AM);
    LAS float* SEG = (LAS float*)(lds + HP_SEG); LAS float* ER = (LAS float*)(lds + HP_ER); LAS float* EE = (LAS float*)(lds + HP_EE);
    unsigned zz[8], qq[8];
#define HP_LOAD(it) do { const int it_ = min((it), nitems - 1); const int c_ = it_ % nchunk, sd_ = it_ / nchunk, dir_ = sd_ & 1, h_ = (sd_ >> 1) & 3, base_ = (sd_ >> 3) * T; \
        const bf16* zs = PA + (dir_ ? C_HZB : C_HZF) + h_ * 128 + 2 * kp; const bf16* qs = PA + C_HQ + h_ * 128 + 2 * kp; \
        _Pragma("unroll") for (int i = 0; i < 8; ++i) { const int tau = c_ * 64 + 8 * ts + i; const size_t ro = (size_t)(base_ + (dir_ ? (T - 1 - tau) : tau)) * PA_LD; zz[i] = *(const unsigned*)(zs + ro); qq[i] = *(const unsigned*)(qs + ro); } } while (0)
    HP_LOAD(item0);
    for (int item = item0; item < nitems; item += istride) {
        const int sd = item / nchunk, dir = sd & 1, h = (sd >> 1) & 3;
        float lb[2];
#pragma unroll
        for (int j = 0; j < 2; ++j) { float lg[4], mx = -3e38f;
#pragma unroll
          for (int l = 0; l < 4; ++l) { lg[l] = lb_logits[(dir * 4 + l) * 512 + h * 128 + 2 * kp + j]; mx = fmaxf(mx, lg[l]); }
          float tot = 0.f, num = 0.f;
#pragma unroll
          for (int l = 0; l < 4; ++l) { const float e = __expf(lg[l] - mx); tot += e; if (l >= 1 && l <= layer) num += e; }
          lb[j] = num / tot; }
        float b[2][8], kv[2][8], qv[2][8]; float cum[2] = {0.f, 0.f};
#pragma unroll
        for (int i = 0; i < 8; ++i)
#pragma unroll
            for (int j = 0; j < 2; ++j) { const float zf = j ? bfhi(zz[i]) : bflo(zz[i]); const float sg = sigm(zf); const float oml = 1.0f - lb[j]; const float f = lb[j] + oml * sg;
                cum[j] += __logf(fmaxf(f, 1e-30f)); b[j][i] = cum[j]; kv[j][i] = oml * (1.0f - sg); qv[j][i] = j ? bfhi(qq[i]) : bflo(qq[i]); }
        HP_LOAD(item + istride);
        SEG[ts * 128 + 2 * kp] = cum[0]; SEG[ts * 128 + 2 * kp + 1] = cum[1];
        __syncthreads();
        float pre[2], r[2], bend[2];
#pragma unroll
        for (int j = 0; j < 2; ++j) { float p = 0.f, rr = 0.f, be = 0.f;
#pragma unroll
            for (int q = 0; q < 8; ++q) { const float v = SEG[q * 128 + 2 * kp + j]; if (q < ts) p += v; if (q < 4) rr += v; be += v; }
            pre[j] = p; r[j] = rr; bend[j] = be; }
        unsigned kpk[2][4];
#pragma unroll
        for (int i = 0; i < 8; ++i) {
            unsigned qb[2], kb[2];
#pragma unroll
            for (int j = 0; j < 2; ++j) { const float bt = pre[j] + b[j][i];
                const float eq = __expf(fminf(bt - r[j], 80.f)), ek = __expf(fminf(r[j] - bt, 80.f));
                qb[j] = f2bf(qv[j][i] * eq); kb[j] = f2bf(kv[j][i] * ek);
                if (i & 1) kpk[j][i >> 1] |= kb[j] << 16; else kpk[j][i >> 1] = kb[j]; }
            const int tau = 8 * ts + i;
            *(LAS unsigned*)(QT + tau * 136 + 2 * kp) = qb[0] | (qb[1] << 16);
            *(LAS unsigned*)(KT + tau * 136 + 2 * kp) = kb[0] | (kb[1] << 16);
        }
#pragma unroll
        for (int j = 0; j < 2; ++j) *(LAS v4u*)(KTT + (2 * kp + j) * 72 + 8 * ts) = (v4u){kpk[j][0], kpk[j][1], kpk[j][2], kpk[j][3]};
        if (ts == 0) {
#pragma unroll
            for (int j = 0; j < 2; ++j) { ER[2 * kp + j] = __expf(r[j]); EE[2 * kp + j] = __expf(bend[j] - r[j]); } }
        __syncthreads();
#pragma unroll
        for (int e = 0; e < 2; ++e) { const int id = wave * 2 + e, tt = id >> 2, st = id & 3;
            f32x4 a = (f32x4){0.f, 0.f, 0.f, 0.f};
            if (st <= tt) a = mma_lds<128>(a, QT + tt * 16 * 136, 136, KT + st * 16 * 136, 136, lane);
#pragma unroll
            for (int i = 0; i < 4; ++i) { const int t = tt * 16 + quad * 4 + i, s = st * 16 + c16; const float val = (st <= tt && s <= t) ? a[i] : 0.f; AM[t * 72 + s] = (bf16)f2bf(val); } }
        __syncthreads();
        unsigned char* dst = SCR + (size_t)item * HP_BLK;
#pragma unroll
        for (int j = 0; j < 6; ++j) { const int idx = tid + 512 * j; *(v4u*)(dst + (size_t)idx * 16) = *(const LAS v4u*)(lds + idx * 16); }
        __syncthreads();
    }
#undef HP_LOAD
}

template <int NVT> __device__ __forceinline__ void hg_scan_item(LAS unsigned char* lds, bf16* PA, const unsigned char* SCR, int item, int T, int tid) {
    constexpr int NVS = 8 / NVT, VW = 16 * NVT, VTHR = 128 * NVT, VSH = (NVT == 2) ? 2 : 1;
    const int lane = tid & 63, wave = __builtin_amdgcn_readfirstlane(tid >> 6), c16 = lane & 15, quad = lane >> 4;
    const int vs = item % NVS, sd = item / NVS, dir = sd & 1, h = (sd >> 1) & 3, seq = sd >> 3;
    const int base = seq * T, nchunk = T / 64;
    const unsigned char* blk = SCR + (size_t)sd * nchunk * HP_BLK;
    const bf16* vsrc = PA + C_HI + h * 128 + vs * VW + (tid & (VW / 8 - 1)) * 8;
    bf16* odst = PA + (dir ? C_HZF : C_HQ) + h * 128 + vs * VW;
    v4u preA[6], preB[6]; v4u vrA = {0u, 0u, 0u, 0u}, vrB = vrA; f32x4 ervA, eevA, ervB, eevB;
#define HG_ROW(tau) (base + (dir ? (T - 1 - (tau)) : (tau)))
#define HS_LOAD(c, pre, vr, erv, eev) do { const int c_ = min((c), nchunk - 1); const unsigned char* bp = blk + (size_t)c_ * HP_BLK;     \
        _Pragma("unroll") for (int j = 0; j < 6; ++j) pre[j] = *(const v4u*)(bp + (size_t)(tid + 512 * j) * 16); \
        erv = *(const f32x4*)(bp + HP_ER + (wave * 16 + quad * 4) * 4); eev = *(const f32x4*)(blk + (size_t)max(c_ - 1, 0) * HP_BLK + HP_EE + (wave * 16 + quad * 4) * 4);     \
        vr = *(const v4u*)(vsrc + (size_t)HG_ROW(c_ * 64 + ((tid & (VTHR - 1)) >> VSH)) * PA_LD); } while (0)
    HS_LOAD(0, preA, vrA, ervA, eevA);
    HS_LOAD(1, preB, vrB, ervB, eevB);
    f32x4 accS[NVT];
#pragma unroll
    for (int e = 0; e < NVT; ++e) accS[e] = (f32x4){0.f, 0.f, 0.f, 0.f};
#define HS_STEP(c, BUFI, pre, vr, erv, eev) do { \
        LAS unsigned char* B = lds + (BUFI) * HS_BUF; \
        LAS bf16* QT = (LAS bf16*)(B + HP_QT); LAS bf16* KTT = (LAS bf16*)(B + HP_KTT); LAS bf16* AM = (LAS bf16*)(B + HP_AM); \
        LAS bf16* VT = (LAS bf16*)(B + HS_VT); LAS bf16* STt = (LAS bf16*)(B + HS_ST); \
        _Pragma("unroll") for (int j = 0; j < 6; ++j) *(LAS v4u*)(B + (tid + 512 * j) * 16) = pre[j]; \
        if (tid < VTHR) { const int s_ = tid >> VSH, vq = tid & (VW / 8 - 1); \
            VT[(vq * 8 + 0) * 72 + s_] = (bf16)(vr.x & 0xffffu); VT[(vq * 8 + 1) * 72 + s_] = (bf16)(vr.x >> 16); \
            VT[(vq * 8 + 2) * 72 + s_] = (bf16)(vr.y & 0xffffu); VT[(vq * 8 + 3) * 72 + s_] = (bf16)(vr.y >> 16); \
            VT[(vq * 8 + 4) * 72 + s_] = (bf16)(vr.z & 0xffffu); VT[(vq * 8 + 5) * 72 + s_] = (bf16)(vr.z >> 16); \
            VT[(vq * 8 + 6) * 72 + s_] = (bf16)(vr.w & 0xffffu); VT[(vq * 8 + 7) * 72 + s_] = (bf16)(vr.w >> 16); } \
        f32x4 sp[NVT]; const f32x4 sc_ = erv * eev;     \
        _Pragma("unroll") for (int e = 0; e < NVT; ++e) { sp[e] = accS[e] * sc_; v2u w; w.x = cvt_pk_bf16(sp[e][0], sp[e][1]); w.y = cvt_pk_bf16(sp[e][2], sp[e][3]); \
            *(LAS v2u*)(STt + (e * 16 + c16) * 136 + wave * 16 + quad * 4) = w; } \
        HS_LOAD((c) + 2, pre, vr, erv, eev); \
        __syncthreads(); \
        if ((wave >> 2) < NVT) { const int tt = wave & 3, vt = wave >> 2; f32x4 o = (f32x4){0.f, 0.f, 0.f, 0.f}; \
          o = mma_lds<128>(o, QT + tt * 16 * 136, 136, STt + vt * 16 * 136, 136, lane); \
          o = mma_lds<64>(o, AM + tt * 16 * 72, 72, VT + vt * 16 * 72, 72, lane); \
          _Pragma("unroll") for (int i = 0; i < 4; ++i) { const int tau = (c) * 64 + tt * 16 + quad * 4 + i; odst[(size_t)HG_ROW(tau) * PA_LD + vt * 16 + c16] = (bf16)f2bf(o[i]); } } \
        _Pragma("unroll") for (int e = 0; e < NVT; ++e) { accS[e] = mma_lds<64>(sp[e], KTT + wave * 16 * 72, 72, VT + e * 16 * 72, 72, lane); } \
    } while (0)
    for (int c = 0; c < nchunk; c += 2) {
        HS_STEP(c, 0, preA, vrA, ervA, eevA);
        HS_STEP(c + 1, 1, preB, vrB, ervB, eevB);
    }
    __syncthreads();
#undef HG_ROW
#undef HS_LOAD
#undef HS_STEP
}

__device__ __forceinline__ void na_item(LAS unsigned char* lds, const bf16* PA, const float* rpb, bf16* ONA, int item, int T, int tid) {
    const int lane = tid & 63, h = __builtin_amdgcn_readfirstlane(tid >> 6), c16 = lane & 15, quad = lane >> 4;
    const int ips = T / 16, seq = item / ips, rem = item % ips, r = rem >> 2, j = rem & 3;
    const int rows = T / 64, rs = min(max(r - 4, 0), rows - 8), kstart = (j == 0) ? 0 : (j == 1) ? 8 : (j == 2) ? 24 : 32;
    const int base = seq * T, qtok = base + r * 64 + 16 * j + c16;
    const bf16* qp = PA + (size_t)qtok * PA_LD + C_NQ + h * 64 + quad * 8;
    const bf16x8 Qb0 = *(const bf16x8*)qp, Qb1 = *(const bf16x8*)(qp + 32);
    const int qcol = 16 * j + c16, cs = min(max(qcol - 8, 0), 48);
    v4u vbufA[8], vbufB[8], vbufC[8], vbufD[8];
#define NA_VLOAD(qd, vbuf) do { _Pragma("unroll") for (int it = 0; it < 8; ++it) { const int idx = it * 64 + lane, key = idx >> 3, dg = idx & 7; \
        const int tok = base + (rs + 2 * (qd) + (key >> 5)) * 64 + kstart + (key & 31); vbuf[it] = *(const v4u*)(PA + (size_t)tok * PA_LD + C_NV + h * 64 + dg * 8); } } while (0)
    NA_VLOAD(0, vbufA); NA_VLOAD(1, vbufB);
    const float* rp = rpb + h * 465;
    f32x4 sacc[16]; float mx = -3e38f;
    int dcv[8]; bool okv[8];
#pragma unroll
    for (int e = 0; e < 8; ++e) { const int kcol = kstart + (e >> 2) * 16 + quad * 4 + (e & 3); okv[e] = (kcol >= cs) && (kcol < cs + 16); dcv[e] = min(max(kcol - qcol + 15, 0), 30); }
#pragma unroll
    for (int a = 0; a < 8; ++a) {
        const float rowv = rp[(rs + a - r + 7) * 31 + min(lane, 30)];
        float bv[8];
#pragma unroll
        for (int e = 0; e < 8; ++e) bv[e] = __builtin_bit_cast(float, __builtin_amdgcn_ds_bpermute(dcv[e] << 2, __builtin_bit_cast(int, rowv)));
#pragma unroll
        for (int hh = 0; hh < 2; ++hh) {
            const int ktok = base + (rs + a) * 64 + kstart + hh * 16 + c16;
            const bf16* kp = PA + (size_t)ktok * PA_LD + C_NK + h * 64 + quad * 8;
            const bf16x8 Ka0 = *(const bf16x8*)kp, Ka1 = *(const bf16x8*)(kp + 32);
            f32x4 s = (f32x4){0.f, 0.f, 0.f, 0.f};
            s = __builtin_amdgcn_mfma_f32_16x16x32_bf16(Ka0, Qb0, s, 0, 0, 0);
            s = __builtin_amdgcn_mfma_f32_16x16x32_bf16(Ka1, Qb1, s, 0, 0, 0);
#pragma unroll
            for (int i = 0; i < 4; ++i) { const float val = okv[hh * 4 + i] ? s[i] * 0.125f + bv[hh * 4 + i] : -1e30f; s[i] = val; mx = fmaxf(mx, val); }
            sacc[a * 2 + hh] = s;
        }
    }
    NA_VLOAD(2, vbufC); NA_VLOAD(3, vbufD);
    mx = fmaxf(mx, __shfl_xor(mx, 16)); mx = fmaxf(mx, __shfl_xor(mx, 32));
    float sum = 0.f;
#pragma unroll
    for (int t = 0; t < 16; ++t)
#pragma unroll
        for (int i = 0; i < 4; ++i) { const float p = __expf(sacc[t][i] - mx); sacc[t][i] = p; sum += p; }
    sum += __shfl_xor(sum, 16); sum += __shfl_xor(sum, 32);
    bf16x8 pb[8];
#pragma unroll
    for (int a = 0; a < 8; ++a) { v4u w; w.x = cvt_pk_bf16(sacc[2 * a][0], sacc[2 * a][1]); w.y = cvt_pk_bf16(sacc[2 * a][2], sacc[2 * a][3]);
        w.z = cvt_pk_bf16(sacc[2 * a + 1][0], sacc[2 * a + 1][1]); w.w = cvt_pk_bf16(sacc[2 * a + 1][2], sacc[2 * a + 1][3]); pb[a] = __builtin_bit_cast(bf16x8, w); }
    LAS bf16* VS = (LAS bf16*)(lds + h * 10240);
    f32x4 oacc[4];
#pragma unroll
    for (int dt = 0; dt < 4; ++dt) oacc[dt] = (f32x4){0.f, 0.f, 0.f, 0.f};
    const int trq = (lane & 15) >> 2, trp = lane & 3;
    const LAS bf16* trbase = VS + (quad * 4 + trq) * 80 + 4 * trp;
#define NA_PV(qd, vbuf) do { \
        _Pragma("unroll") for (int it = 0; it < 8; ++it) { const int idx = it * 64 + lane, key = idx >> 3, dg = idx & 7; *(LAS v4u*)(VS + key * 80 + dg * 8) = vbuf[it]; } \
        _Pragma("unroll") for (int al = 0; al < 2; ++al) \
            _Pragma("unroll") for (int dt = 0; dt < 4; ++dt) { const LAS bf16* p = trbase + al * 32 * 80 + dt * 16; \
                const v4i16_t lo = __builtin_amdgcn_ds_read_tr16_b64_v4i16((LAS v4i16_t*)p), hi = __builtin_amdgcn_ds_read_tr16_b64_v4i16((LAS v4i16_t*)(p + 16 * 80)); \
                const bf16x8 af = {lo[0], lo[1], lo[2], lo[3], hi[0], hi[1], hi[2], hi[3]}; \
                oacc[dt] = __builtin_amdgcn_mfma_f32_16x16x32_bf16(af, pb[(qd) * 2 + al], oacc[dt], 0, 0, 0); } } while (0)
    NA_PV(0, vbufA); NA_PV(1, vbufB); NA_PV(2, vbufC); NA_PV(3, vbufD);
#undef NA_PV
#undef NA_VLOAD
    const float inv = __builtin_amdgcn_rcpf(sum);
#pragma unroll
    for (int dt = 0; dt < 4; ++dt) { const f32x4 o = oacc[dt] * inv; v2u w; w.x = cvt_pk_bf16(o[0], o[1]); w.y = cvt_pk_bf16(o[2], o[3]);
        *(v2u*)(ONA + (size_t)qtok * 512 + h * 64 + dt * 16 + quad * 4) = w; }
}

#define XB_TMO      128
#define XB_XCNT(j)  (256  + 64 * (j))
#define XB_XSUB(j)  (1280 + 64 * (j))
#define XB_XGEN(j)  (2304 + 64 * (j))
#define XB_TOP      3328
#define XB_TOPGEN   3392
#define XCD_BAR_WORDS 3456
#define XB_SPIN_CAP (1u << 18)

__device__ __forceinline__ unsigned xb_ld(unsigned* p)              { return __hip_atomic_load(p, __ATOMIC_RELAXED, __HIP_MEMORY_SCOPE_AGENT); }
__device__ __forceinline__ unsigned xb_add(unsigned* p, unsigned v) { return __hip_atomic_fetch_add(p, v, __ATOMIC_RELAXED, __HIP_MEMORY_SCOPE_AGENT); }
__device__ __forceinline__ unsigned xb_xcc_id() { return (unsigned)__builtin_amdgcn_s_getreg((3 << 11) | 20) & 0xFu; }
#define XB_SPIN(cond, bar) do { unsigned _sp = 0; while (cond) { __builtin_amdgcn_s_sleep(1); \
    if ((++_sp & 255u) == 0u) { if (xb_ld(&(bar)[XB_TMO])) break; if (_sp > XB_SPIN_CAP) { atomicAdd(&(bar)[XB_TMO], 1u); break; } } } } while (0)

struct XcdBarrier {
    unsigned* bar; unsigned x;
    volatile LAS unsigned* st;
};

__device__ __forceinline__ XcdBarrier xcd_barrier_post(unsigned* bar, volatile LAS unsigned* st) {
    XcdBarrier b; b.bar = bar; b.x = xb_xcc_id(); b.st = st;
    if (threadIdx.x == 0) (void)xb_add(&bar[XB_XCNT(b.x)], 1u);
    return b;
}
__device__ __forceinline__ void xcd_barrier_complete(unsigned* bar, unsigned x, unsigned& nloc, unsigned& nx) {
    const unsigned G = gridDim.x * gridDim.y * gridDim.z;
    unsigned sum, cnt, mine, sp = 0u;
    for (;;) {
        sum = 0u; cnt = 0u; mine = 0u;
#pragma unroll
        for (unsigned j = 0; j < 16; ++j) { const unsigned c = xb_ld(&bar[XB_XCNT(j)]); sum += c; cnt += (c > 0u) ? 1u : 0u; mine = (j == x) ? c : mine; }
        if (sum == G) break;
        __builtin_amdgcn_s_sleep(1);
        if ((++sp & 255u) == 0u) { if (xb_ld(&bar[XB_TMO])) break; if (sp > XB_SPIN_CAP) { atomicAdd(&bar[XB_TMO], 1u); break; } }
    }
    nloc = mine > 0u ? mine : 1u; nx = cnt > 0u ? cnt : 1u;
}

__device__ __forceinline__ void xcd_barrier(const XcdBarrier& b) {
    asm volatile("s_waitcnt vmcnt(0)" ::: "memory");
    __syncthreads();
    if (threadIdx.x == 0) {
        unsigned* bar = b.bar;
        __builtin_amdgcn_s_waitcnt(0);
        unsigned nloc = b.st[0], nx = b.st[1];
        if (nloc == 0u) { xcd_barrier_complete(bar, b.x, nloc, nx); b.st[0] = nloc; b.st[1] = nx; }
        const unsigned old = xb_add(&bar[XB_XSUB(b.x)], 1u);
        const unsigned gen = old / nloc;
        if (old + 1u == (gen + 1u) * nloc) {
            __builtin_amdgcn_fence(__ATOMIC_RELEASE, "agent");
            asm volatile("s_waitcnt vmcnt(0)" ::: "memory");
            const unsigned og = xb_add(&bar[XB_TOP], 1u);
            const unsigned tg = og / nx;
            if (og + 1u == (tg + 1u) * nx) xb_add(&bar[XB_TOPGEN], 1u);
            else XB_SPIN(xb_ld(&bar[XB_TOPGEN]) == tg, bar);
            __builtin_amdgcn_fence(__ATOMIC_ACQUIRE, "agent");
            xb_add(&bar[XB_XGEN(b.x)], 1u);
            asm volatile("s_waitcnt vmcnt(0)" ::: "memory");
        } else {
            XB_SPIN(xb_ld(&bar[XB_XGEN(b.x)]) == gen, bar);
            __builtin_amdgcn_fence(__ATOMIC_ACQUIRE, "agent");
            asm volatile("s_waitcnt vmcnt(0)" ::: "memory");
        }
    }
    __syncthreads();
}
struct Args { const float* in[20]; float* out; unsigned char* ws; int ph_lo, ph_hi; };
enum { K_CVT = 0, K_G0, K_UP, K_RES, K_M1, K_M2A, K_M2B, K_M3, K_M4, K_GF };

__global__ void __launch_bounds__(NTHR, 2) mk_fwd(Args args) {
    extern __shared__ __attribute__((aligned(16))) unsigned char lds_raw[];
    LAS unsigned char* lds = (LAS unsigned char*)lds_raw;
    cg::grid_group grid = cg::this_grid();
    const int hi = args.ph_hi;
    { volatile LAS unsigned* st0 = (volatile LAS unsigned*)(lds + LDS_MISC + 32); if (threadIdx.x < 2) st0[threadIdx.x] = 0u; __syncthreads(); }
    XcdBarrier xbar = xcd_barrier_post((unsigned*)(args.ws + WS_CTL) + CW_BAR, (volatile LAS unsigned*)(lds + LDS_MISC + 32));
#if TPROBE
    unsigned long long tacc = 0ull;
#endif
    for (int ph = args.ph_lo; ph < hi; ++ph) {
#if TPROBE
        const unsigned long long tp0 = __builtin_amdgcn_s_memrealtime();
#endif
        int bid = blockIdx.x, G = gridDim.x; asm volatile("" : "+s"(bid), "+s"(G));
        int tid = threadIdx.x; asm volatile("" : "+v"(tid));
        const int lane = tid & 63, wave = __builtin_amdgcn_readfirstlane(tid >> 6);
        const int gw = bid * NWAVES + wave, NGW = G * NWAVES;
        int kind, pr = 0, l = 0, s = 0, g2 = 0;
        if (ph == 0) kind = K_CVT;
        else { const int q = ph - 1; pr = q / PH_PER_PAIR; const int r = q % PH_PER_PAIR;
            if (r == 0) kind = K_G0; else if (r == PH_PER_PAIR - 1) kind = K_GF;
            else { l = (r - 1) / 16; s = (r - 1) % 16;
                if (s == 0 || s == 14) kind = K_UP; else if (s == 1 || s == 15) kind = K_RES;
                else { g2 = (s - 2) / 6; const int t = (s - 2) % 6; kind = (t == 0) ? K_M1 : (t == 1) ? K_M2A : (t == 2) ? K_M2B : (t == 3) ? K_M3 : (t == 4) ? K_M4 : K_RES; } } }
        const bool mix = (s >= 2 && s <= 13);
        unsigned char* ws = args.ws;
        bf16* XBp = (bf16*)(ws + WS_XB); float* SSQp = (float*)(ws + WS_SSQ);
        bf16* XB = XBp + (size_t)g2 * TG * D; float* SSQ = SSQp + (size_t)g2 * TG * 16;
        bf16* PA = (bf16*)(ws + WS_PA); bf16* PG = (bf16*)(ws + WS_PG);
        bf16* ONA = (bf16*)(ws + WS_ONA); bf16* OHG = ONA + (size_t)TG * 512; bf16* OCV = OHG + (size_t)TG * 512;
        unsigned char* SCR = ws + WS_SCR;
        const bf16* Wl = (const bf16*)(ws + WS_W) + (size_t)l * LAYER_EL;
        const int T = pr == 0 ? 2048 : 4096;
        const int g = pr * 2 + g2;
        float* X = args.out + (size_t)pr * 2 * TG * D;

        if (kind == K_CVT) {
            LAS float* scr = (LAS float*)(lds + wave * 16384);
            constexpr int I_GU = 16 * 176, I_DN = 44 * 32, I_IN = 16 * 272, I_MX = 8 * 32, I_OUT = 16 * 32;
            constexpr int I_LAYER = 2 * I_GU + 2 * I_DN + I_IN + 3 * I_MX + I_OUT, I_TOT = NLAYER * I_LAYER;
#define CVT_DECODE(it_) const int ll = (it_) / I_LAYER; int r = (it_) % I_LAYER; \
                const float* src; const float* gain = nullptr; int K, N; size_t off; bool perm = false; \
                if (r < I_GU) { src = args.in[3] + (size_t)ll * D * 2 * FF; K = D; N = 2 * FF; off = OFF_GU1; gain = args.in[2] + ll * D; perm = true; } \
                else if ((r -= I_GU) < I_DN) { src = args.in[4] + (size_t)ll * FF * D; K = FF; N = D; off = OFF_D1; } \
                else if ((r -= I_DN) < I_IN) { src = args.in[6] + (size_t)ll * D * 8704; K = D; N = 8704; off = OFF_IN; gain = args.in[5] + ll * D; } \
                else if ((r -= I_IN) < I_MX) { src = args.in[9] + (size_t)ll * 512 * D; K = 512; N = D; off = OFF_HG; } \
                else if ((r -= I_MX) < I_MX) { src = args.in[12] + (size_t)ll * 512 * D; K = 512; N = D; off = OFF_CV; } \
                else if ((r -= I_MX) < I_MX) { src = args.in[14] + (size_t)ll * 512 * D; K = 512; N = D; off = OFF_NA; } \
                else if ((r -= I_MX) < I_OUT) { src = args.in[15] + (size_t)ll * D * D; K = D; N = D; off = OFF_OUT; } \
                else if ((r -= I_OUT) < I_GU) { src = args.in[17] + (size_t)ll * D * 2 * FF; K = D; N = 2 * FF; off = OFF_GU2; gain = args.in[16] + ll * D; perm = true; } \
                else { r -= I_GU; src = args.in[18] + (size_t)ll * FF * D; K = FF; N = D; off = OFF_D2; } \
                const int nblk = N / 32, kb = r / nblk, nb = r % nblk, k0 = 64 * kb, n0 = 32 * nb;
#define CVT_LOAD(it_, wv) do { CVT_DECODE(min((it_), I_TOT - 1)) (void)off; (void)perm; \
                _Pragma("unroll") for (int i = 0; i < 32; ++i) { const int kk = 2 * i + (lane >> 5); wv[i] = src[(size_t)(k0 + kk) * N + n0 + (lane & 31)] * (gain ? gain[k0 + kk] : 1.0f); } } while (0)
#define CVT_PROC(it_, wv) do { CVT_DECODE(it_) (void)src; (void)gain; \
                _Pragma("unroll") for (int i = 0; i < 32; ++i) { const int kk = 2 * i + (lane >> 5); scr[kk * 33 + (lane & 31)] = wv[i]; } \
                asm volatile("s_waitcnt lgkmcnt(0)" ::: "memory"); \
                int dn0 = n0; if (perm) { const int half = n0 >= FF ? 1 : 0; const int j_ = n0 - half * FF; dn0 = (j_ >> 7) * 256 + half * 128 + (j_ & 127); } \
                bf16* WT = (bf16*)(ws + WS_W) + (size_t)ll * LAYER_EL + off; const int c_ = lane & 7; \
                _Pragma("unroll") for (int j = 0; j < 4; ++j) { const int n = (lane >> 3) + 8 * j; const LAS float* sp_ = scr + (8 * c_) * 33 + n; \
                    v4u o; o.x = cvt_pk_bf16(sp_[0 * 33], sp_[1 * 33]); o.y = cvt_pk_bf16(sp_[2 * 33], sp_[3 * 33]); o.z = cvt_pk_bf16(sp_[4 * 33], sp_[5 * 33]); o.w = cvt_pk_bf16(sp_[6 * 33], sp_[7 * 33]); \
                    *(v4u*)(WT + (size_t)(dn0 + n) * K + k0 + 8 * c_) = o; } \
                asm volatile("s_waitcnt lgkmcnt(0)" ::: "memory"); } while (0)
            float wa[32], wb[32];
            int it = gw;
            CVT_LOAD(it, wa);
            while (it < I_TOT) {
                CVT_LOAD(it + NGW, wb);
                CVT_PROC(it, wa);
                it += NGW;
                CVT_LOAD(it + NGW, wa);
                if (it < I_TOT) CVT_PROC(it, wb);
                it += NGW;
            }
#undef CVT_DECODE
#undef CVT_LOAD
#undef CVT_PROC
        } else if (kind == K_G0) {
            const float* xin = pr == 0 ? args.in[0] : args.in[1];
#define G0_LOAD(rowx_, S) do { const int r_ = min((rowx_), 2 * TG - 1); const f32x4* xr_ = (const f32x4*)(xin + (size_t)r_ * D) + lane; \
                _Pragma("unroll") for (int j = 0; j < 4; ++j) gx##S[j] = xr_[64 * j]; } while (0)
#define G0_PROC(rowx_, S) do { const int rw_ = (rowx_); v2u* bo_ = (v2u*)(XBp + (size_t)rw_ * D) + lane; float ss_ = 0.f; \
                _Pragma("unroll") for (int j = 0; j < 4; ++j) { const f32x4 v = gx##S[j]; v2u w_; w_.x = cvt_pk_bf16(v[0], v[1]); w_.y = cvt_pk_bf16(v[2], v[3]); bo_[64 * j] = w_; ss_ += (v[0] * v[0] + v[1] * v[1]) + (v[2] * v[2] + v[3] * v[3]); } \
                ss_ = wave_sum(ss_); if (lane < 16) SSQp[(size_t)rw_ * 16 + lane] = lane == 0 ? ss_ : 0.f; } while (0)
            f32x4 gxA[4], gxB[4];
            { int rowi = gw;
              G0_LOAD(rowi, A);
              while (rowi < 2 * TG) {
                  G0_LOAD(rowi + NGW, B); G0_PROC(rowi, A); rowi += NGW;
                  G0_LOAD(rowi + NGW, A); if (rowi < 2 * TG) G0_PROC(rowi, B); rowi += NGW;
              } }
#undef G0_LOAD
#undef G0_PROC
        } else if (kind == K_UP) {
            pg8::Gemm gm{XBp, Wl + (s == 14 ? OFF_GU2 : OFF_GU1), 2 * TG, 2 * FF, D}; pg8::StaticOrder S; S.init(2 * TG, 2 * FF, G, bid);
            LAS float* rst = (LAS float*)(lds + 131072); LAS int* pml = (LAS int*)(lds + 131072 + 12288);
            __syncthreads();
            if (tid == 0) { int n = 0; pg8::Unit uu;
                for (int i = 0; S.next(i, uu); ++i) { bool f = false; for (int q = 0; q < n; ++q) f = f || (pml[q] == uu.pm); if (!f && n < 12) pml[n++] = uu.pm; }
                pml[15] = n; }
            __syncthreads();
            { const int n = pml[15];
              for (int idx = tid; idx < n * 256; idx += NTHR) { const int row = pml[idx >> 8] * 256 + (idx & 255); rst[idx] = pg8::row_rs(SSQp, row); } }
            __syncthreads();
            pg8::EpiSwiGLU E{PA, rst, pml, SSQp};
#ifndef NO_UP
            for (int rep = 0; rep < REP_GEMM; ++rep) pg8::gemm_phase<pg8::EpiSwiGLU, pg8::StaticOrder, PGA, PGS>(lds, gm, S, E);
#endif
        } else if (kind == K_RES) {
            const int K = mix ? D : FF, Mr = mix ? TG : 2 * TG; const size_t off = mix ? OFF_OUT : (s == 1 ? OFF_D1 : OFF_D2);
            pg8::Gemm gm{PA, Wl + off, Mr, D, K}; pg8::StaticOrder S; S.init(Mr, D, G, bid);
            pg8::EpiRes E{mix ? XB : XBp, mix ? SSQ : SSQp, mix ? 1.0f : 0.5f};
#ifndef NO_RES
            for (int rep = 0; rep < REP_RES; ++rep) { if (rep + 1 < REP_RES) { pg8::EpiRes E0 = E; E0.alpha = 0.f; pg8::gemm_phase<pg8::EpiRes, pg8::StaticOrder, PGA, PGS>(lds, gm, S, E0); }
                else pg8::gemm_phase<pg8::EpiRes, pg8::StaticOrder, PGA, PGS>(lds, gm, S, E); }
#endif
        } else if (kind == K_M1) {
            pg8::Gemm gm{XBp, Wl + OFF_IN, 2 * TG, 8704, D}; pg8::M1Order S; S.init(G, bid, g2);
            LAS float* rst = (LAS float*)(lds + 131072); LAS int* pml = (LAS int*)(lds + 131072 + 12288);
            __syncthreads();
            if (tid == 0) { int n = 0; pg8::Unit uu;
                for (int i = 0; S.next(i, uu); ++i) { bool f = false; for (int q = 0; q < n; ++q) f = f || (pml[q] == uu.pm); if (!f && n < 12) pml[n++] = uu.pm; }
                pml[15] = n; }
            __syncthreads();
            { const int n = pml[15];
              for (int idx = tid; idx < n * 256; idx += NTHR) { const int row = pml[idx >> 8] * 256 + (idx & 255); rst[idx] = pg8::row_rs(SSQp, row); } }
            __syncthreads();
            pg8::EpiProj E{PA, (unsigned char*)PG, (unsigned char*)PG + (size_t)TG * 3072, rst, pml, SSQp};
#ifndef NO_PROJ
            for (int rep = 0; rep < REP_GEMM; ++rep) pg8::gemm_phase<pg8::EpiProj, pg8::M1Order, PGA, PGS>(lds, gm, S, E);
#endif
        } else if (kind == K_M2A) {
#ifndef NO_HG
            { const int nP = (TG / 64) * 8;
              if (G == 256) { const int vcu1 = (bid % 8) * 32 + bid / 8; for (int rep = 0; rep < REP_HG; ++rep) hg_prep_items(lds, PA, SCR, args.in[7], l, vcu1 * (nP / 256), 1, (vcu1 + 1) * (nP / 256), T, tid); }
              else { for (int rep = 0; rep < REP_HG; ++rep) if (bid < nP) hg_prep_items(lds, PA, SCR, args.in[7], l, bid, G, nP, T, tid); } }
#endif
            const float* rpb = args.in[13] + (size_t)l * 8 * 465;
            const int vcu = (G % 8 == 0) ? (bid % 8) * (G / 8) + bid / 8 : bid;
            const int nNA = TG / 16, ipb = (nNA + G - 1) / G;
            for (int rep = 0; rep < REP_NA; ++rep)
                for (int q = 0; q < ipb; ++q) { const int it = vcu * ipb + q; if (it < nNA) {
#ifndef NO_NA
                    na_item(lds, PA, rpb, ONA, it, T, tid);
#endif
                    __syncthreads(); } }
        } else if (kind == K_M2B) {
#ifndef NO_HG
            const int vcu2 = (G % 8 == 0) ? (bid % 8) * (G / 8) + bid / 8 : bid;
            for (int rep = 0; rep < REP_HG; ++rep) {
                if (pr == 0) { for (int it = vcu2; it < 256; it += G) hg_scan_item<2>(lds, PA, SCR, it, T, tid); }
                else       { for (int it = vcu2; it < 256; it += G) hg_scan_item<1>(lds, PA, SCR, it, T, tid); }
            }
#endif
        } else if (kind == K_M3) {
            const float* gno = args.in[8] + l * 512; const float* cw = args.in[10] + l * 3 * 512; const float* cbias = args.in[11] + l * 512;
            const int c0 = lane * 8;
            const bf16* __restrict__ PAr = PA; bf16* __restrict__ OHGr = OHG; bf16* __restrict__ OCVr = OCV;
            const f32x4 gn0 = *(const f32x4*)(gno + c0), gn1 = *(const f32x4*)(gno + c0 + 4);
            const f32x4 w00 = *(const f32x4*)(cw + c0), w01 = *(const f32x4*)(cw + c0 + 4), w10 = *(const f32x4*)(cw + 512 + c0), w11 = *(const f32x4*)(cw + 512 + c0 + 4);
            const f32x4 w20 = *(const f32x4*)(cw + 1024 + c0), w21 = *(const f32x4*)(cw + 1024 + c0 + 4), bs0 = *(const f32x4*)(cbias + c0), bs1 = *(const f32x4*)(cbias + c0 + 4);
#define M3_DECL(S) v4u fw##S, bw##S, hg##S, a1##S, c1##S, bb##S, a0##S, q0##S, a2##S, q2##S
#define M3_LOAD(row_, S) do { const int r_ = min((row_), TG - 1); const bf16* pr_ = PAr + (size_t)r_ * PA_LD + c0; \
                const bf16* pm_ = PAr + (size_t)max(r_ - 1, 0) * PA_LD + c0; const bf16* pp_ = PAr + (size_t)min(r_ + 1, TG - 1) * PA_LD + c0; \
                fw##S = *(const v4u*)(pr_ + C_HQ); bw##S = *(const v4u*)(pr_ + C_HZF); hg##S = *(const v4u*)(pr_ + C_HG); \
                a1##S = *(const v4u*)(pr_ + C_CA); c1##S = *(const v4u*)(pr_ + C_CC); bb##S = *(const v4u*)(pr_ + C_CB); \
                a0##S = *(const v4u*)(pm_ + C_CA); q0##S = *(const v4u*)(pm_ + C_CC); a2##S = *(const v4u*)(pp_ + C_CA); q2##S = *(const v4u*)(pp_ + C_CC); } while (0)
#define M3_MUL8(A, B) {bflo(A.x) * bflo(B.x), bfhi(A.x) * bfhi(B.x), bflo(A.y) * bflo(B.y), bfhi(A.y) * bfhi(B.y), bflo(A.z) * bflo(B.z), bfhi(A.z) * bfhi(B.z), bflo(A.w) * bflo(B.w), bfhi(A.w) * bfhi(B.w)}
#define M3_PROC(row_, S) do { const int rw_ = (row_);     \
                float o[8] = {bflo(fw##S.x) + bflo(bw##S.x), bfhi(fw##S.x) + bfhi(bw##S.x), bflo(fw##S.y) + bflo(bw##S.y), bfhi(fw##S.y) + bfhi(bw##S.y), bflo(fw##S.z) + bflo(bw##S.z), bfhi(fw##S.z) + bfhi(bw##S.z), bflo(fw##S.w) + bflo(bw##S.w), bfhi(fw##S.w) + bfhi(bw##S.w)}; \
                float ss = 0.f; \
                _Pragma("unroll") for (int e = 0; e < 8; ++e) ss += o[e] * o[e]; \
                ss += __shfl_xor(ss, 1); ss += __shfl_xor(ss, 2); ss += __shfl_xor(ss, 4); ss += __shfl_xor(ss, 8); \
                const float rs = __builtin_amdgcn_rsqf(ss * (1.0f / 128.0f) + 1e-6f); \
                const float hgv[8] = {bflo(hg##S.x), bfhi(hg##S.x), bflo(hg##S.y), bfhi(hg##S.y), bflo(hg##S.z), bfhi(hg##S.z), bflo(hg##S.w), bfhi(hg##S.w)}; \
                const float gn[8] = {gn0[0], gn0[1], gn0[2], gn0[3], gn1[0], gn1[1], gn1[2], gn1[3]}; \
                float r8[8]; \
                _Pragma("unroll") for (int e = 0; e < 8; ++e) r8[e] = o[e] * rs * gn[e] * (hgv[e] * sigm(hgv[e])); \
                v4u wo; wo.x = cvt_pk_bf16(r8[0], r8[1]); wo.y = cvt_pk_bf16(r8[2], r8[3]); wo.z = cvt_pk_bf16(r8[4], r8[5]); wo.w = cvt_pk_bf16(r8[6], r8[7]); \
                *(v4u*)(OHGr + (size_t)rw_ * 512 + c0) = wo; \
                const int tl = rw_ & (T - 1); const float m0 = tl > 0 ? 1.f : 0.f, m2 = tl < T - 1 ? 1.f : 0.f; \
                const float zm[8] = M3_MUL8(a0##S, q0##S); const float zc[8] = M3_MUL8(a1##S, c1##S); const float zp[8] = M3_MUL8(a2##S, q2##S); \
                const float cbv[8] = {bflo(bb##S.x), bfhi(bb##S.x), bflo(bb##S.y), bfhi(bb##S.y), bflo(bb##S.z), bfhi(bb##S.z), bflo(bb##S.w), bfhi(bb##S.w)}; \
                _Pragma("unroll") for (int e = 0; e < 4; ++e) { r8[e] = cbv[e] * (w00[e] * (m0 * zm[e]) + w10[e] * zc[e] + w20[e] * (m2 * zp[e]) + bs0[e]); \
                    r8[4 + e] = cbv[4 + e] * (w01[e] * (m0 * zm[4 + e]) + w11[e] * zc[4 + e] + w21[e] * (m2 * zp[4 + e]) + bs1[e]); } \
                wo.x = cvt_pk_bf16(r8[0], r8[1]); wo.y = cvt_pk_bf16(r8[2], r8[3]); wo.z = cvt_pk_bf16(r8[4], r8[5]); wo.w = cvt_pk_bf16(r8[6], r8[7]); \
                *(v4u*)(OCVr + (size_t)rw_ * 512 + c0) = wo; } while (0)
            M3_DECL(A); M3_DECL(B);
            { int row = gw;
              M3_LOAD(row, A);
              while (row < TG) {
                  M3_LOAD(row + NGW, B);
                  M3_PROC(row, A);
                  row += NGW;
                  M3_LOAD(row + NGW, A);
                  if (row < TG) M3_PROC(row, B);
                  row += NGW;
              } }
#undef M3_DECL
#undef M3_LOAD
#undef M3_MUL8
#undef M3_PROC
        } else if (kind == K_M4) {
            pg8::Gemm gm{ONA, Wl + OFF_HG, 3 * TG, 3 * D, 512}; pg8::MergeOrder S; S.init(TG, D, G, bid);
            pg8::EpiMerge E{(const unsigned char*)PG + (size_t)g2 * TG * 3072, PA};
#ifndef NO_MERGE
            for (int rep = 0; rep < REP_MERGE; ++rep) pg8::gemm_phase<pg8::EpiMerge, pg8::MergeOrder, PGA, PGS>(lds, gm, S, E);
#endif
        } else {
            const f32x4* fgp = (const f32x4*)args.in[19] + lane;
            const f32x4 fg0 = fgp[0], fg1 = fgp[64], fg2 = fgp[128], fg3 = fgp[192];
#define GF_LOAD(rowx_, S) do { const int r_ = min((rowx_), 2 * TG - 1); const v2u* bi_ = (const v2u*)(XBp + (size_t)r_ * D) + lane; const f32x4* sq_ = (const f32x4*)(SSQp + (size_t)r_ * 16); \
                _Pragma("unroll") for (int j = 0; j < 4; ++j) { fb##S[j] = bi_[64 * j]; fs##S[j] = sq_[j]; } } while (0)
#define GF_PROC(rowx_, S) do { const int rw_ = (rowx_); float t_ = 0.f; \
                _Pragma("unroll") for (int j = 0; j < 4; ++j) t_ += (fs##S[j][0] + fs##S[j][1]) + (fs##S[j][2] + fs##S[j][3]); \
                const float rs_ = __builtin_amdgcn_rsqf(t_ * (1.0f / 1024.0f) + 1e-6f); f32x4* xo_ = (f32x4*)(X + (size_t)rw_ * D) + lane; \
                { const v2u w_ = fb##S[0]; const f32x4 v = {bflo(w_.x), bfhi(w_.x), bflo(w_.y), bfhi(w_.y)}; xo_[0] = v * fg0 * rs_; } \
                { const v2u w_ = fb##S[1]; const f32x4 v = {bflo(w_.x), bfhi(w_.x), bflo(w_.y), bfhi(w_.y)}; xo_[64] = v * fg1 * rs_; } \
                { const v2u w_ = fb##S[2]; const f32x4 v = {bflo(w_.x), bfhi(w_.x), bflo(w_.y), bfhi(w_.y)}; xo_[128] = v * fg2 * rs_; } \
                { const v2u w_ = fb##S[3]; const f32x4 v = {bflo(w_.x), bfhi(w_.x), bflo(w_.y), bfhi(w_.y)}; xo_[192] = v * fg3 * rs_; } } while (0)
            v2u fbA[4], fbB[4]; f32x4 fsA[4], fsB[4];
            { int rowi = gw;
              GF_LOAD(rowi, A);
              while (rowi < 2 * TG) {
                  GF_LOAD(rowi + NGW, B); GF_PROC(rowi, A); rowi += NGW;
                  GF_LOAD(rowi + NGW, A); if (rowi < 2 * TG) GF_PROC(rowi, B); rowi += NGW;
              } }
#undef GF_LOAD
#undef GF_PROC
        }
#if TPROBE
        __syncthreads();
        const unsigned long long tp1 = __builtin_amdgcn_s_memrealtime();
#endif
        if (ph + 1 < hi) { for (int rep = 0; rep < REP_SYNC; ++rep) { if (hi < 0) grid.sync(); else xcd_barrier(xbar);     } }
#if TPROBE
        const unsigned long long tp2 = __builtin_amdgcn_s_memrealtime();
        if (TPROBE == 100) tacc += tp2 - tp1;
        else if (kind == TPROBE - 1) tacc += tp1 - tp0;
#endif
    }
#if TPROBE
    if (blockIdx.x == TPROBE_BLOCK) { const unsigned long long te = __builtin_amdgcn_s_memrealtime(); while (__builtin_amdgcn_s_memrealtime() - te < tacc) __builtin_amdgcn_s_sleep(8); }
#endif
}
constexpr int N_PHASES = 1 + 2 * PH_PER_PAIR;

extern "C" void kernel_launch(void* const* d_in, const int* in_sizes, int n_in, void* d_out, int out_size, void* d_ws, size_t ws_size, hipStream_t stream) {
    static int grid = 0;
    if (grid == 0) {
        if (n_in != 20 || ws_size < WS_END) { fprintf(stderr, "kernel_launch: unexpected n_in %d / ws %zu\n", n_in, ws_size); grid = -1; return; }
        int dev = 0, cus = 0, per_cu = 0;
        hipGetDevice(&dev); hipDeviceGetAttribute(&cus, hipDeviceAttributeMultiprocessorCount, dev);
        hipFuncSetAttribute((const void*)mk_fwd, hipFuncAttributeMaxDynamicSharedMemorySize, LDS_BYTES);
        hipOccupancyMaxActiveBlocksPerMultiprocessor(&per_cu, (const void*)mk_fwd, NTHR, LDS_BYTES);
        if (per_cu < 1) per_cu = 1;
        grid = cus * per_cu;
        (void)hipGetLastError();
    }
    if (grid < 0) return;
    hipMemsetAsync((char*)d_ws + WS_CTL, 0, CTL_BYTES, stream);
    Args a{};
    for (int i = 0; i < 20; ++i) a.in[i] = (const float*)d_in[i];
    a.out = (float*)d_out; a.ws = (unsigned char*)d_ws;
#if ONE_LAUNCH
    a.ph_lo = 0; a.ph_hi = N_PHASES;
    void* kargs[] = {&a};
    hipError_t e = hipLaunchCooperativeKernel((const void*)mk_fwd, dim3(grid), dim3(NTHR), kargs, LDS_BYTES, stream);
    if (e != hipSuccess) fprintf(stderr, "cooperative launch failed: %s (grid %d)\n", hipGetErrorString(e), grid);
#else
    for (int p = 0; p < N_PHASES; ++p) { a.ph_lo = p; a.ph_hi = p + 1; hipLaunchKernelGGL(mk_fwd, dim3(grid), dim3(NTHR), LDS_BYTES, stream, a); }
#endif
}
```

```cpp
#include <hip/hip_runtime.h>
#include <hip/hip_cooperative_groups.h>
#include <cstdio>
#include <cstdint>
namespace cg = cooperative_groups;
#ifndef ONE_LAUNCH
#define ONE_LAUNCH 1
#endif
#ifndef REP_HG
#define REP_HG 1
#endif
#ifndef REP_NA
#define REP_NA 1
#endif
#ifndef REP_SYNC
#define REP_SYNC 1
#endif
#ifndef REP_GEMM
#define REP_GEMM 1
#endif
#ifndef REP_M3
#define REP_M3 1
#endif
#ifndef REP_RES
#define REP_RES 1
#endif
#ifndef REP_MERGE
#define REP_MERGE 1
#endif
#ifndef REP_MISC
#define REP_MISC 1
#endif
#ifndef TPROBE
#define TPROBE 0
#endif
#ifndef TPROBE_BLOCK
#define TPROBE_BLOCK 0
#endif
#ifndef PGA
#define PGA true
#endif
#ifndef PGS
#define PGS true
#endif
#ifndef RS_PROBE
#define RS_PROBE 0
#endif
namespace pg8 {
#define PG8_LAS __attribute__((address_space(3)))
typedef unsigned short bf16_t;
typedef short bf16x8 __attribute__((ext_vector_type(8)));
typedef float f32x4 __attribute__((ext_vector_type(4)));
typedef unsigned u32x4 __attribute__((ext_vector_type(4)));
constexpr int BM = 256, BK = 64, HALF = 128, HTB = HALF * BK * 2  , STAGE_BYTES = 8 * HTB, NXCD = 8, WGM = 8;

__host__ __device__ __forceinline__ int lds_byte(int r, int c) { const int st = (r >> 4) * 2 + (c >> 5), rr = r & 15, cc = c & 31, ob = rr * 64 + cc * 2; return st * 1024 + (ob ^ (((ob >> 9) & 1) << 5)); }
__host__ __device__ __forceinline__ void stage_rc(int b, int& R, int& C) { const int st = b / 1024, sb = b % 1024, swz = sb ^ (((sb >> 9) & 1) << 5); R = (st >> 1) * 16 + swz / 64; C = (st & 1) * 32 + (swz % 64) / 2; }
__host__ __device__ __forceinline__ int perm32(int rho) { const int n = rho >> 4, i = rho & 15; return 8 * (i >> 2) + 4 * n + (i & 3); }

struct Unit { int pm, pn; };
struct Gemm { const bf16_t* A; const bf16_t* Bt; int M, N, K; };

struct StaticOrder {
    int nM, nN, nwg, G, c;
    __host__ __device__ void init(int M, int N, int G_, int c_) { nM = M / BM; nN = N / BM; nwg = nM * nN; G = G_; c = c_; }
    __host__ __device__ bool next(int i, Unit& u) const {
        const long L = (long)i * G + c; if (L >= nwg) return false;
        int wgid = (int)L; { const int q = nwg / NXCD, r = nwg % NXCD, xcd = wgid % NXCD, off = wgid / NXCD; wgid = (xcd < r ? xcd * (q + 1) : r * (q + 1) + (xcd - r) * q) + off; }
        const int nig = WGM * nN, gid = wgid / nig, fm = gid * WGM, gsz = (nM - fm) < WGM ? (nM - fm) : WGM;
        u.pm = fm + ((wgid % nig) % gsz); u.pn = (wgid % nig) / gsz; return true;
    }
    __device__ __forceinline__ void a_ready(const Unit&) const {}
    __device__ __forceinline__ void done(const Unit&) const {}
};

__device__ __forceinline__ unsigned cvt_pk_bf16(float lo, float hi) { unsigned r; asm volatile("v_cvt_pk_bf16_f32 %0, %1, %2" : "=v"(r) : "v"(lo), "v"(hi)); return r; }
__device__ __forceinline__ float row_rs(const float* ssq, int row) {
    const f32x4* p = (const f32x4*)(ssq + (size_t)row * 16);
    const f32x4 a = p[0], b = p[1], c = p[2], d = p[3];
    const float s = (((a[0] + a[1]) + (a[2] + a[3])) + ((b[0] + b[1]) + (b[2] + b[3]))) + (((c[0] + c[1]) + (c[2] + c[3])) + ((d[0] + d[1]) + (d[2] + d[3])));
    return __builtin_amdgcn_rsqf(s * (1.0f / 1024.0f) + 1e-6f);
}
__device__ __forceinline__ void row_rs8_impl(const float* ssq, int row0, float (&rsv)[8]) {
#pragma unroll
    for (int ai = 0; ai < 2; ++ai) {
        f32x4 p[4][4];
#pragma unroll
        for (int m = 0; m < 4; ++m) { const f32x4* q = (const f32x4*)(ssq + (size_t)(row0 + ai * HALF + m * 16) * 16);
#pragma unroll
            for (int j = 0; j < 4; ++j) p[m][j] = q[j]; }
#pragma unroll
        for (int m = 0; m < 4; ++m) { float t = 0.f;
#pragma unroll
            for (int j = 0; j < 4; ++j) t += (p[m][j][0] + p[m][j][1]) + (p[m][j][2] + p[m][j][3]);
            rsv[ai * 4 + m] = __builtin_amdgcn_rsqf(t * (1.0f / 1024.0f) + 1e-6f); }
    }
}
__device__ __forceinline__ void row_rs8(const float* ssq, int row0, float (&rsv)[8]) {
#if RS_PROBE
    { const float* ssq2 = ssq; asm volatile("" : "+s"(ssq2)); float t2[8]; row_rs8_impl(ssq2, row0, t2); row_rs8_impl(ssq, row0, rsv);
#pragma unroll
      for (int i = 0; i < 8; ++i) rsv[i] = 0.5f * (rsv[i] + t2[i]); return; }
#endif
    row_rs8_impl(ssq, row0, rsv);
}
__device__ __forceinline__ void row_rs8_lds(const PG8_LAS float* rst, const PG8_LAS int* pml, const float* ssq, int pm, int wr, int fr, float (&rsv)[8]) {
    const int n = pml[15]; int slot = -1;
#pragma unroll
    for (int s_ = 0; s_ < 12; ++s_) if (s_ < n && pml[s_] == pm) slot = s_;
    if (slot < 0) { row_rs8(ssq, pm * BM + wr * 64 + fr, rsv); return; }
    const PG8_LAS float* t = rst + slot * 256 + wr * 64 + fr;
#pragma unroll
    for (int ai = 0; ai < 2; ++ai)
#pragma unroll
        for (int m = 0; m < 4; ++m) rsv[ai * 4 + m] = t[ai * HALF + m * 16];
}
__device__ __forceinline__ float sigm(float v) { return __builtin_amdgcn_rcpf(1.0f + __expf(-v)); }

struct EpiSwiGLU {
    static constexpr bool PERM = true, AFTER_DRAIN = false, CARRY = false;
    bf16_t* H; const PG8_LAS float* rst; const PG8_LAS int* pml; const float* ssq;
    __device__ __forceinline__ void operator()(const f32x4 (&acc)[2][2][4][2], const Unit& u, int wr, int wc, int fr, int fq) const {
        const int row0 = u.pm * BM + wr * 64 + fr, col0 = u.pn * 128 + wc * 32 + 8 * fq;
        float rsv[8]; row_rs8_lds(rst, pml, ssq, u.pm, wr, fr, rsv);
#pragma unroll
        for (int ai = 0; ai < 2; ++ai)
#pragma unroll
            for (int m = 0; m < 4; ++m) {
                const int row = row0 + ai * HALF + m * 16; const float rs = rsv[ai * 4 + m];
                const float c1 = rs * -1.4426950408889634f, rs2 = rs * rs;
                u32x4 w;
#pragma unroll
                for (int n = 0; n < 2; ++n) {
                    const f32x4 na = acc[ai][0][m][n] * c1, p = acc[ai][0][m][n] * acc[ai][1][m][n]; f32x4 d;
#pragma unroll
                    for (int e = 0; e < 4; ++e) d[e] = __builtin_amdgcn_rcpf(1.0f + __builtin_amdgcn_exp2f(na[e]));
                    const f32x4 h = p * (d * rs2);
                    w[2 * n] = cvt_pk_bf16(h[0], h[1]); w[2 * n + 1] = cvt_pk_bf16(h[2], h[3]);
                }
                *(u32x4*)(H + (size_t)row * 2816 + col0) = w;
            }
    }
};
__device__ __forceinline__ void unpack8(const u32x4 w, f32x4& lo, f32x4& hi) {
    lo[0] = __uint_as_float(w.x << 16); lo[1] = __uint_as_float(w.x & 0xffff0000u); lo[2] = __uint_as_float(w.y << 16); lo[3] = __uint_as_float(w.y & 0xffff0000u);
    hi[0] = __uint_as_float(w.z << 16); hi[1] = __uint_as_float(w.z & 0xffff0000u); hi[2] = __uint_as_float(w.w << 16); hi[3] = __uint_as_float(w.w & 0xffff0000u);
}
struct EpiRes {
    static constexpr bool PERM = true, AFTER_DRAIN = false, CARRY = false;
    bf16_t* XB; float* ssq; float alpha;
    __device__ __forceinline__ void operator()(const f32x4 (&acc)[2][2][4][2], const Unit& u, int wr, int wc, int fr, int fq) const {
        const int row0 = u.pm * BM + wr * 64 + fr, col0 = u.pn * BM + wc * 32 + 8 * fq;
#pragma unroll
        for (int ai = 0; ai < 2; ++ai) {
            u32x4 xin[4][2];
#pragma unroll
            for (int m = 0; m < 4; ++m)
#pragma unroll
                for (int bj = 0; bj < 2; ++bj) xin[m][bj] = *(const u32x4*)(XB + (size_t)(row0 + ai * HALF + m * 16) * 1024 + col0 + bj * HALF);
#pragma unroll
            for (int m = 0; m < 4; ++m) {
                const int row = row0 + ai * HALF + m * 16; float ss = 0.f;
#pragma unroll
                for (int bj = 0; bj < 2; ++bj) {
                    bf16_t* xp = XB + (size_t)row * 1024 + col0 + bj * HALF;
                    f32x4 x0, x1; unpack8(xin[m][bj], x0, x1);
                    x0 = x0 + acc[ai][bj][m][0] * alpha; x1 = x1 + acc[ai][bj][m][1] * alpha;
                    u32x4 w; w.x = cvt_pk_bf16(x0[0], x0[1]); w.y = cvt_pk_bf16(x0[2], x0[3]); w.z = cvt_pk_bf16(x1[0], x1[1]); w.w = cvt_pk_bf16(x1[2], x1[3]);
                    *(u32x4*)xp = w;
                    ss += ((x0[0] * x0[0] + x0[1] * x0[1]) + (x0[2] * x0[2] + x0[3] * x0[3])) + ((x1[0] * x1[0] + x1[1] * x1[1]) + (x1[2] * x1[2] + x1[3] * x1[3]));
                }
                ss += __shfl_xor(ss, 16); ss += __shfl_xor(ss, 32);
                if (fq == 0) ssq[(size_t)row * 16 + u.pn * 4 + wc] = ss;
            }
            asm volatile("" ::: "memory");
        }
    }
};
struct M1Order {
    StaticOrder so; int second, G, c;
    __device__ void init(int G_, int c_, int second_) { second = second_; G = G_; c = c_; so.init(16384, second_ ? 8192 : 8704, G_, c_); }
    __device__ bool next(int i, Unit& u) const {
        if (!second) { if (so.next(i, u)) return true;
            const long L = (long)i * G + c - 2176; if (L < 0 || L >= 128) return false; u.pm = 64 + (int)(L >> 1); u.pn = 22 + (int)(L & 1); return true; }
        Unit b; if (!so.next(i, b)) return false; u.pm = b.pm + 64; u.pn = b.pn < 22 ? b.pn : b.pn + 2; return true;
    }
    __device__ __forceinline__ void a_ready(const Unit&) const {}
    __device__ __forceinline__ void done(const Unit&) const {}
};
struct EpiProj {
    static constexpr bool PERM = true, AFTER_DRAIN = false, CARRY = false;
    bf16_t* PA; unsigned char* PGa; unsigned char* PGb; const PG8_LAS float* rst; const PG8_LAS int* pml; const float* ssq;
    __device__ __forceinline__ void operator()(const f32x4 (&acc)[2][2][4][2], const Unit& u, int wr, int wc, int fr, int fq) const {
        unsigned char* PG8 = u.pm < 64 ? PGa : PGb;
        const int prow0 = u.pm * BM + wr * 64 + fr, row0 = prow0 & 16383;
        float rsv[8]; row_rs8_lds(rst, pml, ssq, u.pm, wr, fr, rsv);
        if (u.pn < 22) {
            const int col0 = u.pn * BM + wc * 32 + 8 * fq;
#pragma unroll
            for (int ai = 0; ai < 2; ++ai)
#pragma unroll
                for (int m = 0; m < 4; ++m) {
                    const int row = row0 + ai * HALF + m * 16; const float rs = rsv[ai * 4 + m];
#pragma unroll
                    for (int bj = 0; bj < 2; ++bj) {
                        const f32x4 v0 = acc[ai][bj][m][0] * rs, v1 = acc[ai][bj][m][1] * rs;
                        u32x4 w; w.x = cvt_pk_bf16(v0[0], v0[1]); w.y = cvt_pk_bf16(v0[2], v0[3]); w.z = cvt_pk_bf16(v1[0], v1[1]); w.w = cvt_pk_bf16(v1[2], v1[3]);
                        *(u32x4*)(PA + (size_t)row * 5632 + col0 + bj * HALF) = w;
                    }
                }
        } else {
            const int col0 = (u.pn - 22) * BM + wc * 32 + 8 * fq;
#pragma unroll
            for (int ai = 0; ai < 2; ++ai)
#pragma unroll
                for (int m = 0; m < 4; ++m) {
                    const int row = row0 + ai * HALF + m * 16; const float c1 = rsv[ai * 4 + m] * -1.4426950408889634f;
#pragma unroll
                    for (int bj = 0; bj < 2; ++bj) {
                        unsigned q[8];
#pragma unroll
                        for (int e = 0; e < 4; ++e) { q[e] = (unsigned)(__builtin_amdgcn_rcpf(1.0f + __builtin_amdgcn_exp2f(acc[ai][bj][m][0][e] * c1)) * 255.0f + 0.5f); q[4 + e] = (unsigned)(__builtin_amdgcn_rcpf(1.0f + __builtin_amdgcn_exp2f(acc[ai][bj][m][1][e] * c1)) * 255.0f + 0.5f); }
                        typedef unsigned u32x2_ __attribute__((ext_vector_type(2)));
                        u32x2_ w; w.x = q[0] | (q[1] << 8) | (q[2] << 16) | (q[3] << 24); w.y = q[4] | (q[5] << 8) | (q[6] << 16) | (q[7] << 24);
                        *(u32x2_*)(PG8 + (size_t)row * 3072 + col0 + bj * HALF) = w;
                    }
                }
        }
    }
};
struct MergeOrder {
    StaticOrder so;
    __device__ void init(int M, int N, int G_, int c_) { so.init(M, N, G_, c_); }
    __device__ bool next(int i, Unit& u) const { Unit b; if (!so.next(i / 3, b)) return false; const int m = i % 3, w = (m == 0) ? 2 : m - 1; u.pm = b.pm + 64 * m; u.pn = b.pn + 4 * w; return true; }
    __device__ __forceinline__ void a_ready(const Unit&) const {}
    __device__ __forceinline__ void done(const Unit&) const {}
};
struct EpiMerge {
    static constexpr bool PERM = true, AFTER_DRAIN = false, CARRY = true;
    const unsigned char* PG8; bf16_t* MB;
    __device__ __forceinline__ void operator()(const f32x4 (&)[2][2][4][2], const Unit&, int, int, int, int) const {}
    __device__ __forceinline__ bool carry(f32x4 (&acc)[2][2][4][2], const Unit& u, int wr, int wc, int fr, int fq) const {
        typedef unsigned u32x2_ __attribute__((ext_vector_type(2)));
        const int m_ = u.pm >> 6, pm = u.pm & 63, w_ = u.pn >> 2, pn = u.pn & 3;
        const int wn = (m_ == 0) ? 0 : 1;
        const bool last = (m_ == 2);
        const int row0 = pm * BM + wr * 64 + fr, col0 = pn * BM + wc * 32 + 8 * fq;
#pragma unroll
        for (int ai = 0; ai < 2; ++ai) {
            u32x2_ gc[4][2], gn[4][2];
#pragma unroll
            for (int m = 0; m < 4; ++m)
#pragma unroll
                for (int bj = 0; bj < 2; ++bj) { const size_t o = (size_t)(row0 + ai * HALF + m * 16) * 3072 + col0 + bj * HALF;
                    gc[m][bj] = *(const u32x2_*)(PG8 + o + w_ * 1024);
                    gn[m][bj] = last ? (u32x2_){0x01010101u, 0x01010101u} : *(const u32x2_*)(PG8 + o + wn * 1024); }
#pragma unroll
            for (int m = 0; m < 4; ++m)
#pragma unroll
                for (int bj = 0; bj < 2; ++bj) {
                    float f[8];
#pragma unroll
                    for (int e = 0; e < 8; ++e) { const unsigned wc_ = e < 4 ? gc[m][bj].x : gc[m][bj].y, wn_ = e < 4 ? gn[m][bj].x : gn[m][bj].y; const int sh = 8 * (e & 3);
                        const float qc = (float)max((wc_ >> sh) & 255u, 1u), qn = (float)max((wn_ >> sh) & 255u, 1u);
                        f[e] = last ? qc * (1.0f / 255.0f) : qc * __builtin_amdgcn_rcpf(qn); }
#pragma unroll
                    for (int e = 0; e < 4; ++e) { acc[ai][bj][m][0][e] *= f[e]; acc[ai][bj][m][1][e] *= f[4 + e]; }
                    if (last) { const f32x4 t0 = acc[ai][bj][m][0], t1 = acc[ai][bj][m][1];
                        u32x4 w; w.x = cvt_pk_bf16(t0[0], t0[1]); w.y = cvt_pk_bf16(t0[2], t0[3]); w.z = cvt_pk_bf16(t1[0], t1[1]); w.w = cvt_pk_bf16(t1[2], t1[3]);
                        *(u32x4*)(MB + (size_t)(row0 + ai * HALF + m * 16) * 1024 + col0 + bj * HALF) = w; }
                }
            asm volatile("" ::: "memory");
        }
        return !last;
    }
};
template <class Epi, class Sched, bool ALIGN_EPI = false, bool SP2 = false>
__device__ __forceinline__ void gemm_phase(PG8_LAS unsigned char* lds, const Gemm g, const Sched& S, const Epi& E) {
    int tid = threadIdx.x; asm volatile("" : "+v"(tid));
    const int wid = __builtin_amdgcn_readfirstlane(tid >> 6), lane = tid & 63, wr = wid >> 2, wc = wid & 3, fr = lane & 15, fq = lane >> 4;
    const int K = g.K, nt = K / BK;
    unsigned voffA[2], voffB[2];
#pragma unroll
    for (int i = 0; i < 2; ++i) { int R, C; stage_rc(tid * 16 + i * 8192, R, C); const int Rb = Epi::PERM ? ((R & ~31) + perm32(R & 31)) : R;
        voffA[i] = (unsigned)(R * K + C) * 2u; voffB[i] = (unsigned)(Rb * K + C) * 2u; }
    const size_t kstep = (size_t)(BK * 2);
    const size_t hstep = (size_t)HALF * K * 2;
    const size_t tstep = 2 * hstep;
    const unsigned ldsw = (unsigned)wid * 1024u;
    const int aoff = lds_byte(wr * 64 + fr, fq * 8), boff = lds_byte(wc * 32 + fr, fq * 8);
#define PG8_SA(b, h) (((b) * 2 + (h)) * HTB)
#define PG8_SB(b, h) ((4 + (b) * 2 + (h)) * HTB)
#define PG8_STAGE(bufoff, gbase, voff) do { _Pragma("unroll") for (int _i = 0; _i < 2; ++_i) \
        __builtin_amdgcn_global_load_lds((const unsigned*)((const char*)(gbase) + (voff)[_i]), (PG8_LAS unsigned*)(lds + (bufoff) + ldsw + _i * 8192), 16, 0, 0); } while (0)
#define PG8_LDA(dst, b, h) do { _Pragma("unroll") for (int m = 0; m < 4; ++m) _Pragma("unroll") for (int k = 0; k < 2; ++k) dst[m][k] = *(const PG8_LAS bf16x8*)(lds + PG8_SA(b, h) + aoff + m * 2048 + k * 1024); } while (0)
#define PG8_LDB(dst, b, h) do { _Pragma("unroll") for (int n = 0; n < 2; ++n) _Pragma("unroll") for (int k = 0; k < 2; ++k) dst[n][k] = *(const PG8_LAS bf16x8*)(lds + PG8_SB(b, h) + boff + n * 2048 + k * 1024); } while (0)
#define PG8_MMA(ai, bj, At, Bt) do { __builtin_amdgcn_s_setprio(1); _Pragma("unroll") for (int m = 0; m < 4; ++m) _Pragma("unroll") for (int n = 0; n < 2; ++n) _Pragma("unroll") for (int k = 0; k < 2; ++k) \
        acc[ai][bj][m][n] = __builtin_amdgcn_mfma_f32_16x16x32_bf16(Bt[n][k], At[m][k], acc[ai][bj][m][n], 0, 0, 0); __builtin_amdgcn_s_setprio(0); } while (0)
#define PG8_WAIT_V(n) asm volatile("s_waitcnt vmcnt(" #n ")" ::: "memory")
#define PG8_WAIT_L(n) asm volatile("s_waitcnt lgkmcnt(" #n ")" ::: "memory")
#define PG8_BAR __builtin_amdgcn_s_barrier()
#define PG8_SCHED __builtin_amdgcn_sched_barrier(0)
    Unit cur, nxt; int ui = 0;
    if (!S.next(0, cur)) return;
    f32x4 acc[2][2][4][2];
#pragma unroll
    for (int a = 0; a < 2; ++a)
#pragma unroll
        for (int b = 0; b < 2; ++b)
#pragma unroll
            for (int m = 0; m < 4; ++m)
#pragma unroll
                for (int n = 0; n < 2; ++n) acc[a][b][m][n] = (f32x4){0.f, 0.f, 0.f, 0.f};
    bf16x8 At[4][2], B0[2][2], B1[2][2];
    const char* cA = (const char*)g.A + (size_t)cur.pm * tstep; const char* cB = (const char*)g.Bt + (size_t)cur.pn * tstep;
    S.a_ready(cur);
    if constexpr (SP2) {
        PG8_STAGE(PG8_SB(0, 0), cB, voffB); PG8_STAGE(PG8_SB(0, 1), cB + hstep, voffB); PG8_STAGE(PG8_SA(0, 0), cA, voffA); PG8_STAGE(PG8_SA(0, 1), cA + hstep, voffA);
        if (wr == 1) PG8_BAR;
        PG8_WAIT_V(2); PG8_BAR;
        PG8_STAGE(PG8_SB(1, 0), cB + kstep, voffB); PG8_STAGE(PG8_SA(1, 0), cA + kstep, voffA); PG8_STAGE(PG8_SB(1, 1), cB + hstep + kstep, voffB);
        PG8_WAIT_V(6); PG8_BAR;
    } else {
        PG8_STAGE(PG8_SB(0, 0), cB, voffB); PG8_STAGE(PG8_SA(0, 0), cA, voffA); PG8_STAGE(PG8_SB(0, 1), cB + hstep, voffB); PG8_STAGE(PG8_SA(0, 1), cA + hstep, voffA);
        if (wr == 1) PG8_BAR;
        PG8_WAIT_V(4); PG8_BAR;
        PG8_STAGE(PG8_SB(1, 0), cB + kstep, voffB); PG8_STAGE(PG8_SA(1, 0), cA + kstep, voffA); PG8_STAGE(PG8_SB(1, 1), cB + hstep + kstep, voffB);
        PG8_WAIT_V(6); PG8_BAR;
    }
    for (;;) {
        const bool has_next = S.next(ui + 1, nxt);
        const char* nA = has_next ? (const char*)g.A + (size_t)nxt.pm * tstep : cA; const char* nB = has_next ? (const char*)g.Bt + (size_t)nxt.pn * tstep : cB;
        for (int t = 0; t < nt; t += 2) {
            const bool last = (t == nt - 2);
            const char* a1 = cA + (size_t)(t + 1) * kstep;
            const char* a2 = last ? nA : cA + (size_t)(t + 2) * kstep; const char* b2 = last ? nB : cB + (size_t)(t + 2) * kstep;
            const char* a3 = a2 + kstep; const char* b3 = b2 + kstep;
            if (last && has_next) S.a_ready(nxt);
            if constexpr (SP2) {
            PG8_LDB(B0, 0, 0); PG8_LDB(B1, 0, 1); PG8_SCHED; PG8_LDA(At, 0, 0); PG8_STAGE(PG8_SA(1, 1), a1 + hstep, voffA);
            PG8_WAIT_V(8); PG8_WAIT_L(0); PG8_BAR; PG8_MMA(0, 0, At, B0); PG8_MMA(0, 1, At, B1); PG8_BAR; PG8_SCHED;
            PG8_LDA(At, 0, 1); PG8_STAGE(PG8_SB(0, 0), b2, voffB); PG8_STAGE(PG8_SB(0, 1), b2 + hstep, voffB); PG8_STAGE(PG8_SA(0, 0), a2, voffA);
            PG8_WAIT_V(8); PG8_WAIT_L(0); PG8_BAR; PG8_MMA(1, 0, At, B0); PG8_MMA(1, 1, At, B1); PG8_BAR; PG8_SCHED;
            PG8_LDB(B0, 1, 0); PG8_LDB(B1, 1, 1); PG8_SCHED; PG8_LDA(At, 1, 0); PG8_STAGE(PG8_SA(0, 1), a2 + hstep, voffA);
            PG8_WAIT_V(8); PG8_WAIT_L(0); PG8_BAR; PG8_MMA(0, 0, At, B0); PG8_MMA(0, 1, At, B1); PG8_BAR; PG8_SCHED;
            PG8_LDA(At, 1, 1); PG8_STAGE(PG8_SB(1, 0), b3, voffB); PG8_STAGE(PG8_SB(1, 1), b3 + hstep, voffB); PG8_STAGE(PG8_SA(1, 0), a3, voffA);
            PG8_WAIT_V(8); PG8_WAIT_L(0); PG8_BAR; PG8_MMA(1, 0, At, B0); PG8_MMA(1, 1, At, B1); PG8_BAR; PG8_SCHED;
            } else {
            PG8_LDB(B0, 0, 0); PG8_SCHED; PG8_LDA(At, 0, 0); PG8_STAGE(PG8_SA(1, 1), a1 + hstep, voffA);
            PG8_WAIT_L(8); PG8_BAR; PG8_WAIT_L(0); PG8_MMA(0, 0, At, B0); PG8_BAR; PG8_SCHED;
            PG8_LDB(B1, 0, 1); PG8_STAGE(PG8_SB(0, 0), b2, voffB);
            PG8_BAR; PG8_WAIT_L(0); PG8_MMA(0, 1, At, B1); PG8_BAR;
            PG8_LDA(At, 0, 1); PG8_STAGE(PG8_SA(0, 0), a2, voffA);
            PG8_BAR; PG8_WAIT_L(0); PG8_MMA(1, 0, At, B0); PG8_BAR; PG8_SCHED;
            PG8_STAGE(PG8_SB(0, 1), b2 + hstep, voffB);
            PG8_WAIT_V(6); PG8_BAR; PG8_MMA(1, 1, At, B1); PG8_BAR;
            PG8_LDB(B0, 1, 0); PG8_SCHED; PG8_LDA(At, 1, 0); PG8_STAGE(PG8_SA(0, 1), a2 + hstep, voffA);
            PG8_WAIT_L(8); PG8_BAR; PG8_WAIT_L(0); PG8_MMA(0, 0, At, B0); PG8_BAR; PG8_SCHED;
            PG8_LDB(B1, 1, 1); PG8_STAGE(PG8_SB(1, 0), b3, voffB);
            PG8_BAR; PG8_WAIT_L(0); PG8_MMA(0, 1, At, B1); PG8_BAR;
            PG8_LDA(At, 1, 1); PG8_STAGE(PG8_SA(1, 0), a3, voffA);
            PG8_BAR; PG8_WAIT_L(0); PG8_MMA(1, 0, At, B0); PG8_BAR; PG8_SCHED;
            PG8_STAGE(PG8_SB(1, 1), b3 + hstep, voffB);
            PG8_WAIT_V(6); PG8_BAR; PG8_MMA(1, 1, At, B1); PG8_BAR;
            }
        }
        if constexpr (ALIGN_EPI) { if (wr == 0) PG8_BAR; }
        bool keep = false;
        if constexpr (Epi::CARRY) { keep = E.carry(acc, cur, wr, wc, fr, fq); S.done(cur); }
        else if constexpr (!Epi::AFTER_DRAIN) { E(acc, cur, wr, wc, fr, fq); S.done(cur); }
        if (!has_next) break;
        if (!keep) {
#pragma unroll
        for (int a = 0; a < 2; ++a)
#pragma unroll
            for (int b = 0; b < 2; ++b)
#pragma unroll
                for (int m = 0; m < 4; ++m)
#pragma unroll
                    for (int n = 0; n < 2; ++n) acc[a][b][m][n] = (f32x4){0.f, 0.f, 0.f, 0.f};
        }
        cur = nxt; cA = nA; cB = nB; ++ui;
        if constexpr (ALIGN_EPI) { if (wr == 1) PG8_BAR; }
    }
    PG8_WAIT_V(0);
    if constexpr (!ALIGN_EPI) { if (wr == 0) PG8_BAR; }
    PG8_BAR;
    if constexpr (Epi::AFTER_DRAIN) { E.fused(acc, cur, wr, wc, fr, fq, lds, wid, lane); S.done(cur); }
#undef PG8_SA
#undef PG8_SB
#undef PG8_STAGE
#undef PG8_LDA
#undef PG8_LDB
#undef PG8_MMA
#undef PG8_WAIT_V
#undef PG8_WAIT_L
#undef PG8_BAR
#undef PG8_SCHED
}
}
#define LAS __attribute__((address_space(3)))
typedef unsigned short bf16;
typedef unsigned v4u __attribute__((ext_vector_type(4)));
typedef unsigned v2u __attribute__((ext_vector_type(2)));
typedef short v4i16_t __attribute__((ext_vector_type(4)));
using pg8::f32x4; using pg8::bf16x8; using pg8::cvt_pk_bf16;

constexpr int D = 1024, FF = 2816, NLAYER = 4, TG = 16384, NGROUP = 4, NTHR = 512, NWAVES = 8;
constexpr int PA_LD = 5632, PG_LD = 3072;
constexpr int C_HQ = 0, C_HI = 512, C_HZF = 1024, C_HZB = 1536, C_HG = 2048, C_CA = 2560, C_CB = 3072, C_CC = 3584, C_NQ = 4096, C_NK = 4608, C_NV = 5120;
constexpr size_t MiB = 1u << 20;
constexpr size_t WS_CTL = 0, CTL_BYTES = 1 * MiB, WS_W = 1 * MiB, WS_XB = 221 * MiB, WS_SSQ = 285 * MiB, WS_PA = 287 * MiB, WS_PG = 463 * MiB, WS_ONA = 559 * MiB, WS_SCR = 575 * MiB, WS_END = 671 * MiB;
constexpr size_t OFF_GU1 = 0, OFF_D1 = 5767168, OFF_IN = 8650752, OFF_HG = 17563648, OFF_CV = 18087936, OFF_NA = 18612224, OFF_OUT = 19136512, OFF_GU2 = 20185088, OFF_D2 = 25952256, LAYER_EL = 28835840;
constexpr int LDS_BYTES = 147456, LDS_MISC = 147456 - 64;
constexpr int PH_PER_PAIR = 1 + NLAYER * 16 + 1;
constexpr int CW_BAR = 4096;

__device__ __forceinline__ unsigned f2bf(float f) { unsigned u = __float_as_uint(f); return (u + 0x7fffu + ((u >> 16) & 1u)) >> 16; }
__device__ __forceinline__ float bf2f(unsigned b) { return __uint_as_float(b << 16); }
__device__ __forceinline__ float bflo(unsigned w) { return __uint_as_float(w << 16); }
__device__ __forceinline__ float bfhi(unsigned w) { return __uint_as_float(w & 0xffff0000u); }
__device__ __forceinline__ float sigm(float v) { return __builtin_amdgcn_rcpf(1.0f + __expf(-v)); }
__device__ __forceinline__ float wave_sum(float v) {
#pragma unroll
    for (int o = 1; o < 64; o <<= 1) v += __shfl_xor(v, o);
    return v;
}

__device__ __forceinline__ void cvt_item(const float* W, int K, int N, bf16* WT, const float* gain, bool permgu, LAS float* scr, int item, int lane) {
    const int nblk = N / 32, kb = item / nblk, nb = item % nblk, k0 = 64 * kb, n0 = 32 * nb;
#pragma unroll
    for (int i = 0; i < 32; ++i) { const int kk = 2 * i + (lane >> 5); const float g = gain ? gain[k0 + kk] : 1.0f; scr[kk * 33 + (lane & 31)] = W[(size_t)(k0 + kk) * N + n0 + (lane & 31)] * g; }
    asm volatile("s_waitcnt lgkmcnt(0)" ::: "memory");
    int dn0 = n0;
    if (permgu) { const int half = n0 >= FF ? 1 : 0; const int j = n0 - half * FF; dn0 = (j >> 7) * 256 + half * 128 + (j & 127); }
    const int c = lane & 7;
#pragma unroll
    for (int j = 0; j < 4; ++j) { const int n = (lane >> 3) + 8 * j; const LAS float* s = scr + (8 * c) * 33 + n;
        v4u o; o.x = cvt_pk_bf16(s[0 * 33], s[1 * 33]); o.y = cvt_pk_bf16(s[2 * 33], s[3 * 33]); o.z = cvt_pk_bf16(s[4 * 33], s[5 * 33]); o.w = cvt_pk_bf16(s[6 * 33], s[7 * 33]);
        *(v4u*)(WT + (size_t)(dn0 + n) * K + k0 + 8 * c) = o; }
    asm volatile("s_waitcnt lgkmcnt(0)" ::: "memory");
}

template <int K> __device__ __forceinline__ f32x4 mma_lds(f32x4 acc, const LAS bf16* A, int pa, const LAS bf16* B, int pb, int lane) {
    const int r = lane & 15, q = lane >> 4;
#pragma unroll
    for (int ks = 0; ks < K / 32; ++ks) {
        const bf16x8 a = *(const LAS bf16x8*)(A + r * pa + ks * 32 + q * 8);
        const bf16x8 b = *(const LAS bf16x8*)(B + r * pb + ks * 32 + q * 8);
        acc = __builtin_amdgcn_mfma_f32_16x16x32_bf16(a, b, acc, 0, 0, 0);
    }
    return acc;
}

constexpr int HP_QT = 0, HP_KTT = 17408, HP_AM = 35840, HP_ER = 45056, HP_EE = 45568, HP_BLK = 49152;
constexpr int HP_KT = 49152, HP_SEG = 66560;
constexpr int HS_VT = 49152, HS_ST = 53760, HS_BUF = 62464;
__device__ __forceinline__ void hg_prep_items(LAS unsigned char* lds, const bf16* PA, unsigned char* SCR, const float* lb_logits, int layer, int item0, int istride, int nitems, int T, int tid) {
    const int lane = tid & 63, wave = __builtin_amdgcn_readfirstlane(tid >> 6), c16 = lane & 15, quad = lane >> 4;
    const int nchunk = T / 64;
    const int kp = tid & 63, ts = tid >> 6;
    LAS bf16* QT = (LAS bf16*)(lds + HP_QT); LAS bf16* KT = (LAS bf16*)(lds + HP_KT); LAS bf16* KTT = (LAS bf16*)(lds + HP_KTT); LAS bf16* AM = (LAS bf16*)(lds + HP_AM);
    LAS float* SEG = (LAS float*)(lds + HP_SEG); LAS float* ER = (LAS float*)(lds + HP_ER); LAS float* EE = (LAS float*)(lds + HP_EE);
    unsigned zz[8], qq[8];
#define HP_LOAD(it) do { const int it_ = min((it), nitems - 1); const int c_ = it_ % nchunk, sd_ = it_ / nchunk, dir_ = sd_ & 1, h_ = (sd_ >> 1) & 3, base_ = (sd_ >> 3) * T; \
        const bf16* zs = PA + (dir_ ? C_HZB : C_HZF) + h_ * 128 + 2 * kp; const bf16* qs = PA + C_HQ + h_ * 128 + 2 * kp; \
        _Pragma("unroll") for (int i = 0; i < 8; ++i) { const int tau = c_ * 64 + 8 * ts + i; const size_t ro = (size_t)(base_ + (dir_ ? (T - 1 - tau) : tau)) * PA_LD; zz[i] = *(const unsigned*)(zs + ro); qq[i] = *(const unsigned*)(qs + ro); } } while (0)
    HP_LOAD(item0);
    for (int item = item0; item < nitems; item += istride) {
        const int sd = item / nchunk, dir = sd & 1, h = (sd >> 1) & 3;
        float lb[2];
#pragma unroll
        for (int j = 0; j < 2; ++j) { float lg[4], mx = -3e38f;
#pragma unroll
          for (int l = 0; l < 4; ++l) { lg[l] = lb_logits[(dir * 4 + l) * 512 + h * 128 + 2 * kp + j]; mx = fmaxf(mx, lg[l]); }
          float tot = 0.f, num = 0.f;
#pragma unroll
          for (int l = 0; l < 4; ++l) { const float e = __expf(lg[l] - mx); tot += e; if (l >= 1 && l <= layer) num += e; }
          lb[j] = num / tot; }
        float b[2][8], kv[2][8], qv[2][8]; float cum[2] = {0.f, 0.f};
#pragma unroll
        for (int i = 0; i < 8; ++i)
#pragma unroll
            for (int j = 0; j < 2; ++j) { const float zf = j ? bfhi(zz[i]) : bflo(zz[i]); const float sg = __builtin_amdgcn_rcpf(1.0f + __builtin_amdgcn_exp2f(zf * -1.4426950408889634f)); const float oml = 1.0f - lb[j]; const float f = lb[j] + oml * sg;
                cum[j] += __builtin_amdgcn_logf(fmaxf(f, 1e-30f)); b[j][i] = cum[j]; kv[j][i] = oml * (1.0f - sg); qv[j][i] = j ? bfhi(qq[i]) : bflo(qq[i]); }
        HP_LOAD(item + istride);
        SEG[ts * 128 + 2 * kp] = cum[0]; SEG[ts * 128 + 2 * kp + 1] = cum[1];
        __syncthreads();
        float pre[2], r[2], bend[2];
#pragma unroll
        for (int j = 0; j < 2; ++j) { float p = 0.f, rr = 0.f, be = 0.f;
#pragma unroll
            for (int q = 0; q < 8; ++q) { const float v = SEG[q * 128 + 2 * kp + j]; if (q < ts) p += v; if (q < 4) rr += v; be += v; }
            pre[j] = p; r[j] = rr; bend[j] = be; }
        unsigned kpk[2][4];
#pragma unroll
        for (int i = 0; i < 8; ++i) {
            unsigned qb[2], kb[2];
#pragma unroll
            for (int j = 0; j < 2; ++j) { const float bt = pre[j] + b[j][i];
                const float eq = __builtin_amdgcn_exp2f(fminf(bt - r[j], 115.4f)), ek = __builtin_amdgcn_exp2f(fminf(r[j] - bt, 115.4f));
                qb[j] = f2bf(qv[j][i] * eq); kb[j] = f2bf(kv[j][i] * ek);
                if (i & 1) kpk[j][i >> 1] |= kb[j] << 16; else kpk[j][i >> 1] = kb[j]; }
            const int tau = 8 * ts + i;
            *(LAS unsigned*)(QT + tau * 136 + 2 * kp) = qb[0] | (qb[1] << 16);
            *(LAS unsigned*)(KT + tau * 136 + 2 * kp) = kb[0] | (kb[1] << 16);
        }
#pragma unroll
        for (int j = 0; j < 2; ++j) *(LAS v4u*)(KTT + (2 * kp + j) * 72 + 8 * ts) = (v4u){kpk[j][0], kpk[j][1], kpk[j][2], kpk[j][3]};
        if (ts == 0) {
#pragma unroll
            for (int j = 0; j < 2; ++j) { ER[2 * kp + j] = __builtin_amdgcn_exp2f(r[j]); EE[2 * kp + j] = __builtin_amdgcn_exp2f(bend[j] - r[j]); } }
        __syncthreads();
#pragma unroll
        for (int e = 0; e < 2; ++e) { const int id = wave * 2 + e, tt = id >> 2, st = id & 3;
            f32x4 a = (f32x4){0.f, 0.f, 0.f, 0.f};
            if (st <= tt) a = mma_lds<128>(a, QT + tt * 16 * 136, 136, KT + st * 16 * 136, 136, lane);
#pragma unroll
            for (int i = 0; i < 4; ++i) { const int t = tt * 16 + quad * 4 + i, s = st * 16 + c16; const float val = (st <= tt && s <= t) ? a[i] : 0.f; AM[t * 72 + s] = (bf16)f2bf(val); } }
        __syncthreads();
        unsigned char* dst = SCR + (size_t)item * HP_BLK;
#pragma unroll
        for (int j = 0; j < 6; ++j) { const int idx = tid + 512 * j; *(v4u*)(dst + (size_t)idx * 16) = *(const LAS v4u*)(lds + idx * 16); }
        __syncthreads();
    }
#undef HP_LOAD
}

template <int NVT> __device__ __forceinline__ void hg_scan_item(LAS unsigned char* lds, bf16* PA, const unsigned char* SCR, int item, int T, int tid) {
    constexpr int NVS = 8 / NVT, VW = 16 * NVT, VTHR = 128 * NVT, VSH = (NVT == 2) ? 2 : 1;
    const int lane = tid & 63, wave = __builtin_amdgcn_readfirstlane(tid >> 6), c16 = lane & 15, quad = lane >> 4;
    const int vs = item % NVS, sd = item / NVS, dir = sd & 1, h = (sd >> 1) & 3, seq = sd >> 3;
    const int base = seq * T, nchunk = T / 64;
    const unsigned char* blk = SCR + (size_t)sd * nchunk * HP_BLK;
    const bf16* vsrc = PA + C_HI + h * 128 + vs * VW + (tid & (VW / 8 - 1)) * 8;
    bf16* odst = PA + (dir ? C_HZF : C_HQ) + h * 128 + vs * VW;
    v4u preA[6], preB[6]; v4u vrA = {0u, 0u, 0u, 0u}, vrB = vrA; f32x4 ervA, eevA, ervB, eevB;
#define HG_ROW(tau) (base + (dir ? (T - 1 - (tau)) : (tau)))
#define HS_LOAD(c, pre, vr, erv, eev) do { const int c_ = min((c), nchunk - 1); const unsigned char* bp = blk + (size_t)c_ * HP_BLK;     \
        _Pragma("unroll") for (int j = 0; j < 6; ++j) pre[j] = *(const v4u*)(bp + (size_t)(tid + 512 * j) * 16); \
        erv = *(const f32x4*)(bp + HP_ER + (wave * 16 + quad * 4) * 4); eev = *(const f32x4*)(blk + (size_t)max(c_ - 1, 0) * HP_BLK + HP_EE + (wave * 16 + quad * 4) * 4);     \
        vr = *(const v4u*)(vsrc + (size_t)HG_ROW(c_ * 64 + ((tid & (VTHR - 1)) >> VSH)) * PA_LD); } while (0)
    HS_LOAD(0, preA, vrA, ervA, eevA);
    HS_LOAD(1, preB, vrB, ervB, eevB);
    f32x4 accS[NVT];
#pragma unroll
    for (int e = 0; e < NVT; ++e) accS[e] = (f32x4){0.f, 0.f, 0.f, 0.f};
#define HS_STEP(c, BUFI, pre, vr, erv, eev) do { \
        LAS unsigned char* B = lds + (BUFI) * HS_BUF; \
        LAS bf16* QT = (LAS bf16*)(B + HP_QT); LAS bf16* KTT = (LAS bf16*)(B + HP_KTT); LAS bf16* AM = (LAS bf16*)(B + HP_AM); \
        LAS bf16* VT = (LAS bf16*)(B + HS_VT); LAS bf16* STt = (LAS bf16*)(B + HS_ST); \
        _Pragma("unroll") for (int j = 0; j < 6; ++j) *(LAS v4u*)(B + (tid + 512 * j) * 16) = pre[j]; \
        if (tid < VTHR) { const int s_ = tid >> VSH, vq = tid & (VW / 8 - 1); \
            VT[(vq * 8 + 0) * 72 + s_] = (bf16)(vr.x & 0xffffu); VT[(vq * 8 + 1) * 72 + s_] = (bf16)(vr.x >> 16); \
            VT[(vq * 8 + 2) * 72 + s_] = (bf16)(vr.y & 0xffffu); VT[(vq * 8 + 3) * 72 + s_] = (bf16)(vr.y >> 16); \
            VT[(vq * 8 + 4) * 72 + s_] = (bf16)(vr.z & 0xffffu); VT[(vq * 8 + 5) * 72 + s_] = (bf16)(vr.z >> 16); \
            VT[(vq * 8 + 6) * 72 + s_] = (bf16)(vr.w & 0xffffu); VT[(vq * 8 + 7) * 72 + s_] = (bf16)(vr.w >> 16); } \
        f32x4 sp[NVT]; const f32x4 sc_ = erv * eev;     \
        _Pragma("unroll") for (int e = 0; e < NVT; ++e) { sp[e] = accS[e] * sc_; v2u w; w.x = cvt_pk_bf16(sp[e][0], sp[e][1]); w.y = cvt_pk_bf16(sp[e][2], sp[e][3]); \
            *(LAS v2u*)(STt + (e * 16 + c16) * 136 + wave * 16 + quad * 4) = w; } \
        HS_LOAD((c) + 2, pre, vr, erv, eev); \
        __syncthreads(); \
        if ((wave >> 2) < NVT) { const int tt = wave & 3, vt = wave >> 2; f32x4 o = (f32x4){0.f, 0.f, 0.f, 0.f}; \
          o = mma_lds<128>(o, QT + tt * 16 * 136, 136, STt + vt * 16 * 136, 136, lane); \
          o = mma_lds<64>(o, AM + tt * 16 * 72, 72, VT + vt * 16 * 72, 72, lane); \
          _Pragma("unroll") for (int i = 0; i < 4; ++i) { const int tau = (c) * 64 + tt * 16 + quad * 4 + i; odst[(size_t)HG_ROW(tau) * PA_LD + vt * 16 + c16] = (bf16)f2bf(o[i]); } } \
        _Pragma("unroll") for (int e = 0; e < NVT; ++e) { accS[e] = mma_lds<64>(sp[e], KTT + wave * 16 * 72, 72, VT + e * 16 * 72, 72, lane); } \
    } while (0)
    for (int c = 0; c < nchunk; c += 2) {
        HS_STEP(c, 0, preA, vrA, ervA, eevA);
        HS_STEP(c + 1, 1, preB, vrB, ervB, eevB);
    }
    __syncthreads();
#undef HG_ROW
#undef HS_LOAD
#undef HS_STEP
}

__device__ __forceinline__ void na_item(LAS unsigned char* lds, const bf16* PA, const float* rpb, bf16* ONA, int item, int T, int tid) {
    const int lane = tid & 63, h = __builtin_amdgcn_readfirstlane(tid >> 6), c16 = lane & 15, quad = lane >> 4;
    const int ips = T / 16, seq = item / ips, rem = item % ips, r = rem >> 2, j = rem & 3;
    const int rows = T / 64, rs = min(max(r - 4, 0), rows - 8), kstart = (j == 0) ? 0 : (j == 1) ? 8 : (j == 2) ? 24 : 32;
    const int base = seq * T, qtok = base + r * 64 + 16 * j + c16;
    const bf16* qp = PA + (size_t)qtok * PA_LD + C_NQ + h * 64 + quad * 8;
    const bf16x8 Qb0 = *(const bf16x8*)qp, Qb1 = *(const bf16x8*)(qp + 32);
    const int qcol = 16 * j + c16, cs = min(max(qcol - 8, 0), 48);
    v4u vbufA[8], vbufB[8], vbufC[8], vbufD[8];
#define NA_VLOAD(qd, vbuf) do { _Pragma("unroll") for (int it = 0; it < 8; ++it) { const int idx = it * 64 + lane, key = idx >> 3, dg = idx & 7; \
        const int tok = base + (rs + 2 * (qd) + (key >> 5)) * 64 + kstart + (key & 31); vbuf[it] = *(const v4u*)(PA + (size_t)tok * PA_LD + C_NV + h * 64 + dg * 8); } } while (0)
    NA_VLOAD(0, vbufA); NA_VLOAD(1, vbufB);
    const float* rp = rpb + h * 465;
    f32x4 sacc[16]; float mx = -3e38f;
    int dcv[8]; bool okv[8];
#pragma unroll
    for (int e = 0; e < 8; ++e) { const int kcol = kstart + (e >> 2) * 16 + quad * 4 + (e & 3); okv[e] = (kcol >= cs) && (kcol < cs + 16); dcv[e] = min(max(kcol - qcol + 15, 0), 30); }
#pragma unroll
    for (int a = 0; a < 8; ++a) {
        const float rowv = rp[(rs + a - r + 7) * 31 + min(lane, 30)] * 1.4426950408889634f;
        float bv[8];
#pragma unroll
        for (int e = 0; e < 8; ++e) bv[e] = __builtin_bit_cast(float, __builtin_amdgcn_ds_bpermute(dcv[e] << 2, __builtin_bit_cast(int, rowv)));
#pragma unroll
        for (int hh = 0; hh < 2; ++hh) {
            const int ktok = base + (rs + a) * 64 + kstart + hh * 16 + c16;
            const bf16* kp = PA + (size_t)ktok * PA_LD + C_NK + h * 64 + quad * 8;
            const bf16x8 Ka0 = *(const bf16x8*)kp, Ka1 = *(const bf16x8*)(kp + 32);
            f32x4 s = (f32x4){0.f, 0.f, 0.f, 0.f};
            s = __builtin_amdgcn_mfma_f32_16x16x32_bf16(Ka0, Qb0, s, 0, 0, 0);
            s = __builtin_amdgcn_mfma_f32_16x16x32_bf16(Ka1, Qb1, s, 0, 0, 0);
#pragma unroll
            for (int i = 0; i < 4; ++i) { const float val = okv[hh * 4 + i] ? s[i] * (0.125f * 1.4426950408889634f) + bv[hh * 4 + i] : -1e30f;     s[i] = val; mx = fmaxf(mx, val); }
            sacc[a * 2 + hh] = s;
        }
    }
    NA_VLOAD(2, vbufC); NA_VLOAD(3, vbufD);
    mx = fmaxf(mx, __shfl_xor(mx, 16)); mx = fmaxf(mx, __shfl_xor(mx, 32));
    float sum = 0.f;
#pragma unroll
    for (int t = 0; t < 16; ++t)
#pragma unroll
        for (int i = 0; i < 4; ++i) { const float p = __builtin_amdgcn_exp2f(sacc[t][i] - mx); sacc[t][i] = p; sum += p; }
    sum += __shfl_xor(sum, 16); sum += __shfl_xor(sum, 32);
    bf16x8 pb[8];
#pragma unroll
    for (int a = 0; a < 8; ++a) { v4u w; w.x = cvt_pk_bf16(sacc[2 * a][0], sacc[2 * a][1]); w.y = cvt_pk_bf16(sacc[2 * a][2], sacc[2 * a][3]);
        w.z = cvt_pk_bf16(sacc[2 * a + 1][0], sacc[2 * a + 1][1]); w.w = cvt_pk_bf16(sacc[2 * a + 1][2], sacc[2 * a + 1][3]); pb[a] = __builtin_bit_cast(bf16x8, w); }
    LAS bf16* VS = (LAS bf16*)(lds + h * 10240);
    f32x4 oacc[4];
#pragma unroll
    for (int dt = 0; dt < 4; ++dt) oacc[dt] = (f32x4){0.f, 0.f, 0.f, 0.f};
    const int trq = (lane & 15) >> 2, trp = lane & 3;
    const LAS bf16* trbase = VS + (quad * 4 + trq) * 80 + 4 * trp;
#define NA_PV(qd, vbuf) do { \
        _Pragma("unroll") for (int it = 0; it < 8; ++it) { const int idx = it * 64 + lane, key = idx >> 3, dg = idx & 7; *(LAS v4u*)(VS + key * 80 + dg * 8) = vbuf[it]; } \
        _Pragma("unroll") for (int al = 0; al < 2; ++al) \
            _Pragma("unroll") for (int dt = 0; dt < 4; ++dt) { const LAS bf16* p = trbase + al * 32 * 80 + dt * 16; \
                const v4i16_t lo = __builtin_amdgcn_ds_read_tr16_b64_v4i16((LAS v4i16_t*)p), hi = __builtin_amdgcn_ds_read_tr16_b64_v4i16((LAS v4i16_t*)(p + 16 * 80)); \
                const bf16x8 af = {lo[0], lo[1], lo[2], lo[3], hi[0], hi[1], hi[2], hi[3]}; \
                oacc[dt] = __builtin_amdgcn_mfma_f32_16x16x32_bf16(af, pb[(qd) * 2 + al], oacc[dt], 0, 0, 0); } } while (0)
    NA_PV(0, vbufA); NA_PV(1, vbufB); NA_PV(2, vbufC); NA_PV(3, vbufD);
#undef NA_PV
#undef NA_VLOAD
    const float inv = __builtin_amdgcn_rcpf(sum);
#pragma unroll
    for (int dt = 0; dt < 4; ++dt) { const f32x4 o = oacc[dt] * inv; v2u w; w.x = cvt_pk_bf16(o[0], o[1]); w.y = cvt_pk_bf16(o[2], o[3]);
        *(v2u*)(ONA + (size_t)qtok * 512 + h * 64 + dt * 16 + quad * 4) = w; }
}

#define XB_TMO      128
#define XB_XCNT(j)  (256  + 64 * (j))
#define XB_XSUB(j)  (1280 + 64 * (j))
#define XB_XGEN(j)  (2304 + 64 * (j))
#define XB_TOP      3328
#define XB_TOPGEN   3392
#define XCD_BAR_WORDS 3456
#define XB_SPIN_CAP (1u << 18)

__device__ __forceinline__ unsigned xb_ld(unsigned* p)              { return __hip_atomic_load(p, __ATOMIC_RELAXED, __HIP_MEMORY_SCOPE_AGENT); }
__device__ __forceinline__ unsigned xb_add(unsigned* p, unsigned v) { return __hip_atomic_fetch_add(p, v, __ATOMIC_RELAXED, __HIP_MEMORY_SCOPE_AGENT); }
__device__ __forceinline__ unsigned xb_xcc_id() { return (unsigned)__builtin_amdgcn_s_getreg((3 << 11) | 20) & 0xFu; }
#define XB_SPIN(cond, bar) do { unsigned _sp = 0; while (cond) { __builtin_amdgcn_s_sleep(1); \
    if ((++_sp & 255u) == 0u) { if (xb_ld(&(bar)[XB_TMO])) break; if (_sp > XB_SPIN_CAP) { atomicAdd(&(bar)[XB_TMO], 1u); break; } } } } while (0)

struct XcdBarrier {
    unsigned* bar; unsigned x;
    volatile LAS unsigned* st;
};

__device__ __forceinline__ XcdBarrier xcd_barrier_post(unsigned* bar, volatile LAS unsigned* st) {
    XcdBarrier b; b.bar = bar; b.x = xb_xcc_id(); b.st = st;
    if (threadIdx.x == 0) (void)xb_add(&bar[XB_XCNT(b.x)], 1u);
    return b;
}
__device__ __forceinline__ void xcd_barrier_complete(unsigned* bar, unsigned x, unsigned& nloc, unsigned& nx) {
    const unsigned G = gridDim.x * gridDim.y * gridDim.z;
    unsigned sum, cnt, mine, sp = 0u;
    for (;;) {
        sum = 0u; cnt = 0u; mine = 0u;
#pragma unroll
        for (unsigned j = 0; j < 16; ++j) { const unsigned c = xb_ld(&bar[XB_XCNT(j)]); sum += c; cnt += (c > 0u) ? 1u : 0u; mine = (j == x) ? c : mine; }
        if (sum == G) break;
        __builtin_amdgcn_s_sleep(1);
        if ((++sp & 255u) == 0u) { if (xb_ld(&bar[XB_TMO])) break; if (sp > XB_SPIN_CAP) { atomicAdd(&bar[XB_TMO], 1u); break; } }
    }
    nloc = mine > 0u ? mine : 1u; nx = cnt > 0u ? cnt : 1u;
}

__device__ __forceinline__ void xcd_barrier(const XcdBarrier& b) {
    asm volatile("s_waitcnt vmcnt(0)" ::: "memory");
    __syncthreads();
    if (threadIdx.x == 0) {
        unsigned* bar = b.bar;
        __builtin_amdgcn_s_waitcnt(0);
        unsigned nloc = b.st[0], nx = b.st[1];
        if (nloc == 0u) { xcd_barrier_complete(bar, b.x, nloc, nx); b.st[0] = nloc; b.st[1] = nx; }
        const unsigned old = xb_add(&bar[XB_XSUB(b.x)], 1u);
        const unsigned gen = old / nloc;
        if (old + 1u == (gen + 1u) * nloc) {
            __builtin_amdgcn_fence(__ATOMIC_RELEASE, "agent");
            asm volatile("s_waitcnt vmcnt(0)" ::: "memory");
            const unsigned og = xb_add(&bar[XB_TOP], 1u);
            const unsigned tg = og / nx;
            if (og + 1u == (tg + 1u) * nx) xb_add(&bar[XB_TOPGEN], 1u);
            else XB_SPIN(xb_ld(&bar[XB_TOPGEN]) == tg, bar);
            __builtin_amdgcn_fence(__ATOMIC_ACQUIRE, "agent");
            xb_add(&bar[XB_XGEN(b.x)], 1u);
            asm volatile("s_waitcnt vmcnt(0)" ::: "memory");
        } else {
            XB_SPIN(xb_ld(&bar[XB_XGEN(b.x)]) == gen, bar);
            __builtin_amdgcn_fence(__ATOMIC_ACQUIRE, "agent");
            asm volatile("s_waitcnt vmcnt(0)" ::: "memory");
        }
    }
    __syncthreads();
}
struct Args { const float* in[20]; float* out; unsigned char* ws; int ph_lo, ph_hi; };
enum { K_CVT = 0, K_G0, K_UP, K_RES, K_M1, K_M2A, K_M2B, K_M3, K_M4, K_GF };

__global__ void __launch_bounds__(NTHR, 2) mk_fwd(Args args) {
    extern __shared__ __attribute__((aligned(16))) unsigned char lds_raw[];
    LAS unsigned char* lds = (LAS unsigned char*)lds_raw;
    cg::grid_group grid = cg::this_grid();
    const int hi = args.ph_hi;
    { volatile LAS unsigned* st0 = (volatile LAS unsigned*)(lds + LDS_MISC + 32); if (threadIdx.x < 2) st0[threadIdx.x] = 0u; __syncthreads(); }
    XcdBarrier xbar = xcd_barrier_post((unsigned*)(args.ws + WS_CTL) + CW_BAR, (volatile LAS unsigned*)(lds + LDS_MISC + 32));
#if TPROBE
    unsigned long long tacc = 0ull;
#endif
    for (int ph = args.ph_lo; ph < hi; ++ph) {
#if TPROBE
        const unsigned long long tp0 = __builtin_amdgcn_s_memrealtime();
#endif
        int bid = blockIdx.x, G = gridDim.x; asm volatile("" : "+s"(bid), "+s"(G));
        int tid = threadIdx.x; asm volatile("" : "+v"(tid));
        const int lane = tid & 63, wave = __builtin_amdgcn_readfirstlane(tid >> 6);
        const int gw = bid * NWAVES + wave, NGW = G * NWAVES;
        int kind, pr = 0, l = 0, s = 0, g2 = 0;
        if (ph == 0) kind = K_CVT;
        else { const int q = ph - 1; pr = q / PH_PER_PAIR; const int r = q % PH_PER_PAIR;
            if (r == 0) kind = K_G0; else if (r == PH_PER_PAIR - 1) kind = K_GF;
            else { l = (r - 1) / 16; s = (r - 1) % 16;
                if (s == 0 || s == 14) kind = K_UP; else if (s == 1 || s == 15) kind = K_RES;
                else { g2 = (s - 2) / 6; const int t = (s - 2) % 6; kind = (t == 0) ? K_M1 : (t == 1) ? K_M2A : (t == 2) ? K_M2B : (t == 3) ? K_M3 : (t == 4) ? K_M4 : K_RES; } } }
        const bool mix = (s >= 2 && s <= 13);
        unsigned char* ws = args.ws;
        bf16* XBp = (bf16*)(ws + WS_XB); float* SSQp = (float*)(ws + WS_SSQ);
        bf16* XB = XBp + (size_t)g2 * TG * D; float* SSQ = SSQp + (size_t)g2 * TG * 16;
        bf16* PA = (bf16*)(ws + WS_PA); bf16* PG = (bf16*)(ws + WS_PG);
        bf16* ONA = (bf16*)(ws + WS_ONA); bf16* OHG = ONA + (size_t)TG * 512; bf16* OCV = OHG + (size_t)TG * 512;
        unsigned char* SCR = ws + WS_SCR;
        const bf16* Wl = (const bf16*)(ws + WS_W) + (size_t)l * LAYER_EL;
        const int T = pr == 0 ? 2048 : 4096;
        const int g = pr * 2 + g2;
        float* X = args.out + (size_t)pr * 2 * TG * D;

        if (kind == K_CVT) {
            LAS float* scr = (LAS float*)(lds + wave * 16384);
            constexpr int I_GU = 16 * 176, I_DN = 44 * 32, I_IN = 16 * 272, I_MX = 8 * 32, I_OUT = 16 * 32;
            constexpr int I_LAYER = 2 * I_GU + 2 * I_DN + I_IN + 3 * I_MX + I_OUT, I_TOT = NLAYER * I_LAYER;
#define CVT_DECODE(it_) const int ll = (it_) / I_LAYER; int r = (it_) % I_LAYER; \
                const float* src; const float* gain = nullptr; int K, N; size_t off; bool perm = false; \
                if (r < I_GU) { src = args.in[3] + (size_t)ll * D * 2 * FF; K = D; N = 2 * FF; off = OFF_GU1; gain = args.in[2] + ll * D; perm = true; } \
                else if ((r -= I_GU) < I_DN) { src = args.in[4] + (size_t)ll * FF * D; K = FF; N = D; off = OFF_D1; } \
                else if ((r -= I_DN) < I_IN) { src = args.in[6] + (size_t)ll * D * 8704; K = D; N = 8704; off = OFF_IN; gain = args.in[5] + ll * D; } \
                else if ((r -= I_IN) < I_MX) { src = args.in[9] + (size_t)ll * 512 * D; K = 512; N = D; off = OFF_HG; } \
                else if ((r -= I_MX) < I_MX) { src = args.in[12] + (size_t)ll * 512 * D; K = 512; N = D; off = OFF_CV; } \
                else if ((r -= I_MX) < I_MX) { src = args.in[14] + (size_t)ll * 512 * D; K = 512; N = D; off = OFF_NA; } \
                else if ((r -= I_MX) < I_OUT) { src = args.in[15] + (size_t)ll * D * D; K = D; N = D; off = OFF_OUT; } \
                else if ((r -= I_OUT) < I_GU) { src = args.in[17] + (size_t)ll * D * 2 * FF; K = D; N = 2 * FF; off = OFF_GU2; gain = args.in[16] + ll * D; perm = true; } \
                else { r -= I_GU; src = args.in[18] + (size_t)ll * FF * D; K = FF; N = D; off = OFF_D2; } \
                const int nblk = N / 32, kb = r / nblk, nb = r % nblk, k0 = 64 * kb, n0 = 32 * nb;
#define CVT_LOAD(it_, wv) do { CVT_DECODE(min((it_), I_TOT - 1)) (void)off; (void)perm; \
                _Pragma("unroll") for (int i = 0; i < 32; ++i) { const int kk = 2 * i + (lane >> 5); wv[i] = src[(size_t)(k0 + kk) * N + n0 + (lane & 31)] * (gain ? gain[k0 + kk] : 1.0f); } } while (0)
#define CVT_PROC(it_, wv) do { CVT_DECODE(it_) (void)src; (void)gain; \
                _Pragma("unroll") for (int i = 0; i < 32; ++i) { const int kk = 2 * i + (lane >> 5); scr[kk * 33 + (lane & 31)] = wv[i]; } \
                asm volatile("s_waitcnt lgkmcnt(0)" ::: "memory"); \
                int dn0 = n0; if (perm) { const int half = n0 >= FF ? 1 : 0; const int j_ = n0 - half * FF; dn0 = (j_ >> 7) * 256 + half * 128 + (j_ & 127); } \
                bf16* WT = (bf16*)(ws + WS_W) + (size_t)ll * LAYER_EL + off; const int c_ = lane & 7; \
                _Pragma("unroll") for (int j = 0; j < 4; ++j) { const int n = (lane >> 3) + 8 * j; const LAS float* sp_ = scr + (8 * c_) * 33 + n; \
                    v4u o; o.x = cvt_pk_bf16(sp_[0 * 33], sp_[1 * 33]); o.y = cvt_pk_bf16(sp_[2 * 33], sp_[3 * 33]); o.z = cvt_pk_bf16(sp_[4 * 33], sp_[5 * 33]); o.w = cvt_pk_bf16(sp_[6 * 33], sp_[7 * 33]); \
                    *(v4u*)(WT + (size_t)(dn0 + n) * K + k0 + 8 * c_) = o; } \
                asm volatile("s_waitcnt lgkmcnt(0)" ::: "memory"); } while (0)
            float wa[32], wb[32];
            int it = gw;
            CVT_LOAD(it, wa);
            while (it < I_TOT) {
                CVT_LOAD(it + NGW, wb);
                CVT_PROC(it, wa);
                it += NGW;
                CVT_LOAD(it + NGW, wa);
                if (it < I_TOT) CVT_PROC(it, wb);
                it += NGW;
            }
#undef CVT_DECODE
#undef CVT_LOAD
#undef CVT_PROC
        } else if (kind == K_G0) {
            const float* xin = pr == 0 ? args.in[0] : args.in[1];
#define G0_LOAD(rowx_, S) do { const int r_ = min((rowx_), 2 * TG - 1); const f32x4* xr_ = (const f32x4*)(xin + (size_t)r_ * D) + lane; \
                _Pragma("unroll") for (int j = 0; j < 4; ++j) gx##S[j] = xr_[64 * j]; } while (0)
#define G0_PROC(rowx_, S) do { const int rw_ = (rowx_); v2u* bo_ = (v2u*)(XBp + (size_t)rw_ * D) + lane; float ss_ = 0.f; \
                _Pragma("unroll") for (int j = 0; j < 4; ++j) { const f32x4 v = gx##S[j]; v2u w_; w_.x = cvt_pk_bf16(v[0], v[1]); w_.y = cvt_pk_bf16(v[2], v[3]); bo_[64 * j] = w_; ss_ += (v[0] * v[0] + v[1] * v[1]) + (v[2] * v[2] + v[3] * v[3]); } \
                ss_ = wave_sum(ss_); if (lane < 16) SSQp[(size_t)rw_ * 16 + lane] = lane == 0 ? ss_ : 0.f; } while (0)
            f32x4 gxA[4], gxB[4];
            { int rowi = gw;
              G0_LOAD(rowi, A);
              while (rowi < 2 * TG) {
                  G0_LOAD(rowi + NGW, B); G0_PROC(rowi, A); rowi += NGW;
                  G0_LOAD(rowi + NGW, A); if (rowi < 2 * TG) G0_PROC(rowi, B); rowi += NGW;
              } }
#undef G0_LOAD
#undef G0_PROC
        } else if (kind == K_UP) {
            pg8::Gemm gm{XBp, Wl + (s == 14 ? OFF_GU2 : OFF_GU1), 2 * TG, 2 * FF, D}; pg8::StaticOrder S; S.init(2 * TG, 2 * FF, G, bid);
            LAS float* rst = (LAS float*)(lds + 131072); LAS int* pml = (LAS int*)(lds + 131072 + 12288);
            __syncthreads();
            if (tid == 0) { int n = 0; pg8::Unit uu;
                for (int i = 0; S.next(i, uu); ++i) { bool f = false; for (int q = 0; q < n; ++q) f = f || (pml[q] == uu.pm); if (!f && n < 12) pml[n++] = uu.pm; }
                pml[15] = n; }
            __syncthreads();
            { const int n = pml[15];
              for (int idx = tid; idx < n * 256; idx += NTHR) { const int row = pml[idx >> 8] * 256 + (idx & 255); rst[idx] = pg8::row_rs(SSQp, row); } }
            __syncthreads();
            pg8::EpiSwiGLU E{PA, rst, pml, SSQp};
#ifndef NO_UP
            for (int rep = 0; rep < REP_GEMM; ++rep) pg8::gemm_phase<pg8::EpiSwiGLU, pg8::StaticOrder, PGA, PGS>(lds, gm, S, E);
#endif
        } else if (kind == K_RES) {
            const int K = mix ? D : FF, Mr = mix ? TG : 2 * TG; const size_t off = mix ? OFF_OUT : (s == 1 ? OFF_D1 : OFF_D2);
            pg8::Gemm gm{PA, Wl + off, Mr, D, K}; pg8::StaticOrder S; S.init(Mr, D, G, bid);
            pg8::EpiRes E{mix ? XB : XBp, mix ? SSQ : SSQp, mix ? 1.0f : 0.5f};
#ifndef NO_RES
            for (int rep = 0; rep < REP_RES; ++rep) { if (rep + 1 < REP_RES) { pg8::EpiRes E0 = E; E0.alpha = 0.f; pg8::gemm_phase<pg8::EpiRes, pg8::StaticOrder, PGA, PGS>(lds, gm, S, E0); }
                else pg8::gemm_phase<pg8::EpiRes, pg8::StaticOrder, PGA, PGS>(lds, gm, S, E); }
#endif
        } else if (kind == K_M1) {
            pg8::Gemm gm{XBp, Wl + OFF_IN, 2 * TG, 8704, D}; pg8::M1Order S; S.init(G, bid, g2);
            LAS float* rst = (LAS float*)(lds + 131072); LAS int* pml = (LAS int*)(lds + 131072 + 12288);
            __syncthreads();
            if (tid == 0) { int n = 0; pg8::Unit uu;
                for (int i = 0; S.next(i, uu); ++i) { bool f = false; for (int q = 0; q < n; ++q) f = f || (pml[q] == uu.pm); if (!f && n < 12) pml[n++] = uu.pm; }
                pml[15] = n; }
            __syncthreads();
            { const int n = pml[15];
              for (int idx = tid; idx < n * 256; idx += NTHR) { const int row = pml[idx >> 8] * 256 + (idx & 255); rst[idx] = pg8::row_rs(SSQp, row); } }
            __syncthreads();
            pg8::EpiProj E{PA, (unsigned char*)PG, (unsigned char*)PG + (size_t)TG * 3072, rst, pml, SSQp};
#ifndef NO_PROJ
            for (int rep = 0; rep < REP_GEMM; ++rep) pg8::gemm_phase<pg8::EpiProj, pg8::M1Order, PGA, PGS>(lds, gm, S, E);
#endif
        } else if (kind == K_M2A) {
#ifndef NO_HG
            { const int nP = (TG / 64) * 8;
              if (G == 256) { const int vcu1 = (bid % 8) * 32 + bid / 8; for (int rep = 0; rep < REP_HG; ++rep) hg_prep_items(lds, PA, SCR, args.in[7], l, vcu1 * (nP / 256), 1, (vcu1 + 1) * (nP / 256), T, tid); }
              else { for (int rep = 0; rep < REP_HG; ++rep) if (bid < nP) hg_prep_items(lds, PA, SCR, args.in[7], l, bid, G, nP, T, tid); } }
#endif
            const float* rpb = args.in[13] + (size_t)l * 8 * 465;
            const int vcu = (G % 8 == 0) ? (bid % 8) * (G / 8) + bid / 8 : bid;
            const int nNA = TG / 16, ipb = (nNA + G - 1) / G;
            for (int rep = 0; rep < REP_NA; ++rep)
                for (int q = 0; q < ipb; ++q) { const int it = vcu * ipb + q; if (it < nNA) {
#ifndef NO_NA
                    na_item(lds, PA, rpb, ONA, it, T, tid);
#endif
                    __syncthreads(); } }
        } else if (kind == K_M2B) {
#ifndef NO_HG
            const int vcu2 = (G % 8 == 0) ? (bid % 8) * (G / 8) + bid / 8 : bid;
            for (int rep = 0; rep < REP_HG; ++rep) {
                if (pr == 0) { for (int it = vcu2; it < 256; it += G) hg_scan_item<2>(lds, PA, SCR, it, T, tid); }
                else       { for (int it = vcu2; it < 256; it += G) hg_scan_item<1>(lds, PA, SCR, it, T, tid); }
            }
#endif
        } else if (kind == K_M3) {
            const float* gno = args.in[8] + l * 512; const float* cw = args.in[10] + l * 3 * 512; const float* cbias = args.in[11] + l * 512;
            const int c0 = lane * 8;
            const bf16* __restrict__ PAr = PA; bf16* __restrict__ OHGr = OHG; bf16* __restrict__ OCVr = OCV;
            const f32x4 gn0 = *(const f32x4*)(gno + c0), gn1 = *(const f32x4*)(gno + c0 + 4);
            const f32x4 w00 = *(const f32x4*)(cw + c0), w01 = *(const f32x4*)(cw + c0 + 4), w10 = *(const f32x4*)(cw + 512 + c0), w11 = *(const f32x4*)(cw + 512 + c0 + 4);
            const f32x4 w20 = *(const f32x4*)(cw + 1024 + c0), w21 = *(const f32x4*)(cw + 1024 + c0 + 4), bs0 = *(const f32x4*)(cbias + c0), bs1 = *(const f32x4*)(cbias + c0 + 4);
#define M3_DECL(S) v4u fw##S, bw##S, hg##S, a1##S, c1##S, bb##S, a0##S, q0##S, a2##S, q2##S
#define M3_LOAD(row_, S) do { const int r_ = min((row_), TG - 1); const bf16* pr_ = PAr + (size_t)r_ * PA_LD + c0; \
                const bf16* pm_ = PAr + (size_t)max(r_ - 1, 0) * PA_LD + c0; const bf16* pp_ = PAr + (size_t)min(r_ + 1, TG - 1) * PA_LD + c0; \
                fw##S = *(const v4u*)(pr_ + C_HQ); bw##S = *(const v4u*)(pr_ + C_HZF); hg##S = *(const v4u*)(pr_ + C_HG); \
                a1##S = *(const v4u*)(pr_ + C_CA); c1##S = *(const v4u*)(pr_ + C_CC); bb##S = *(const v4u*)(pr_ + C_CB); \
                a0##S = *(const v4u*)(pm_ + C_CA); q0##S = *(const v4u*)(pm_ + C_CC); a2##S = *(const v4u*)(pp_ + C_CA); q2##S = *(const v4u*)(pp_ + C_CC); } while (0)
#define M3_MUL8(A, B) {bflo(A.x) * bflo(B.x), bfhi(A.x) * bfhi(B.x), bflo(A.y) * bflo(B.y), bfhi(A.y) * bfhi(B.y), bflo(A.z) * bflo(B.z), bfhi(A.z) * bfhi(B.z), bflo(A.w) * bflo(B.w), bfhi(A.w) * bfhi(B.w)}
#define M3_PROC(row_, S) do { const int rw_ = (row_);     \
                float o[8] = {bflo(fw##S.x) + bflo(bw##S.x), bfhi(fw##S.x) + bfhi(bw##S.x), bflo(fw##S.y) + bflo(bw##S.y), bfhi(fw##S.y) + bfhi(bw##S.y), bflo(fw##S.z) + bflo(bw##S.z), bfhi(fw##S.z) + bfhi(bw##S.z), bflo(fw##S.w) + bflo(bw##S.w), bfhi(fw##S.w) + bfhi(bw##S.w)}; \
                float ss = 0.f; \
                _Pragma("unroll") for (int e = 0; e < 8; ++e) ss += o[e] * o[e]; \
                ss += __shfl_xor(ss, 1); ss += __shfl_xor(ss, 2); ss += __shfl_xor(ss, 4); ss += __shfl_xor(ss, 8); \
                const float rs = __builtin_amdgcn_rsqf(ss * (1.0f / 128.0f) + 1e-6f); \
                const float hgv[8] = {bflo(hg##S.x), bfhi(hg##S.x), bflo(hg##S.y), bfhi(hg##S.y), bflo(hg##S.z), bfhi(hg##S.z), bflo(hg##S.w), bfhi(hg##S.w)}; \
                const float gn[8] = {gn0[0], gn0[1], gn0[2], gn0[3], gn1[0], gn1[1], gn1[2], gn1[3]}; \
                float r8[8]; \
                _Pragma("unroll") for (int e = 0; e < 8; ++e) r8[e] = o[e] * rs * gn[e] * (hgv[e] * sigm(hgv[e])); \
                v4u wo; wo.x = cvt_pk_bf16(r8[0], r8[1]); wo.y = cvt_pk_bf16(r8[2], r8[3]); wo.z = cvt_pk_bf16(r8[4], r8[5]); wo.w = cvt_pk_bf16(r8[6], r8[7]); \
                *(v4u*)(OHGr + (size_t)rw_ * 512 + c0) = wo; \
                const int tl = rw_ & (T - 1); const float m0 = tl > 0 ? 1.f : 0.f, m2 = tl < T - 1 ? 1.f : 0.f; \
                const float zm[8] = M3_MUL8(a0##S, q0##S); const float zc[8] = M3_MUL8(a1##S, c1##S); const float zp[8] = M3_MUL8(a2##S, q2##S); \
                const float cbv[8] = {bflo(bb##S.x), bfhi(bb##S.x), bflo(bb##S.y), bfhi(bb##S.y), bflo(bb##S.z), bfhi(bb##S.z), bflo(bb##S.w), bfhi(bb##S.w)}; \
                _Pragma("unroll") for (int e = 0; e < 4; ++e) { r8[e] = cbv[e] * (w00[e] * (m0 * zm[e]) + w10[e] * zc[e] + w20[e] * (m2 * zp[e]) + bs0[e]); \
                    r8[4 + e] = cbv[4 + e] * (w01[e] * (m0 * zm[4 + e]) + w11[e] * zc[4 + e] + w21[e] * (m2 * zp[4 + e]) + bs1[e]); } \
                wo.x = cvt_pk_bf16(r8[0], r8[1]); wo.y = cvt_pk_bf16(r8[2], r8[3]); wo.z = cvt_pk_bf16(r8[4], r8[5]); wo.w = cvt_pk_bf16(r8[6], r8[7]); \
                *(v4u*)(OCVr + (size_t)rw_ * 512 + c0) = wo; } while (0)
            M3_DECL(A); M3_DECL(B);
            { int row = gw;
              M3_LOAD(row, A);
              while (row < TG) {
                  M3_LOAD(row + NGW, B);
                  M3_PROC(row, A);
                  row += NGW;
                  M3_LOAD(row + NGW, A);
                  if (row < TG) M3_PROC(row, B);
                  row += NGW;
              } }
#undef M3_DECL
#undef M3_LOAD
#undef M3_MUL8
#undef M3_PROC
        } else if (kind == K_M4) {
            pg8::Gemm gm{ONA, Wl + OFF_HG, 3 * TG, 3 * D, 512}; pg8::MergeOrder S; S.init(TG, D, G, bid);
            pg8::EpiMerge E{(const unsigned char*)PG + (size_t)g2 * TG * 3072, PA};
#ifndef NO_MERGE
            for (int rep = 0; rep < REP_MERGE; ++rep) pg8::gemm_phase<pg8::EpiMerge, pg8::MergeOrder, PGA, PGS>(lds, gm, S, E);
#endif
        } else {
            const f32x4* fgp = (const f32x4*)args.in[19] + lane;
            const f32x4 fg0 = fgp[0], fg1 = fgp[64], fg2 = fgp[128], fg3 = fgp[192];
#define GF_LOAD(rowx_, S) do { const int r_ = min((rowx_), 2 * TG - 1); const v2u* bi_ = (const v2u*)(XBp + (size_t)r_ * D) + lane; const f32x4* sq_ = (const f32x4*)(SSQp + (size_t)r_ * 16); \
                _Pragma("unroll") for (int j = 0; j < 4; ++j) { fb##S[j] = bi_[64 * j]; fs##S[j] = sq_[j]; } } while (0)
#define GF_PROC(rowx_, S) do { const int rw_ = (rowx_); float t_ = 0.f; \
                _Pragma("unroll") for (int j = 0; j < 4; ++j) t_ += (fs##S[j][0] + fs##S[j][1]) + (fs##S[j][2] + fs##S[j][3]); \
                const float rs_ = __builtin_amdgcn_rsqf(t_ * (1.0f / 1024.0f) + 1e-6f); f32x4* xo_ = (f32x4*)(X + (size_t)rw_ * D) + lane; \
                { const v2u w_ = fb##S[0]; const f32x4 v = {bflo(w_.x), bfhi(w_.x), bflo(w_.y), bfhi(w_.y)}; xo_[0] = v * fg0 * rs_; } \
                { const v2u w_ = fb##S[1]; const f32x4 v = {bflo(w_.x), bfhi(w_.x), bflo(w_.y), bfhi(w_.y)}; xo_[64] = v * fg1 * rs_; } \
                { const v2u w_ = fb##S[2]; const f32x4 v = {bflo(w_.x), bfhi(w_.x), bflo(w_.y), bfhi(w_.y)}; xo_[128] = v * fg2 * rs_; } \
                { const v2u w_ = fb##S[3]; const f32x4 v = {bflo(w_.x), bfhi(w_.x), bflo(w_.y), bfhi(w_.y)}; xo_[192] = v * fg3 * rs_; } } while (0)
            v2u fbA[4], fbB[4]; f32x4 fsA[4], fsB[4];
            { int rowi = gw;
              GF_LOAD(rowi, A);
              while (rowi < 2 * TG) {
                  GF_LOAD(rowi + NGW, B); GF_PROC(rowi, A); rowi += NGW;
                  GF_LOAD(rowi + NGW, A); if (rowi < 2 * TG) GF_PROC(rowi, B); rowi += NGW;
              } }
#undef GF_LOAD
#undef GF_PROC
        }
#if TPROBE
        __syncthreads();
        const unsigned long long tp1 = __builtin_amdgcn_s_memrealtime();
#endif
        if (ph + 1 < hi) { for (int rep = 0; rep < REP_SYNC; ++rep) { if (hi < 0) grid.sync(); else xcd_barrier(xbar);     } }
#if TPROBE
        const unsigned long long tp2 = __builtin_amdgcn_s_memrealtime();
        if (TPROBE == 100) tacc += tp2 - tp1;
        else if (kind == TPROBE - 1) tacc += tp1 - tp0;
#endif
    }
#if TPROBE
    if (blockIdx.x == TPROBE_BLOCK) { const unsigned long long te = __builtin_amdgcn_s_memrealtime(); while (__builtin_amdgcn_s_memrealtime() - te < tacc) __builtin_amdgcn_s_sleep(8); }
#endif
}
constexpr int N_PHASES = 1 + 2 * PH_PER_PAIR;

extern "C" void kernel_launch(void* const* d_in, const int* in_sizes, int n_in, void* d_out, int out_size, void* d_ws, size_t ws_size, hipStream_t stream) {
    static int grid = 0;
    if (grid == 0) {
        if (n_in != 20 || ws_size < WS_END) { fprintf(stderr, "kernel_launch: unexpected n_in %d / ws %zu\n", n_in, ws_size); grid = -1; return; }
        int dev = 0, cus = 0, per_cu = 0;
        hipGetDevice(&dev); hipDeviceGetAttribute(&cus, hipDeviceAttributeMultiprocessorCount, dev);
        hipFuncSetAttribute((const void*)mk_fwd, hipFuncAttributeMaxDynamicSharedMemorySize, LDS_BYTES);
        hipOccupancyMaxActiveBlocksPerMultiprocessor(&per_cu, (const void*)mk_fwd, NTHR, LDS_BYTES);
        if (per_cu < 1) per_cu = 1;
        grid = cus * per_cu;
        (void)hipGetLastError();
    }
    if (grid < 0) return;
    hipMemsetAsync((char*)d_ws + WS_CTL, 0, CTL_BYTES, stream);
    Args a{};
    for (int i = 0; i < 20; ++i) a.in[i] = (const float*)d_in[i];
    a.out = (float*)d_out; a.ws = (unsigned char*)d_ws;
#if ONE_LAUNCH
    a.ph_lo = 0; a.ph_hi = N_PHASES;
    void* kargs[] = {&a};
    hipError_t e = hipLaunchCooperativeKernel((const void*)mk_fwd, dim3(grid), dim3(NTHR), kargs, LDS_BYTES, stream);
    if (e != hipSuccess) fprintf(stderr, "cooperative launch failed: %s (grid %d)\n", hipGetErrorString(e), grid);
#else
    for (int p = 0; p < N_PHASES; ++p) { a.ph_lo = p; a.ph_hi = p + 1; hipLaunchKernelGGL(mk_fwd, dim3(grid), dim3(NTHR), LDS_BYTES, stream, a); }
#endif
}
```

```cpp
#include <hip/hip_runtime.h>
#include <hip/hip_cooperative_groups.h>
#include <cstdio>
#include <cstdint>
namespace cg = cooperative_groups;
#ifndef ONE_LAUNCH
#define ONE_LAUNCH 1
#endif
#ifndef REP_HG
#define REP_HG 1
#endif
#ifndef REP_NA
#define REP_NA 1
#endif
#ifndef REP_SYNC
#define REP_SYNC 1
#endif
#ifndef REP_GEMM
#define REP_GEMM 1
#endif
#ifndef REP_M3
#define REP_M3 1
#endif
#ifndef REP_RES
#define REP_RES 1
#endif
#ifndef REP_MERGE
#define REP_MERGE 1
#endif
#ifndef REP_MISC
#define REP_MISC 1
#endif
#ifndef TPROBE
#define TPROBE 0
#endif
#ifndef TPROBE_BLOCK
#define TPROBE_BLOCK 0
#endif
#ifndef PGA
#define PGA true
#endif
#ifndef PGS
#define PGS true
#endif
#ifndef RS_PROBE
#define RS_PROBE 0
#endif
namespace pg8 {
#define PG8_LAS __attribute__((address_space(3)))
typedef unsigned short bf16_t;
typedef short bf16x8 __attribute__((ext_vector_type(8)));
typedef float f32x4 __attribute__((ext_vector_type(4)));
typedef unsigned u32x4 __attribute__((ext_vector_type(4)));
constexpr int BM = 256, BK = 64, HALF = 128, HTB = HALF * BK * 2  , STAGE_BYTES = 8 * HTB, NXCD = 8, WGM = 8;

__host__ __device__ __forceinline__ int lds_byte(int r, int c) { const int st = (r >> 4) * 2 + (c >> 5), rr = r & 15, cc = c & 31, ob = rr * 64 + cc * 2; return st * 1024 + (ob ^ (((ob >> 9) & 1) << 5)); }
__host__ __device__ __forceinline__ void stage_rc(int b, int& R, int& C) { const int st = b / 1024, sb = b % 1024, swz = sb ^ (((sb >> 9) & 1) << 5); R = (st >> 1) * 16 + swz / 64; C = (st & 1) * 32 + (swz % 64) / 2; }
__host__ __device__ __forceinline__ int perm32(int rho) { const int n = rho >> 4, i = rho & 15; return 8 * (i >> 2) + 4 * n + (i & 3); }

struct Unit { int pm, pn; };
struct Gemm { const bf16_t* A; const bf16_t* Bt; int M, N, K; };

struct StaticOrder {
    int nM, nN, nwg, G, c;
    __host__ __device__ void init(int M, int N, int G_, int c_) { nM = M / BM; nN = N / BM; nwg = nM * nN; G = G_; c = c_; }
    __host__ __device__ bool next(int i, Unit& u) const {
        const long L = (long)i * G + c; if (L >= nwg) return false;
        int wgid = (int)L; { const int q = nwg / NXCD, r = nwg % NXCD, xcd = wgid % NXCD, off = wgid / NXCD; wgid = (xcd < r ? xcd * (q + 1) : r * (q + 1) + (xcd - r) * q) + off; }
        const int nig = WGM * nN, gid = wgid / nig, fm = gid * WGM, gsz = (nM - fm) < WGM ? (nM - fm) : WGM;
        u.pm = fm + ((wgid % nig) % gsz); u.pn = (wgid % nig) / gsz; return true;
    }
    __device__ __forceinline__ void a_ready(const Unit&) const {}
    __device__ __forceinline__ void done(const Unit&) const {}
};

__device__ __forceinline__ unsigned cvt_pk_bf16(float lo, float hi) { unsigned r; asm volatile("v_cvt_pk_bf16_f32 %0, %1, %2" : "=v"(r) : "v"(lo), "v"(hi)); return r; }
__device__ __forceinline__ float row_rs(const float* ssq, int row) {
    const f32x4* p = (const f32x4*)(ssq + (size_t)row * 16);
    const f32x4 a = p[0], b = p[1], c = p[2], d = p[3];
    const float s = (((a[0] + a[1]) + (a[2] + a[3])) + ((b[0] + b[1]) + (b[2] + b[3]))) + (((c[0] + c[1]) + (c[2] + c[3])) + ((d[0] + d[1]) + (d[2] + d[3])));
    return __builtin_amdgcn_rsqf(s * (1.0f / 1024.0f) + 1e-6f);
}
__device__ __forceinline__ void row_rs8_impl(const float* ssq, int row0, float (&rsv)[8]) {
#pragma unroll
    for (int ai = 0; ai < 2; ++ai) {
        f32x4 p[4][4];
#pragma unroll
        for (int m = 0; m < 4; ++m) { const f32x4* q = (const f32x4*)(ssq + (size_t)(row0 + ai * HALF + m * 16) * 16);
#pragma unroll
            for (int j = 0; j < 4; ++j) p[m][j] = q[j]; }
#pragma unroll
        for (int m = 0; m < 4; ++m) { float t = 0.f;
#pragma unroll
            for (int j = 0; j < 4; ++j) t += (p[m][j][0] + p[m][j][1]) + (p[m][j][2] + p[m][j][3]);
            rsv[ai * 4 + m] = __builtin_amdgcn_rsqf(t * (1.0f / 1024.0f) + 1e-6f); }
    }
}
__device__ __forceinline__ void row_rs8(const float* ssq, int row0, float (&rsv)[8]) {
#if RS_PROBE
    { const float* ssq2 = ssq; asm volatile("" : "+s"(ssq2)); float t2[8]; row_rs8_impl(ssq2, row0, t2); row_rs8_impl(ssq, row0, rsv);
#pragma unroll
      for (int i = 0; i < 8; ++i) rsv[i] = 0.5f * (rsv[i] + t2[i]); return; }
#endif
    row_rs8_impl(ssq, row0, rsv);
}
__device__ __forceinline__ void row_rs8_lds(const PG8_LAS float* rst, const PG8_LAS int* pml, const float* ssq, int pm, int wr, int fr, float (&rsv)[8]) {
    const int n = pml[15]; int slot = -1;
#pragma unroll
    for (int s_ = 0; s_ < 12; ++s_) if (s_ < n && pml[s_] == pm) slot = s_;
    if (slot < 0) { row_rs8(ssq, pm * BM + wr * 64 + fr, rsv); return; }
    const PG8_LAS float* t = rst + slot * 256 + wr * 64 + fr;
#pragma unroll
    for (int ai = 0; ai < 2; ++ai)
#pragma unroll
        for (int m = 0; m < 4; ++m) rsv[ai * 4 + m] = t[ai * HALF + m * 16];
}
__device__ __forceinline__ float sigm(float v) { return __builtin_amdgcn_rcpf(1.0f + __expf(-v)); }

struct EpiSwiGLU {
    static constexpr bool PERM = true, AFTER_DRAIN = false, CARRY = false;
    bf16_t* H; const PG8_LAS float* rst; const PG8_LAS int* pml; const float* ssq;
    __device__ __forceinline__ void operator()(const f32x4 (&acc)[2][2][4][2], const Unit& u, int wr, int wc, int fr, int fq) const {
        const int row0 = u.pm * BM + wr * 64 + fr, col0 = u.pn * 128 + wc * 32 + 8 * fq;
        float rsv[8]; row_rs8_lds(rst, pml, ssq, u.pm, wr, fr, rsv);
#pragma unroll
        for (int ai = 0; ai < 2; ++ai)
#pragma unroll
            for (int m = 0; m < 4; ++m) {
                const int row = row0 + ai * HALF + m * 16; const float rs = rsv[ai * 4 + m];
                const float c1 = rs * -1.4426950408889634f, rs2 = rs * rs;
                u32x4 w;
#pragma unroll
                for (int n = 0; n < 2; ++n) {
                    const f32x4 na = acc[ai][0][m][n] * c1, p = acc[ai][0][m][n] * acc[ai][1][m][n]; f32x4 d;
#pragma unroll
                    for (int e = 0; e < 4; ++e) d[e] = __builtin_amdgcn_rcpf(1.0f + __builtin_amdgcn_exp2f(na[e]));
                    const f32x4 h = p * (d * rs2);
                    w[2 * n] = cvt_pk_bf16(h[0], h[1]); w[2 * n + 1] = cvt_pk_bf16(h[2], h[3]);
                }
                *(u32x4*)(H + (size_t)row * 2816 + col0) = w;
            }
    }
};
__device__ __forceinline__ void unpack8(const u32x4 w, f32x4& lo, f32x4& hi) {
    lo[0] = __uint_as_float(w.x << 16); lo[1] = __uint_as_float(w.x & 0xffff0000u); lo[2] = __uint_as_float(w.y << 16); lo[3] = __uint_as_float(w.y & 0xffff0000u);
    hi[0] = __uint_as_float(w.z << 16); hi[1] = __uint_as_float(w.z & 0xffff0000u); hi[2] = __uint_as_float(w.w << 16); hi[3] = __uint_as_float(w.w & 0xffff0000u);
}
struct EpiRes {
    static constexpr bool PERM = true, AFTER_DRAIN = false, CARRY = false;
    bf16_t* XB; float* ssq; float alpha;
    __device__ __forceinline__ void operator()(const f32x4 (&acc)[2][2][4][2], const Unit& u, int wr, int wc, int fr, int fq) const {
        const int row0 = u.pm * BM + wr * 64 + fr, col0 = u.pn * BM + wc * 32 + 8 * fq;
#pragma unroll
        for (int ai = 0; ai < 2; ++ai) {
            u32x4 xin[4][2];
#pragma unroll
            for (int m = 0; m < 4; ++m)
#pragma unroll
                for (int bj = 0; bj < 2; ++bj) xin[m][bj] = *(const u32x4*)(XB + (size_t)(row0 + ai * HALF + m * 16) * 1024 + col0 + bj * HALF);
#pragma unroll
            for (int m = 0; m < 4; ++m) {
                const int row = row0 + ai * HALF + m * 16; float ss = 0.f;
#pragma unroll
                for (int bj = 0; bj < 2; ++bj) {
                    bf16_t* xp = XB + (size_t)row * 1024 + col0 + bj * HALF;
                    f32x4 x0, x1; unpack8(xin[m][bj], x0, x1);
                    x0 = x0 + acc[ai][bj][m][0] * alpha; x1 = x1 + acc[ai][bj][m][1] * alpha;
                    u32x4 w; w.x = cvt_pk_bf16(x0[0], x0[1]); w.y = cvt_pk_bf16(x0[2], x0[3]); w.z = cvt_pk_bf16(x1[0], x1[1]); w.w = cvt_pk_bf16(x1[2], x1[3]);
                    *(u32x4*)xp = w;
                    ss += ((x0[0] * x0[0] + x0[1] * x0[1]) + (x0[2] * x0[2] + x0[3] * x0[3])) + ((x1[0] * x1[0] + x1[1] * x1[1]) + (x1[2] * x1[2] + x1[3] * x1[3]));
                }
                ss += __shfl_xor(ss, 16); ss += __shfl_xor(ss, 32);
                if (fq == 0) ssq[(size_t)row * 16 + u.pn * 4 + wc] = ss;
            }
            asm volatile("" ::: "memory");
        }
    }
};
struct M1Order {
    StaticOrder so; int second, G, c;
    __device__ void init(int G_, int c_, int second_) { second = second_; G = G_; c = c_; so.init(16384, second_ ? 8192 : 8704, G_, c_); }
    __device__ bool next(int i, Unit& u) const {
        if (!second) { if (so.next(i, u)) return true;
            const long L = (long)i * G + c - 2176; if (L < 0 || L >= 128) return false; u.pm = 64 + (int)(L >> 1); u.pn = 22 + (int)(L & 1); return true; }
        Unit b; if (!so.next(i, b)) return false; u.pm = b.pm + 64; u.pn = b.pn < 22 ? b.pn : b.pn + 2; return true;
    }
    __device__ __forceinline__ void a_ready(const Unit&) const {}
    __device__ __forceinline__ void done(const Unit&) const {}
};
struct EpiProj {
    static constexpr bool PERM = true, AFTER_DRAIN = false, CARRY = false;
    bf16_t* PA; unsigned char* PGa; unsigned char* PGb; const PG8_LAS float* rst; const PG8_LAS int* pml; const float* ssq;
    __device__ __forceinline__ void operator()(const f32x4 (&acc)[2][2][4][2], const Unit& u, int wr, int wc, int fr, int fq) const {
        unsigned char* PG8 = u.pm < 64 ? PGa : PGb;
        const int prow0 = u.pm * BM + wr * 64 + fr, row0 = prow0 & 16383;
        float rsv[8]; row_rs8_lds(rst, pml, ssq, u.pm, wr, fr, rsv);
        if (u.pn < 22) {
            const int col0 = u.pn * BM + wc * 32 + 8 * fq;
#pragma unroll
            for (int ai = 0; ai < 2; ++ai)
#pragma unroll
                for (int m = 0; m < 4; ++m) {
                    const int row = row0 + ai * HALF + m * 16; const float rs = rsv[ai * 4 + m];
#pragma unroll
                    for (int bj = 0; bj < 2; ++bj) {
                        const f32x4 v0 = acc[ai][bj][m][0] * rs, v1 = acc[ai][bj][m][1] * rs;
                        u32x4 w; w.x = cvt_pk_bf16(v0[0], v0[1]); w.y = cvt_pk_bf16(v0[2], v0[3]); w.z = cvt_pk_bf16(v1[0], v1[1]); w.w = cvt_pk_bf16(v1[2], v1[3]);
                        *(u32x4*)(PA + (size_t)row * 5632 + col0 + bj * HALF) = w;
                    }
                }
        } else {
            const int col0 = (u.pn - 22) * BM + wc * 32 + 8 * fq;
#pragma unroll
            for (int ai = 0; ai < 2; ++ai)
#pragma unroll
                for (int m = 0; m < 4; ++m) {
                    const int row = row0 + ai * HALF + m * 16; const float c1 = rsv[ai * 4 + m] * -1.4426950408889634f;
#pragma unroll
                    for (int bj = 0; bj < 2; ++bj) {
                        unsigned q[8];
#pragma unroll
                        for (int e = 0; e < 4; ++e) { q[e] = (unsigned)(__builtin_amdgcn_rcpf(1.0f + __builtin_amdgcn_exp2f(acc[ai][bj][m][0][e] * c1)) * 255.0f + 0.5f); q[4 + e] = (unsigned)(__builtin_amdgcn_rcpf(1.0f + __builtin_amdgcn_exp2f(acc[ai][bj][m][1][e] * c1)) * 255.0f + 0.5f); }
                        typedef unsigned u32x2_ __attribute__((ext_vector_type(2)));
                        u32x2_ w; w.x = q[0] | (q[1] << 8) | (q[2] << 16) | (q[3] << 24); w.y = q[4] | (q[5] << 8) | (q[6] << 16) | (q[7] << 24);
                        *(u32x2_*)(PG8 + (size_t)row * 3072 + col0 + bj * HALF) = w;
                    }
                }
        }
    }
};
struct MergeOrder {
    StaticOrder so;
    __device__ void init(int M, int N, int G_, int c_) { so.init(M, N, G_, c_); }
    __device__ bool next(int i, Unit& u) const { Unit b; if (!so.next(i / 3, b)) return false; const int m = i % 3, w = (m == 0) ? 2 : m - 1; u.pm = b.pm + 64 * m; u.pn = b.pn + 4 * w; return true; }
    __device__ __forceinline__ void a_ready(const Unit&) const {}
    __device__ __forceinline__ void done(const Unit&) const {}
};
struct EpiMerge {
    static constexpr bool PERM = true, AFTER_DRAIN = false, CARRY = true;
    const unsigned char* PG8; bf16_t* MB;
    __device__ __forceinline__ void operator()(const f32x4 (&)[2][2][4][2], const Unit&, int, int, int, int) const {}
    __device__ __forceinline__ bool carry(f32x4 (&acc)[2][2][4][2], const Unit& u, int wr, int wc, int fr, int fq) const {
        typedef unsigned u32x2_ __attribute__((ext_vector_type(2)));
        const int m_ = u.pm >> 6, pm = u.pm & 63, w_ = u.pn >> 2, pn = u.pn & 3;
        const int wn = (m_ == 0) ? 0 : 1;
        const bool last = (m_ == 2);
        const int row0 = pm * BM + wr * 64 + fr, col0 = pn * BM + wc * 32 + 8 * fq;
#pragma unroll
        for (int ai = 0; ai < 2; ++ai) {
            u32x2_ gc[4][2], gn[4][2];
#pragma unroll
            for (int m = 0; m < 4; ++m)
#pragma unroll
                for (int bj = 0; bj < 2; ++bj) { const size_t o = (size_t)(row0 + ai * HALF + m * 16) * 3072 + col0 + bj * HALF;
                    gc[m][bj] = *(const u32x2_*)(PG8 + o + w_ * 1024);
                    gn[m][bj] = last ? (u32x2_){0x01010101u, 0x01010101u} : *(const u32x2_*)(PG8 + o + wn * 1024); }
#pragma unroll
            for (int m = 0; m < 4; ++m)
#pragma unroll
                for (int bj = 0; bj < 2; ++bj) {
                    float f[8];
#pragma unroll
                    for (int e = 0; e < 8; ++e) { const unsigned wc_ = e < 4 ? gc[m][bj].x : gc[m][bj].y, wn_ = e < 4 ? gn[m][bj].x : gn[m][bj].y; const int sh = 8 * (e & 3);
                        const float qc = (float)max((wc_ >> sh) & 255u, 1u), qn = (float)max((wn_ >> sh) & 255u, 1u);
                        f[e] = last ? qc * (1.0f / 255.0f) : qc * __builtin_amdgcn_rcpf(qn); }
#pragma unroll
                    for (int e = 0; e < 4; ++e) { acc[ai][bj][m][0][e] *= f[e]; acc[ai][bj][m][1][e] *= f[4 + e]; }
                    if (last) { const f32x4 t0 = acc[ai][bj][m][0], t1 = acc[ai][bj][m][1];
                        u32x4 w; w.x = cvt_pk_bf16(t0[0], t0[1]); w.y = cvt_pk_bf16(t0[2], t0[3]); w.z = cvt_pk_bf16(t1[0], t1[1]); w.w = cvt_pk_bf16(t1[2], t1[3]);
                        *(u32x4*)(MB + (size_t)(row0 + ai * HALF + m * 16) * 1024 + col0 + bj * HALF) = w; }
                }
            asm volatile("" ::: "memory");
        }
        return !last;
    }
};
template <class Epi, class Sched, bool ALIGN_EPI = false, bool SP2 = false>
__device__ __forceinline__ void gemm_phase(PG8_LAS unsigned char* lds, const Gemm g, const Sched& S, const Epi& E) {
    int tid = threadIdx.x; asm volatile("" : "+v"(tid));
    const int wid = __builtin_amdgcn_readfirstlane(tid >> 6), lane = tid & 63, wr = wid >> 2, wc = wid & 3, fr = lane & 15, fq = lane >> 4;
    const int K = g.K, nt = K / BK;
    unsigned voffA[2], voffB[2];
#pragma unroll
    for (int i = 0; i < 2; ++i) { int R, C; stage_rc(tid * 16 + i * 8192, R, C); const int Rb = Epi::PERM ? ((R & ~31) + perm32(R & 31)) : R;
        voffA[i] = (unsigned)(R * K + C) * 2u; voffB[i] = (unsigned)(Rb * K + C) * 2u; }
    const size_t kstep = (size_t)(BK * 2);
    const size_t hstep = (size_t)HALF * K * 2;
    const size_t tstep = 2 * hstep;
    const unsigned ldsw = (unsigned)wid * 1024u;
    const int aoff = lds_byte(wr * 64 + fr, fq * 8), boff = lds_byte(wc * 32 + fr, fq * 8);
#define PG8_SA(b, h) (((b) * 2 + (h)) * HTB)
#define PG8_SB(b, h) ((4 + (b) * 2 + (h)) * HTB)
#define PG8_STAGE(bufoff, gbase, voff) do { _Pragma("unroll") for (int _i = 0; _i < 2; ++_i) \
        __builtin_amdgcn_global_load_lds((const unsigned*)((const char*)(gbase) + (voff)[_i]), (PG8_LAS unsigned*)(lds + (bufoff) + ldsw + _i * 8192), 16, 0, 0); } while (0)
#define PG8_LDA(dst, b, h) do { _Pragma("unroll") for (int m = 0; m < 4; ++m) _Pragma("unroll") for (int k = 0; k < 2; ++k) dst[m][k] = *(const PG8_LAS bf16x8*)(lds + PG8_SA(b, h) + aoff + m * 2048 + k * 1024); } while (0)
#define PG8_LDB(dst, b, h) do { _Pragma("unroll") for (int n = 0; n < 2; ++n) _Pragma("unroll") for (int k = 0; k < 2; ++k) dst[n][k] = *(const PG8_LAS bf16x8*)(lds + PG8_SB(b, h) + boff + n * 2048 + k * 1024); } while (0)
#define PG8_MMA(ai, bj, At, Bt) do { __builtin_amdgcn_s_setprio(1); _Pragma("unroll") for (int m = 0; m < 4; ++m) _Pragma("unroll") for (int n = 0; n < 2; ++n) _Pragma("unroll") for (int k = 0; k < 2; ++k) \
        acc[ai][bj][m][n] = __builtin_amdgcn_mfma_f32_16x16x32_bf16(Bt[n][k], At[m][k], acc[ai][bj][m][n], 0, 0, 0); __builtin_amdgcn_s_setprio(0); } while (0)
#define PG8_WAIT_V(n) asm volatile("s_waitcnt vmcnt(" #n ")" ::: "memory")
#define PG8_WAIT_L(n) asm volatile("s_waitcnt lgkmcnt(" #n ")" ::: "memory")
#define PG8_BAR __builtin_amdgcn_s_barrier()
#define PG8_SCHED __builtin_amdgcn_sched_barrier(0)
    Unit cur, nxt; int ui = 0;
    if (!S.next(0, cur)) return;
    f32x4 acc[2][2][4][2];
#pragma unroll
    for (int a = 0; a < 2; ++a)
#pragma unroll
        for (int b = 0; b < 2; ++b)
#pragma unroll
            for (int m = 0; m < 4; ++m)
#pragma unroll
                for (int n = 0; n < 2; ++n) acc[a][b][m][n] = (f32x4){0.f, 0.f, 0.f, 0.f};
    bf16x8 At[4][2], B0[2][2], B1[2][2];
    const char* cA = (const char*)g.A + (size_t)cur.pm * tstep; const char* cB = (const char*)g.Bt + (size_t)cur.pn * tstep;
    S.a_ready(cur);
    if constexpr (SP2) {
        PG8_STAGE(PG8_SB(0, 0), cB, voffB); PG8_STAGE(PG8_SB(0, 1), cB + hstep, voffB); PG8_STAGE(PG8_SA(0, 0), cA, voffA); PG8_STAGE(PG8_SA(0, 1), cA + hstep, voffA);
        if (wr == 1) PG8_BAR;
        PG8_WAIT_V(2); PG8_BAR;
        PG8_STAGE(PG8_SB(1, 0), cB + kstep, voffB); PG8_STAGE(PG8_SA(1, 0), cA + kstep, voffA); PG8_STAGE(PG8_SB(1, 1), cB + hstep + kstep, voffB);
        PG8_WAIT_V(6); PG8_BAR;
    } else {
        PG8_STAGE(PG8_SB(0, 0), cB, voffB); PG8_STAGE(PG8_SA(0, 0), cA, voffA); PG8_STAGE(PG8_SB(0, 1), cB + hstep, voffB); PG8_STAGE(PG8_SA(0, 1), cA + hstep, voffA);
        if (wr == 1) PG8_BAR;
        PG8_WAIT_V(4); PG8_BAR;
        PG8_STAGE(PG8_SB(1, 0), cB + kstep, voffB); PG8_STAGE(PG8_SA(1, 0), cA + kstep, voffA); PG8_STAGE(PG8_SB(1, 1), cB + hstep + kstep, voffB);
        PG8_WAIT_V(6); PG8_BAR;
    }
    for (;;) {
        const bool has_next = S.next(ui + 1, nxt);
        const char* nA = has_next ? (const char*)g.A + (size_t)nxt.pm * tstep : cA; const char* nB = has_next ? (const char*)g.Bt + (size_t)nxt.pn * tstep : cB;
        for (int t = 0; t < nt; t += 2) {
            const bool last = (t == nt - 2);
            const char* a1 = cA + (size_t)(t + 1) * kstep;
            const char* a2 = last ? nA : cA + (size_t)(t + 2) * kstep; const char* b2 = last ? nB : cB + (size_t)(t + 2) * kstep;
            const char* a3 = a2 + kstep; const char* b3 = b2 + kstep;
            if (last && has_next) S.a_ready(nxt);
            if constexpr (SP2) {
            PG8_LDB(B0, 0, 0); PG8_LDB(B1, 0, 1); PG8_SCHED; PG8_LDA(At, 0, 0); PG8_STAGE(PG8_SA(1, 1), a1 + hstep, voffA);
            PG8_WAIT_V(8); PG8_WAIT_L(0); PG8_BAR; PG8_MMA(0, 0, At, B0); PG8_MMA(0, 1, At, B1); PG8_BAR; PG8_SCHED;
            PG8_LDA(At, 0, 1); PG8_STAGE(PG8_SB(0, 0), b2, voffB); PG8_STAGE(PG8_SB(0, 1), b2 + hstep, voffB); PG8_STAGE(PG8_SA(0, 0), a2, voffA);
            PG8_WAIT_V(8); PG8_WAIT_L(0); PG8_BAR; PG8_MMA(1, 0, At, B0); PG8_MMA(1, 1, At, B1); PG8_BAR; PG8_SCHED;
            PG8_LDB(B0, 1, 0); PG8_LDB(B1, 1, 1); PG8_SCHED; PG8_LDA(At, 1, 0); PG8_STAGE(PG8_SA(0, 1), a2 + hstep, voffA);
            PG8_WAIT_V(8); PG8_WAIT_L(0); PG8_BAR; PG8_MMA(0, 0, At, B0); PG8_MMA(0, 1, At, B1); PG8_BAR; PG8_SCHED;
            PG8_LDA(At, 1, 1); PG8_STAGE(PG8_SB(1, 0), b3, voffB); PG8_STAGE(PG8_SB(1, 1), b3 + hstep, voffB); PG8_STAGE(PG8_SA(1, 0), a3, voffA);
            PG8_WAIT_V(8); PG8_WAIT_L(0); PG8_BAR; PG8_MMA(1, 0, At, B0); PG8_MMA(1, 1, At, B1); PG8_BAR; PG8_SCHED;
            } else {
            PG8_LDB(B0, 0, 0); PG8_SCHED; PG8_LDA(At, 0, 0); PG8_STAGE(PG8_SA(1, 1), a1 + hstep, voffA);
            PG8_WAIT_L(8); PG8_BAR; PG8_WAIT_L(0); PG8_MMA(0, 0, At, B0); PG8_BAR; PG8_SCHED;
            PG8_LDB(B1, 0, 1); PG8_STAGE(PG8_SB(0, 0), b2, voffB);
            PG8_BAR; PG8_WAIT_L(0); PG8_MMA(0, 1, At, B1); PG8_BAR;
            PG8_LDA(At, 0, 1); PG8_STAGE(PG8_SA(0, 0), a2, voffA);
            PG8_BAR; PG8_WAIT_L(0); PG8_MMA(1, 0, At, B0); PG8_BAR; PG8_SCHED;
            PG8_STAGE(PG8_SB(0, 1), b2 + hstep, voffB);
            PG8_WAIT_V(6); PG8_BAR; PG8_MMA(1, 1, At, B1); PG8_BAR;
            PG8_LDB(B0, 1, 0); PG8_SCHED; PG8_LDA(At, 1, 0); PG8_STAGE(PG8_SA(0, 1), a2 + hstep, voffA);
            PG8_WAIT_L(8); PG8_BAR; PG8_WAIT_L(0); PG8_MMA(0, 0, At, B0); PG8_BAR; PG8_SCHED;
            PG8_LDB(B1, 1, 1); PG8_STAGE(PG8_SB(1, 0), b3, voffB);
            PG8_BAR; PG8_WAIT_L(0); PG8_MMA(0, 1, At, B1); PG8_BAR;
            PG8_LDA(At, 1, 1); PG8_STAGE(PG8_SA(1, 0), a3, voffA);
            PG8_BAR; PG8_WAIT_L(0); PG8_MMA(1, 0, At, B0); PG8_BAR; PG8_SCHED;
            PG8_STAGE(PG8_SB(1, 1), b3 + hstep, voffB);
            PG8_WAIT_V(6); PG8_BAR; PG8_MMA(1, 1, At, B1); PG8_BAR;
            }
        }
        if constexpr (ALIGN_EPI) { if (wr == 0) PG8_BAR; }
        bool keep = false;
        if constexpr (Epi::CARRY) { keep = E.carry(acc, cur, wr, wc, fr, fq); S.done(cur); }
        else if constexpr (!Epi::AFTER_DRAIN) { E(acc, cur, wr, wc, fr, fq); S.done(cur); }
        if (!has_next) break;
        if (!keep) {
#pragma unroll
        for (int a = 0; a < 2; ++a)
#pragma unroll
            for (int b = 0; b < 2; ++b)
#pragma unroll
                for (int m = 0; m < 4; ++m)
#pragma unroll
                    for (int n = 0; n < 2; ++n) acc[a][b][m][n] = (f32x4){0.f, 0.f, 0.f, 0.f};
        }
        cur = nxt; cA = nA; cB = nB; ++ui;
        if constexpr (ALIGN_EPI) { if (wr == 1) PG8_BAR; }
    }
    PG8_WAIT_V(0);
    if constexpr (!ALIGN_EPI) { if (wr == 0) PG8_BAR; }
    PG8_BAR;
    if constexpr (Epi::AFTER_DRAIN) { E.fused(acc, cur, wr, wc, fr, fq, lds, wid, lane); S.done(cur); }
#undef PG8_SA
#undef PG8_SB
#undef PG8_STAGE
#undef PG8_LDA
#undef PG8_LDB
#undef PG8_MMA
#undef PG8_WAIT_V
#undef PG8_WAIT_L
#undef PG8_BAR
#undef PG8_SCHED
}
}
#define LAS __attribute__((address_space(3)))
typedef unsigned short bf16;
typedef unsigned v4u __attribute__((ext_vector_type(4)));
typedef unsigned v2u __attribute__((ext_vector_type(2)));
typedef short v4i16_t __attribute__((ext_vector_type(4)));
using pg8::f32x4; using pg8::bf16x8; using pg8::cvt_pk_bf16;

constexpr int D = 1024, FF = 2816, NLAYER = 4, TG = 16384, NGROUP = 4, NTHR = 512, NWAVES = 8;
constexpr int PA_LD = 5632, PG_LD = 3072;
constexpr int C_HQ = 0, C_HI = 512, C_HZF = 1024, C_HZB = 1536, C_HG = 2048, C_CA = 2560, C_CB = 3072, C_CC = 3584, C_NQ = 4096, C_NK = 4608, C_NV = 5120;
constexpr size_t MiB = 1u << 20;
constexpr size_t WS_CTL = 0, CTL_BYTES = 1 * MiB, WS_W = 1 * MiB, WS_XB = 221 * MiB, WS_SSQ = 285 * MiB, WS_PA = 287 * MiB, WS_PG = 463 * MiB, WS_ONA = 559 * MiB, WS_SCR = 575 * MiB, WS_END = 671 * MiB;
constexpr size_t OFF_GU1 = 0, OFF_D1 = 5767168, OFF_IN = 8650752, OFF_HG = 17563648, OFF_CV = 18087936, OFF_NA = 18612224, OFF_OUT = 19136512, OFF_GU2 = 20185088, OFF_D2 = 25952256, LAYER_EL = 28835840;
constexpr int LDS_BYTES = 147456, LDS_MISC = 147456 - 64;
constexpr int PH_PER_PAIR = 1 + NLAYER * 16 + 1;
constexpr int CW_BAR = 4096;

__device__ __forceinline__ unsigned f2bf(float f) { unsigned u = __float_as_uint(f); return (u + 0x7fffu + ((u >> 16) & 1u)) >> 16; }
__device__ __forceinline__ float bf2f(unsigned b) { return __uint_as_float(b << 16); }
__device__ __forceinline__ float bflo(unsigned w) { return __uint_as_float(w << 16); }
__device__ __forceinline__ float bfhi(unsigned w) { return __uint_as_float(w & 0xffff0000u); }
__device__ __forceinline__ float sigm(float v) { return __builtin_amdgcn_rcpf(1.0f + __expf(-v)); }
__device__ __forceinline__ float wave_sum(float v) {
#pragma unroll
    for (int o = 1; o < 64; o <<= 1) v += __shfl_xor(v, o);
    return v;
}

__device__ __forceinline__ void cvt_item(const float* W, int K, int N, bf16* WT, const float* gain, bool permgu, LAS float* scr, int item, int lane) {
    const int nblk = N / 32, kb = item / nblk, nb = item % nblk, k0 = 64 * kb, n0 = 32 * nb;
#pragma unroll
    for (int i = 0; i < 32; ++i) { const int kk = 2 * i + (lane >> 5); const float g = gain ? gain[k0 + kk] : 1.0f; scr[kk * 33 + (lane & 31)] = W[(size_t)(k0 + kk) * N + n0 + (lane & 31)] * g; }
    asm volatile("s_waitcnt lgkmcnt(0)" ::: "memory");
    int dn0 = n0;
    if (permgu) { const int half = n0 >= FF ? 1 : 0; const int j = n0 - half * FF; dn0 = (j >> 7) * 256 + half * 128 + (j & 127); }
    const int c = lane & 7;
#pragma unroll
    for (int j = 0; j < 4; ++j) { const int n = (lane >> 3) + 8 * j; const LAS float* s = scr + (8 * c) * 33 + n;
        v4u o; o.x = cvt_pk_bf16(s[0 * 33], s[1 * 33]); o.y = cvt_pk_bf16(s[2 * 33], s[3 * 33]); o.z = cvt_pk_bf16(s[4 * 33], s[5 * 33]); o.w = cvt_pk_bf16(s[6 * 33], s[7 * 33]);
        *(v4u*)(WT + (size_t)(dn0 + n) * K + k0 + 8 * c) = o; }
    asm volatile("s_waitcnt lgkmcnt(0)" ::: "memory");
}

template <int K> __device__ __forceinline__ f32x4 mma_lds(f32x4 acc, const LAS bf16* A, int pa, const LAS bf16* B, int pb, int lane) {
    const int r = lane & 15, q = lane >> 4;
#pragma unroll
    for (int ks = 0; ks < K / 32; ++ks) {
        const bf16x8 a = *(const LAS bf16x8*)(A + r * pa + ks * 32 + q * 8);
        const bf16x8 b = *(const LAS bf16x8*)(B + r * pb + ks * 32 + q * 8);
        acc = __builtin_amdgcn_mfma_f32_16x16x32_bf16(a, b, acc, 0, 0, 0);
    }
    return acc;
}

constexpr int HP_QT = 0, HP_KTT = 17408, HP_AM = 35840, HP_ER = 45056, HP_EE = 45568, HP_BLK = 49152;
constexpr int HP_KT = 49152, HP_SEG = 66560;
constexpr int HS_VT = 49152, HS_ST = 53760, HS_BUF = 62464;
__device__ __forceinline__ void hg_prep_items(LAS unsigned char* lds, const bf16* PA, unsigned char* SCR, const float* lb_logits, int layer, int item0, int istride, int nitems, int T, int tid) {
    const int lane = tid & 63, wave = __builtin_amdgcn_readfirstlane(tid >> 6), c16 = lane & 15, quad = lane >> 4;
    const int nchunk = T / 64;
    const int kp = tid & 63, ts = tid >> 6;
    LAS bf16* QT = (LAS bf16*)(lds + HP_QT); LAS bf16* KT = (LAS bf16*)(lds + HP_KT); LAS bf16* KTT = (LAS bf16*)(lds + HP_KTT); LAS bf16* AM = (LAS bf16*)(lds + HP_AM);
    LAS float* SEG = (LAS float*)(lds + HP_SEG); LAS float* ER = (LAS float*)(lds + HP_ER); LAS float* EE = (LAS float*)(lds + HP_EE);
    unsigned zz[8], qq[8];
#define HP_LOAD(it) do { const int it_ = min((it), nitems - 1); const int c_ = it_ % nchunk, sd_ = it_ / nchunk, dir_ = sd_ & 1, h_ = (sd_ >> 1) & 3, base_ = (sd_ >> 3) * T; \
        const bf16* zs = PA + (dir_ ? C_HZB : C_HZF) + h_ * 128 + 2 * kp; const bf16* qs = PA + C_HQ + h_ * 128 + 2 * kp; \
        _Pragma("unroll") for (int i = 0; i < 8; ++i) { const int tau = c_ * 64 + 8 * ts + i; const size_t ro = (size_t)(base_ + (dir_ ? (T - 1 - tau) : tau)) * PA_LD; zz[i] = *(const unsigned*)(zs + ro); qq[i] = *(const unsigned*)(qs + ro); } } while (0)
    HP_LOAD(item0);
    for (int item = item0; item < nitems; item += istride) {
        const int sd = item / nchunk, dir = sd & 1, h = (sd >> 1) & 3;
        float lb[2];
#pragma unroll
        for (int j = 0; j < 2; ++j) { float lg[4], mx = -3e38f;
#pragma unroll
          for (int l = 0; l < 4; ++l) { lg[l] = lb_logits[(dir * 4 + l) * 512 + h * 128 + 2 * kp + j]; mx = fmaxf(mx, lg[l]); }
          float tot = 0.f, num = 0.f;
#pragma unroll
          for (int l = 0; l < 4; ++l) { const float e = __expf(lg[l] - mx); tot += e; if (l >= 1 && l <= layer) num += e; }
          lb[j] = num / tot; }
        float b[2][8], kv[2][8], qv[2][8]; float cum[2] = {0.f, 0.f};
#pragma unroll
        for (int i = 0; i < 8; ++i)
#pragma unroll
            for (int j = 0; j < 2; ++j) { const float zf = j ? bfhi(zz[i]) : bflo(zz[i]); const float sg = __builtin_amdgcn_rcpf(1.0f + __builtin_amdgcn_exp2f(zf * -1.4426950408889634f)); const float oml = 1.0f - lb[j]; const float f = lb[j] + oml * sg;
                cum[j] += __builtin_amdgcn_logf(fmaxf(f, 1e-30f)); b[j][i] = cum[j]; kv[j][i] = oml * (1.0f - sg); qv[j][i] = j ? bfhi(qq[i]) : bflo(qq[i]); }
        HP_LOAD(item + istride);
        SEG[ts * 128 + 2 * kp] = cum[0]; SEG[ts * 128 + 2 * kp + 1] = cum[1];
        __syncthreads();
        float pre[2], r[2], bend[2];
#pragma unroll
        for (int j = 0; j < 2; ++j) { float p = 0.f, rr = 0.f, be = 0.f;
#pragma unroll
            for (int q = 0; q < 8; ++q) { const float v = SEG[q * 128 + 2 * kp + j]; if (q < ts) p += v; if (q < 4) rr += v; be += v; }
            pre[j] = p; r[j] = rr; bend[j] = be; }
        unsigned kpk[2][4];
#pragma unroll
        for (int i = 0; i < 8; ++i) {
            unsigned qb[2], kb[2];
#pragma unroll
            for (int j = 0; j < 2; ++j) { const float bt = pre[j] + b[j][i];
                const float eq = __builtin_amdgcn_exp2f(fminf(bt - r[j], 115.4f)), ek = __builtin_amdgcn_exp2f(fminf(r[j] - bt, 115.4f));
                qb[j] = f2bf(qv[j][i] * eq); kb[j] = f2bf(kv[j][i] * ek);
                if (i & 1) kpk[j][i >> 1] |= kb[j] << 16; else kpk[j][i >> 1] = kb[j]; }
            const int tau = 8 * ts + i;
            *(LAS unsigned*)(QT + tau * 136 + 2 * kp) = qb[0] | (qb[1] << 16);
            *(LAS unsigned*)(KT + tau * 136 + 2 * kp) = kb[0] | (kb[1] << 16);
        }
#pragma unroll
        for (int j = 0; j < 2; ++j) *(LAS v4u*)(KTT + (2 * kp + j) * 72 + 8 * ts) = (v4u){kpk[j][0], kpk[j][1], kpk[j][2], kpk[j][3]};
        if (ts == 0) {
#pragma unroll
            for (int j = 0; j < 2; ++j) { ER[2 * kp + j] = __builtin_amdgcn_exp2f(r[j]); EE[2 * kp + j] = __builtin_amdgcn_exp2f(bend[j] - r[j]); } }
        __syncthreads();
#pragma unroll
        for (int e = 0; e < 2; ++e) { const int id = wave * 2 + e, tt = id >> 2, st = id & 3;
            f32x4 a = (f32x4){0.f, 0.f, 0.f, 0.f};
            if (st <= tt) a = mma_lds<128>(a, QT + tt * 16 * 136, 136, KT + st * 16 * 136, 136, lane);
#pragma unroll
            for (int i = 0; i < 4; ++i) { const int t = tt * 16 + quad * 4 + i, s = st * 16 + c16; const float val = (st <= tt && s <= t) ? a[i] : 0.f; AM[t * 72 + s] = (bf16)f2bf(val); } }
        __syncthreads();
        unsigned char* dst = SCR + (size_t)item * HP_BLK;
#pragma unroll
        for (int j = 0; j < 6; ++j) { const int idx = tid + 512 * j; *(v4u*)(dst + (size_t)idx * 16) = *(const LAS v4u*)(lds + idx * 16); }
        __syncthreads();
    }
#undef HP_LOAD
}

template <int NVT> __device__ __forceinline__ void hg_scan_item(LAS unsigned char* lds, bf16* PA, const unsigned char* SCR, int item, int T, int tid) {
    constexpr int NVS = 8 / NVT, VW = 16 * NVT, VTHR = 128 * NVT, VSH = (NVT == 2) ? 2 : 1;
    const int lane = tid & 63, wave = __builtin_amdgcn_readfirstlane(tid >> 6), c16 = lane & 15, quad = lane >> 4;
    const int vs = item % NVS, sd = item / NVS, dir = sd & 1, h = (sd >> 1) & 3, seq = sd >> 3;
    const int base = seq * T, nchunk = T / 64;
    const unsigned char* blk = SCR + (size_t)sd * nchunk * HP_BLK;
    const bf16* vsrc = PA + C_HI + h * 128 + vs * VW + (tid & (VW / 8 - 1)) * 8;
    bf16* odst = PA + (dir ? C_HZF : C_HQ) + h * 128 + vs * VW;
    v4u preA[6], preB[6]; v4u vrA = {0u, 0u, 0u, 0u}, vrB = vrA; f32x4 ervA, eevA, ervB, eevB;
#define HG_ROW(tau) (base + (dir ? (T - 1 - (tau)) : (tau)))
#define HS_LOAD(c, pre, vr, erv, eev) do { const int c_ = min((c), nchunk - 1); const unsigned char* bp = blk + (size_t)c_ * HP_BLK;     \
        _Pragma("unroll") for (int j = 0; j < 6; ++j) pre[j] = *(const v4u*)(bp + (size_t)(tid + 512 * j) * 16); \
        erv = *(const f32x4*)(bp + HP_ER + (wave * 16 + quad * 4) * 4); eev = *(const f32x4*)(blk + (size_t)max(c_ - 1, 0) * HP_BLK + HP_EE + (wave * 16 + quad * 4) * 4);     \
        vr = *(const v4u*)(vsrc + (size_t)HG_ROW(c_ * 64 + ((tid & (VTHR - 1)) >> VSH)) * PA_LD); } while (0)
    HS_LOAD(0, preA, vrA, ervA, eevA);
    HS_LOAD(1, preB, vrB, ervB, eevB);
    f32x4 accS[NVT];
#pragma unroll
    for (int e = 0; e < NVT; ++e) accS[e] = (f32x4){0.f, 0.f, 0.f, 0.f};
#define HS_STEP(c, BUFI, pre, vr, erv, eev) do { \
        LAS unsigned char* B = lds + (BUFI) * HS_BUF; \
        LAS bf16* QT = (LAS bf16*)(B + HP_QT); LAS bf16* KTT = (LAS bf16*)(B + HP_KTT); LAS bf16* AM = (LAS bf16*)(B + HP_AM); \
        LAS bf16* VT = (LAS bf16*)(B + HS_VT); LAS bf16* STt = (LAS bf16*)(B + HS_ST); \
        _Pragma("unroll") for (int j = 0; j < 6; ++j) *(LAS v4u*)(B + (tid + 512 * j) * 16) = pre[j]; \
        if (tid < VTHR) { const int s_ = tid >> VSH, vq = tid & (VW / 8 - 1); \
            VT[(vq * 8 + 0) * 72 + s_] = (bf16)(vr.x & 0xffffu); VT[(vq * 8 + 1) * 72 + s_] = (bf16)(vr.x >> 16); \
            VT[(vq * 8 + 2) * 72 + s_] = (bf16)(vr.y & 0xffffu); VT[(vq * 8 + 3) * 72 + s_] = (bf16)(vr.y >> 16); \
            VT[(vq * 8 + 4) * 72 + s_] = (bf16)(vr.z & 0xffffu); VT[(vq * 8 + 5) * 72 + s_] = (bf16)(vr.z >> 16); \
            VT[(vq * 8 + 6) * 72 + s_] = (bf16)(vr.w & 0xffffu); VT[(vq * 8 + 7) * 72 + s_] = (bf16)(vr.w >> 16); } \
        f32x4 sp[NVT]; const f32x4 sc_ = erv * eev;     \
        _Pragma("unroll") for (int e = 0; e < NVT; ++e) { sp[e] = accS[e] * sc_; v2u w; w.x = cvt_pk_bf16(sp[e][0], sp[e][1]); w.y = cvt_pk_bf16(sp[e][2], sp[e][3]); \
            *(LAS v2u*)(STt + (e * 16 + c16) * 136 + wave * 16 + quad * 4) = w; } \
        HS_LOAD((c) + 2, pre, vr, erv, eev); \
        __syncthreads(); \
        if ((wave >> 2) < NVT) { const int tt = wave & 3, vt = wave >> 2; f32x4 o = (f32x4){0.f, 0.f, 0.f, 0.f}; \
          o = mma_lds<128>(o, QT + tt * 16 * 136, 136, STt + vt * 16 * 136, 136, lane); \
          o = mma_lds<64>(o, AM + tt * 16 * 72, 72, VT + vt * 16 * 72, 72, lane); \
          _Pragma("unroll") for (int i = 0; i < 4; ++i) { const int tau = (c) * 64 + tt * 16 + quad * 4 + i; odst[(size_t)HG_ROW(tau) * PA_LD + vt * 16 + c16] = (bf16)f2bf(o[i]); } } \
        _Pragma("unroll") for (int e = 0; e < NVT; ++e) { accS[e] = mma_lds<64>(sp[e], KTT + wave * 16 * 72, 72, VT + e * 16 * 72, 72, lane); } \
    } while (0)
    for (int c = 0; c < nchunk; c += 2) {
        HS_STEP(c, 0, preA, vrA, ervA, eevA);
        HS_STEP(c + 1, 1, preB, vrB, ervB, eevB);
    }
    __syncthreads();
#undef HG_ROW
#undef HS_LOAD
#undef HS_STEP
}

__device__ __forceinline__ void na_item(LAS unsigned char* lds, const bf16* PA, const float* rpb, bf16* ONA, int item, int T, int tid) {
    const int lane = tid & 63, h = __builtin_amdgcn_readfirstlane(tid >> 6), c16 = lane & 15, quad = lane >> 4;
    const int ips = T / 16, seq = item / ips, rem = item % ips, r = rem >> 2, j = rem & 3;
    const int rows = T / 64, rs = min(max(r - 4, 0), rows - 8), kstart = (j == 0) ? 0 : (j == 1) ? 8 : (j == 2) ? 24 : 32;
    const int base = seq * T, qtok = base + r * 64 + 16 * j + c16;
    const bf16* qp = PA + (size_t)qtok * PA_LD + C_NQ + h * 64 + quad * 8;
    const bf16x8 Qb0 = *(const bf16x8*)qp, Qb1 = *(const bf16x8*)(qp + 32);
    const int qcol = 16 * j + c16, cs = min(max(qcol - 8, 0), 48);
    v4u vbufA[8], vbufB[8], vbufC[8], vbufD[8];
#define NA_VLOAD(qd, vbuf) do { _Pragma("unroll") for (int it = 0; it < 8; ++it) { const int idx = it * 64 + lane, key = idx >> 3, dg = idx & 7; \
        const int tok = base + (rs + 2 * (qd) + (key >> 5)) * 64 + kstart + (key & 31); vbuf[it] = *(const v4u*)(PA + (size_t)tok * PA_LD + C_NV + h * 64 + dg * 8); } } while (0)
    NA_VLOAD(0, vbufA); NA_VLOAD(1, vbufB);
    const float* rp = rpb + h * 465;
    f32x4 sacc[16]; float mx = -3e38f;
    int dcv[8]; bool okv[8];
#pragma unroll
    for (int e = 0; e < 8; ++e) { const int kcol = kstart + (e >> 2) * 16 + quad * 4 + (e & 3); okv[e] = (kcol >= cs) && (kcol < cs + 16); dcv[e] = min(max(kcol - qcol + 15, 0), 30); }
#pragma unroll
    for (int a = 0; a < 8; ++a) {
        const float rowv = rp[(rs + a - r + 7) * 31 + min(lane, 30)] * 1.4426950408889634f;
        float bv[8];
#pragma unroll
        for (int e = 0; e < 8; ++e) bv[e] = __builtin_bit_cast(float, __builtin_amdgcn_ds_bpermute(dcv[e] << 2, __builtin_bit_cast(int, rowv)));
#pragma unroll
        for (int hh = 0; hh < 2; ++hh) {
            const int ktok = base + (rs + a) * 64 + kstart + hh * 16 + c16;
            const bf16* kp = PA + (size_t)ktok * PA_LD + C_NK + h * 64 + quad * 8;
            const bf16x8 Ka0 = *(const bf16x8*)kp, Ka1 = *(const bf16x8*)(kp + 32);
            f32x4 s = (f32x4){0.f, 0.f, 0.f, 0.f};
            s = __builtin_amdgcn_mfma_f32_16x16x32_bf16(Ka0, Qb0, s, 0, 0, 0);
            s = __builtin_amdgcn_mfma_f32_16x16x32_bf16(Ka1, Qb1, s, 0, 0, 0);
#pragma unroll
            for (int i = 0; i < 4; ++i) { const float val = okv[hh * 4 + i] ? s[i] * (0.125f * 1.4426950408889634f) + bv[hh * 4 + i] : -1e30f;     s[i] = val; mx = fmaxf(mx, val); }
            sacc[a * 2 + hh] = s;
        }
    }
    NA_VLOAD(2, vbufC); NA_VLOAD(3, vbufD);
    mx = fmaxf(mx, __shfl_xor(mx, 16)); mx = fmaxf(mx, __shfl_xor(mx, 32));
    float sum = 0.f;
#pragma unroll
    for (int t = 0; t < 16; ++t)
#pragma unroll
        for (int i = 0; i < 4; ++i) { const float p = __builtin_amdgcn_exp2f(sacc[t][i] - mx); sacc[t][i] = p; sum += p; }
    sum += __shfl_xor(sum, 16); sum += __shfl_xor(sum, 32);
    bf16x8 pb[8];
#pragma unroll
    for (int a = 0; a < 8; ++a) { v4u w; w.x = cvt_pk_bf16(sacc[2 * a][0], sacc[2 * a][1]); w.y = cvt_pk_bf16(sacc[2 * a][2], sacc[2 * a][3]);
        w.z = cvt_pk_bf16(sacc[2 * a + 1][0], sacc[2 * a + 1][1]); w.w = cvt_pk_bf16(sacc[2 * a + 1][2], sacc[2 * a + 1][3]); pb[a] = __builtin_bit_cast(bf16x8, w); }
    LAS bf16* VS = (LAS bf16*)(lds + h * 10240);
    f32x4 oacc[4];
#pragma unroll
    for (int dt = 0; dt < 4; ++dt) oacc[dt] = (f32x4){0.f, 0.f, 0.f, 0.f};
    const int trq = (lane & 15) >> 2, trp = lane & 3;
    const LAS bf16* trbase = VS + (quad * 4 + trq) * 80 + 4 * trp;
#define NA_PV(qd, vbuf) do { \
        _Pragma("unroll") for (int it = 0; it < 8; ++it) { const int idx = it * 64 + lane, key = idx >> 3, dg = idx & 7; *(LAS v4u*)(VS + key * 80 + dg * 8) = vbuf[it]; } \
        _Pragma("unroll") for (int al = 0; al < 2; ++al) \
            _Pragma("unroll") for (int dt = 0; dt < 4; ++dt) { const LAS bf16* p = trbase + al * 32 * 80 + dt * 16; \
                const v4i16_t lo = __builtin_amdgcn_ds_read_tr16_b64_v4i16((LAS v4i16_t*)p), hi = __builtin_amdgcn_ds_read_tr16_b64_v4i16((LAS v4i16_t*)(p + 16 * 80)); \
                const bf16x8 af = {lo[0], lo[1], lo[2], lo[3], hi[0], hi[1], hi[2], hi[3]}; \
                oacc[dt] = __builtin_amdgcn_mfma_f32_16x16x32_bf16(af, pb[(qd) * 2 + al], oacc[dt], 0, 0, 0); } } while (0)
    NA_PV(0, vbufA); NA_PV(1, vbufB); NA_PV(2, vbufC); NA_PV(3, vbufD);
#undef NA_PV
#undef NA_VLOAD
    const float inv = __builtin_amdgcn_rcpf(sum);
#pragma unroll
    for (int dt = 0; dt < 4; ++dt) { const f32x4 o = oacc[dt] * inv; v2u w; w.x = cvt_pk_bf16(o[0], o[1]); w.y = cvt_pk_bf16(o[2], o[3]);
        *(v2u*)(ONA + (size_t)qtok * 512 + h * 64 + dt * 16 + quad * 4) = w; }
}

#define XB_TMO      128
#define XB_XCNT(j)  (256  + 64 * (j))
#define XB_XSUB(j)  (1280 + 64 * (j))
#define XB_XGEN(j)  (2304 + 64 * (j))
#define XB_TOP      3328
#define XB_TOPGEN   3392
#define XCD_BAR_WORDS 3456
#define XB_SPIN_CAP (1u << 18)

__device__ __forceinline__ unsigned xb_ld(unsigned* p)              { return __hip_atomic_load(p, __ATOMIC_RELAXED, __HIP_MEMORY_SCOPE_AGENT); }
__device__ __forceinline__ unsigned xb_add(unsigned* p, unsigned v) { return __hip_atomic_fetch_add(p, v, __ATOMIC_RELAXED, __HIP_MEMORY_SCOPE_AGENT); }
__device__ __forceinline__ unsigned xb_xcc_id() { return (unsigned)__builtin_amdgcn_s_getreg((3 << 11) | 20) & 0xFu; }
#define XB_SPIN(cond, bar) do { unsigned _sp = 0; while (cond) { __builtin_amdgcn_s_sleep(1); \
    if ((++_sp & 255u) == 0u) { if (xb_ld(&(bar)[XB_TMO])) break; if (_sp > XB_SPIN_CAP) { atomicAdd(&(bar)[XB_TMO], 1u); break; } } } } while (0)

struct XcdBarrier {
    unsigned* bar; unsigned x;
    volatile LAS unsigned* st;
};

__device__ __forceinline__ XcdBarrier xcd_barrier_post(unsigned* bar, volatile LAS unsigned* st) {
    XcdBarrier b; b.bar = bar; b.x = xb_xcc_id(); b.st = st;
    if (threadIdx.x == 0) (void)xb_add(&bar[XB_XCNT(b.x)], 1u);
    return b;
}
__device__ __forceinline__ void xcd_barrier_complete(unsigned* bar, unsigned x, unsigned& nloc, unsigned& nx) {
    const unsigned G = gridDim.x * gridDim.y * gridDim.z;
    unsigned sum, cnt, mine, sp = 0u;
    for (;;) {
        sum = 0u; cnt = 0u; mine = 0u;
#pragma unroll
        for (unsigned j = 0; j < 16; ++j) { const unsigned c = xb_ld(&bar[XB_XCNT(j)]); sum += c; cnt += (c > 0u) ? 1u : 0u; mine = (j == x) ? c : mine; }
        if (sum == G) break;
        __builtin_amdgcn_s_sleep(1);
        if ((++sp & 255u) == 0u) { if (xb_ld(&bar[XB_TMO])) break; if (sp > XB_SPIN_CAP) { atomicAdd(&bar[XB_TMO], 1u); break; } }
    }
    nloc = mine > 0u ? mine : 1u; nx = cnt > 0u ? cnt : 1u;
}

__device__ __forceinline__ void xcd_barrier(const XcdBarrier& b) {
    asm volatile("s_waitcnt vmcnt(0)" ::: "memory");
    __syncthreads();
    if (threadIdx.x == 0) {
        unsigned* bar = b.bar;
        __builtin_amdgcn_s_waitcnt(0);
        unsigned nloc = b.st[0], nx = b.st[1];
        if (nloc == 0u) { xcd_barrier_complete(bar, b.x, nloc, nx); b.st[0] = nloc; b.st[1] = nx; }
        const unsigned old = xb_add(&bar[XB_XSUB(b.x)], 1u);
        const unsigned gen = old / nloc;
        if (old + 1u == (gen + 1u) * nloc) {
            __builtin_amdgcn_fence(__ATOMIC_RELEASE, "agent");
            asm volatile("s_waitcnt vmcnt(0)" ::: "memory");
            const unsigned og = xb_add(&bar[XB_TOP], 1u);
            const unsigned tg = og / nx;
            if (og + 1u == (tg + 1u) * nx) xb_add(&bar[XB_TOPGEN], 1u);
            else XB_SPIN(xb_ld(&bar[XB_TOPGEN]) == tg, bar);
            __builtin_amdgcn_fence(__ATOMIC_ACQUIRE, "agent");
            xb_add(&bar[XB_XGEN(b.x)], 1u);
            asm volatile("s_waitcnt vmcnt(0)" ::: "memory");
        } else {
            XB_SPIN(xb_ld(&bar[XB_XGEN(b.x)]) == gen, bar);
            __builtin_amdgcn_fence(__ATOMIC_ACQUIRE, "agent");
            asm volatile("s_waitcnt vmcnt(0)" ::: "memory");
        }
    }
    __syncthreads();
}
struct Args { const float* in[20]; float* out; unsigned char* ws; int ph_lo, ph_hi; };
enum { K_CVT = 0, K_G0, K_UP, K_RES, K_M1, K_M2A, K_M2B, K_M3, K_M4, K_GF };

__global__ void __launch_bounds__(NTHR, 2) mk_fwd(Args args) {
    extern __shared__ __attribute__((aligned(16))) unsigned char lds_raw[];
    LAS unsigned char* lds = (LAS unsigned char*)lds_raw;
    cg::grid_group grid = cg::this_grid();
    const int hi = args.ph_hi;
    { volatile LAS unsigned* st0 = (volatile LAS unsigned*)(lds + LDS_MISC + 32); if (threadIdx.x < 2) st0[threadIdx.x] = 0u; __syncthreads(); }
    XcdBarrier xbar = xcd_barrier_post((unsigned*)(args.ws + WS_CTL) + CW_BAR, (volatile LAS unsigned*)(lds + LDS_MISC + 32));
#if TPROBE
    unsigned long long tacc = 0ull;
#endif
    for (int ph = args.ph_lo; ph < hi; ++ph) {
#if TPROBE
        const unsigned long long tp0 = __builtin_amdgcn_s_memrealtime();
#endif
        int bid = blockIdx.x, G = gridDim.x; asm volatile("" : "+s"(bid), "+s"(G));
        int tid = threadIdx.x; asm volatile("" : "+v"(tid));
        const int lane = tid & 63, wave = __builtin_amdgcn_readfirstlane(tid >> 6);
        const int gw = bid * NWAVES + wave, NGW = G * NWAVES;
        int kind, pr = 0, l = 0, s = 0, g2 = 0;
        if (ph == 0) kind = K_CVT;
        else { const int q = ph - 1; pr = q / PH_PER_PAIR; const int r = q % PH_PER_PAIR;
            if (r == 0) kind = K_G0; else if (r == PH_PER_PAIR - 1) kind = K_GF;
            else { l = (r - 1) / 16; s = (r - 1) % 16;
                if (s == 0 || s == 14) kind = K_UP; else if (s == 1 || s == 15) kind = K_RES;
                else { g2 = (s - 2) / 6; const int t = (s - 2) % 6; kind = (t == 0) ? K_M1 : (t == 1) ? K_M2A : (t == 2) ? K_M2B : (t == 3) ? K_M3 : (t == 4) ? K_M4 : K_RES; } } }
        const bool mix = (s >= 2 && s <= 13);
        unsigned char* ws = args.ws;
        bf16* XBp = (bf16*)(ws + WS_XB); float* SSQp = (float*)(ws + WS_SSQ);
        bf16* XB = XBp + (size_t)g2 * TG * D; float* SSQ = SSQp + (size_t)g2 * TG * 16;
        bf16* PA = (bf16*)(ws + WS_PA); bf16* PG = (bf16*)(ws + WS_PG);
        bf16* ONA = (bf16*)(ws + WS_ONA); bf16* OHG = ONA + (size_t)TG * 512; bf16* OCV = OHG + (size_t)TG * 512;
        unsigned char* SCR = ws + WS_SCR;
        const bf16* Wl = (const bf16*)(ws + WS_W) + (size_t)l * LAYER_EL;
        const int T = pr == 0 ? 2048 : 4096;
        const int g = pr * 2 + g2;
        float* X = args.out + (size_t)pr * 2 * TG * D;

        if (kind == K_CVT) {
            LAS float* scr = (LAS float*)(lds + wave * 16384);
            constexpr int I_GU = 16 * 176, I_DN = 44 * 32, I_IN = 16 * 272, I_MX = 8 * 32, I_OUT = 16 * 32;
            constexpr int I_LAYER = 2 * I_GU + 2 * I_DN + I_IN + 3 * I_MX + I_OUT, I_TOT = NLAYER * I_LAYER;
#define CVT_DECODE(it_) const int ll = (it_) / I_LAYER; int r = (it_) % I_LAYER; \
                const float* src; const float* gain = nullptr; int K, N; size_t off; bool perm = false; \
                if (r < I_GU) { src = args.in[3] + (size_t)ll * D * 2 * FF; K = D; N = 2 * FF; off = OFF_GU1; gain = args.in[2] + ll * D; perm = true; } \
                else if ((r -= I_GU) < I_DN) { src = args.in[4] + (size_t)ll * FF * D; K = FF; N = D; off = OFF_D1; } \
                else if ((r -= I_DN) < I_IN) { src = args.in[6] + (size_t)ll * D * 8704; K = D; N = 8704; off = OFF_IN; gain = args.in[5] + ll * D; } \
                else if ((r -= I_IN) < I_MX) { src = args.in[9] + (size_t)ll * 512 * D; K = 512; N = D; off = OFF_HG; } \
                else if ((r -= I_MX) < I_MX) { src = args.in[12] + (size_t)ll * 512 * D; K = 512; N = D; off = OFF_CV; } \
                else if ((r -= I_MX) < I_MX) { src = args.in[14] + (size_t)ll * 512 * D; K = 512; N = D; off = OFF_NA; } \
                else if ((r -= I_MX) < I_OUT) { src = args.in[15] + (size_t)ll * D * D; K = D; N = D; off = OFF_OUT; } \
                else if ((r -= I_OUT) < I_GU) { src = args.in[17] + (size_t)ll * D * 2 * FF; K = D; N = 2 * FF; off = OFF_GU2; gain = args.in[16] + ll * D; perm = true; } \
                else { r -= I_GU; src = args.in[18] + (size_t)ll * FF * D; K = FF; N = D; off = OFF_D2; } \
                const int nblk = N / 32, kb = r / nblk, nb = r % nblk, k0 = 64 * kb, n0 = 32 * nb;
#define CVT_LOAD(it_, wv) do { CVT_DECODE(min((it_), I_TOT - 1)) (void)off; (void)perm; \
                _Pragma("unroll") for (int i = 0; i < 32; ++i) { const int kk = 2 * i + (lane >> 5); wv[i] = src[(size_t)(k0 + kk) * N + n0 + (lane & 31)] * (gain ? gain[k0 + kk] : 1.0f); } } while (0)
#define CVT_PROC(it_, wv) do { CVT_DECODE(it_) (void)src; (void)gain; \
                _Pragma("unroll") for (int i = 0; i < 32; ++i) { const int kk = 2 * i + (lane >> 5); scr[kk * 33 + (lane & 31)] = wv[i]; } \
                asm volatile("s_waitcnt lgkmcnt(0)" ::: "memory"); \
                int dn0 = n0; if (perm) { const int half = n0 >= FF ? 1 : 0; const int j_ = n0 - half * FF; dn0 = (j_ >> 7) * 256 + half * 128 + (j_ & 127); } \
                bf16* WT = (bf16*)(ws + WS_W) + (size_t)ll * LAYER_EL + off; const int c_ = lane & 7; \
                _Pragma("unroll") for (int j = 0; j < 4; ++j) { const int n = (lane >> 3) + 8 * j; const LAS float* sp_ = scr + (8 * c_) * 33 + n; \
                    v4u o; o.x = cvt_pk_bf16(sp_[0 * 33], sp_[1 * 33]); o.y = cvt_pk_bf16(sp_[2 * 33], sp_[3 * 33]); o.z = cvt_pk_bf16(sp_[4 * 33], sp_[5 * 33]); o.w = cvt_pk_bf16(sp_[6 * 33], sp_[7 * 33]); \
                    *(v4u*)(WT + (size_t)(dn0 + n) * K + k0 + 8 * c_) = o; } \
                asm volatile("s_waitcnt lgkmcnt(0)" ::: "memory"); } while (0)
            float wa[32], wb[32];
            int it = gw;
            CVT_LOAD(it, wa);
            while (it < I_TOT) {
                CVT_LOAD(it + NGW, wb);
                CVT_PROC(it, wa);
                it += NGW;
                CVT_LOAD(it + NGW, wa);
                if (it < I_TOT) CVT_PROC(it, wb);
                it += NGW;
            }
#undef CVT_DECODE
#undef CVT_LOAD
#undef CVT_PROC
        } else if (kind == K_G0) {
            const float* xin = pr == 0 ? args.in[0] : args.in[1];
#define G0_LOAD(rowx_, S) do { const int r_ = min((rowx_), 2 * TG - 1); const f32x4* xr_ = (const f32x4*)(xin + (size_t)r_ * D) + lane; \
                _Pragma("unroll") for (int j = 0; j < 4; ++j) gx##S[j] = xr_[64 * j]; } while (0)
#define G0_PROC(rowx_, S) do { const int rw_ = (rowx_); v2u* bo_ = (v2u*)(XBp + (size_t)rw_ * D) + lane; float ss_ = 0.f; \
                _Pragma("unroll") for (int j = 0; j < 4; ++j) { const f32x4 v = gx##S[j]; v2u w_; w_.x = cvt_pk_bf16(v[0], v[1]); w_.y = cvt_pk_bf16(v[2], v[3]); bo_[64 * j] = w_; ss_ += (v[0] * v[0] + v[1] * v[1]) + (v[2] * v[2] + v[3] * v[3]); } \
                ss_ = wave_sum(ss_); if (lane < 16) SSQp[(size_t)rw_ * 16 + lane] = lane == 0 ? ss_ : 0.f; } while (0)
            f32x4 gxA[4], gxB[4];
            { int rowi = gw;
              G0_LOAD(rowi, A);
              while (rowi < 2 * TG) {
                  G0_LOAD(rowi + NGW, B); G0_PROC(rowi, A); rowi += NGW;
                  G0_LOAD(rowi + NGW, A); if (rowi < 2 * TG) G0_PROC(rowi, B); rowi += NGW;
              } }
#undef G0_LOAD
#undef G0_PROC
        } else if (kind == K_UP) {
            pg8::Gemm gm{XBp, Wl + (s == 14 ? OFF_GU2 : OFF_GU1), 2 * TG, 2 * FF, D}; pg8::StaticOrder S; S.init(2 * TG, 2 * FF, G, bid);
            LAS float* rst = (LAS float*)(lds + 131072); LAS int* pml = (LAS int*)(lds + 131072 + 12288);
            __syncthreads();
            if (tid == 0) { int n = 0; pg8::Unit uu;
                for (int i = 0; S.next(i, uu); ++i) { bool f = false; for (int q = 0; q < n; ++q) f = f || (pml[q] == uu.pm); if (!f && n < 12) pml[n++] = uu.pm; }
                pml[15] = n; }
            __syncthreads();
            { const int n = pml[15];
              for (int idx = tid; idx < n * 256; idx += NTHR) { const int row = pml[idx >> 8] * 256 + (idx & 255); rst[idx] = pg8::row_rs(SSQp, row); } }
            __syncthreads();
            pg8::EpiSwiGLU E{PA, rst, pml, SSQp};
#ifndef NO_UP
            for (int rep = 0; rep < REP_GEMM; ++rep) pg8::gemm_phase<pg8::EpiSwiGLU, pg8::StaticOrder, PGA, PGS>(lds, gm, S, E);
#endif
        } else if (kind == K_RES) {
            const int K = mix ? D : FF, Mr = mix ? TG : 2 * TG; const size_t off = mix ? OFF_OUT : (s == 1 ? OFF_D1 : OFF_D2);
            pg8::Gemm gm{PA, Wl + off, Mr, D, K}; pg8::StaticOrder S; S.init(Mr, D, G, bid);
            pg8::EpiRes E{mix ? XB : XBp, mix ? SSQ : SSQp, mix ? 1.0f : 0.5f};
#ifndef NO_RES
            for (int rep = 0; rep < REP_RES; ++rep) { if (rep + 1 < REP_RES) { pg8::EpiRes E0 = E; E0.alpha = 0.f; pg8::gemm_phase<pg8::EpiRes, pg8::StaticOrder, PGA, PGS>(lds, gm, S, E0); }
                else pg8::gemm_phase<pg8::EpiRes, pg8::StaticOrder, PGA, PGS>(lds, gm, S, E); }
#endif
        } else if (kind == K_M1) {
            pg8::Gemm gm{XBp, Wl + OFF_IN, 2 * TG, 8704, D}; pg8::M1Order S; S.init(G, bid, g2);
            LAS float* rst = (LAS float*)(lds + 131072); LAS int* pml = (LAS int*)(lds + 131072 + 12288);
            __syncthreads();
            if (tid == 0) { int n = 0; pg8::Unit uu;
                for (int i = 0; S.next(i, uu); ++i) { bool f = false; for (int q = 0; q < n; ++q) f = f || (pml[q] == uu.pm); if (!f && n < 12) pml[n++] = uu.pm; }
                pml[15] = n; }
            __syncthreads();
            { const int n = pml[15];
              for (int idx = tid; idx < n * 256; idx += NTHR) { const int row = pml[idx >> 8] * 256 + (idx & 255); rst[idx] = pg8::row_rs(SSQp, row); } }
            __syncthreads();
            pg8::EpiProj E{PA, (unsigned char*)PG, (unsigned char*)PG + (size_t)TG * 3072, rst, pml, SSQp};
#ifndef NO_PROJ
            for (int rep = 0; rep < REP_GEMM; ++rep) pg8::gemm_phase<pg8::EpiProj, pg8::M1Order, PGA, PGS>(lds, gm, S, E);
#endif
        } else if (kind == K_M2A) {
#ifndef NO_HG
            { const int nP = (TG / 64) * 8;
              if (G == 256) { const int vcu1 = (bid % 8) * 32 + bid / 8; for (int rep = 0; rep < REP_HG; ++rep) hg_prep_items(lds, PA, SCR, args.in[7], l, vcu1 * (nP / 256), 1, (vcu1 + 1) * (nP / 256), T, tid); }
              else { for (int rep = 0; rep < REP_HG; ++rep) if (bid < nP) hg_prep_items(lds, PA, SCR, args.in[7], l, bid, G, nP, T, tid); } }
#endif
            const float* rpb = args.in[13] + (size_t)l * 8 * 465;
            const int vcu = (G % 8 == 0) ? (bid % 8) * (G / 8) + bid / 8 : bid;
            const int nNA = TG / 16, ipb = (nNA + G - 1) / G;
            for (int rep = 0; rep < REP_NA; ++rep)
                for (int q = 0; q < ipb; ++q) { const int it = vcu * ipb + q; if (it < nNA) {
#ifndef NO_NA
                    na_item(lds, PA, rpb, ONA, it, T, tid);
#endif
                    } }
        } else if (kind == K_M2B) {
#ifndef NO_HG
            const int vcu2 = (G % 8 == 0) ? (bid % 8) * (G / 8) + bid / 8 : bid;
            for (int rep = 0; rep < REP_HG; ++rep) {
                if (pr == 0) { for (int it = vcu2; it < 256; it += G) hg_scan_item<2>(lds, PA, SCR, it, T, tid); }
                else       { for (int it = vcu2; it < 256; it += G) hg_scan_item<1>(lds, PA, SCR, it, T, tid); }
            }
#endif
        } else if (kind == K_M3) {
            const float* gno = args.in[8] + l * 512; const float* cw = args.in[10] + l * 3 * 512; const float* cbias = args.in[11] + l * 512;
            const int c0 = lane * 8;
            const bf16* __restrict__ PAr = PA; bf16* __restrict__ OHGr = OHG; bf16* __restrict__ OCVr = OCV;
            const f32x4 gn0 = *(const f32x4*)(gno + c0), gn1 = *(const f32x4*)(gno + c0 + 4);
            const f32x4 w00 = *(const f32x4*)(cw + c0), w01 = *(const f32x4*)(cw + c0 + 4), w10 = *(const f32x4*)(cw + 512 + c0), w11 = *(const f32x4*)(cw + 512 + c0 + 4);
            const f32x4 w20 = *(const f32x4*)(cw + 1024 + c0), w21 = *(const f32x4*)(cw + 1024 + c0 + 4), bs0 = *(const f32x4*)(cbias + c0), bs1 = *(const f32x4*)(cbias + c0 + 4);
#define M3_DECL(S) v4u fw##S, bw##S, hg##S, a1##S, c1##S, bb##S, a0##S, q0##S, a2##S, q2##S
#define M3_LOAD(row_, S) do { const int r_ = min((row_), TG - 1); const bf16* pr_ = PAr + (size_t)r_ * PA_LD + c0; \
                const bf16* pm_ = PAr + (size_t)max(r_ - 1, 0) * PA_LD + c0; const bf16* pp_ = PAr + (size_t)min(r_ + 1, TG - 1) * PA_LD + c0; \
                fw##S = *(const v4u*)(pr_ + C_HQ); bw##S = *(const v4u*)(pr_ + C_HZF); hg##S = *(const v4u*)(pr_ + C_HG); \
                a1##S = *(const v4u*)(pr_ + C_CA); c1##S = *(const v4u*)(pr_ + C_CC); bb##S = *(const v4u*)(pr_ + C_CB); \
                a0##S = *(const v4u*)(pm_ + C_CA); q0##S = *(const v4u*)(pm_ + C_CC); a2##S = *(const v4u*)(pp_ + C_CA); q2##S = *(const v4u*)(pp_ + C_CC); } while (0)
#define M3_MUL8(A, B) {bflo(A.x) * bflo(B.x), bfhi(A.x) * bfhi(B.x), bflo(A.y) * bflo(B.y), bfhi(A.y) * bfhi(B.y), bflo(A.z) * bflo(B.z), bfhi(A.z) * bfhi(B.z), bflo(A.w) * bflo(B.w), bfhi(A.w) * bfhi(B.w)}
#define M3_PROC(row_, S) do { const int rw_ = (row_);     \
                float o[8] = {bflo(fw##S.x) + bflo(bw##S.x), bfhi(fw##S.x) + bfhi(bw##S.x), bflo(fw##S.y) + bflo(bw##S.y), bfhi(fw##S.y) + bfhi(bw##S.y), bflo(fw##S.z) + bflo(bw##S.z), bfhi(fw##S.z) + bfhi(bw##S.z), bflo(fw##S.w) + bflo(bw##S.w), bfhi(fw##S.w) + bfhi(bw##S.w)}; \
                float ss = 0.f; \
                _Pragma("unroll") for (int e = 0; e < 8; ++e) ss += o[e] * o[e]; \
                ss += __shfl_xor(ss, 1); ss += __shfl_xor(ss, 2); ss += __shfl_xor(ss, 4); ss += __shfl_xor(ss, 8); \
                const float rs = __builtin_amdgcn_rsqf(ss * (1.0f / 128.0f) + 1e-6f); \
                const float hgv[8] = {bflo(hg##S.x), bfhi(hg##S.x), bflo(hg##S.y), bfhi(hg##S.y), bflo(hg##S.z), bfhi(hg##S.z), bflo(hg##S.w), bfhi(hg##S.w)}; \
                const float gn[8] = {gn0[0], gn0[1], gn0[2], gn0[3], gn1[0], gn1[1], gn1[2], gn1[3]}; \
                float r8[8]; \
                _Pragma("unroll") for (int e = 0; e < 8; ++e) r8[e] = o[e] * rs * gn[e] * (hgv[e] * sigm(hgv[e])); \
                v4u wo; wo.x = cvt_pk_bf16(r8[0], r8[1]); wo.y = cvt_pk_bf16(r8[2], r8[3]); wo.z = cvt_pk_bf16(r8[4], r8[5]); wo.w = cvt_pk_bf16(r8[6], r8[7]); \
                *(v4u*)(OHGr + (size_t)rw_ * 512 + c0) = wo; \
                const int tl = rw_ & (T - 1); const float m0 = tl > 0 ? 1.f : 0.f, m2 = tl < T - 1 ? 1.f : 0.f; \
                const float zm[8] = M3_MUL8(a0##S, q0##S); const float zc[8] = M3_MUL8(a1##S, c1##S); const float zp[8] = M3_MUL8(a2##S, q2##S); \
                const float cbv[8] = {bflo(bb##S.x), bfhi(bb##S.x), bflo(bb##S.y), bfhi(bb##S.y), bflo(bb##S.z), bfhi(bb##S.z), bflo(bb##S.w), bfhi(bb##S.w)}; \
                _Pragma("unroll") for (int e = 0; e < 4; ++e) { r8[e] = cbv[e] * (w00[e] * (m0 * zm[e]) + w10[e] * zc[e] + w20[e] * (m2 * zp[e]) + bs0[e]); \
                    r8[4 + e] = cbv[4 + e] * (w01[e] * (m0 * zm[4 + e]) + w11[e] * zc[4 + e] + w21[e] * (m2 * zp[4 + e]) + bs1[e]); } \
                wo.x = cvt_pk_bf16(r8[0], r8[1]); wo.y = cvt_pk_bf16(r8[2], r8[3]); wo.z = cvt_pk_bf16(r8[4], r8[5]); wo.w = cvt_pk_bf16(r8[6], r8[7]); \
                *(v4u*)(OCVr + (size_t)rw_ * 512 + c0) = wo; } while (0)
            M3_DECL(A); M3_DECL(B);
            { int row = gw;
              M3_LOAD(row, A);
              while (row < TG) {
                  M3_LOAD(row + NGW, B);
                  M3_PROC(row, A);
                  row += NGW;
                  M3_LOAD(row + NGW, A);
                  if (row < TG) M3_PROC(row, B);
                  row += NGW;
              } }
#undef M3_DECL
#undef M3_LOAD
#undef M3_MUL8
#undef M3_PROC
        } else if (kind == K_M4) {
            pg8::Gemm gm{ONA, Wl + OFF_HG, 3 * TG, 3 * D, 512}; pg8::MergeOrder S; S.init(TG, D, G, bid);
            pg8::EpiMerge E{(const unsigned char*)PG + (size_t)g2 * TG * 3072, PA};
#ifndef NO_MERGE
            for (int rep = 0; rep < REP_MERGE; ++rep) pg8::gemm_phase<pg8::EpiMerge, pg8::MergeOrder, PGA, PGS>(lds, gm, S, E);
#endif
        } else {
            const f32x4* fgp = (const f32x4*)args.in[19] + lane;
            const f32x4 fg0 = fgp[0], fg1 = fgp[64], fg2 = fgp[128], fg3 = fgp[192];
#define GF_LOAD(rowx_, S) do { const int r_ = min((rowx_), 2 * TG - 1); const v2u* bi_ = (const v2u*)(XBp + (size_t)r_ * D) + lane; const f32x4* sq_ = (const f32x4*)(SSQp + (size_t)r_ * 16); \
                _Pragma("unroll") for (int j = 0; j < 4; ++j) { fb##S[j] = bi_[64 * j]; fs##S[j] = sq_[j]; } } while (0)
#define GF_PROC(rowx_, S) do { const int rw_ = (rowx_); float t_ = 0.f; \
                _Pragma("unroll") for (int j = 0; j < 4; ++j) t_ += (fs##S[j][0] + fs##S[j][1]) + (fs##S[j][2] + fs##S[j][3]); \
                const float rs_ = __builtin_amdgcn_rsqf(t_ * (1.0f / 1024.0f) + 1e-6f); f32x4* xo_ = (f32x4*)(X + (size_t)rw_ * D) + lane; \
                { const v2u w_ = fb##S[0]; const f32x4 v = {bflo(w_.x), bfhi(w_.x), bflo(w_.y), bfhi(w_.y)}; xo_[0] = v * fg0 * rs_; } \
                { const v2u w_ = fb##S[1]; const f32x4 v = {bflo(w_.x), bfhi(w_.x), bflo(w_.y), bfhi(w_.y)}; xo_[64] = v * fg1 * rs_; } \
                { const v2u w_ = fb##S[2]; const f32x4 v = {bflo(w_.x), bfhi(w_.x), bflo(w_.y), bfhi(w_.y)}; xo_[128] = v * fg2 * rs_; } \
                { const v2u w_ = fb##S[3]; const f32x4 v = {bflo(w_.x), bfhi(w_.x), bflo(w_.y), bfhi(w_.y)}; xo_[192] = v * fg3 * rs_; } } while (0)
            v2u fbA[4], fbB[4]; f32x4 fsA[4], fsB[4];
            { int rowi = gw;
              GF_LOAD(rowi, A);
              while (rowi < 2 * TG) {
                  GF_LOAD(rowi + NGW, B); GF_PROC(rowi, A); rowi += NGW;
                  GF_LOAD(rowi + NGW, A); if (rowi < 2 * TG) GF_PROC(rowi, B); rowi += NGW;
              } }
#undef GF_LOAD
#undef GF_PROC
        }
#if TPROBE
        __syncthreads();
        const unsigned long long tp1 = __builtin_amdgcn_s_memrealtime();
#endif
        if (ph + 1 < hi) { for (int rep = 0; rep < REP_SYNC; ++rep) { if (hi < 0) grid.sync(); else xcd_barrier(xbar);     } }
#if TPROBE
        const unsigned long long tp2 = __builtin_amdgcn_s_memrealtime();
        if (TPROBE == 100) tacc += tp2 - tp1;
        else if (kind == TPROBE - 1) tacc += tp1 - tp0;
#endif
    }
#if TPROBE
    if (blockIdx.x == TPROBE_BLOCK) { const unsigned long long te = __builtin_amdgcn_s_memrealtime(); while (__builtin_amdgcn_s_memrealtime() - te < tacc) __builtin_amdgcn_s_sleep(8); }
#endif
}
constexpr int N_PHASES = 1 + 2 * PH_PER_PAIR;

extern "C" void kernel_launch(void* const* d_in, const int* in_sizes, int n_in, void* d_out, int out_size, void* d_ws, size_t ws_size, hipStream_t stream) {
    static int grid = 0;
    if (grid == 0) {
        if (n_in != 20 || ws_size < WS_END) { fprintf(stderr, "kernel_launch: unexpected n_in %d / ws %zu\n", n_in, ws_size); grid = -1; return; }
        int dev = 0, cus = 0, per_cu = 0;
        hipGetDevice(&dev); hipDeviceGetAttribute(&cus, hipDeviceAttributeMultiprocessorCount, dev);
        hipFuncSetAttribute((const void*)mk_fwd, hipFuncAttributeMaxDynamicSharedMemorySize, LDS_BYTES);
        hipOccupancyMaxActiveBlocksPerMultiprocessor(&per_cu, (const void*)mk_fwd, NTHR, LDS_BYTES);
        if (per_cu < 1) per_cu = 1;
        grid = cus * per_cu;
        (void)hipGetLastError();
    }
    if (grid < 0) return;
    hipMemsetAsync((char*)d_ws + WS_CTL, 0, CTL_BYTES, stream);
    Args a{};
    for (int i = 0; i < 20; ++i) a.in[i] = (const float*)d_in[i];
    a.out = (float*)d_out; a.ws = (unsigned char*)d_ws;
#if ONE_LAUNCH
    a.ph_lo = 0; a.ph_hi = N_PHASES;
    void* kargs[] = {&a};
    hipError_t e = hipLaunchCooperativeKernel((const void*)mk_fwd, dim3(grid), dim3(NTHR), kargs, LDS_BYTES, stream);
    if (e != hipSuccess) fprintf(stderr, "cooperative launch failed: %s (grid %d)\n", hipGetErrorString(e), grid);
#else
    for (int p = 0; p < N_PHASES; ++p) { a.ph_lo = p; a.ph_hi = p + 1; hipLaunchKernelGGL(mk_fwd, dim3(grid), dim3(NTHR), LDS_BYTES, stream, a); }
#endif
}
```
